# Optimizing an MI355X kernel written in HIP

```python
import math
import jax
import jax.numpy as jnp
from jax import lax
import numpy as np

D_MODEL = 1024
BATCH = 2
SEQ = 8192
DEPTH = 2

N_EVEN = (DEPTH + 1) // 2
N_ODD = DEPTH // 2

HEAD_DIM = 64
NEG = -1e30
BIG = 1e30
NORM_EPS = 1e-6

N_BUCKETS = 32
MAX_DISTANCE = 1024
N_BIAS_HEADS = 8

NSA_HEADS = 8
NSA_KV_HEADS = 2
NSA_GROUP = NSA_HEADS // NSA_KV_HEADS
CMP_LEN = 32
CMP_STRIDE = 16
CMP_HIDDEN = 256
SLC_BLOCK = 64
SLC_TOPN = 16
NSA_WINDOW = 512
NSA_QBLOCK = 128

MOBA_HEADS = 8
MOBA_BLOCK = 256
MOBA_TOPK = 3
MOBA_QBLOCK = 32

MLA_HEADS = 4
MLA_Q_RANK = 256
MLA_KV_RANK = 128
MLA_NOPE = 128
MLA_ROPE = 64
MLA_V = 128
ROPE_THETA = 10000.0
DENSE_QBLOCK = 128

SWA_HEADS = 8
SWA_KV_HEADS = 2
SWA_GROUP = SWA_HEADS // SWA_KV_HEADS
SWA_WINDOW = 128
SWA_QBLOCK = 128

N_EXPERTS = 16
N_GROUPS = 4
EXPERTS_PER_GROUP = N_EXPERTS // N_GROUPS
TOP_K = 2
D_EXPERT = 512
MOE_BLOCK = 256

ADA_INIT = 0.5

EVEN_WIDTHS = (NSA_HEADS * HEAD_DIM,) + (NSA_KV_HEADS * HEAD_DIM,) * 6 + (3 * NSA_HEADS,) + (MOBA_HEADS * HEAD_DIM,) * 3
EVEN_IN = sum(EVEN_WIDTHS)
EVEN_OUT = NSA_HEADS * HEAD_DIM + MOBA_HEADS * HEAD_DIM
ODD_WIDTHS = (MLA_Q_RANK, MLA_KV_RANK, MLA_ROPE, SWA_HEADS * HEAD_DIM, SWA_KV_HEADS * HEAD_DIM, SWA_KV_HEADS * HEAD_DIM)
ODD_IN = sum(ODD_WIDTHS)
ODD_OUT = MLA_HEADS * MLA_V + SWA_HEADS * HEAD_DIM

kernel_name = "hybrid_nsa_moba_mla_swa_grouped_moe"


def rmsnorm(x, g):
    xf = x.astype(jnp.float32)
    y = xf * lax.rsqrt(jnp.mean(xf * xf, axis=-1, keepdims=True) + NORM_EPS)
    return (y * g.astype(jnp.float32)).astype(x.dtype)


def split_cols(x, widths):
    idx, acc = [], 0
    for w in widths[:-1]:
        acc += w
        idx.append(acc)
    return jnp.split(x, idx, axis=-1)


def masked_softmax(s, mask):
    s = jnp.where(mask, s.astype(jnp.float32), NEG)
    p = jax.nn.softmax(s, axis=-1)
    return jnp.where(mask, p, 0.0)


def rel_bucket(dist):
    exact = N_BUCKETS // 2
    d = jnp.maximum(dist, 0)
    log_part = exact + (jnp.log(jnp.maximum(d, 1).astype(jnp.float32) / exact)
                        / math.log(MAX_DISTANCE / exact) * (N_BUCKETS - exact)).astype(jnp.int32)
    return jnp.where(d < exact, d, jnp.minimum(log_part, N_BUCKETS - 1))


def shared_bias(rel_table, dist, n_kv):
    b = jnp.moveaxis(rel_table[rel_bucket(dist)], -1, 0).astype(jnp.float32)
    return b.reshape(n_kv, -1, *dist.shape)


def gathered_bias(rel_table, dist, n_kv):
    table = rel_table.reshape(N_BUCKETS, n_kv, -1)
    kv = jnp.arange(n_kv)[None, :, None, None]
    return jnp.moveaxis(table[rel_bucket(dist), kv], -1, 2).astype(jnp.float32)


def rope_tables(S, dim):
    inv = ROPE_THETA ** (-jnp.arange(0, dim, 2, dtype=jnp.float32) / dim)
    ang = jnp.arange(S, dtype=jnp.float32)[:, None] * inv[None, :]
    return jnp.cos(ang), jnp.sin(ang)


def apply_rope(x, cos, sin):
    half = x.shape[-1] // 2
    x1 = x[..., :half].astype(jnp.float32)
    x2 = x[..., half:].astype(jnp.float32)
    return jnp.concatenate([x1 * cos - x2 * sin, x1 * sin + x2 * cos], axis=-1).astype(x.dtype)


def adaln(c, w, b):
    m = jax.nn.silu(c) @ w + b
    return jnp.split(m[:, None, :], 6, axis=-1)


def nsa_attention(q, kc, vc, ks, vs, kw, vw, gates, pos_k, pos_v, ck_w1, ck_w2, cv_w1, cv_w2, rel_table):
    B, S, _ = q.shape
    Hk, G, dh, QB = NSA_KV_HEADS, NSA_GROUP, HEAD_DIM, NSA_QBLOCK
    scale = dh ** -0.5
    q = q.reshape(B, S, Hk, G, dh).transpose(0, 2, 3, 1, 4)
    to_kv = lambda t: t.reshape(B, S, Hk, dh).transpose(0, 2, 1, 3)
    kc, vc, ks, vs, kw, vw = (to_kv(t) for t in (kc, vc, ks, vs, kw, vw))
    g = jax.nn.sigmoid(gates.astype(jnp.float32)).reshape(B, S, Hk, G, 3).transpose(0, 2, 3, 1, 4)

    n_cmp = (S - CMP_LEN) // CMP_STRIDE + 1
    cmp_start = np.arange(n_cmp, dtype=np.int32) * CMP_STRIDE
    win_idx = cmp_start[:, None] + np.arange(CMP_LEN, dtype=np.int32)[None, :]
    cmp_end = cmp_start + CMP_LEN - 1

    def compress(t, pos, w1, w2):
        blocks = t[:, :, win_idx, :] + pos
        flat = blocks.reshape(B, Hk, n_cmp, CMP_LEN * dh)
        return jax.nn.gelu(flat @ w1) @ w2

    k_cmp = compress(kc, pos_k, ck_w1, ck_w2)
    v_cmp = compress(vc, pos_v, cv_w1, cv_w2)

    n_slc = S // SLC_BLOCK
    slc_lo = np.arange(n_slc, dtype=np.int32) * SLC_BLOCK
    overlap = ((cmp_start[:, None] <= slc_lo[None, :] + SLC_BLOCK - 1)
               & (cmp_end[:, None] >= slc_lo[None, :])).astype(np.float32)
    n_sel = min(SLC_TOPN, n_slc)
    ks_blocks = ks.reshape(B, Hk, n_slc, SLC_BLOCK, dh)
    vs_blocks = vs.reshape(B, Hk, n_slc, SLC_BLOCK, dh)

    pad = ((0, 0), (0, 0), (NSA_WINDOW, 0), (0, 0))
    kw_pad, vw_pad = jnp.pad(kw, pad), jnp.pad(vw, pad)

    nq = S // QB
    q_blocks = jnp.moveaxis(q.reshape(B, Hk, G, nq, QB, dh), 3, 0)
    g_blocks = jnp.moveaxis(g.reshape(B, Hk, G, nq, QB, 3), 3, 0)
    b_idx = jnp.arange(B)[:, None, None, None]
    kv_idx = jnp.arange(Hk)[None, :, None, None]

    def block(args):
        qb, gb, i = args
        start = i * QB
        t = start + jnp.arange(QB)
        s_c = jnp.einsum('bkgqd,bknd->bkgqn', qb, k_cmp).astype(jnp.float32) * scale \
            + shared_bias(rel_table, t[:, None] - cmp_end[None, :], Hk)
        p_c = masked_softmax(s_c, cmp_end[None, :] <= t[:, None])
        o_c = jnp.einsum('bkgqn,bknd->bkgqd', p_c.astype(v_cmp.dtype), v_cmp)
        imp = jnp.einsum('bkgqn,nm->bkqm', p_c, overlap)
        blk_t = (t // SLC_BLOCK)[:, None]
        j = jnp.arange(n_slc)[None, :]
        forced = (j == 0) | (j == blk_t) | (j == blk_t - 1)
        score = jnp.where(forced, BIG, jnp.where(j <= blk_t, imp, NEG))
        sel = lax.top_k(score, n_sel)[1]
        k_sel = ks_blocks[b_idx, kv_idx, sel].reshape(B, Hk, QB, n_sel * SLC_BLOCK, dh)
        v_sel = vs_blocks[b_idx, kv_idx, sel].reshape(B, Hk, QB, n_sel * SLC_BLOCK, dh)
        pos_sel = (sel[..., None] * SLC_BLOCK + jnp.arange(SLC_BLOCK)).reshape(B, Hk, QB, -1)
        dist_s = t[:, None] - pos_sel
        s_s = jnp.einsum('bkgqd,bkqsd->bkgqs', qb, k_sel).astype(jnp.float32) * scale \
            + gathered_bias(rel_table, dist_s, Hk)
        p_s = masked_softmax(s_s, (dist_s >= 0)[:, :, None])
        o_s = jnp.einsum('bkgqs,bkqsd->bkgqd', p_s.astype(v_sel.dtype), v_sel)
        k_w = lax.dynamic_slice_in_dim(kw_pad, start, QB + NSA_WINDOW, axis=2)
        v_w = lax.dynamic_slice_in_dim(vw_pad, start, QB + NSA_WINDOW, axis=2)
        dist_w = t[:, None] - (start - NSA_WINDOW + jnp.arange(QB + NSA_WINDOW))[None, :]
        s_w = jnp.einsum('bkgqd,bksd->bkgqs', qb, k_w).astype(jnp.float32) * scale \
            + shared_bias(rel_table, dist_w, Hk)
        p_w = masked_softmax(s_w, (dist_w >= 0) & (dist_w < NSA_WINDOW))
        o_w = jnp.einsum('bkgqs,bksd->bkgqd', p_w.astype(v_w.dtype), v_w)
        return (gb[..., 0:1] * o_c + gb[..., 1:2] * o_s + gb[..., 2:3] * o_w).astype(qb.dtype)

    o = lax.map(block, (q_blocks, g_blocks, jnp.arange(nq)))
    return o.transpose(1, 0, 4, 2, 3, 5).reshape(B, S, NSA_HEADS * dh)


def moba_attention(q, k, v, rel_table):
    B, S, _ = q.shape
    H, dh, QB = MOBA_HEADS, HEAD_DIM, MOBA_QBLOCK
    scale = dh ** -0.5
    q, k, v = (t.reshape(B, S, H, dh).transpose(0, 2, 1, 3) for t in (q, k, v))
    n_blk = -(-S // MOBA_BLOCK)
    pad = ((0, 0), (0, 0), (0, n_blk * MOBA_BLOCK - S), (0, 0))
    k_pad, v_pad = jnp.pad(k, pad), jnp.pad(v, pad)
    k_blocks = k_pad.reshape(B, H, n_blk, MOBA_BLOCK, dh)
    v_blocks = v_pad.reshape(B, H, n_blk, MOBA_BLOCK, dh)
    k_mean = jnp.mean(k_blocks.astype(jnp.float32), axis=3)
    n_top = min(MOBA_TOPK, n_blk)
    n_s = n_top * MOBA_BLOCK
    nq = S // QB
    q_blocks = jnp.moveaxis(q.reshape(B, H, nq, QB, dh), 2, 0)
    b_idx = jnp.arange(B)[:, None, None, None]
    h_idx = jnp.arange(H)[None, :, None, None]

    def block(args):
        qb, i = args
        start = i * QB
        t = start + jnp.arange(QB)
        own = start // MOBA_BLOCK
        gate = jnp.einsum('bhqd,bhnd->bhqn', qb.astype(jnp.float32), k_mean)
        gate = jnp.where(jnp.arange(n_blk) < own, gate, NEG)
        sel = lax.top_k(gate, n_top)[1]
        k_sel = k_blocks[b_idx, h_idx, sel].reshape(B, H, QB, n_s, dh)
        v_sel = v_blocks[b_idx, h_idx, sel].reshape(B, H, QB, n_s, dh)
        pos_sel = (sel[..., None] * MOBA_BLOCK + jnp.arange(MOBA_BLOCK)).reshape(B, H, QB, n_s)
        mask_sel = pos_sel < own * MOBA_BLOCK
        k_own = lax.dynamic_slice_in_dim(k_pad, own * MOBA_BLOCK, MOBA_BLOCK, axis=2)
        v_own = lax.dynamic_slice_in_dim(v_pad, own * MOBA_BLOCK, MOBA_BLOCK, axis=2)
        dist_own = t[:, None] - (own * MOBA_BLOCK + jnp.arange(MOBA_BLOCK))[None, :]
        s_sel = jnp.einsum('bhqd,bhqsd->bhqs', qb, k_sel).astype(jnp.float32) * scale \
            + gathered_bias(rel_table, t[:, None] - pos_sel, H)[:, :, 0]
        s_own = jnp.einsum('bhqd,bhsd->bhqs', qb, k_own).astype(jnp.float32) * scale \
            + shared_bias(rel_table, dist_own, H)[:, 0]
        s = jnp.concatenate([s_sel, s_own], axis=-1)
        mask = jnp.concatenate([mask_sel, jnp.broadcast_to(dist_own >= 0, s_own.shape)], axis=-1)
        p = masked_softmax(s, mask).astype(v.dtype)
        return jnp.einsum('bhqs,bhqsd->bhqd', p[..., :n_s], v_sel) \
            + jnp.einsum('bhqs,bhsd->bhqd', p[..., n_s:], v_own)

    o = lax.map(block, (q_blocks, jnp.arange(nq)))
    return o.transpose(1, 0, 3, 2, 4).reshape(B, S, H * dh)


def mla_attention(c_q, c_kv, k_rope, q_norm, kv_norm, w_q_up, w_kv_up):
    B, S, _ = c_q.shape
    H, QB = MLA_HEADS, DENSE_QBLOCK
    q = (rmsnorm(c_q, q_norm) @ w_q_up).reshape(B, S, H, MLA_NOPE + MLA_ROPE)
    kv = (rmsnorm(c_kv, kv_norm) @ w_kv_up).reshape(B, S, H, MLA_NOPE + MLA_V)
    cos, sin = rope_tables(S, MLA_ROPE)
    q_nope = q[..., :MLA_NOPE]
    q_rope = apply_rope(q[..., MLA_NOPE:], cos[:, None, :], sin[:, None, :])
    k_rope = apply_rope(k_rope, cos, sin)
    k_nope = kv[..., :MLA_NOPE].transpose(0, 2, 1, 3)
    v = kv[..., MLA_NOPE:].transpose(0, 2, 1, 3)
    scale = (MLA_NOPE + MLA_ROPE) ** -0.5
    nq = S // QB
    qn_b = q_nope.reshape(B, nq, QB, H, MLA_NOPE).transpose(1, 0, 3, 2, 4)
    qr_b = q_rope.reshape(B, nq, QB, H, MLA_ROPE).transpose(1, 0, 3, 2, 4)
    kpos = jnp.arange(S)

    def block(args):
        qn, qr, i = args
        t = i * QB + jnp.arange(QB)
        s = (jnp.einsum('bhqd,bhkd->bhqk', qn, k_nope)
             + jnp.einsum('bhqd,bkd->bhqk', qr, k_rope)).astype(jnp.float32) * scale
        s = jnp.where(kpos[None, :] <= t[:, None], s, NEG)
        p = jax.nn.softmax(s, axis=-1).astype(v.dtype)
        return jnp.einsum('bhqk,bhkd->bhqd', p, v)

    o = lax.map(block, (qn_b, qr_b, jnp.arange(nq)))
    return o.transpose(1, 0, 3, 2, 4).reshape(B, S, H * MLA_V)


def swa_sink_attention(q, k, v, sinks, rel_table):
    B, S, _ = q.shape
    Hk, G, dh, QB, W = SWA_KV_HEADS, SWA_GROUP, HEAD_DIM, SWA_QBLOCK, SWA_WINDOW
    scale = dh ** -0.5
    q = q.reshape(B, S, Hk, G, dh).transpose(0, 2, 3, 1, 4)
    k = k.reshape(B, S, Hk, dh).transpose(0, 2, 1, 3)
    v = v.reshape(B, S, Hk, dh).transpose(0, 2, 1, 3)
    pad = ((0, 0), (0, 0), (W, 0), (0, 0))
    k_pad, v_pad = jnp.pad(k, pad), jnp.pad(v, pad)
    nq = S // QB
    q_blocks = jnp.moveaxis(q.reshape(B, Hk, G, nq, QB, dh), 3, 0)
    sink = sinks.astype(jnp.float32).reshape(Hk, G, 1, 1)

    def block(args):
        qb, i = args
        start = i * QB
        t = start + jnp.arange(QB)
        k_w = lax.dynamic_slice_in_dim(k_pad, start, QB + W, axis=2)
        v_w = lax.dynamic_slice_in_dim(v_pad, start, QB + W, axis=2)
        dist = t[:, None] - (start - W + jnp.arange(QB + W))[None, :]
        mask = (dist >= 0) & (dist < W)
        s = jnp.einsum('bkgqd,bksd->bkgqs', qb, k_w).astype(jnp.float32) * scale \
            + shared_bias(rel_table, dist, Hk)
        s = jnp.where(mask, s, NEG)
        m = jnp.maximum(jnp.max(s, axis=-1, keepdims=True), sink)
        e = jnp.exp(s - m)
        p = e / (jnp.sum(e, axis=-1, keepdims=True) + jnp.exp(sink - m))
        return jnp.einsum('bkgqs,bksd->bkgqd', p.astype(v_w.dtype), v_w)

    o = lax.map(block, (q_blocks, jnp.arange(nq)))
    return o.transpose(1, 0, 4, 2, 3, 5).reshape(B, S, SWA_HEADS * dh)


def even_mixer(h, w_in, w_out, pos_k, pos_v, ck_w1, ck_w2, cv_w1, cv_w2, rel_table):
    q_a, kc, vc, ks, vs, kw, vw, gates, q_b, k_b, v_b = split_cols(h @ w_in, EVEN_WIDTHS)
    o_a = nsa_attention(q_a, kc, vc, ks, vs, kw, vw, gates, pos_k, pos_v, ck_w1, ck_w2, cv_w1, cv_w2, rel_table)
    o_b = moba_attention(q_b, k_b, v_b, rel_table)
    return jnp.concatenate([o_a, o_b.astype(o_a.dtype)], axis=-1) @ w_out


def odd_mixer(h, w_in, w_out, q_norm, kv_norm, w_q_up, w_kv_up, sinks, rel_table):
    c_q, c_kv, k_rope, q_d, k_d, v_d = split_cols(h @ w_in, ODD_WIDTHS)
    o_c = mla_attention(c_q, c_kv, k_rope, q_norm, kv_norm, w_q_up, w_kv_up)
    o_d = swa_sink_attention(q_d, k_d, v_d, sinks, rel_table)
    return jnp.concatenate([o_c, o_d.astype(o_c.dtype)], axis=-1) @ w_out


def grouped_moe(h, router_w, router_b, w_gate, w_up, w_down):
    B, S, D = h.shape
    T = B * S
    E = N_EXPERTS
    xf = h.reshape(T, D)
    aff = jax.nn.sigmoid((xf @ router_w).astype(jnp.float32))
    biased = (aff + router_b.astype(jnp.float32)).reshape(T, N_GROUPS, EXPERTS_PER_GROUP)
    grp_score = jnp.sum(lax.top_k(biased, TOP_K)[0], axis=-1)
    g_sel = jnp.argmax(grp_score, axis=-1)
    tok = jnp.arange(T)
    local = lax.top_k(biased[tok, g_sel], TOP_K)[1]
    expert = g_sel[:, None] * EXPERTS_PER_GROUP + local
    w = aff[tok[:, None], expert]
    w = w / jnp.sum(w, axis=-1, keepdims=True)

    A = T * TOP_K
    flat_e = expert.reshape(A)
    flat_tok = jnp.repeat(tok, TOP_K)
    flat_w = w.reshape(A)
    order = jnp.argsort(flat_e)
    se, stok, sw = flat_e[order], flat_tok[order], flat_w[order]
    counts = jnp.zeros((E,), jnp.int32).at[flat_e].add(1)
    padded = (counts + MOE_BLOCK - 1) // MOE_BLOCK * MOE_BLOCK
    start = jnp.cumsum(counts) - counts
    pend = jnp.cumsum(padded)
    pstart = pend - padded
    dest = pstart[se] + jnp.arange(A) - start[se]
    n_blocks = (A + E * (MOE_BLOCK - 1) + MOE_BLOCK - 1) // MOE_BLOCK
    P = n_blocks * MOE_BLOCK
    tok_buf = jnp.zeros((P,), jnp.int32).at[dest].set(stok)
    w_buf = jnp.zeros((P,), jnp.float32).at[dest].set(sw)
    blk_expert = jnp.minimum(jnp.searchsorted(pend, jnp.arange(n_blocks) * MOE_BLOCK, side='right'), E - 1)
    xs = xf[tok_buf].reshape(n_blocks, MOE_BLOCK, D)

    def expert_block(args):
        xb, e = args
        hid = jax.nn.silu(xb @ w_gate[e]) * (xb @ w_up[e])
        return hid @ w_down[e]

    ys = lax.map(expert_block, (xs, blk_expert)).reshape(P, D)
    out = jnp.zeros((T, D), ys.dtype).at[tok_buf].add(ys * w_buf[:, None].astype(ys.dtype))
    return out.reshape(B, S, D).astype(h.dtype)


def setup_inputs(seed: int = 0) -> dict:
    key = jax.random.key(seed)
    ks = iter(jax.random.split(key, 40))
    D = D_MODEL

    def nrm(shape, std):
        return jax.random.normal(next(ks), shape, jnp.float32) * std

    def gain(shape):
        return 1.0 + nrm(shape, 0.02)

    return {
        "x": nrm((BATCH, SEQ, D), 1.0),
        "c": nrm((BATCH, D), 1.0),
        "rel_table": nrm((N_BUCKETS, N_BIAS_HEADS), 0.5),
        "router_w": nrm((D, N_EXPERTS), D ** -0.5),
        "router_b": nrm((N_EXPERTS,), 0.01),
        "final_norm": gain((D,)),
        "norm_mix": gain((DEPTH, D)),
        "norm_ffn": gain((DEPTH, D)),
        "ada_w": nrm((DEPTH, D, 6 * D), ADA_INIT * D ** -0.5),
        "ada_b": nrm((DEPTH, 6 * D), 0.02),
        "moe_w_gate": nrm((DEPTH, N_EXPERTS, D, D_EXPERT), D ** -0.5),
        "moe_w_up": nrm((DEPTH, N_EXPERTS, D, D_EXPERT), D ** -0.5),
        "moe_w_down": nrm((DEPTH, N_EXPERTS, D_EXPERT, D), D_EXPERT ** -0.5),
        "ev_w_in": nrm((N_EVEN, D, EVEN_IN), D ** -0.5),
        "ev_w_out": nrm((N_EVEN, EVEN_OUT, D), EVEN_OUT ** -0.5),
        "nsa_pos_k": nrm((N_EVEN, CMP_LEN, HEAD_DIM), 0.1),
        "nsa_pos_v": nrm((N_EVEN, CMP_LEN, HEAD_DIM), 0.1),
        "nsa_ck_w1": nrm((N_EVEN, CMP_LEN * HEAD_DIM, CMP_HIDDEN), (CMP_LEN * HEAD_DIM) ** -0.5),
        "nsa_ck_w2": nrm((N_EVEN, CMP_HIDDEN, HEAD_DIM), CMP_HIDDEN ** -0.5),
        "nsa_cv_w1": nrm((N_EVEN, CMP_LEN * HEAD_DIM, CMP_HIDDEN), (CMP_LEN * HEAD_DIM) ** -0.5),
        "nsa_cv_w2": nrm((N_EVEN, CMP_HIDDEN, HEAD_DIM), CMP_HIDDEN ** -0.5),
        "od_w_in": nrm((N_ODD, D, ODD_IN), D ** -0.5),
        "od_w_out": nrm((N_ODD, ODD_OUT, D), ODD_OUT ** -0.5),
        "mla_q_norm": gain((N_ODD, MLA_Q_RANK)),
        "mla_kv_norm": gain((N_ODD, MLA_KV_RANK)),
        "mla_w_q_up": nrm((N_ODD, MLA_Q_RANK, MLA_HEADS * (MLA_NOPE + MLA_ROPE)), MLA_Q_RANK ** -0.5),
        "mla_w_kv_up": nrm((N_ODD, MLA_KV_RANK, MLA_HEADS * (MLA_NOPE + MLA_V)), MLA_KV_RANK ** -0.5),
        "swa_sinks": nrm((N_ODD, SWA_HEADS), 1.0),
    }


def reference(x, c, rel_table, router_w, router_b, final_norm, norm_mix, norm_ffn, ada_w, ada_b,
              moe_w_gate, moe_w_up, moe_w_down, ev_w_in, ev_w_out, nsa_pos_k, nsa_pos_v,
              nsa_ck_w1, nsa_ck_w2, nsa_cv_w1, nsa_cv_w2, od_w_in, od_w_out, mla_q_norm,
              mla_kv_norm, mla_w_q_up, mla_w_kv_up, swa_sinks):
    for layer in range(DEPTH):
        shift_m, scale_m, gate_m, shift_f, scale_f, gate_f = adaln(c, ada_w[layer], ada_b[layer])
        h = rmsnorm(x, norm_mix[layer]) * (1.0 + scale_m) + shift_m
        i = layer // 2
        if layer % 2 == 0:
            mix = even_mixer(h, ev_w_in[i], ev_w_out[i], nsa_pos_k[i], nsa_pos_v[i], nsa_ck_w1[i],
                             nsa_ck_w2[i], nsa_cv_w1[i], nsa_cv_w2[i], rel_table)
        else:
            mix = odd_mixer(h, od_w_in[i], od_w_out[i], mla_q_norm[i], mla_kv_norm[i],
                            mla_w_q_up[i], mla_w_kv_up[i], swa_sinks[i], rel_table)
        x = x + gate_m * mix.astype(x.dtype)
        h = rmsnorm(x, norm_ffn[layer]) * (1.0 + scale_f) + shift_f
        x = x + gate_f * grouped_moe(h, router_w, router_b, moe_w_gate[layer], moe_w_up[layer],
                                     moe_w_down[layer]).astype(x.dtype)
    return rmsnorm(x, final_norm)
```

```cpp
#include <hip/hip_runtime.h>
#include <stdint.h>

#define T_TOK 16384
#define SEQ 8192
#define DM 1024
#define NEGF (-1e30f)
#define BIGF (1e30f)

typedef unsigned short bf16_t;

__device__ __forceinline__ float bf2f(bf16_t v) { return __uint_as_float(((unsigned)v) << 16); }
__device__ __forceinline__ bf16_t f2bf(float f) {
    unsigned u = __float_as_uint(f);
    u += 0x7fffu + ((u >> 16) & 1u);
    return (bf16_t)(u >> 16);
}
__device__ __forceinline__ float wsum(float v) {
#pragma unroll
    for (int o = 32; o > 0; o >>= 1) v += __shfl_xor(v, o);
    return v;
}
__device__ __forceinline__ float siluf(float v) { return v / (1.0f + __expf(-v)); }
__device__ __forceinline__ float sigmf(float v) { return 1.0f / (1.0f + __expf(-v)); }
__device__ __forceinline__ float gelu_tanh(float x) {
    const float k0 = 0.7978845608028654f, k1 = 0.044715f;
    float u = k0 * (x + k1 * x * x * x);
    return 0.5f * x * (1.0f + tanhf(u));
}
__device__ __forceinline__ int rel_bucket(int d) {
    if (d < 16) return d < 0 ? 0 : d;
    int b = 16;
    b += (d >= 21); b += (d >= 27); b += (d >= 35); b += (d >= 46); b += (d >= 59); b += (d >= 77); b += (d >= 99); b += (d >= 128);
    b += (d >= 166); b += (d >= 216); b += (d >= 280); b += (d >= 363); b += (d >= 470); b += (d >= 609); b += (d >= 790);
    return b;
}

struct P {
    const float *x, *c, *rel, *router_w, *router_b, *final_norm, *norm_mix, *norm_ffn, *ada_w, *ada_b, *moe_wg, *moe_wu, *moe_wd,
        *ev_w_in, *ev_w_out, *pos_k, *pos_v, *ck_w1, *ck_w2, *cv_w1, *cv_w2, *od_w_in, *od_w_out, *q_norm, *kv_norm, *w_q_up, *w_kv_up, *sinks;
    float* out;
    unsigned* bar; int* cnt;
    float *modv, *ropec, *ropes, *blut, *gates, *kcmp, *vcmp, *chid, *kmean, *tokw;
    bf16_t *h, *proj, *o, *hid, *y, *proj1, *qmla, *kvmla, *krope, *cqn;
    int* list;
};

template <int NB, class AF, class BF, class EF>
__device__ __forceinline__ void gemm_tile64(int m0, int n0, int K, AF a, BF b, EF epi, float* sm) {
    float(*As)[68] = (float(*)[68])sm;
    float(*Bs)[68] = (float(*)[68])(sm + 16 * 68);
    const int tid = threadIdx.x, ty = tid >> 4, tx = tid & 15;
    float acc[NB][4][4];
#pragma unroll
    for (int nb = 0; nb < NB; ++nb)
#pragma unroll
        for (int i = 0; i < 4; ++i)
#pragma unroll
            for (int j = 0; j < 4; ++j) acc[nb][i][j] = 0.f;
    for (int k0 = 0; k0 < K; k0 += 16) {
#pragma unroll
        for (int i = 0; i < 4; ++i) { const int idx = tid + 256 * i, m = idx >> 4, k = idx & 15; As[k][m] = a(m0 + m, k0 + k); }
#pragma unroll
        for (int nb = 0; nb < NB; ++nb)
#pragma unroll
            for (int i = 0; i < 4; ++i) { const int idx = tid + 256 * i, k = idx >> 6, n = idx & 63; Bs[nb * 16 + k][n] = b(nb, k0 + k, n0 + n); }
        __syncthreads();
#pragma unroll
        for (int k = 0; k < 16; ++k) {
            const float4 av = *(const float4*)&As[k][ty * 4];
            const float aa[4] = {av.x, av.y, av.z, av.w};
#pragma unroll
            for (int nb = 0; nb < NB; ++nb) {
                const float4 bv = *(const float4*)&Bs[nb * 16 + k][tx * 4];
                const float bb[4] = {bv.x, bv.y, bv.z, bv.w};
#pragma unroll
                for (int i = 0; i < 4; ++i)
#pragma unroll
                    for (int j = 0; j < 4; ++j) acc[nb][i][j] += aa[i] * bb[j];
            }
        }
        __syncthreads();
    }
#pragma unroll
    for (int i = 0; i < 4; ++i)
#pragma unroll
        for (int j = 0; j < 4; ++j) epi(m0 + ty * 4 + i, n0 + tx * 4 + j, acc[0][i][j], acc[NB - 1][i][j]);
}

__device__ void st_prologue(const P& p, int wg, int nwg, float* sm) {
    const int tid = threadIdx.x;
    for (int w = wg; w < 192; w += nwg) {
        const int l = w / 96, cg = w % 96, col = cg * 64 + (tid & 63), kq = tid >> 6;
        const float* W = p.ada_w + (size_t)l * 1024 * 6144;
        float a0 = 0.f, a1 = 0.f;
        for (int k = kq * 256; k < kq * 256 + 256; ++k) {
            const float wv = W[(size_t)k * 6144 + col];
            a0 += siluf(p.c[k]) * wv; a1 += siluf(p.c[1024 + k]) * wv;
        }
        sm[tid] = a0; sm[256 + tid] = a1;
        __syncthreads();
        if (tid < 64) {
            const float s0 = sm[tid] + sm[64 + tid] + sm[128 + tid] + sm[192 + tid];
            const float s1 = sm[256 + tid] + sm[320 + tid] + sm[384 + tid] + sm[448 + tid];
            const float bb = p.ada_b[l * 6144 + col];
            p.modv[(l * 2 + 0) * 6144 + col] = s0 + bb;
            p.modv[(l * 2 + 1) * 6144 + col] = s1 + bb;
        }
        __syncthreads();
    }
    for (int i = wg * 256 + tid; i < SEQ * 32; i += nwg * 256) {
        const int t = i >> 5, j = i & 31;
        const float inv = powf(10000.0f, -(float)(2 * j) / 64.0f);
        const float ang = (float)t * inv;
        p.ropec[i] = cosf(ang); p.ropes[i] = sinf(ang);
    }
    for (int i = wg * 256 + tid; i < 8 * 1024; i += nwg * 256) { const int h = i >> 10, d = i & 1023; p.blut[i] = p.rel[rel_bucket(d) * 8 + h]; }
}

template <int MODE>
__device__ void st_norm(const P& p, int layer, int wg, int nwg) {
    const int wid = threadIdx.x >> 6, lane = threadIdx.x & 63;
    for (int row = wg * 4 + wid; row < T_TOK; row += nwg * 4) {
        const int b = row >> 13;
        float v[16];
        const float* xin = (MODE == 0) ? p.x : p.out;
#pragma unroll
        for (int i = 0; i < 4; ++i) {
            const float4 t4 = *(const float4*)(xin + (size_t)row * DM + i * 256 + lane * 4);
            v[i * 4 + 0] = t4.x; v[i * 4 + 1] = t4.y; v[i * 4 + 2] = t4.z; v[i * 4 + 3] = t4.w;
        }
        if (MODE >= 2) {
            const int lp = (MODE == 2) ? layer - 1 : 1;
            const float* gf = p.modv + (size_t)(lp * 2 + b) * 6144 + 5 * 1024;
#pragma unroll
            for (int i = 0; i < 4; ++i)
#pragma unroll
                for (int j = 0; j < 4; ++j) {
                    const int col = i * 256 + lane * 4 + j;
                    const float y0 = bf2f(p.y[(size_t)(2 * row) * DM + col]), y1 = bf2f(p.y[(size_t)(2 * row + 1) * DM + col]);
                    v[i * 4 + j] += gf[col] * (y0 + y1);
                }
            if (MODE == 2) {
#pragma unroll
                for (int i = 0; i < 4; ++i)
                    *(float4*)(p.out + (size_t)row * DM + i * 256 + lane * 4) = make_float4(v[i * 4], v[i * 4 + 1], v[i * 4 + 2], v[i * 4 + 3]);
            }
        }
        float ss = 0.f;
#pragma unroll
        for (int i = 0; i < 16; ++i) ss += v[i] * v[i];
        ss = wsum(ss);
        const float r = rsqrtf(ss * (1.0f / 1024.0f) + 1e-6f);
        if (MODE == 3) {
#pragma unroll
            for (int i = 0; i < 4; ++i) {
                const float4 g4 = *(const float4*)(p.final_norm + i * 256 + lane * 4);
                *(float4*)(p.out + (size_t)row * DM + i * 256 + lane * 4) =
                    make_float4(v[i * 4] * r * g4.x, v[i * 4 + 1] * r * g4.y, v[i * 4 + 2] * r * g4.z, v[i * 4 + 3] * r * g4.w);
            }
            continue;
        }
        const float* g = ((MODE == 1) ? p.norm_ffn : p.norm_mix) + layer * 1024;
        const float* mv = p.modv + (size_t)(layer * 2 + b) * 6144;
        const float* shift = mv + ((MODE == 1) ? 3 : 0) * 1024;
        const float* scale = mv + ((MODE == 1) ? 4 : 1) * 1024;
        float hv[16];
#pragma unroll
        for (int i = 0; i < 4; ++i)
#pragma unroll
            for (int j = 0; j < 4; ++j) {
                const int col = i * 256 + lane * 4 + j;
                hv[i * 4 + j] = v[i * 4 + j] * r * g[col] * (1.0f + scale[col]) + shift[col];
                p.h[(size_t)row * DM + col] = f2bf(hv[i * 4 + j]);
            }
        if (MODE == 1) {
            float lg[16];
#pragma unroll
            for (int e = 0; e < 16; ++e) lg[e] = 0.f;
#pragma unroll
            for (int i = 0; i < 4; ++i)
#pragma unroll
                for (int j = 0; j < 4; ++j) {
                    const int col = i * 256 + lane * 4 + j;
                    const float* rw = p.router_w + col * 16;
#pragma unroll
                    for (int e = 0; e < 16; ++e) lg[e] += hv[i * 4 + j] * rw[e];
                }
#pragma unroll
            for (int e = 0; e < 16; ++e) lg[e] = wsum(lg[e]);
            float aff[16], bi[16];
#pragma unroll
            for (int e = 0; e < 16; ++e) { aff[e] = 1.0f / (1.0f + expf(-lg[e])); bi[e] = aff[e] + p.router_b[e]; }
            float bestsc = -3e38f; int be0 = 0, be1 = 1; float bw0 = 0.f, bw1 = 0.f;
#pragma unroll
            for (int gI = 0; gI < 4; ++gI) {
                int i1 = 0; float m1 = bi[gI * 4];
#pragma unroll
                for (int i = 1; i < 4; ++i) if (bi[gI * 4 + i] > m1) { m1 = bi[gI * 4 + i]; i1 = i; }
                int i2 = -1; float m2 = -3e38f;
#pragma unroll
                for (int i = 0; i < 4; ++i) if (i != i1 && bi[gI * 4 + i] > m2) { m2 = bi[gI * 4 + i]; i2 = i; }
                const float sc = m1 + m2;
                float a1 = 0.f, a2 = 0.f;
#pragma unroll
                for (int i = 0; i < 4; ++i) { a1 = (i == i1) ? aff[gI * 4 + i] : a1; a2 = (i == i2) ? aff[gI * 4 + i] : a2; }
                if (sc > bestsc) { bestsc = sc; be0 = gI * 4 + i1; be1 = gI * 4 + i2; bw0 = a1; bw1 = a2; }
            }
            if (lane == 0) {
                const float ws = bw0 + bw1;
                int* cnt = p.cnt + layer * 16;
                const int p0 = atomicAdd(&cnt[be0], 1);
                p.list[be0 * T_TOK + p0] = row * 2;
                const int p1 = atomicAdd(&cnt[be1], 1);
                p.list[be1 * T_TOK + p1] = row * 2 + 1;
                p.tokw[row * 2] = bw0 / ws; p.tokw[row * 2 + 1] = bw1 / ws;
            }
        }
    }
}

__device__ void st_inproj0(const P& p, int wg, int nwg, float* sm) {
    const int tn = (2840 + 63) / 64, tm = T_TOK / 64;
    for (int w = wg; w < tm * tn; w += nwg) {
        const int m0 = (w / tn) * 64, n0 = (w % tn) * 64;
        gemm_tile64<1>(m0, n0, 1024,
            [&](int m, int k) { return bf2f(p.h[(size_t)m * DM + k]); },
            [&](int, int k, int n) { return n < 2840 ? p.ev_w_in[(size_t)k * 2840 + n] : 0.f; },
            [&](int m, int n, float a, float) {
                if (n >= 2840) return;
                p.proj[(size_t)m * 2840 + n] = f2bf(a);
                if (n >= 1280 && n < 1304) p.gates[m * 24 + (n - 1280)] = sigmf(a);
            }, sm);
    }
}
__device__ void st_cmp1(const P& p, int wg, int nwg, float* sm) {
    const int tm = (2044 + 63) / 64, tn = 4;
    for (int w = wg; w < 2 * tm * tn; w += nwg) {
        const int which = w / (tm * tn), r = w % (tm * tn), m0 = (r / tn) * 64, n0 = (r % tn) * 64;
        const float* w1 = which ? p.cv_w1 : p.ck_w1;
        const float* pos = which ? p.pos_v : p.pos_k;
        const int colbase = which ? 640 : 512;
        float* chid = p.chid + (size_t)which * 2044 * 256;
        gemm_tile64<1>(m0, n0, 2048,
            [&](int m, int k) {
                if (m >= 2044) return 0.f;
                const int bk = m / 511, n = m % 511, b = bk >> 1, kv = bk & 1, l = k >> 6, d = k & 63;
                return bf2f(p.proj[(size_t)(b * SEQ + 16 * n + l) * 2840 + colbase + kv * 64 + d]) + pos[k];
            },
            [&](int, int k, int n) { return w1[(size_t)k * 256 + n]; },
            [&](int m, int n, float a, float) { if (m < 2044) chid[(size_t)m * 256 + n] = gelu_tanh(a); }, sm);
    }
}
__device__ void st_cmp2(const P& p, int wg, int nwg, float* sm) {
    const int tm = (2044 + 63) / 64;
    for (int w = wg; w < 2 * tm; w += nwg) {
        const int which = w / tm, m0 = (w % tm) * 64;
        const float* w2 = which ? p.cv_w2 : p.ck_w2;
        const float* chid = p.chid + (size_t)which * 2044 * 256;
        float* outp = which ? p.vcmp : p.kcmp;
        gemm_tile64<1>(m0, 0, 256,
            [&](int m, int k) { return m < 2044 ? chid[(size_t)m * 256 + k] : 0.f; },
            [&](int, int k, int n) { return w2[k * 64 + n]; },
            [&](int m, int n, float a, float) { if (m < 2044) outp[(size_t)m * 64 + n] = a; }, sm);
    }
}
__device__ void st_kmean(const P& p, int wg, int nwg) {
    const int wid = threadIdx.x >> 6, lane = threadIdx.x & 63;
    for (int w = wg * 4 + wid; w < 2 * 8 * 32; w += nwg * 4) {
        const int b = w >> 8, h = (w >> 5) & 7, j = w & 31;
        float s = 0.f;
        for (int i = 0; i < 256; ++i) s += bf2f(p.proj[(size_t)(b * SEQ + j * 256 + i) * 2840 + 1816 + h * 64 + lane]);
        p.kmean[(size_t)w * 64 + lane] = s * (1.0f / 256.0f);
    }
}
__device__ void st_outproj(const P& p, int layer, int wg, int nwg, float* sm) {
    const float* W = layer ? p.od_w_out : p.ev_w_out;
    const float* xin = layer ? p.out : p.x;
    for (int w = wg; w < (T_TOK / 64) * 16; w += nwg) {
        const int m0 = (w >> 4) * 64, n0 = (w & 15) * 64;
        gemm_tile64<1>(m0, n0, 1024,
            [&](int m, int k) { return bf2f(p.o[(size_t)m * DM + k]); },
            [&](int, int k, int n) { return W[(size_t)k * DM + n]; },
            [&](int m, int n, float a, float) {
                const int b = m >> 13;
                const float g = p.modv[(size_t)(layer * 2 + b) * 6144 + 2 * 1024 + n];
                p.out[(size_t)m * DM + n] = xin[(size_t)m * DM + n] + g * a;
            }, sm);
    }
}
__device__ __forceinline__ bool moe_tile(const int* cnt, int tt, int& e, int& i0, int& off) {
    int acc = 0, o = 0;
    for (int q = 0; q < 16; ++q) {
        const int c = cnt[q], nt = (c + 63) >> 6;
        if (tt < acc + nt) { e = q; i0 = (tt - acc) * 64; off = o; return true; }
        acc += nt; o += c;
    }
    return false;
}
__device__ void st_moe_up(const P& p, int layer, int wg, int nwg, float* sm) {
    const int* cnt = p.cnt + layer * 16;
    for (int w = wg;; w += nwg) {
        int e, i0, off;
        if (!moe_tile(cnt, w >> 3, e, i0, off)) break;
        const int n0 = (w & 7) * 64, ce = cnt[e];
        const float* wgp = p.moe_wg + (size_t)(layer * 16 + e) * 1024 * 512;
        const float* wup = p.moe_wu + (size_t)(layer * 16 + e) * 1024 * 512;
        const int* lst = p.list + e * T_TOK;
        gemm_tile64<2>(0, n0, 1024,
            [&](int m, int k) { return (i0 + m < ce) ? bf2f(p.h[(size_t)(lst[i0 + m] >> 1) * DM + k]) : 0.f; },
            [&](int nb, int k, int n) { return (nb ? wup : wgp)[(size_t)k * 512 + n]; },
            [&](int m, int n, float g, float u) { if (i0 + m < ce) p.hid[(size_t)(off + i0 + m) * 512 + n] = f2bf(siluf(g) * u); }, sm);
    }
}
__device__ void st_moe_down(const P& p, int layer, int wg, int nwg, float* sm) {
    const int* cnt = p.cnt + layer * 16;
    for (int w = wg;; w += nwg) {
        int e, i0, off;
        if (!moe_tile(cnt, w >> 4, e, i0, off)) break;
        const int n0 = (w & 15) * 64, ce = cnt[e];
        const float* wd = p.moe_wd + (size_t)(layer * 16 + e) * 512 * 1024;
        const int* lst = p.list + e * T_TOK;
        gemm_tile64<1>(0, n0, 512,
            [&](int m, int k) { return (i0 + m < ce) ? bf2f(p.hid[(size_t)(off + i0 + m) * 512 + k]) : 0.f; },
            [&](int, int k, int n) { return wd[(size_t)k * 1024 + n]; },
            [&](int m, int n, float a, float) {
                if (i0 + m < ce) { const int id = lst[i0 + m]; p.y[(size_t)id * DM + n] = f2bf(p.tokw[id] * a); }
            }, sm);
    }
}
__device__ void st_inproj1(const P& p, int wg, int nwg, float* sm) {
    const int tn = 19, tm = T_TOK / 64;
    for (int w = wg; w < tm * tn; w += nwg) {
        const int m0 = (w / tn) * 64, n0 = (w % tn) * 64;
        gemm_tile64<1>(m0, n0, 1024,
            [&](int m, int k) { return bf2f(p.h[(size_t)m * DM + k]); },
            [&](int, int k, int n) { return p.od_w_in[(size_t)k * 1216 + n]; },
            [&](int m, int n, float a, float) { p.proj1[(size_t)m * 1216 + n] = f2bf(a); }, sm);
    }
}
__device__ void st_mla_prep(const P& p, int wg, int nwg) {
    const int wid = threadIdx.x >> 6, lane = threadIdx.x & 63;
    for (int row = wg * 4 + wid; row < T_TOK; row += nwg * 4) {
        const int t = row & (SEQ - 1);
        const bf16_t* pr = p.proj1 + (size_t)row * 1216;
        float q[4], ss = 0.f;
#pragma unroll
        for (int i = 0; i < 4; ++i) { q[i] = bf2f(pr[i * 64 + lane]); ss += q[i] * q[i]; }
        ss = wsum(ss);
        float r = rsqrtf(ss * (1.0f / 256.0f) + 1e-6f);
#pragma unroll
        for (int i = 0; i < 4; ++i) p.cqn[(size_t)row * 384 + i * 64 + lane] = f2bf(q[i] * r * p.q_norm[i * 64 + lane]);
        float kvv[2]; ss = 0.f;
#pragma unroll
        for (int i = 0; i < 2; ++i) { kvv[i] = bf2f(pr[256 + i * 64 + lane]); ss += kvv[i] * kvv[i]; }
        ss = wsum(ss);
        r = rsqrtf(ss * (1.0f / 128.0f) + 1e-6f);
#pragma unroll
        for (int i = 0; i < 2; ++i) p.cqn[(size_t)row * 384 + 256 + i * 64 + lane] = f2bf(kvv[i] * r * p.kv_norm[i * 64 + lane]);
        if (lane < 32) {
            const float x1 = bf2f(pr[384 + lane]), x2 = bf2f(pr[384 + 32 + lane]);
            const float cs = p.ropec[t * 32 + lane], sn = p.ropes[t * 32 + lane];
            p.krope[(size_t)row * 64 + lane] = f2bf(x1 * cs - x2 * sn);
            p.krope[(size_t)row * 64 + 32 + lane] = f2bf(x1 * sn + x2 * cs);
        }
    }
}
__device__ void st_mla_up(const P& p, int wg, int nwg, float* sm) {
    const int tm = T_TOK / 64;
    for (int w = wg; w < tm * (12 + 16); w += nwg) {
        const int m0 = (w / 28) * 64, c = w % 28;
        if (c < 12) {
            gemm_tile64<1>(m0, c * 64, 256,
                [&](int m, int k) { return bf2f(p.cqn[(size_t)m * 384 + k]); },
                [&](int, int k, int n) { return p.w_q_up[(size_t)k * 768 + n]; },
                [&](int m, int n, float a, float) { p.qmla[(size_t)m * 768 + n] = f2bf(a); }, sm);
        } else {
            gemm_tile64<1>(m0, (c - 12) * 64, 128,
                [&](int m, int k) { return bf2f(p.cqn[(size_t)m * 384 + 256 + k]); },
                [&](int, int k, int n) { return p.w_kv_up[(size_t)k * 1024 + n]; },
                [&](int m, int n, float a, float) { p.kvmla[(size_t)m * 1024 + n] = f2bf(a); }, sm);
        }
    }
}
__device__ void st_mla_qrope(const P& p, int wg, int nwg) {
    for (int i = wg * 256 + threadIdx.x; i < T_TOK * 4 * 32; i += nwg * 256) {
        const int row = i >> 7, h = (i >> 5) & 3, j = i & 31, t = row & (SEQ - 1);
        bf16_t* q = p.qmla + (size_t)row * 768 + h * 192 + 128;
        const float x1 = bf2f(q[j]), x2 = bf2f(q[32 + j]);
        const float cs = p.ropec[t * 32 + j], sn = p.ropes[t * 32 + j];
        q[j] = f2bf(x1 * cs - x2 * sn); q[32 + j] = f2bf(x1 * sn + x2 * cs);
    }
}

struct OSM { float m, l, o; };
__device__ __forceinline__ void osm_init(OSM& s) { s.m = -3e38f; s.l = 0.f; s.o = 0.f; }
__device__ __forceinline__ void osm_add(OSM& s, float sc, float v) {
    const float mn = fmaxf(s.m, sc), al = __expf(s.m - mn), pp = __expf(sc - mn);
    s.l = s.l * al + pp; s.o = s.o * al + pp * v; s.m = mn;
}

__device__ void st_nsa(const P& p, int wg, int nwg) {
    const int wid = threadIdx.x >> 6, lane = threadIdx.x & 63;
    for (int w = wg * 4 + wid; w < T_TOK * 2; w += nwg * 4) {
        const int row = w >> 1, kv = w & 1, b = row >> 13, t = row & (SEQ - 1);
        const bf16_t* pb = p.proj + (size_t)b * SEQ * 2840;
        float q[4];
#pragma unroll
        for (int g = 0; g < 4; ++g) q[g] = bf2f(p.proj[(size_t)row * 2840 + (kv * 4 + g) * 64 + lane]);
        const float* kc = p.kcmp + (size_t)((b * 2 + kv) * 511) * 64;
        const float* vc = p.vcmp + (size_t)((b * 2 + kv) * 511) * 64;
        const float* bl = p.blut + (kv * 4) * 1024;
        int nvalid = (t >= 31) ? ((t - 31) >> 4) + 1 : 0; if (nvalid > 511) nvalid = 511;
        float cm[4], cl[4];
#pragma unroll
        for (int g = 0; g < 4; ++g) { cm[g] = -3e38f; cl[g] = 0.f; }
        for (int n = 0; n < nvalid; ++n) {
            const float kd = kc[n * 64 + lane]; const int dist = t - (16 * n + 31);
#pragma unroll
            for (int g = 0; g < 4; ++g) {
                const float s = wsum(q[g] * kd) * 0.125f + bl[g * 1024 + (dist > 1023 ? 1023 : dist)];
                const float mn = fmaxf(cm[g], s); cl[g] = cl[g] * __expf(cm[g] - mn) + __expf(s - mn); cm[g] = mn;
            }
        }
        float oc[4] = {0.f, 0.f, 0.f, 0.f}, imp0 = 0.f, imp1 = 0.f;
        for (int n = 0; n < nvalid; ++n) {
            const float kd = kc[n * 64 + lane], vd = vc[n * 64 + lane]; const int dist = t - (16 * n + 31);
            float ps = 0.f;
#pragma unroll
            for (int g = 0; g < 4; ++g) {
                const float s = wsum(q[g] * kd) * 0.125f + bl[g * 1024 + (dist > 1023 ? 1023 : dist)];
                const float pr = __expf(s - cm[g]) / cl[g];
                oc[g] += pr * vd; ps += pr;
            }
            const int mb = n >> 2;
            if (mb == lane) imp0 += ps;
            if (mb == lane + 64) imp1 += ps;
            if ((n & 3) == 3) { if (mb + 1 == lane) imp0 += ps; if (mb + 1 == lane + 64) imp1 += ps; }
        }
        const int blk_t = t >> 6;
        float s0, s1;
        { const int j = lane; const bool forced = (j == 0) || (j == blk_t) || (j == blk_t - 1); s0 = forced ? BIGF : (j <= blk_t ? imp0 : NEGF); }
        { const int j = lane + 64; const bool forced = (j == blk_t) || (j == blk_t - 1); s1 = forced ? BIGF : (j <= blk_t ? imp1 : NEGF); }
        unsigned long long selA = 0ull, selB = 0ull;
        for (int r = 0; r < 16; ++r) {
            float bv; int bi;
            if (s0 >= s1) { bv = s0; bi = lane; } else { bv = s1; bi = lane + 64; }
#pragma unroll
            for (int o = 32; o > 0; o >>= 1) {
                const float ov = __shfl_xor(bv, o); const int oi = __shfl_xor(bi, o);
                if (ov > bv || (ov == bv && oi < bi)) { bv = ov; bi = oi; }
            }
            if (bv <= NEGF) break;
            if (bi < 64) selA |= 1ull << bi; else selB |= 1ull << (bi - 64);
            if (bi == lane) s0 = -3e38f;
            if (bi == lane + 64) s1 = -3e38f;
        }
        OSM ss_[4];
#pragma unroll
        for (int g = 0; g < 4; ++g) osm_init(ss_[g]);
        for (int j = 0; j <= blk_t; ++j) {
            const bool sel = (j < 64) ? ((selA >> j) & 1ull) : ((selB >> (j - 64)) & 1ull);
            if (!sel) continue;
            const int pend = (j * 64 + 63 < t) ? j * 64 + 63 : t;
            for (int pos = j * 64; pos <= pend; ++pos) {
                const float kd = bf2f(pb[(size_t)pos * 2840 + 768 + kv * 64 + lane]), vd = bf2f(pb[(size_t)pos * 2840 + 896 + kv * 64 + lane]);
                const int dist = t - pos;
#pragma unroll
                for (int g = 0; g < 4; ++g) {
                    const float s = wsum(q[g] * kd) * 0.125f + bl[g * 1024 + (dist > 1023 ? 1023 : dist)];
                    osm_add(ss_[g], s, vd);
                }
            }
        }
        OSM sw_[4];
#pragma unroll
        for (int g = 0; g < 4; ++g) osm_init(sw_[g]);
        for (int pos = t - 511; pos <= t; ++pos) {
            float kd = 0.f, vd = 0.f;
            if (pos >= 0) { kd = bf2f(pb[(size_t)pos * 2840 + 1024 + kv * 64 + lane]); vd = bf2f(pb[(size_t)pos * 2840 + 1152 + kv * 64 + lane]); }
            const int dist = t - pos;
#pragma unroll
            for (int g = 0; g < 4; ++g) {
                const float s = wsum(q[g] * kd) * 0.125f + bl[g * 1024 + dist];
                osm_add(sw_[g], s, vd);
            }
        }
#pragma unroll
        for (int g = 0; g < 4; ++g) {
            const float* gt = p.gates + (size_t)row * 24 + (kv * 4 + g) * 3;
            const float ov = gt[0] * oc[g] + gt[1] * (ss_[g].o / ss_[g].l) + gt[2] * (sw_[g].o / sw_[g].l);
            p.o[(size_t)row * DM + (kv * 4 + g) * 64 + lane] = f2bf(ov);
        }
    }
}
__device__ void st_moba(const P& p, int wg, int nwg) {
    const int wid = threadIdx.x >> 6, lane = threadIdx.x & 63;
    for (int w = wg * 4 + wid; w < T_TOK * 8; w += nwg * 4) {
        const int row = w >> 3, h = w & 7, b = row >> 13, t = row & (SEQ - 1), own = t >> 8;
        const bf16_t* pb = p.proj + (size_t)b * SEQ * 2840;
        const float q = bf2f(p.proj[(size_t)row * 2840 + 1304 + h * 64 + lane]);
        const float* km = p.kmean + (size_t)((b * 8 + h) * 32) * 64;
        const float* bl = p.blut + h * 1024;
        float gate = NEGF;
        for (int j = 0; j < own; ++j) { const float gj = wsum(q * km[j * 64 + lane]); if (lane == j) gate = gj; }
        unsigned selm = 0u;
        for (int r = 0; r < 3; ++r) {
            float bv = gate; int bi = lane;
#pragma unroll
            for (int o = 32; o > 0; o >>= 1) {
                const float ov = __shfl_xor(bv, o); const int oi = __shfl_xor(bi, o);
                if (ov > bv || (ov == bv && oi < bi)) { bv = ov; bi = oi; }
            }
            if (bv <= NEGF) break;
            selm |= 1u << bi;
            if (bi == lane) gate = -3e38f;
        }
        OSM st; osm_init(st);
        for (int j = 0; j <= own; ++j) {
            if (j < own && !((selm >> j) & 1u)) continue;
            const int pend = (j < own) ? j * 256 + 255 : t;
            for (int pos = j * 256; pos <= pend; ++pos) {
                const float kd = bf2f(pb[(size_t)pos * 2840 + 1816 + h * 64 + lane]), vd = bf2f(pb[(size_t)pos * 2840 + 2328 + h * 64 + lane]);
                const int dist = t - pos;
                const float s = wsum(q * kd) * 0.125f + bl[dist > 1023 ? 1023 : dist];
                osm_add(st, s, vd);
            }
        }
        p.o[(size_t)row * DM + 512 + h * 64 + lane] = f2bf(st.o / st.l);
    }
}
__device__ void st_mla(const P& p, int wg, int nwg) {
    const int wid = threadIdx.x >> 6, lane = threadIdx.x & 63;
    const float scale = 0.07216878364870322f;
    for (int w = wg * 4 + wid; w < T_TOK * 4; w += nwg * 4) {
        const int row = w >> 2, h = w & 3, b = row >> 13, t = row & (SEQ - 1);
        const bf16_t* qp = p.qmla + (size_t)row * 768 + h * 192;
        const float q0 = bf2f(qp[lane]), q1 = bf2f(qp[64 + lane]), q2 = bf2f(qp[128 + lane]);
        float m = -3e38f, l = 0.f, o0 = 0.f, o1 = 0.f;
        for (int pos = 0; pos <= t; ++pos) {
            const size_t kr = (size_t)(b * SEQ + pos);
            const bf16_t* kvp = p.kvmla + kr * 1024 + h * 256;
            const float s = wsum(q0 * bf2f(kvp[lane]) + q1 * bf2f(kvp[64 + lane]) + q2 * bf2f(p.krope[kr * 64 + lane])) * scale;
            const float mn = fmaxf(m, s), al = __expf(m - mn), pp = __expf(s - mn);
            l = l * al + pp; o0 = o0 * al + pp * bf2f(kvp[128 + lane]); o1 = o1 * al + pp * bf2f(kvp[192 + lane]); m = mn;
        }
        p.o[(size_t)row * DM + h * 128 + lane] = f2bf(o0 / l);
        p.o[(size_t)row * DM + h * 128 + 64 + lane] = f2bf(o1 / l);
    }
}
__device__ void st_swa(const P& p, int wg, int nwg) {
    const int wid = threadIdx.x >> 6, lane = threadIdx.x & 63;
    for (int w = wg * 4 + wid; w < T_TOK * 8; w += nwg * 4) {
        const int row = w >> 3, h = w & 7, kv = h >> 2, b = row >> 13, t = row & (SEQ - 1);
        const bf16_t* pb = p.proj1 + (size_t)b * SEQ * 1216;
        const float q = bf2f(p.proj1[(size_t)row * 1216 + 448 + h * 64 + lane]);
        const float* bl = p.blut + h * 1024;
        float m = p.sinks[h], l = 1.0f, o = 0.f;
        for (int pos = t - 127; pos <= t; ++pos) {
            float kd = 0.f, vd = 0.f;
            if (pos >= 0) { kd = bf2f(pb[(size_t)pos * 1216 + 960 + kv * 64 + lane]); vd = bf2f(pb[(size_t)pos * 1216 + 1088 + kv * 64 + lane]); }
            const float s = wsum(q * kd) * 0.125f + bl[t - pos];
            const float mn = fmaxf(m, s), al = __expf(m - mn), pp = __expf(s - mn);
            l = l * al + pp; o = o * al + pp * vd; m = mn;
        }
        p.o[(size_t)row * DM + 512 + h * 64 + lane] = f2bf(o / l);
    }
}

template <int ST>
__global__ void __launch_bounds__(256, 2) k_stage(P p) {
    __shared__ float sm[16 * 68 * 3];
    const int wg = blockIdx.x, nwg = gridDim.x;
    if (ST == 0) st_prologue(p, wg, nwg, sm);
    if (ST == 1) st_norm<0>(p, 0, wg, nwg);
    if (ST == 2) st_inproj0(p, wg, nwg, sm);
    if (ST == 3) { st_cmp1(p, wg, nwg, sm); st_kmean(p, wg, nwg); }
    if (ST == 4) st_cmp2(p, wg, nwg, sm);
    if (ST == 5) { st_nsa(p, wg, nwg); st_moba(p, wg, nwg); }
    if (ST == 6) st_outproj(p, 0, wg, nwg, sm);
    if (ST == 7) st_norm<1>(p, 0, wg, nwg);
    if (ST == 8) st_moe_up(p, 0, wg, nwg, sm);
    if (ST == 9) st_moe_down(p, 0, wg, nwg, sm);
    if (ST == 10) st_norm<2>(p, 1, wg, nwg);
    if (ST == 11) st_inproj1(p, wg, nwg, sm);
    if (ST == 12) st_mla_prep(p, wg, nwg);
    if (ST == 13) st_mla_up(p, wg, nwg, sm);
    if (ST == 14) st_mla_qrope(p, wg, nwg);
    if (ST == 15) { st_mla(p, wg, nwg); st_swa(p, wg, nwg); }
    if (ST == 16) st_outproj(p, 1, wg, nwg, sm);
    if (ST == 17) st_norm<1>(p, 1, wg, nwg);
    if (ST == 18) st_moe_up(p, 1, wg, nwg, sm);
    if (ST == 19) st_moe_down(p, 1, wg, nwg, sm);
    if (ST == 20) st_norm<3>(p, 1, wg, nwg);
}

template <int ST> static void launch_stage(const P& p, hipStream_t s) { hipLaunchKernelGGL(k_stage<ST>, dim3(1024), dim3(256), 0, s, p); }

extern "C" void kernel_launch(void* const* d_in, const int* in_sizes, int n_in, void* d_out, int out_size, void* d_ws, size_t ws_size,
                              hipStream_t stream) {
    (void)in_sizes; (void)n_in; (void)out_size; (void)ws_size;
    P p{};
    const float* const* in = (const float* const*)d_in;
    p.x = in[0]; p.c = in[1]; p.rel = in[2]; p.router_w = in[3]; p.router_b = in[4]; p.final_norm = in[5]; p.norm_mix = in[6]; p.norm_ffn = in[7];
    p.ada_w = in[8]; p.ada_b = in[9]; p.moe_wg = in[10]; p.moe_wu = in[11]; p.moe_wd = in[12]; p.ev_w_in = in[13]; p.ev_w_out = in[14];
    p.pos_k = in[15]; p.pos_v = in[16]; p.ck_w1 = in[17]; p.ck_w2 = in[18]; p.cv_w1 = in[19]; p.cv_w2 = in[20]; p.od_w_in = in[21]; p.od_w_out = in[22];
    p.q_norm = in[23]; p.kv_norm = in[24]; p.w_q_up = in[25]; p.w_kv_up = in[26]; p.sinks = in[27];
    p.out = (float*)d_out;
    char* ws = (char*)d_ws; size_t off = 0;
    auto take = [&](size_t bytes) { char* r = ws + off; off += (bytes + 255) & ~(size_t)255; return r; };
    p.bar = (unsigned*)take(16384);
    p.cnt = (int*)take(256);
    const size_t zero_bytes = off;
    p.modv = (float*)take(2 * 2 * 6144 * 4);
    p.ropec = (float*)take(SEQ * 32 * 4); p.ropes = (float*)take(SEQ * 32 * 4);
    p.blut = (float*)take(8 * 1024 * 4);
    p.gates = (float*)take((size_t)T_TOK * 24 * 4);
    p.kcmp = (float*)take(2044 * 64 * 4); p.vcmp = (float*)take(2044 * 64 * 4);
    p.chid = (float*)take((size_t)2 * 2044 * 256 * 4);
    p.kmean = (float*)take(2 * 8 * 32 * 64 * 4);
    p.tokw = (float*)take((size_t)T_TOK * 2 * 4);
    p.list = (int*)take((size_t)16 * T_TOK * 4);
    p.cqn = (bf16_t*)take((size_t)T_TOK * 384 * 2);
    p.krope = (bf16_t*)take((size_t)T_TOK * 64 * 2);
    p.h = (bf16_t*)take((size_t)T_TOK * DM * 2);
    p.o = (bf16_t*)take((size_t)T_TOK * DM * 2);
    p.hid = p.o;
    char* region = take((size_t)100 * 1024 * 1024);
    p.proj = (bf16_t*)region;
    p.proj1 = (bf16_t*)region;
    p.qmla = (bf16_t*)(region + (size_t)T_TOK * 1216 * 2);
    p.kvmla = (bf16_t*)(region + (size_t)T_TOK * (1216 + 768) * 2);
    p.y = (bf16_t*)region;
    hipMemsetAsync(d_ws, 0, zero_bytes, stream);
    launch_stage<0>(p, stream); launch_stage<1>(p, stream); launch_stage<2>(p, stream); launch_stage<3>(p, stream); launch_stage<4>(p, stream);
    launch_stage<5>(p, stream); launch_stage<6>(p, stream); launch_stage<7>(p, stream); launch_stage<8>(p, stream); launch_stage<9>(p, stream);
    launch_stage<10>(p, stream); launch_stage<11>(p, stream); launch_stage<12>(p, stream); launch_stage<13>(p, stream); launch_stage<14>(p, stream);
    launch_stage<15>(p, stream); launch_stage<16>(p, stream); launch_stage<17>(p, stream); launch_stage<18>(p, stream); launch_stage<19>(p, stream);
    launch_stage<20>(p, stream);
}
```

```cpp
#include <hip/hip_runtime.h>
#include <stdint.h>

#define T_TOK 16384
#define SEQ 8192
#define DM 1024
#define NEGF (-1e30f)
#define BIGF (1e30f)

typedef unsigned short bf16_t;

__device__ __forceinline__ float bf2f(bf16_t v) { return __uint_as_float(((unsigned)v) << 16); }
__device__ __forceinline__ bf16_t f2bf(float f) {
    unsigned u = __float_as_uint(f);
    u += 0x7fffu + ((u >> 16) & 1u);
    return (bf16_t)(u >> 16);
}
__device__ __forceinline__ unsigned cvtpk(float lo, float hi) { unsigned r; asm("v_cvt_pk_bf16_f32 %0, %1, %2" : "=v"(r) : "v"(lo), "v"(hi)); return r; }
__device__ __forceinline__ float wsum(float v) {
#pragma unroll
    for (int o = 32; o > 0; o >>= 1) v += __shfl_xor(v, o);
    return v;
}
__device__ __forceinline__ float siluf(float v) { return v / (1.0f + __expf(-v)); }
__device__ __forceinline__ float sigmf(float v) { return 1.0f / (1.0f + __expf(-v)); }
__device__ __forceinline__ float gelu_tanh(float x) {
    const float k0 = 0.7978845608028654f, k1 = 0.044715f;
    float u = k0 * (x + k1 * x * x * x);
    return 0.5f * x * (1.0f + tanhf(u));
}
__device__ __forceinline__ int rel_bucket(int d) {
    if (d < 16) return d < 0 ? 0 : d;
    int b = 16;
    b += (d >= 21); b += (d >= 27); b += (d >= 35); b += (d >= 46); b += (d >= 59); b += (d >= 77); b += (d >= 99); b += (d >= 128);
    b += (d >= 166); b += (d >= 216); b += (d >= 280); b += (d >= 363); b += (d >= 470); b += (d >= 609); b += (d >= 790);
    return b;
}

__device__ __forceinline__ int otid() { int t = threadIdx.x; asm volatile("" : "+v"(t)); return t; }

struct P {
    const float *x, *c, *rel, *router_w, *router_b, *final_norm, *norm_mix, *norm_ffn, *ada_w, *ada_b, *moe_wg, *moe_wu, *moe_wd,
        *ev_w_in, *ev_w_out, *pos_k, *pos_v, *ck_w1, *ck_w2, *cv_w1, *cv_w2, *od_w_in, *od_w_out, *q_norm, *kv_norm, *w_q_up, *w_kv_up, *sinks;
    float* out;
    unsigned* bar; int* cnt;
    float *modv, *ropec, *ropes, *blut, *gates, *kcmp, *vcmp, *chid, *kmean, *tokw;
    bf16_t *h, *proj, *o, *hid, *y, *proj1, *qmla, *kvmla, *krope, *cqn;
    int* list;
    bf16_t *wt_gu, *wt_d, *wt_in0, *wt_out0, *wt_c1, *wt_c2, *wt_in1, *wt_out1, *wt_qup, *wt_kvup, *chidb;
    float* c1;
    int* wq;
    bf16_t* zrow;
    bf16_t *kcmpb, *kmeanb, *mlap;
    float* mlal;
};

template <int NB, class AF, class BF, class EF>
__device__ __forceinline__ void gemm_tile64(int m0, int n0, int K, AF a, BF b, EF epi, float* sm) {
    const int TIDX = otid();
    float(*As)[68] = (float(*)[68])sm;
    float(*Bs)[68] = (float(*)[68])(sm + 16 * 68);
    const int tid = TIDX, ty = tid >> 4, tx = tid & 15;
    float acc[NB][4][4];
#pragma unroll
    for (int nb = 0; nb < NB; ++nb)
#pragma unroll
        for (int i = 0; i < 4; ++i)
#pragma unroll
            for (int j = 0; j < 4; ++j) acc[nb][i][j] = 0.f;
    for (int k0 = 0; k0 < K; k0 += 16) {
#pragma unroll
        for (int i = 0; i < 4; ++i) { const int idx = tid + 256 * i, m = idx >> 4, k = idx & 15; As[k][m] = a(m0 + m, k0 + k); }
#pragma unroll
        for (int nb = 0; nb < NB; ++nb)
#pragma unroll
            for (int i = 0; i < 4; ++i) { const int idx = tid + 256 * i, k = idx >> 6, n = idx & 63; Bs[nb * 16 + k][n] = b(nb, k0 + k, n0 + n); }
        __syncthreads();
#pragma unroll
        for (int k = 0; k < 16; ++k) {
            const float4 av = *(const float4*)&As[k][ty * 4];
            const float aa[4] = {av.x, av.y, av.z, av.w};
#pragma unroll
            for (int nb = 0; nb < NB; ++nb) {
                const float4 bv = *(const float4*)&Bs[nb * 16 + k][tx * 4];
                const float bb[4] = {bv.x, bv.y, bv.z, bv.w};
#pragma unroll
                for (int i = 0; i < 4; ++i)
#pragma unroll
                    for (int j = 0; j < 4; ++j) acc[nb][i][j] += aa[i] * bb[j];
            }
        }
        __syncthreads();
    }
#pragma unroll
    for (int i = 0; i < 4; ++i)
#pragma unroll
        for (int j = 0; j < 4; ++j) epi(m0 + ty * 4 + i, n0 + tx * 4 + j, acc[0][i][j], acc[NB - 1][i][j]);
}

__device__ __forceinline__ void st_prologue(const P& p, int wg, int nwg, float* sm) {
    const int TIDX = otid();
    const int tid = TIDX;
    {
        for (int i = tid; i < 2048; i += 256) sm[i] = siluf(p.c[i]);
        __syncthreads();
        const int wid = tid >> 6, lane = tid & 63;
        for (int w = wg; w < 192; w += nwg) {
            const int l = w / 96, cg = w % 96, col = cg * 64 + lane;
            const float* W = p.ada_w + (size_t)l * 1024 * 6144 + (size_t)(wid * 256) * 6144 + col;
            float a0 = 0.f, a1 = 0.f;
#pragma unroll 32
            for (int k = 0; k < 256; ++k) { const float wv = W[(size_t)k * 6144]; a0 += sm[wid * 256 + k] * wv; a1 += sm[1024 + wid * 256 + k] * wv; }
            sm[2048 + tid] = a0; sm[2304 + tid] = a1;
            __syncthreads();
            if (tid < 64) {
                const float bb = p.ada_b[l * 6144 + col];
                p.modv[(l * 2 + 0) * 6144 + col] = ((sm[2048 + tid] + sm[2048 + 64 + tid]) + (sm[2048 + 128 + tid] + sm[2048 + 192 + tid])) + bb;
                p.modv[(l * 2 + 1) * 6144 + col] = ((sm[2304 + tid] + sm[2304 + 64 + tid]) + (sm[2304 + 128 + tid] + sm[2304 + 192 + tid])) + bb;
            }
            __syncthreads();
        }
        __syncthreads();
    }
    for (int i = wg * 256 + tid; i < SEQ * 32; i += nwg * 256) {
        const int t = i >> 5, j = i & 31;
        const float inv = powf(10000.0f, -(float)(2 * j) / 64.0f);
        const float ang = (float)t * inv;
        p.ropec[i] = cosf(ang); p.ropes[i] = sinf(ang);
    }
    for (int i = wg * 256 + tid; i < 8 * 1024; i += nwg * 256) { const int h = i >> 10, d = i & 1023; p.blut[i] = p.rel[rel_bucket(d) * 8 + h]; }
}

template <int MODE>
__device__ __forceinline__ void st_norm(const P& p, int layer, int wg, int nwg, float* sm) {
    const int TIDX = otid();
    const int wid = TIDX >> 6, lane = TIDX & 63;
    int* rl_cnt = (int*)sm; int* rl_base = rl_cnt + 16; int* rl_ent = rl_cnt + 32;
    if (MODE == 1) { if (TIDX < 16) rl_cnt[TIDX] = 0; for (int i = TIDX; i < 64; i += 256) rl_ent[i] = -1; __syncthreads(); }
    const int niter = (T_TOK + nwg * 4 - 1) / (nwg * 4);
    for (int it = 0; it < niter; ++it) {
        const int row = wg * 4 + wid + it * nwg * 4;
        if (MODE != 1 && row >= T_TOK) break;
        if (MODE != 1 || row < T_TOK) {
        const int b = row >> 13;
        float v[16];
        const float* xin = (MODE == 0) ? p.x : p.out;
#pragma unroll
        for (int i = 0; i < 4; ++i) {
            const float4 t4 = *(const float4*)(xin + (size_t)row * DM + i * 256 + lane * 4);
            v[i * 4 + 0] = t4.x; v[i * 4 + 1] = t4.y; v[i * 4 + 2] = t4.z; v[i * 4 + 3] = t4.w;
        }
        if (MODE >= 2) {
            const int lp = (MODE == 2) ? layer - 1 : 1;
            const float* gf = p.modv + (size_t)(lp * 2 + b) * 6144 + 5 * 1024;
#pragma unroll
            for (int i = 0; i < 4; ++i)
#pragma unroll
                for (int j = 0; j < 4; ++j) {
                    const int col = i * 256 + lane * 4 + j;
                    const float y0 = bf2f(p.y[(size_t)(2 * row) * DM + col]), y1 = bf2f(p.y[(size_t)(2 * row + 1) * DM + col]);
                    v[i * 4 + j] += gf[col] * (y0 + y1);
                }
            if (MODE == 2) {
#pragma unroll
                for (int i = 0; i < 4; ++i)
                    *(float4*)(p.out + (size_t)row * DM + i * 256 + lane * 4) = make_float4(v[i * 4], v[i * 4 + 1], v[i * 4 + 2], v[i * 4 + 3]);
            }
        }
        float ss = 0.f;
#pragma unroll
        for (int i = 0; i < 16; ++i) ss += v[i] * v[i];
        ss = wsum(ss);
        const float r = rsqrtf(ss * (1.0f / 1024.0f) + 1e-6f);
        if (MODE == 3) {
#pragma unroll
            for (int i = 0; i < 4; ++i) {
                const float4 g4 = *(const float4*)(p.final_norm + i * 256 + lane * 4);
                *(float4*)(p.out + (size_t)row * DM + i * 256 + lane * 4) =
                    make_float4(v[i * 4] * r * g4.x, v[i * 4 + 1] * r * g4.y, v[i * 4 + 2] * r * g4.z, v[i * 4 + 3] * r * g4.w);
            }
            continue;
        }
        const float* g = ((MODE == 1) ? p.norm_ffn : p.norm_mix) + layer * 1024;
        const float* mv = p.modv + (size_t)(layer * 2 + b) * 6144;
        const float* shift = mv + ((MODE == 1) ? 3 : 0) * 1024;
        const float* scale = mv + ((MODE == 1) ? 4 : 1) * 1024;
        float hv[16];
#pragma unroll
        for (int i = 0; i < 4; ++i)
#pragma unroll
            for (int j = 0; j < 4; ++j) {
                const int col = i * 256 + lane * 4 + j;
                hv[i * 4 + j] = v[i * 4 + j] * r * g[col] * (1.0f + scale[col]) + shift[col];
                p.h[(size_t)row * DM + col] = f2bf(hv[i * 4 + j]);
            }
        if (MODE == 1) {
            float lg[16];
#pragma unroll
            for (int e = 0; e < 16; ++e) lg[e] = 0.f;
#pragma unroll
            for (int i = 0; i < 4; ++i)
#pragma unroll
                for (int j = 0; j < 4; ++j) {
                    const int col = i * 256 + lane * 4 + j;
                    const float* rw = p.router_w + col * 16;
#pragma unroll
                    for (int e = 0; e < 16; ++e) lg[e] += hv[i * 4 + j] * rw[e];
                    asm volatile("" ::: "memory");
                }
#pragma unroll
            for (int e = 0; e < 16; ++e) lg[e] = wsum(lg[e]);
            float aff[16], bi[16];
#pragma unroll
            for (int e = 0; e < 16; ++e) { aff[e] = 1.0f / (1.0f + expf(-lg[e])); bi[e] = aff[e] + p.router_b[e]; }
            float bestsc = -3e38f; int be0 = 0, be1 = 1; float bw0 = 0.f, bw1 = 0.f;
#pragma unroll
            for (int gI = 0; gI < 4; ++gI) {
                int i1 = 0; float m1 = bi[gI * 4];
#pragma unroll
                for (int i = 1; i < 4; ++i) if (bi[gI * 4 + i] > m1) { m1 = bi[gI * 4 + i]; i1 = i; }
                int i2 = -1; float m2 = -3e38f;
#pragma unroll
                for (int i = 0; i < 4; ++i) if (i != i1 && bi[gI * 4 + i] > m2) { m2 = bi[gI * 4 + i]; i2 = i; }
                const float sc = m1 + m2;
                float a1 = 0.f, a2 = 0.f;
#pragma unroll
                for (int i = 0; i < 4; ++i) { a1 = (i == i1) ? aff[gI * 4 + i] : a1; a2 = (i == i2) ? aff[gI * 4 + i] : a2; }
                if (sc > bestsc) { bestsc = sc; be0 = gI * 4 + i1; be1 = gI * 4 + i2; bw0 = a1; bw1 = a2; }
            }
            if (lane == 0) {
                const float ws = bw0 + bw1;
                p.tokw[row * 2] = bw0 / ws; p.tokw[row * 2 + 1] = bw1 / ws;
                const int s_ = (it & 7) * 4 + wid;
                const int r0 = atomicAdd(&rl_cnt[be0], 1), r1 = atomicAdd(&rl_cnt[be1], 1);
                rl_ent[s_ * 2] = (row << 12) | (be0 << 8) | r0;
                rl_ent[s_ * 2 + 1] = (row << 12) | (be1 << 8) | r1;
            }
        }
        }
        if (MODE == 1 && ((it & 7) == 7 || it == niter - 1)) {
            __syncthreads();
            if (TIDX < 16) { const int c = rl_cnt[TIDX]; rl_base[TIDX] = c ? atomicAdd(&p.cnt[(layer * 16 + TIDX) * 32], c) : 0; rl_cnt[TIDX] = 0; }
            __syncthreads();
            if (TIDX < 64) {
                const int en = rl_ent[TIDX];
                if (en >= 0) { const int e = (en >> 8) & 15; p.list[e * T_TOK + rl_base[e] + (en & 255)] = (en >> 12) * 2 + (TIDX & 1); rl_ent[TIDX] = -1; }
            }
            __syncthreads();
        }
    }
}

__device__ __forceinline__ void st_inproj0(const P& p, int wg, int nwg, float* sm) {
    const int TIDX = otid();
    const int tn = (2840 + 63) / 64, tm = T_TOK / 64;
    for (int w = wg; w < tm * tn; w += nwg) {
        const int m0 = (w / tn) * 64, n0 = (w % tn) * 64;
        gemm_tile64<1>(m0, n0, 1024,
            [&](int m, int k) { return bf2f(p.h[(size_t)m * DM + k]); },
            [&](int, int k, int n) { return n < 2840 ? p.ev_w_in[(size_t)k * 2840 + n] : 0.f; },
            [&](int m, int n, float a, float) {
                if (n >= 2840) return;
                p.proj[(size_t)m * 2840 + n] = f2bf(a);
                if (n >= 1280 && n < 1304) p.gates[m * 24 + (n - 1280)] = sigmf(a);
            }, sm);
    }
}
__device__ __forceinline__ void st_cmp1(const P& p, int wg, int nwg, float* sm) {
    const int TIDX = otid();
    const int tm = (2044 + 63) / 64, tn = 4;
    for (int w = wg; w < 2 * tm * tn; w += nwg) {
        const int which = w / (tm * tn), r = w % (tm * tn), m0 = (r / tn) * 64, n0 = (r % tn) * 64;
        const float* w1 = which ? p.cv_w1 : p.ck_w1;
        const float* pos = which ? p.pos_v : p.pos_k;
        const int colbase = which ? 640 : 512;
        float* chid = p.chid + (size_t)which * 2044 * 256;
        gemm_tile64<1>(m0, n0, 2048,
            [&](int m, int k) {
                if (m >= 2044) return 0.f;
                const int bk = m / 511, n = m % 511, b = bk >> 1, kv = bk & 1, l = k >> 6, d = k & 63;
                return bf2f(p.proj[(size_t)(b * SEQ + 16 * n + l) * 2840 + colbase + kv * 64 + d]) + pos[k];
            },
            [&](int, int k, int n) { return w1[(size_t)k * 256 + n]; },
            [&](int m, int n, float a, float) { if (m < 2044) chid[(size_t)m * 256 + n] = gelu_tanh(a); }, sm);
    }
}
__device__ __forceinline__ void st_cmp2(const P& p, int wg, int nwg, float* sm) {
    const int TIDX = otid();
    const int tm = (2044 + 63) / 64;
    for (int w = wg; w < 2 * tm; w += nwg) {
        const int which = w / tm, m0 = (w % tm) * 64;
        const float* w2 = which ? p.cv_w2 : p.ck_w2;
        const float* chid = p.chid + (size_t)which * 2044 * 256;
        float* outp = which ? p.vcmp : p.kcmp;
        gemm_tile64<1>(m0, 0, 256,
            [&](int m, int k) { return m < 2044 ? chid[(size_t)m * 256 + k] : 0.f; },
            [&](int, int k, int n) { return w2[k * 64 + n]; },
            [&](int m, int n, float a, float) { if (m < 2044) outp[(size_t)m * 64 + n] = a; }, sm);
    }
}
__device__ __forceinline__ void st_kmean(const P& p, int wg, int nwg) {
    const int TIDX = otid();
    const int wid = TIDX >> 6, lane = TIDX & 63;
    for (int w = wg * 4 + wid; w < 2 * 8 * 32; w += nwg * 4) {
        const int b = w >> 8, h = (w >> 5) & 7, j = w & 31;
        float s = 0.f;
        for (int i = 0; i < 256; ++i) s += bf2f(p.proj[(size_t)(b * SEQ + j * 256 + i) * 2840 + 1816 + h * 64 + lane]);
        p.kmean[(size_t)w * 64 + lane] = s * (1.0f / 256.0f);
        p.kmeanb[(size_t)w * 64 + lane] = f2bf(s * (1.0f / 256.0f));
    }
}
__device__ __forceinline__ void st_outproj(const P& p, int layer, int wg, int nwg, float* sm) {
    const int TIDX = otid();
    const float* W = layer ? p.od_w_out : p.ev_w_out;
    const float* xin = layer ? p.out : p.x;
    for (int w = wg; w < (T_TOK / 64) * 16; w += nwg) {
        const int m0 = (w >> 4) * 64, n0 = (w & 15) * 64;
        gemm_tile64<1>(m0, n0, 1024,
            [&](int m, int k) { return bf2f(p.o[(size_t)m * DM + k]); },
            [&](int, int k, int n) { return W[(size_t)k * DM + n]; },
            [&](int m, int n, float a, float) {
                const int b = m >> 13;
                const float g = p.modv[(size_t)(layer * 2 + b) * 6144 + 2 * 1024 + n];
                p.out[(size_t)m * DM + n] = xin[(size_t)m * DM + n] + g * a;
            }, sm);
    }
}
__device__ __forceinline__ bool moe_tile(const int* cnt, int tt, int& e, int& i0, int& off) {
    int acc = 0, o = 0;
    for (int q = 0; q < 16; ++q) {
        const int c = cnt[q], nt = (c + 63) >> 6;
        if (tt < acc + nt) { e = q; i0 = (tt - acc) * 64; off = o; return true; }
        acc += nt; o += c;
    }
    return false;
}
__device__ __forceinline__ void st_moe_up(const P& p, int layer, int wg, int nwg, float* sm) {
    const int TIDX = otid();
    const int* cnt = p.cnt + layer * 16;
    for (int w = wg;; w += nwg) {
        int e, i0, off;
        if (!moe_tile(cnt, w >> 3, e, i0, off)) break;
        const int n0 = (w & 7) * 64, ce = cnt[e];
        const float* wgp = p.moe_wg + (size_t)(layer * 16 + e) * 1024 * 512;
        const float* wup = p.moe_wu + (size_t)(layer * 16 + e) * 1024 * 512;
        const int* lst = p.list + e * T_TOK;
        gemm_tile64<2>(0, n0, 1024,
            [&](int m, int k) { return (i0 + m < ce) ? bf2f(p.h[(size_t)(lst[i0 + m] >> 1) * DM + k]) : 0.f; },
            [&](int nb, int k, int n) { return (nb ? wup : wgp)[(size_t)k * 512 + n]; },
            [&](int m, int n, float g, float u) { if (i0 + m < ce) p.hid[(size_t)(off + i0 + m) * 512 + n] = f2bf(siluf(g) * u); }, sm);
    }
}
__device__ __forceinline__ void st_moe_down(const P& p, int layer, int wg, int nwg, float* sm) {
    const int TIDX = otid();
    const int* cnt = p.cnt + layer * 16;
    for (int w = wg;; w += nwg) {
        int e, i0, off;
        if (!moe_tile(cnt, w >> 4, e, i0, off)) break;
        const int n0 = (w & 15) * 64, ce = cnt[e];
        const float* wd = p.moe_wd + (size_t)(layer * 16 + e) * 512 * 1024;
        const int* lst = p.list + e * T_TOK;
        gemm_tile64<1>(0, n0, 512,
            [&](int m, int k) { return (i0 + m < ce) ? bf2f(p.hid[(size_t)(off + i0 + m) * 512 + k]) : 0.f; },
            [&](int, int k, int n) { return wd[(size_t)k * 1024 + n]; },
            [&](int m, int n, float a, float) {
                if (i0 + m < ce) { const int id = lst[i0 + m]; p.y[(size_t)id * DM + n] = f2bf(p.tokw[id] * a); }
            }, sm);
    }
}
__device__ __forceinline__ void st_inproj1(const P& p, int wg, int nwg, float* sm) {
    const int TIDX = otid();
    const int tn = 19, tm = T_TOK / 64;
    for (int w = wg; w < tm * tn; w += nwg) {
        const int m0 = (w / tn) * 64, n0 = (w % tn) * 64;
        gemm_tile64<1>(m0, n0, 1024,
            [&](int m, int k) { return bf2f(p.h[(size_t)m * DM + k]); },
            [&](int, int k, int n) { return p.od_w_in[(size_t)k * 1216 + n]; },
            [&](int m, int n, float a, float) { p.proj1[(size_t)m * 1216 + n] = f2bf(a); }, sm);
    }
}
__device__ __forceinline__ void st_mla_prep(const P& p, int wg, int nwg) {
    const int TIDX = otid();
    const int wid = TIDX >> 6, lane = TIDX & 63;
    for (int row = wg * 4 + wid; row < T_TOK; row += nwg * 4) {
        const int t = row & (SEQ - 1);
        const bf16_t* pr = p.proj1 + (size_t)row * 1216;
        float q[4], ss = 0.f;
#pragma unroll
        for (int i = 0; i < 4; ++i) { q[i] = bf2f(pr[i * 64 + lane]); ss += q[i] * q[i]; }
        ss = wsum(ss);
        float r = rsqrtf(ss * (1.0f / 256.0f) + 1e-6f);
#pragma unroll
        for (int i = 0; i < 4; ++i) p.cqn[(size_t)row * 384 + i * 64 + lane] = f2bf(q[i] * r * p.q_norm[i * 64 + lane]);
        float kvv[2]; ss = 0.f;
#pragma unroll
        for (int i = 0; i < 2; ++i) { kvv[i] = bf2f(pr[256 + i * 64 + lane]); ss += kvv[i] * kvv[i]; }
        ss = wsum(ss);
        r = rsqrtf(ss * (1.0f / 128.0f) + 1e-6f);
#pragma unroll
        for (int i = 0; i < 2; ++i) p.cqn[(size_t)row * 384 + 256 + i * 64 + lane] = f2bf(kvv[i] * r * p.kv_norm[i * 64 + lane]);
        if (lane < 32) {
            const float x1 = bf2f(pr[384 + lane]), x2 = bf2f(pr[384 + 32 + lane]);
            const float cs = p.ropec[t * 32 + lane], sn = p.ropes[t * 32 + lane];
            p.krope[(size_t)row * 64 + lane] = f2bf(x1 * cs - x2 * sn);
            p.krope[(size_t)row * 64 + 32 + lane] = f2bf(x1 * sn + x2 * cs);
        }
    }
}
__device__ __forceinline__ void st_mla_up(const P& p, int wg, int nwg, float* sm) {
    const int TIDX = otid();
    const int tm = T_TOK / 64;
    for (int w = wg; w < tm * (12 + 16); w += nwg) {
        const int m0 = (w / 28) * 64, c = w % 28;
        if (c < 12) {
            gemm_tile64<1>(m0, c * 64, 256,
                [&](int m, int k) { return bf2f(p.cqn[(size_t)m * 384 + k]); },
                [&](int, int k, int n) { return p.w_q_up[(size_t)k * 768 + n]; },
                [&](int m, int n, float a, float) { p.qmla[(size_t)m * 768 + n] = f2bf(a); }, sm);
        } else {
            gemm_tile64<1>(m0, (c - 12) * 64, 128,
                [&](int m, int k) { return bf2f(p.cqn[(size_t)m * 384 + 256 + k]); },
                [&](int, int k, int n) { return p.w_kv_up[(size_t)k * 1024 + n]; },
                [&](int m, int n, float a, float) { p.kvmla[(size_t)m * 1024 + n] = f2bf(a); }, sm);
        }
    }
}
__device__ __forceinline__ void st_mla_qrope(const P& p, int wg, int nwg) {
    const int TIDX = otid();
    for (int i = wg * 256 + TIDX; i < T_TOK * 4 * 32; i += nwg * 256) {
        const int row = i >> 7, h = (i >> 5) & 3, j = i & 31, t = row & (SEQ - 1);
        bf16_t* q = p.qmla + (size_t)row * 768 + h * 192 + 128;
        const float x1 = bf2f(q[j]), x2 = bf2f(q[32 + j]);
        const float cs = p.ropec[t * 32 + j], sn = p.ropes[t * 32 + j];
        q[j] = f2bf(x1 * cs - x2 * sn); q[32 + j] = f2bf(x1 * sn + x2 * cs);
    }
}

struct OSM { float m, l, o; };
__device__ __forceinline__ void osm_init(OSM& s) { s.m = -3e38f; s.l = 0.f; s.o = 0.f; }
__device__ __forceinline__ void osm_add(OSM& s, float sc, float v) {
    const float mn = fmaxf(s.m, sc), al = __expf(s.m - mn), pp = __expf(sc - mn);
    s.l = s.l * al + pp; s.o = s.o * al + pp * v; s.m = mn;
}

__device__ __forceinline__ void st_nsa(const P& p, int wg, int nwg) {
    const int TIDX = otid();
    const int wid = TIDX >> 6, lane = TIDX & 63;
    for (int w = wg * 4 + wid; w < T_TOK * 2; w += nwg * 4) {
        const int row = w >> 1, kv = w & 1, b = row >> 13, t = row & (SEQ - 1);
        const bf16_t* pb = p.proj + (size_t)b * SEQ * 2840;
        float q[4];
#pragma unroll
        for (int g = 0; g < 4; ++g) q[g] = bf2f(p.proj[(size_t)row * 2840 + (kv * 4 + g) * 64 + lane]);
        const float* kc = p.kcmp + (size_t)((b * 2 + kv) * 511) * 64;
        const float* vc = p.vcmp + (size_t)((b * 2 + kv) * 511) * 64;
        const float* bl = p.blut + (kv * 4) * 1024;
        int nvalid = (t >= 31) ? ((t - 31) >> 4) + 1 : 0; if (nvalid > 511) nvalid = 511;
        float cm[4], cl[4];
#pragma unroll
        for (int g = 0; g < 4; ++g) { cm[g] = -3e38f; cl[g] = 0.f; }
        for (int n = 0; n < nvalid; ++n) {
            const float kd = kc[n * 64 + lane]; const int dist = t - (16 * n + 31);
#pragma unroll
            for (int g = 0; g < 4; ++g) {
                const float s = wsum(q[g] * kd) * 0.125f + bl[g * 1024 + (dist > 1023 ? 1023 : dist)];
                const float mn = fmaxf(cm[g], s); cl[g] = cl[g] * __expf(cm[g] - mn) + __expf(s - mn); cm[g] = mn;
            }
        }
        float oc[4] = {0.f, 0.f, 0.f, 0.f}, imp0 = 0.f, imp1 = 0.f;
        for (int n = 0; n < nvalid; ++n) {
            const float kd = kc[n * 64 + lane], vd = vc[n * 64 + lane]; const int dist = t - (16 * n + 31);
            float ps = 0.f;
#pragma unroll
            for (int g = 0; g < 4; ++g) {
                const float s = wsum(q[g] * kd) * 0.125f + bl[g * 1024 + (dist > 1023 ? 1023 : dist)];
                const float pr = __expf(s - cm[g]) / cl[g];
                oc[g] += pr * vd; ps += pr;
            }
            const int mb = n >> 2;
            if (mb == lane) imp0 += ps;
            if (mb == lane + 64) imp1 += ps;
            if ((n & 3) == 3) { if (mb + 1 == lane) imp0 += ps; if (mb + 1 == lane + 64) imp1 += ps; }
        }
        const int blk_t = t >> 6;
        float s0, s1;
        { const int j = lane; const bool forced = (j == 0) || (j == blk_t) || (j == blk_t - 1); s0 = forced ? BIGF : (j <= blk_t ? imp0 : NEGF); }
        { const int j = lane + 64; const bool forced = (j == blk_t) || (j == blk_t - 1); s1 = forced ? BIGF : (j <= blk_t ? imp1 : NEGF); }
        unsigned long long selA = 0ull, selB = 0ull;
        for (int r = 0; r < 16; ++r) {
            float bv; int bi;
            if (s0 >= s1) { bv = s0; bi = lane; } else { bv = s1; bi = lane + 64; }
#pragma unroll
            for (int o = 32; o > 0; o >>= 1) {
                const float ov = __shfl_xor(bv, o); const int oi = __shfl_xor(bi, o);
                if (ov > bv || (ov == bv && oi < bi)) { bv = ov; bi = oi; }
            }
            if (bv <= NEGF) break;
            if (bi < 64) selA |= 1ull << bi; else selB |= 1ull << (bi - 64);
            if (bi == lane) s0 = -3e38f;
            if (bi == lane + 64) s1 = -3e38f;
        }
        OSM ss_[4];
#pragma unroll
        for (int g = 0; g < 4; ++g) osm_init(ss_[g]);
        for (int j = 0; j <= blk_t; ++j) {
            const bool sel = (j < 64) ? ((selA >> j) & 1ull) : ((selB >> (j - 64)) & 1ull);
            if (!sel) continue;
            const int pend = (j * 64 + 63 < t) ? j * 64 + 63 : t;
            for (int pos = j * 64; pos <= pend; ++pos) {
                const float kd = bf2f(pb[(size_t)pos * 2840 + 768 + kv * 64 + lane]), vd = bf2f(pb[(size_t)pos * 2840 + 896 + kv * 64 + lane]);
                const int dist = t - pos;
#pragma unroll
                for (int g = 0; g < 4; ++g) {
                    const float s = wsum(q[g] * kd) * 0.125f + bl[g * 1024 + (dist > 1023 ? 1023 : dist)];
                    osm_add(ss_[g], s, vd);
                }
            }
        }
        OSM sw_[4];
#pragma unroll
        for (int g = 0; g < 4; ++g) osm_init(sw_[g]);
        for (int pos = t - 511; pos <= t; ++pos) {
            float kd = 0.f, vd = 0.f;
            if (pos >= 0) { kd = bf2f(pb[(size_t)pos * 2840 + 1024 + kv * 64 + lane]); vd = bf2f(pb[(size_t)pos * 2840 + 1152 + kv * 64 + lane]); }
            const int dist = t - pos;
#pragma unroll
            for (int g = 0; g < 4; ++g) {
                const float s = wsum(q[g] * kd) * 0.125f + bl[g * 1024 + dist];
                osm_add(sw_[g], s, vd);
            }
        }
#pragma unroll
        for (int g = 0; g < 4; ++g) {
            const float* gt = p.gates + (size_t)row * 24 + (kv * 4 + g) * 3;
            const float ov = gt[0] * oc[g] + gt[1] * (ss_[g].o / ss_[g].l) + gt[2] * (sw_[g].o / sw_[g].l);
            p.o[(size_t)row * DM + (kv * 4 + g) * 64 + lane] = f2bf(ov);
        }
    }
}
__device__ __forceinline__ void st_moba(const P& p, int wg, int nwg) {
    const int TIDX = otid();
    const int wid = TIDX >> 6, lane = TIDX & 63;
    for (int w = wg * 4 + wid; w < T_TOK * 8; w += nwg * 4) {
        const int row = w >> 3, h = w & 7, b = row >> 13, t = row & (SEQ - 1), own = t >> 8;
        const bf16_t* pb = p.proj + (size_t)b * SEQ * 2840;
        const float q = bf2f(p.proj[(size_t)row * 2840 + 1304 + h * 64 + lane]);
        const float* km = p.kmean + (size_t)((b * 8 + h) * 32) * 64;
        const float* bl = p.blut + h * 1024;
        float gate = NEGF;
        for (int j = 0; j < own; ++j) { const float gj = wsum(q * km[j * 64 + lane]); if (lane == j) gate = gj; }
        unsigned selm = 0u;
        for (int r = 0; r < 3; ++r) {
            float bv = gate; int bi = lane;
#pragma unroll
            for (int o = 32; o > 0; o >>= 1) {
                const float ov = __shfl_xor(bv, o); const int oi = __shfl_xor(bi, o);
                if (ov > bv || (ov == bv && oi < bi)) { bv = ov; bi = oi; }
            }
            if (bv <= NEGF) break;
            selm |= 1u << bi;
            if (bi == lane) gate = -3e38f;
        }
        OSM st; osm_init(st);
        for (int j = 0; j <= own; ++j) {
            if (j < own && !((selm >> j) & 1u)) continue;
            const int pend = (j < own) ? j * 256 + 255 : t;
            for (int pos = j * 256; pos <= pend; ++pos) {
                const float kd = bf2f(pb[(size_t)pos * 2840 + 1816 + h * 64 + lane]), vd = bf2f(pb[(size_t)pos * 2840 + 2328 + h * 64 + lane]);
                const int dist = t - pos;
                const float s = wsum(q * kd) * 0.125f + bl[dist > 1023 ? 1023 : dist];
                osm_add(st, s, vd);
            }
        }
        p.o[(size_t)row * DM + 512 + h * 64 + lane] = f2bf(st.o / st.l);
    }
}
__device__ __forceinline__ void st_mla(const P& p, int wg, int nwg) {
    const int TIDX = otid();
    const int wid = TIDX >> 6, lane = TIDX & 63;
    const float scale = 0.07216878364870322f;
    for (int w = wg * 4 + wid; w < T_TOK * 4; w += nwg * 4) {
        const int row = w >> 2, h = w & 3, b = row >> 13, t = row & (SEQ - 1);
        const bf16_t* qp = p.qmla + (size_t)row * 768 + h * 192;
        const float q0 = bf2f(qp[lane]), q1 = bf2f(qp[64 + lane]), q2 = bf2f(qp[128 + lane]);
        float m = -3e38f, l = 0.f, o0 = 0.f, o1 = 0.f;
        for (int pos = 0; pos <= t; ++pos) {
            const size_t kr = (size_t)(b * SEQ + pos);
            const bf16_t* kvp = p.kvmla + kr * 1024 + h * 256;
            const float s = wsum(q0 * bf2f(kvp[lane]) + q1 * bf2f(kvp[64 + lane]) + q2 * bf2f(p.krope[kr * 64 + lane])) * scale;
            const float mn = fmaxf(m, s), al = __expf(m - mn), pp = __expf(s - mn);
            l = l * al + pp; o0 = o0 * al + pp * bf2f(kvp[128 + lane]); o1 = o1 * al + pp * bf2f(kvp[192 + lane]); m = mn;
        }
        p.o[(size_t)row * DM + h * 128 + lane] = f2bf(o0 / l);
        p.o[(size_t)row * DM + h * 128 + 64 + lane] = f2bf(o1 / l);
    }
}
__device__ __forceinline__ void st_swa(const P& p, int wg, int nwg) {
    const int TIDX = otid();
    const int wid = TIDX >> 6, lane = TIDX & 63;
    for (int w = wg * 4 + wid; w < T_TOK * 8; w += nwg * 4) {
        const int row = w >> 3, h = w & 7, kv = h >> 2, b = row >> 13, t = row & (SEQ - 1);
        const bf16_t* pb = p.proj1 + (size_t)b * SEQ * 1216;
        const float q = bf2f(p.proj1[(size_t)row * 1216 + 448 + h * 64 + lane]);
        const float* bl = p.blut + h * 1024;
        float m = p.sinks[h], l = 1.0f, o = 0.f;
        for (int pos = t - 127; pos <= t; ++pos) {
            float kd = 0.f, vd = 0.f;
            if (pos >= 0) { kd = bf2f(pb[(size_t)pos * 1216 + 960 + kv * 64 + lane]); vd = bf2f(pb[(size_t)pos * 1216 + 1088 + kv * 64 + lane]); }
            const float s = wsum(q * kd) * 0.125f + bl[t - pos];
            const float mn = fmaxf(m, s), al = __expf(m - mn), pp = __expf(s - mn);
            l = l * al + pp; o = o * al + pp * vd; m = mn;
        }
        p.o[(size_t)row * DM + 512 + h * 64 + lane] = f2bf(o / l);
    }
}

typedef short bf16x8 __attribute__((ext_vector_type(8)));
typedef float f32x4 __attribute__((ext_vector_type(4)));
typedef unsigned u32x2 __attribute__((ext_vector_type(2)));
typedef unsigned u32x4v __attribute__((ext_vector_type(4)));
#define LDSP __attribute__((address_space(3)))
#define GEMM_LDS_BYTES 65536

__device__ __forceinline__ unsigned pack_bf16(float lo, float hi) { return (unsigned)f2bf(lo) | ((unsigned)f2bf(hi) << 16); }

template <class AR, class BR, class Epi>
__device__ __forceinline__ void gemm128(const int nk, const size_t akstep, const size_t bkstep, AR arow, BR brow, Epi epi, LDSP char* lds, const int tid) {
    const int wid = tid >> 6, lane = tid & 63, wr = wid >> 1, wc = wid & 1, fr = lane & 15, fq = lane >> 4;
    const int srow = tid >> 3, gch = ((tid & 7) ^ (srow & 7)) * 8;
    const bf16_t* ap0 = arow(srow) + gch; const bf16_t* ap1 = arow(32 + srow) + gch; const bf16_t* ap2 = arow(64 + srow) + gch; const bf16_t* ap3 = arow(96 + srow) + gch;
    const bf16_t* bp0 = brow(srow) + gch; const bf16_t* bp1 = brow(32 + srow) + gch; const bf16_t* bp2 = brow(64 + srow) + gch; const bf16_t* bp3 = brow(96 + srow) + gch;
    LDSP char* lw = lds + wid * 1024;
#define G128_ISSUE(st, kt) do { LDSP char* la_ = lw + (st) * 32768; const size_t ao_ = (size_t)(kt) * akstep, bo_ = (size_t)(kt) * bkstep; \
        __builtin_amdgcn_global_load_lds((const unsigned*)(ap0 + ao_), (LDSP unsigned*)(la_), 16, 0, 0); \
        __builtin_amdgcn_global_load_lds((const unsigned*)(ap1 + ao_), (LDSP unsigned*)(la_ + 4096), 16, 0, 0); \
        __builtin_amdgcn_global_load_lds((const unsigned*)(ap2 + ao_), (LDSP unsigned*)(la_ + 8192), 16, 0, 0); \
        __builtin_amdgcn_global_load_lds((const unsigned*)(ap3 + ao_), (LDSP unsigned*)(la_ + 12288), 16, 0, 0); \
        __builtin_amdgcn_global_load_lds((const unsigned*)(bp0 + bo_), (LDSP unsigned*)(la_ + 16384), 16, 0, 0); \
        __builtin_amdgcn_global_load_lds((const unsigned*)(bp1 + bo_), (LDSP unsigned*)(la_ + 16384 + 4096), 16, 0, 0); \
        __builtin_amdgcn_global_load_lds((const unsigned*)(bp2 + bo_), (LDSP unsigned*)(la_ + 16384 + 8192), 16, 0, 0); \
        __builtin_amdgcn_global_load_lds((const unsigned*)(bp3 + bo_), (LDSP unsigned*)(la_ + 16384 + 12288), 16, 0, 0); } while (0)
    f32x4 acc[4][4];
#pragma unroll
    for (int m = 0; m < 4; ++m)
#pragma unroll
        for (int n = 0; n < 4; ++n) acc[m][n] = (f32x4){0.f, 0.f, 0.f, 0.f};
    const int aoff = (wr * 64 + fr) * 128, boff = 16384 + (wc * 64 + fr) * 128, c0 = (fq ^ (fr & 7)) * 16;
    G128_ISSUE(0, 0);
    for (int kt = 0; kt < nk; ++kt) {
        const int cur = kt & 1;
        asm volatile("s_waitcnt vmcnt(0)" ::: "memory");
        __builtin_amdgcn_s_barrier();
        asm volatile("" ::: "memory");
        if (kt + 1 < nk) G128_ISSUE(cur ^ 1, kt + 1);
        LDSP char* sb = lds + cur * 32768;
#pragma unroll
        for (int kk = 0; kk < 2; ++kk) {
            const int cc = kk ? (c0 ^ 64) : c0;
            bf16x8 af[4], bf[4];
#pragma unroll
            for (int m = 0; m < 4; ++m) af[m] = *(const LDSP bf16x8*)(sb + aoff + m * 2048 + cc);
#pragma unroll
            for (int n = 0; n < 4; ++n) bf[n] = *(const LDSP bf16x8*)(sb + boff + n * 2048 + cc);
#pragma unroll
            for (int m = 0; m < 4; ++m)
#pragma unroll
                for (int n = 0; n < 4; ++n) acc[m][n] = __builtin_amdgcn_mfma_f32_16x16x32_bf16(bf[n], af[m], acc[m][n], 0, 0, 0);
        }
    }
    asm volatile("s_waitcnt lgkmcnt(0)" ::: "memory");
    __builtin_amdgcn_s_barrier();
    asm volatile("" ::: "memory");
#undef G128_ISSUE
#pragma unroll
    for (int m = 0; m < 4; ++m) epi(wr * 64 + m * 16 + fr, wc * 64 + fq * 4, acc[m]);
}

template <int MAP> __device__ __forceinline__ int conv_rowmap(int n) {
    if (MAP == 0) return n;
    const int tile = n >> 6, cc = n & 63, wc = cc >> 5, i16 = (cc >> 4) & 1, i = cc & 15;
    return tile * 128 + wc * 64 + ((MAP == 1 ? 0 : 2) + i16) * 16 + i;
}
template <int MAP>
__device__ __forceinline__ void conv_batched(const float* src, int nmat, int K, int N, size_t sstride, bf16_t* dst, size_t dstride, int wg, int nwg, float* sm, int tid) {
    float(*t)[65] = (float(*)[65])sm;
    const int tk = K >> 6, tn = (N + 63) >> 6, per = tk * tn, total = nmat * per;
    f32x4 v[4];
    auto ld = [&](int w) {
        const int mat = w / per, r = w % per, kt = r / tn, nt = r % tn;
        const float* s = src + (size_t)mat * sstride;
#pragma unroll
        for (int i = 0; i < 4; ++i) {
            const int idx = tid + 256 * i, k = idx >> 4, n = (idx & 15) * 4;
            v[i] = (f32x4){0.f, 0.f, 0.f, 0.f};
            if (nt * 64 + n < N) v[i] = *(const f32x4*)(s + (size_t)(kt * 64 + k) * N + nt * 64 + n);
        }
    };
    if (wg < total) ld(wg);
    for (int w = wg; w < total; w += nwg) {
        const int mat = w / per, r = w % per, kt = r / tn, nt = r % tn;
        bf16_t* d = dst + (size_t)mat * dstride;
#pragma unroll
        for (int i = 0; i < 4; ++i) {
            const int idx = tid + 256 * i, k = idx >> 4, n = (idx & 15) * 4;
            t[k][n] = v[i][0]; t[k][n + 1] = v[i][1]; t[k][n + 2] = v[i][2]; t[k][n + 3] = v[i][3];
        }
        __syncthreads();
        if (w + nwg < total) ld(w + nwg);
        {
            const int n = tid >> 2, kq = (tid & 3) * 16;
            if (nt * 64 + n < N) {
                unsigned pk[8];
#pragma unroll
                for (int j = 0; j < 8; ++j) pk[j] = cvtpk(t[kq + 2 * j][n], t[kq + 2 * j + 1][n]);
                bf16_t* o = d + (size_t)conv_rowmap<MAP>(nt * 64 + n) * K + kt * 64 + kq;
                *(u32x4v*)o = (u32x4v){pk[0], pk[1], pk[2], pk[3]};
                *(u32x4v*)(o + 8) = (u32x4v){pk[4], pk[5], pk[6], pk[7]};
            }
        }
        __syncthreads();
    }
}
__device__ __forceinline__ void st_convert(const P& p, int wg, int nwg, float* sm) {
    const int tid = otid();
    conv_batched<1>(p.moe_wg, 32, 1024, 512, (size_t)1024 * 512, p.wt_gu, (size_t)1024 * 1024, wg, nwg, sm, tid);
    conv_batched<2>(p.moe_wu, 32, 1024, 512, (size_t)1024 * 512, p.wt_gu, (size_t)1024 * 1024, wg, nwg, sm, tid);
    conv_batched<0>(p.moe_wd, 32, 512, 1024, (size_t)512 * 1024, p.wt_d, (size_t)1024 * 512, wg, nwg, sm, tid);
    conv_batched<0>(p.ev_w_in, 1, 1024, 2840, 0, p.wt_in0, 0, wg, nwg, sm, tid);
    conv_batched<0>(p.ev_w_out, 1, 1024, 1024, 0, p.wt_out0, 0, wg, nwg, sm, tid);
    conv_batched<0>(p.ck_w1, 1, 2048, 256, 0, p.wt_c1, 0, wg, nwg, sm, tid);
    conv_batched<0>(p.cv_w1, 1, 2048, 256, 0, p.wt_c1 + 256 * 2048, 0, wg, nwg, sm, tid);
    conv_batched<0>(p.ck_w2, 1, 256, 64, 0, p.wt_c2, 0, wg, nwg, sm, tid);
    conv_batched<0>(p.cv_w2, 1, 256, 64, 0, p.wt_c2 + 64 * 256, 0, wg, nwg, sm, tid);
    conv_batched<0>(p.od_w_in, 1, 1024, 1216, 0, p.wt_in1, 0, wg, nwg, sm, tid);
    conv_batched<0>(p.od_w_out, 1, 1024, 1024, 0, p.wt_out1, 0, wg, nwg, sm, tid);
    conv_batched<0>(p.w_q_up, 1, 256, 768, 0, p.wt_qup, 0, wg, nwg, sm, tid);
    conv_batched<0>(p.w_kv_up, 1, 128, 1024, 0, p.wt_kvup, 0, wg, nwg, sm, tid);
    for (int w = wg; w < 8; w += nwg) {
        const int which = w >> 2, col = (w & 3) * 64 + (tid & 63), kq = tid >> 6;
        const float* w1 = which ? p.cv_w1 : p.ck_w1; const float* pos = which ? p.pos_v : p.pos_k;
        float a = 0.f;
        for (int k = kq * 512; k < kq * 512 + 512; ++k) a += pos[k] * w1[(size_t)k * 256 + col];
        sm[tid] = a;
        __syncthreads();
        if (tid < 64) p.c1[which * 256 + col] = sm[tid] + sm[64 + tid] + sm[128 + tid] + sm[192 + tid];
        __syncthreads();
    }
}


struct XcdOrder {
    int xcd, lw, nlw, tn, per;
    __device__ __forceinline__ XcdOrder(int wg, int nwg, int nM, int tn_) : xcd(wg & 7), lw(wg >> 3), nlw(nwg >> 3), tn(tn_), per((nM >> 3) * tn_) {}
    __device__ __forceinline__ bool get(int k, int& mt, int& nt) const { const int lt = lw + k * nlw; if (lt >= per) return false; mt = xcd + 8 * (lt / tn); nt = lt % tn; return true; }
};
__device__ __forceinline__ void st_inproj0_mf(const P& p, int wg, int nwg, LDSP char* lds) {
    const int tid = otid();
    const XcdOrder ord(wg, nwg, 128, 23);
    for (int k = 0;; ++k) {
        int mt, nt;
        if (!ord.get(k, mt, nt)) break;
        gemm128(16, 64, 64,
            [&](int r) { return p.h + (size_t)(mt * 128 + r) * DM; },
            [&](int r) { int n = nt * 128 + r; n = n < 2840 ? n : 2839; return p.wt_in0 + (size_t)n * 1024; },
            [&](int rl, int cl, const f32x4 (&a)[4]) {
                const int row = mt * 128 + rl;
#pragma unroll
                for (int n = 0; n < 4; ++n) {
                    const int col = nt * 128 + cl + n * 16;
                    if (col < 2840) {
                        *(u32x2*)(p.proj + (size_t)row * 2840 + col) = (u32x2){pack_bf16(a[n][0], a[n][1]), pack_bf16(a[n][2], a[n][3])};
                        if (col >= 1280 && col < 1304)
                            *(f32x4*)(p.gates + (size_t)row * 24 + (col - 1280)) = (f32x4){sigmf(a[n][0]), sigmf(a[n][1]), sigmf(a[n][2]), sigmf(a[n][3])};
                    }
                }
            }, lds, tid);
    }
}
__device__ __forceinline__ void st_cmp1_mf(const P& p, int wg, int nwg, LDSP char* lds) {
    const int tid = otid();
    for (int w = wg; w < 2 * 16 * 2; w += nwg) {
        const int which = w >> 5, mt = (w >> 1) & 15, nt = w & 1;
        const int colbase = which ? 640 : 512;
        gemm128(32, 2840, 64,
            [&](int r) { int m = mt * 128 + r; m = m < 2044 ? m : 2043; const int bk = m / 511, n = m % 511, b = bk >> 1, kv = bk & 1;
                         return p.proj + (size_t)(b * SEQ + 16 * n) * 2840 + colbase + kv * 64; },
            [&](int r) { return p.wt_c1 + (size_t)(which * 256 + nt * 128 + r) * 2048; },
            [&](int rl, int cl, const f32x4 (&a)[4]) {
                const int m = mt * 128 + rl;
                if (m < 2044) {
#pragma unroll
                    for (int n = 0; n < 4; ++n) {
                        const int col = nt * 128 + cl + n * 16;
                        const f32x4 cb = *(const f32x4*)(p.c1 + which * 256 + col);
                        *(u32x2*)(p.chidb + (size_t)(which * 2048 + m) * 256 + col) =
                            (u32x2){pack_bf16(gelu_tanh(a[n][0] + cb[0]), gelu_tanh(a[n][1] + cb[1])), pack_bf16(gelu_tanh(a[n][2] + cb[2]), gelu_tanh(a[n][3] + cb[3]))};
                    }
                }
            }, lds, tid);
    }
}
__device__ __forceinline__ void st_cmp2_mf(const P& p, int wg, int nwg, LDSP char* lds) {
    const int tid = otid();
    for (int w = wg; w < 2 * 16; w += nwg) {
        const int which = w >> 4, mt = w & 15;
        float* outp = which ? p.vcmp : p.kcmp;
        gemm128(4, 64, 64,
            [&](int r) { int m = mt * 128 + r; m = m < 2044 ? m : 2043; return p.chidb + (size_t)(which * 2048 + m) * 256; },
            [&](int r) { return p.wt_c2 + (size_t)(which * 64 + (r & 63)) * 256; },
            [&](int rl, int cl, const f32x4 (&a)[4]) {
                const int m = mt * 128 + rl;
                if (m < 2044) {
#pragma unroll
                    for (int n = 0; n < 4; ++n) { const int col = cl + n * 16; if (col < 64) {
                        *(f32x4*)(outp + (size_t)m * 64 + col) = a[n];
                        const int bk = m / 511, nn = m % 511;
                        *(u32x2*)(p.kcmpb + ((size_t)((which * 4 + bk) * 512 + nn)) * 64 + col) = (u32x2){cvtpk(a[n][0], a[n][1]), cvtpk(a[n][2], a[n][3])}; } }
                }
            }, lds, tid);
    }
}
__device__ __forceinline__ void st_outproj_mf(const P& p, int layer, int wg, int nwg, LDSP char* lds) {
    const int tid = otid();
    const bf16_t* W = layer ? p.wt_out1 : p.wt_out0;
    const float* xin = layer ? p.out : p.x;
    const XcdOrder ord(wg, nwg, 128, 8);
    for (int k = 0;; ++k) {
        int mt, nt;
        if (!ord.get(k, mt, nt)) break;
        gemm128(16, 64, 64,
            [&](int r) { return p.o + (size_t)(mt * 128 + r) * DM; },
            [&](int r) { return W + (size_t)(nt * 128 + r) * 1024; },
            [&](int rl, int cl, const f32x4 (&a)[4]) {
                const int row = mt * 128 + rl, b = row >> 13;
                const float* g = p.modv + (size_t)(layer * 2 + b) * 6144 + 2 * 1024;
#pragma unroll
                for (int n = 0; n < 4; ++n) {
                    const int col = nt * 128 + cl + n * 16;
                    const f32x4 xv = *(const f32x4*)(xin + (size_t)row * DM + col), gv = *(const f32x4*)(g + col);
                    *(f32x4*)(p.out + (size_t)row * DM + col) = xv + gv * a[n];
                }
            }, lds, tid);
    }
}
__device__ __forceinline__ bool moe_tile128(const int* cnt, int tt, int& e, int& i0, int& off) {
    int acc = 0, o = 0;
    for (int q = 0; q < 16; ++q) {
        const int c = cnt[q * 32], nt = (c + 127) >> 7;
        if (tt < acc + nt) { e = q; i0 = (tt - acc) * 128; off = o; return true; }
        acc += nt; o += c;
    }
    return false;
}
__device__ __forceinline__ void st_moe_up_mf(const P& p, int layer, int wg, int nwg, LDSP char* lds) {
    const int tid = otid();
    const int* cnt = p.cnt + layer * 512;
    for (int w = wg;; w += nwg) {
        int e, i0, off;
        if (!moe_tile128(cnt, w >> 3, e, i0, off)) break;
        const int nt = w & 7, ce = cnt[e * 32];
        const int* lst = p.list + e * T_TOK;
        const bf16_t* B = p.wt_gu + ((size_t)(layer * 16 + e) * 1024 + nt * 128) * 1024;
        gemm128(16, 64, 64,
            [&](int r) { const int i = (i0 + r < ce) ? i0 + r : i0; return p.h + (size_t)(lst[i] >> 1) * DM; },
            [&](int r) { return B + (size_t)r * 1024; },
            [&](int rl, int cl, const f32x4 (&a)[4]) {
                if (i0 + rl < ce) {
                    const int wc = cl >> 6, fq4 = cl & 63;
#pragma unroll
                    for (int n = 0; n < 2; ++n) {
                        const int col = nt * 64 + wc * 32 + n * 16 + fq4;
                        const f32x4 g = a[n], u = a[n + 2];
                        *(u32x2*)(p.hid + (size_t)(off + i0 + rl) * 512 + col) =
                            (u32x2){pack_bf16(siluf(g[0]) * u[0], siluf(g[1]) * u[1]), pack_bf16(siluf(g[2]) * u[2], siluf(g[3]) * u[3])};
                    }
                }
            }, lds, tid);
    }
}
__device__ __forceinline__ void st_moe_down_mf(const P& p, int layer, int wg, int nwg, LDSP char* lds) {
    const int tid = otid();
    const int* cnt = p.cnt + layer * 512;
    for (int w = wg;; w += nwg) {
        int e, i0, off;
        if (!moe_tile128(cnt, w >> 3, e, i0, off)) break;
        const int nt = w & 7, ce = cnt[e * 32];
        const int* lst = p.list + e * T_TOK;
        const bf16_t* B = p.wt_d + ((size_t)(layer * 16 + e) * 1024 + nt * 128) * 512;
        gemm128(8, 64, 64,
            [&](int r) { const int i = (i0 + r < ce) ? i0 + r : i0; return p.hid + (size_t)(off + i) * 512; },
            [&](int r) { return B + (size_t)r * 512; },
            [&](int rl, int cl, const f32x4 (&a)[4]) {
                if (i0 + rl < ce) {
                    const int id = lst[i0 + rl]; const float wt = p.tokw[id];
#pragma unroll
                    for (int n = 0; n < 4; ++n) {
                        const int col = nt * 128 + cl + n * 16;
                        *(u32x2*)(p.y + (size_t)id * DM + col) = (u32x2){pack_bf16(wt * a[n][0], wt * a[n][1]), pack_bf16(wt * a[n][2], wt * a[n][3])};
                    }
                }
            }, lds, tid);
    }
}
__device__ __forceinline__ void st_inproj1_mf(const P& p, int wg, int nwg, LDSP char* lds) {
    const int tid = otid();
    const XcdOrder ord(wg, nwg, 128, 10);
    for (int k = 0;; ++k) {
        int mt, nt;
        if (!ord.get(k, mt, nt)) break;
        gemm128(16, 64, 64,
            [&](int r) { return p.h + (size_t)(mt * 128 + r) * DM; },
            [&](int r) { int n = nt * 128 + r; n = n < 1216 ? n : 1215; return p.wt_in1 + (size_t)n * 1024; },
            [&](int rl, int cl, const f32x4 (&a)[4]) {
                const int row = mt * 128 + rl;
#pragma unroll
                for (int n = 0; n < 4; ++n) {
                    const int col = nt * 128 + cl + n * 16;
                    if (col < 1216) *(u32x2*)(p.proj1 + (size_t)row * 1216 + col) = (u32x2){pack_bf16(a[n][0], a[n][1]), pack_bf16(a[n][2], a[n][3])};
                }
            }, lds, tid);
    }
}
__device__ __forceinline__ void st_mla_up_mf(const P& p, int wg, int nwg, LDSP char* lds) {
    const int tid = otid();
    const XcdOrder ord(wg, nwg, 128, 14);
    for (int k = 0;; ++k) {
        int mt, c;
        if (!ord.get(k, mt, c)) break;
        if (c < 6) {
            gemm128(4, 64, 64,
                [&](int r) { return p.cqn + (size_t)(mt * 128 + r) * 384; },
                [&](int r) { return p.wt_qup + (size_t)(c * 128 + r) * 256; },
                [&](int rl, int cl, const f32x4 (&a)[4]) {
                    const int row = mt * 128 + rl, wc = cl >> 6;
                    f32x4 v[4] = {a[0], a[1], a[2], a[3]};
                    if (((c == 1 || c == 4) && wc == 0) || ((c == 2 || c == 5) && wc == 1)) {
                        const int t = row & (SEQ - 1), i0 = cl & 63;
#pragma unroll
                        for (int n = 0; n < 2; ++n) {
                            const f32x4 cs = *(const f32x4*)(p.ropec + t * 32 + n * 16 + i0), sn = *(const f32x4*)(p.ropes + t * 32 + n * 16 + i0);
                            v[n] = a[n] * cs - a[n + 2] * sn; v[n + 2] = a[n] * sn + a[n + 2] * cs;
                        }
                    }
#pragma unroll
                    for (int n = 0; n < 4; ++n) *(u32x2*)(p.qmla + (size_t)row * 768 + c * 128 + cl + n * 16) = (u32x2){cvtpk(v[n][0], v[n][1]), cvtpk(v[n][2], v[n][3])};
                }, lds, tid);
        } else {
            gemm128(2, 64, 64,
                [&](int r) { return p.cqn + (size_t)(mt * 128 + r) * 384 + 256; },
                [&](int r) { return p.wt_kvup + (size_t)((c - 6) * 128 + r) * 128; },
                [&](int rl, int cl, const f32x4 (&a)[4]) {
                    const int row = mt * 128 + rl;
#pragma unroll
                    for (int n = 0; n < 4; ++n) *(u32x2*)(p.kvmla + (size_t)row * 1024 + (c - 6) * 128 + cl + n * 16) = (u32x2){pack_bf16(a[n][0], a[n][1]), pack_bf16(a[n][2], a[n][3])};
                }, lds, tid);
        }
    }
}

typedef float f32x16 __attribute__((ext_vector_type(16)));
typedef short s16x4 __attribute__((ext_vector_type(4)));
#define ATT_NEG (-1e30f)
#define ATT_SHIFT (-16.0f)
#define LOG2E 1.4426950408889634f

__device__ __forceinline__ int swz128(int row) { return (((row >> 1) & 1) << 2) | ((row >> 2) & 3); }
__device__ __forceinline__ int swz256(int row) { return ((row & 3) << 2) | ((row >> 2) & 3); }

struct AttLane {
    int kbase;
    int v0[2];
};
template <int KROWB, int VROWB, int DT>
__device__ __forceinline__ void att_lane_init(AttLane& L, int lane) {
    const int q = lane & 31, hh = lane >> 5, x = hh ^ swz128(q);
    L.kbase = q * KROWB + x * 16;
    const int rl = 4 * hh + ((lane & 15) >> 2), blk = (lane >> 4) & 1, pp = lane & 3;
#pragma unroll
    for (int t = 0; t < 2; ++t) {
        const int g = (VROWB == 256) ? (((rl & 3) << 2) | ((2 * t + hh) & 3)) : ((((rl >> 1) & 1) << 2) | ((2 * t + hh) & 3));
        L.v0[t] = rl * VROWB + (((2 * blk + (pp >> 1)) ^ g) * 16) + 8 * (pp & 1);
    }
}
template <int KS, int KROWB, int MODE, bool WANT_P, bool IMP>
__device__ __forceinline__ void att_qk(LDSP const char* kb, const AttLane& L, const bf16x8 (&qf)[KS], bf16x8 (&pf)[4], float& lsum, const float c1, const float cadd,
                                       const unsigned lutv, const int dq16, LDSP float* improw, const float invl) {
    float la = 0.f, lb = 0.f, lc = 0.f, ld = 0.f;
#pragma unroll
    for (int kt = 0; kt < 2; ++kt) {
        f32x16 s;
#pragma unroll
        for (int r = 0; r < 16; ++r) s[r] = 0.f;
        constexpr int KG = (KS > 4) ? 2 : 4;
#pragma unroll
        for (int k4 = 0; k4 < KS; k4 += KG) {
            bf16x8 a[KG];
#pragma unroll
            for (int j = 0; j < KG; ++j) { const int ks = k4 + j; a[j] = *(const LDSP bf16x8*)(kb + (L.kbase ^ (32 * (ks & 3))) + (ks >> 2) * 128 + kt * 32 * KROWB); }
#pragma unroll
            for (int j = 0; j < KG; ++j) s = __builtin_amdgcn_mfma_f32_32x32x16_bf16(a[j], qf[k4 + j], s, 0, 0, 0);
            asm volatile("" ::: "memory");
        }
        float pr[16];
#pragma unroll
        for (int r = 0; r < 16; ++r) {
            const int koff = 32 * kt + (r & 3) + 8 * (r >> 2);
            float add = cadd;
            if (MODE == 1) add = *(const LDSP float*)(lutv + (63 - koff) * 4);
            if (MODE == 2) { int d = dq16 - 16 * koff; d = d < -1 ? -1 : d; d = d > 1087 ? 1087 : d; add = *(const LDSP float*)(lutv + (unsigned)(64 + d) * 4u); }
            pr[r] = __builtin_amdgcn_exp2f(__builtin_fmaf(s[r], c1, add));
        }
#pragma unroll
        for (int r = 0; r < 16; r += 4) { la += pr[r]; lb += pr[r + 1]; lc += pr[r + 2]; ld += pr[r + 3]; }
        if (IMP) {
#pragma unroll
            for (int g = 0; g < 4; ++g) {
                (void)__hip_atomic_fetch_add((LDSP unsigned*)improw + 8 * kt + 2 * g, (unsigned)(((pr[4 * g] + pr[4 * g + 1]) + (pr[4 * g + 2] + pr[4 * g + 3])) * invl + 0.5f), __ATOMIC_RELAXED, __HIP_MEMORY_SCOPE_WORKGROUP);
                (void)__hip_atomic_fetch_add((LDSP unsigned*)improw + 8 * kt + 2 * g + 1, (unsigned)(pr[4 * g + 3] * invl + 0.5f), __ATOMIC_RELAXED, __HIP_MEMORY_SCOPE_WORKGROUP);
            }
        }
        if (WANT_P) {
#pragma unroll
            for (int sI = 0; sI < 2; ++sI) {
                union { unsigned u[4]; bf16x8 v; } cv;
#pragma unroll
                for (int i = 0; i < 4; ++i) cv.u[i] = cvtpk(pr[8 * sI + 2 * i], pr[8 * sI + 2 * i + 1]);
                pf[kt * 2 + sI] = cv.v;
            }
        }
    }
    lsum += (la + lb) + (lc + ld);
}
template <int DT, int VROWB>
__device__ __forceinline__ void att_pv(LDSP const char* vb, const AttLane& L, const bf16x8 (&pf)[4], f32x16 (&o)[DT]) {
    const unsigned vba = (unsigned)(size_t)vb;
#pragma unroll
    for (int ks2 = 0; ks2 < 4; ++ks2) {
#pragma unroll
        for (int d0 = 0; d0 < DT; d0 += 2) {
            s16x4 lo[2], hi[2];
#pragma unroll
            for (int j = 0; j < 2; ++j) {
                asm volatile("ds_read_b64_tr_b16 %0, %1 offset:%2" : "=v"(lo[j]) : "v"(vba + (L.v0[0] ^ ((d0 + j) << 6))), "i"((16 * ks2) * VROWB) : "memory");
                asm volatile("ds_read_b64_tr_b16 %0, %1 offset:%2" : "=v"(hi[j]) : "v"(vba + (L.v0[1] ^ ((d0 + j) << 6))), "i"((16 * ks2 + 8) * VROWB) : "memory");
            }
            asm volatile("s_waitcnt lgkmcnt(0)" ::: "memory");
#pragma unroll
            for (int j = 0; j < 2; ++j) {
                asm volatile("" : "+v"(lo[j]), "+v"(hi[j]));
                const bf16x8 vf = __builtin_shufflevector(lo[j], hi[j], 0, 1, 2, 3, 4, 5, 6, 7);
                o[d0 + j] = __builtin_amdgcn_mfma_f32_32x32x16_bf16(vf, pf[ks2], o[d0 + j], 0, 0, 0);
            }
        }
    }
}
template <int CPR>
__device__ __forceinline__ void att_stage_map(int (&rowc)[(CPR == 24) ? 6 : 1], int tid) {
    if (CPR == 24) {
#pragma unroll
        for (int i = 0; i < 6; ++i) {
            const int c = tid + 256 * i, row = c / 24, cc = c % 24;
            rowc[i % ((CPR == 24) ? 6 : 1)] = (row << 8) | ((cc & ~7) | ((cc & 7) ^ swz128(row)));
        }
    } else if (CPR == 16) {
        const int row = tid >> 4; rowc[0] = (row << 8) | ((tid & 15) ^ swz256(row));
    } else {
        const int row = tid >> 3; rowc[0] = (row << 8) | ((tid & 7) ^ swz128(row));
    }
}
template <int CPR, class SRC>
__device__ __forceinline__ void att_stage(LDSP char* dst, SRC src, const int (&rowc)[(CPR == 24) ? 6 : 1], int wid) {
#pragma unroll
    for (int i = 0; i < CPR / 4; ++i) {
        const int rc = rowc[(CPR == 24) ? i : 0];
        const int row = (rc >> 8) + ((CPR == 24) ? 0 : i * (256 / CPR));
        __builtin_amdgcn_global_load_lds((const unsigned*)src(row, rc & 255), (LDSP unsigned*)(dst + (256 * i + 64 * wid) * 16), 16, 0, 0);
    }
}
__device__ __forceinline__ int wq_next(int* ctr, LDSP int* slot, int tid) {
    __syncthreads();
    if (tid == 0) *slot = atomicAdd(ctr, 1);
    __syncthreads();
    return *slot;
}

__device__ __forceinline__ void build_lut(LDSP float* tab, const float* blut_h, int n, int wlimit, int tid) {
    for (int i = tid; i < n; i += 256) { const int d = i - 64; tab[i] = (d < 0 || d >= wlimit) ? ATT_NEG : blut_h[d > 1023 ? 1023 : d] * LOG2E + ATT_SHIFT; }
}
#define ATT_BAR() do { __builtin_amdgcn_s_barrier(); asm volatile("" ::: "memory"); } while (0)

__device__ __forceinline__ void mla_item(const P& p, const int item, LDSP char* lds, const int tid0) {
    LDSP char* kb = lds; LDSP char* vb = lds + 24576; LDSP float* lut = (LDSP float*)(lds + 40960);
    const float c1 = 0.07216878364870322f * LOG2E;
    int tid = tid0; asm volatile("" : "+v"(tid));
    const int wid = tid >> 6, lane = tid & 63, q = lane & 31, hh = lane >> 5;
    AttLane L; att_lane_init<384, 256, 4>(L, lane);
    int krc[6], vrc[1];
    att_stage_map<24>(krc, tid); att_stage_map<16>(vrc, tid);
    int qt, bh, part;
    if (item >= 640) { const int r = item - 640; qt = 15 - (r >> 3); bh = r & 7; part = 0; }
    else {
        int g = 0; while (16 * (g + 1) + 8 * ((g + 2) >> 1) <= item) ++g;
        const int r = item - (16 * g + 8 * ((g + 1) >> 1)), Ln = 64 - g;
        if (r < 16) { qt = Ln - 1; bh = r & 7; part = 1 + (r >> 3); } else { qt = (Ln >> 1) - 1; bh = (r - 16) & 7; part = 0; }
    }
    const int b = bh >> 2, h = bh & 3;
    const int tw = qt * 128 + wid * 32;
    bf16x8 qf[12];
    {
        const bf16_t* qp = p.qmla + (size_t)(b * SEQ + tw + q) * 768 + h * 192 + 8 * hh;
#pragma unroll
        for (int ks = 0; ks < 12; ++ks) qf[ks] = *(const bf16x8*)(qp + 16 * ks);
    }
    f32x16 o[4];
#pragma unroll
    for (int dt = 0; dt < 4; ++dt)
#pragma unroll
        for (int r = 0; r < 16; ++r) o[dt][r] = 0.f;
    float lsum = 0.f;
    const int i0 = (part == 2) ? qt + 1 : 0, ntiles = (part == 1) ? qt + 1 : 2 * qt + 2;
    const bf16_t* kvb = p.kvmla + (size_t)b * SEQ * 1024 + h * 256;
    const bf16_t* krb = p.krope + (size_t)b * SEQ * 64;
    auto ksrc = [&](int pos0) { return [=](int row, int gc) { return gc < 16 ? kvb + (size_t)(pos0 + row) * 1024 + gc * 8 : krb + (size_t)(pos0 + row) * 64 + (gc - 16) * 8; }; };
    auto vsrc = [&](int pos0) { return [=](int row, int gc) { return kvb + (size_t)(pos0 + row) * 1024 + 128 + gc * 8; }; };
    att_stage<24>(kb, ksrc(i0 * 64), krc, wid);
    for (int i = i0; i < ntiles; ++i) {
        const int pos0 = i * 64;
        asm volatile("s_waitcnt vmcnt(0)" ::: "memory"); ATT_BAR();
        att_stage<16>(vb, vsrc(pos0), vrc, wid);
        const bool active = pos0 <= tw + 31, diag = pos0 + 63 > tw;
        bf16x8 pf[4];
        if (active) {
            if (diag) {
                int dq = tw + q - pos0 - 4 * hh; dq = dq < -1 ? -1 : dq;
                att_qk<12, 384, 1, true, false>(kb, L, qf, pf, lsum, c1, 0.f, (unsigned)(size_t)lut + (unsigned)(dq + 1) * 4u, 0, nullptr, 0.f);
            } else att_qk<12, 384, 0, true, false>(kb, L, qf, pf, lsum, c1, ATT_SHIFT, 0u, 0, nullptr, 0.f);
        }
        asm volatile("s_waitcnt vmcnt(0) lgkmcnt(0)" ::: "memory"); ATT_BAR();
        if (i + 1 < ntiles) att_stage<24>(kb, ksrc(pos0 + 64), krc, wid);
        if (active) att_pv<4, 256>(vb, L, pf, o);
    }
    const float lt = lsum + __shfl_xor(lsum, 32);
    int tid2 = tid0; asm volatile("" : "+v"(tid2));
    const int lane2 = tid2 & 63, trow = qt * 128 + (tid2 >> 6) * 32 + (lane2 & 31);
    bf16_t* op; float inv;
    if (part == 0) { inv = 1.0f / lt; op = p.o + (size_t)(b * SEQ + trow) * DM + h * 128 + 4 * (lane2 >> 5); }
    else {
        const size_t rec = (size_t)((part - 1) * 8 + bh) * (SEQ / 2) + (trow - SEQ / 2);
        inv = 1.0f; op = p.mlap + rec * 128 + 4 * (lane2 >> 5);
        if (lane2 < 32) p.mlal[rec] = lt;
    }
#pragma unroll
    for (int dt = 0; dt < 4; ++dt)
#pragma unroll
        for (int rq = 0; rq < 4; ++rq)
            *(u32x2*)(op + 32 * dt + 8 * rq) = (u32x2){cvtpk(o[dt][4 * rq] * inv, o[dt][4 * rq + 1] * inv), cvtpk(o[dt][4 * rq + 2] * inv, o[dt][4 * rq + 3] * inv)};
}
__device__ __forceinline__ void st_mla_combine(const P& p, int wg, int nwg) {
    const int TIDX = otid();
    const int wid = TIDX >> 6, lane = TIDX & 63;
    for (int w = wg * 4 + wid; w < 8 * (SEQ / 2); w += nwg * 4) {
        const int bh = w / (SEQ / 2), t = SEQ / 2 + w % (SEQ / 2), b = bh >> 2, h = bh & 3;
        const size_t r0 = (size_t)w, r1 = (size_t)(8 * (SEQ / 2) + w);
        const float inv = 1.0f / (p.mlal[r0] + p.mlal[r1]);
        const unsigned a = *(const unsigned*)(p.mlap + r0 * 128 + lane * 2), c = *(const unsigned*)(p.mlap + r1 * 128 + lane * 2);
        const float x0 = __uint_as_float(a << 16) + __uint_as_float(c << 16), x1 = __uint_as_float(a & 0xffff0000u) + __uint_as_float(c & 0xffff0000u);
        *(unsigned*)(p.o + (size_t)(b * SEQ + t) * DM + h * 128 + lane * 2) = cvtpk(x0 * inv, x1 * inv);
    }
}

__device__ __forceinline__ void swa_item(const P& p, const int item, LDSP char* lds, const int tid0) {
    LDSP char* kb = lds; LDSP char* vb = lds + 8192; LDSP float* luts = (LDSP float*)(lds + 46080);
    const float c1 = 0.125f * LOG2E;
    int tid = tid0; asm volatile("" : "+v"(tid));
    const int wid = tid >> 6, lane = tid & 63, q = lane & 31, hh = lane >> 5;
    AttLane L; att_lane_init<128, 128, 2>(L, lane);
    int rc[1]; att_stage_map<8>(rc, tid);
    const int b = item >> 9, kvh = (item >> 8) & 1, t0 = (item & 255) * 32, head = kvh * 4 + wid;
    bf16x8 qf[4];
    {
        const bf16_t* qp = p.proj1 + (size_t)(b * SEQ + t0 + q) * 1216 + 448 + head * 64 + 8 * hh;
#pragma unroll
        for (int ks = 0; ks < 4; ++ks) qf[ks] = *(const bf16x8*)(qp + 16 * ks);
    }
    f32x16 o[2];
#pragma unroll
    for (int dt = 0; dt < 2; ++dt)
#pragma unroll
        for (int r = 0; r < 16; ++r) o[dt][r] = 0.f;
    float lsum = 0.f;
    const bf16_t* kbp = p.proj1 + (size_t)b * SEQ * 1216 + 960 + kvh * 64;
    const bf16_t* zr = p.zrow;
    auto ksrc = [&](int pos0) { return [=](int row, int gc) { const int pos = pos0 + row; return (pos >= 0 && pos < SEQ) ? kbp + (size_t)pos * 1216 + gc * 8 : zr + gc * 8; }; };
    auto vsrc = [&](int pos0) { return [=](int row, int gc) { const int pos = pos0 + row; return (pos >= 0 && pos < SEQ) ? kbp + (size_t)pos * 1216 + 128 + gc * 8 : zr + gc * 8; }; };
    const unsigned tab = (unsigned)(size_t)(luts + head * 256);
    att_stage<8>(kb, ksrc(t0 - 128), rc, wid);
    for (int i = 0; i < 3; ++i) {
        const int pos0 = t0 - 128 + 64 * i;
        asm volatile("s_waitcnt vmcnt(0)" ::: "memory"); ATT_BAR();
        att_stage<8>(vb, vsrc(pos0), rc, wid);
        bf16x8 pf[4];
        int dq = t0 + q - pos0 - 4 * hh; dq = dq < -1 ? -1 : dq;
        att_qk<4, 128, 1, true, false>(kb, L, qf, pf, lsum, c1, 0.f, tab + (unsigned)(dq + 1) * 4u, 0, nullptr, 0.f);
        asm volatile("s_waitcnt vmcnt(0) lgkmcnt(0)" ::: "memory"); ATT_BAR();
        if (i + 1 < 3) att_stage<8>(kb, ksrc(pos0 + 64), rc, wid);
        att_pv<2, 128>(vb, L, pf, o);
    }
    const float lt = lsum + __shfl_xor(lsum, 32) + __builtin_amdgcn_exp2f(p.sinks[head] * LOG2E + ATT_SHIFT);
    const float inv = 1.0f / lt;
    bf16_t* op = p.o + (size_t)(b * SEQ + t0 + q) * DM + 512 + head * 64 + 4 * hh;
#pragma unroll
    for (int dt = 0; dt < 2; ++dt)
#pragma unroll
        for (int rq = 0; rq < 4; ++rq)
            *(u32x2*)(op + 32 * dt + 8 * rq) = (u32x2){cvtpk(o[dt][4 * rq] * inv, o[dt][4 * rq + 1] * inv), cvtpk(o[dt][4 * rq + 2] * inv, o[dt][4 * rq + 3] * inv)};
}
__device__ __forceinline__ void st_attn1(const P& p, LDSP char* lds) {
    const int tid0 = otid();
    LDSP float* lut = (LDSP float*)(lds + 40960); LDSP int* slot = (LDSP int*)(lds + 45568); LDSP float* luts = (LDSP float*)(lds + 46080);
    for (int i = tid0; i < 1152; i += 256) lut[i] = (i < 64) ? ATT_NEG : ATT_SHIFT;
#pragma unroll 1
    for (int h = 0; h < 8; ++h) build_lut(luts + h * 256, p.blut + h * 1024, 256, 128, tid0);
    for (;;) {
        const int item = wq_next(p.wq + 0, slot, tid0);
        if (item >= 768 + 1024) break;
        if (item < 768) mla_item(p, item, lds, tid0); else swa_item(p, item - 768, lds, tid0);
    }
}

#define A0_GLUT 16384
#define A0_WLUT 34816
#define A0_IMP 45056
#define A0_SEL 61568
#define A0_UN 62080
#define A0_LIST 62144
#define A0_SLOT 62720
__device__ __forceinline__ unsigned wmax_u32(unsigned v) {
#pragma unroll
    for (int o = 32; o > 0; o >>= 1) { const unsigned t = (unsigned)__shfl_xor((int)v, o); v = t > v ? t : v; }
    return v;
}
#define ATT_STORE_O(op, o, sc) do { _Pragma("unroll") for (int dt_ = 0; dt_ < 2; ++dt_) _Pragma("unroll") for (int rq_ = 0; rq_ < 4; ++rq_) \
        *(u32x2*)((op) + 32 * dt_ + 8 * rq_) = (u32x2){cvtpk((o)[dt_][4 * rq_] * (sc), (o)[dt_][4 * rq_ + 1] * (sc)), cvtpk((o)[dt_][4 * rq_ + 2] * (sc), (o)[dt_][4 * rq_ + 3] * (sc))}; } while (0)

__device__ __forceinline__ void nsa_item(const P& p, const int item, LDSP char* lds, const int tid0) {
    LDSP char* kb = lds; LDSP char* vb = lds + 8192;
    LDSP float* glut = (LDSP float*)(lds + A0_GLUT); LDSP float* wlut = (LDSP float*)(lds + A0_WLUT); LDSP float* imp = (LDSP float*)(lds + A0_IMP);
    LDSP unsigned* sel = (LDSP unsigned*)(lds + A0_SEL); LDSP unsigned* un = (LDSP unsigned*)(lds + A0_UN); LDSP unsigned short* blist = (LDSP unsigned short*)(lds + A0_LIST);
    const float c1 = 0.125f * LOG2E;
    int tid = tid0; asm volatile("" : "+v"(tid));
    const int wid = tid >> 6, lane = tid & 63, q = lane & 31, hh = lane >> 5;
    const int tile = 255 - (item >> 2), b = (item >> 1) & 1, kvh = item & 1, t0 = tile * 32, blk_t = t0 >> 6, head = kvh * 4 + wid;
#pragma unroll 1
    for (int h = 0; h < 4; ++h) { build_lut(glut + h * 1152, p.blut + (kvh * 4 + h) * 1024, 1152, 1 << 30, tid); build_lut(wlut + h * 640, p.blut + (kvh * 4 + h) * 1024, 640, 512, tid); }
    for (int i = tid; i < 32 * 129; i += 256) imp[i] = 0.f;
    AttLane L; att_lane_init<128, 128, 2>(L, lane);
    int rc[1]; att_stage_map<8>(rc, tid);
    const size_t rowq = (size_t)(b * SEQ + t0 + q);
    bf16x8 qf[4];
    {
        const bf16_t* qp = p.proj + rowq * 2840 + head * 64 + 8 * hh;
#pragma unroll
        for (int ks = 0; ks < 4; ++ks) qf[ks] = *(const bf16x8*)(qp + 16 * ks);
    }
    const float gc = p.gates[rowq * 24 + head * 3 + 0], gs = p.gates[rowq * 24 + head * 3 + 1], gw = p.gates[rowq * 24 + head * 3 + 2];
    const unsigned gtab = (unsigned)(size_t)(glut + wid * 1152), wtab = (unsigned)(size_t)(wlut + wid * 640);
    const bf16_t* zr = p.zrow;
    const bf16_t* pb = p.proj + (size_t)b * SEQ * 2840;
    f32x16 of[2], o[2];
#pragma unroll
    for (int dt = 0; dt < 2; ++dt)
#pragma unroll
        for (int r = 0; r < 16; ++r) { of[dt][r] = 0.f; o[dt][r] = 0.f; }
    bf16x8 pf[4];
    __syncthreads();
    const float cfar = glut[wid * 1152 + 64 + 1023];
    {
        int nvm = (t0 >> 4) + 1; nvm = nvm > 511 ? 511 : nvm;
        const int ntc = (nvm + 63) >> 6;
        const bf16_t* kcb = p.kcmpb + (size_t)((b * 2 + kvh) * 512) * 64;
        const bf16_t* vcb = p.kcmpb + (size_t)((4 + b * 2 + kvh) * 512) * 64;
        auto csrc = [&](const bf16_t* base, int n0) { return [=](int row, int gcx) { const int n = n0 + row; return n < 511 ? base + (size_t)n * 64 + gcx * 8 : zr + gcx * 8; }; };
        float lsum = 0.f;
        for (int nt = 0; nt < ntc; ++nt) {
            att_stage<8>(kb, csrc(kcb, nt * 64), rc, wid);
            asm volatile("s_waitcnt vmcnt(0)" ::: "memory"); ATT_BAR();
            const int dq16 = t0 + q - 31 - 1024 * nt - 64 * hh;
            if (t0 - 31 - 16 * (nt * 64 + 63) >= 1023) att_qk<4, 128, 0, false, false>(kb, L, qf, pf, lsum, c1, cfar, 0u, 0, nullptr, 0.f);
            else att_qk<4, 128, 2, false, false>(kb, L, qf, pf, lsum, c1, 0.f, gtab, dq16, nullptr, 0.f);
            asm volatile("s_waitcnt lgkmcnt(0)" ::: "memory"); ATT_BAR();
        }
        const float lc = lsum + __shfl_xor(lsum, 32);
        const float invl = lc > 0.f ? 1.0f / lc : 0.f;
        float dummy = 0.f;
        for (int nt = 0; nt < ntc; ++nt) {
            att_stage<8>(kb, csrc(kcb, nt * 64), rc, wid);
            att_stage<8>(vb, csrc(vcb, nt * 64), rc, wid);
            asm volatile("s_waitcnt vmcnt(0)" ::: "memory"); ATT_BAR();
            const int dq16 = t0 + q - 31 - 1024 * nt - 64 * hh;
            LDSP float* improw = imp + q * 129 + 16 * nt + hh;
            if (t0 - 31 - 16 * (nt * 64 + 63) >= 1023) att_qk<4, 128, 0, true, true>(kb, L, qf, pf, dummy, c1, cfar, 0u, 0, improw, invl * 524288.0f);
            else att_qk<4, 128, 2, true, true>(kb, L, qf, pf, dummy, c1, 0.f, gtab, dq16, improw, invl * 524288.0f);
            att_pv<2, 128>(vb, L, pf, o);
            asm volatile("s_waitcnt lgkmcnt(0)" ::: "memory"); ATT_BAR();
        }
        const float sc = gc * invl;
#pragma unroll
        for (int dt = 0; dt < 2; ++dt)
#pragma unroll
            for (int r = 0; r < 16; ++r) { of[dt][r] = o[dt][r] * sc; o[dt][r] = 0.f; }
    }
    __syncthreads();
    {
        unsigned u0 = 0u, u1 = 0u, u2 = 0u, u3 = 0u;
        for (int i = 0; i < 8; ++i) {
            const int tok = wid * 8 + i;
            const unsigned v0 = ((LDSP const unsigned*)imp)[tok * 129 + lane], v1 = ((LDSP const unsigned*)imp)[tok * 129 + 64 + lane];
            const int j0 = lane, j1 = lane + 64;
            const bool f0 = (j0 == 0) || (j0 == blk_t) || (j0 == blk_t - 1), f1 = (j1 == blk_t) || (j1 == blk_t - 1);
            unsigned k0 = f0 ? (0xFFFFFF80u | (unsigned)(127 - j0)) : (j0 <= blk_t ? ((v0 << 7) | (unsigned)(127 - j0)) : 0u);
            unsigned k1 = f1 ? (0xFFFFFF80u | (unsigned)(127 - j1)) : (j1 <= blk_t ? ((v1 << 7) | (unsigned)(127 - j1)) : 0u);
            unsigned thr = 0u;
#pragma unroll 1
            for (int bit = 31; bit >= 0; --bit) {
                const unsigned cand = thr | (1u << bit);
                const int c = __popcll(__ballot(k0 >= cand)) + __popcll(__ballot(k1 >= cand));
                thr = (c >= 16) ? cand : thr;
            }
            thr = thr ? thr : 1u;
            const unsigned long long b0 = __ballot(k0 >= thr), b1 = __ballot(k1 >= thr);
            const unsigned m0 = (unsigned)b0, m1 = (unsigned)(b0 >> 32), m2 = (unsigned)b1, m3 = (unsigned)(b1 >> 32);
            if (lane == 0) { sel[tok * 4 + 0] = m0; sel[tok * 4 + 1] = m1; sel[tok * 4 + 2] = m2; sel[tok * 4 + 3] = m3; }
            u0 |= m0; u1 |= m1; u2 |= m2; u3 |= m3;
        }
        if (lane == 0) { un[wid * 4 + 0] = u0; un[wid * 4 + 1] = u1; un[wid * 4 + 2] = u2; un[wid * 4 + 3] = u3; }
    }
    __syncthreads();
    {
        unsigned uw[4];
#pragma unroll
        for (int k = 0; k < 4; ++k) uw[k] = (unsigned)__builtin_amdgcn_readfirstlane((int)(un[k] | un[4 + k] | un[8 + k] | un[12 + k]));
        if (tid < 128) {
            const int k = tid >> 5, jb = tid & 31;
            unsigned wv = 0u; int below = 0;
#pragma unroll
            for (int kk = 0; kk < 4; ++kk) { if (kk == k) wv = uw[kk]; if (kk < k) below += __popc(uw[kk]); }
            if ((wv >> jb) & 1u) blist[below + __popc(wv & ((1u << jb) - 1u))] = (unsigned short)tid;
        }
        const int nb = __popc(uw[0]) + __popc(uw[1]) + __popc(uw[2]) + __popc(uw[3]);
        unsigned sq[4];
#pragma unroll
        for (int k = 0; k < 4; ++k) sq[k] = sel[q * 4 + k];
        __syncthreads();
        const bf16_t* ksb = pb + 768 + kvh * 64;
        auto ssrc = [&](int pos0, int colo) { return [=](int row, int gcx) { return ksb + (size_t)(pos0 + row) * 2840 + colo + gcx * 8; }; };
        float lsum = 0.f;
        att_stage<8>(kb, ssrc(64 * (int)blist[0], 0), rc, wid);
        for (int i = 0; i < nb; ++i) {
            const int j = __builtin_amdgcn_readfirstlane((int)blist[i]), pos0 = 64 * j;
            asm volatile("s_waitcnt vmcnt(0)" ::: "memory"); ATT_BAR();
            att_stage<8>(vb, ssrc(pos0, 128), rc, wid);
            unsigned sw = 0u;
#pragma unroll
            for (int k = 0; k < 4; ++k) if ((j >> 5) == k) sw = sq[k];
            const bool selq = (sw >> (j & 31)) & 1u;
            {
                int dq = t0 + q - pos0 - 4 * hh; dq = dq > 1087 ? 1087 : dq; dq = (dq < -1 || !selq) ? -1 : dq;
                att_qk<4, 128, 1, true, false>(kb, L, qf, pf, lsum, c1, 0.f, gtab + (unsigned)(dq + 1) * 4u, 0, nullptr, 0.f);
            }
            asm volatile("s_waitcnt vmcnt(0) lgkmcnt(0)" ::: "memory"); ATT_BAR();
            if (i + 1 < nb) att_stage<8>(kb, ssrc(64 * (int)blist[i + 1], 0), rc, wid);
            att_pv<2, 128>(vb, L, pf, o);
        }
        const float ls = lsum + __shfl_xor(lsum, 32);
        const float sc = gs / ls;
#pragma unroll
        for (int dt = 0; dt < 2; ++dt)
#pragma unroll
            for (int r = 0; r < 16; ++r) { of[dt][r] += o[dt][r] * sc; o[dt][r] = 0.f; }
    }
    {
        const bf16_t* kwb = pb + 1024 + kvh * 64;
        auto wsrc = [&](int pos0, int colo) { return [=](int row, int gcx) { const int pos = pos0 + row; return (pos >= 0 && pos < SEQ) ? kwb + (size_t)pos * 2840 + colo + gcx * 8 : zr + gcx * 8; }; };
        float lsum = 0.f;
        asm volatile("s_waitcnt lgkmcnt(0)" ::: "memory"); ATT_BAR();
        att_stage<8>(kb, wsrc(t0 - 512, 0), rc, wid);
        for (int i = 0; i < 9; ++i) {
            const int pos0 = t0 - 512 + 64 * i;
            asm volatile("s_waitcnt vmcnt(0)" ::: "memory"); ATT_BAR();
            att_stage<8>(vb, wsrc(pos0, 128), rc, wid);
            int dq = t0 + q - pos0 - 4 * hh; dq = dq < -1 ? -1 : dq;
            att_qk<4, 128, 1, true, false>(kb, L, qf, pf, lsum, c1, 0.f, wtab + (unsigned)(dq + 1) * 4u, 0, nullptr, 0.f);
            asm volatile("s_waitcnt vmcnt(0) lgkmcnt(0)" ::: "memory"); ATT_BAR();
            if (i + 1 < 9) att_stage<8>(kb, wsrc(pos0 + 64, 0), rc, wid);
            att_pv<2, 128>(vb, L, pf, o);
        }
        const float lw = lsum + __shfl_xor(lsum, 32);
        const float sc = gw / lw;
#pragma unroll
        for (int dt = 0; dt < 2; ++dt)
#pragma unroll
            for (int r = 0; r < 16; ++r) of[dt][r] += o[dt][r] * sc;
    }
    bf16_t* op = p.o + rowq * DM + head * 64 + 4 * hh;
    ATT_STORE_O(op, of, 1.0f);
}

__device__ __forceinline__ void moba_item(const P& p, const int item, LDSP char* lds, const int tid0) {
    LDSP char* kb = lds; LDSP char* vb = lds + 8192;
    LDSP float* glut = (LDSP float*)(lds + A0_GLUT); LDSP char* kmt = lds + A0_IMP;
    LDSP unsigned* un = (LDSP unsigned*)(lds + A0_UN); LDSP unsigned short* blist = (LDSP unsigned short*)(lds + A0_LIST);
    const float c1 = 0.125f * LOG2E;
    int tid = tid0; asm volatile("" : "+v"(tid));
    const int wid = tid >> 6, lane = tid & 63, q = lane & 31, hh = lane >> 5;
    const int tile = 63 - (item >> 4), b = (item >> 3) & 1, h = item & 7, t0 = tile * 128, own = t0 >> 8, tw = t0 + wid * 32;
    build_lut(glut, p.blut + h * 1024, 1152, 1 << 30, tid);
    if (tid == 0) un[0] = 0u;
    AttLane L; att_lane_init<128, 128, 2>(L, lane);
    int rc[1]; att_stage_map<8>(rc, tid);
    const size_t rowq = (size_t)(b * SEQ + tw + q);
    bf16x8 qf[4];
    {
        const bf16_t* qp = p.proj + rowq * 2840 + 1304 + h * 64 + 8 * hh;
#pragma unroll
        for (int ks = 0; ks < 4; ++ks) qf[ks] = *(const bf16x8*)(qp + 16 * ks);
    }
    const bf16_t* zr = p.zrow;
    unsigned selm = 0u;
    if (own > 0) {
        const bf16_t* kmb = p.kmeanb + (size_t)((b * 8 + h) * 32) * 64;
        att_stage<8>(kmt, [=](int row, int gcx) { return row < 32 ? kmb + (size_t)row * 64 + gcx * 8 : zr + gcx * 8; }, rc, wid);
        asm volatile("s_waitcnt vmcnt(0)" ::: "memory"); ATT_BAR();
        f32x16 s;
#pragma unroll
        for (int r = 0; r < 16; ++r) s[r] = 0.f;
#pragma unroll
        for (int ks = 0; ks < 4; ++ks) {
            const bf16x8 a = *(const LDSP bf16x8*)(kmt + (L.kbase ^ (32 * (ks & 3))));
            s = __builtin_amdgcn_mfma_f32_32x32x16_bf16(a, qf[ks], s, 0, 0, 0);
        }
        unsigned key[16];
#pragma unroll
        for (int r = 0; r < 16; ++r) {
            const int j = (r & 3) + 8 * (r >> 2) + 4 * hh;
            const unsigned bits = __float_as_uint(s[r]);
            const unsigned srt = (bits & 0x80000000u) ? ~bits : (bits | 0x80000000u);
            key[r] = (j < own) ? ((srt & ~31u) | (unsigned)(31 - j)) : 0u;
        }
#pragma unroll 1
        for (int rnd = 0; rnd < 3; ++rnd) {
            unsigned m = 0u;
#pragma unroll
            for (int r = 0; r < 16; ++r) m = key[r] > m ? key[r] : m;
            const unsigned mo = (unsigned)__shfl_xor((int)m, 32);
            const unsigned wk = mo > m ? mo : m;
            if (wk != 0u) selm |= 1u << (31 - (wk & 31u));
#pragma unroll
            for (int r = 0; r < 16; ++r) key[r] = (key[r] == wk) ? 0u : key[r];
        }
        (void)__hip_atomic_fetch_or(un, selm, __ATOMIC_RELAXED, __HIP_MEMORY_SCOPE_WORKGROUP);
    }
    __syncthreads();
    const unsigned uni = (unsigned)__builtin_amdgcn_readfirstlane((int)un[0]);
    const int cmax = ((t0 + 127) >> 6) & 3;
    const int nsel = 4 * __popc(uni), nb = nsel + cmax + 1;
    if (tid < 128) {
        const int jb = tid >> 2, c = tid & 3;
        if ((uni >> jb) & 1u) blist[4 * __popc(uni & ((1u << jb) - 1u)) + c] = (unsigned short)(4 * jb + c);
    }
    if (tid >= 128 && tid - 128 <= cmax) blist[nsel + tid - 128] = (unsigned short)(4 * own + tid - 128);
    __syncthreads();
    const unsigned gtab = (unsigned)(size_t)glut;
    const bf16_t* kbb = p.proj + (size_t)b * SEQ * 2840 + 1816 + h * 64;
    auto msrc = [&](int pos0, int colo) { return [=](int row, int gcx) { return kbb + (size_t)(pos0 + row) * 2840 + colo + gcx * 8; }; };
    f32x16 o[2];
#pragma unroll
    for (int dt = 0; dt < 2; ++dt)
#pragma unroll
        for (int r = 0; r < 16; ++r) o[dt][r] = 0.f;
    float lsum = 0.f;
    bf16x8 pf[4];
    att_stage<8>(kb, msrc(64 * (int)blist[0], 0), rc, wid);
    for (int i = 0; i < nb; ++i) {
        const int tl = __builtin_amdgcn_readfirstlane((int)blist[i]), pos0 = 64 * tl, j = tl >> 2;
        asm volatile("s_waitcnt vmcnt(0)" ::: "memory"); ATT_BAR();
        att_stage<8>(vb, msrc(pos0, 512), rc, wid);
        const bool ownblk = (j == own);
        const bool active = !ownblk || (pos0 <= tw + 31);
        if (active) {
            const bool selq = ownblk || ((selm >> j) & 1u);
            {
                int dq = tw + q - pos0 - 4 * hh; dq = dq > 1087 ? 1087 : dq; dq = (dq < -1 || !selq) ? -1 : dq;
                att_qk<4, 128, 1, true, false>(kb, L, qf, pf, lsum, c1, 0.f, gtab + (unsigned)(dq + 1) * 4u, 0, nullptr, 0.f);
            }
        }
        asm volatile("s_waitcnt vmcnt(0) lgkmcnt(0)" ::: "memory"); ATT_BAR();
        if (i + 1 < nb) att_stage<8>(kb, msrc(64 * (int)blist[i + 1], 0), rc, wid);
        if (active) att_pv<2, 128>(vb, L, pf, o);
    }
    const float lt = lsum + __shfl_xor(lsum, 32);
    const float inv = 1.0f / lt;
    bf16_t* op = p.o + rowq * DM + 512 + h * 64 + 4 * hh;
    ATT_STORE_O(op, o, inv);
}
__device__ __forceinline__ void st_attn0(const P& p, LDSP char* lds) {
    const int tid0 = otid();
    LDSP int* slot = (LDSP int*)(lds + A0_SLOT);
    for (;;) {
        const int item = wq_next(p.wq + 1, slot, tid0);
        if (item >= 2048) break;
        if (item & 1) moba_item(p, item >> 1, lds, tid0); else nsa_item(p, item >> 1, lds, tid0);
    }
}

#define XB_TMO      128
#define XB_XCNT(j)  (256  + 64 * (j))
#define XB_XSUB(j)  (1280 + 64 * (j))
#define XB_XGEN(j)  (2304 + 64 * (j))
#define XB_TOP      3328
#define XB_TOPGEN   3392
#define XCD_BAR_WORDS 3456
#define XB_SPIN_CAP (1u << 20)
#define LAS __attribute__((address_space(3)))

__device__ __forceinline__ unsigned xb_ld(unsigned* p)              { return __hip_atomic_load(p, __ATOMIC_RELAXED, __HIP_MEMORY_SCOPE_AGENT); }
__device__ __forceinline__ unsigned xb_add(unsigned* p, unsigned v) { return __hip_atomic_fetch_add(p, v, __ATOMIC_RELAXED, __HIP_MEMORY_SCOPE_AGENT); }
__device__ __forceinline__ unsigned xb_xcc_id() { return (unsigned)__builtin_amdgcn_s_getreg((3 << 11) | 20) & 0xFu; }
#define XB_SPIN(cond, bar) do { unsigned _sp = 0; while (cond) { __builtin_amdgcn_s_sleep(1); \
    if ((++_sp & 255u) == 0u) { if (xb_ld(&(bar)[XB_TMO])) break; if (_sp > XB_SPIN_CAP) { atomicAdd(&(bar)[XB_TMO], 1u); break; } } } } while (0)

struct XcdBarrier {
    unsigned* bar; unsigned x;
    volatile LAS unsigned* st;
};

__device__ __forceinline__ XcdBarrier xcd_barrier_post(unsigned* bar, volatile LAS unsigned* st) {
    XcdBarrier b; b.bar = bar; b.x = xb_xcc_id(); b.st = st;
    if (threadIdx.x == 0) (void)xb_add(&bar[XB_XCNT(b.x)], 1u);
    return b;
}
__device__ __forceinline__ void xcd_barrier_complete(unsigned* bar, unsigned x, unsigned& nloc, unsigned& nx) {
    const unsigned G = gridDim.x * gridDim.y * gridDim.z;
    unsigned sum, cnt, mine, sp = 0u;
    for (;;) {
        sum = 0u; cnt = 0u; mine = 0u;
#pragma unroll
        for (unsigned j = 0; j < 16; ++j) { const unsigned c = xb_ld(&bar[XB_XCNT(j)]); sum += c; cnt += (c > 0u) ? 1u : 0u; mine = (j == x) ? c : mine; }
        if (sum == G) break;
        __builtin_amdgcn_s_sleep(1);
        if ((++sp & 255u) == 0u) { if (xb_ld(&bar[XB_TMO])) break; if (sp > XB_SPIN_CAP) { atomicAdd(&bar[XB_TMO], 1u); break; } }
    }
    nloc = mine > 0u ? mine : 1u; nx = cnt > 0u ? cnt : 1u;
}

__device__ __forceinline__ void xcd_barrier(const XcdBarrier& b) {
    asm volatile("s_waitcnt vmcnt(0)" ::: "memory");
    __syncthreads();
    if (threadIdx.x == 0) {
        unsigned* bar = b.bar;
        __builtin_amdgcn_s_waitcnt(0);
        unsigned nloc = b.st[0], nx = b.st[1];
        if (nloc == 0u) { xcd_barrier_complete(bar, b.x, nloc, nx); b.st[0] = nloc; b.st[1] = nx; }
        const unsigned old = xb_add(&bar[XB_XSUB(b.x)], 1u);
        const unsigned gen = old / nloc;
        if (old + 1u == (gen + 1u) * nloc) {
            __builtin_amdgcn_fence(__ATOMIC_RELEASE, "agent");
            asm volatile("s_waitcnt vmcnt(0)" ::: "memory");
            const unsigned og = xb_add(&bar[XB_TOP], 1u);
            const unsigned tg = og / nx;
            if (og + 1u == (tg + 1u) * nx) xb_add(&bar[XB_TOPGEN], 1u);
            else XB_SPIN(xb_ld(&bar[XB_TOPGEN]) == tg, bar);
            __builtin_amdgcn_fence(__ATOMIC_ACQUIRE, "agent");
            xb_add(&bar[XB_XGEN(b.x)], 1u);
            asm volatile("s_waitcnt vmcnt(0)" ::: "memory");
        } else {
            XB_SPIN(xb_ld(&bar[XB_XGEN(b.x)]) == gen, bar);
            __builtin_amdgcn_fence(__ATOMIC_ACQUIRE, "agent");
            asm volatile("s_waitcnt vmcnt(0)" ::: "memory");
        }
    }
    __syncthreads();
}


#define PHASE_SYNC() do { PP qb_ = (PP)__builtin_amdgcn_kernarg_segment_ptr(); asm volatile("" : "+s"(qb_)); XcdBarrier b_; b_.bar = qb_->bar; b_.x = xb_xcc_id(); \
        b_.st = (volatile LAS unsigned*)(dlds + GEMM_LDS_BYTES); xcd_barrier(b_); } while (0)
typedef const __attribute__((address_space(4))) P* PP;
#define PHASE_ARGS() PP q_ = (PP)__builtin_amdgcn_kernarg_segment_ptr(); int wg = blockIdx.x, nwg = gridDim.x; asm volatile("" : "+s"(q_), "+s"(wg), "+s"(nwg)); P p; { const __attribute__((address_space(4))) unsigned long long* s64_ = (const __attribute__((address_space(4))) unsigned long long*)q_; unsigned long long* d64_ = (unsigned long long*)&p; _Pragma("unroll") for (int i_ = 0; i_ < (int)(sizeof(P) / 8); ++i_) d64_[i_] = s64_[i_]; } float* sm = (float*)dlds; LDSP char* lds = (LDSP char*)dlds; (void)sm; (void)lds
#define KERNEL_LDS_BYTES (GEMM_LDS_BYTES + 64)
__global__ void __launch_bounds__(256, 2) k_mega(P pk) {
    extern __shared__ __attribute__((aligned(16))) unsigned char dlds[];
    if (threadIdx.x == 0) *(uint4*)(dlds + GEMM_LDS_BYTES) = make_uint4(0u, 0u, 0u, 0u);
    __syncthreads();
    (void)xcd_barrier_post(pk.bar, (volatile LAS unsigned*)(dlds + GEMM_LDS_BYTES));
    { PHASE_ARGS(); st_prologue(p, wg, nwg, sm); st_convert(p, wg, nwg, sm); } PHASE_SYNC();
    { PHASE_ARGS(); st_norm<0>(p, 0, wg, nwg, sm); } PHASE_SYNC();
    { PHASE_ARGS(); st_inproj0_mf(p, wg, nwg, lds); } PHASE_SYNC();
    { PHASE_ARGS(); st_cmp1_mf(p, wg, nwg, lds); st_kmean(p, wg, nwg); } PHASE_SYNC();
    { PHASE_ARGS(); st_cmp2_mf(p, wg, nwg, lds); } PHASE_SYNC();
    { PHASE_ARGS(); st_attn0(p, lds); } PHASE_SYNC();
    { PHASE_ARGS(); st_outproj_mf(p, 0, wg, nwg, lds); } PHASE_SYNC();
    { PHASE_ARGS(); st_norm<1>(p, 0, wg, nwg, sm); } PHASE_SYNC();
    { PHASE_ARGS(); st_moe_up_mf(p, 0, wg, nwg, lds); } PHASE_SYNC();
    { PHASE_ARGS(); st_moe_down_mf(p, 0, wg, nwg, lds); } PHASE_SYNC();
    { PHASE_ARGS(); st_norm<2>(p, 1, wg, nwg, sm); } PHASE_SYNC();
    { PHASE_ARGS(); st_inproj1_mf(p, wg, nwg, lds); } PHASE_SYNC();
    { PHASE_ARGS(); st_mla_prep(p, wg, nwg); } PHASE_SYNC();
    { PHASE_ARGS(); st_mla_up_mf(p, wg, nwg, lds); } PHASE_SYNC();
    { PHASE_ARGS(); st_attn1(p, lds); } PHASE_SYNC();
    { PHASE_ARGS(); st_mla_combine(p, wg, nwg); } PHASE_SYNC();
    { PHASE_ARGS(); st_outproj_mf(p, 1, wg, nwg, lds); } PHASE_SYNC();
    { PHASE_ARGS(); st_norm<1>(p, 1, wg, nwg, sm); } PHASE_SYNC();
    { PHASE_ARGS(); st_moe_up_mf(p, 1, wg, nwg, lds); } PHASE_SYNC();
    { PHASE_ARGS(); st_moe_down_mf(p, 1, wg, nwg, lds); } PHASE_SYNC();
    { PHASE_ARGS(); st_norm<3>(p, 1, wg, nwg, sm); }
}

extern "C" void kernel_launch(void* const* d_in, const int* in_sizes, int n_in, void* d_out, int out_size, void* d_ws, size_t ws_size,
                              hipStream_t stream) {
    (void)in_sizes; (void)n_in; (void)out_size; (void)ws_size;
    P p{};
    const float* const* in = (const float* const*)d_in;
    p.x = in[0]; p.c = in[1]; p.rel = in[2]; p.router_w = in[3]; p.router_b = in[4]; p.final_norm = in[5]; p.norm_mix = in[6]; p.norm_ffn = in[7];
    p.ada_w = in[8]; p.ada_b = in[9]; p.moe_wg = in[10]; p.moe_wu = in[11]; p.moe_wd = in[12]; p.ev_w_in = in[13]; p.ev_w_out = in[14];
    p.pos_k = in[15]; p.pos_v = in[16]; p.ck_w1 = in[17]; p.ck_w2 = in[18]; p.cv_w1 = in[19]; p.cv_w2 = in[20]; p.od_w_in = in[21]; p.od_w_out = in[22];
    p.q_norm = in[23]; p.kv_norm = in[24]; p.w_q_up = in[25]; p.w_kv_up = in[26]; p.sinks = in[27];
    p.out = (float*)d_out;
    char* ws = (char*)d_ws; size_t off = 0;
    auto take = [&](size_t bytes) { char* r = ws + off; off += (bytes + 255) & ~(size_t)255; return r; };
    p.bar = (unsigned*)take(16384);
    p.cnt = (int*)take(4096);
    p.wq = (int*)take(256);
    p.modv = (float*)take(2 * 2 * 6144 * 4);
    p.zrow = (bf16_t*)take(256);
    const size_t zero_bytes = off;
    p.ropec = (float*)take(SEQ * 32 * 4); p.ropes = (float*)take(SEQ * 32 * 4);
    p.blut = (float*)take(8 * 1024 * 4);
    p.gates = (float*)take((size_t)T_TOK * 24 * 4);
    p.kcmp = (float*)take(2044 * 64 * 4); p.vcmp = (float*)take(2044 * 64 * 4);
    p.chid = (float*)take((size_t)2 * 2044 * 256 * 4);
    p.kmean = (float*)take(2 * 8 * 32 * 64 * 4);
    p.tokw = (float*)take((size_t)T_TOK * 2 * 4);
    p.list = (int*)take((size_t)16 * T_TOK * 4);
    p.cqn = (bf16_t*)take((size_t)T_TOK * 384 * 2);
    p.krope = (bf16_t*)take((size_t)T_TOK * 64 * 2);
    p.h = (bf16_t*)take((size_t)T_TOK * DM * 2);
    p.o = (bf16_t*)take((size_t)T_TOK * DM * 2);
    p.mlap = p.h;
    p.mlal = (float*)(p.h + (size_t)2 * 8 * (SEQ / 2) * 128);
    p.hid = p.o;
    char* region = take((size_t)100 * 1024 * 1024);
    p.proj = (bf16_t*)region;
    p.proj1 = (bf16_t*)region;
    p.qmla = (bf16_t*)(region + (size_t)T_TOK * 1216 * 2);
    p.kvmla = (bf16_t*)(region + (size_t)T_TOK * (1216 + 768) * 2);
    p.y = (bf16_t*)region;
    p.chidb = (bf16_t*)take((size_t)2 * 2048 * 256 * 2);
    p.kcmpb = (bf16_t*)take((size_t)8 * 512 * 64 * 2);
    p.kmeanb = (bf16_t*)take((size_t)2 * 8 * 32 * 64 * 2);
    p.c1 = (float*)take(512 * 4);
    p.wt_gu = (bf16_t*)take((size_t)32 * 1024 * 1024 * 2);
    p.wt_d = (bf16_t*)take((size_t)32 * 1024 * 512 * 2);
    p.wt_in0 = (bf16_t*)take((size_t)2840 * 1024 * 2);
    p.wt_out0 = (bf16_t*)take((size_t)1024 * 1024 * 2);
    p.wt_c1 = (bf16_t*)take((size_t)2 * 256 * 2048 * 2);
    p.wt_c2 = (bf16_t*)take((size_t)2 * 64 * 256 * 2);
    p.wt_in1 = (bf16_t*)take((size_t)1216 * 1024 * 2);
    p.wt_out1 = (bf16_t*)take((size_t)1024 * 1024 * 2);
    p.wt_qup = (bf16_t*)take((size_t)768 * 256 * 2);
    p.wt_kvup = (bf16_t*)take((size_t)1024 * 128 * 2);
    static int grid = 0;
    if (!grid) {
        int dev = 0, cus = 0, per_cu = 0;
        (void)hipGetDevice(&dev);
        (void)hipDeviceGetAttribute(&cus, hipDeviceAttributeMultiprocessorCount, dev);
        (void)hipFuncSetAttribute((const void*)k_mega, hipFuncAttributeMaxDynamicSharedMemorySize, KERNEL_LDS_BYTES);
        (void)hipOccupancyMaxActiveBlocksPerMultiprocessor(&per_cu, k_mega, 256, KERNEL_LDS_BYTES);
        if (cus <= 0) cus = 256;
        if (per_cu < 1) per_cu = 1;
        grid = cus * (per_cu < 2 ? per_cu : 2);
    }
    (void)hipMemsetAsync(d_ws, 0, zero_bytes, stream);
    hipLaunchKernelGGL(k_mega, dim3(grid), dim3(256), KERNEL_LDS_BYTES, stream, p);
}
```

```cpp
#include <hip/hip_runtime.h>
#include <stdint.h>

#define T_TOK 16384
#define SEQ 8192
#define DM 1024
#define NEGF (-1e30f)
#define BIGF (1e30f)

typedef unsigned short bf16_t;

__device__ __forceinline__ float bf2f(bf16_t v) { return __uint_as_float(((unsigned)v) << 16); }
__device__ __forceinline__ bf16_t f2bf(float f) {
    unsigned u = __float_as_uint(f);
    u += 0x7fffu + ((u >> 16) & 1u);
    return (bf16_t)(u >> 16);
}
__device__ __forceinline__ unsigned cvtpk(float lo, float hi) { unsigned r; asm("v_cvt_pk_bf16_f32 %0, %1, %2" : "=v"(r) : "v"(lo), "v"(hi)); return r; }
__device__ __forceinline__ float wsum(float v) {
#pragma unroll
    for (int o = 32; o > 0; o >>= 1) v += __shfl_xor(v, o);
    return v;
}
__device__ __forceinline__ float siluf(float v) { return v / (1.0f + __expf(-v)); }
__device__ __forceinline__ float sigmf(float v) { return 1.0f / (1.0f + __expf(-v)); }
__device__ __forceinline__ float gelu_tanh(float x) {
    const float k0 = 0.7978845608028654f, k1 = 0.044715f;
    float u = k0 * (x + k1 * x * x * x);
    return 0.5f * x * (1.0f + tanhf(u));
}
__device__ __forceinline__ int rel_bucket(int d) {
    if (d < 16) return d < 0 ? 0 : d;
    int b = 16;
    b += (d >= 21); b += (d >= 27); b += (d >= 35); b += (d >= 46); b += (d >= 59); b += (d >= 77); b += (d >= 99); b += (d >= 128);
    b += (d >= 166); b += (d >= 216); b += (d >= 280); b += (d >= 363); b += (d >= 470); b += (d >= 609); b += (d >= 790);
    return b;
}

__device__ __forceinline__ int otid() { int t = threadIdx.x; asm volatile("" : "+v"(t)); return t; }

struct P {
    const float *x, *c, *rel, *router_w, *router_b, *final_norm, *norm_mix, *norm_ffn, *ada_w, *ada_b, *moe_wg, *moe_wu, *moe_wd,
        *ev_w_in, *ev_w_out, *pos_k, *pos_v, *ck_w1, *ck_w2, *cv_w1, *cv_w2, *od_w_in, *od_w_out, *q_norm, *kv_norm, *w_q_up, *w_kv_up, *sinks;
    float* out;
    unsigned* bar; int* cnt;
    float *modv, *ropec, *ropes, *blut, *gates, *kcmp, *vcmp, *chid, *kmean, *tokw;
    bf16_t *h, *proj, *o, *hid, *y, *proj1, *qmla, *kvmla, *krope, *cqn;
    int* list;
    bf16_t *wt_gu, *wt_d, *wt_in0, *wt_out0, *wt_c1, *wt_c2, *wt_in1, *wt_out1, *wt_qup, *wt_kvup, *chidb;
    float* c1;
    int* wq;
    bf16_t* zrow;
    bf16_t *kcmpb, *kmeanb, *mlap;
    float* mlal;
    int* mcnt; unsigned short* mlist; bf16_t *mp01, *mp2; float* mpl;
};


__device__ __forceinline__ void st_prologue(const P& p, int wg, int nwg, float* sm) {
    const int TIDX = otid();
    const int tid = TIDX;
    {
        for (int i = tid; i < 2048; i += 256) sm[i] = siluf(p.c[i]);
        __syncthreads();
        const int wid = tid >> 6, lane = tid & 63;
        for (int w = wg; w < 192; w += nwg) {
            const int l = w / 96, cg = w % 96, col = cg * 64 + lane;
            const float* W = p.ada_w + (size_t)l * 1024 * 6144 + (size_t)(wid * 256) * 6144 + col;
            float a0 = 0.f, a1 = 0.f;
#pragma unroll 32
            for (int k = 0; k < 256; ++k) { const float wv = W[(size_t)k * 6144]; a0 += sm[wid * 256 + k] * wv; a1 += sm[1024 + wid * 256 + k] * wv; }
            sm[2048 + tid] = a0; sm[2304 + tid] = a1;
            __syncthreads();
            if (tid < 64) {
                const float bb = p.ada_b[l * 6144 + col];
                p.modv[(l * 2 + 0) * 6144 + col] = ((sm[2048 + tid] + sm[2048 + 64 + tid]) + (sm[2048 + 128 + tid] + sm[2048 + 192 + tid])) + bb;
                p.modv[(l * 2 + 1) * 6144 + col] = ((sm[2304 + tid] + sm[2304 + 64 + tid]) + (sm[2304 + 128 + tid] + sm[2304 + 192 + tid])) + bb;
            }
            __syncthreads();
        }
        __syncthreads();
    }
    for (int i = wg * 256 + tid; i < SEQ * 32; i += nwg * 256) {
        const int t = i >> 5, j = i & 31;
        const float inv = powf(10000.0f, -(float)(2 * j) / 64.0f);
        const float ang = (float)t * inv;
        p.ropec[i] = cosf(ang); p.ropes[i] = sinf(ang);
    }
    for (int i = wg * 256 + tid; i < 8 * 1024; i += nwg * 256) { const int h = i >> 10, d = i & 1023; p.blut[i] = p.rel[rel_bucket(d) * 8 + h]; }
}

template <int MODE>
__device__ __forceinline__ void st_norm(const P& p, int layer, int wg, int nwg, float* sm) {
    const int TIDX = otid();
    const int wid = TIDX >> 6, lane = TIDX & 63;
    int* rl_cnt = (int*)sm; int* rl_base = rl_cnt + 16; int* rl_ent = rl_cnt + 32;
    if (MODE == 1) { if (TIDX < 16) rl_cnt[TIDX] = 0; for (int i = TIDX; i < 64; i += 256) rl_ent[i] = -1; __syncthreads(); }
    const int niter = (T_TOK + nwg * 4 - 1) / (nwg * 4);
    for (int it = 0; it < niter; ++it) {
        const int row = wg * 4 + wid + it * nwg * 4;
        if (MODE != 1 && row >= T_TOK) break;
        if (MODE != 1 || row < T_TOK) {
        const int b = row >> 13;
        float v[16];
        const float* xin = (MODE == 0) ? p.x : p.out;
#pragma unroll
        for (int i = 0; i < 4; ++i) {
            const float4 t4 = *(const float4*)(xin + (size_t)row * DM + i * 256 + lane * 4);
            v[i * 4 + 0] = t4.x; v[i * 4 + 1] = t4.y; v[i * 4 + 2] = t4.z; v[i * 4 + 3] = t4.w;
        }
        if (MODE >= 2) {
            const int lp = (MODE == 2) ? layer - 1 : 1;
            const float* gf = p.modv + (size_t)(lp * 2 + b) * 6144 + 5 * 1024;
#pragma unroll
            for (int i = 0; i < 4; ++i)
#pragma unroll
                for (int j = 0; j < 4; ++j) {
                    const int col = i * 256 + lane * 4 + j;
                    const float y0 = bf2f(p.y[(size_t)(2 * row) * DM + col]), y1 = bf2f(p.y[(size_t)(2 * row + 1) * DM + col]);
                    v[i * 4 + j] += gf[col] * (y0 + y1);
                }
            if (MODE == 2) {
#pragma unroll
                for (int i = 0; i < 4; ++i)
                    *(float4*)(p.out + (size_t)row * DM + i * 256 + lane * 4) = make_float4(v[i * 4], v[i * 4 + 1], v[i * 4 + 2], v[i * 4 + 3]);
            }
        }
        float ss = 0.f;
#pragma unroll
        for (int i = 0; i < 16; ++i) ss += v[i] * v[i];
        ss = wsum(ss);
        const float r = rsqrtf(ss * (1.0f / 1024.0f) + 1e-6f);
        if (MODE == 3) {
#pragma unroll
            for (int i = 0; i < 4; ++i) {
                const float4 g4 = *(const float4*)(p.final_norm + i * 256 + lane * 4);
                *(float4*)(p.out + (size_t)row * DM + i * 256 + lane * 4) =
                    make_float4(v[i * 4] * r * g4.x, v[i * 4 + 1] * r * g4.y, v[i * 4 + 2] * r * g4.z, v[i * 4 + 3] * r * g4.w);
            }
            continue;
        }
        const float* g = ((MODE == 1) ? p.norm_ffn : p.norm_mix) + layer * 1024;
        const float* mv = p.modv + (size_t)(layer * 2 + b) * 6144;
        const float* shift = mv + ((MODE == 1) ? 3 : 0) * 1024;
        const float* scale = mv + ((MODE == 1) ? 4 : 1) * 1024;
        float hv[16];
#pragma unroll
        for (int i = 0; i < 4; ++i)
#pragma unroll
            for (int j = 0; j < 4; ++j) {
                const int col = i * 256 + lane * 4 + j;
                hv[i * 4 + j] = v[i * 4 + j] * r * g[col] * (1.0f + scale[col]) + shift[col];
                p.h[(size_t)row * DM + col] = f2bf(hv[i * 4 + j]);
            }
        if (MODE == 1) {
            float lg[16];
#pragma unroll
            for (int e = 0; e < 16; ++e) lg[e] = 0.f;
#pragma unroll
            for (int i = 0; i < 4; ++i)
#pragma unroll
                for (int j = 0; j < 4; ++j) {
                    const int col = i * 256 + lane * 4 + j;
                    const float* rw = p.router_w + col * 16;
#pragma unroll
                    for (int e = 0; e < 16; ++e) lg[e] += hv[i * 4 + j] * rw[e];
                    asm volatile("" ::: "memory");
                }
#pragma unroll
            for (int e = 0; e < 16; ++e) lg[e] = wsum(lg[e]);
            float aff[16], bi[16];
#pragma unroll
            for (int e = 0; e < 16; ++e) { aff[e] = 1.0f / (1.0f + expf(-lg[e])); bi[e] = aff[e] + p.router_b[e]; }
            float bestsc = -3e38f; int be0 = 0, be1 = 1; float bw0 = 0.f, bw1 = 0.f;
#pragma unroll
            for (int gI = 0; gI < 4; ++gI) {
                int i1 = 0; float m1 = bi[gI * 4];
#pragma unroll
                for (int i = 1; i < 4; ++i) if (bi[gI * 4 + i] > m1) { m1 = bi[gI * 4 + i]; i1 = i; }
                int i2 = -1; float m2 = -3e38f;
#pragma unroll
                for (int i = 0; i < 4; ++i) if (i != i1 && bi[gI * 4 + i] > m2) { m2 = bi[gI * 4 + i]; i2 = i; }
                const float sc = m1 + m2;
                float a1 = 0.f, a2 = 0.f;
#pragma unroll
                for (int i = 0; i < 4; ++i) { a1 = (i == i1) ? aff[gI * 4 + i] : a1; a2 = (i == i2) ? aff[gI * 4 + i] : a2; }
                if (sc > bestsc) { bestsc = sc; be0 = gI * 4 + i1; be1 = gI * 4 + i2; bw0 = a1; bw1 = a2; }
            }
            if (lane == 0) {
                const float ws = bw0 + bw1;
                p.tokw[row * 2] = bw0 / ws; p.tokw[row * 2 + 1] = bw1 / ws;
                const int s_ = (it & 7) * 4 + wid;
                const int r0 = atomicAdd(&rl_cnt[be0], 1), r1 = atomicAdd(&rl_cnt[be1], 1);
                rl_ent[s_ * 2] = (row << 12) | (be0 << 8) | r0;
                rl_ent[s_ * 2 + 1] = (row << 12) | (be1 << 8) | r1;
            }
        }
        }
        if (MODE == 1 && ((it & 7) == 7 || it == niter - 1)) {
            __syncthreads();
            if (TIDX < 16) { const int c = rl_cnt[TIDX]; rl_base[TIDX] = c ? atomicAdd(&p.cnt[(layer * 16 + TIDX) * 32], c) : 0; rl_cnt[TIDX] = 0; }
            __syncthreads();
            if (TIDX < 64) {
                const int en = rl_ent[TIDX];
                if (en >= 0) { const int e = (en >> 8) & 15; p.list[e * T_TOK + rl_base[e] + (en & 255)] = (en >> 12) * 2 + (TIDX & 1); rl_ent[TIDX] = -1; }
            }
            __syncthreads();
        }
    }
}

__device__ __forceinline__ void st_kmean(const P& p, int wg, int nwg) {
    const int TIDX = otid();
    const int wid = TIDX >> 6, lane = TIDX & 63;
    for (int w = wg * 4 + wid; w < 2 * 8 * 32; w += nwg * 4) {
        const int b = w >> 8, h = (w >> 5) & 7, j = w & 31;
        float s = 0.f;
        for (int i = 0; i < 256; ++i) s += bf2f(p.proj[(size_t)(b * SEQ + j * 256 + i) * 2840 + 1816 + h * 64 + lane]);
        p.kmean[(size_t)w * 64 + lane] = s * (1.0f / 256.0f);
        p.kmeanb[(size_t)w * 64 + lane] = f2bf(s * (1.0f / 256.0f));
    }
}
__device__ __forceinline__ void st_mla_prep(const P& p, int wg, int nwg) {
    const int TIDX = otid();
    const int wid = TIDX >> 6, lane = TIDX & 63;
    for (int row = wg * 4 + wid; row < T_TOK; row += nwg * 4) {
        const int t = row & (SEQ - 1);
        const bf16_t* pr = p.proj1 + (size_t)row * 1216;
        float q[4], ss = 0.f;
#pragma unroll
        for (int i = 0; i < 4; ++i) { q[i] = bf2f(pr[i * 64 + lane]); ss += q[i] * q[i]; }
        ss = wsum(ss);
        float r = rsqrtf(ss * (1.0f / 256.0f) + 1e-6f);
#pragma unroll
        for (int i = 0; i < 4; ++i) p.cqn[(size_t)row * 384 + i * 64 + lane] = f2bf(q[i] * r * p.q_norm[i * 64 + lane]);
        float kvv[2]; ss = 0.f;
#pragma unroll
        for (int i = 0; i < 2; ++i) { kvv[i] = bf2f(pr[256 + i * 64 + lane]); ss += kvv[i] * kvv[i]; }
        ss = wsum(ss);
        r = rsqrtf(ss * (1.0f / 128.0f) + 1e-6f);
#pragma unroll
        for (int i = 0; i < 2; ++i) p.cqn[(size_t)row * 384 + 256 + i * 64 + lane] = f2bf(kvv[i] * r * p.kv_norm[i * 64 + lane]);
        if (lane < 32) {
            const float x1 = bf2f(pr[384 + lane]), x2 = bf2f(pr[384 + 32 + lane]);
            const float cs = p.ropec[t * 32 + lane], sn = p.ropes[t * 32 + lane];
            p.krope[(size_t)row * 64 + lane] = f2bf(x1 * cs - x2 * sn);
            p.krope[(size_t)row * 64 + 32 + lane] = f2bf(x1 * sn + x2 * cs);
        }
    }
}


typedef short bf16x8 __attribute__((ext_vector_type(8)));
typedef float f32x4 __attribute__((ext_vector_type(4)));
typedef unsigned u32x2 __attribute__((ext_vector_type(2)));
typedef unsigned u32x4v __attribute__((ext_vector_type(4)));
#define LDSP __attribute__((address_space(3)))
#define GEMM_LDS_BYTES 65536

__device__ __forceinline__ unsigned pack_bf16(float lo, float hi) { return (unsigned)f2bf(lo) | ((unsigned)f2bf(hi) << 16); }

template <class AR, class BR, class Epi>
__device__ __forceinline__ void gemm128(const int nk, const size_t akstep, const size_t bkstep, AR arow, BR brow, Epi epi, LDSP char* lds, const int tid) {
    const int wid = tid >> 6, lane = tid & 63, wr = wid >> 1, wc = wid & 1, fr = lane & 15, fq = lane >> 4;
    const int srow = tid >> 3, gch = ((tid & 7) ^ (srow & 7)) * 8;
    const bf16_t* ap0 = arow(srow) + gch; const bf16_t* ap1 = arow(32 + srow) + gch; const bf16_t* ap2 = arow(64 + srow) + gch; const bf16_t* ap3 = arow(96 + srow) + gch;
    const bf16_t* bp0 = brow(srow) + gch; const bf16_t* bp1 = brow(32 + srow) + gch; const bf16_t* bp2 = brow(64 + srow) + gch; const bf16_t* bp3 = brow(96 + srow) + gch;
    LDSP char* lw = lds + wid * 1024;
#define G128_ISSUE(st, kt) do { LDSP char* la_ = lw + (st) * 32768; const size_t ao_ = (size_t)(kt) * akstep, bo_ = (size_t)(kt) * bkstep; \
        __builtin_amdgcn_global_load_lds((const unsigned*)(ap0 + ao_), (LDSP unsigned*)(la_), 16, 0, 0); \
        __builtin_amdgcn_global_load_lds((const unsigned*)(ap1 + ao_), (LDSP unsigned*)(la_ + 4096), 16, 0, 0); \
        __builtin_amdgcn_global_load_lds((const unsigned*)(ap2 + ao_), (LDSP unsigned*)(la_ + 8192), 16, 0, 0); \
        __builtin_amdgcn_global_load_lds((const unsigned*)(ap3 + ao_), (LDSP unsigned*)(la_ + 12288), 16, 0, 0); \
        __builtin_amdgcn_global_load_lds((const unsigned*)(bp0 + bo_), (LDSP unsigned*)(la_ + 16384), 16, 0, 0); \
        __builtin_amdgcn_global_load_lds((const unsigned*)(bp1 + bo_), (LDSP unsigned*)(la_ + 16384 + 4096), 16, 0, 0); \
        __builtin_amdgcn_global_load_lds((const unsigned*)(bp2 + bo_), (LDSP unsigned*)(la_ + 16384 + 8192), 16, 0, 0); \
        __builtin_amdgcn_global_load_lds((const unsigned*)(bp3 + bo_), (LDSP unsigned*)(la_ + 16384 + 12288), 16, 0, 0); } while (0)
    f32x4 acc[4][4];
#pragma unroll
    for (int m = 0; m < 4; ++m)
#pragma unroll
        for (int n = 0; n < 4; ++n) acc[m][n] = (f32x4){0.f, 0.f, 0.f, 0.f};
    const int aoff = (wr * 64 + fr) * 128, boff = 16384 + (wc * 64 + fr) * 128, c0 = (fq ^ (fr & 7)) * 16;
    G128_ISSUE(0, 0);
    for (int kt = 0; kt < nk; ++kt) {
        const int cur = kt & 1;
        asm volatile("s_waitcnt vmcnt(0)" ::: "memory");
        __builtin_amdgcn_s_barrier();
        asm volatile("" ::: "memory");
        if (kt + 1 < nk) G128_ISSUE(cur ^ 1, kt + 1);
        LDSP char* sb = lds + cur * 32768;
#pragma unroll
        for (int kk = 0; kk < 2; ++kk) {
            const int cc = kk ? (c0 ^ 64) : c0;
            bf16x8 af[4], bf[4];
#pragma unroll
            for (int m = 0; m < 4; ++m) af[m] = *(const LDSP bf16x8*)(sb + aoff + m * 2048 + cc);
#pragma unroll
            for (int n = 0; n < 4; ++n) bf[n] = *(const LDSP bf16x8*)(sb + boff + n * 2048 + cc);
#pragma unroll
            for (int m = 0; m < 4; ++m)
#pragma unroll
                for (int n = 0; n < 4; ++n) acc[m][n] = __builtin_amdgcn_mfma_f32_16x16x32_bf16(bf[n], af[m], acc[m][n], 0, 0, 0);
        }
    }
    asm volatile("s_waitcnt lgkmcnt(0)" ::: "memory");
    __builtin_amdgcn_s_barrier();
    asm volatile("" ::: "memory");
#undef G128_ISSUE
#pragma unroll
    for (int m = 0; m < 4; ++m) epi(wr * 64 + m * 16 + fr, wc * 64 + fq * 4, acc[m]);
}

template <int MAP> __device__ __forceinline__ int conv_rowmap(int n) {
    if (MAP == 0) return n;
    const int tile = n >> 6, cc = n & 63, wc = cc >> 5, i16 = (cc >> 4) & 1, i = cc & 15;
    return tile * 128 + wc * 64 + ((MAP == 1 ? 0 : 2) + i16) * 16 + i;
}
template <int MAP>
__device__ __forceinline__ void conv_batched(const float* src, int nmat, int K, int N, size_t sstride, bf16_t* dst, size_t dstride, int wg, int nwg, float* sm, int tid) {
    float(*t)[65] = (float(*)[65])sm;
    const int tk = K >> 6, tn = (N + 63) >> 6, per = tk * tn, total = nmat * per;
    f32x4 v[4];
    auto ld = [&](int w) {
        const int mat = w / per, r = w % per, kt = r / tn, nt = r % tn;
        const float* s = src + (size_t)mat * sstride;
#pragma unroll
        for (int i = 0; i < 4; ++i) {
            const int idx = tid + 256 * i, k = idx >> 4, n = (idx & 15) * 4;
            v[i] = (f32x4){0.f, 0.f, 0.f, 0.f};
            if (nt * 64 + n < N) v[i] = *(const f32x4*)(s + (size_t)(kt * 64 + k) * N + nt * 64 + n);
        }
    };
    if (wg < total) ld(wg);
    for (int w = wg; w < total; w += nwg) {
        const int mat = w / per, r = w % per, kt = r / tn, nt = r % tn;
        bf16_t* d = dst + (size_t)mat * dstride;
#pragma unroll
        for (int i = 0; i < 4; ++i) {
            const int idx = tid + 256 * i, k = idx >> 4, n = (idx & 15) * 4;
            t[k][n] = v[i][0]; t[k][n + 1] = v[i][1]; t[k][n + 2] = v[i][2]; t[k][n + 3] = v[i][3];
        }
        __syncthreads();
        if (w + nwg < total) ld(w + nwg);
        {
            const int n = tid >> 2, kq = (tid & 3) * 16;
            if (nt * 64 + n < N) {
                unsigned pk[8];
#pragma unroll
                for (int j = 0; j < 8; ++j) pk[j] = cvtpk(t[kq + 2 * j][n], t[kq + 2 * j + 1][n]);
                bf16_t* o = d + (size_t)conv_rowmap<MAP>(nt * 64 + n) * K + kt * 64 + kq;
                *(u32x4v*)o = (u32x4v){pk[0], pk[1], pk[2], pk[3]};
                *(u32x4v*)(o + 8) = (u32x4v){pk[4], pk[5], pk[6], pk[7]};
            }
        }
        __syncthreads();
    }
}
__device__ __forceinline__ void st_convert(const P& p, int wg, int nwg, float* sm) {
    const int tid = otid();
    conv_batched<1>(p.moe_wg, 32, 1024, 512, (size_t)1024 * 512, p.wt_gu, (size_t)1024 * 1024, wg, nwg, sm, tid);
    conv_batched<2>(p.moe_wu, 32, 1024, 512, (size_t)1024 * 512, p.wt_gu, (size_t)1024 * 1024, wg, nwg, sm, tid);
    conv_batched<0>(p.moe_wd, 32, 512, 1024, (size_t)512 * 1024, p.wt_d, (size_t)1024 * 512, wg, nwg, sm, tid);
    conv_batched<0>(p.ev_w_in, 1, 1024, 2840, 0, p.wt_in0, 0, wg, nwg, sm, tid);
    conv_batched<0>(p.ev_w_out, 1, 1024, 1024, 0, p.wt_out0, 0, wg, nwg, sm, tid);
    conv_batched<0>(p.ck_w1, 1, 2048, 256, 0, p.wt_c1, 0, wg, nwg, sm, tid);
    conv_batched<0>(p.cv_w1, 1, 2048, 256, 0, p.wt_c1 + 256 * 2048, 0, wg, nwg, sm, tid);
    conv_batched<0>(p.ck_w2, 1, 256, 64, 0, p.wt_c2, 0, wg, nwg, sm, tid);
    conv_batched<0>(p.cv_w2, 1, 256, 64, 0, p.wt_c2 + 64 * 256, 0, wg, nwg, sm, tid);
    conv_batched<0>(p.od_w_in, 1, 1024, 1216, 0, p.wt_in1, 0, wg, nwg, sm, tid);
    conv_batched<0>(p.od_w_out, 1, 1024, 1024, 0, p.wt_out1, 0, wg, nwg, sm, tid);
    conv_batched<0>(p.w_q_up, 1, 256, 768, 0, p.wt_qup, 0, wg, nwg, sm, tid);
    conv_batched<0>(p.w_kv_up, 1, 128, 1024, 0, p.wt_kvup, 0, wg, nwg, sm, tid);
    for (int w = wg; w < 8; w += nwg) {
        const int which = w >> 2, col = (w & 3) * 64 + (tid & 63), kq = tid >> 6;
        const float* w1 = which ? p.cv_w1 : p.ck_w1; const float* pos = which ? p.pos_v : p.pos_k;
        float a = 0.f;
        for (int k = kq * 512; k < kq * 512 + 512; ++k) a += pos[k] * w1[(size_t)k * 256 + col];
        sm[tid] = a;
        __syncthreads();
        if (tid < 64) p.c1[which * 256 + col] = sm[tid] + sm[64 + tid] + sm[128 + tid] + sm[192 + tid];
        __syncthreads();
    }
}


struct XcdOrder {
    int xcd, lw, nlw, tn, per;
    __device__ __forceinline__ XcdOrder(int wg, int nwg, int nM, int tn_) : xcd(wg & 7), lw(wg >> 3), nlw(nwg >> 3), tn(tn_), per((nM >> 3) * tn_) {}
    __device__ __forceinline__ bool get(int k, int& mt, int& nt) const { const int lt = lw + k * nlw; if (lt >= per) return false; mt = xcd + 8 * (lt / tn); nt = lt % tn; return true; }
};
__device__ __forceinline__ void st_inproj0_mf(const P& p, int wg, int nwg, LDSP char* lds) {
    const int tid = otid();
    const XcdOrder ord(wg, nwg, 128, 23);
    for (int k = 0;; ++k) {
        int mt, nt;
        if (!ord.get(k, mt, nt)) break;
        gemm128(16, 64, 64,
            [&](int r) { return p.h + (size_t)(mt * 128 + r) * DM; },
            [&](int r) { int n = nt * 128 + r; n = n < 2840 ? n : 2839; return p.wt_in0 + (size_t)n * 1024; },
            [&](int rl, int cl, const f32x4 (&a)[4]) {
                const int row = mt * 128 + rl;
#pragma unroll
                for (int n = 0; n < 4; ++n) {
                    const int col = nt * 128 + cl + n * 16;
                    if (col < 2840) {
                        *(u32x2*)(p.proj + (size_t)row * 2840 + col) = (u32x2){pack_bf16(a[n][0], a[n][1]), pack_bf16(a[n][2], a[n][3])};
                        if (col >= 1280 && col < 1304)
                            *(f32x4*)(p.gates + (size_t)row * 24 + (col - 1280)) = (f32x4){sigmf(a[n][0]), sigmf(a[n][1]), sigmf(a[n][2]), sigmf(a[n][3])};
                    }
                }
            }, lds, tid);
    }
}
__device__ __forceinline__ void st_cmp1_mf(const P& p, int wg, int nwg, LDSP char* lds) {
    const int tid = otid();
    for (int w = wg; w < 2 * 16 * 2; w += nwg) {
        const int which = w >> 5, mt = (w >> 1) & 15, nt = w & 1;
        const int colbase = which ? 640 : 512;
        gemm128(32, 2840, 64,
            [&](int r) { int m = mt * 128 + r; m = m < 2044 ? m : 2043; const int bk = m / 511, n = m % 511, b = bk >> 1, kv = bk & 1;
                         return p.proj + (size_t)(b * SEQ + 16 * n) * 2840 + colbase + kv * 64; },
            [&](int r) { return p.wt_c1 + (size_t)(which * 256 + nt * 128 + r) * 2048; },
            [&](int rl, int cl, const f32x4 (&a)[4]) {
                const int m = mt * 128 + rl;
                if (m < 2044) {
#pragma unroll
                    for (int n = 0; n < 4; ++n) {
                        const int col = nt * 128 + cl + n * 16;
                        const f32x4 cb = *(const f32x4*)(p.c1 + which * 256 + col);
                        *(u32x2*)(p.chidb + (size_t)(which * 2048 + m) * 256 + col) =
                            (u32x2){pack_bf16(gelu_tanh(a[n][0] + cb[0]), gelu_tanh(a[n][1] + cb[1])), pack_bf16(gelu_tanh(a[n][2] + cb[2]), gelu_tanh(a[n][3] + cb[3]))};
                    }
                }
            }, lds, tid);
    }
}
__device__ __forceinline__ void st_cmp2_mf(const P& p, int wg, int nwg, LDSP char* lds) {
    const int tid = otid();
    for (int w = wg; w < 2 * 16; w += nwg) {
        const int which = w >> 4, mt = w & 15;
        gemm128(4, 64, 64,
            [&](int r) { int m = mt * 128 + r; m = m < 2044 ? m : 2043; return p.chidb + (size_t)(which * 2048 + m) * 256; },
            [&](int r) { return p.wt_c2 + (size_t)(which * 64 + (r & 63)) * 256; },
            [&](int rl, int cl, const f32x4 (&a)[4]) {
                const int m = mt * 128 + rl;
                if (m < 2044) {
#pragma unroll
                    for (int n = 0; n < 4; ++n) { const int col = cl + n * 16; if (col < 64) {
                        const int bk = m / 511, nn = m % 511;
                        *(u32x2*)(p.kcmpb + ((size_t)((which * 4 + bk) * 512 + nn)) * 64 + col) = (u32x2){cvtpk(a[n][0], a[n][1]), cvtpk(a[n][2], a[n][3])}; } }
                }
            }, lds, tid);
    }
}
__device__ __forceinline__ void st_outproj_mf(const P& p, int layer, int wg, int nwg, LDSP char* lds) {
    const int tid = otid();
    const bf16_t* W = layer ? p.wt_out1 : p.wt_out0;
    const float* xin = layer ? p.out : p.x;
    const XcdOrder ord(wg, nwg, 128, 8);
    for (int k = 0;; ++k) {
        int mt, nt;
        if (!ord.get(k, mt, nt)) break;
        gemm128(16, 64, 64,
            [&](int r) { return p.o + (size_t)(mt * 128 + r) * DM; },
            [&](int r) { return W + (size_t)(nt * 128 + r) * 1024; },
            [&](int rl, int cl, const f32x4 (&a)[4]) {
                const int row = mt * 128 + rl, b = row >> 13;
                const float* g = p.modv + (size_t)(layer * 2 + b) * 6144 + 2 * 1024;
#pragma unroll
                for (int n = 0; n < 4; ++n) {
                    const int col = nt * 128 + cl + n * 16;
                    const f32x4 xv = *(const f32x4*)(xin + (size_t)row * DM + col), gv = *(const f32x4*)(g + col);
                    *(f32x4*)(p.out + (size_t)row * DM + col) = xv + gv * a[n];
                }
            }, lds, tid);
    }
}
__device__ __forceinline__ bool moe_tile128(const int* cnt, int tt, int& e, int& i0, int& off) {
    int acc = 0, o = 0;
    for (int q = 0; q < 16; ++q) {
        const int c = cnt[q * 32], nt = (c + 127) >> 7;
        if (tt < acc + nt) { e = q; i0 = (tt - acc) * 128; off = o; return true; }
        acc += nt; o += c;
    }
    return false;
}
__device__ __forceinline__ void st_moe_up_mf(const P& p, int layer, int wg, int nwg, LDSP char* lds) {
    const int tid = otid();
    const int* cnt = p.cnt + layer * 512;
    for (int w = wg;; w += nwg) {
        int e, i0, off;
        if (!moe_tile128(cnt, w >> 3, e, i0, off)) break;
        const int nt = w & 7, ce = cnt[e * 32];
        const int* lst = p.list + e * T_TOK;
        const bf16_t* B = p.wt_gu + ((size_t)(layer * 16 + e) * 1024 + nt * 128) * 1024;
        gemm128(16, 64, 64,
            [&](int r) { const int i = (i0 + r < ce) ? i0 + r : i0; return p.h + (size_t)(lst[i] >> 1) * DM; },
            [&](int r) { return B + (size_t)r * 1024; },
            [&](int rl, int cl, const f32x4 (&a)[4]) {
                if (i0 + rl < ce) {
                    const int wc = cl >> 6, fq4 = cl & 63;
#pragma unroll
                    for (int n = 0; n < 2; ++n) {
                        const int col = nt * 64 + wc * 32 + n * 16 + fq4;
                        const f32x4 g = a[n], u = a[n + 2];
                        *(u32x2*)(p.hid + (size_t)(off + i0 + rl) * 512 + col) =
                            (u32x2){pack_bf16(siluf(g[0]) * u[0], siluf(g[1]) * u[1]), pack_bf16(siluf(g[2]) * u[2], siluf(g[3]) * u[3])};
                    }
                }
            }, lds, tid);
    }
}
__device__ __forceinline__ void st_moe_down_mf(const P& p, int layer, int wg, int nwg, LDSP char* lds) {
    const int tid = otid();
    const int* cnt = p.cnt + layer * 512;
    for (int w = wg;; w += nwg) {
        int e, i0, off;
        if (!moe_tile128(cnt, w >> 3, e, i0, off)) break;
        const int nt = w & 7, ce = cnt[e * 32];
        const int* lst = p.list + e * T_TOK;
        const bf16_t* B = p.wt_d + ((size_t)(layer * 16 + e) * 1024 + nt * 128) * 512;
        gemm128(8, 64, 64,
            [&](int r) { const int i = (i0 + r < ce) ? i0 + r : i0; return p.hid + (size_t)(off + i) * 512; },
            [&](int r) { return B + (size_t)r * 512; },
            [&](int rl, int cl, const f32x4 (&a)[4]) {
                if (i0 + rl < ce) {
                    const int id = lst[i0 + rl]; const float wt = p.tokw[id];
#pragma unroll
                    for (int n = 0; n < 4; ++n) {
                        const int col = nt * 128 + cl + n * 16;
                        *(u32x2*)(p.y + (size_t)id * DM + col) = (u32x2){pack_bf16(wt * a[n][0], wt * a[n][1]), pack_bf16(wt * a[n][2], wt * a[n][3])};
                    }
                }
            }, lds, tid);
    }
}
__device__ __forceinline__ void st_inproj1_mf(const P& p, int wg, int nwg, LDSP char* lds) {
    const int tid = otid();
    const XcdOrder ord(wg, nwg, 128, 10);
    for (int k = 0;; ++k) {
        int mt, nt;
        if (!ord.get(k, mt, nt)) break;
        gemm128(16, 64, 64,
            [&](int r) { return p.h + (size_t)(mt * 128 + r) * DM; },
            [&](int r) { int n = nt * 128 + r; n = n < 1216 ? n : 1215; return p.wt_in1 + (size_t)n * 1024; },
            [&](int rl, int cl, const f32x4 (&a)[4]) {
                const int row = mt * 128 + rl;
#pragma unroll
                for (int n = 0; n < 4; ++n) {
                    const int col = nt * 128 + cl + n * 16;
                    if (col < 1216) *(u32x2*)(p.proj1 + (size_t)row * 1216 + col) = (u32x2){pack_bf16(a[n][0], a[n][1]), pack_bf16(a[n][2], a[n][3])};
                }
            }, lds, tid);
    }
}
__device__ __forceinline__ void st_mla_up_mf(const P& p, int wg, int nwg, LDSP char* lds) {
    const int tid = otid();
    const XcdOrder ord(wg, nwg, 128, 14);
    for (int k = 0;; ++k) {
        int mt, c;
        if (!ord.get(k, mt, c)) break;
        if (c < 6) {
            gemm128(4, 64, 64,
                [&](int r) { return p.cqn + (size_t)(mt * 128 + r) * 384; },
                [&](int r) { return p.wt_qup + (size_t)(c * 128 + r) * 256; },
                [&](int rl, int cl, const f32x4 (&a)[4]) {
                    const int row = mt * 128 + rl, wc = cl >> 6;
                    f32x4 v[4] = {a[0], a[1], a[2], a[3]};
                    if (((c == 1 || c == 4) && wc == 0) || ((c == 2 || c == 5) && wc == 1)) {
                        const int t = row & (SEQ - 1), i0 = cl & 63;
#pragma unroll
                        for (int n = 0; n < 2; ++n) {
                            const f32x4 cs = *(const f32x4*)(p.ropec + t * 32 + n * 16 + i0), sn = *(const f32x4*)(p.ropes + t * 32 + n * 16 + i0);
                            v[n] = a[n] * cs - a[n + 2] * sn; v[n + 2] = a[n] * sn + a[n + 2] * cs;
                        }
                    }
#pragma unroll
                    for (int n = 0; n < 4; ++n) *(u32x2*)(p.qmla + (size_t)row * 768 + c * 128 + cl + n * 16) = (u32x2){cvtpk(v[n][0], v[n][1]), cvtpk(v[n][2], v[n][3])};
                }, lds, tid);
        } else {
            gemm128(2, 64, 64,
                [&](int r) { return p.cqn + (size_t)(mt * 128 + r) * 384 + 256; },
                [&](int r) { return p.wt_kvup + (size_t)((c - 6) * 128 + r) * 128; },
                [&](int rl, int cl, const f32x4 (&a)[4]) {
                    const int row = mt * 128 + rl;
#pragma unroll
                    for (int n = 0; n < 4; ++n) *(u32x2*)(p.kvmla + (size_t)row * 1024 + (c - 6) * 128 + cl + n * 16) = (u32x2){pack_bf16(a[n][0], a[n][1]), pack_bf16(a[n][2], a[n][3])};
                }, lds, tid);
        }
    }
}

typedef float f32x16 __attribute__((ext_vector_type(16)));
typedef short s16x4 __attribute__((ext_vector_type(4)));
#define ATT_NEG (-1e30f)
#define ATT_SHIFT (-16.0f)
#define LOG2E 1.4426950408889634f

__device__ __forceinline__ int swz128(int row) { return (((row >> 1) & 1) << 2) | ((row >> 2) & 3); }
__device__ __forceinline__ int swz256(int row) { return ((row & 3) << 2) | ((row >> 2) & 3); }

struct AttLane {
    int kbase;
    int v0[2];
};
template <int KROWB, int VROWB, int DT>
__device__ __forceinline__ void att_lane_init(AttLane& L, int lane) {
    const int q = lane & 31, hh = lane >> 5, x = hh ^ swz128(q);
    L.kbase = q * KROWB + x * 16;
    const int rl = 4 * hh + ((lane & 15) >> 2), blk = (lane >> 4) & 1, pp = lane & 3;
#pragma unroll
    for (int t = 0; t < 2; ++t) {
        const int g = (VROWB == 256) ? (((rl & 3) << 2) | ((2 * t + hh) & 3)) : ((((rl >> 1) & 1) << 2) | ((2 * t + hh) & 3));
        L.v0[t] = rl * VROWB + (((2 * blk + (pp >> 1)) ^ g) * 16) + 8 * (pp & 1);
    }
}
template <int KS, int KROWB, int MODE, bool WANT_P, bool IMP>
__device__ __forceinline__ void att_qk(LDSP const char* kb, const AttLane& L, const bf16x8 (&qf)[KS], bf16x8 (&pf)[4], float& lsum, const float c1, const float cadd,
                                       const unsigned lutv, const int dq16, LDSP float* improw, const float invl) {
    float la = 0.f, lb = 0.f, lc = 0.f, ld = 0.f;
#pragma unroll
    for (int kt = 0; kt < 2; ++kt) {
        f32x16 s;
#pragma unroll
        for (int r = 0; r < 16; ++r) s[r] = 0.f;
        constexpr int KG = (KS > 4) ? 2 : 4;
#pragma unroll
        for (int k4 = 0; k4 < KS; k4 += KG) {
            bf16x8 a[KG];
#pragma unroll
            for (int j = 0; j < KG; ++j) { const int ks = k4 + j; a[j] = *(const LDSP bf16x8*)(kb + (L.kbase ^ (32 * (ks & 3))) + (ks >> 2) * 128 + kt * 32 * KROWB); }
#pragma unroll
            for (int j = 0; j < KG; ++j) s = __builtin_amdgcn_mfma_f32_32x32x16_bf16(a[j], qf[k4 + j], s, 0, 0, 0);
            asm volatile("" ::: "memory");
        }
        float pr[16];
#pragma unroll
        for (int r = 0; r < 16; ++r) {
            const int koff = 32 * kt + (r & 3) + 8 * (r >> 2);
            float add = cadd;
            if (MODE == 1) add = *(const LDSP float*)(lutv + (63 - koff) * 4);
            if (MODE == 2) { int d = dq16 - 16 * koff; d = d < -1 ? -1 : d; d = d > 1087 ? 1087 : d; add = *(const LDSP float*)(lutv + (unsigned)(64 + d) * 4u); }
            pr[r] = __builtin_amdgcn_exp2f(__builtin_fmaf(s[r], c1, add));
        }
#pragma unroll
        for (int r = 0; r < 16; r += 4) { la += pr[r]; lb += pr[r + 1]; lc += pr[r + 2]; ld += pr[r + 3]; }
        if (IMP) {
#pragma unroll
            for (int g = 0; g < 4; ++g) {
                (void)__hip_atomic_fetch_add((LDSP unsigned*)improw + 8 * kt + 2 * g, (unsigned)(((pr[4 * g] + pr[4 * g + 1]) + (pr[4 * g + 2] + pr[4 * g + 3])) * invl + 0.5f), __ATOMIC_RELAXED, __HIP_MEMORY_SCOPE_WORKGROUP);
                (void)__hip_atomic_fetch_add((LDSP unsigned*)improw + 8 * kt + 2 * g + 1, (unsigned)(pr[4 * g + 3] * invl + 0.5f), __ATOMIC_RELAXED, __HIP_MEMORY_SCOPE_WORKGROUP);
            }
        }
        if (WANT_P) {
#pragma unroll
            for (int sI = 0; sI < 2; ++sI) {
                union { unsigned u[4]; bf16x8 v; } cv;
#pragma unroll
                for (int i = 0; i < 4; ++i) cv.u[i] = cvtpk(pr[8 * sI + 2 * i], pr[8 * sI + 2 * i + 1]);
                pf[kt * 2 + sI] = cv.v;
            }
        }
    }
    lsum += (la + lb) + (lc + ld);
}
template <int DT, int VROWB>
__device__ __forceinline__ void att_pv(LDSP const char* vb, const AttLane& L, const bf16x8 (&pf)[4], f32x16 (&o)[DT]) {
    const unsigned vba = (unsigned)(size_t)vb;
#pragma unroll
    for (int ks2 = 0; ks2 < 4; ++ks2) {
#pragma unroll
        for (int d0 = 0; d0 < DT; d0 += 2) {
            s16x4 lo[2], hi[2];
#pragma unroll
            for (int j = 0; j < 2; ++j) {
                asm volatile("ds_read_b64_tr_b16 %0, %1 offset:%2" : "=v"(lo[j]) : "v"(vba + (L.v0[0] ^ ((d0 + j) << 6))), "i"((16 * ks2) * VROWB) : "memory");
                asm volatile("ds_read_b64_tr_b16 %0, %1 offset:%2" : "=v"(hi[j]) : "v"(vba + (L.v0[1] ^ ((d0 + j) << 6))), "i"((16 * ks2 + 8) * VROWB) : "memory");
            }
            asm volatile("s_waitcnt lgkmcnt(0)" ::: "memory");
#pragma unroll
            for (int j = 0; j < 2; ++j) {
                asm volatile("" : "+v"(lo[j]), "+v"(hi[j]));
                const bf16x8 vf = __builtin_shufflevector(lo[j], hi[j], 0, 1, 2, 3, 4, 5, 6, 7);
                o[d0 + j] = __builtin_amdgcn_mfma_f32_32x32x16_bf16(vf, pf[ks2], o[d0 + j], 0, 0, 0);
            }
        }
    }
}
template <int CPR>
__device__ __forceinline__ void att_stage_map(int (&rowc)[(CPR == 24) ? 6 : 1], int tid) {
    if (CPR == 24) {
#pragma unroll
        for (int i = 0; i < 6; ++i) {
            const int c = tid + 256 * i, row = c / 24, cc = c % 24;
            rowc[i % ((CPR == 24) ? 6 : 1)] = (row << 8) | ((cc & ~7) | ((cc & 7) ^ swz128(row)));
        }
    } else if (CPR == 16) {
        const int row = tid >> 4; rowc[0] = (row << 8) | ((tid & 15) ^ swz256(row));
    } else {
        const int row = tid >> 3; rowc[0] = (row << 8) | ((tid & 7) ^ swz128(row));
    }
}
template <int CPR, class SRC>
__device__ __forceinline__ void att_stage(LDSP char* dst, SRC src, const int (&rowc)[(CPR == 24) ? 6 : 1], int wid) {
#pragma unroll
    for (int i = 0; i < CPR / 4; ++i) {
        const int rc = rowc[(CPR == 24) ? i : 0];
        const int row = (rc >> 8) + ((CPR == 24) ? 0 : i * (256 / CPR));
        __builtin_amdgcn_global_load_lds((const unsigned*)src(row, rc & 255), (LDSP unsigned*)(dst + (256 * i + 64 * wid) * 16), 16, 0, 0);
    }
}
__device__ __forceinline__ int wq_next(int* ctr, LDSP int* slot, int tid) {
    __syncthreads();
    if (tid == 0) *slot = atomicAdd(ctr, 1);
    __syncthreads();
    return *slot;
}

__device__ __forceinline__ void build_lut(LDSP float* tab, const float* blut_h, int n, int wlimit, int tid) {
    for (int i = tid; i < n; i += 256) { const int d = i - 64; tab[i] = (d < 0 || d >= wlimit) ? ATT_NEG : blut_h[d > 1023 ? 1023 : d] * LOG2E + ATT_SHIFT; }
}
#define ATT_BAR() do { __builtin_amdgcn_s_barrier(); asm volatile("" ::: "memory"); } while (0)

__device__ __forceinline__ void mla_item(const P& p, const int item, LDSP char* lds, const int tid0) {
    LDSP char* kb = lds; LDSP char* vb = lds + 24576; LDSP float* lut = (LDSP float*)(lds + 40960);
    const float c1 = 0.07216878364870322f * LOG2E;
    int tid = tid0; asm volatile("" : "+v"(tid));
    const int wid = tid >> 6, lane = tid & 63, q = lane & 31, hh = lane >> 5;
    AttLane L; att_lane_init<384, 256, 4>(L, lane);
    int krc[6], vrc[1];
    att_stage_map<24>(krc, tid); att_stage_map<16>(vrc, tid);
    int qt, bh, part;
    if (item >= 640) { const int r = item - 640; qt = 15 - (r >> 3); bh = r & 7; part = 0; }
    else {
        int g = 0; while (16 * (g + 1) + 8 * ((g + 2) >> 1) <= item) ++g;
        const int r = item - (16 * g + 8 * ((g + 1) >> 1)), Ln = 64 - g;
        if (r < 16) { qt = Ln - 1; bh = r & 7; part = 1 + (r >> 3); } else { qt = (Ln >> 1) - 1; bh = (r - 16) & 7; part = 0; }
    }
    const int b = bh >> 2, h = bh & 3;
    const int tw = qt * 128 + wid * 32;
    bf16x8 qf[12];
    {
        const bf16_t* qp = p.qmla + (size_t)(b * SEQ + tw + q) * 768 + h * 192 + 8 * hh;
#pragma unroll
        for (int ks = 0; ks < 12; ++ks) qf[ks] = *(const bf16x8*)(qp + 16 * ks);
    }
    f32x16 o[4];
#pragma unroll
    for (int dt = 0; dt < 4; ++dt)
#pragma unroll
        for (int r = 0; r < 16; ++r) o[dt][r] = 0.f;
    float lsum = 0.f;
    const int i0 = (part == 2) ? qt + 1 : 0, ntiles = (part == 1) ? qt + 1 : 2 * qt + 2;
    const bf16_t* kvb = p.kvmla + (size_t)b * SEQ * 1024 + h * 256;
    const bf16_t* krb = p.krope + (size_t)b * SEQ * 64;
    auto ksrc = [&](int pos0) { return [=](int row, int gc) { return gc < 16 ? kvb + (size_t)(pos0 + row) * 1024 + gc * 8 : krb + (size_t)(pos0 + row) * 64 + (gc - 16) * 8; }; };
    auto vsrc = [&](int pos0) { return [=](int row, int gc) { return kvb + (size_t)(pos0 + row) * 1024 + 128 + gc * 8; }; };
    att_stage<24>(kb, ksrc(i0 * 64), krc, wid);
    for (int i = i0; i < ntiles; ++i) {
        const int pos0 = i * 64;
        asm volatile("s_waitcnt vmcnt(0)" ::: "memory"); ATT_BAR();
        att_stage<16>(vb, vsrc(pos0), vrc, wid);
        const bool active = pos0 <= tw + 31, diag = pos0 + 63 > tw;
        bf16x8 pf[4];
        if (active) {
            if (diag) {
                int dq = tw + q - pos0 - 4 * hh; dq = dq < -1 ? -1 : dq;
                att_qk<12, 384, 1, true, false>(kb, L, qf, pf, lsum, c1, 0.f, (unsigned)(size_t)lut + (unsigned)(dq + 1) * 4u, 0, nullptr, 0.f);
            } else att_qk<12, 384, 0, true, false>(kb, L, qf, pf, lsum, c1, ATT_SHIFT, 0u, 0, nullptr, 0.f);
        }
        asm volatile("s_waitcnt vmcnt(0) lgkmcnt(0)" ::: "memory"); ATT_BAR();
        if (i + 1 < ntiles) att_stage<24>(kb, ksrc(pos0 + 64), krc, wid);
        if (active) att_pv<4, 256>(vb, L, pf, o);
    }
    const float lt = lsum + __shfl_xor(lsum, 32);
    int tid2 = tid0; asm volatile("" : "+v"(tid2));
    const int lane2 = tid2 & 63, trow = qt * 128 + (tid2 >> 6) * 32 + (lane2 & 31);
    bf16_t* op; float inv;
    if (part == 0) { inv = 1.0f / lt; op = p.o + (size_t)(b * SEQ + trow) * DM + h * 128 + 4 * (lane2 >> 5); }
    else {
        const size_t rec = (size_t)((part - 1) * 8 + bh) * (SEQ / 2) + (trow - SEQ / 2);
        inv = 1.0f; op = p.mlap + rec * 128 + 4 * (lane2 >> 5);
        if (lane2 < 32) p.mlal[rec] = lt;
    }
#pragma unroll
    for (int dt = 0; dt < 4; ++dt)
#pragma unroll
        for (int rq = 0; rq < 4; ++rq)
            *(u32x2*)(op + 32 * dt + 8 * rq) = (u32x2){cvtpk(o[dt][4 * rq] * inv, o[dt][4 * rq + 1] * inv), cvtpk(o[dt][4 * rq + 2] * inv, o[dt][4 * rq + 3] * inv)};
}
__device__ __forceinline__ void st_mla_combine(const P& p, int wg, int nwg) {
    const int TIDX = otid();
    const int wid = TIDX >> 6, lane = TIDX & 63;
    for (int w = wg * 4 + wid; w < 8 * (SEQ / 2); w += nwg * 4) {
        const int bh = w / (SEQ / 2), t = SEQ / 2 + w % (SEQ / 2), b = bh >> 2, h = bh & 3;
        const size_t r0 = (size_t)w, r1 = (size_t)(8 * (SEQ / 2) + w);
        const float inv = 1.0f / (p.mlal[r0] + p.mlal[r1]);
        const unsigned a = *(const unsigned*)(p.mlap + r0 * 128 + lane * 2), c = *(const unsigned*)(p.mlap + r1 * 128 + lane * 2);
        const float x0 = __uint_as_float(a << 16) + __uint_as_float(c << 16), x1 = __uint_as_float(a & 0xffff0000u) + __uint_as_float(c & 0xffff0000u);
        *(unsigned*)(p.o + (size_t)(b * SEQ + t) * DM + h * 128 + lane * 2) = cvtpk(x0 * inv, x1 * inv);
    }
}

__device__ __forceinline__ void swa_item(const P& p, const int item, LDSP char* lds, const int tid0) {
    LDSP char* kb = lds; LDSP char* vb = lds + 8192; LDSP float* luts = (LDSP float*)(lds + 46080);
    const float c1 = 0.125f * LOG2E;
    int tid = tid0; asm volatile("" : "+v"(tid));
    const int wid = tid >> 6, lane = tid & 63, q = lane & 31, hh = lane >> 5;
    AttLane L; att_lane_init<128, 128, 2>(L, lane);
    int rc[1]; att_stage_map<8>(rc, tid);
    const int b = item >> 9, kvh = (item >> 8) & 1, t0 = (item & 255) * 32, head = kvh * 4 + wid;
    bf16x8 qf[4];
    {
        const bf16_t* qp = p.proj1 + (size_t)(b * SEQ + t0 + q) * 1216 + 448 + head * 64 + 8 * hh;
#pragma unroll
        for (int ks = 0; ks < 4; ++ks) qf[ks] = *(const bf16x8*)(qp + 16 * ks);
    }
    f32x16 o[2];
#pragma unroll
    for (int dt = 0; dt < 2; ++dt)
#pragma unroll
        for (int r = 0; r < 16; ++r) o[dt][r] = 0.f;
    float lsum = 0.f;
    const bf16_t* kbp = p.proj1 + (size_t)b * SEQ * 1216 + 960 + kvh * 64;
    const bf16_t* zr = p.zrow;
    auto ksrc = [&](int pos0) { return [=](int row, int gc) { const int pos = pos0 + row; return (pos >= 0 && pos < SEQ) ? kbp + (size_t)pos * 1216 + gc * 8 : zr + gc * 8; }; };
    auto vsrc = [&](int pos0) { return [=](int row, int gc) { const int pos = pos0 + row; return (pos >= 0 && pos < SEQ) ? kbp + (size_t)pos * 1216 + 128 + gc * 8 : zr + gc * 8; }; };
    const unsigned tab = (unsigned)(size_t)(luts + head * 256);
    att_stage<8>(kb, ksrc(t0 - 128), rc, wid);
    for (int i = 0; i < 3; ++i) {
        const int pos0 = t0 - 128 + 64 * i;
        asm volatile("s_waitcnt vmcnt(0)" ::: "memory"); ATT_BAR();
        att_stage<8>(vb, vsrc(pos0), rc, wid);
        bf16x8 pf[4];
        int dq = t0 + q - pos0 - 4 * hh; dq = dq < -1 ? -1 : dq;
        att_qk<4, 128, 1, true, false>(kb, L, qf, pf, lsum, c1, 0.f, tab + (unsigned)(dq + 1) * 4u, 0, nullptr, 0.f);
        asm volatile("s_waitcnt vmcnt(0) lgkmcnt(0)" ::: "memory"); ATT_BAR();
        if (i + 1 < 3) att_stage<8>(kb, ksrc(pos0 + 64), rc, wid);
        att_pv<2, 128>(vb, L, pf, o);
    }
    const float lt = lsum + __shfl_xor(lsum, 32) + __builtin_amdgcn_exp2f(p.sinks[head] * LOG2E + ATT_SHIFT);
    const float inv = 1.0f / lt;
    bf16_t* op = p.o + (size_t)(b * SEQ + t0 + q) * DM + 512 + head * 64 + 4 * hh;
#pragma unroll
    for (int dt = 0; dt < 2; ++dt)
#pragma unroll
        for (int rq = 0; rq < 4; ++rq)
            *(u32x2*)(op + 32 * dt + 8 * rq) = (u32x2){cvtpk(o[dt][4 * rq] * inv, o[dt][4 * rq + 1] * inv), cvtpk(o[dt][4 * rq + 2] * inv, o[dt][4 * rq + 3] * inv)};
}
__device__ __forceinline__ void st_attn1(const P& p, LDSP char* lds) {
    const int tid0 = otid();
    LDSP float* lut = (LDSP float*)(lds + 40960); LDSP int* slot = (LDSP int*)(lds + 45568); LDSP float* luts = (LDSP float*)(lds + 46080);
    for (int i = tid0; i < 1152; i += 256) lut[i] = (i < 64) ? ATT_NEG : ATT_SHIFT;
#pragma unroll 1
    for (int h = 0; h < 8; ++h) build_lut(luts + h * 256, p.blut + h * 1024, 256, 128, tid0);
    for (;;) {
        const int item = wq_next(p.wq + 0, slot, tid0);
        if (item >= 768 + 1024) break;
        if (item < 768) mla_item(p, item, lds, tid0); else swa_item(p, item - 768, lds, tid0);
    }
}

#define A0_GLUT 16384
#define A0_WLUT 34816
#define A0_IMP 45056
#define A0_SEL 61568
#define A0_UN 62080
#define A0_LIST 62144
#define A0_SLOT 62720
__device__ __forceinline__ unsigned wmax_u32(unsigned v) {
#pragma unroll
    for (int o = 32; o > 0; o >>= 1) { const unsigned t = (unsigned)__shfl_xor((int)v, o); v = t > v ? t : v; }
    return v;
}
#define ATT_STORE_O(op, o, sc) do { _Pragma("unroll") for (int dt_ = 0; dt_ < 2; ++dt_) _Pragma("unroll") for (int rq_ = 0; rq_ < 4; ++rq_) \
        *(u32x2*)((op) + 32 * dt_ + 8 * rq_) = (u32x2){cvtpk((o)[dt_][4 * rq_] * (sc), (o)[dt_][4 * rq_ + 1] * (sc)), cvtpk((o)[dt_][4 * rq_ + 2] * (sc), (o)[dt_][4 * rq_ + 3] * (sc))}; } while (0)

__device__ __forceinline__ void nsa_item(const P& p, const int item, LDSP char* lds, const int tid0) {
    LDSP char* kb = lds; LDSP char* vb = lds + 8192;
    LDSP float* glut = (LDSP float*)(lds + A0_GLUT); LDSP float* wlut = (LDSP float*)(lds + A0_WLUT); LDSP float* imp = (LDSP float*)(lds + A0_IMP);
    LDSP unsigned* sel = (LDSP unsigned*)(lds + A0_SEL); LDSP unsigned* un = (LDSP unsigned*)(lds + A0_UN); LDSP unsigned short* blist = (LDSP unsigned short*)(lds + A0_LIST);
    const float c1 = 0.125f * LOG2E;
    int tid = tid0; asm volatile("" : "+v"(tid));
    const int wid = tid >> 6, lane = tid & 63, q = lane & 31, hh = lane >> 5;
    const int tile = 255 - (item >> 2), b = (item >> 1) & 1, kvh = item & 1, t0 = tile * 32, blk_t = t0 >> 6, head = kvh * 4 + wid;
#pragma unroll 1
    for (int h = 0; h < 4; ++h) { build_lut(glut + h * 1152, p.blut + (kvh * 4 + h) * 1024, 1152, 1 << 30, tid); build_lut(wlut + h * 640, p.blut + (kvh * 4 + h) * 1024, 640, 512, tid); }
    for (int i = tid; i < 32 * 129; i += 256) imp[i] = 0.f;
    AttLane L; att_lane_init<128, 128, 2>(L, lane);
    int rc[1]; att_stage_map<8>(rc, tid);
    const size_t rowq = (size_t)(b * SEQ + t0 + q);
    bf16x8 qf[4];
    {
        const bf16_t* qp = p.proj + rowq * 2840 + head * 64 + 8 * hh;
#pragma unroll
        for (int ks = 0; ks < 4; ++ks) qf[ks] = *(const bf16x8*)(qp + 16 * ks);
    }
    const float gc = p.gates[rowq * 24 + head * 3 + 0], gs = p.gates[rowq * 24 + head * 3 + 1], gw = p.gates[rowq * 24 + head * 3 + 2];
    const unsigned gtab = (unsigned)(size_t)(glut + wid * 1152), wtab = (unsigned)(size_t)(wlut + wid * 640);
    const bf16_t* zr = p.zrow;
    const bf16_t* pb = p.proj + (size_t)b * SEQ * 2840;
    f32x16 of[2], o[2];
#pragma unroll
    for (int dt = 0; dt < 2; ++dt)
#pragma unroll
        for (int r = 0; r < 16; ++r) { of[dt][r] = 0.f; o[dt][r] = 0.f; }
    bf16x8 pf[4];
    __syncthreads();
    const float cfar = glut[wid * 1152 + 64 + 1023];
    {
        int nvm = (t0 >> 4) + 1; nvm = nvm > 511 ? 511 : nvm;
        const int ntc = (nvm + 63) >> 6;
        const bf16_t* kcb = p.kcmpb + (size_t)((b * 2 + kvh) * 512) * 64;
        const bf16_t* vcb = p.kcmpb + (size_t)((4 + b * 2 + kvh) * 512) * 64;
        auto csrc = [&](const bf16_t* base, int n0) { return [=](int row, int gcx) { const int n = n0 + row; return n < 511 ? base + (size_t)n * 64 + gcx * 8 : zr + gcx * 8; }; };
        float lsum = 0.f;
        for (int nt = 0; nt < ntc; ++nt) {
            att_stage<8>(kb, csrc(kcb, nt * 64), rc, wid);
            asm volatile("s_waitcnt vmcnt(0)" ::: "memory"); ATT_BAR();
            const int dq16 = t0 + q - 31 - 1024 * nt - 64 * hh;
            if (t0 - 31 - 16 * (nt * 64 + 63) >= 1023) att_qk<4, 128, 0, false, false>(kb, L, qf, pf, lsum, c1, cfar, 0u, 0, nullptr, 0.f);
            else att_qk<4, 128, 2, false, false>(kb, L, qf, pf, lsum, c1, 0.f, gtab, dq16, nullptr, 0.f);
            asm volatile("s_waitcnt lgkmcnt(0)" ::: "memory"); ATT_BAR();
        }
        const float lc = lsum + __shfl_xor(lsum, 32);
        const float invl = lc > 0.f ? 1.0f / lc : 0.f;
        float dummy = 0.f;
        for (int nt = 0; nt < ntc; ++nt) {
            att_stage<8>(kb, csrc(kcb, nt * 64), rc, wid);
            att_stage<8>(vb, csrc(vcb, nt * 64), rc, wid);
            asm volatile("s_waitcnt vmcnt(0)" ::: "memory"); ATT_BAR();
            const int dq16 = t0 + q - 31 - 1024 * nt - 64 * hh;
            LDSP float* improw = imp + q * 129 + 16 * nt + hh;
            if (t0 - 31 - 16 * (nt * 64 + 63) >= 1023) att_qk<4, 128, 0, true, true>(kb, L, qf, pf, dummy, c1, cfar, 0u, 0, improw, invl * 524288.0f);
            else att_qk<4, 128, 2, true, true>(kb, L, qf, pf, dummy, c1, 0.f, gtab, dq16, improw, invl * 524288.0f);
            att_pv<2, 128>(vb, L, pf, o);
            asm volatile("s_waitcnt lgkmcnt(0)" ::: "memory"); ATT_BAR();
        }
        const float sc = gc * invl;
#pragma unroll
        for (int dt = 0; dt < 2; ++dt)
#pragma unroll
            for (int r = 0; r < 16; ++r) { of[dt][r] = o[dt][r] * sc; o[dt][r] = 0.f; }
    }
    __syncthreads();
    {
        unsigned u0 = 0u, u1 = 0u, u2 = 0u, u3 = 0u;
        for (int i = 0; i < 8; ++i) {
            const int tok = wid * 8 + i;
            const unsigned v0 = ((LDSP const unsigned*)imp)[tok * 129 + lane], v1 = ((LDSP const unsigned*)imp)[tok * 129 + 64 + lane];
            const int j0 = lane, j1 = lane + 64;
            const bool f0 = (j0 == 0) || (j0 == blk_t) || (j0 == blk_t - 1), f1 = (j1 == blk_t) || (j1 == blk_t - 1);
            unsigned k0 = f0 ? (0xFFFFFF80u | (unsigned)(127 - j0)) : (j0 <= blk_t ? ((v0 << 7) | (unsigned)(127 - j0)) : 0u);
            unsigned k1 = f1 ? (0xFFFFFF80u | (unsigned)(127 - j1)) : (j1 <= blk_t ? ((v1 << 7) | (unsigned)(127 - j1)) : 0u);
            unsigned thr = 0u;
#pragma unroll 1
            for (int bit = 31; bit >= 0; --bit) {
                const unsigned cand = thr | (1u << bit);
                const int c = __popcll(__ballot(k0 >= cand)) + __popcll(__ballot(k1 >= cand));
                thr = (c >= 16) ? cand : thr;
            }
            thr = thr ? thr : 1u;
            const unsigned long long b0 = __ballot(k0 >= thr), b1 = __ballot(k1 >= thr);
            const unsigned m0 = (unsigned)b0, m1 = (unsigned)(b0 >> 32), m2 = (unsigned)b1, m3 = (unsigned)(b1 >> 32);
            if (lane == 0) { sel[tok * 4 + 0] = m0; sel[tok * 4 + 1] = m1; sel[tok * 4 + 2] = m2; sel[tok * 4 + 3] = m3; }
            u0 |= m0; u1 |= m1; u2 |= m2; u3 |= m3;
        }
        if (lane == 0) { un[wid * 4 + 0] = u0; un[wid * 4 + 1] = u1; un[wid * 4 + 2] = u2; un[wid * 4 + 3] = u3; }
    }
    __syncthreads();
    {
        unsigned uw[4];
#pragma unroll
        for (int k = 0; k < 4; ++k) uw[k] = (unsigned)__builtin_amdgcn_readfirstlane((int)(un[k] | un[4 + k] | un[8 + k] | un[12 + k]));
        if (tid < 128) {
            const int k = tid >> 5, jb = tid & 31;
            unsigned wv = 0u; int below = 0;
#pragma unroll
            for (int kk = 0; kk < 4; ++kk) { if (kk == k) wv = uw[kk]; if (kk < k) below += __popc(uw[kk]); }
            if ((wv >> jb) & 1u) blist[below + __popc(wv & ((1u << jb) - 1u))] = (unsigned short)tid;
        }
        const int nb = __popc(uw[0]) + __popc(uw[1]) + __popc(uw[2]) + __popc(uw[3]);
        unsigned sq[4];
#pragma unroll
        for (int k = 0; k < 4; ++k) sq[k] = sel[q * 4 + k];
        __syncthreads();
        const bf16_t* ksb = pb + 768 + kvh * 64;
        auto ssrc = [&](int pos0, int colo) { return [=](int row, int gcx) { return ksb + (size_t)(pos0 + row) * 2840 + colo + gcx * 8; }; };
        float lsum = 0.f;
        att_stage<8>(kb, ssrc(64 * (int)blist[0], 0), rc, wid);
        for (int i = 0; i < nb; ++i) {
            const int j = __builtin_amdgcn_readfirstlane((int)blist[i]), pos0 = 64 * j;
            asm volatile("s_waitcnt vmcnt(0)" ::: "memory"); ATT_BAR();
            att_stage<8>(vb, ssrc(pos0, 128), rc, wid);
            unsigned sw = 0u;
#pragma unroll
            for (int k = 0; k < 4; ++k) if ((j >> 5) == k) sw = sq[k];
            const bool selq = (sw >> (j & 31)) & 1u;
            {
                int dq = t0 + q - pos0 - 4 * hh; dq = dq > 1087 ? 1087 : dq; dq = (dq < -1 || !selq) ? -1 : dq;
                att_qk<4, 128, 1, true, false>(kb, L, qf, pf, lsum, c1, 0.f, gtab + (unsigned)(dq + 1) * 4u, 0, nullptr, 0.f);
            }
            asm volatile("s_waitcnt vmcnt(0) lgkmcnt(0)" ::: "memory"); ATT_BAR();
            if (i + 1 < nb) att_stage<8>(kb, ssrc(64 * (int)blist[i + 1], 0), rc, wid);
            att_pv<2, 128>(vb, L, pf, o);
        }
        const float ls = lsum + __shfl_xor(lsum, 32);
        const float sc = gs / ls;
#pragma unroll
        for (int dt = 0; dt < 2; ++dt)
#pragma unroll
            for (int r = 0; r < 16; ++r) { of[dt][r] += o[dt][r] * sc; o[dt][r] = 0.f; }
    }
    {
        const bf16_t* kwb = pb + 1024 + kvh * 64;
        auto wsrc = [&](int pos0, int colo) { return [=](int row, int gcx) { const int pos = pos0 + row; return (pos >= 0 && pos < SEQ) ? kwb + (size_t)pos * 2840 + colo + gcx * 8 : zr + gcx * 8; }; };
        float lsum = 0.f;
        asm volatile("s_waitcnt lgkmcnt(0)" ::: "memory"); ATT_BAR();
        att_stage<8>(kb, wsrc(t0 - 512, 0), rc, wid);
        for (int i = 0; i < 9; ++i) {
            const int pos0 = t0 - 512 + 64 * i;
            asm volatile("s_waitcnt vmcnt(0)" ::: "memory"); ATT_BAR();
            att_stage<8>(vb, wsrc(pos0, 128), rc, wid);
            int dq = t0 + q - pos0 - 4 * hh; dq = dq < -1 ? -1 : dq;
            att_qk<4, 128, 1, true, false>(kb, L, qf, pf, lsum, c1, 0.f, wtab + (unsigned)(dq + 1) * 4u, 0, nullptr, 0.f);
            asm volatile("s_waitcnt vmcnt(0) lgkmcnt(0)" ::: "memory"); ATT_BAR();
            if (i + 1 < 9) att_stage<8>(kb, wsrc(pos0 + 64, 0), rc, wid);
            att_pv<2, 128>(vb, L, pf, o);
        }
        const float lw = lsum + __shfl_xor(lsum, 32);
        const float sc = gw / lw;
#pragma unroll
        for (int dt = 0; dt < 2; ++dt)
#pragma unroll
            for (int r = 0; r < 16; ++r) of[dt][r] += o[dt][r] * sc;
    }
    bf16_t* op = p.o + rowq * DM + head * 64 + 4 * hh;
    ATT_STORE_O(op, of, 1.0f);
}

#define MG_CNT 8192
#define MG_BASE 8320
#define MG_ENT 8448
__device__ __forceinline__ void st_moba_gate(const P& p, int wg, int nwg, LDSP char* lds) {
    const int tid = otid();
    const int wid = tid >> 6, lane = tid & 63, q = lane & 31, hh = lane >> 5;
    LDSP char* kmt = lds; LDSP int* lcnt = (LDSP int*)(lds + MG_CNT); LDSP int* lbase = (LDSP int*)(lds + MG_BASE); LDSP int* ent = (LDSP int*)(lds + MG_ENT);
    AttLane L; att_lane_init<128, 128, 2>(L, lane);
    int rc[1]; att_stage_map<8>(rc, tid);
    const bf16_t* zr = p.zrow;
    for (int item = wg; item < 1024; item += nwg) {
        const int tile = item >> 4, b = (item >> 3) & 1, h = item & 7, t0 = tile * 128, own = t0 >> 8, tw = t0 + wid * 32, bh = b * 8 + h;
        if (own == 0) continue;
        __syncthreads();
        if (tid < 32) lcnt[tid] = 0;
        bf16x8 qf[4];
        {
            const bf16_t* qp = p.proj + (size_t)(b * SEQ + tw + q) * 2840 + 1304 + h * 64 + 8 * hh;
#pragma unroll
            for (int ks = 0; ks < 4; ++ks) qf[ks] = *(const bf16x8*)(qp + 16 * ks);
        }
        const bf16_t* kmb = p.kmeanb + (size_t)(bh * 32) * 64;
        att_stage<8>(kmt, [=](int row, int gcx) { return row < 32 ? kmb + (size_t)row * 64 + gcx * 8 : zr + gcx * 8; }, rc, wid);
        asm volatile("s_waitcnt vmcnt(0)" ::: "memory");
        __syncthreads();
        f32x16 s;
#pragma unroll
        for (int r = 0; r < 16; ++r) s[r] = 0.f;
#pragma unroll
        for (int ks = 0; ks < 4; ++ks) {
            const bf16x8 a = *(const LDSP bf16x8*)(kmt + (L.kbase ^ (32 * (ks & 3))));
            s = __builtin_amdgcn_mfma_f32_32x32x16_bf16(a, qf[ks], s, 0, 0, 0);
        }
        unsigned key[16];
#pragma unroll
        for (int r = 0; r < 16; ++r) {
            const int j = (r & 3) + 8 * (r >> 2) + 4 * hh;
            const unsigned bits = __float_as_uint(s[r]);
            const unsigned srt = (bits & 0x80000000u) ? ~bits : (bits | 0x80000000u);
            key[r] = (j < own) ? ((srt & ~31u) | (unsigned)(31 - j)) : 0u;
        }
        unsigned selm = 0u;
#pragma unroll 1
        for (int rnd = 0; rnd < 3; ++rnd) {
            unsigned m = 0u;
#pragma unroll
            for (int r = 0; r < 16; ++r) m = key[r] > m ? key[r] : m;
            const unsigned mo = (unsigned)__shfl_xor((int)m, 32);
            const unsigned wk = mo > m ? mo : m;
            if (wk != 0u) selm |= 1u << (31 - (wk & 31u));
#pragma unroll
            for (int r = 0; r < 16; ++r) key[r] = (key[r] == wk) ? 0u : key[r];
        }
        if (hh == 0) {
            unsigned mm = selm;
#pragma unroll
            for (int sI = 0; sI < 3; ++sI) {
                int en = -1;
                if (mm) { const int j = __builtin_ctz(mm); mm &= mm - 1u; const int lp = __hip_atomic_fetch_add(lcnt + j, 1, __ATOMIC_RELAXED, __HIP_MEMORY_SCOPE_WORKGROUP); en = (j << 8) | lp; }
                ent[(wid * 32 + q) * 3 + sI] = en;
            }
        }
        __syncthreads();
        if (tid < 32) { const int c = lcnt[tid]; lbase[tid] = c ? atomicAdd(p.mcnt + bh * 32 + tid, c) : 0; }
        __syncthreads();
        for (int e = tid; e < 384; e += 256) {
            const int en = ent[e];
            if (en >= 0) { const int j = en >> 8, tokl = e / 3, sI = e - tokl * 3; p.mlist[(size_t)(bh * 32 + j) * 8192 + lbase[j] + (en & 255)] = (unsigned short)((t0 + tokl) | (sI << 13)); }
        }
    }
}
__device__ __forceinline__ bf16_t* moba_part(const P& p, int slot, size_t row) { return (slot < 2 ? p.mp01 + (size_t)slot * 131072 * 64 : p.mp2) + row * 64; }

__device__ __forceinline__ void moba_inv_item(const P& p, const int lid, const int chunk, LDSP char* lds, const int tid0) {
    LDSP char* kb = lds; LDSP char* vb = lds + 8192; LDSP float* glut = (LDSP float*)(lds + A0_GLUT);
    const float c1 = 0.125f * LOG2E;
    int tid = tid0; asm volatile("" : "+v"(tid));
    const int wid = tid >> 6, lane = tid & 63, q = lane & 31, hh = lane >> 5;
    const int bh = lid / 31, j = lid - bh * 31, b = bh >> 3, h = bh & 7;
    build_lut(glut, p.blut + h * 1024, 1152, 1 << 30, tid);
    AttLane L; att_lane_init<128, 128, 2>(L, lane);
    int rc[1]; att_stage_map<8>(rc, tid);
    const int n = p.mcnt[bh * 32 + j], idx = chunk * 128 + wid * 32 + q;
    const bool valid = idx < n;
    const unsigned en = valid ? (unsigned)p.mlist[(size_t)(bh * 32 + j) * 8192 + idx] : (unsigned)(256 * (j + 1));
    const int tok = (int)(en & 8191u), slot = (int)(en >> 13);
    bf16x8 qf[4];
    {
        const bf16_t* qp = p.proj + (size_t)(b * SEQ + tok) * 2840 + 1304 + h * 64 + 8 * hh;
#pragma unroll
        for (int ks = 0; ks < 4; ++ks) qf[ks] = *(const bf16x8*)(qp + 16 * ks);
    }
    const unsigned gtab = (unsigned)(size_t)glut;
    const bf16_t* kbb = p.proj + (size_t)b * SEQ * 2840 + 1816 + h * 64;
    auto msrc = [&](int pos0, int colo) { return [=](int row, int gcx) { return kbb + (size_t)(pos0 + row) * 2840 + colo + gcx * 8; }; };
    f32x16 o[2];
#pragma unroll
    for (int dt = 0; dt < 2; ++dt)
#pragma unroll
        for (int r = 0; r < 16; ++r) o[dt][r] = 0.f;
    float lsum = 0.f;
    bf16x8 pf[4];
    __syncthreads();
    att_stage<8>(kb, msrc(256 * j, 0), rc, wid);
    for (int i = 0; i < 4; ++i) {
        const int pos0 = 256 * j + 64 * i;
        asm volatile("s_waitcnt vmcnt(0)" ::: "memory"); ATT_BAR();
        att_stage<8>(vb, msrc(pos0, 512), rc, wid);
        {
            int dq = tok - pos0 - 4 * hh; dq = dq > 1087 ? 1087 : dq; dq = valid ? dq : -1;
            att_qk<4, 128, 1, true, false>(kb, L, qf, pf, lsum, c1, 0.f, gtab + (unsigned)(dq + 1) * 4u, 0, nullptr, 0.f);
        }
        asm volatile("s_waitcnt vmcnt(0) lgkmcnt(0)" ::: "memory"); ATT_BAR();
        if (i + 1 < 4) att_stage<8>(kb, msrc(pos0 + 64, 0), rc, wid);
        att_pv<2, 128>(vb, L, pf, o);
    }
    const float lt = lsum + __shfl_xor(lsum, 32);
    if (valid) {
        const size_t row = (size_t)bh * SEQ + tok;
        bf16_t* op = moba_part(p, slot, row) + 4 * hh;
        ATT_STORE_O(op, o, 1.0f);
        if (hh == 0) p.mpl[(size_t)slot * 131072 + row] = lt;
    }
}
__device__ __forceinline__ void moba_own_item(const P& p, const int item, LDSP char* lds, const int tid0) {
    LDSP char* kb = lds; LDSP char* vb = lds + 8192; LDSP float* glut = (LDSP float*)(lds + A0_GLUT);
    const float c1 = 0.125f * LOG2E;
    int tid = tid0; asm volatile("" : "+v"(tid));
    const int wid = tid >> 6, lane = tid & 63, q = lane & 31, hh = lane >> 5;
    const int tile = item >> 4, b = (item >> 3) & 1, h = item & 7, t0 = tile * 128, own = t0 >> 8, tw = t0 + wid * 32, bh = b * 8 + h;
    __syncthreads();
    build_lut(glut, p.blut + h * 1024, 1152, 1 << 30, tid);
    AttLane L; att_lane_init<128, 128, 2>(L, lane);
    int rc[1]; att_stage_map<8>(rc, tid);
    const size_t rowq = (size_t)(b * SEQ + tw + q);
    bf16x8 qf[4];
    {
        const bf16_t* qp = p.proj + rowq * 2840 + 1304 + h * 64 + 8 * hh;
#pragma unroll
        for (int ks = 0; ks < 4; ++ks) qf[ks] = *(const bf16x8*)(qp + 16 * ks);
    }
    const unsigned gtab = (unsigned)(size_t)glut;
    const bf16_t* kbb = p.proj + (size_t)b * SEQ * 2840 + 1816 + h * 64;
    auto msrc = [&](int pos0, int colo) { return [=](int row, int gcx) { return kbb + (size_t)(pos0 + row) * 2840 + colo + gcx * 8; }; };
    f32x16 o[2];
#pragma unroll
    for (int dt = 0; dt < 2; ++dt)
#pragma unroll
        for (int r = 0; r < 16; ++r) o[dt][r] = 0.f;
    float lsum = 0.f;
    bf16x8 pf[4];
    const int nb = (((t0 + 127) >> 6) & 3) + 1;
    __syncthreads();
    att_stage<8>(kb, msrc(256 * own, 0), rc, wid);
    for (int i = 0; i < nb; ++i) {
        const int pos0 = 256 * own + 64 * i;
        asm volatile("s_waitcnt vmcnt(0)" ::: "memory"); ATT_BAR();
        att_stage<8>(vb, msrc(pos0, 512), rc, wid);
        const bool active = pos0 <= tw + 31;
        if (active) {
            int dq = tw + q - pos0 - 4 * hh; dq = dq < -1 ? -1 : dq;
            att_qk<4, 128, 1, true, false>(kb, L, qf, pf, lsum, c1, 0.f, gtab + (unsigned)(dq + 1) * 4u, 0, nullptr, 0.f);
        }
        asm volatile("s_waitcnt vmcnt(0) lgkmcnt(0)" ::: "memory"); ATT_BAR();
        if (i + 1 < nb) att_stage<8>(kb, msrc(pos0 + 64, 0), rc, wid);
        if (active) att_pv<2, 128>(vb, L, pf, o);
    }
    float lt = lsum + __shfl_xor(lsum, 32);
    const int npick = own < 3 ? own : 3;
    const size_t row = (size_t)bh * SEQ + tw + q;
#pragma unroll 1
    for (int sI = 0; sI < npick; ++sI) {
        lt += p.mpl[(size_t)sI * 131072 + row];
        const bf16_t* pp = moba_part(p, sI, row) + 4 * hh;
#pragma unroll
        for (int dt = 0; dt < 2; ++dt)
#pragma unroll
            for (int rq = 0; rq < 4; ++rq) {
                const u32x2 w = *(const u32x2*)(pp + 32 * dt + 8 * rq);
                o[dt][4 * rq] += __uint_as_float(w[0] << 16); o[dt][4 * rq + 1] += __uint_as_float(w[0] & 0xffff0000u);
                o[dt][4 * rq + 2] += __uint_as_float(w[1] << 16); o[dt][4 * rq + 3] += __uint_as_float(w[1] & 0xffff0000u);
            }
    }
    const float inv = 1.0f / lt;
    bf16_t* op = p.o + rowq * DM + 512 + h * 64 + 4 * hh;
    ATT_STORE_O(op, o, inv);
}
__device__ __forceinline__ void st_moba_own(const P& p, int wg, int nwg, LDSP char* lds) {
    const int tid0 = otid();
    for (int item = wg; item < 1024; item += nwg) moba_own_item(p, item, lds, tid0);
}
#define A0_PRE 62736
__device__ __forceinline__ void st_attn0(const P& p, LDSP char* lds) {
    const int tid0 = otid();
    LDSP int* slot = (LDSP int*)(lds + A0_SLOT); LDSP int* pre = (LDSP int*)(lds + A0_PRE);
    LDSP int* tmp = (LDSP int*)lds;
    for (int i = tid0; i < 496; i += 256) { const int bh = i / 31, j = i - bh * 31; tmp[i] = (p.mcnt[bh * 32 + j] + 127) >> 7; }
    __syncthreads();
    for (int i = tid0; i < 497; i += 256) { int s = 0; for (int k = 0; k < i; ++k) s += tmp[k]; pre[i] = s; }
    __syncthreads();
    const int ninv = pre[496];
    for (;;) {
        const int item = wq_next(p.wq + 1, slot, tid0);
        if (item >= 1024 + ninv) break;
        if (item < 1024) nsa_item(p, item, lds, tid0);
        else {
            const int idx = item - 1024;
            int lo = 0, hi = 495;
            while (lo < hi) { const int mid = (lo + hi + 1) >> 1; if (pre[mid] <= idx) lo = mid; else hi = mid - 1; }
            moba_inv_item(p, lo, idx - pre[lo], lds, tid0);
        }
    }
}

#define XB_TMO      128
#define XB_XCNT(j)  (256  + 64 * (j))
#define XB_XSUB(j)  (1280 + 64 * (j))
#define XB_XGEN(j)  (2304 + 64 * (j))
#define XB_TOP      3328
#define XB_TOPGEN   3392
#define XCD_BAR_WORDS 3456
#define XB_SPIN_CAP (1u << 20)
#define LAS __attribute__((address_space(3)))

__device__ __forceinline__ unsigned xb_ld(unsigned* p)              { return __hip_atomic_load(p, __ATOMIC_RELAXED, __HIP_MEMORY_SCOPE_AGENT); }
__device__ __forceinline__ unsigned xb_add(unsigned* p, unsigned v) { return __hip_atomic_fetch_add(p, v, __ATOMIC_RELAXED, __HIP_MEMORY_SCOPE_AGENT); }
__device__ __forceinline__ unsigned xb_xcc_id() { return (unsigned)__builtin_amdgcn_s_getreg((3 << 11) | 20) & 0xFu; }
#define XB_SPIN(cond, bar) do { unsigned _sp = 0; while (cond) { __builtin_amdgcn_s_sleep(1); \
    if ((++_sp & 255u) == 0u) { if (xb_ld(&(bar)[XB_TMO])) break; if (_sp > XB_SPIN_CAP) { atomicAdd(&(bar)[XB_TMO], 1u); break; } } } } while (0)

struct XcdBarrier {
    unsigned* bar; unsigned x;
    volatile LAS unsigned* st;
};

__device__ __forceinline__ XcdBarrier xcd_barrier_post(unsigned* bar, volatile LAS unsigned* st) {
    XcdBarrier b; b.bar = bar; b.x = xb_xcc_id(); b.st = st;
    if (threadIdx.x == 0) (void)xb_add(&bar[XB_XCNT(b.x)], 1u);
    return b;
}
__device__ __forceinline__ void xcd_barrier_complete(unsigned* bar, unsigned x, unsigned& nloc, unsigned& nx) {
    const unsigned G = gridDim.x * gridDim.y * gridDim.z;
    unsigned sum, cnt, mine, sp = 0u;
    for (;;) {
        sum = 0u; cnt = 0u; mine = 0u;
#pragma unroll
        for (unsigned j = 0; j < 16; ++j) { const unsigned c = xb_ld(&bar[XB_XCNT(j)]); sum += c; cnt += (c > 0u) ? 1u : 0u; mine = (j == x) ? c : mine; }
        if (sum == G) break;
        __builtin_amdgcn_s_sleep(1);
        if ((++sp & 255u) == 0u) { if (xb_ld(&bar[XB_TMO])) break; if (sp > XB_SPIN_CAP) { atomicAdd(&bar[XB_TMO], 1u); break; } }
    }
    nloc = mine > 0u ? mine : 1u; nx = cnt > 0u ? cnt : 1u;
}

__device__ __forceinline__ void xcd_barrier(const XcdBarrier& b) {
    asm volatile("s_waitcnt vmcnt(0)" ::: "memory");
    __syncthreads();
    if (threadIdx.x == 0) {
        unsigned* bar = b.bar;
        __builtin_amdgcn_s_waitcnt(0);
        unsigned nloc = b.st[0], nx = b.st[1];
        if (nloc == 0u) { xcd_barrier_complete(bar, b.x, nloc, nx); b.st[0] = nloc; b.st[1] = nx; }
        const unsigned old = xb_add(&bar[XB_XSUB(b.x)], 1u);
        const unsigned gen = old / nloc;
        if (old + 1u == (gen + 1u) * nloc) {
            __builtin_amdgcn_fence(__ATOMIC_RELEASE, "agent");
            asm volatile("s_waitcnt vmcnt(0)" ::: "memory");
            const unsigned og = xb_add(&bar[XB_TOP], 1u);
            const unsigned tg = og / nx;
            if (og + 1u == (tg + 1u) * nx) xb_add(&bar[XB_TOPGEN], 1u);
            else XB_SPIN(xb_ld(&bar[XB_TOPGEN]) == tg, bar);
            __builtin_amdgcn_fence(__ATOMIC_ACQUIRE, "agent");
            xb_add(&bar[XB_XGEN(b.x)], 1u);
            asm volatile("s_waitcnt vmcnt(0)" ::: "memory");
        } else {
            XB_SPIN(xb_ld(&bar[XB_XGEN(b.x)]) == gen, bar);
            __builtin_amdgcn_fence(__ATOMIC_ACQUIRE, "agent");
            asm volatile("s_waitcnt vmcnt(0)" ::: "memory");
        }
    }
    __syncthreads();
}


#define PHASE_SYNC() do { PP qb_ = (PP)__builtin_amdgcn_kernarg_segment_ptr(); asm volatile("" : "+s"(qb_)); XcdBarrier b_; b_.bar = qb_->bar; b_.x = xb_xcc_id(); \
        b_.st = (volatile LAS unsigned*)(dlds + GEMM_LDS_BYTES); xcd_barrier(b_); } while (0)
typedef const __attribute__((address_space(4))) P* PP;
#define PHASE_ARGS() PP q_ = (PP)__builtin_amdgcn_kernarg_segment_ptr(); int wg = blockIdx.x, nwg = gridDim.x; asm volatile("" : "+s"(q_), "+s"(wg), "+s"(nwg)); P p; { const __attribute__((address_space(4))) unsigned long long* s64_ = (const __attribute__((address_space(4))) unsigned long long*)q_; unsigned long long* d64_ = (unsigned long long*)&p; _Pragma("unroll") for (int i_ = 0; i_ < (int)(sizeof(P) / 8); ++i_) d64_[i_] = s64_[i_]; } float* sm = (float*)dlds; LDSP char* lds = (LDSP char*)dlds; (void)sm; (void)lds
#define KERNEL_LDS_BYTES (GEMM_LDS_BYTES + 64)
__global__ void __launch_bounds__(256, 2) k_mega(P pk) {
    extern __shared__ __attribute__((aligned(16))) unsigned char dlds[];
    if (threadIdx.x == 0) *(uint4*)(dlds + GEMM_LDS_BYTES) = make_uint4(0u, 0u, 0u, 0u);
    __syncthreads();
    (void)xcd_barrier_post(pk.bar, (volatile LAS unsigned*)(dlds + GEMM_LDS_BYTES));
    { PHASE_ARGS(); st_prologue(p, wg, nwg, sm); st_convert(p, wg, nwg, sm); } PHASE_SYNC();
    { PHASE_ARGS(); st_norm<0>(p, 0, wg, nwg, sm); } PHASE_SYNC();
    { PHASE_ARGS(); st_inproj0_mf(p, wg, nwg, lds); } PHASE_SYNC();
    { PHASE_ARGS(); st_cmp1_mf(p, wg, nwg, lds); st_kmean(p, wg, nwg); } PHASE_SYNC();
    { PHASE_ARGS(); st_cmp2_mf(p, wg, nwg, lds); st_moba_gate(p, wg, nwg, lds); } PHASE_SYNC();
    { PHASE_ARGS(); st_attn0(p, lds); } PHASE_SYNC();
    { PHASE_ARGS(); st_moba_own(p, wg, nwg, lds); } PHASE_SYNC();
    { PHASE_ARGS(); st_outproj_mf(p, 0, wg, nwg, lds); } PHASE_SYNC();
    { PHASE_ARGS(); st_norm<1>(p, 0, wg, nwg, sm); } PHASE_SYNC();
    { PHASE_ARGS(); st_moe_up_mf(p, 0, wg, nwg, lds); } PHASE_SYNC();
    { PHASE_ARGS(); st_moe_down_mf(p, 0, wg, nwg, lds); } PHASE_SYNC();
    { PHASE_ARGS(); st_norm<2>(p, 1, wg, nwg, sm); } PHASE_SYNC();
    { PHASE_ARGS(); st_inproj1_mf(p, wg, nwg, lds); } PHASE_SYNC();
    { PHASE_ARGS(); st_mla_prep(p, wg, nwg); } PHASE_SYNC();
    { PHASE_ARGS(); st_mla_up_mf(p, wg, nwg, lds); } PHASE_SYNC();
    { PHASE_ARGS(); st_attn1(p, lds); } PHASE_SYNC();
    { PHASE_ARGS(); st_mla_combine(p, wg, nwg); } PHASE_SYNC();
    { PHASE_ARGS(); st_outproj_mf(p, 1, wg, nwg, lds); } PHASE_SYNC();
    { PHASE_ARGS(); st_norm<1>(p, 1, wg, nwg, sm); } PHASE_SYNC();
    { PHASE_ARGS(); st_moe_up_mf(p, 1, wg, nwg, lds); } PHASE_SYNC();
    { PHASE_ARGS(); st_moe_down_mf(p, 1, wg, nwg, lds); } PHASE_SYNC();
    { PHASE_ARGS(); st_norm<3>(p, 1, wg, nwg, sm); }
}

extern "C" void kernel_launch(void* const* d_in, const int* in_sizes, int n_in, void* d_out, int out_size, void* d_ws, size_t ws_size,
                              hipStream_t stream) {
    (void)in_sizes; (void)n_in; (void)out_size; (void)ws_size;
    P p{};
    const float* const* in = (const float* const*)d_in;
    p.x = in[0]; p.c = in[1]; p.rel = in[2]; p.router_w = in[3]; p.router_b = in[4]; p.final_norm = in[5]; p.norm_mix = in[6]; p.norm_ffn = in[7];
    p.ada_w = in[8]; p.ada_b = in[9]; p.moe_wg = in[10]; p.moe_wu = in[11]; p.moe_wd = in[12]; p.ev_w_in = in[13]; p.ev_w_out = in[14];
    p.pos_k = in[15]; p.pos_v = in[16]; p.ck_w1 = in[17]; p.ck_w2 = in[18]; p.cv_w1 = in[19]; p.cv_w2 = in[20]; p.od_w_in = in[21]; p.od_w_out = in[22];
    p.q_norm = in[23]; p.kv_norm = in[24]; p.w_q_up = in[25]; p.w_kv_up = in[26]; p.sinks = in[27];
    p.out = (float*)d_out;
    char* ws = (char*)d_ws; size_t off = 0;
    auto take = [&](size_t bytes) { char* r = ws + off; off += (bytes + 255) & ~(size_t)255; return r; };
    p.bar = (unsigned*)take(16384);
    p.cnt = (int*)take(4096);
    p.wq = (int*)take(256);
    p.mcnt = (int*)take(512 * 4);
    p.modv = (float*)take(2 * 2 * 6144 * 4);
    p.zrow = (bf16_t*)take(256);
    const size_t zero_bytes = off;
    p.ropec = (float*)take(SEQ * 32 * 4); p.ropes = (float*)take(SEQ * 32 * 4);
    p.blut = (float*)take(8 * 1024 * 4);
    p.gates = (float*)take((size_t)T_TOK * 24 * 4);
    p.kmean = (float*)take(2 * 8 * 32 * 64 * 4);
    p.tokw = (float*)take((size_t)T_TOK * 2 * 4);
    p.list = (int*)take((size_t)16 * T_TOK * 4);
    p.cqn = (bf16_t*)take((size_t)T_TOK * 384 * 2);
    p.krope = (bf16_t*)take((size_t)T_TOK * 64 * 2);
    p.h = (bf16_t*)take((size_t)T_TOK * DM * 2);
    p.o = (bf16_t*)take((size_t)T_TOK * DM * 2);
    p.mlap = p.h;
    p.mlal = (float*)(p.h + (size_t)2 * 8 * (SEQ / 2) * 128);
    p.mp01 = p.h;
    p.mp2 = (bf16_t*)take((size_t)131072 * 64 * 2);
    p.mpl = (float*)take((size_t)3 * 131072 * 4);
    p.mlist = (unsigned short*)take((size_t)16 * 32 * 8192 * 2);
    p.hid = p.o;
    char* region = take((size_t)100 * 1024 * 1024);
    p.proj = (bf16_t*)region;
    p.proj1 = (bf16_t*)region;
    p.qmla = (bf16_t*)(region + (size_t)T_TOK * 1216 * 2);
    p.kvmla = (bf16_t*)(region + (size_t)T_TOK * (1216 + 768) * 2);
    p.y = (bf16_t*)region;
    p.chidb = (bf16_t*)take((size_t)2 * 2048 * 256 * 2);
    p.kcmpb = (bf16_t*)take((size_t)8 * 512 * 64 * 2);
    p.kmeanb = (bf16_t*)take((size_t)2 * 8 * 32 * 64 * 2);
    p.c1 = (float*)take(512 * 4);
    p.wt_gu = (bf16_t*)take((size_t)32 * 1024 * 1024 * 2);
    p.wt_d = (bf16_t*)take((size_t)32 * 1024 * 512 * 2);
    p.wt_in0 = (bf16_t*)take((size_t)2840 * 1024 * 2);
    p.wt_out0 = (bf16_t*)take((size_t)1024 * 1024 * 2);
    p.wt_c1 = (bf16_t*)take((size_t)2 * 256 * 2048 * 2);
    p.wt_c2 = (bf16_t*)take((size_t)2 * 64 * 256 * 2);
    p.wt_in1 = (bf16_t*)take((size_t)1216 * 1024 * 2);
    p.wt_out1 = (bf16_t*)take((size_t)1024 * 1024 * 2);
    p.wt_qup = (bf16_t*)take((size_t)768 * 256 * 2);
    p.wt_kvup = (bf16_t*)take((size_t)1024 * 128 * 2);
    static int grid = 0;
    if (!grid) {
        int dev = 0, cus = 0, per_cu = 0;
        (void)hipGetDevice(&dev);
        (void)hipDeviceGetAttribute(&cus, hipDeviceAttributeMultiprocessorCount, dev);
        (void)hipFuncSetAttribute((const void*)k_mega, hipFuncAttributeMaxDynamicSharedMemorySize, KERNEL_LDS_BYTES);
        (void)hipOccupancyMaxActiveBlocksPerMultiprocessor(&per_cu, k_mega, 256, KERNEL_LDS_BYTES);
        if (cus <= 0) cus = 256;
        if (per_cu < 1) per_cu = 1;
        grid = cus * (per_cu < 2 ? per_cu : 2);
    }
    (void)hipMemsetAsync(d_ws, 0, zero_bytes, stream);
    hipLaunchKernelGGL(k_mega, dim3(grid), dim3(256), KERNEL_LDS_BYTES, stream, p);
}
```

```cpp
#include <hip/hip_runtime.h>
#include <stdint.h>

#define T_TOK 16384
#define SEQ 8192
#define DM 1024
#define NEGF (-1e30f)
#define BIGF (1e30f)

typedef unsigned short bf16_t;

__device__ __forceinline__ float bf2f(bf16_t v) { return __uint_as_float(((unsigned)v) << 16); }
__device__ __forceinline__ bf16_t f2bf(float f) {
    unsigned u = __float_as_uint(f);
    u += 0x7fffu + ((u >> 16) & 1u);
    return (bf16_t)(u >> 16);
}
__device__ __forceinline__ unsigned cvtpk(float lo, float hi) { unsigned r; asm("v_cvt_pk_bf16_f32 %0, %1, %2" : "=v"(r) : "v"(lo), "v"(hi)); return r; }
__device__ __forceinline__ float wsum(float v) {
#pragma unroll
    for (int o = 32; o > 0; o >>= 1) v += __shfl_xor(v, o);
    return v;
}
__device__ __forceinline__ float siluf(float v) { return v / (1.0f + __expf(-v)); }
__device__ __forceinline__ float sigmf(float v) { return 1.0f / (1.0f + __expf(-v)); }
__device__ __forceinline__ float gelu_tanh(float x) {
    const float k0 = 0.7978845608028654f, k1 = 0.044715f;
    float u = k0 * (x + k1 * x * x * x);
    return 0.5f * x * (1.0f + tanhf(u));
}
__device__ __forceinline__ int rel_bucket(int d) {
    if (d < 16) return d < 0 ? 0 : d;
    int b = 16;
    b += (d >= 21); b += (d >= 27); b += (d >= 35); b += (d >= 46); b += (d >= 59); b += (d >= 77); b += (d >= 99); b += (d >= 128);
    b += (d >= 166); b += (d >= 216); b += (d >= 280); b += (d >= 363); b += (d >= 470); b += (d >= 609); b += (d >= 790);
    return b;
}

__device__ __forceinline__ int otid() { int t = threadIdx.x; asm volatile("" : "+v"(t)); return t; }

struct P {
    const float *x, *c, *rel, *router_w, *router_b, *final_norm, *norm_mix, *norm_ffn, *ada_w, *ada_b, *moe_wg, *moe_wu, *moe_wd,
        *ev_w_in, *ev_w_out, *pos_k, *pos_v, *ck_w1, *ck_w2, *cv_w1, *cv_w2, *od_w_in, *od_w_out, *q_norm, *kv_norm, *w_q_up, *w_kv_up, *sinks;
    float* out;
    unsigned* bar; int* cnt;
    float *modv, *ropec, *ropes, *blut, *gates, *kcmp, *vcmp, *chid, *kmean, *tokw;
    bf16_t *h, *proj, *o, *hid, *y, *proj1, *qmla, *kvmla, *krope, *cqn;
    int* list;
    bf16_t *wt_gu, *wt_d, *wt_in0, *wt_out0, *wt_c1, *wt_c2, *wt_in1, *wt_out1, *wt_qup, *wt_kvup, *chidb;
    float *c1, *c1p;
    int* wq;
    bf16_t* zrow;
    bf16_t *kcmpb, *kmeanb, *mlap;
    float* mlal;
    int* mcnt; unsigned short* mlist; bf16_t *mp01, *mp2; float* mpl;
};


__device__ __forceinline__ void st_prologue(const P& p, int wg, int nwg, float* sm) {
    const int TIDX = otid();
    const int tid = TIDX;
    {
        for (int i = tid; i < 2048; i += 256) sm[i] = siluf(p.c[i]);
        __syncthreads();
        const int wid = tid >> 6, lane = tid & 63;
        for (int w = wg; w < 192; w += nwg) {
            const int l = w / 96, cg = w % 96, col = cg * 64 + lane;
            const float* W = p.ada_w + (size_t)l * 1024 * 6144 + (size_t)(wid * 256) * 6144 + col;
            float a0 = 0.f, a1 = 0.f;
#pragma unroll 32
            for (int k = 0; k < 256; ++k) { const float wv = W[(size_t)k * 6144]; a0 += sm[wid * 256 + k] * wv; a1 += sm[1024 + wid * 256 + k] * wv; }
            sm[2048 + tid] = a0; sm[2304 + tid] = a1;
            __syncthreads();
            if (tid < 64) {
                const float bb = p.ada_b[l * 6144 + col];
                p.modv[(l * 2 + 0) * 6144 + col] = ((sm[2048 + tid] + sm[2048 + 64 + tid]) + (sm[2048 + 128 + tid] + sm[2048 + 192 + tid])) + bb;
                p.modv[(l * 2 + 1) * 6144 + col] = ((sm[2304 + tid] + sm[2304 + 64 + tid]) + (sm[2304 + 128 + tid] + sm[2304 + 192 + tid])) + bb;
            }
            __syncthreads();
        }
        __syncthreads();
    }
    for (int i = wg * 256 + tid; i < SEQ * 32; i += nwg * 256) {
        const int t = i >> 5, j = i & 31;
        const float inv = powf(10000.0f, -(float)(2 * j) / 64.0f);
        const float ang = (float)t * inv;
        p.ropec[i] = cosf(ang); p.ropes[i] = sinf(ang);
    }
    for (int i = wg * 256 + tid; i < 8 * 1024; i += nwg * 256) { const int h = i >> 10, d = i & 1023; p.blut[i] = p.rel[rel_bucket(d) * 8 + h]; }
}

template <int MODE>
__device__ __forceinline__ void st_norm(const P& p, int layer, int wg, int nwg, float* sm) {
    const int TIDX = otid();
    const int wid = TIDX >> 6, lane = TIDX & 63;
    int* rl_cnt = (int*)sm; int* rl_base = rl_cnt + 16; int* rl_ent = rl_cnt + 32;
    if (MODE == 1) { if (TIDX < 16) rl_cnt[TIDX] = 0; for (int i = TIDX; i < 64; i += 256) rl_ent[i] = -1; __syncthreads(); }
    const int niter = (T_TOK + nwg * 4 - 1) / (nwg * 4);
    for (int it = 0; it < niter; ++it) {
        const int row = wg * 4 + wid + it * nwg * 4;
        if (MODE != 1 && row >= T_TOK) break;
        if (MODE != 1 || row < T_TOK) {
        const int b = row >> 13;
        float v[16];
        const float* xin = (MODE == 0) ? p.x : p.out;
#pragma unroll
        for (int i = 0; i < 4; ++i) {
            const float4 t4 = *(const float4*)(xin + (size_t)row * DM + i * 256 + lane * 4);
            v[i * 4 + 0] = t4.x; v[i * 4 + 1] = t4.y; v[i * 4 + 2] = t4.z; v[i * 4 + 3] = t4.w;
        }
        if (MODE >= 2) {
            const int lp = (MODE == 2) ? layer - 1 : 1;
            const float* gf = p.modv + (size_t)(lp * 2 + b) * 6144 + 5 * 1024;
#pragma unroll
            for (int i = 0; i < 4; ++i)
#pragma unroll
                for (int j = 0; j < 4; ++j) {
                    const int col = i * 256 + lane * 4 + j;
                    const float y0 = bf2f(p.y[(size_t)(2 * row) * DM + col]), y1 = bf2f(p.y[(size_t)(2 * row + 1) * DM + col]);
                    v[i * 4 + j] += gf[col] * (y0 + y1);
                }
            if (MODE == 2) {
#pragma unroll
                for (int i = 0; i < 4; ++i)
                    *(float4*)(p.out + (size_t)row * DM + i * 256 + lane * 4) = make_float4(v[i * 4], v[i * 4 + 1], v[i * 4 + 2], v[i * 4 + 3]);
            }
        }
        float ss = 0.f;
#pragma unroll
        for (int i = 0; i < 16; ++i) ss += v[i] * v[i];
        ss = wsum(ss);
        const float r = rsqrtf(ss * (1.0f / 1024.0f) + 1e-6f);
        if (MODE == 3) {
#pragma unroll
            for (int i = 0; i < 4; ++i) {
                const float4 g4 = *(const float4*)(p.final_norm + i * 256 + lane * 4);
                *(float4*)(p.out + (size_t)row * DM + i * 256 + lane * 4) =
                    make_float4(v[i * 4] * r * g4.x, v[i * 4 + 1] * r * g4.y, v[i * 4 + 2] * r * g4.z, v[i * 4 + 3] * r * g4.w);
            }
            continue;
        }
        const float* g = ((MODE == 1) ? p.norm_ffn : p.norm_mix) + layer * 1024;
        const float* mv = p.modv + (size_t)(layer * 2 + b) * 6144;
        const float* shift = mv + ((MODE == 1) ? 3 : 0) * 1024;
        const float* scale = mv + ((MODE == 1) ? 4 : 1) * 1024;
        float hv[16];
#pragma unroll
        for (int i = 0; i < 4; ++i)
#pragma unroll
            for (int j = 0; j < 4; ++j) {
                const int col = i * 256 + lane * 4 + j;
                hv[i * 4 + j] = v[i * 4 + j] * r * g[col] * (1.0f + scale[col]) + shift[col];
                p.h[(size_t)row * DM + col] = f2bf(hv[i * 4 + j]);
            }
        if (MODE == 1) {
            float lg[16];
#pragma unroll
            for (int e = 0; e < 16; ++e) lg[e] = 0.f;
#pragma unroll
            for (int i = 0; i < 4; ++i)
#pragma unroll
                for (int j = 0; j < 4; ++j) {
                    const int col = i * 256 + lane * 4 + j;
                    const float* rw = p.router_w + col * 16;
#pragma unroll
                    for (int e = 0; e < 16; ++e) lg[e] += hv[i * 4 + j] * rw[e];
                    asm volatile("" ::: "memory");
                }
#pragma unroll
            for (int e = 0; e < 16; ++e) lg[e] = wsum(lg[e]);
            float aff[16], bi[16];
#pragma unroll
            for (int e = 0; e < 16; ++e) { aff[e] = 1.0f / (1.0f + expf(-lg[e])); bi[e] = aff[e] + p.router_b[e]; }
            float bestsc = -3e38f; int be0 = 0, be1 = 1; float bw0 = 0.f, bw1 = 0.f;
#pragma unroll
            for (int gI = 0; gI < 4; ++gI) {
                int i1 = 0; float m1 = bi[gI * 4];
#pragma unroll
                for (int i = 1; i < 4; ++i) if (bi[gI * 4 + i] > m1) { m1 = bi[gI * 4 + i]; i1 = i; }
                int i2 = -1; float m2 = -3e38f;
#pragma unroll
                for (int i = 0; i < 4; ++i) if (i != i1 && bi[gI * 4 + i] > m2) { m2 = bi[gI * 4 + i]; i2 = i; }
                const float sc = m1 + m2;
                float a1 = 0.f, a2 = 0.f;
#pragma unroll
                for (int i = 0; i < 4; ++i) { a1 = (i == i1) ? aff[gI * 4 + i] : a1; a2 = (i == i2) ? aff[gI * 4 + i] : a2; }
                if (sc > bestsc) { bestsc = sc; be0 = gI * 4 + i1; be1 = gI * 4 + i2; bw0 = a1; bw1 = a2; }
            }
            if (lane == 0) {
                const float ws = bw0 + bw1;
                p.tokw[row * 2] = bw0 / ws; p.tokw[row * 2 + 1] = bw1 / ws;
                const int s_ = (it & 7) * 4 + wid;
                const int r0 = atomicAdd(&rl_cnt[be0], 1), r1 = atomicAdd(&rl_cnt[be1], 1);
                rl_ent[s_ * 2] = (row << 12) | (be0 << 8) | r0;
                rl_ent[s_ * 2 + 1] = (row << 12) | (be1 << 8) | r1;
            }
        }
        }
        if (MODE == 1 && ((it & 7) == 7 || it == niter - 1)) {
            __syncthreads();
            if (TIDX < 16) { const int c = rl_cnt[TIDX]; rl_base[TIDX] = c ? atomicAdd(&p.cnt[(layer * 16 + TIDX) * 32], c) : 0; rl_cnt[TIDX] = 0; }
            __syncthreads();
            if (TIDX < 64) {
                const int en = rl_ent[TIDX];
                if (en >= 0) { const int e = (en >> 8) & 15; p.list[e * T_TOK + rl_base[e] + (en & 255)] = (en >> 12) * 2 + (TIDX & 1); rl_ent[TIDX] = -1; }
            }
            __syncthreads();
        }
    }
}

__device__ __forceinline__ void st_kmean(const P& p, int wg, int nwg, float* sm) {
    const int TIDX = otid();
    const int wid = TIDX >> 6, lane = TIDX & 63;
    for (int w = wg; w < 2 * 8 * 32; w += nwg) {
        const int b = w >> 8, h = (w >> 5) & 7, j = w & 31;
        const bf16_t* kp = p.proj + (size_t)(b * SEQ + j * 256 + wid * 64) * 2840 + 1816 + h * 64 + lane;
        float s = 0.f;
#pragma unroll 16
        for (int i = 0; i < 64; ++i) s += bf2f(kp[(size_t)i * 2840]);
        __syncthreads();
        sm[TIDX] = s;
        __syncthreads();
        if (TIDX < 64) {
            const float m = ((sm[TIDX] + sm[64 + TIDX]) + (sm[128 + TIDX] + sm[192 + TIDX])) * (1.0f / 256.0f);
            p.kmean[(size_t)w * 64 + TIDX] = m;
            p.kmeanb[(size_t)w * 64 + TIDX] = f2bf(m);
        }
    }
}
__device__ __forceinline__ void st_mla_prep(const P& p, int wg, int nwg) {
    const int TIDX = otid();
    const int wid = TIDX >> 6, lane = TIDX & 63;
    for (int row = wg * 4 + wid; row < T_TOK; row += nwg * 4) {
        const int t = row & (SEQ - 1);
        const bf16_t* pr = p.proj1 + (size_t)row * 1216;
        float q[4], ss = 0.f;
#pragma unroll
        for (int i = 0; i < 4; ++i) { q[i] = bf2f(pr[i * 64 + lane]); ss += q[i] * q[i]; }
        ss = wsum(ss);
        float r = rsqrtf(ss * (1.0f / 256.0f) + 1e-6f);
#pragma unroll
        for (int i = 0; i < 4; ++i) p.cqn[(size_t)row * 384 + i * 64 + lane] = f2bf(q[i] * r * p.q_norm[i * 64 + lane]);
        float kvv[2]; ss = 0.f;
#pragma unroll
        for (int i = 0; i < 2; ++i) { kvv[i] = bf2f(pr[256 + i * 64 + lane]); ss += kvv[i] * kvv[i]; }
        ss = wsum(ss);
        r = rsqrtf(ss * (1.0f / 128.0f) + 1e-6f);
#pragma unroll
        for (int i = 0; i < 2; ++i) p.cqn[(size_t)row * 384 + 256 + i * 64 + lane] = f2bf(kvv[i] * r * p.kv_norm[i * 64 + lane]);
        if (lane < 32) {
            const float x1 = bf2f(pr[384 + lane]), x2 = bf2f(pr[384 + 32 + lane]);
            const float cs = p.ropec[t * 32 + lane], sn = p.ropes[t * 32 + lane];
            p.krope[(size_t)row * 64 + lane] = f2bf(x1 * cs - x2 * sn);
            p.krope[(size_t)row * 64 + 32 + lane] = f2bf(x1 * sn + x2 * cs);
        }
    }
}


typedef short bf16x8 __attribute__((ext_vector_type(8)));
typedef float f32x4 __attribute__((ext_vector_type(4)));
typedef unsigned u32x2 __attribute__((ext_vector_type(2)));
typedef unsigned u32x4v __attribute__((ext_vector_type(4)));
#define LDSP __attribute__((address_space(3)))
#define GEMM_LDS_BYTES 65536

__device__ __forceinline__ unsigned pack_bf16(float lo, float hi) { return (unsigned)f2bf(lo) | ((unsigned)f2bf(hi) << 16); }

template <class AR, class BR, class Epi>
__device__ __forceinline__ void gemm128(const int nk, const size_t akstep, const size_t bkstep, AR arow, BR brow, Epi epi, LDSP char* lds, const int tid) {
    const int wid = tid >> 6, lane = tid & 63, wr = wid >> 1, wc = wid & 1, fr = lane & 15, fq = lane >> 4;
    const int srow = tid >> 3, gch = ((tid & 7) ^ (srow & 7)) * 8;
    const bf16_t* ap0 = arow(srow) + gch; const bf16_t* ap1 = arow(32 + srow) + gch; const bf16_t* ap2 = arow(64 + srow) + gch; const bf16_t* ap3 = arow(96 + srow) + gch;
    const bf16_t* bp0 = brow(srow) + gch; const bf16_t* bp1 = brow(32 + srow) + gch; const bf16_t* bp2 = brow(64 + srow) + gch; const bf16_t* bp3 = brow(96 + srow) + gch;
    LDSP char* lw = lds + wid * 1024;
#define G128_ISSUE(st, kt) do { LDSP char* la_ = lw + (st) * 32768; const size_t ao_ = (size_t)(kt) * akstep, bo_ = (size_t)(kt) * bkstep; \
        __builtin_amdgcn_global_load_lds((const unsigned*)(ap0 + ao_), (LDSP unsigned*)(la_), 16, 0, 0); \
        __builtin_amdgcn_global_load_lds((const unsigned*)(ap1 + ao_), (LDSP unsigned*)(la_ + 4096), 16, 0, 0); \
        __builtin_amdgcn_global_load_lds((const unsigned*)(ap2 + ao_), (LDSP unsigned*)(la_ + 8192), 16, 0, 0); \
        __builtin_amdgcn_global_load_lds((const unsigned*)(ap3 + ao_), (LDSP unsigned*)(la_ + 12288), 16, 0, 0); \
        __builtin_amdgcn_global_load_lds((const unsigned*)(bp0 + bo_), (LDSP unsigned*)(la_ + 16384), 16, 0, 0); \
        __builtin_amdgcn_global_load_lds((const unsigned*)(bp1 + bo_), (LDSP unsigned*)(la_ + 16384 + 4096), 16, 0, 0); \
        __builtin_amdgcn_global_load_lds((const unsigned*)(bp2 + bo_), (LDSP unsigned*)(la_ + 16384 + 8192), 16, 0, 0); \
        __builtin_amdgcn_global_load_lds((const unsigned*)(bp3 + bo_), (LDSP unsigned*)(la_ + 16384 + 12288), 16, 0, 0); } while (0)
    f32x4 acc[4][4];
#pragma unroll
    for (int m = 0; m < 4; ++m)
#pragma unroll
        for (int n = 0; n < 4; ++n) acc[m][n] = (f32x4){0.f, 0.f, 0.f, 0.f};
    const int aoff = (wr * 64 + fr) * 128, boff = 16384 + (wc * 64 + fr) * 128, c0 = (fq ^ (fr & 7)) * 16;
    G128_ISSUE(0, 0);
    for (int kt = 0; kt < nk; ++kt) {
        const int cur = kt & 1;
        asm volatile("s_waitcnt vmcnt(0)" ::: "memory");
        __builtin_amdgcn_s_barrier();
        asm volatile("" ::: "memory");
        if (kt + 1 < nk) G128_ISSUE(cur ^ 1, kt + 1);
        LDSP char* sb = lds + cur * 32768;
#pragma unroll
        for (int kk = 0; kk < 2; ++kk) {
            const int cc = kk ? (c0 ^ 64) : c0;
            bf16x8 af[4], bf[4];
#pragma unroll
            for (int m = 0; m < 4; ++m) af[m] = *(const LDSP bf16x8*)(sb + aoff + m * 2048 + cc);
#pragma unroll
            for (int n = 0; n < 4; ++n) bf[n] = *(const LDSP bf16x8*)(sb + boff + n * 2048 + cc);
#pragma unroll
            for (int m = 0; m < 4; ++m)
#pragma unroll
                for (int n = 0; n < 4; ++n) acc[m][n] = __builtin_amdgcn_mfma_f32_16x16x32_bf16(bf[n], af[m], acc[m][n], 0, 0, 0);
        }
    }
    asm volatile("s_waitcnt lgkmcnt(0)" ::: "memory");
    __builtin_amdgcn_s_barrier();
    asm volatile("" ::: "memory");
#undef G128_ISSUE
#pragma unroll
    for (int m = 0; m < 4; ++m) epi(wr * 64 + m * 16 + fr, wc * 64 + fq * 4, acc[m]);
}

template <int MAP> __device__ __forceinline__ int conv_rowmap(int n) {
    if (MAP == 0) return n;
    const int tile = n >> 6, cc = n & 63, wc = cc >> 5, i16 = (cc >> 4) & 1, i = cc & 15;
    return tile * 128 + wc * 64 + ((MAP == 1 ? 0 : 2) + i16) * 16 + i;
}
template <int MAP>
__device__ __forceinline__ void conv_batched(const float* src, int nmat, int K, int N, size_t sstride, bf16_t* dst, size_t dstride, int wg, int nwg, float* sm, int tid, int wend = 0x7fffffff) {
    float(*t)[65] = (float(*)[65])sm;
    const int tk = K >> 6, tn = (N + 63) >> 6, per = tk * tn, total = (nmat * per < wend) ? nmat * per : wend;
    f32x4 v[4];
    auto ld = [&](int w) {
        const int mat = w / per, r = w % per, kt = r / tn, nt = r % tn;
        const float* s = src + (size_t)mat * sstride;
#pragma unroll
        for (int i = 0; i < 4; ++i) {
            const int idx = tid + 256 * i, k = idx >> 4, n = (idx & 15) * 4;
            v[i] = (f32x4){0.f, 0.f, 0.f, 0.f};
            if (nt * 64 + n < N) v[i] = *(const f32x4*)(s + (size_t)(kt * 64 + k) * N + nt * 64 + n);
        }
    };
    if (wg < total) ld(wg);
    for (int w = wg; w < total; w += nwg) {
        const int mat = w / per, r = w % per, kt = r / tn, nt = r % tn;
        bf16_t* d = dst + (size_t)mat * dstride;
#pragma unroll
        for (int i = 0; i < 4; ++i) {
            const int idx = tid + 256 * i, k = idx >> 4, n = (idx & 15) * 4;
            t[k][n] = v[i][0]; t[k][n + 1] = v[i][1]; t[k][n + 2] = v[i][2]; t[k][n + 3] = v[i][3];
        }
        __syncthreads();
        if (w + nwg < total) ld(w + nwg);
        {
            const int n = tid >> 2, kq = (tid & 3) * 16;
            if (nt * 64 + n < N) {
                unsigned pk[8];
#pragma unroll
                for (int j = 0; j < 8; ++j) pk[j] = cvtpk(t[kq + 2 * j][n], t[kq + 2 * j + 1][n]);
                bf16_t* o = d + (size_t)conv_rowmap<MAP>(nt * 64 + n) * K + kt * 64 + kq;
                *(u32x4v*)o = (u32x4v){pk[0], pk[1], pk[2], pk[3]};
                *(u32x4v*)(o + 8) = (u32x4v){pk[4], pk[5], pk[6], pk[7]};
            }
        }
        __syncthreads();
    }
}
__device__ __forceinline__ void st_convert(const P& p, int wg, int nwg, float* sm) {
    const int tid = otid();
    conv_batched<0>(p.ev_w_in, 1, 1024, 2840, 0, p.wt_in0, 0, wg, nwg, sm, tid);
    conv_batched<0>(p.ev_w_out, 1, 1024, 1024, 0, p.wt_out0, 0, wg, nwg, sm, tid);
    conv_batched<0>(p.ck_w1, 1, 2048, 256, 0, p.wt_c1, 0, wg, nwg, sm, tid);
    conv_batched<0>(p.cv_w1, 1, 2048, 256, 0, p.wt_c1 + 256 * 2048, 0, wg, nwg, sm, tid);
    conv_batched<0>(p.ck_w2, 1, 256, 64, 0, p.wt_c2, 0, wg, nwg, sm, tid);
    conv_batched<0>(p.cv_w2, 1, 256, 64, 0, p.wt_c2 + 64 * 256, 0, wg, nwg, sm, tid);
    conv_batched<0>(p.od_w_in, 1, 1024, 1216, 0, p.wt_in1, 0, wg, nwg, sm, tid);
    conv_batched<0>(p.od_w_out, 1, 1024, 1024, 0, p.wt_out1, 0, wg, nwg, sm, tid);
    conv_batched<0>(p.w_q_up, 1, 256, 768, 0, p.wt_qup, 0, wg, nwg, sm, tid);
    conv_batched<0>(p.w_kv_up, 1, 128, 1024, 0, p.wt_kvup, 0, wg, nwg, sm, tid);
    {
        const int wid = tid >> 6, lane = tid & 63;
        for (int w = wg * 4 + wid; w < 512; w += nwg * 4) {
            const int which = w >> 8, cg = (w >> 6) & 3, ks = w & 63, col = cg * 64 + lane;
            const float* w1 = (which ? p.cv_w1 : p.ck_w1) + (size_t)(ks * 32) * 256 + col; const float* pos = (which ? p.pos_v : p.pos_k) + ks * 32;
            float a = 0.f;
#pragma unroll
            for (int k = 0; k < 32; ++k) a += pos[k] * w1[(size_t)k * 256];
            p.c1p[(which * 64 + ks) * 256 + col] = a;
        }
    }
}
__device__ __forceinline__ void st_c1_reduce(const P& p, int wg, int nwg) {
    const int tid = otid();
    for (int i = wg * 256 + tid; i < 512; i += nwg * 256) {
        const int which = i >> 8, col = i & 255;
        float a = 0.f;
#pragma unroll 16
        for (int ks = 0; ks < 64; ++ks) a += p.c1p[(which * 64 + ks) * 256 + col];
        p.c1[i] = a;
    }
}


struct XcdOrder {
    int xcd, lw, nlw, tn, per;
    __device__ __forceinline__ XcdOrder(int wg, int nwg, int nM, int tn_) : xcd(wg & 7), lw(wg >> 3), nlw(nwg >> 3), tn(tn_), per((nM >> 3) * tn_) {}
    __device__ __forceinline__ bool get(int k, int& mt, int& nt) const { const int lt = lw + k * nlw; if (lt >= per) return false; mt = xcd + 8 * (lt / tn); nt = lt % tn; return true; }
};
__device__ __forceinline__ void st_inproj0_mf(const P& p, int wg, int nwg, LDSP char* lds) {
    const int tid = otid();
    const XcdOrder ord(wg, nwg, 128, 23);
    for (int k = 0;; ++k) {
        int mt, nt;
        if (!ord.get(k, mt, nt)) break;
        gemm128(16, 64, 64,
            [&](int r) { return p.h + (size_t)(mt * 128 + r) * DM; },
            [&](int r) { int n = nt * 128 + r; n = n < 2840 ? n : 2839; return p.wt_in0 + (size_t)n * 1024; },
            [&](int rl, int cl, const f32x4 (&a)[4]) {
                const int row = mt * 128 + rl;
#pragma unroll
                for (int n = 0; n < 4; ++n) {
                    const int col = nt * 128 + cl + n * 16;
                    if (col < 2840) {
                        *(u32x2*)(p.proj + (size_t)row * 2840 + col) = (u32x2){pack_bf16(a[n][0], a[n][1]), pack_bf16(a[n][2], a[n][3])};
                        if (col >= 1280 && col < 1304)
                            *(f32x4*)(p.gates + (size_t)row * 24 + (col - 1280)) = (f32x4){sigmf(a[n][0]), sigmf(a[n][1]), sigmf(a[n][2]), sigmf(a[n][3])};
                    }
                }
            }, lds, tid);
    }
}
__device__ __forceinline__ void st_cmp1_mf(const P& p, int wg, int nwg, LDSP char* lds) {
    const int tid = otid();
    for (int w = wg; w < 2 * 16 * 2; w += nwg) {
        const int which = w >> 5, mt = (w >> 1) & 15, nt = w & 1;
        const int colbase = which ? 640 : 512;
        gemm128(32, 2840, 64,
            [&](int r) { int m = mt * 128 + r; m = m < 2044 ? m : 2043; const int bk = m / 511, n = m % 511, b = bk >> 1, kv = bk & 1;
                         return p.proj + (size_t)(b * SEQ + 16 * n) * 2840 + colbase + kv * 64; },
            [&](int r) { return p.wt_c1 + (size_t)(which * 256 + nt * 128 + r) * 2048; },
            [&](int rl, int cl, const f32x4 (&a)[4]) {
                const int m = mt * 128 + rl;
                if (m < 2044) {
#pragma unroll
                    for (int n = 0; n < 4; ++n) {
                        const int col = nt * 128 + cl + n * 16;
                        const f32x4 cb = *(const f32x4*)(p.c1 + which * 256 + col);
                        *(u32x2*)(p.chidb + (size_t)(which * 2048 + m) * 256 + col) =
                            (u32x2){pack_bf16(gelu_tanh(a[n][0] + cb[0]), gelu_tanh(a[n][1] + cb[1])), pack_bf16(gelu_tanh(a[n][2] + cb[2]), gelu_tanh(a[n][3] + cb[3]))};
                    }
                }
            }, lds, tid);
    }
}
__device__ __forceinline__ void st_cmp2_mf(const P& p, int wg, int nwg, LDSP char* lds) {
    const int tid = otid();
    for (int w = wg; w < 2 * 16; w += nwg) {
        const int which = w >> 4, mt = w & 15;
        gemm128(4, 64, 64,
            [&](int r) { int m = mt * 128 + r; m = m < 2044 ? m : 2043; return p.chidb + (size_t)(which * 2048 + m) * 256; },
            [&](int r) { return p.wt_c2 + (size_t)(which * 64 + (r & 63)) * 256; },
            [&](int rl, int cl, const f32x4 (&a)[4]) {
                const int m = mt * 128 + rl;
                if (m < 2044) {
#pragma unroll
                    for (int n = 0; n < 4; ++n) { const int col = cl + n * 16; if (col < 64) {
                        const int bk = m / 511, nn = m % 511;
                        *(u32x2*)(p.kcmpb + ((size_t)((which * 4 + bk) * 512 + nn)) * 64 + col) = (u32x2){cvtpk(a[n][0], a[n][1]), cvtpk(a[n][2], a[n][3])}; } }
                }
            }, lds, tid);
    }
}
__device__ __forceinline__ void st_outproj_mf(const P& p, int layer, int wg, int nwg, LDSP char* lds) {
    const int tid = otid();
    const bf16_t* W = layer ? p.wt_out1 : p.wt_out0;
    const float* xin = layer ? p.out : p.x;
    const XcdOrder ord(wg, nwg, 128, 8);
    for (int k = 0;; ++k) {
        int mt, nt;
        if (!ord.get(k, mt, nt)) break;
        gemm128(16, 64, 64,
            [&](int r) { return p.o + (size_t)(mt * 128 + r) * DM; },
            [&](int r) { return W + (size_t)(nt * 128 + r) * 1024; },
            [&](int rl, int cl, const f32x4 (&a)[4]) {
                const int row = mt * 128 + rl, b = row >> 13;
                const float* g = p.modv + (size_t)(layer * 2 + b) * 6144 + 2 * 1024;
#pragma unroll
                for (int n = 0; n < 4; ++n) {
                    const int col = nt * 128 + cl + n * 16;
                    const f32x4 xv = *(const f32x4*)(xin + (size_t)row * DM + col), gv = *(const f32x4*)(g + col);
                    *(f32x4*)(p.out + (size_t)row * DM + col) = xv + gv * a[n];
                }
            }, lds, tid);
    }
}
__device__ __forceinline__ bool moe_tile128(const int* cnt, int tt, int& e, int& i0, int& off) {
    int acc = 0, o = 0;
    for (int q = 0; q < 16; ++q) {
        const int c = cnt[q * 32], nt = (c + 127) >> 7;
        if (tt < acc + nt) { e = q; i0 = (tt - acc) * 128; off = o; return true; }
        acc += nt; o += c;
    }
    return false;
}
__device__ __forceinline__ void st_moe_up_mf(const P& p, int layer, int wg, int nwg, LDSP char* lds) {
    const int tid = otid();
    const int* cnt = p.cnt + layer * 512;
    for (int w = wg;; w += nwg) {
        int e, i0, off;
        if (!moe_tile128(cnt, w >> 3, e, i0, off)) break;
        const int nt = w & 7, ce = cnt[e * 32];
        const int* lst = p.list + e * T_TOK;
        const bf16_t* B = p.wt_gu + ((size_t)(layer * 16 + e) * 1024 + nt * 128) * 1024;
        gemm128(16, 64, 64,
            [&](int r) { const int i = (i0 + r < ce) ? i0 + r : i0; return p.h + (size_t)(lst[i] >> 1) * DM; },
            [&](int r) { return B + (size_t)r * 1024; },
            [&](int rl, int cl, const f32x4 (&a)[4]) {
                if (i0 + rl < ce) {
                    const int wc = cl >> 6, fq4 = cl & 63;
#pragma unroll
                    for (int n = 0; n < 2; ++n) {
                        const int col = nt * 64 + wc * 32 + n * 16 + fq4;
                        const f32x4 g = a[n], u = a[n + 2];
                        *(u32x2*)(p.hid + (size_t)(off + i0 + rl) * 512 + col) =
                            (u32x2){pack_bf16(siluf(g[0]) * u[0], siluf(g[1]) * u[1]), pack_bf16(siluf(g[2]) * u[2], siluf(g[3]) * u[3])};
                    }
                }
            }, lds, tid);
    }
}
__device__ __forceinline__ void st_moe_down_mf(const P& p, int layer, int wg, int nwg, LDSP char* lds) {
    const int tid = otid();
    const int* cnt = p.cnt + layer * 512;
    for (int w = wg;; w += nwg) {
        int e, i0, off;
        if (!moe_tile128(cnt, w >> 3, e, i0, off)) break;
        const int nt = w & 7, ce = cnt[e * 32];
        const int* lst = p.list + e * T_TOK;
        const bf16_t* B = p.wt_d + ((size_t)(layer * 16 + e) * 1024 + nt * 128) * 512;
        gemm128(8, 64, 64,
            [&](int r) { const int i = (i0 + r < ce) ? i0 + r : i0; return p.hid + (size_t)(off + i) * 512; },
            [&](int r) { return B + (size_t)r * 512; },
            [&](int rl, int cl, const f32x4 (&a)[4]) {
                if (i0 + rl < ce) {
                    const int id = lst[i0 + rl]; const float wt = p.tokw[id];
#pragma unroll
                    for (int n = 0; n < 4; ++n) {
                        const int col = nt * 128 + cl + n * 16;
                        *(u32x2*)(p.y + (size_t)id * DM + col) = (u32x2){pack_bf16(wt * a[n][0], wt * a[n][1]), pack_bf16(wt * a[n][2], wt * a[n][3])};
                    }
                }
            }, lds, tid);
    }
}
__device__ __forceinline__ void st_inproj1_mf(const P& p, int wg, int nwg, LDSP char* lds) {
    const int tid = otid();
    const XcdOrder ord(wg, nwg, 128, 10);
    for (int k = 0;; ++k) {
        int mt, nt;
        if (!ord.get(k, mt, nt)) break;
        gemm128(16, 64, 64,
            [&](int r) { return p.h + (size_t)(mt * 128 + r) * DM; },
            [&](int r) { int n = nt * 128 + r; n = n < 1216 ? n : 1215; return p.wt_in1 + (size_t)n * 1024; },
            [&](int rl, int cl, const f32x4 (&a)[4]) {
                const int row = mt * 128 + rl;
#pragma unroll
                for (int n = 0; n < 4; ++n) {
                    const int col = nt * 128 + cl + n * 16;
                    if (col < 1216) *(u32x2*)(p.proj1 + (size_t)row * 1216 + col) = (u32x2){pack_bf16(a[n][0], a[n][1]), pack_bf16(a[n][2], a[n][3])};
                }
            }, lds, tid);
    }
}
__device__ __forceinline__ void st_mla_up_mf(const P& p, int wg, int nwg, LDSP char* lds) {
    const int tid = otid();
    const XcdOrder ord(wg, nwg, 128, 14);
    for (int k = 0;; ++k) {
        int mt, c;
        if (!ord.get(k, mt, c)) break;
        if (c < 6) {
            gemm128(4, 64, 64,
                [&](int r) { return p.cqn + (size_t)(mt * 128 + r) * 384; },
                [&](int r) { return p.wt_qup + (size_t)(c * 128 + r) * 256; },
                [&](int rl, int cl, const f32x4 (&a)[4]) {
                    const int row = mt * 128 + rl, wc = cl >> 6;
                    f32x4 v[4] = {a[0], a[1], a[2], a[3]};
                    if (((c == 1 || c == 4) && wc == 0) || ((c == 2 || c == 5) && wc == 1)) {
                        const int t = row & (SEQ - 1), i0 = cl & 63;
#pragma unroll
                        for (int n = 0; n < 2; ++n) {
                            const f32x4 cs = *(const f32x4*)(p.ropec + t * 32 + n * 16 + i0), sn = *(const f32x4*)(p.ropes + t * 32 + n * 16 + i0);
                            v[n] = a[n] * cs - a[n + 2] * sn; v[n + 2] = a[n] * sn + a[n + 2] * cs;
                        }
                    }
#pragma unroll
                    for (int n = 0; n < 4; ++n) *(u32x2*)(p.qmla + (size_t)row * 768 + c * 128 + cl + n * 16) = (u32x2){cvtpk(v[n][0], v[n][1]), cvtpk(v[n][2], v[n][3])};
                }, lds, tid);
        } else {
            gemm128(2, 64, 64,
                [&](int r) { return p.cqn + (size_t)(mt * 128 + r) * 384 + 256; },
                [&](int r) { return p.wt_kvup + (size_t)((c - 6) * 128 + r) * 128; },
                [&](int rl, int cl, const f32x4 (&a)[4]) {
                    const int row = mt * 128 + rl;
#pragma unroll
                    for (int n = 0; n < 4; ++n) *(u32x2*)(p.kvmla + (size_t)row * 1024 + (c - 6) * 128 + cl + n * 16) = (u32x2){pack_bf16(a[n][0], a[n][1]), pack_bf16(a[n][2], a[n][3])};
                }, lds, tid);
        }
    }
}

typedef float f32x16 __attribute__((ext_vector_type(16)));
typedef short s16x4 __attribute__((ext_vector_type(4)));
#define ATT_NEG (-1e30f)
#define ATT_SHIFT (-16.0f)
#define LOG2E 1.4426950408889634f

__device__ __forceinline__ int swz128(int row) { return (((row >> 1) & 1) << 2) | ((row >> 2) & 3); }
__device__ __forceinline__ int swz256(int row) { return ((row & 3) << 2) | ((row >> 2) & 3); }

struct AttLane {
    int kbase;
    int v0[2];
};
template <int KROWB, int VROWB, int DT>
__device__ __forceinline__ void att_lane_init(AttLane& L, int lane) {
    const int q = lane & 31, hh = lane >> 5, x = hh ^ swz128(q);
    L.kbase = q * KROWB + x * 16;
    const int rl = 4 * hh + ((lane & 15) >> 2), blk = (lane >> 4) & 1, pp = lane & 3;
#pragma unroll
    for (int t = 0; t < 2; ++t) {
        const int g = (VROWB == 256) ? (((rl & 3) << 2) | ((2 * t + hh) & 3)) : ((((rl >> 1) & 1) << 2) | ((2 * t + hh) & 3));
        L.v0[t] = rl * VROWB + (((2 * blk + (pp >> 1)) ^ g) * 16) + 8 * (pp & 1);
    }
}
template <int KS, int KROWB, int MODE, bool WANT_P, bool IMP>
__device__ __forceinline__ void att_qk(LDSP const char* kb, const AttLane& L, const bf16x8 (&qf)[KS], bf16x8 (&pf)[4], float& lsum, const float c1, const float cadd,
                                       const unsigned lutv, const int dq16, LDSP float* improw, const float invl) {
    float la = 0.f, lb = 0.f, lc = 0.f, ld = 0.f;
#pragma unroll
    for (int kt = 0; kt < 2; ++kt) {
        f32x16 s;
#pragma unroll
        for (int r = 0; r < 16; ++r) s[r] = 0.f;
        constexpr int KG = (KS > 4) ? 2 : 4;
#pragma unroll
        for (int k4 = 0; k4 < KS; k4 += KG) {
            bf16x8 a[KG];
#pragma unroll
            for (int j = 0; j < KG; ++j) { const int ks = k4 + j; a[j] = *(const LDSP bf16x8*)(kb + (L.kbase ^ (32 * (ks & 3))) + (ks >> 2) * 128 + kt * 32 * KROWB); }
#pragma unroll
            for (int j = 0; j < KG; ++j) s = __builtin_amdgcn_mfma_f32_32x32x16_bf16(a[j], qf[k4 + j], s, 0, 0, 0);
            asm volatile("" ::: "memory");
        }
        float pr[16];
#pragma unroll
        for (int r = 0; r < 16; ++r) {
            const int koff = 32 * kt + (r & 3) + 8 * (r >> 2);
            float add = cadd;
            if (MODE == 1) add = *(const LDSP float*)(lutv + (63 - koff) * 4);
            if (MODE == 2) { int d = dq16 - 16 * koff; d = d < -1 ? -1 : d; d = d > 1087 ? 1087 : d; add = *(const LDSP float*)(lutv + (unsigned)(64 + d) * 4u); }
            pr[r] = __builtin_amdgcn_exp2f(__builtin_fmaf(s[r], c1, add));
        }
#pragma unroll
        for (int r = 0; r < 16; r += 4) { la += pr[r]; lb += pr[r + 1]; lc += pr[r + 2]; ld += pr[r + 3]; }
        if (IMP) {
#pragma unroll
            for (int g = 0; g < 4; ++g) {
                (void)__hip_atomic_fetch_add((LDSP unsigned*)improw + 8 * kt + 2 * g, (unsigned)(((pr[4 * g] + pr[4 * g + 1]) + (pr[4 * g + 2] + pr[4 * g + 3])) * invl + 0.5f), __ATOMIC_RELAXED, __HIP_MEMORY_SCOPE_WORKGROUP);
                (void)__hip_atomic_fetch_add((LDSP unsigned*)improw + 8 * kt + 2 * g + 1, (unsigned)(pr[4 * g + 3] * invl + 0.5f), __ATOMIC_RELAXED, __HIP_MEMORY_SCOPE_WORKGROUP);
            }
        }
        if (WANT_P) {
#pragma unroll
            for (int sI = 0; sI < 2; ++sI) {
                union { unsigned u[4]; bf16x8 v; } cv;
#pragma unroll
                for (int i = 0; i < 4; ++i) cv.u[i] = cvtpk(pr[8 * sI + 2 * i], pr[8 * sI + 2 * i + 1]);
                pf[kt * 2 + sI] = cv.v;
            }
        }
    }
    lsum += (la + lb) + (lc + ld);
}
template <int DT, int VROWB>
__device__ __forceinline__ void att_pv(LDSP const char* vb, const AttLane& L, const bf16x8 (&pf)[4], f32x16 (&o)[DT]) {
    const unsigned vba = (unsigned)(size_t)vb;
#pragma unroll
    for (int ks2 = 0; ks2 < 4; ++ks2) {
#pragma unroll
        for (int d0 = 0; d0 < DT; d0 += 2) {
            s16x4 lo[2], hi[2];
#pragma unroll
            for (int j = 0; j < 2; ++j) {
                asm volatile("ds_read_b64_tr_b16 %0, %1 offset:%2" : "=v"(lo[j]) : "v"(vba + (L.v0[0] ^ ((d0 + j) << 6))), "i"((16 * ks2) * VROWB) : "memory");
                asm volatile("ds_read_b64_tr_b16 %0, %1 offset:%2" : "=v"(hi[j]) : "v"(vba + (L.v0[1] ^ ((d0 + j) << 6))), "i"((16 * ks2 + 8) * VROWB) : "memory");
            }
            asm volatile("s_waitcnt lgkmcnt(0)" ::: "memory");
#pragma unroll
            for (int j = 0; j < 2; ++j) {
                asm volatile("" : "+v"(lo[j]), "+v"(hi[j]));
                const bf16x8 vf = __builtin_shufflevector(lo[j], hi[j], 0, 1, 2, 3, 4, 5, 6, 7);
                o[d0 + j] = __builtin_amdgcn_mfma_f32_32x32x16_bf16(vf, pf[ks2], o[d0 + j], 0, 0, 0);
            }
        }
    }
}
template <int CPR>
__device__ __forceinline__ void att_stage_map(int (&rowc)[(CPR == 24) ? 6 : 1], int tid) {
    if (CPR == 24) {
#pragma unroll
        for (int i = 0; i < 6; ++i) {
            const int c = tid + 256 * i, row = c / 24, cc = c % 24;
            rowc[i % ((CPR == 24) ? 6 : 1)] = (row << 8) | ((cc & ~7) | ((cc & 7) ^ swz128(row)));
        }
    } else if (CPR == 16) {
        const int row = tid >> 4; rowc[0] = (row << 8) | ((tid & 15) ^ swz256(row));
    } else {
        const int row = tid >> 3; rowc[0] = (row << 8) | ((tid & 7) ^ swz128(row));
    }
}
template <int CPR, class SRC>
__device__ __forceinline__ void att_stage(LDSP char* dst, SRC src, const int (&rowc)[(CPR == 24) ? 6 : 1], int wid) {
#pragma unroll
    for (int i = 0; i < CPR / 4; ++i) {
        const int rc = rowc[(CPR == 24) ? i : 0];
        const int row = (rc >> 8) + ((CPR == 24) ? 0 : i * (256 / CPR));
        __builtin_amdgcn_global_load_lds((const unsigned*)src(row, rc & 255), (LDSP unsigned*)(dst + (256 * i + 64 * wid) * 16), 16, 0, 0);
    }
}
__device__ __forceinline__ int wq_next(int* ctr, LDSP int* slot, int tid) {
    __syncthreads();
    if (tid == 0) *slot = atomicAdd(ctr, 1);
    __syncthreads();
    return *slot;
}

__device__ __forceinline__ void build_lut(LDSP float* tab, const float* blut_h, int n, int wlimit, int tid) {
    for (int i = tid; i < n; i += 256) { const int d = i - 64; tab[i] = (d < 0 || d >= wlimit) ? ATT_NEG : blut_h[d > 1023 ? 1023 : d] * LOG2E + ATT_SHIFT; }
}
#define ATT_BAR() do { __builtin_amdgcn_s_barrier(); asm volatile("" ::: "memory"); } while (0)

__device__ __forceinline__ void mla_item(const P& p, const int item, LDSP char* lds, const int tid0) {
    LDSP char* kb = lds; LDSP char* vb = lds + 24576; LDSP float* lut = (LDSP float*)(lds + 40960);
    const float c1 = 0.07216878364870322f * LOG2E;
    int tid = tid0; asm volatile("" : "+v"(tid));
    const int wid = tid >> 6, lane = tid & 63, q = lane & 31, hh = lane >> 5;
    AttLane L; att_lane_init<384, 256, 4>(L, lane);
    int krc[6], vrc[1];
    att_stage_map<24>(krc, tid); att_stage_map<16>(vrc, tid);
    int qt, bh, part;
    if (item >= 640) { const int r = item - 640; qt = 15 - (r >> 3); bh = r & 7; part = 0; }
    else {
        int g = 0; while (16 * (g + 1) + 8 * ((g + 2) >> 1) <= item) ++g;
        const int r = item - (16 * g + 8 * ((g + 1) >> 1)), Ln = 64 - g;
        if (r < 16) { qt = Ln - 1; bh = r & 7; part = 1 + (r >> 3); } else { qt = (Ln >> 1) - 1; bh = (r - 16) & 7; part = 0; }
    }
    const int b = bh >> 2, h = bh & 3;
    const int tw = qt * 128 + wid * 32;
    bf16x8 qf[12];
    {
        const bf16_t* qp = p.qmla + (size_t)(b * SEQ + tw + q) * 768 + h * 192 + 8 * hh;
#pragma unroll
        for (int ks = 0; ks < 12; ++ks) qf[ks] = *(const bf16x8*)(qp + 16 * ks);
    }
    f32x16 o[4];
#pragma unroll
    for (int dt = 0; dt < 4; ++dt)
#pragma unroll
        for (int r = 0; r < 16; ++r) o[dt][r] = 0.f;
    float lsum = 0.f;
    const int i0 = (part == 2) ? qt + 1 : 0, ntiles = (part == 1) ? qt + 1 : 2 * qt + 2;
    const bf16_t* kvb = p.kvmla + (size_t)b * SEQ * 1024 + h * 256;
    const bf16_t* krb = p.krope + (size_t)b * SEQ * 64;
    auto ksrc = [&](int pos0) { return [=](int row, int gc) { return gc < 16 ? kvb + (size_t)(pos0 + row) * 1024 + gc * 8 : krb + (size_t)(pos0 + row) * 64 + (gc - 16) * 8; }; };
    auto vsrc = [&](int pos0) { return [=](int row, int gc) { return kvb + (size_t)(pos0 + row) * 1024 + 128 + gc * 8; }; };
    att_stage<24>(kb, ksrc(i0 * 64), krc, wid);
    for (int i = i0; i < ntiles; ++i) {
        const int pos0 = i * 64;
        asm volatile("s_waitcnt vmcnt(0)" ::: "memory"); ATT_BAR();
        att_stage<16>(vb, vsrc(pos0), vrc, wid);
        const bool active = pos0 <= tw + 31, diag = pos0 + 63 > tw;
        bf16x8 pf[4];
        if (active) {
            if (diag) {
                int dq = tw + q - pos0 - 4 * hh; dq = dq < -1 ? -1 : dq;
                att_qk<12, 384, 1, true, false>(kb, L, qf, pf, lsum, c1, 0.f, (unsigned)(size_t)lut + (unsigned)(dq + 1) * 4u, 0, nullptr, 0.f);
            } else att_qk<12, 384, 0, true, false>(kb, L, qf, pf, lsum, c1, ATT_SHIFT, 0u, 0, nullptr, 0.f);
        }
        asm volatile("s_waitcnt vmcnt(0) lgkmcnt(0)" ::: "memory"); ATT_BAR();
        if (i + 1 < ntiles) att_stage<24>(kb, ksrc(pos0 + 64), krc, wid);
        if (active) att_pv<4, 256>(vb, L, pf, o);
    }
    const float lt = lsum + __shfl_xor(lsum, 32);
    int tid2 = tid0; asm volatile("" : "+v"(tid2));
    const int lane2 = tid2 & 63, trow = qt * 128 + (tid2 >> 6) * 32 + (lane2 & 31);
    bf16_t* op; float inv;
    if (part == 0) { inv = 1.0f / lt; op = p.o + (size_t)(b * SEQ + trow) * DM + h * 128 + 4 * (lane2 >> 5); }
    else {
        const size_t rec = (size_t)((part - 1) * 8 + bh) * (SEQ / 2) + (trow - SEQ / 2);
        inv = 1.0f; op = p.mlap + rec * 128 + 4 * (lane2 >> 5);
        if (lane2 < 32) p.mlal[rec] = lt;
    }
#pragma unroll
    for (int dt = 0; dt < 4; ++dt)
#pragma unroll
        for (int rq = 0; rq < 4; ++rq)
            *(u32x2*)(op + 32 * dt + 8 * rq) = (u32x2){cvtpk(o[dt][4 * rq] * inv, o[dt][4 * rq + 1] * inv), cvtpk(o[dt][4 * rq + 2] * inv, o[dt][4 * rq + 3] * inv)};
}
__device__ __forceinline__ void st_mla_combine(const P& p, int wg, int nwg) {
    const int TIDX = otid();
    const int wid = TIDX >> 6, lane = TIDX & 63;
    for (int w = wg * 4 + wid; w < 8 * (SEQ / 2); w += nwg * 4) {
        const int bh = w / (SEQ / 2), t = SEQ / 2 + w % (SEQ / 2), b = bh >> 2, h = bh & 3;
        const size_t r0 = (size_t)w, r1 = (size_t)(8 * (SEQ / 2) + w);
        const float inv = 1.0f / (p.mlal[r0] + p.mlal[r1]);
        const unsigned a = *(const unsigned*)(p.mlap + r0 * 128 + lane * 2), c = *(const unsigned*)(p.mlap + r1 * 128 + lane * 2);
        const float x0 = __uint_as_float(a << 16) + __uint_as_float(c << 16), x1 = __uint_as_float(a & 0xffff0000u) + __uint_as_float(c & 0xffff0000u);
        *(unsigned*)(p.o + (size_t)(b * SEQ + t) * DM + h * 128 + lane * 2) = cvtpk(x0 * inv, x1 * inv);
    }
}

__device__ __forceinline__ void swa_item(const P& p, const int item, LDSP char* lds, const int tid0) {
    LDSP char* kb = lds; LDSP char* vb = lds + 8192; LDSP float* luts = (LDSP float*)(lds + 46080);
    const float c1 = 0.125f * LOG2E;
    int tid = tid0; asm volatile("" : "+v"(tid));
    const int wid = tid >> 6, lane = tid & 63, q = lane & 31, hh = lane >> 5;
    AttLane L; att_lane_init<128, 128, 2>(L, lane);
    int rc[1]; att_stage_map<8>(rc, tid);
    const int b = item >> 9, kvh = (item >> 8) & 1, t0 = (item & 255) * 32, head = kvh * 4 + wid;
    bf16x8 qf[4];
    {
        const bf16_t* qp = p.proj1 + (size_t)(b * SEQ + t0 + q) * 1216 + 448 + head * 64 + 8 * hh;
#pragma unroll
        for (int ks = 0; ks < 4; ++ks) qf[ks] = *(const bf16x8*)(qp + 16 * ks);
    }
    f32x16 o[2];
#pragma unroll
    for (int dt = 0; dt < 2; ++dt)
#pragma unroll
        for (int r = 0; r < 16; ++r) o[dt][r] = 0.f;
    float lsum = 0.f;
    const bf16_t* kbp = p.proj1 + (size_t)b * SEQ * 1216 + 960 + kvh * 64;
    const bf16_t* zr = p.zrow;
    auto ksrc = [&](int pos0) { return [=](int row, int gc) { const int pos = pos0 + row; return (pos >= 0 && pos < SEQ) ? kbp + (size_t)pos * 1216 + gc * 8 : zr + gc * 8; }; };
    auto vsrc = [&](int pos0) { return [=](int row, int gc) { const int pos = pos0 + row; return (pos >= 0 && pos < SEQ) ? kbp + (size_t)pos * 1216 + 128 + gc * 8 : zr + gc * 8; }; };
    const unsigned tab = (unsigned)(size_t)(luts + head * 256);
    att_stage<8>(kb, ksrc(t0 - 128), rc, wid);
    for (int i = 0; i < 3; ++i) {
        const int pos0 = t0 - 128 + 64 * i;
        asm volatile("s_waitcnt vmcnt(0)" ::: "memory"); ATT_BAR();
        att_stage<8>(vb, vsrc(pos0), rc, wid);
        bf16x8 pf[4];
        int dq = t0 + q - pos0 - 4 * hh; dq = dq < -1 ? -1 : dq;
        att_qk<4, 128, 1, true, false>(kb, L, qf, pf, lsum, c1, 0.f, tab + (unsigned)(dq + 1) * 4u, 0, nullptr, 0.f);
        asm volatile("s_waitcnt vmcnt(0) lgkmcnt(0)" ::: "memory"); ATT_BAR();
        if (i + 1 < 3) att_stage<8>(kb, ksrc(pos0 + 64), rc, wid);
        att_pv<2, 128>(vb, L, pf, o);
    }
    const float lt = lsum + __shfl_xor(lsum, 32) + __builtin_amdgcn_exp2f(p.sinks[head] * LOG2E + ATT_SHIFT);
    const float inv = 1.0f / lt;
    bf16_t* op = p.o + (size_t)(b * SEQ + t0 + q) * DM + 512 + head * 64 + 4 * hh;
#pragma unroll
    for (int dt = 0; dt < 2; ++dt)
#pragma unroll
        for (int rq = 0; rq < 4; ++rq)
            *(u32x2*)(op + 32 * dt + 8 * rq) = (u32x2){cvtpk(o[dt][4 * rq] * inv, o[dt][4 * rq + 1] * inv), cvtpk(o[dt][4 * rq + 2] * inv, o[dt][4 * rq + 3] * inv)};
}
__device__ __forceinline__ void moe_conv_item(const P& p, const int layer, const int item, LDSP char* lds, const int tid0) {
    float* sm = (float*)lds;
    const int set = item >> 8, t0 = (item & 255) * 8;
    if (set == 0) conv_batched<1>(p.moe_wg + (size_t)layer * 16 * 1024 * 512, 16, 1024, 512, (size_t)1024 * 512, p.wt_gu + (size_t)layer * 16 * 1024 * 1024, (size_t)1024 * 1024, t0, 1, sm, tid0, t0 + 8);
    else if (set == 1) conv_batched<2>(p.moe_wu + (size_t)layer * 16 * 1024 * 512, 16, 1024, 512, (size_t)1024 * 512, p.wt_gu + (size_t)layer * 16 * 1024 * 1024, (size_t)1024 * 1024, t0, 1, sm, tid0, t0 + 8);
    else conv_batched<0>(p.moe_wd + (size_t)layer * 16 * 512 * 1024, 16, 512, 1024, (size_t)512 * 1024, p.wt_d + (size_t)layer * 16 * 1024 * 512, (size_t)1024 * 512, t0, 1, sm, tid0, t0 + 8);
}
__device__ __forceinline__ void st_attn1(const P& p, LDSP char* lds) {
    const int tid0 = otid();
    LDSP float* lut = (LDSP float*)(lds + 40960); LDSP int* slot = (LDSP int*)(lds + 45568); LDSP float* luts = (LDSP float*)(lds + 46080);
    for (int i = tid0; i < 1152; i += 256) lut[i] = (i < 64) ? ATT_NEG : ATT_SHIFT;
#pragma unroll 1
    for (int h = 0; h < 8; ++h) build_lut(luts + h * 256, p.blut + h * 1024, 256, 128, tid0);
    for (;;) {
        const int item = wq_next(p.wq + 0, slot, tid0);
        if (item >= 768 + 1024 + 768) break;
        if (item < 768) mla_item(p, item, lds, tid0);
        else { const int r = item - 768, g = r / 7, ps = r - g * 7;
               if (ps < 4) swa_item(p, g * 4 + ps, lds, tid0); else moe_conv_item(p, 1, g * 3 + ps - 4, lds, tid0); }
    }
}

#define A0_GLUT 16384
#define A0_WLUT 34816
#define A0_IMP 45056
#define A0_SEL 61568
#define A0_UN 62080
#define A0_LIST 62144
#define A0_SLOT 62720
__device__ __forceinline__ unsigned wmax_u32(unsigned v) {
#pragma unroll
    for (int o = 32; o > 0; o >>= 1) { const unsigned t = (unsigned)__shfl_xor((int)v, o); v = t > v ? t : v; }
    return v;
}
#define ATT_STORE_O(op, o, sc) do { _Pragma("unroll") for (int dt_ = 0; dt_ < 2; ++dt_) _Pragma("unroll") for (int rq_ = 0; rq_ < 4; ++rq_) \
        *(u32x2*)((op) + 32 * dt_ + 8 * rq_) = (u32x2){cvtpk((o)[dt_][4 * rq_] * (sc), (o)[dt_][4 * rq_ + 1] * (sc)), cvtpk((o)[dt_][4 * rq_ + 2] * (sc), (o)[dt_][4 * rq_ + 3] * (sc))}; } while (0)

__device__ __forceinline__ void nsa_item(const P& p, const int item, LDSP char* lds, const int tid0) {
    LDSP char* kb = lds; LDSP char* vb = lds + 8192;
    LDSP float* glut = (LDSP float*)(lds + A0_GLUT); LDSP float* wlut = (LDSP float*)(lds + A0_WLUT); LDSP float* imp = (LDSP float*)(lds + A0_IMP);
    LDSP unsigned* sel = (LDSP unsigned*)(lds + A0_SEL); LDSP unsigned* un = (LDSP unsigned*)(lds + A0_UN); LDSP unsigned short* blist = (LDSP unsigned short*)(lds + A0_LIST);
    const float c1 = 0.125f * LOG2E;
    int tid = tid0; asm volatile("" : "+v"(tid));
    const int wid = tid >> 6, lane = tid & 63, q = lane & 31, hh = lane >> 5;
    const int tile = 255 - (item >> 2), b = (item >> 1) & 1, kvh = item & 1, t0 = tile * 32, blk_t = t0 >> 6, head = kvh * 4 + wid;
#pragma unroll 1
    for (int h = 0; h < 4; ++h) { build_lut(glut + h * 1152, p.blut + (kvh * 4 + h) * 1024, 1152, 1 << 30, tid); build_lut(wlut + h * 640, p.blut + (kvh * 4 + h) * 1024, 640, 512, tid); }
    for (int i = tid; i < 32 * 129; i += 256) imp[i] = 0.f;
    AttLane L; att_lane_init<128, 128, 2>(L, lane);
    int rc[1]; att_stage_map<8>(rc, tid);
    const size_t rowq = (size_t)(b * SEQ + t0 + q);
    bf16x8 qf[4];
    {
        const bf16_t* qp = p.proj + rowq * 2840 + head * 64 + 8 * hh;
#pragma unroll
        for (int ks = 0; ks < 4; ++ks) qf[ks] = *(const bf16x8*)(qp + 16 * ks);
    }
    const float gc = p.gates[rowq * 24 + head * 3 + 0], gs = p.gates[rowq * 24 + head * 3 + 1], gw = p.gates[rowq * 24 + head * 3 + 2];
    const unsigned gtab = (unsigned)(size_t)(glut + wid * 1152), wtab = (unsigned)(size_t)(wlut + wid * 640);
    const bf16_t* zr = p.zrow;
    const bf16_t* pb = p.proj + (size_t)b * SEQ * 2840;
    f32x16 of[2], o[2];
#pragma unroll
    for (int dt = 0; dt < 2; ++dt)
#pragma unroll
        for (int r = 0; r < 16; ++r) { of[dt][r] = 0.f; o[dt][r] = 0.f; }
    bf16x8 pf[4];
    __syncthreads();
    const float cfar = glut[wid * 1152 + 64 + 1023];
    {
        int nvm = (t0 >> 4) + 1; nvm = nvm > 511 ? 511 : nvm;
        const int ntc = (nvm + 63) >> 6;
        const bf16_t* kcb = p.kcmpb + (size_t)((b * 2 + kvh) * 512) * 64;
        const bf16_t* vcb = p.kcmpb + (size_t)((4 + b * 2 + kvh) * 512) * 64;
        auto csrc = [&](const bf16_t* base, int n0) { return [=](int row, int gcx) { const int n = n0 + row; return n < 511 ? base + (size_t)n * 64 + gcx * 8 : zr + gcx * 8; }; };
        float lsum = 0.f;
        for (int nt = 0; nt < ntc; ++nt) {
            att_stage<8>(kb, csrc(kcb, nt * 64), rc, wid);
            asm volatile("s_waitcnt vmcnt(0)" ::: "memory"); ATT_BAR();
            const int dq16 = t0 + q - 31 - 1024 * nt - 64 * hh;
            if (t0 - 31 - 16 * (nt * 64 + 63) >= 1023) att_qk<4, 128, 0, false, false>(kb, L, qf, pf, lsum, c1, cfar, 0u, 0, nullptr, 0.f);
            else att_qk<4, 128, 2, false, false>(kb, L, qf, pf, lsum, c1, 0.f, gtab, dq16, nullptr, 0.f);
            asm volatile("s_waitcnt lgkmcnt(0)" ::: "memory"); ATT_BAR();
        }
        const float lc = lsum + __shfl_xor(lsum, 32);
        const float invl = lc > 0.f ? 1.0f / lc : 0.f;
        float dummy = 0.f;
        for (int nt = 0; nt < ntc; ++nt) {
            att_stage<8>(kb, csrc(kcb, nt * 64), rc, wid);
            att_stage<8>(vb, csrc(vcb, nt * 64), rc, wid);
            asm volatile("s_waitcnt vmcnt(0)" ::: "memory"); ATT_BAR();
            const int dq16 = t0 + q - 31 - 1024 * nt - 64 * hh;
            LDSP float* improw = imp + q * 129 + 16 * nt + hh;
            if (t0 - 31 - 16 * (nt * 64 + 63) >= 1023) att_qk<4, 128, 0, true, true>(kb, L, qf, pf, dummy, c1, cfar, 0u, 0, improw, invl * 524288.0f);
            else att_qk<4, 128, 2, true, true>(kb, L, qf, pf, dummy, c1, 0.f, gtab, dq16, improw, invl * 524288.0f);
            att_pv<2, 128>(vb, L, pf, o);
            asm volatile("s_waitcnt lgkmcnt(0)" ::: "memory"); ATT_BAR();
        }
        const float sc = gc * invl;
#pragma unroll
        for (int dt = 0; dt < 2; ++dt)
#pragma unroll
            for (int r = 0; r < 16; ++r) { of[dt][r] = o[dt][r] * sc; o[dt][r] = 0.f; }
    }
    __syncthreads();
    {
        unsigned u0 = 0u, u1 = 0u, u2 = 0u, u3 = 0u;
        for (int i = 0; i < 8; ++i) {
            const int tok = wid * 8 + i;
            const unsigned v0 = ((LDSP const unsigned*)imp)[tok * 129 + lane], v1 = ((LDSP const unsigned*)imp)[tok * 129 + 64 + lane];
            const int j0 = lane, j1 = lane + 64;
            const bool f0 = (j0 == 0) || (j0 == blk_t) || (j0 == blk_t - 1), f1 = (j1 == blk_t) || (j1 == blk_t - 1);
            unsigned k0 = f0 ? (0xFFFFFF80u | (unsigned)(127 - j0)) : (j0 <= blk_t ? ((v0 << 7) | (unsigned)(127 - j0)) : 0u);
            unsigned k1 = f1 ? (0xFFFFFF80u | (unsigned)(127 - j1)) : (j1 <= blk_t ? ((v1 << 7) | (unsigned)(127 - j1)) : 0u);
            unsigned thr = 0u;
#pragma unroll 1
            for (int bit = 31; bit >= 0; --bit) {
                const unsigned cand = thr | (1u << bit);
                const int c = __popcll(__ballot(k0 >= cand)) + __popcll(__ballot(k1 >= cand));
                thr = (c >= 16) ? cand : thr;
            }
            thr = thr ? thr : 1u;
            const unsigned long long b0 = __ballot(k0 >= thr), b1 = __ballot(k1 >= thr);
            const unsigned m0 = (unsigned)b0, m1 = (unsigned)(b0 >> 32), m2 = (unsigned)b1, m3 = (unsigned)(b1 >> 32);
            if (lane == 0) { sel[tok * 4 + 0] = m0; sel[tok * 4 + 1] = m1; sel[tok * 4 + 2] = m2; sel[tok * 4 + 3] = m3; }
            u0 |= m0; u1 |= m1; u2 |= m2; u3 |= m3;
        }
        if (lane == 0) { un[wid * 4 + 0] = u0; un[wid * 4 + 1] = u1; un[wid * 4 + 2] = u2; un[wid * 4 + 3] = u3; }
    }
    __syncthreads();
    {
        unsigned uw[4];
#pragma unroll
        for (int k = 0; k < 4; ++k) uw[k] = (unsigned)__builtin_amdgcn_readfirstlane((int)(un[k] | un[4 + k] | un[8 + k] | un[12 + k]));
        if (tid < 128) {
            const int k = tid >> 5, jb = tid & 31;
            unsigned wv = 0u; int below = 0;
#pragma unroll
            for (int kk = 0; kk < 4; ++kk) { if (kk == k) wv = uw[kk]; if (kk < k) below += __popc(uw[kk]); }
            if ((wv >> jb) & 1u) blist[below + __popc(wv & ((1u << jb) - 1u))] = (unsigned short)tid;
        }
        const int nb = __popc(uw[0]) + __popc(uw[1]) + __popc(uw[2]) + __popc(uw[3]);
        unsigned sq[4];
#pragma unroll
        for (int k = 0; k < 4; ++k) sq[k] = sel[q * 4 + k];
        __syncthreads();
        const bf16_t* ksb = pb + 768 + kvh * 64;
        auto ssrc = [&](int pos0, int colo) { return [=](int row, int gcx) { return ksb + (size_t)(pos0 + row) * 2840 + colo + gcx * 8; }; };
        float lsum = 0.f;
        att_stage<8>(kb, ssrc(64 * (int)blist[0], 0), rc, wid);
        for (int i = 0; i < nb; ++i) {
            const int j = __builtin_amdgcn_readfirstlane((int)blist[i]), pos0 = 64 * j;
            asm volatile("s_waitcnt vmcnt(0)" ::: "memory"); ATT_BAR();
            att_stage<8>(vb, ssrc(pos0, 128), rc, wid);
            unsigned sw = 0u;
#pragma unroll
            for (int k = 0; k < 4; ++k) if ((j >> 5) == k) sw = sq[k];
            const bool selq = (sw >> (j & 31)) & 1u;
            {
                int dq = t0 + q - pos0 - 4 * hh; dq = dq > 1087 ? 1087 : dq; dq = (dq < -1 || !selq) ? -1 : dq;
                att_qk<4, 128, 1, true, false>(kb, L, qf, pf, lsum, c1, 0.f, gtab + (unsigned)(dq + 1) * 4u, 0, nullptr, 0.f);
            }
            asm volatile("s_waitcnt vmcnt(0) lgkmcnt(0)" ::: "memory"); ATT_BAR();
            if (i + 1 < nb) att_stage<8>(kb, ssrc(64 * (int)blist[i + 1], 0), rc, wid);
            att_pv<2, 128>(vb, L, pf, o);
        }
        const float ls = lsum + __shfl_xor(lsum, 32);
        const float sc = gs / ls;
#pragma unroll
        for (int dt = 0; dt < 2; ++dt)
#pragma unroll
            for (int r = 0; r < 16; ++r) { of[dt][r] += o[dt][r] * sc; o[dt][r] = 0.f; }
    }
    {
        const bf16_t* kwb = pb + 1024 + kvh * 64;
        auto wsrc = [&](int pos0, int colo) { return [=](int row, int gcx) { const int pos = pos0 + row; return (pos >= 0 && pos < SEQ) ? kwb + (size_t)pos * 2840 + colo + gcx * 8 : zr + gcx * 8; }; };
        float lsum = 0.f;
        asm volatile("s_waitcnt lgkmcnt(0)" ::: "memory"); ATT_BAR();
        att_stage<8>(kb, wsrc(t0 - 512, 0), rc, wid);
        for (int i = 0; i < 9; ++i) {
            const int pos0 = t0 - 512 + 64 * i;
            asm volatile("s_waitcnt vmcnt(0)" ::: "memory"); ATT_BAR();
            att_stage<8>(vb, wsrc(pos0, 128), rc, wid);
            int dq = t0 + q - pos0 - 4 * hh; dq = dq < -1 ? -1 : dq;
            att_qk<4, 128, 1, true, false>(kb, L, qf, pf, lsum, c1, 0.f, wtab + (unsigned)(dq + 1) * 4u, 0, nullptr, 0.f);
            asm volatile("s_waitcnt vmcnt(0) lgkmcnt(0)" ::: "memory"); ATT_BAR();
            if (i + 1 < 9) att_stage<8>(kb, wsrc(pos0 + 64, 0), rc, wid);
            att_pv<2, 128>(vb, L, pf, o);
        }
        const float lw = lsum + __shfl_xor(lsum, 32);
        const float sc = gw / lw;
#pragma unroll
        for (int dt = 0; dt < 2; ++dt)
#pragma unroll
            for (int r = 0; r < 16; ++r) of[dt][r] += o[dt][r] * sc;
    }
    bf16_t* op = p.o + rowq * DM + head * 64 + 4 * hh;
    ATT_STORE_O(op, of, 1.0f);
}

#define MG_CNT 8192
#define MG_BASE 8320
#define MG_ENT 8448
__device__ __forceinline__ void st_moba_gate(const P& p, int wg, int nwg, LDSP char* lds) {
    const int tid = otid();
    const int wid = tid >> 6, lane = tid & 63, q = lane & 31, hh = lane >> 5;
    LDSP char* kmt = lds; LDSP int* lcnt = (LDSP int*)(lds + MG_CNT); LDSP int* lbase = (LDSP int*)(lds + MG_BASE); LDSP int* ent = (LDSP int*)(lds + MG_ENT);
    AttLane L; att_lane_init<128, 128, 2>(L, lane);
    int rc[1]; att_stage_map<8>(rc, tid);
    const bf16_t* zr = p.zrow;
    for (int item = wg; item < 1024; item += nwg) {
        const int tile = item >> 4, b = (item >> 3) & 1, h = item & 7, t0 = tile * 128, own = t0 >> 8, tw = t0 + wid * 32, bh = b * 8 + h;
        if (own == 0) continue;
        __syncthreads();
        if (tid < 32) lcnt[tid] = 0;
        bf16x8 qf[4];
        {
            const bf16_t* qp = p.proj + (size_t)(b * SEQ + tw + q) * 2840 + 1304 + h * 64 + 8 * hh;
#pragma unroll
            for (int ks = 0; ks < 4; ++ks) qf[ks] = *(const bf16x8*)(qp + 16 * ks);
        }
        const bf16_t* kmb = p.kmeanb + (size_t)(bh * 32) * 64;
        att_stage<8>(kmt, [=](int row, int gcx) { return row < 32 ? kmb + (size_t)row * 64 + gcx * 8 : zr + gcx * 8; }, rc, wid);
        asm volatile("s_waitcnt vmcnt(0)" ::: "memory");
        __syncthreads();
        f32x16 s;
#pragma unroll
        for (int r = 0; r < 16; ++r) s[r] = 0.f;
#pragma unroll
        for (int ks = 0; ks < 4; ++ks) {
            const bf16x8 a = *(const LDSP bf16x8*)(kmt + (L.kbase ^ (32 * (ks & 3))));
            s = __builtin_amdgcn_mfma_f32_32x32x16_bf16(a, qf[ks], s, 0, 0, 0);
        }
        unsigned key[16];
#pragma unroll
        for (int r = 0; r < 16; ++r) {
            const int j = (r & 3) + 8 * (r >> 2) + 4 * hh;
            const unsigned bits = __float_as_uint(s[r]);
            const unsigned srt = (bits & 0x80000000u) ? ~bits : (bits | 0x80000000u);
            key[r] = (j < own) ? ((srt & ~31u) | (unsigned)(31 - j)) : 0u;
        }
        unsigned selm = 0u;
#pragma unroll 1
        for (int rnd = 0; rnd < 3; ++rnd) {
            unsigned m = 0u;
#pragma unroll
            for (int r = 0; r < 16; ++r) m = key[r] > m ? key[r] : m;
            const unsigned mo = (unsigned)__shfl_xor((int)m, 32);
            const unsigned wk = mo > m ? mo : m;
            if (wk != 0u) selm |= 1u << (31 - (wk & 31u));
#pragma unroll
            for (int r = 0; r < 16; ++r) key[r] = (key[r] == wk) ? 0u : key[r];
        }
        if (hh == 0) {
            unsigned mm = selm;
#pragma unroll
            for (int sI = 0; sI < 3; ++sI) {
                int en = -1;
                if (mm) { const int j = __builtin_ctz(mm); mm &= mm - 1u; const int lp = __hip_atomic_fetch_add(lcnt + j, 1, __ATOMIC_RELAXED, __HIP_MEMORY_SCOPE_WORKGROUP); en = (j << 8) | lp; }
                ent[(wid * 32 + q) * 3 + sI] = en;
            }
        }
        __syncthreads();
        if (tid < 32) { const int c = lcnt[tid]; lbase[tid] = c ? atomicAdd(p.mcnt + bh * 32 + tid, c) : 0; }
        __syncthreads();
        for (int e = tid; e < 384; e += 256) {
            const int en = ent[e];
            if (en >= 0) { const int j = en >> 8, tokl = e / 3, sI = e - tokl * 3; p.mlist[(size_t)(bh * 32 + j) * 8192 + lbase[j] + (en & 255)] = (unsigned short)((t0 + tokl) | (sI << 13)); }
        }
    }
}
__device__ __forceinline__ bf16_t* moba_part(const P& p, int slot, size_t row) { return (slot < 2 ? p.mp01 + (size_t)slot * 131072 * 64 : p.mp2) + row * 64; }

__device__ __forceinline__ void moba_inv_item(const P& p, const int lid, const int chunk, LDSP char* lds, const int tid0) {
    LDSP char* kb = lds; LDSP char* vb = lds + 8192; LDSP float* glut = (LDSP float*)(lds + A0_GLUT);
    const float c1 = 0.125f * LOG2E;
    int tid = tid0; asm volatile("" : "+v"(tid));
    const int wid = tid >> 6, lane = tid & 63, q = lane & 31, hh = lane >> 5;
    const int bh = lid / 31, j = lid - bh * 31, b = bh >> 3, h = bh & 7;
    build_lut(glut, p.blut + h * 1024, 1152, 1 << 30, tid);
    AttLane L; att_lane_init<128, 128, 2>(L, lane);
    int rc[1]; att_stage_map<8>(rc, tid);
    const int n = p.mcnt[bh * 32 + j], idx = chunk * 128 + wid * 32 + q;
    const bool valid = idx < n;
    const unsigned en = valid ? (unsigned)p.mlist[(size_t)(bh * 32 + j) * 8192 + idx] : (unsigned)(256 * (j + 1));
    const int tok = (int)(en & 8191u), slot = (int)(en >> 13);
    bf16x8 qf[4];
    {
        const bf16_t* qp = p.proj + (size_t)(b * SEQ + tok) * 2840 + 1304 + h * 64 + 8 * hh;
#pragma unroll
        for (int ks = 0; ks < 4; ++ks) qf[ks] = *(const bf16x8*)(qp + 16 * ks);
    }
    const unsigned gtab = (unsigned)(size_t)glut;
    const bf16_t* kbb = p.proj + (size_t)b * SEQ * 2840 + 1816 + h * 64;
    auto msrc = [&](int pos0, int colo) { return [=](int row, int gcx) { return kbb + (size_t)(pos0 + row) * 2840 + colo + gcx * 8; }; };
    f32x16 o[2];
#pragma unroll
    for (int dt = 0; dt < 2; ++dt)
#pragma unroll
        for (int r = 0; r < 16; ++r) o[dt][r] = 0.f;
    float lsum = 0.f;
    bf16x8 pf[4];
    __syncthreads();
    att_stage<8>(kb, msrc(256 * j, 0), rc, wid);
    for (int i = 0; i < 4; ++i) {
        const int pos0 = 256 * j + 64 * i;
        asm volatile("s_waitcnt vmcnt(0)" ::: "memory"); ATT_BAR();
        att_stage<8>(vb, msrc(pos0, 512), rc, wid);
        {
            int dq = tok - pos0 - 4 * hh; dq = dq > 1087 ? 1087 : dq; dq = valid ? dq : -1;
            att_qk<4, 128, 1, true, false>(kb, L, qf, pf, lsum, c1, 0.f, gtab + (unsigned)(dq + 1) * 4u, 0, nullptr, 0.f);
        }
        asm volatile("s_waitcnt vmcnt(0) lgkmcnt(0)" ::: "memory"); ATT_BAR();
        if (i + 1 < 4) att_stage<8>(kb, msrc(pos0 + 64, 0), rc, wid);
        att_pv<2, 128>(vb, L, pf, o);
    }
    const float lt = lsum + __shfl_xor(lsum, 32);
    if (valid) {
        const size_t row = (size_t)bh * SEQ + tok;
        bf16_t* op = moba_part(p, slot, row) + 4 * hh;
        ATT_STORE_O(op, o, 1.0f);
        if (hh == 0) p.mpl[(size_t)slot * 131072 + row] = lt;
    }
}
__device__ __forceinline__ void moba_own_item(const P& p, const int item, LDSP char* lds, const int tid0) {
    LDSP char* kb = lds; LDSP char* vb = lds + 8192; LDSP float* glut = (LDSP float*)(lds + A0_GLUT);
    const float c1 = 0.125f * LOG2E;
    int tid = tid0; asm volatile("" : "+v"(tid));
    const int wid = tid >> 6, lane = tid & 63, q = lane & 31, hh = lane >> 5;
    const int tile = item >> 4, b = (item >> 3) & 1, h = item & 7, t0 = tile * 128, own = t0 >> 8, tw = t0 + wid * 32, bh = b * 8 + h;
    __syncthreads();
    build_lut(glut, p.blut + h * 1024, 1152, 1 << 30, tid);
    AttLane L; att_lane_init<128, 128, 2>(L, lane);
    int rc[1]; att_stage_map<8>(rc, tid);
    const size_t rowq = (size_t)(b * SEQ + tw + q);
    bf16x8 qf[4];
    {
        const bf16_t* qp = p.proj + rowq * 2840 + 1304 + h * 64 + 8 * hh;
#pragma unroll
        for (int ks = 0; ks < 4; ++ks) qf[ks] = *(const bf16x8*)(qp + 16 * ks);
    }
    const unsigned gtab = (unsigned)(size_t)glut;
    const bf16_t* kbb = p.proj + (size_t)b * SEQ * 2840 + 1816 + h * 64;
    auto msrc = [&](int pos0, int colo) { return [=](int row, int gcx) { return kbb + (size_t)(pos0 + row) * 2840 + colo + gcx * 8; }; };
    f32x16 o[2];
#pragma unroll
    for (int dt = 0; dt < 2; ++dt)
#pragma unroll
        for (int r = 0; r < 16; ++r) o[dt][r] = 0.f;
    float lsum = 0.f;
    bf16x8 pf[4];
    const int nb = (((t0 + 127) >> 6) & 3) + 1;
    __syncthreads();
    att_stage<8>(kb, msrc(256 * own, 0), rc, wid);
    for (int i = 0; i < nb; ++i) {
        const int pos0 = 256 * own + 64 * i;
        asm volatile("s_waitcnt vmcnt(0)" ::: "memory"); ATT_BAR();
        att_stage<8>(vb, msrc(pos0, 512), rc, wid);
        const bool active = pos0 <= tw + 31;
        if (active) {
            int dq = tw + q - pos0 - 4 * hh; dq = dq < -1 ? -1 : dq;
            att_qk<4, 128, 1, true, false>(kb, L, qf, pf, lsum, c1, 0.f, gtab + (unsigned)(dq + 1) * 4u, 0, nullptr, 0.f);
        }
        asm volatile("s_waitcnt vmcnt(0) lgkmcnt(0)" ::: "memory"); ATT_BAR();
        if (i + 1 < nb) att_stage<8>(kb, msrc(pos0 + 64, 0), rc, wid);
        if (active) att_pv<2, 128>(vb, L, pf, o);
    }
    float lt = lsum + __shfl_xor(lsum, 32);
    const int npick = own < 3 ? own : 3;
    const size_t row = (size_t)bh * SEQ + tw + q;
#pragma unroll 1
    for (int sI = 0; sI < npick; ++sI) {
        lt += p.mpl[(size_t)sI * 131072 + row];
        const bf16_t* pp = moba_part(p, sI, row) + 4 * hh;
#pragma unroll
        for (int dt = 0; dt < 2; ++dt)
#pragma unroll
            for (int rq = 0; rq < 4; ++rq) {
                const u32x2 w = *(const u32x2*)(pp + 32 * dt + 8 * rq);
                o[dt][4 * rq] += __uint_as_float(w[0] << 16); o[dt][4 * rq + 1] += __uint_as_float(w[0] & 0xffff0000u);
                o[dt][4 * rq + 2] += __uint_as_float(w[1] << 16); o[dt][4 * rq + 3] += __uint_as_float(w[1] & 0xffff0000u);
            }
    }
    const float inv = 1.0f / lt;
    bf16_t* op = p.o + rowq * DM + 512 + h * 64 + 4 * hh;
    ATT_STORE_O(op, o, inv);
}
__device__ __forceinline__ void st_moba_own(const P& p, int wg, int nwg, LDSP char* lds) {
    const int tid0 = otid();
    for (int item = wg; item < 1024; item += nwg) moba_own_item(p, item, lds, tid0);
}
#define A0_PRE 62736
__device__ __forceinline__ void st_attn0(const P& p, LDSP char* lds) {
    const int tid0 = otid();
    LDSP int* slot = (LDSP int*)(lds + A0_SLOT); LDSP int* pre = (LDSP int*)(lds + A0_PRE);
    LDSP int* tmp = (LDSP int*)lds;
    for (int i = tid0; i < 496; i += 256) { const int bh = i / 31, j = i - bh * 31; tmp[i] = (p.mcnt[bh * 32 + j] + 127) >> 7; }
    __syncthreads();
    for (int i = tid0; i < 497; i += 256) { int s = 0; for (int k = 0; k < i; ++k) s += tmp[k]; pre[i] = s; }
    __syncthreads();
    const int ninv = pre[496];
    for (;;) {
        const int item = wq_next(p.wq + 1, slot, tid0);
        const int ntail = 5 * 768 + (ninv > 3072 ? ninv - 3072 : 0);
        if (item >= 1024 + ntail) break;
        if (item < 1024) nsa_item(p, item, lds, tid0);
        else {
            const int r = item - 1024, g = r / 5, ps = r - g * 5;
            if (g < 768 && ps == 4) { moe_conv_item(p, 0, g, lds, tid0); continue; }
            const int idx = (g < 768) ? g * 4 + ps : 3072 + (r - 5 * 768);
            if (idx >= ninv) continue;
            int lo = 0, hi = 495;
            while (lo < hi) { const int mid = (lo + hi + 1) >> 1; if (pre[mid] <= idx) lo = mid; else hi = mid - 1; }
            moba_inv_item(p, lo, idx - pre[lo], lds, tid0);
        }
    }
}

#define XB_TMO      128
#define XB_XCNT(j)  (256  + 64 * (j))
#define XB_XSUB(j)  (1280 + 64 * (j))
#define XB_XGEN(j)  (2304 + 64 * (j))
#define XB_TOP      3328
#define XB_TOPGEN   3392
#define XCD_BAR_WORDS 3456
#define XB_SPIN_CAP (1u << 20)
#define LAS __attribute__((address_space(3)))

__device__ __forceinline__ unsigned xb_ld(unsigned* p)              { return __hip_atomic_load(p, __ATOMIC_RELAXED, __HIP_MEMORY_SCOPE_AGENT); }
__device__ __forceinline__ unsigned xb_add(unsigned* p, unsigned v) { return __hip_atomic_fetch_add(p, v, __ATOMIC_RELAXED, __HIP_MEMORY_SCOPE_AGENT); }
__device__ __forceinline__ unsigned xb_xcc_id() { return (unsigned)__builtin_amdgcn_s_getreg((3 << 11) | 20) & 0xFu; }
#define XB_SPIN(cond, bar) do { unsigned _sp = 0; while (cond) { __builtin_amdgcn_s_sleep(1); \
    if ((++_sp & 255u) == 0u) { if (xb_ld(&(bar)[XB_TMO])) break; if (_sp > XB_SPIN_CAP) { atomicAdd(&(bar)[XB_TMO], 1u); break; } } } } while (0)

struct XcdBarrier {
    unsigned* bar; unsigned x;
    volatile LAS unsigned* st;
};

__device__ __forceinline__ XcdBarrier xcd_barrier_post(unsigned* bar, volatile LAS unsigned* st) {
    XcdBarrier b; b.bar = bar; b.x = xb_xcc_id(); b.st = st;
    if (threadIdx.x == 0) (void)xb_add(&bar[XB_XCNT(b.x)], 1u);
    return b;
}
__device__ __forceinline__ void xcd_barrier_complete(unsigned* bar, unsigned x, unsigned& nloc, unsigned& nx) {
    const unsigned G = gridDim.x * gridDim.y * gridDim.z;
    unsigned sum, cnt, mine, sp = 0u;
    for (;;) {
        sum = 0u; cnt = 0u; mine = 0u;
#pragma unroll
        for (unsigned j = 0; j < 16; ++j) { const unsigned c = xb_ld(&bar[XB_XCNT(j)]); sum += c; cnt += (c > 0u) ? 1u : 0u; mine = (j == x) ? c : mine; }
        if (sum == G) break;
        __builtin_amdgcn_s_sleep(1);
        if ((++sp & 255u) == 0u) { if (xb_ld(&bar[XB_TMO])) break; if (sp > XB_SPIN_CAP) { atomicAdd(&bar[XB_TMO], 1u); break; } }
    }
    nloc = mine > 0u ? mine : 1u; nx = cnt > 0u ? cnt : 1u;
}

__device__ __forceinline__ void xcd_barrier(const XcdBarrier& b) {
    asm volatile("s_waitcnt vmcnt(0)" ::: "memory");
    __syncthreads();
    if (threadIdx.x == 0) {
        unsigned* bar = b.bar;
        __builtin_amdgcn_s_waitcnt(0);
        unsigned nloc = b.st[0], nx = b.st[1];
        if (nloc == 0u) { xcd_barrier_complete(bar, b.x, nloc, nx); b.st[0] = nloc; b.st[1] = nx; }
        const unsigned old = xb_add(&bar[XB_XSUB(b.x)], 1u);
        const unsigned gen = old / nloc;
        if (old + 1u == (gen + 1u) * nloc) {
            __builtin_amdgcn_fence(__ATOMIC_RELEASE, "agent");
            asm volatile("s_waitcnt vmcnt(0)" ::: "memory");
            const unsigned og = xb_add(&bar[XB_TOP], 1u);
            const unsigned tg = og / nx;
            if (og + 1u == (tg + 1u) * nx) xb_add(&bar[XB_TOPGEN], 1u);
            else XB_SPIN(xb_ld(&bar[XB_TOPGEN]) == tg, bar);
            __builtin_amdgcn_fence(__ATOMIC_ACQUIRE, "agent");
            xb_add(&bar[XB_XGEN(b.x)], 1u);
            asm volatile("s_waitcnt vmcnt(0)" ::: "memory");
        } else {
            XB_SPIN(xb_ld(&bar[XB_XGEN(b.x)]) == gen, bar);
            __builtin_amdgcn_fence(__ATOMIC_ACQUIRE, "agent");
            asm volatile("s_waitcnt vmcnt(0)" ::: "memory");
        }
    }
    __syncthreads();
}


#define PHASE_SYNC() do { PP qb_ = (PP)__builtin_amdgcn_kernarg_segment_ptr(); asm volatile("" : "+s"(qb_)); XcdBarrier b_; b_.bar = qb_->bar; b_.x = xb_xcc_id(); \
        b_.st = (volatile LAS unsigned*)(dlds + GEMM_LDS_BYTES); xcd_barrier(b_); } while (0)
typedef const __attribute__((address_space(4))) P* PP;
#define PHASE_ARGS() PP q_ = (PP)__builtin_amdgcn_kernarg_segment_ptr(); int wg = blockIdx.x, nwg = gridDim.x; asm volatile("" : "+s"(q_), "+s"(wg), "+s"(nwg)); P p; { const __attribute__((address_space(4))) unsigned long long* s64_ = (const __attribute__((address_space(4))) unsigned long long*)q_; unsigned long long* d64_ = (unsigned long long*)&p; _Pragma("unroll") for (int i_ = 0; i_ < (int)(sizeof(P) / 8); ++i_) d64_[i_] = s64_[i_]; } float* sm = (float*)dlds; LDSP char* lds = (LDSP char*)dlds; (void)sm; (void)lds
#define KERNEL_LDS_BYTES (GEMM_LDS_BYTES + 64)
__global__ void __launch_bounds__(256, 2) k_mega(P pk) {
    extern __shared__ __attribute__((aligned(16))) unsigned char dlds[];
    if (threadIdx.x == 0) *(uint4*)(dlds + GEMM_LDS_BYTES) = make_uint4(0u, 0u, 0u, 0u);
    __syncthreads();
    (void)xcd_barrier_post(pk.bar, (volatile LAS unsigned*)(dlds + GEMM_LDS_BYTES));
    { PHASE_ARGS(); st_prologue(p, wg, nwg, sm); st_convert(p, wg, nwg, sm); } PHASE_SYNC();
    { PHASE_ARGS(); st_norm<0>(p, 0, wg, nwg, sm); st_c1_reduce(p, wg, nwg); } PHASE_SYNC();
    { PHASE_ARGS(); st_inproj0_mf(p, wg, nwg, lds); } PHASE_SYNC();
    { PHASE_ARGS(); st_cmp1_mf(p, wg, nwg, lds); st_kmean(p, wg, nwg, sm); } PHASE_SYNC();
    { PHASE_ARGS(); st_cmp2_mf(p, wg, nwg, lds); st_moba_gate(p, wg, nwg, lds); } PHASE_SYNC();
    { PHASE_ARGS(); st_attn0(p, lds); } PHASE_SYNC();
    { PHASE_ARGS(); st_moba_own(p, wg, nwg, lds); } PHASE_SYNC();
    { PHASE_ARGS(); st_outproj_mf(p, 0, wg, nwg, lds); } PHASE_SYNC();
    { PHASE_ARGS(); st_norm<1>(p, 0, wg, nwg, sm); } PHASE_SYNC();
    { PHASE_ARGS(); st_moe_up_mf(p, 0, wg, nwg, lds); } PHASE_SYNC();
    { PHASE_ARGS(); st_moe_down_mf(p, 0, wg, nwg, lds); } PHASE_SYNC();
    { PHASE_ARGS(); st_norm<2>(p, 1, wg, nwg, sm); } PHASE_SYNC();
    { PHASE_ARGS(); st_inproj1_mf(p, wg, nwg, lds); } PHASE_SYNC();
    { PHASE_ARGS(); st_mla_prep(p, wg, nwg); } PHASE_SYNC();
    { PHASE_ARGS(); st_mla_up_mf(p, wg, nwg, lds); } PHASE_SYNC();
    { PHASE_ARGS(); st_attn1(p, lds); } PHASE_SYNC();
    { PHASE_ARGS(); st_mla_combine(p, wg, nwg); } PHASE_SYNC();
    { PHASE_ARGS(); st_outproj_mf(p, 1, wg, nwg, lds); } PHASE_SYNC();
    { PHASE_ARGS(); st_norm<1>(p, 1, wg, nwg, sm); } PHASE_SYNC();
    { PHASE_ARGS(); st_moe_up_mf(p, 1, wg, nwg, lds); } PHASE_SYNC();
    { PHASE_ARGS(); st_moe_down_mf(p, 1, wg, nwg, lds); } PHASE_SYNC();
    { PHASE_ARGS(); st_norm<3>(p, 1, wg, nwg, sm); }
}

extern "C" void kernel_launch(void* const* d_in, const int* in_sizes, int n_in, void* d_out, int out_size, void* d_ws, size_t ws_size,
                              hipStream_t stream) {
    (void)in_sizes; (void)n_in; (void)out_size; (void)ws_size;
    P p{};
    const float* const* in = (const float* const*)d_in;
    p.x = in[0]; p.c = in[1]; p.rel = in[2]; p.router_w = in[3]; p.router_b = in[4]; p.final_norm = in[5]; p.norm_mix = in[6]; p.norm_ffn = in[7];
    p.ada_w = in[8]; p.ada_b = in[9]; p.moe_wg = in[10]; p.moe_wu = in[11]; p.moe_wd = in[12]; p.ev_w_in = in[13]; p.ev_w_out = in[14];
    p.pos_k = in[15]; p.pos_v = in[16]; p.ck_w1 = in[17]; p.ck_w2 = in[18]; p.cv_w1 = in[19]; p.cv_w2 = in[20]; p.od_w_in = in[21]; p.od_w_out = in[22];
    p.q_norm = in[23]; p.kv_norm = in[24]; p.w_q_up = in[25]; p.w_kv_up = in[26]; p.sinks = in[27];
    p.out = (float*)d_out;
    char* ws = (char*)d_ws; size_t off = 0;
    auto take = [&](size_t bytes) { char* r = ws + off; off += (bytes + 255) & ~(size_t)255; return r; };
    p.bar = (unsigned*)take(16384);
    p.cnt = (int*)take(4096);
    p.wq = (int*)take(256);
    p.mcnt = (int*)take(512 * 4);
    p.modv = (float*)take(2 * 2 * 6144 * 4);
    p.zrow = (bf16_t*)take(256);
    const size_t zero_bytes = off;
    p.ropec = (float*)take(SEQ * 32 * 4); p.ropes = (float*)take(SEQ * 32 * 4);
    p.blut = (float*)take(8 * 1024 * 4);
    p.gates = (float*)take((size_t)T_TOK * 24 * 4);
    p.kmean = (float*)take(2 * 8 * 32 * 64 * 4);
    p.tokw = (float*)take((size_t)T_TOK * 2 * 4);
    p.list = (int*)take((size_t)16 * T_TOK * 4);
    p.cqn = (bf16_t*)take((size_t)T_TOK * 384 * 2);
    p.krope = (bf16_t*)take((size_t)T_TOK * 64 * 2);
    p.h = (bf16_t*)take((size_t)T_TOK * DM * 2);
    p.o = (bf16_t*)take((size_t)T_TOK * DM * 2);
    p.mlap = p.h;
    p.mlal = (float*)(p.h + (size_t)2 * 8 * (SEQ / 2) * 128);
    p.mp01 = p.h;
    p.mp2 = (bf16_t*)take((size_t)131072 * 64 * 2);
    p.mpl = (float*)take((size_t)3 * 131072 * 4);
    p.mlist = (unsigned short*)take((size_t)16 * 32 * 8192 * 2);
    p.hid = p.o;
    char* region = take((size_t)100 * 1024 * 1024);
    p.proj = (bf16_t*)region;
    p.proj1 = (bf16_t*)region;
    p.qmla = (bf16_t*)(region + (size_t)T_TOK * 1216 * 2);
    p.kvmla = (bf16_t*)(region + (size_t)T_TOK * (1216 + 768) * 2);
    p.y = (bf16_t*)region;
    p.chidb = (bf16_t*)take((size_t)2 * 2048 * 256 * 2);
    p.kcmpb = (bf16_t*)take((size_t)8 * 512 * 64 * 2);
    p.kmeanb = (bf16_t*)take((size_t)2 * 8 * 32 * 64 * 2);
    p.c1 = (float*)take(512 * 4);
    p.c1p = (float*)take((size_t)2 * 64 * 256 * 4);
    p.wt_gu = (bf16_t*)take((size_t)32 * 1024 * 1024 * 2);
    p.wt_d = (bf16_t*)take((size_t)32 * 1024 * 512 * 2);
    p.wt_in0 = (bf16_t*)take((size_t)2840 * 1024 * 2);
    p.wt_out0 = (bf16_t*)take((size_t)1024 * 1024 * 2);
    p.wt_c1 = (bf16_t*)take((size_t)2 * 256 * 2048 * 2);
    p.wt_c2 = (bf16_t*)take((size_t)2 * 64 * 256 * 2);
    p.wt_in1 = (bf16_t*)take((size_t)1216 * 1024 * 2);
    p.wt_out1 = (bf16_t*)take((size_t)1024 * 1024 * 2);
    p.wt_qup = (bf16_t*)take((size_t)768 * 256 * 2);
    p.wt_kvup = (bf16_t*)take((size_t)1024 * 128 * 2);
    static int grid = 0;
    if (!grid) {
        int dev = 0, cus = 0, per_cu = 0;
        (void)hipGetDevice(&dev);
        (void)hipDeviceGetAttribute(&cus, hipDeviceAttributeMultiprocessorCount, dev);
        (void)hipFuncSetAttribute((const void*)k_mega, hipFuncAttributeMaxDynamicSharedMemorySize, KERNEL_LDS_BYTES);
        (void)hipOccupancyMaxActiveBlocksPerMultiprocessor(&per_cu, k_mega, 256, KERNEL_LDS_BYTES);
        if (cus <= 0) cus = 256;
        if (per_cu < 1) per_cu = 1;
        grid = cus * (per_cu < 2 ? per_cu : 2);
    }
    (void)hipMemsetAsync(d_ws, 0, zero_bytes, stream);
    hipLaunchKernelGGL(k_mega, dim3(grid), dim3(256), KERNEL_LDS_BYTES, stream, p);
}
```

```cpp
#include <hip/hip_runtime.h>
#include <stdint.h>

#define T_TOK 16384
#define SEQ 8192
#define DM 1024
#define NEGF (-1e30f)
#define BIGF (1e30f)

typedef unsigned short bf16_t;

__device__ __forceinline__ float bf2f(bf16_t v) { return __uint_as_float(((unsigned)v) << 16); }
__device__ __forceinline__ bf16_t f2bf(float f) {
    unsigned u = __float_as_uint(f);
    u += 0x7fffu + ((u >> 16) & 1u);
    return (bf16_t)(u >> 16);
}
typedef __bf16 bf16x2_t __attribute__((ext_vector_type(2)));
typedef float f32x2_t __attribute__((ext_vector_type(2)));
__device__ __forceinline__ unsigned cvtpk(float lo, float hi) { const f32x2_t f = {lo, hi}; return __builtin_bit_cast(unsigned, __builtin_convertvector(f, bf16x2_t)); }
__device__ __forceinline__ unsigned cvtpk_valu(float lo, float hi) { unsigned r; asm("v_cvt_pk_bf16_f32 %0, %1, %2" : "=v"(r) : "v"(lo), "v"(hi)); return r; }
__device__ __forceinline__ float wsum(float v) {
#pragma unroll
    for (int o = 32; o > 0; o >>= 1) v += __shfl_xor(v, o);
    return v;
}
__device__ __forceinline__ float siluf(float v) { return v / (1.0f + __expf(-v)); }
__device__ __forceinline__ float sigmf(float v) { return 1.0f / (1.0f + __expf(-v)); }
__device__ __forceinline__ float gelu_tanh(float x) {
    const float k0 = 0.7978845608028654f, k1 = 0.044715f;
    float u = k0 * (x + k1 * x * x * x);
    return 0.5f * x * (1.0f + tanhf(u));
}
__device__ __forceinline__ int rel_bucket(int d) {
    if (d < 16) return d < 0 ? 0 : d;
    int b = 16;
    b += (d >= 21); b += (d >= 27); b += (d >= 35); b += (d >= 46); b += (d >= 59); b += (d >= 77); b += (d >= 99); b += (d >= 128);
    b += (d >= 166); b += (d >= 216); b += (d >= 280); b += (d >= 363); b += (d >= 470); b += (d >= 609); b += (d >= 790);
    return b;
}

__device__ __forceinline__ int otid() { int t = threadIdx.x; asm volatile("" : "+v"(t)); return t; }

struct P {
    const float *x, *c, *rel, *router_w, *router_b, *final_norm, *norm_mix, *norm_ffn, *ada_w, *ada_b, *moe_wg, *moe_wu, *moe_wd,
        *ev_w_in, *ev_w_out, *pos_k, *pos_v, *ck_w1, *ck_w2, *cv_w1, *cv_w2, *od_w_in, *od_w_out, *q_norm, *kv_norm, *w_q_up, *w_kv_up, *sinks;
    float* out;
    unsigned* bar; int* cnt;
    float *modv, *ropec, *ropes, *blut, *gates, *kcmp, *vcmp, *chid, *kmean, *tokw;
    bf16_t *h, *proj, *o, *hid, *y, *proj1, *qmla, *kvmla, *krope, *cqn;
    int* list;
    bf16_t *wt_gu, *wt_d, *wt_in0, *wt_out0, *wt_c1, *wt_c2, *wt_in1, *wt_out1, *wt_qup, *wt_kvup, *chidb;
    float *c1, *c1p;
    int* wq;
    bf16_t* zrow;
    bf16_t *kcmpb, *kmeanb, *mlap;
    float* mlal;
    int* mcnt; unsigned short* mlist; bf16_t *mp01, *mp2; float* mpl;
};


__device__ __forceinline__ void st_prologue(const P& p, int wg, int nwg, float* sm) {
    const int TIDX = otid();
    const int tid = TIDX;
    {
        for (int i = tid; i < 2048; i += 256) sm[i] = siluf(p.c[i]);
        __syncthreads();
        const int wid = tid >> 6, lane = tid & 63;
        for (int w = wg; w < 192; w += nwg) {
            const int l = w / 96, cg = w % 96, col = cg * 64 + lane;
            const float* W = p.ada_w + (size_t)l * 1024 * 6144 + (size_t)(wid * 256) * 6144 + col;
            float a0 = 0.f, a1 = 0.f;
#pragma unroll 32
            for (int k = 0; k < 256; ++k) { const float wv = W[(size_t)k * 6144]; a0 += sm[wid * 256 + k] * wv; a1 += sm[1024 + wid * 256 + k] * wv; }
            sm[2048 + tid] = a0; sm[2304 + tid] = a1;
            __syncthreads();
            if (tid < 64) {
                const float bb = p.ada_b[l * 6144 + col];
                p.modv[(l * 2 + 0) * 6144 + col] = ((sm[2048 + tid] + sm[2048 + 64 + tid]) + (sm[2048 + 128 + tid] + sm[2048 + 192 + tid])) + bb;
                p.modv[(l * 2 + 1) * 6144 + col] = ((sm[2304 + tid] + sm[2304 + 64 + tid]) + (sm[2304 + 128 + tid] + sm[2304 + 192 + tid])) + bb;
            }
            __syncthreads();
        }
        __syncthreads();
    }
    for (int i = wg * 256 + tid; i < SEQ * 32; i += nwg * 256) {
        const int t = i >> 5, j = i & 31;
        const float inv = powf(10000.0f, -(float)(2 * j) / 64.0f);
        const float ang = (float)t * inv;
        p.ropec[i] = cosf(ang); p.ropes[i] = sinf(ang);
    }
    for (int i = wg * 256 + tid; i < 8 * 1024; i += nwg * 256) { const int h = i >> 10, d = i & 1023; p.blut[i] = p.rel[rel_bucket(d) * 8 + h]; }
}

template <int MODE>
__device__ __forceinline__ void st_norm(const P& p, int layer, int wg, int nwg, float* sm) {
    const int TIDX = otid();
    const int wid = TIDX >> 6, lane = TIDX & 63;
    int* rl_cnt = (int*)sm; int* rl_base = rl_cnt + 16; int* rl_ent = rl_cnt + 32;
    if (MODE == 1) { if (TIDX < 16) rl_cnt[TIDX] = 0; for (int i = TIDX; i < 64; i += 256) rl_ent[i] = -1; __syncthreads(); }
    const int niter = (T_TOK + nwg * 4 - 1) / (nwg * 4);
    const float* xin = (MODE == 0) ? p.x : p.out;
    float4 pre4[4];
    {
        const int row0 = wg * 4 + wid;
#pragma unroll
        for (int i = 0; i < 4; ++i) pre4[i] = (row0 < T_TOK) ? *(const float4*)(xin + (size_t)row0 * DM + i * 256 + lane * 4) : make_float4(0.f, 0.f, 0.f, 0.f);
    }
    for (int it = 0; it < niter; ++it) {
        const int row = wg * 4 + wid + it * nwg * 4;
        if (MODE != 1 && row >= T_TOK) break;
        float v[16];
#pragma unroll
        for (int i = 0; i < 4; ++i) { v[i * 4 + 0] = pre4[i].x; v[i * 4 + 1] = pre4[i].y; v[i * 4 + 2] = pre4[i].z; v[i * 4 + 3] = pre4[i].w; }
        {
            const int rown = row + nwg * 4;
            if (rown < T_TOK) {
#pragma unroll
                for (int i = 0; i < 4; ++i) pre4[i] = *(const float4*)(xin + (size_t)rown * DM + i * 256 + lane * 4);
            }
        }
        if (MODE != 1 || row < T_TOK) {
        const int b = row >> 13;
        if (MODE >= 2) {
            const int lp = (MODE == 2) ? layer - 1 : 1;
            const float* gf = p.modv + (size_t)(lp * 2 + b) * 6144 + 5 * 1024;
#pragma unroll
            for (int i = 0; i < 4; ++i)
#pragma unroll
                for (int j = 0; j < 4; ++j) {
                    const int col = i * 256 + lane * 4 + j;
                    const float y0 = bf2f(p.y[(size_t)(2 * row) * DM + col]), y1 = bf2f(p.y[(size_t)(2 * row + 1) * DM + col]);
                    v[i * 4 + j] += gf[col] * (y0 + y1);
                }
            if (MODE == 2) {
#pragma unroll
                for (int i = 0; i < 4; ++i)
                    *(float4*)(p.out + (size_t)row * DM + i * 256 + lane * 4) = make_float4(v[i * 4], v[i * 4 + 1], v[i * 4 + 2], v[i * 4 + 3]);
            }
        }
        float ss = 0.f;
#pragma unroll
        for (int i = 0; i < 16; ++i) ss += v[i] * v[i];
        ss = wsum(ss);
        const float r = rsqrtf(ss * (1.0f / 1024.0f) + 1e-6f);
        if (MODE == 3) {
#pragma unroll
            for (int i = 0; i < 4; ++i) {
                const float4 g4 = *(const float4*)(p.final_norm + i * 256 + lane * 4);
                *(float4*)(p.out + (size_t)row * DM + i * 256 + lane * 4) =
                    make_float4(v[i * 4] * r * g4.x, v[i * 4 + 1] * r * g4.y, v[i * 4 + 2] * r * g4.z, v[i * 4 + 3] * r * g4.w);
            }
            continue;
        }
        const float* g = ((MODE == 1) ? p.norm_ffn : p.norm_mix) + layer * 1024;
        const float* mv = p.modv + (size_t)(layer * 2 + b) * 6144;
        const float* shift = mv + ((MODE == 1) ? 3 : 0) * 1024;
        const float* scale = mv + ((MODE == 1) ? 4 : 1) * 1024;
        float hv[16];
#pragma unroll
        for (int i = 0; i < 4; ++i)
#pragma unroll
            for (int j = 0; j < 4; ++j) {
                const int col = i * 256 + lane * 4 + j;
                hv[i * 4 + j] = v[i * 4 + j] * r * g[col] * (1.0f + scale[col]) + shift[col];
                p.h[(size_t)row * DM + col] = f2bf(hv[i * 4 + j]);
            }
        if (MODE == 1) {
            float lg[16];
#pragma unroll
            for (int e = 0; e < 16; ++e) lg[e] = 0.f;
#pragma unroll
            for (int i = 0; i < 4; ++i)
#pragma unroll
                for (int j = 0; j < 4; ++j) {
                    const int col = i * 256 + lane * 4 + j;
                    const float* rw = p.router_w + col * 16;
#pragma unroll
                    for (int e = 0; e < 16; ++e) lg[e] += hv[i * 4 + j] * rw[e];
                    asm volatile("" ::: "memory");
                }
#pragma unroll
            for (int e = 0; e < 16; ++e) lg[e] = wsum(lg[e]);
            float aff[16], bi[16];
#pragma unroll
            for (int e = 0; e < 16; ++e) { aff[e] = 1.0f / (1.0f + expf(-lg[e])); bi[e] = aff[e] + p.router_b[e]; }
            float bestsc = -3e38f; int be0 = 0, be1 = 1; float bw0 = 0.f, bw1 = 0.f;
#pragma unroll
            for (int gI = 0; gI < 4; ++gI) {
                int i1 = 0; float m1 = bi[gI * 4];
#pragma unroll
                for (int i = 1; i < 4; ++i) if (bi[gI * 4 + i] > m1) { m1 = bi[gI * 4 + i]; i1 = i; }
                int i2 = -1; float m2 = -3e38f;
#pragma unroll
                for (int i = 0; i < 4; ++i) if (i != i1 && bi[gI * 4 + i] > m2) { m2 = bi[gI * 4 + i]; i2 = i; }
                const float sc = m1 + m2;
                float a1 = 0.f, a2 = 0.f;
#pragma unroll
                for (int i = 0; i < 4; ++i) { a1 = (i == i1) ? aff[gI * 4 + i] : a1; a2 = (i == i2) ? aff[gI * 4 + i] : a2; }
                if (sc > bestsc) { bestsc = sc; be0 = gI * 4 + i1; be1 = gI * 4 + i2; bw0 = a1; bw1 = a2; }
            }
            if (lane == 0) {
                const float ws = bw0 + bw1;
                p.tokw[row * 2] = bw0 / ws; p.tokw[row * 2 + 1] = bw1 / ws;
                const int s_ = (it & 7) * 4 + wid;
                const int r0 = atomicAdd(&rl_cnt[be0], 1), r1 = atomicAdd(&rl_cnt[be1], 1);
                rl_ent[s_ * 2] = (row << 12) | (be0 << 8) | r0;
                rl_ent[s_ * 2 + 1] = (row << 12) | (be1 << 8) | r1;
            }
        }
        }
        if (MODE == 1 && ((it & 7) == 7 || it == niter - 1)) {
            __syncthreads();
            if (TIDX < 16) { const int c = rl_cnt[TIDX]; rl_base[TIDX] = c ? atomicAdd(&p.cnt[(layer * 16 + TIDX) * 32], c) : 0; rl_cnt[TIDX] = 0; }
            __syncthreads();
            if (TIDX < 64) {
                const int en = rl_ent[TIDX];
                if (en >= 0) { const int e = (en >> 8) & 15; p.list[e * T_TOK + rl_base[e] + (en & 255)] = (en >> 12) * 2 + (TIDX & 1); rl_ent[TIDX] = -1; }
            }
            __syncthreads();
        }
    }
}

__device__ __forceinline__ void st_kmean(const P& p, int wg, int nwg, float* sm) {
    const int TIDX = otid();
    const int wid = TIDX >> 6, lane = TIDX & 63;
    for (int w = wg; w < 2 * 8 * 32; w += nwg) {
        const int b = w >> 8, h = (w >> 5) & 7, j = w & 31;
        const bf16_t* kp = p.proj + (size_t)(b * SEQ + j * 256 + wid * 64) * 2840 + 1816 + h * 64 + lane;
        float s = 0.f;
#pragma unroll 16
        for (int i = 0; i < 64; ++i) s += bf2f(kp[(size_t)i * 2840]);
        __syncthreads();
        sm[TIDX] = s;
        __syncthreads();
        if (TIDX < 64) {
            const float m = ((sm[TIDX] + sm[64 + TIDX]) + (sm[128 + TIDX] + sm[192 + TIDX])) * (1.0f / 256.0f);
            p.kmean[(size_t)w * 64 + TIDX] = m;
            p.kmeanb[(size_t)w * 64 + TIDX] = f2bf(m);
        }
    }
}
__device__ __forceinline__ void st_mla_prep(const P& p, int wg, int nwg) {
    const int TIDX = otid();
    const int wid = TIDX >> 6, lane = TIDX & 63;
    for (int row = wg * 4 + wid; row < T_TOK; row += nwg * 4) {
        const int t = row & (SEQ - 1);
        const bf16_t* pr = p.proj1 + (size_t)row * 1216;
        float q[4], ss = 0.f;
#pragma unroll
        for (int i = 0; i < 4; ++i) { q[i] = bf2f(pr[i * 64 + lane]); ss += q[i] * q[i]; }
        ss = wsum(ss);
        float r = rsqrtf(ss * (1.0f / 256.0f) + 1e-6f);
#pragma unroll
        for (int i = 0; i < 4; ++i) p.cqn[(size_t)row * 384 + i * 64 + lane] = f2bf(q[i] * r * p.q_norm[i * 64 + lane]);
        float kvv[2]; ss = 0.f;
#pragma unroll
        for (int i = 0; i < 2; ++i) { kvv[i] = bf2f(pr[256 + i * 64 + lane]); ss += kvv[i] * kvv[i]; }
        ss = wsum(ss);
        r = rsqrtf(ss * (1.0f / 128.0f) + 1e-6f);
#pragma unroll
        for (int i = 0; i < 2; ++i) p.cqn[(size_t)row * 384 + 256 + i * 64 + lane] = f2bf(kvv[i] * r * p.kv_norm[i * 64 + lane]);
        if (lane < 32) {
            const float x1 = bf2f(pr[384 + lane]), x2 = bf2f(pr[384 + 32 + lane]);
            const float cs = p.ropec[t * 32 + lane], sn = p.ropes[t * 32 + lane];
            p.krope[(size_t)row * 64 + lane] = f2bf(x1 * cs - x2 * sn);
            p.krope[(size_t)row * 64 + 32 + lane] = f2bf(x1 * sn + x2 * cs);
        }
    }
}


typedef short bf16x8 __attribute__((ext_vector_type(8)));
typedef float f32x4 __attribute__((ext_vector_type(4)));
typedef unsigned u32x2 __attribute__((ext_vector_type(2)));
typedef unsigned u32x4v __attribute__((ext_vector_type(4)));
#define LDSP __attribute__((address_space(3)))
#define GEMM_LDS_BYTES 65536

__device__ __forceinline__ unsigned pack_bf16(float lo, float hi) { return cvtpk(lo, hi); }

template <class AR, class BR, class Epi, class NX>
__device__ __forceinline__ void gemm128x(const int nk, const size_t akstep, const size_t bkstep, AR arow, BR brow, Epi epi, LDSP char* lds, const int tid, const bool staged, NX next) {
    const int wid = tid >> 6, lane = tid & 63, wr = wid >> 1, wc = wid & 1, fr = lane & 15, fq = lane >> 4;
    const int srow = tid >> 3, gch = ((tid & 7) ^ (srow & 7)) * 8;
    const bf16_t* ap0 = arow(srow) + gch; const bf16_t* ap1 = arow(32 + srow) + gch; const bf16_t* ap2 = arow(64 + srow) + gch; const bf16_t* ap3 = arow(96 + srow) + gch;
    const bf16_t* bp0 = brow(srow) + gch; const bf16_t* bp1 = brow(32 + srow) + gch; const bf16_t* bp2 = brow(64 + srow) + gch; const bf16_t* bp3 = brow(96 + srow) + gch;
    LDSP char* lw = lds + wid * 1024;
#define G128_ISSUE(st, kt) do { LDSP char* la_ = lw + (st) * 32768; const size_t ao_ = (size_t)(kt) * akstep, bo_ = (size_t)(kt) * bkstep; \
        __builtin_amdgcn_global_load_lds((const unsigned*)(ap0 + ao_), (LDSP unsigned*)(la_), 16, 0, 0); \
        __builtin_amdgcn_global_load_lds((const unsigned*)(ap1 + ao_), (LDSP unsigned*)(la_ + 4096), 16, 0, 0); \
        __builtin_amdgcn_global_load_lds((const unsigned*)(ap2 + ao_), (LDSP unsigned*)(la_ + 8192), 16, 0, 0); \
        __builtin_amdgcn_global_load_lds((const unsigned*)(ap3 + ao_), (LDSP unsigned*)(la_ + 12288), 16, 0, 0); \
        __builtin_amdgcn_global_load_lds((const unsigned*)(bp0 + bo_), (LDSP unsigned*)(la_ + 16384), 16, 0, 0); \
        __builtin_amdgcn_global_load_lds((const unsigned*)(bp1 + bo_), (LDSP unsigned*)(la_ + 16384 + 4096), 16, 0, 0); \
        __builtin_amdgcn_global_load_lds((const unsigned*)(bp2 + bo_), (LDSP unsigned*)(la_ + 16384 + 8192), 16, 0, 0); \
        __builtin_amdgcn_global_load_lds((const unsigned*)(bp3 + bo_), (LDSP unsigned*)(la_ + 16384 + 12288), 16, 0, 0); } while (0)
    f32x4 acc[4][4];
#pragma unroll
    for (int m = 0; m < 4; ++m)
#pragma unroll
        for (int n = 0; n < 4; ++n) acc[m][n] = (f32x4){0.f, 0.f, 0.f, 0.f};
    const int aoff = (wr * 64 + fr) * 128, boff = 16384 + (wc * 64 + fr) * 128, c0 = (fq ^ (fr & 7)) * 16;
    if (!staged) G128_ISSUE(0, 0);
    for (int kt = 0; kt < nk; ++kt) {
        const int cur = kt & 1;
        asm volatile("s_waitcnt vmcnt(0)" ::: "memory");
        __builtin_amdgcn_s_barrier();
        asm volatile("" ::: "memory");
        if (kt + 1 < nk) G128_ISSUE(cur ^ 1, kt + 1);
        LDSP char* sb = lds + cur * 32768;
#pragma unroll
        for (int kk = 0; kk < 2; ++kk) {
            const int cc = kk ? (c0 ^ 64) : c0;
            bf16x8 af[4], bf[4];
#pragma unroll
            for (int m = 0; m < 4; ++m) af[m] = *(const LDSP bf16x8*)(sb + aoff + m * 2048 + cc);
#pragma unroll
            for (int n = 0; n < 4; ++n) bf[n] = *(const LDSP bf16x8*)(sb + boff + n * 2048 + cc);
#pragma unroll
            for (int m = 0; m < 4; ++m)
#pragma unroll
                for (int n = 0; n < 4; ++n) acc[m][n] = __builtin_amdgcn_mfma_f32_16x16x32_bf16(bf[n], af[m], acc[m][n], 0, 0, 0);
        }
    }
    asm volatile("s_waitcnt lgkmcnt(0)" ::: "memory");
    __builtin_amdgcn_s_barrier();
    asm volatile("" ::: "memory");
    next();
#undef G128_ISSUE
#pragma unroll
    for (int m = 0; m < 4; ++m) epi(wr * 64 + m * 16 + fr, wc * 64 + fq * 4, acc[m], m);
}

template <class AR, class BR>
__device__ __forceinline__ void g128_stage0(AR arow, BR brow, LDSP char* lds, const int tid) {
    const int wid = tid >> 6, srow = tid >> 3, gch = ((tid & 7) ^ (srow & 7)) * 8;
    LDSP char* lw = lds + wid * 1024;
#pragma unroll
    for (int i = 0; i < 4; ++i) {
        __builtin_amdgcn_global_load_lds((const unsigned*)(arow(32 * i + srow) + gch), (LDSP unsigned*)(lw + 4096 * i), 16, 0, 0);
    }
#pragma unroll
    for (int i = 0; i < 4; ++i) {
        __builtin_amdgcn_global_load_lds((const unsigned*)(brow(32 * i + srow) + gch), (LDSP unsigned*)(lw + 16384 + 4096 * i), 16, 0, 0);
    }
}
template <class AR, class BR, class Epi>
__device__ __forceinline__ void gemm128(const int nk, const size_t akstep, const size_t bkstep, AR arow, BR brow, Epi epi, LDSP char* lds, const int tid) {
    gemm128x(nk, akstep, bkstep, arow, brow, epi, lds, tid, false, [] {});
}

template <int MAP> __device__ __forceinline__ int conv_rowmap(int n) {
    if (MAP == 0) return n;
    const int tile = n >> 6, cc = n & 63, wc = cc >> 5, i16 = (cc >> 4) & 1, i = cc & 15;
    return tile * 128 + wc * 64 + ((MAP == 1 ? 0 : 2) + i16) * 16 + i;
}
template <int MAP>
__device__ __forceinline__ void conv_batched(const float* src, int nmat, int K, int N, size_t sstride, bf16_t* dst, size_t dstride, int wg, int nwg, float* sm, int tid, int wend = 0x7fffffff) {
    float(*t)[65] = (float(*)[65])sm;
    const int tk = K >> 6, tn = (N + 63) >> 6, per = tk * tn, total = (nmat * per < wend) ? nmat * per : wend;
    f32x4 v[4];
    auto ld = [&](int w) {
        const int mat = w / per, r = w % per, kt = r / tn, nt = r % tn;
        const float* s = src + (size_t)mat * sstride;
#pragma unroll
        for (int i = 0; i < 4; ++i) {
            const int idx = tid + 256 * i, k = idx >> 4, n = (idx & 15) * 4;
            v[i] = (f32x4){0.f, 0.f, 0.f, 0.f};
            if (nt * 64 + n < N) v[i] = *(const f32x4*)(s + (size_t)(kt * 64 + k) * N + nt * 64 + n);
        }
    };
    if (wg < total) ld(wg);
    for (int w = wg; w < total; w += nwg) {
        const int mat = w / per, r = w % per, kt = r / tn, nt = r % tn;
        bf16_t* d = dst + (size_t)mat * dstride;
#pragma unroll
        for (int i = 0; i < 4; ++i) {
            const int idx = tid + 256 * i, k = idx >> 4, n = (idx & 15) * 4;
            t[k][n] = v[i][0]; t[k][n + 1] = v[i][1]; t[k][n + 2] = v[i][2]; t[k][n + 3] = v[i][3];
        }
        __syncthreads();
        if (w + nwg < total) ld(w + nwg);
        {
            const int n = tid >> 2, kq = (tid & 3) * 16;
            if (nt * 64 + n < N) {
                unsigned pk[8];
#pragma unroll
                for (int j = 0; j < 8; ++j) pk[j] = cvtpk(t[kq + 2 * j][n], t[kq + 2 * j + 1][n]);
                bf16_t* o = d + (size_t)conv_rowmap<MAP>(nt * 64 + n) * K + kt * 64 + kq;
                *(u32x4v*)o = (u32x4v){pk[0], pk[1], pk[2], pk[3]};
                *(u32x4v*)(o + 8) = (u32x4v){pk[4], pk[5], pk[6], pk[7]};
            }
        }
        __syncthreads();
    }
}
__device__ __forceinline__ void st_convert(const P& p, int wg, int nwg, float* sm) {
    const int tid = otid();
    conv_batched<0>(p.ev_w_in, 1, 1024, 2840, 0, p.wt_in0, 0, wg, nwg, sm, tid);
    conv_batched<0>(p.ev_w_out, 1, 1024, 1024, 0, p.wt_out0, 0, wg, nwg, sm, tid);
    conv_batched<0>(p.ck_w1, 1, 2048, 256, 0, p.wt_c1, 0, wg, nwg, sm, tid);
    conv_batched<0>(p.cv_w1, 1, 2048, 256, 0, p.wt_c1 + 256 * 2048, 0, wg, nwg, sm, tid);
    conv_batched<0>(p.ck_w2, 1, 256, 64, 0, p.wt_c2, 0, wg, nwg, sm, tid);
    conv_batched<0>(p.cv_w2, 1, 256, 64, 0, p.wt_c2 + 64 * 256, 0, wg, nwg, sm, tid);
    conv_batched<0>(p.od_w_in, 1, 1024, 1216, 0, p.wt_in1, 0, wg, nwg, sm, tid);
    conv_batched<0>(p.od_w_out, 1, 1024, 1024, 0, p.wt_out1, 0, wg, nwg, sm, tid);
    conv_batched<0>(p.w_q_up, 1, 256, 768, 0, p.wt_qup, 0, wg, nwg, sm, tid);
    conv_batched<0>(p.w_kv_up, 1, 128, 1024, 0, p.wt_kvup, 0, wg, nwg, sm, tid);
    {
        const int wid = tid >> 6, lane = tid & 63;
        for (int w = wg * 4 + wid; w < 512; w += nwg * 4) {
            const int which = w >> 8, cg = (w >> 6) & 3, ks = w & 63, col = cg * 64 + lane;
            const float* w1 = (which ? p.cv_w1 : p.ck_w1) + (size_t)(ks * 32) * 256 + col; const float* pos = (which ? p.pos_v : p.pos_k) + ks * 32;
            float a = 0.f;
#pragma unroll
            for (int k = 0; k < 32; ++k) a += pos[k] * w1[(size_t)k * 256];
            p.c1p[(which * 64 + ks) * 256 + col] = a;
        }
    }
}
__device__ __forceinline__ void st_c1_reduce(const P& p, int wg, int nwg) {
    const int tid = otid();
    for (int i = wg * 256 + tid; i < 512; i += nwg * 256) {
        const int which = i >> 8, col = i & 255;
        float a = 0.f;
#pragma unroll 16
        for (int ks = 0; ks < 64; ++ks) a += p.c1p[(which * 64 + ks) * 256 + col];
        p.c1[i] = a;
    }
}


struct XcdOrder {
    int xcd, lw, nlw, tn, per;
    __device__ __forceinline__ XcdOrder(int wg, int nwg, int nM, int tn_) : xcd(wg & 7), lw(wg >> 3), nlw(nwg >> 3), tn(tn_), per((nM >> 3) * tn_) {}
    __device__ __forceinline__ bool get(int k, int& mt, int& nt) const { const int lt = lw + k * nlw; if (lt >= per) return false; mt = xcd + 8 * (lt / tn); nt = lt % tn; return true; }
};
__device__ __forceinline__ void st_inproj0_mf(const P& p, int wg, int nwg, LDSP char* lds) {
    const int tid = otid();
    const XcdOrder ord(wg, nwg, 128, 23);
    auto Af = [&](int mt_) { return [=](int r) { return p.h + (size_t)(mt_ * 128 + r) * DM; }; };
    auto Bf = [&](int nt_) { return [=](int r) { int n = nt_ * 128 + r; n = n < 2840 ? n : 2839; return p.wt_in0 + (size_t)n * 1024; }; };
    bool staged = false;
    for (int k = 0;; ++k) {
        int mt, nt, mt2 = 0, nt2 = 0;
        if (!ord.get(k, mt, nt)) break;
        const bool has2 = ord.get(k + 1, mt2, nt2);
        const bool st_ = staged; staged = has2;
        gemm128x(16, 64, 64, Af(mt), Bf(nt),
            [&](int rl, int cl, const f32x4 (&a)[4], int mfrag) {
                const int row = mt * 128 + rl;
#pragma unroll
                for (int n = 0; n < 4; ++n) {
                    const int col = nt * 128 + cl + n * 16;
                    if (col < 2840) {
                        *(u32x2*)(p.proj + (size_t)row * 2840 + col) = (u32x2){pack_bf16(a[n][0], a[n][1]), pack_bf16(a[n][2], a[n][3])};
                        if (col >= 1280 && col < 1304)
                            *(f32x4*)(p.gates + (size_t)row * 24 + (col - 1280)) = (f32x4){sigmf(a[n][0]), sigmf(a[n][1]), sigmf(a[n][2]), sigmf(a[n][3])};
                    }
                }
            }, lds, tid, st_, [&] { if (has2) g128_stage0(Af(mt2), Bf(nt2), lds, tid); });
    }
}
__device__ __forceinline__ void st_cmp1_mf(const P& p, int wg, int nwg, LDSP char* lds) {
    const int tid = otid();
    for (int w = wg; w < 2 * 16 * 2; w += nwg) {
        const int which = w >> 5, mt = (w >> 1) & 15, nt = w & 1;
        const int colbase = which ? 640 : 512;
        gemm128(32, 2840, 64,
            [&](int r) { int m = mt * 128 + r; m = m < 2044 ? m : 2043; const int bk = m / 511, n = m % 511, b = bk >> 1, kv = bk & 1;
                         return p.proj + (size_t)(b * SEQ + 16 * n) * 2840 + colbase + kv * 64; },
            [&](int r) { return p.wt_c1 + (size_t)(which * 256 + nt * 128 + r) * 2048; },
            [&](int rl, int cl, const f32x4 (&a)[4], int mfrag) {
                const int m = mt * 128 + rl;
                if (m < 2044) {
#pragma unroll
                    for (int n = 0; n < 4; ++n) {
                        const int col = nt * 128 + cl + n * 16;
                        const f32x4 cb = *(const f32x4*)(p.c1 + which * 256 + col);
                        *(u32x2*)(p.chidb + (size_t)(which * 2048 + m) * 256 + col) =
                            (u32x2){pack_bf16(gelu_tanh(a[n][0] + cb[0]), gelu_tanh(a[n][1] + cb[1])), pack_bf16(gelu_tanh(a[n][2] + cb[2]), gelu_tanh(a[n][3] + cb[3]))};
                    }
                }
            }, lds, tid);
    }
}
__device__ __forceinline__ void st_cmp2_mf(const P& p, int wg, int nwg, LDSP char* lds) {
    const int tid = otid();
    for (int w = wg; w < 2 * 16; w += nwg) {
        const int which = w >> 4, mt = w & 15;
        gemm128(4, 64, 64,
            [&](int r) { int m = mt * 128 + r; m = m < 2044 ? m : 2043; return p.chidb + (size_t)(which * 2048 + m) * 256; },
            [&](int r) { return p.wt_c2 + (size_t)(which * 64 + (r & 63)) * 256; },
            [&](int rl, int cl, const f32x4 (&a)[4], int mfrag) {
                const int m = mt * 128 + rl;
                if (m < 2044) {
#pragma unroll
                    for (int n = 0; n < 4; ++n) { const int col = cl + n * 16; if (col < 64) {
                        const int bk = m / 511, nn = m % 511;
                        *(u32x2*)(p.kcmpb + ((size_t)((which * 4 + bk) * 512 + nn)) * 64 + col) = (u32x2){cvtpk(a[n][0], a[n][1]), cvtpk(a[n][2], a[n][3])}; } }
                }
            }, lds, tid);
    }
}
__device__ __forceinline__ void st_outproj_mf(const P& p, int layer, int wg, int nwg, LDSP char* lds) {
    const int tid = otid();
    const bf16_t* W = layer ? p.wt_out1 : p.wt_out0;
    const float* xin = layer ? p.out : p.x;
    const XcdOrder ord(wg, nwg, 128, 8);
    auto Af = [&](int mt_) { return [=](int r) { return p.o + (size_t)(mt_ * 128 + r) * DM; }; };
    auto Bf = [&](int nt_) { return [=](int r) { return W + (size_t)(nt_ * 128 + r) * 1024; }; };
    bool staged = false;
    for (int k = 0;; ++k) {
        int mt, nt, mt2 = 0, nt2 = 0;
        if (!ord.get(k, mt, nt)) break;
        const bool has2 = ord.get(k + 1, mt2, nt2);
        const bool st_ = staged; staged = has2;
        gemm128x(16, 64, 64, Af(mt), Bf(nt),
            [&](int rl, int cl, const f32x4 (&a)[4], int mfrag) {
                const int row = mt * 128 + rl, b = row >> 13;
                const float* g = p.modv + (size_t)(layer * 2 + b) * 6144 + 2 * 1024;
#pragma unroll
                for (int n = 0; n < 4; ++n) {
                    const int col = nt * 128 + cl + n * 16;
                    const f32x4 xv = *(const f32x4*)(xin + (size_t)row * DM + col), gv = *(const f32x4*)(g + col);
                    *(f32x4*)(p.out + (size_t)row * DM + col) = xv + gv * a[n];
                }
            }, lds, tid, st_, [&] { if (has2) g128_stage0(Af(mt2), Bf(nt2), lds, tid); });
    }
}
__device__ __forceinline__ bool moe_tile128(const int* cnt, int tt, int& e, int& i0, int& off) {
    int acc = 0, o = 0;
    for (int q = 0; q < 16; ++q) {
        const int c = cnt[q * 32], nt = (c + 127) >> 7;
        if (tt < acc + nt) { e = q; i0 = (tt - acc) * 128; off = o; return true; }
        acc += nt; o += c;
    }
    return false;
}
struct MoeTile { int e, i0, off, nt, ce; bool ok; };
__device__ __forceinline__ MoeTile moe_get(const int* cnt, int w) {
    MoeTile t; t.ok = moe_tile128(cnt, w >> 3, t.e, t.i0, t.off); t.nt = w & 7; t.ce = t.ok ? cnt[t.e * 32] : 0; return t;
}
__device__ __forceinline__ void st_moe_up_mf(const P& p, int layer, int wg, int nwg, LDSP char* lds) {
    const int tid = otid();
    const int* cnt = p.cnt + layer * 512;
    auto Af = [&](const MoeTile& t) { const int* lst = p.list + t.e * T_TOK; const int i0 = t.i0, ce = t.ce;
                                      return [=](int r) { const int i = (i0 + r < ce) ? i0 + r : i0; return p.h + (size_t)(lst[i] >> 1) * DM; }; };
    auto Bf = [&](const MoeTile& t) { const bf16_t* B = p.wt_gu + ((size_t)(layer * 16 + t.e) * 1024 + t.nt * 128) * 1024; return [=](int r) { return B + (size_t)r * 1024; }; };
    MoeTile cur = moe_get(cnt, wg);
    bool staged = false;
    for (int w = wg; cur.ok; w += nwg) {
        const MoeTile nx = moe_get(cnt, w + nwg);
        const bool st_ = staged; staged = nx.ok;
        const int i0 = cur.i0, ce = cur.ce, off = cur.off, nt = cur.nt;
        gemm128x(16, 64, 64, Af(cur), Bf(cur),
            [&](int rl, int cl, const f32x4 (&a)[4], int mfrag) {
                if (i0 + rl < ce) {
                    const int wc = cl >> 6, fq4 = cl & 63;
#pragma unroll
                    for (int n = 0; n < 2; ++n) {
                        const int col = nt * 64 + wc * 32 + n * 16 + fq4;
                        const f32x4 g = a[n], u = a[n + 2];
                        *(u32x2*)(p.hid + (size_t)(off + i0 + rl) * 512 + col) =
                            (u32x2){pack_bf16(siluf(g[0]) * u[0], siluf(g[1]) * u[1]), pack_bf16(siluf(g[2]) * u[2], siluf(g[3]) * u[3])};
                    }
                }
            }, lds, tid, st_, [&] { if (nx.ok) g128_stage0(Af(nx), Bf(nx), lds, tid); });
        cur = nx;
    }
}
__device__ __forceinline__ void st_moe_down_mf(const P& p, int layer, int wg, int nwg, LDSP char* lds) {
    const int tid = otid();
    const int* cnt = p.cnt + layer * 512;
    auto Af = [&](const MoeTile& t) { const int i0 = t.i0, ce = t.ce, off = t.off; return [=](int r) { const int i = (i0 + r < ce) ? i0 + r : i0; return p.hid + (size_t)(off + i) * 512; }; };
    auto Bf = [&](const MoeTile& t) { const bf16_t* B = p.wt_d + ((size_t)(layer * 16 + t.e) * 1024 + t.nt * 128) * 512; return [=](int r) { return B + (size_t)r * 512; }; };
    MoeTile cur = moe_get(cnt, wg);
    bool staged = false;
    for (int w = wg; cur.ok; w += nwg) {
        const MoeTile nx = moe_get(cnt, w + nwg);
        const bool st_ = staged; staged = nx.ok;
        const int i0 = cur.i0, ce = cur.ce, nt = cur.nt;
        const int* lst = p.list + cur.e * T_TOK;
        int ids[4]; float wts[4];
#pragma unroll
        for (int m = 0; m < 4; ++m) { const int rl = ((tid >> 7) & 1) * 64 + m * 16 + (tid & 15); ids[m] = (i0 + rl < ce) ? lst[i0 + rl] : -1; }
#pragma unroll
        for (int m = 0; m < 4; ++m) wts[m] = ids[m] >= 0 ? p.tokw[ids[m]] : 0.f;
        gemm128x(8, 64, 64, Af(cur), Bf(cur),
            [&](int rl, int cl, const f32x4 (&a)[4], int mfrag) {
                if (i0 + rl < ce) {
                    const int id = ids[mfrag]; const float wt = wts[mfrag];
#pragma unroll
                    for (int n = 0; n < 4; ++n) {
                        const int col = nt * 128 + cl + n * 16;
                        *(u32x2*)(p.y + (size_t)id * DM + col) = (u32x2){pack_bf16(wt * a[n][0], wt * a[n][1]), pack_bf16(wt * a[n][2], wt * a[n][3])};
                    }
                }
            }, lds, tid, st_, [&] { if (nx.ok) g128_stage0(Af(nx), Bf(nx), lds, tid); });
        cur = nx;
    }
}
__device__ __forceinline__ void st_inproj1_mf(const P& p, int wg, int nwg, LDSP char* lds) {
    const int tid = otid();
    const XcdOrder ord(wg, nwg, 128, 10);
    auto Af = [&](int mt_) { return [=](int r) { return p.h + (size_t)(mt_ * 128 + r) * DM; }; };
    auto Bf = [&](int nt_) { return [=](int r) { int n = nt_ * 128 + r; n = n < 1216 ? n : 1215; return p.wt_in1 + (size_t)n * 1024; }; };
    bool staged = false;
    for (int k = 0;; ++k) {
        int mt, nt, mt2 = 0, nt2 = 0;
        if (!ord.get(k, mt, nt)) break;
        const bool has2 = ord.get(k + 1, mt2, nt2);
        const bool st_ = staged; staged = has2;
        gemm128x(16, 64, 64, Af(mt), Bf(nt),
            [&](int rl, int cl, const f32x4 (&a)[4], int mfrag) {
                const int row = mt * 128 + rl;
#pragma unroll
                for (int n = 0; n < 4; ++n) {
                    const int col = nt * 128 + cl + n * 16;
                    if (col < 1216) *(u32x2*)(p.proj1 + (size_t)row * 1216 + col) = (u32x2){pack_bf16(a[n][0], a[n][1]), pack_bf16(a[n][2], a[n][3])};
                }
            }, lds, tid, st_, [&] { if (has2) g128_stage0(Af(mt2), Bf(nt2), lds, tid); });
    }
}
__device__ __forceinline__ void st_mla_up_mf(const P& p, int wg, int nwg, LDSP char* lds) {
    const int tid = otid();
    const XcdOrder ord(wg, nwg, 128, 14);
    for (int k = 0;; ++k) {
        int mt, c;
        if (!ord.get(k, mt, c)) break;
        if (c < 6) {
            gemm128(4, 64, 64,
                [&](int r) { return p.cqn + (size_t)(mt * 128 + r) * 384; },
                [&](int r) { return p.wt_qup + (size_t)(c * 128 + r) * 256; },
                [&](int rl, int cl, const f32x4 (&a)[4], int mfrag) {
                    const int row = mt * 128 + rl, wc = cl >> 6;
                    f32x4 v[4] = {a[0], a[1], a[2], a[3]};
                    if (((c == 1 || c == 4) && wc == 0) || ((c == 2 || c == 5) && wc == 1)) {
                        const int t = row & (SEQ - 1), i0 = cl & 63;
#pragma unroll
                        for (int n = 0; n < 2; ++n) {
                            const f32x4 cs = *(const f32x4*)(p.ropec + t * 32 + n * 16 + i0), sn = *(const f32x4*)(p.ropes + t * 32 + n * 16 + i0);
                            v[n] = a[n] * cs - a[n + 2] * sn; v[n + 2] = a[n] * sn + a[n + 2] * cs;
                        }
                    }
#pragma unroll
                    for (int n = 0; n < 4; ++n) *(u32x2*)(p.qmla + (size_t)row * 768 + c * 128 + cl + n * 16) = (u32x2){cvtpk(v[n][0], v[n][1]), cvtpk(v[n][2], v[n][3])};
                }, lds, tid);
        } else {
            gemm128(2, 64, 64,
                [&](int r) { return p.cqn + (size_t)(mt * 128 + r) * 384 + 256; },
                [&](int r) { return p.wt_kvup + (size_t)((c - 6) * 128 + r) * 128; },
                [&](int rl, int cl, const f32x4 (&a)[4], int mfrag) {
                    const int row = mt * 128 + rl;
#pragma unroll
                    for (int n = 0; n < 4; ++n) *(u32x2*)(p.kvmla + (size_t)row * 1024 + (c - 6) * 128 + cl + n * 16) = (u32x2){pack_bf16(a[n][0], a[n][1]), pack_bf16(a[n][2], a[n][3])};
                }, lds, tid);
        }
    }
}

typedef float f32x16 __attribute__((ext_vector_type(16)));
typedef short s16x4 __attribute__((ext_vector_type(4)));
#define ATT_NEG (-1e30f)
#define ATT_SHIFT (-16.0f)
#define LOG2E 1.4426950408889634f

__device__ __forceinline__ int swz128(int row) { return (((row >> 1) & 1) << 2) | ((row >> 2) & 3); }
__device__ __forceinline__ int swz256(int row) { return ((row & 3) << 2) | ((row >> 2) & 3); }

struct AttLane {
    int kbase;
    int v0[2];
};
template <int KROWB, int VROWB, int DT>
__device__ __forceinline__ void att_lane_init(AttLane& L, int lane) {
    const int q = lane & 31, hh = lane >> 5, x = hh ^ swz128(q);
    L.kbase = q * KROWB + x * 16;
    const int rl = 4 * hh + ((lane & 15) >> 2), blk = (lane >> 4) & 1, pp = lane & 3;
#pragma unroll
    for (int t = 0; t < 2; ++t) {
        const int g = (VROWB == 256) ? (((rl & 3) << 2) | ((2 * t + hh) & 3)) : ((((rl >> 1) & 1) << 2) | ((2 * t + hh) & 3));
        L.v0[t] = rl * VROWB + (((2 * blk + (pp >> 1)) ^ g) * 16) + 8 * (pp & 1);
    }
}
template <int KS, int KROWB, int MODE, bool WANT_P, bool IMP>
__device__ __forceinline__ void att_qk(LDSP const char* kb, const AttLane& L, const bf16x8 (&qf)[KS], bf16x8 (&pf)[4], float& lsum, const float c1, const float cadd,
                                       const unsigned lutv, const int dq16, LDSP float* improw, const float invl) {
    float la = 0.f, lb = 0.f, lc = 0.f, ld = 0.f;
#pragma unroll
    for (int kt = 0; kt < 2; ++kt) {
        f32x16 s;
#pragma unroll
        for (int r = 0; r < 16; ++r) s[r] = 0.f;
        constexpr int KG = (KS > 4) ? 2 : 4;
#pragma unroll
        for (int k4 = 0; k4 < KS; k4 += KG) {
            bf16x8 a[KG];
#pragma unroll
            for (int j = 0; j < KG; ++j) { const int ks = k4 + j; a[j] = *(const LDSP bf16x8*)(kb + (L.kbase ^ (32 * (ks & 3))) + (ks >> 2) * 128 + kt * 32 * KROWB); }
#pragma unroll
            for (int j = 0; j < KG; ++j) s = __builtin_amdgcn_mfma_f32_32x32x16_bf16(a[j], qf[k4 + j], s, 0, 0, 0);
            asm volatile("" ::: "memory");
        }
        float pr[16];
#pragma unroll
        for (int r = 0; r < 16; ++r) {
            const int koff = 32 * kt + (r & 3) + 8 * (r >> 2);
            float add = cadd;
            if (MODE == 1) add = *(const LDSP float*)(lutv + (63 - koff) * 4);
            if (MODE == 2) { int d = dq16 - 16 * koff; d = d < -1 ? -1 : d; d = d > 1087 ? 1087 : d; add = *(const LDSP float*)(lutv + (unsigned)(64 + d) * 4u); }
            pr[r] = __builtin_amdgcn_exp2f(__builtin_fmaf(s[r], c1, add));
        }
#pragma unroll
        for (int r = 0; r < 16; r += 4) { la += pr[r]; lb += pr[r + 1]; lc += pr[r + 2]; ld += pr[r + 3]; }
        if (IMP) {
#pragma unroll
            for (int g = 0; g < 4; ++g) {
                (void)__hip_atomic_fetch_add((LDSP unsigned*)improw + 8 * kt + 2 * g, (unsigned)(((pr[4 * g] + pr[4 * g + 1]) + (pr[4 * g + 2] + pr[4 * g + 3])) * invl + 0.5f), __ATOMIC_RELAXED, __HIP_MEMORY_SCOPE_WORKGROUP);
                (void)__hip_atomic_fetch_add((LDSP unsigned*)improw + 8 * kt + 2 * g + 1, (unsigned)(pr[4 * g + 3] * invl + 0.5f), __ATOMIC_RELAXED, __HIP_MEMORY_SCOPE_WORKGROUP);
            }
        }
        if (WANT_P) {
#pragma unroll
            for (int sI = 0; sI < 2; ++sI) {
                union { unsigned u[4]; bf16x8 v; } cv;
#pragma unroll
                for (int i = 0; i < 4; ++i) cv.u[i] = cvtpk_valu(pr[8 * sI + 2 * i], pr[8 * sI + 2 * i + 1]);
                pf[kt * 2 + sI] = cv.v;
            }
        }
    }
    lsum += (la + lb) + (lc + ld);
}
template <int DT, int VROWB>
__device__ __forceinline__ void att_pv(LDSP const char* vb, const AttLane& L, const bf16x8 (&pf)[4], f32x16 (&o)[DT]) {
    const unsigned vba = (unsigned)(size_t)vb;
#pragma unroll
    for (int ks2 = 0; ks2 < 4; ++ks2) {
#pragma unroll
        for (int d0 = 0; d0 < DT; d0 += 2) {
            s16x4 lo[2], hi[2];
#pragma unroll
            for (int j = 0; j < 2; ++j) {
                asm volatile("ds_read_b64_tr_b16 %0, %1 offset:%2" : "=v"(lo[j]) : "v"(vba + (L.v0[0] ^ ((d0 + j) << 6))), "i"((16 * ks2) * VROWB) : "memory");
                asm volatile("ds_read_b64_tr_b16 %0, %1 offset:%2" : "=v"(hi[j]) : "v"(vba + (L.v0[1] ^ ((d0 + j) << 6))), "i"((16 * ks2 + 8) * VROWB) : "memory");
            }
            asm volatile("s_waitcnt lgkmcnt(0)" ::: "memory");
#pragma unroll
            for (int j = 0; j < 2; ++j) {
                asm volatile("" : "+v"(lo[j]), "+v"(hi[j]));
                const bf16x8 vf = __builtin_shufflevector(lo[j], hi[j], 0, 1, 2, 3, 4, 5, 6, 7);
                o[d0 + j] = __builtin_amdgcn_mfma_f32_32x32x16_bf16(vf, pf[ks2], o[d0 + j], 0, 0, 0);
            }
        }
    }
}
template <int CPR>
__device__ __forceinline__ void att_stage_map(int (&rowc)[(CPR == 24) ? 6 : 1], int tid) {
    if (CPR == 24) {
#pragma unroll
        for (int i = 0; i < 6; ++i) {
            const int c = tid + 256 * i, row = c / 24, cc = c % 24;
            rowc[i % ((CPR == 24) ? 6 : 1)] = (row << 8) | ((cc & ~7) | ((cc & 7) ^ swz128(row)));
        }
    } else if (CPR == 16) {
        const int row = tid >> 4; rowc[0] = (row << 8) | ((tid & 15) ^ swz256(row));
    } else {
        const int row = tid >> 3; rowc[0] = (row << 8) | ((tid & 7) ^ swz128(row));
    }
}
template <int CPR, class SRC>
__device__ __forceinline__ void att_stage(LDSP char* dst, SRC src, const int (&rowc)[(CPR == 24) ? 6 : 1], int wid) {
#pragma unroll
    for (int i = 0; i < CPR / 4; ++i) {
        const int rc = rowc[(CPR == 24) ? i : 0];
        const int row = (rc >> 8) + ((CPR == 24) ? 0 : i * (256 / CPR));
        __builtin_amdgcn_global_load_lds((const unsigned*)src(row, rc & 255), (LDSP unsigned*)(dst + (256 * i + 64 * wid) * 16), 16, 0, 0);
    }
}
__device__ __forceinline__ int wq_next(int* ctr, LDSP int* slot, int tid) {
    __syncthreads();
    if (tid == 0) *slot = atomicAdd(ctr, 1);
    __syncthreads();
    return *slot;
}

__device__ __forceinline__ void build_lut(LDSP float* tab, const float* blut_h, int n, int wlimit, int tid) {
    for (int i = tid; i < n; i += 256) { const int d = i - 64; tab[i] = (d < 0 || d >= wlimit) ? ATT_NEG : blut_h[d > 1023 ? 1023 : d] * LOG2E + ATT_SHIFT; }
}
#define ATT_BAR() do { __builtin_amdgcn_s_barrier(); asm volatile("" ::: "memory"); } while (0)

__device__ __forceinline__ void mla_item(const P& p, const int item, LDSP char* lds, const int tid0) {
    LDSP char* kb = lds; LDSP char* vb = lds + 24576; LDSP float* lut = (LDSP float*)(lds + 40960);
    const float c1 = 0.07216878364870322f * LOG2E;
    int tid = tid0; asm volatile("" : "+v"(tid));
    const int wid = tid >> 6, lane = tid & 63, q = lane & 31, hh = lane >> 5;
    AttLane L; att_lane_init<384, 256, 4>(L, lane);
    int krc[6], vrc[1];
    att_stage_map<24>(krc, tid); att_stage_map<16>(vrc, tid);
    int qt, bh, part;
    if (item >= 640) { const int r = item - 640; qt = 15 - (r >> 3); bh = r & 7; part = 0; }
    else {
        int g = 0; while (16 * (g + 1) + 8 * ((g + 2) >> 1) <= item) ++g;
        const int r = item - (16 * g + 8 * ((g + 1) >> 1)), Ln = 64 - g;
        if (r < 16) { qt = Ln - 1; bh = r & 7; part = 1 + (r >> 3); } else { qt = (Ln >> 1) - 1; bh = (r - 16) & 7; part = 0; }
    }
    const int b = bh >> 2, h = bh & 3;
    const int tw = qt * 128 + wid * 32;
    bf16x8 qf[12];
    {
        const bf16_t* qp = p.qmla + (size_t)(b * SEQ + tw + q) * 768 + h * 192 + 8 * hh;
#pragma unroll
        for (int ks = 0; ks < 12; ++ks) qf[ks] = *(const bf16x8*)(qp + 16 * ks);
    }
    f32x16 o[4];
#pragma unroll
    for (int dt = 0; dt < 4; ++dt)
#pragma unroll
        for (int r = 0; r < 16; ++r) o[dt][r] = 0.f;
    float lsum = 0.f;
    const int i0 = (part == 2) ? qt + 1 : 0, ntiles = (part == 1) ? qt + 1 : 2 * qt + 2;
    const bf16_t* kvb = p.kvmla + (size_t)b * SEQ * 1024 + h * 256;
    const bf16_t* krb = p.krope + (size_t)b * SEQ * 64;
    auto ksrc = [&](int pos0) { return [=](int row, int gc) { return gc < 16 ? kvb + (size_t)(pos0 + row) * 1024 + gc * 8 : krb + (size_t)(pos0 + row) * 64 + (gc - 16) * 8; }; };
    auto vsrc = [&](int pos0) { return [=](int row, int gc) { return kvb + (size_t)(pos0 + row) * 1024 + 128 + gc * 8; }; };
    att_stage<24>(kb, ksrc(i0 * 64), krc, wid);
    for (int i = i0; i < ntiles; ++i) {
        const int pos0 = i * 64;
        asm volatile("s_waitcnt vmcnt(0)" ::: "memory"); ATT_BAR();
        att_stage<16>(vb, vsrc(pos0), vrc, wid);
        const bool active = pos0 <= tw + 31, diag = pos0 + 63 > tw;
        bf16x8 pf[4];
        if (active) {
            if (diag) {
                int dq = tw + q - pos0 - 4 * hh; dq = dq < -1 ? -1 : dq;
                att_qk<12, 384, 1, true, false>(kb, L, qf, pf, lsum, c1, 0.f, (unsigned)(size_t)lut + (unsigned)(dq + 1) * 4u, 0, nullptr, 0.f);
            } else att_qk<12, 384, 0, true, false>(kb, L, qf, pf, lsum, c1, ATT_SHIFT, 0u, 0, nullptr, 0.f);
        }
        asm volatile("s_waitcnt vmcnt(0) lgkmcnt(0)" ::: "memory"); ATT_BAR();
        if (i + 1 < ntiles) att_stage<24>(kb, ksrc(pos0 + 64), krc, wid);
        if (active) att_pv<4, 256>(vb, L, pf, o);
    }
    const float lt = lsum + __shfl_xor(lsum, 32);
    int tid2 = tid0; asm volatile("" : "+v"(tid2));
    const int lane2 = tid2 & 63, trow = qt * 128 + (tid2 >> 6) * 32 + (lane2 & 31);
    bf16_t* op; float inv;
    if (part == 0) { inv = 1.0f / lt; op = p.o + (size_t)(b * SEQ + trow) * DM + h * 128 + 4 * (lane2 >> 5); }
    else {
        const size_t rec = (size_t)((part - 1) * 8 + bh) * (SEQ / 2) + (trow - SEQ / 2);
        inv = 1.0f; op = p.mlap + rec * 128 + 4 * (lane2 >> 5);
        if (lane2 < 32) p.mlal[rec] = lt;
    }
#pragma unroll
    for (int dt = 0; dt < 4; ++dt)
#pragma unroll
        for (int rq = 0; rq < 4; ++rq)
            *(u32x2*)(op + 32 * dt + 8 * rq) = (u32x2){cvtpk(o[dt][4 * rq] * inv, o[dt][4 * rq + 1] * inv), cvtpk(o[dt][4 * rq + 2] * inv, o[dt][4 * rq + 3] * inv)};
}
__device__ __forceinline__ void st_mla_combine(const P& p, int wg, int nwg) {
    const int TIDX = otid();
    const int wid = TIDX >> 6, lane = TIDX & 63;
    for (int w = wg * 4 + wid; w < 8 * (SEQ / 2); w += nwg * 4) {
        const int bh = w / (SEQ / 2), t = SEQ / 2 + w % (SEQ / 2), b = bh >> 2, h = bh & 3;
        const size_t r0 = (size_t)w, r1 = (size_t)(8 * (SEQ / 2) + w);
        const float inv = 1.0f / (p.mlal[r0] + p.mlal[r1]);
        const unsigned a = *(const unsigned*)(p.mlap + r0 * 128 + lane * 2), c = *(const unsigned*)(p.mlap + r1 * 128 + lane * 2);
        const float x0 = __uint_as_float(a << 16) + __uint_as_float(c << 16), x1 = __uint_as_float(a & 0xffff0000u) + __uint_as_float(c & 0xffff0000u);
        *(unsigned*)(p.o + (size_t)(b * SEQ + t) * DM + h * 128 + lane * 2) = cvtpk(x0 * inv, x1 * inv);
    }
}

__device__ __forceinline__ void swa_item(const P& p, const int item, LDSP char* lds, const int tid0) {
    LDSP char* kb = lds; LDSP char* vb = lds + 8192; LDSP float* luts = (LDSP float*)(lds + 46080);
    const float c1 = 0.125f * LOG2E;
    int tid = tid0; asm volatile("" : "+v"(tid));
    const int wid = tid >> 6, lane = tid & 63, q = lane & 31, hh = lane >> 5;
    AttLane L; att_lane_init<128, 128, 2>(L, lane);
    int rc[1]; att_stage_map<8>(rc, tid);
    const int b = item >> 9, kvh = (item >> 8) & 1, t0 = (item & 255) * 32, head = kvh * 4 + wid;
    bf16x8 qf[4];
    {
        const bf16_t* qp = p.proj1 + (size_t)(b * SEQ + t0 + q) * 1216 + 448 + head * 64 + 8 * hh;
#pragma unroll
        for (int ks = 0; ks < 4; ++ks) qf[ks] = *(const bf16x8*)(qp + 16 * ks);
    }
    f32x16 o[2];
#pragma unroll
    for (int dt = 0; dt < 2; ++dt)
#pragma unroll
        for (int r = 0; r < 16; ++r) o[dt][r] = 0.f;
    float lsum = 0.f;
    const bf16_t* kbp = p.proj1 + (size_t)b * SEQ * 1216 + 960 + kvh * 64;
    const bf16_t* zr = p.zrow;
    auto ksrc = [&](int pos0) { return [=](int row, int gc) { const int pos = pos0 + row; return (pos >= 0 && pos < SEQ) ? kbp + (size_t)pos * 1216 + gc * 8 : zr + gc * 8; }; };
    auto vsrc = [&](int pos0) { return [=](int row, int gc) { const int pos = pos0 + row; return (pos >= 0 && pos < SEQ) ? kbp + (size_t)pos * 1216 + 128 + gc * 8 : zr + gc * 8; }; };
    const unsigned tab = (unsigned)(size_t)(luts + head * 256);
    att_stage<8>(kb, ksrc(t0 - 128), rc, wid);
    for (int i = 0; i < 3; ++i) {
        const int pos0 = t0 - 128 + 64 * i;
        asm volatile("s_waitcnt vmcnt(0)" ::: "memory"); ATT_BAR();
        att_stage<8>(vb, vsrc(pos0), rc, wid);
        bf16x8 pf[4];
        int dq = t0 + q - pos0 - 4 * hh; dq = dq < -1 ? -1 : dq;
        att_qk<4, 128, 1, true, false>(kb, L, qf, pf, lsum, c1, 0.f, tab + (unsigned)(dq + 1) * 4u, 0, nullptr, 0.f);
        asm volatile("s_waitcnt vmcnt(0) lgkmcnt(0)" ::: "memory"); ATT_BAR();
        if (i + 1 < 3) att_stage<8>(kb, ksrc(pos0 + 64), rc, wid);
        att_pv<2, 128>(vb, L, pf, o);
    }
    const float lt = lsum + __shfl_xor(lsum, 32) + __builtin_amdgcn_exp2f(p.sinks[head] * LOG2E + ATT_SHIFT);
    const float inv = 1.0f / lt;
    bf16_t* op = p.o + (size_t)(b * SEQ + t0 + q) * DM + 512 + head * 64 + 4 * hh;
#pragma unroll
    for (int dt = 0; dt < 2; ++dt)
#pragma unroll
        for (int rq = 0; rq < 4; ++rq)
            *(u32x2*)(op + 32 * dt + 8 * rq) = (u32x2){cvtpk(o[dt][4 * rq] * inv, o[dt][4 * rq + 1] * inv), cvtpk(o[dt][4 * rq + 2] * inv, o[dt][4 * rq + 3] * inv)};
}
__device__ __forceinline__ void moe_conv_item(const P& p, const int layer, const int item, LDSP char* lds, const int tid0) {
    float* sm = (float*)lds;
    const int set = item >> 8, t0 = (item & 255) * 8;
    if (set == 0) conv_batched<1>(p.moe_wg + (size_t)layer * 16 * 1024 * 512, 16, 1024, 512, (size_t)1024 * 512, p.wt_gu + (size_t)layer * 16 * 1024 * 1024, (size_t)1024 * 1024, t0, 1, sm, tid0, t0 + 8);
    else if (set == 1) conv_batched<2>(p.moe_wu + (size_t)layer * 16 * 1024 * 512, 16, 1024, 512, (size_t)1024 * 512, p.wt_gu + (size_t)layer * 16 * 1024 * 1024, (size_t)1024 * 1024, t0, 1, sm, tid0, t0 + 8);
    else conv_batched<0>(p.moe_wd + (size_t)layer * 16 * 512 * 1024, 16, 512, 1024, (size_t)512 * 1024, p.wt_d + (size_t)layer * 16 * 1024 * 512, (size_t)1024 * 512, t0, 1, sm, tid0, t0 + 8);
}
__device__ __forceinline__ void st_attn1(const P& p, LDSP char* lds) {
    const int tid0 = otid();
    LDSP float* lut = (LDSP float*)(lds + 40960); LDSP int* slot = (LDSP int*)(lds + 45568); LDSP float* luts = (LDSP float*)(lds + 46080);
    for (int i = tid0; i < 1152; i += 256) lut[i] = (i < 64) ? ATT_NEG : ATT_SHIFT;
#pragma unroll 1
    for (int h = 0; h < 8; ++h) build_lut(luts + h * 256, p.blut + h * 1024, 256, 128, tid0);
    for (;;) {
        const int item = wq_next(p.wq + 0, slot, tid0);
        if (item >= 768 + 1024 + 768) break;
        if (item < 768) mla_item(p, item, lds, tid0);
        else { const int r = item - 768, g = r / 7, ps = r - g * 7;
               if (ps < 4) swa_item(p, g * 4 + ps, lds, tid0); else moe_conv_item(p, 1, g * 3 + ps - 4, lds, tid0); }
    }
}

#define A0_GLUT 16384
#define A0_WLUT 34816
#define A0_IMP 45056
#define A0_SEL 61568
#define A0_UN 62080
#define A0_LIST 62144
#define A0_SLOT 62720
__device__ __forceinline__ unsigned wmax_u32(unsigned v) {
#pragma unroll
    for (int o = 32; o > 0; o >>= 1) { const unsigned t = (unsigned)__shfl_xor((int)v, o); v = t > v ? t : v; }
    return v;
}
#define ATT_STORE_O(op, o, sc) do { _Pragma("unroll") for (int dt_ = 0; dt_ < 2; ++dt_) _Pragma("unroll") for (int rq_ = 0; rq_ < 4; ++rq_) \
        *(u32x2*)((op) + 32 * dt_ + 8 * rq_) = (u32x2){cvtpk((o)[dt_][4 * rq_] * (sc), (o)[dt_][4 * rq_ + 1] * (sc)), cvtpk((o)[dt_][4 * rq_ + 2] * (sc), (o)[dt_][4 * rq_ + 3] * (sc))}; } while (0)

__device__ __forceinline__ void nsa_item(const P& p, const int item, LDSP char* lds, const int tid0) {
    LDSP char* kb = lds; LDSP char* vb = lds + 8192;
    LDSP float* glut = (LDSP float*)(lds + A0_GLUT); LDSP float* wlut = (LDSP float*)(lds + A0_WLUT); LDSP float* imp = (LDSP float*)(lds + A0_IMP);
    LDSP unsigned* sel = (LDSP unsigned*)(lds + A0_SEL); LDSP unsigned* un = (LDSP unsigned*)(lds + A0_UN); LDSP unsigned short* blist = (LDSP unsigned short*)(lds + A0_LIST);
    const float c1 = 0.125f * LOG2E;
    int tid = tid0; asm volatile("" : "+v"(tid));
    const int wid = tid >> 6, lane = tid & 63, q = lane & 31, hh = lane >> 5;
    const int tile = 255 - (item >> 2), b = (item >> 1) & 1, kvh = item & 1, t0 = tile * 32, blk_t = t0 >> 6, head = kvh * 4 + wid;
#pragma unroll 1
    for (int h = 0; h < 4; ++h) { build_lut(glut + h * 1152, p.blut + (kvh * 4 + h) * 1024, 1152, 1 << 30, tid); build_lut(wlut + h * 640, p.blut + (kvh * 4 + h) * 1024, 640, 512, tid); }
    for (int i = tid; i < 32 * 129; i += 256) imp[i] = 0.f;
    AttLane L; att_lane_init<128, 128, 2>(L, lane);
    int rc[1]; att_stage_map<8>(rc, tid);
    const size_t rowq = (size_t)(b * SEQ + t0 + q);
    bf16x8 qf[4];
    {
        const bf16_t* qp = p.proj + rowq * 2840 + head * 64 + 8 * hh;
#pragma unroll
        for (int ks = 0; ks < 4; ++ks) qf[ks] = *(const bf16x8*)(qp + 16 * ks);
    }
    const float gc = p.gates[rowq * 24 + head * 3 + 0], gs = p.gates[rowq * 24 + head * 3 + 1], gw = p.gates[rowq * 24 + head * 3 + 2];
    const unsigned gtab = (unsigned)(size_t)(glut + wid * 1152), wtab = (unsigned)(size_t)(wlut + wid * 640);
    const bf16_t* zr = p.zrow;
    const bf16_t* pb = p.proj + (size_t)b * SEQ * 2840;
    f32x16 of[2], o[2];
#pragma unroll
    for (int dt = 0; dt < 2; ++dt)
#pragma unroll
        for (int r = 0; r < 16; ++r) { of[dt][r] = 0.f; o[dt][r] = 0.f; }
    bf16x8 pf[4];
    __syncthreads();
    const float cfar = glut[wid * 1152 + 64 + 1023];
    {
        int nvm = (t0 >> 4) + 1; nvm = nvm > 511 ? 511 : nvm;
        const int ntc = (nvm + 63) >> 6;
        const bf16_t* kcb = p.kcmpb + (size_t)((b * 2 + kvh) * 512) * 64;
        const bf16_t* vcb = p.kcmpb + (size_t)((4 + b * 2 + kvh) * 512) * 64;
        auto csrc = [&](const bf16_t* base, int n0) { return [=](int row, int gcx) { const int n = n0 + row; return n < 511 ? base + (size_t)n * 64 + gcx * 8 : zr + gcx * 8; }; };
        float lsum = 0.f;
        for (int nt = 0; nt < ntc; ++nt) {
            att_stage<8>(kb, csrc(kcb, nt * 64), rc, wid);
            asm volatile("s_waitcnt vmcnt(0)" ::: "memory"); ATT_BAR();
            const int dq16 = t0 + q - 31 - 1024 * nt - 64 * hh;
            if (t0 - 31 - 16 * (nt * 64 + 63) >= 1023) att_qk<4, 128, 0, false, false>(kb, L, qf, pf, lsum, c1, cfar, 0u, 0, nullptr, 0.f);
            else att_qk<4, 128, 2, false, false>(kb, L, qf, pf, lsum, c1, 0.f, gtab, dq16, nullptr, 0.f);
            asm volatile("s_waitcnt lgkmcnt(0)" ::: "memory"); ATT_BAR();
        }
        const float lc = lsum + __shfl_xor(lsum, 32);
        const float invl = lc > 0.f ? 1.0f / lc : 0.f;
        float dummy = 0.f;
        for (int nt = 0; nt < ntc; ++nt) {
            att_stage<8>(kb, csrc(kcb, nt * 64), rc, wid);
            att_stage<8>(vb, csrc(vcb, nt * 64), rc, wid);
            asm volatile("s_waitcnt vmcnt(0)" ::: "memory"); ATT_BAR();
            const int dq16 = t0 + q - 31 - 1024 * nt - 64 * hh;
            LDSP float* improw = imp + q * 129 + 16 * nt + hh;
            if (t0 - 31 - 16 * (nt * 64 + 63) >= 1023) att_qk<4, 128, 0, true, true>(kb, L, qf, pf, dummy, c1, cfar, 0u, 0, improw, invl * 524288.0f);
            else att_qk<4, 128, 2, true, true>(kb, L, qf, pf, dummy, c1, 0.f, gtab, dq16, improw, invl * 524288.0f);
            att_pv<2, 128>(vb, L, pf, o);
            asm volatile("s_waitcnt lgkmcnt(0)" ::: "memory"); ATT_BAR();
        }
        const float sc = gc * invl;
#pragma unroll
        for (int dt = 0; dt < 2; ++dt)
#pragma unroll
            for (int r = 0; r < 16; ++r) { of[dt][r] = o[dt][r] * sc; o[dt][r] = 0.f; }
    }
    __syncthreads();
    {
        unsigned u0 = 0u, u1 = 0u, u2 = 0u, u3 = 0u;
        for (int i = 0; i < 8; ++i) {
            const int tok = wid * 8 + i;
            const unsigned v0 = ((LDSP const unsigned*)imp)[tok * 129 + lane], v1 = ((LDSP const unsigned*)imp)[tok * 129 + 64 + lane];
            const int j0 = lane, j1 = lane + 64;
            const bool f0 = (j0 == 0) || (j0 == blk_t) || (j0 == blk_t - 1), f1 = (j1 == blk_t) || (j1 == blk_t - 1);
            unsigned k0 = f0 ? (0xFFFFFF80u | (unsigned)(127 - j0)) : (j0 <= blk_t ? ((v0 << 7) | (unsigned)(127 - j0)) : 0u);
            unsigned k1 = f1 ? (0xFFFFFF80u | (unsigned)(127 - j1)) : (j1 <= blk_t ? ((v1 << 7) | (unsigned)(127 - j1)) : 0u);
            unsigned thr = 0u;
#pragma unroll 1
            for (int bit = 31; bit >= 0; --bit) {
                const unsigned cand = thr | (1u << bit);
                const int c = __popcll(__ballot(k0 >= cand)) + __popcll(__ballot(k1 >= cand));
                thr = (c >= 16) ? cand : thr;
            }
            thr = thr ? thr : 1u;
            const unsigned long long b0 = __ballot(k0 >= thr), b1 = __ballot(k1 >= thr);
            const unsigned m0 = (unsigned)b0, m1 = (unsigned)(b0 >> 32), m2 = (unsigned)b1, m3 = (unsigned)(b1 >> 32);
            if (lane == 0) { sel[tok * 4 + 0] = m0; sel[tok * 4 + 1] = m1; sel[tok * 4 + 2] = m2; sel[tok * 4 + 3] = m3; }
            u0 |= m0; u1 |= m1; u2 |= m2; u3 |= m3;
        }
        if (lane == 0) { un[wid * 4 + 0] = u0; un[wid * 4 + 1] = u1; un[wid * 4 + 2] = u2; un[wid * 4 + 3] = u3; }
    }
    __syncthreads();
    {
        unsigned uw[4];
#pragma unroll
        for (int k = 0; k < 4; ++k) uw[k] = (unsigned)__builtin_amdgcn_readfirstlane((int)(un[k] | un[4 + k] | un[8 + k] | un[12 + k]));
        if (tid < 128) {
            const int k = tid >> 5, jb = tid & 31;
            unsigned wv = 0u; int below = 0;
#pragma unroll
            for (int kk = 0; kk < 4; ++kk) { if (kk == k) wv = uw[kk]; if (kk < k) below += __popc(uw[kk]); }
            if ((wv >> jb) & 1u) blist[below + __popc(wv & ((1u << jb) - 1u))] = (unsigned short)tid;
        }
        const int nb = __popc(uw[0]) + __popc(uw[1]) + __popc(uw[2]) + __popc(uw[3]);
        unsigned sq[4];
#pragma unroll
        for (int k = 0; k < 4; ++k) sq[k] = sel[q * 4 + k];
        __syncthreads();
        const bf16_t* ksb = pb + 768 + kvh * 64;
        auto ssrc = [&](int pos0, int colo) { return [=](int row, int gcx) { return ksb + (size_t)(pos0 + row) * 2840 + colo + gcx * 8; }; };
        float lsum = 0.f;
        att_stage<8>(kb, ssrc(64 * (int)blist[0], 0), rc, wid);
        for (int i = 0; i < nb; ++i) {
            const int j = __builtin_amdgcn_readfirstlane((int)blist[i]), pos0 = 64 * j;
            asm volatile("s_waitcnt vmcnt(0)" ::: "memory"); ATT_BAR();
            att_stage<8>(vb, ssrc(pos0, 128), rc, wid);
            unsigned sw = 0u;
#pragma unroll
            for (int k = 0; k < 4; ++k) if ((j >> 5) == k) sw = sq[k];
            const bool selq = (sw >> (j & 31)) & 1u;
            {
                int dq = t0 + q - pos0 - 4 * hh; dq = dq > 1087 ? 1087 : dq; dq = (dq < -1 || !selq) ? -1 : dq;
                att_qk<4, 128, 1, true, false>(kb, L, qf, pf, lsum, c1, 0.f, gtab + (unsigned)(dq + 1) * 4u, 0, nullptr, 0.f);
            }
            asm volatile("s_waitcnt vmcnt(0) lgkmcnt(0)" ::: "memory"); ATT_BAR();
            if (i + 1 < nb) att_stage<8>(kb, ssrc(64 * (int)blist[i + 1], 0), rc, wid);
            att_pv<2, 128>(vb, L, pf, o);
        }
        const float ls = lsum + __shfl_xor(lsum, 32);
        const float sc = gs / ls;
#pragma unroll
        for (int dt = 0; dt < 2; ++dt)
#pragma unroll
            for (int r = 0; r < 16; ++r) { of[dt][r] += o[dt][r] * sc; o[dt][r] = 0.f; }
    }
    {
        const bf16_t* kwb = pb + 1024 + kvh * 64;
        auto wsrc = [&](int pos0, int colo) { return [=](int row, int gcx) { const int pos = pos0 + row; return (pos >= 0 && pos < SEQ) ? kwb + (size_t)pos * 2840 + colo + gcx * 8 : zr + gcx * 8; }; };
        float lsum = 0.f;
        asm volatile("s_waitcnt lgkmcnt(0)" ::: "memory"); ATT_BAR();
        att_stage<8>(kb, wsrc(t0 - 512, 0), rc, wid);
        for (int i = 0; i < 9; ++i) {
            const int pos0 = t0 - 512 + 64 * i;
            asm volatile("s_waitcnt vmcnt(0)" ::: "memory"); ATT_BAR();
            att_stage<8>(vb, wsrc(pos0, 128), rc, wid);
            int dq = t0 + q - pos0 - 4 * hh; dq = dq < -1 ? -1 : dq;
            att_qk<4, 128, 1, true, false>(kb, L, qf, pf, lsum, c1, 0.f, wtab + (unsigned)(dq + 1) * 4u, 0, nullptr, 0.f);
            asm volatile("s_waitcnt vmcnt(0) lgkmcnt(0)" ::: "memory"); ATT_BAR();
            if (i + 1 < 9) att_stage<8>(kb, wsrc(pos0 + 64, 0), rc, wid);
            att_pv<2, 128>(vb, L, pf, o);
        }
        const float lw = lsum + __shfl_xor(lsum, 32);
        const float sc = gw / lw;
#pragma unroll
        for (int dt = 0; dt < 2; ++dt)
#pragma unroll
            for (int r = 0; r < 16; ++r) of[dt][r] += o[dt][r] * sc;
    }
    bf16_t* op = p.o + rowq * DM + head * 64 + 4 * hh;
    ATT_STORE_O(op, of, 1.0f);
}

#define MG_CNT 8192
#define MG_BASE 8320
#define MG_ENT 8448
__device__ __forceinline__ void st_moba_gate(const P& p, int wg, int nwg, LDSP char* lds) {
    const int tid = otid();
    const int wid = tid >> 6, lane = tid & 63, q = lane & 31, hh = lane >> 5;
    LDSP char* kmt = lds; LDSP int* lcnt = (LDSP int*)(lds + MG_CNT); LDSP int* lbase = (LDSP int*)(lds + MG_BASE); LDSP int* ent = (LDSP int*)(lds + MG_ENT);
    AttLane L; att_lane_init<128, 128, 2>(L, lane);
    int rc[1]; att_stage_map<8>(rc, tid);
    const bf16_t* zr = p.zrow;
    for (int item = wg; item < 1024; item += nwg) {
        const int tile = item >> 4, b = (item >> 3) & 1, h = item & 7, t0 = tile * 128, own = t0 >> 8, tw = t0 + wid * 32, bh = b * 8 + h;
        if (own == 0) continue;
        __syncthreads();
        if (tid < 32) lcnt[tid] = 0;
        bf16x8 qf[4];
        {
            const bf16_t* qp = p.proj + (size_t)(b * SEQ + tw + q) * 2840 + 1304 + h * 64 + 8 * hh;
#pragma unroll
            for (int ks = 0; ks < 4; ++ks) qf[ks] = *(const bf16x8*)(qp + 16 * ks);
        }
        const bf16_t* kmb = p.kmeanb + (size_t)(bh * 32) * 64;
        att_stage<8>(kmt, [=](int row, int gcx) { return row < 32 ? kmb + (size_t)row * 64 + gcx * 8 : zr + gcx * 8; }, rc, wid);
        asm volatile("s_waitcnt vmcnt(0)" ::: "memory");
        __syncthreads();
        f32x16 s;
#pragma unroll
        for (int r = 0; r < 16; ++r) s[r] = 0.f;
#pragma unroll
        for (int ks = 0; ks < 4; ++ks) {
            const bf16x8 a = *(const LDSP bf16x8*)(kmt + (L.kbase ^ (32 * (ks & 3))));
            s = __builtin_amdgcn_mfma_f32_32x32x16_bf16(a, qf[ks], s, 0, 0, 0);
        }
        unsigned key[16];
#pragma unroll
        for (int r = 0; r < 16; ++r) {
            const int j = (r & 3) + 8 * (r >> 2) + 4 * hh;
            const unsigned bits = __float_as_uint(s[r]);
            const unsigned srt = (bits & 0x80000000u) ? ~bits : (bits | 0x80000000u);
            key[r] = (j < own) ? ((srt & ~31u) | (unsigned)(31 - j)) : 0u;
        }
        unsigned selm = 0u;
#pragma unroll 1
        for (int rnd = 0; rnd < 3; ++rnd) {
            unsigned m = 0u;
#pragma unroll
            for (int r = 0; r < 16; ++r) m = key[r] > m ? key[r] : m;
            const unsigned mo = (unsigned)__shfl_xor((int)m, 32);
            const unsigned wk = mo > m ? mo : m;
            if (wk != 0u) selm |= 1u << (31 - (wk & 31u));
#pragma unroll
            for (int r = 0; r < 16; ++r) key[r] = (key[r] == wk) ? 0u : key[r];
        }
        if (hh == 0) {
            unsigned mm = selm;
#pragma unroll
            for (int sI = 0; sI < 3; ++sI) {
                int en = -1;
                if (mm) { const int j = __builtin_ctz(mm); mm &= mm - 1u; const int lp = __hip_atomic_fetch_add(lcnt + j, 1, __ATOMIC_RELAXED, __HIP_MEMORY_SCOPE_WORKGROUP); en = (j << 8) | lp; }
                ent[(wid * 32 + q) * 3 + sI] = en;
            }
        }
        __syncthreads();
        if (tid < 32) { const int c = lcnt[tid]; lbase[tid] = c ? atomicAdd(p.mcnt + bh * 32 + tid, c) : 0; }
        __syncthreads();
        for (int e = tid; e < 384; e += 256) {
            const int en = ent[e];
            if (en >= 0) { const int j = en >> 8, tokl = e / 3, sI = e - tokl * 3; p.mlist[(size_t)(bh * 32 + j) * 8192 + lbase[j] + (en & 255)] = (unsigned short)((t0 + tokl) | (sI << 13)); }
        }
    }
}
__device__ __forceinline__ bf16_t* moba_part(const P& p, int slot, size_t row) { return (slot < 2 ? p.mp01 + (size_t)slot * 131072 * 64 : p.mp2) + row * 64; }

__device__ __forceinline__ void moba_inv_item(const P& p, const int lid, const int chunk, LDSP char* lds, const int tid0) {
    LDSP char* kb = lds; LDSP char* vb = lds + 8192; LDSP float* glut = (LDSP float*)(lds + A0_GLUT);
    const float c1 = 0.125f * LOG2E;
    int tid = tid0; asm volatile("" : "+v"(tid));
    const int wid = tid >> 6, lane = tid & 63, q = lane & 31, hh = lane >> 5;
    const int bh = lid / 31, j = lid - bh * 31, b = bh >> 3, h = bh & 7;
    build_lut(glut, p.blut + h * 1024, 1152, 1 << 30, tid);
    AttLane L; att_lane_init<128, 128, 2>(L, lane);
    int rc[1]; att_stage_map<8>(rc, tid);
    const int n = p.mcnt[bh * 32 + j], idx = chunk * 128 + wid * 32 + q;
    const bool valid = idx < n;
    const unsigned en = valid ? (unsigned)p.mlist[(size_t)(bh * 32 + j) * 8192 + idx] : (unsigned)(256 * (j + 1));
    const int tok = (int)(en & 8191u), slot = (int)(en >> 13);
    bf16x8 qf[4];
    {
        const bf16_t* qp = p.proj + (size_t)(b * SEQ + tok) * 2840 + 1304 + h * 64 + 8 * hh;
#pragma unroll
        for (int ks = 0; ks < 4; ++ks) qf[ks] = *(const bf16x8*)(qp + 16 * ks);
    }
    const unsigned gtab = (unsigned)(size_t)glut;
    const bf16_t* kbb = p.proj + (size_t)b * SEQ * 2840 + 1816 + h * 64;
    auto msrc = [&](int pos0, int colo) { return [=](int row, int gcx) { return kbb + (size_t)(pos0 + row) * 2840 + colo + gcx * 8; }; };
    f32x16 o[2];
#pragma unroll
    for (int dt = 0; dt < 2; ++dt)
#pragma unroll
        for (int r = 0; r < 16; ++r) o[dt][r] = 0.f;
    float lsum = 0.f;
    bf16x8 pf[4];
    __syncthreads();
    att_stage<8>(kb, msrc(256 * j, 0), rc, wid);
    for (int i = 0; i < 4; ++i) {
        const int pos0 = 256 * j + 64 * i;
        asm volatile("s_waitcnt vmcnt(0)" ::: "memory"); ATT_BAR();
        att_stage<8>(vb, msrc(pos0, 512), rc, wid);
        {
            int dq = tok - pos0 - 4 * hh; dq = dq > 1087 ? 1087 : dq; dq = valid ? dq : -1;
            att_qk<4, 128, 1, true, false>(kb, L, qf, pf, lsum, c1, 0.f, gtab + (unsigned)(dq + 1) * 4u, 0, nullptr, 0.f);
        }
        asm volatile("s_waitcnt vmcnt(0) lgkmcnt(0)" ::: "memory"); ATT_BAR();
        if (i + 1 < 4) att_stage<8>(kb, msrc(pos0 + 64, 0), rc, wid);
        att_pv<2, 128>(vb, L, pf, o);
    }
    const float lt = lsum + __shfl_xor(lsum, 32);
    if (valid) {
        const size_t row = (size_t)bh * SEQ + tok;
        bf16_t* op = moba_part(p, slot, row) + 4 * hh;
        ATT_STORE_O(op, o, 1.0f);
        if (hh == 0) p.mpl[(size_t)slot * 131072 + row] = lt;
    }
}
__device__ __forceinline__ void moba_own_item(const P& p, const int item, LDSP char* lds, const int tid0) {
    LDSP char* kb = lds; LDSP char* vb = lds + 8192; LDSP float* glut = (LDSP float*)(lds + A0_GLUT);
    const float c1 = 0.125f * LOG2E;
    int tid = tid0; asm volatile("" : "+v"(tid));
    const int wid = tid >> 6, lane = tid & 63, q = lane & 31, hh = lane >> 5;
    const int tile = item >> 4, b = (item >> 3) & 1, h = item & 7, t0 = tile * 128, own = t0 >> 8, tw = t0 + wid * 32, bh = b * 8 + h;
    __syncthreads();
    build_lut(glut, p.blut + h * 1024, 1152, 1 << 30, tid);
    AttLane L; att_lane_init<128, 128, 2>(L, lane);
    int rc[1]; att_stage_map<8>(rc, tid);
    const size_t rowq = (size_t)(b * SEQ + tw + q);
    bf16x8 qf[4];
    {
        const bf16_t* qp = p.proj + rowq * 2840 + 1304 + h * 64 + 8 * hh;
#pragma unroll
        for (int ks = 0; ks < 4; ++ks) qf[ks] = *(const bf16x8*)(qp + 16 * ks);
    }
    const unsigned gtab = (unsigned)(size_t)glut;
    const bf16_t* kbb = p.proj + (size_t)b * SEQ * 2840 + 1816 + h * 64;
    auto msrc = [&](int pos0, int colo) { return [=](int row, int gcx) { return kbb + (size_t)(pos0 + row) * 2840 + colo + gcx * 8; }; };
    f32x16 o[2];
#pragma unroll
    for (int dt = 0; dt < 2; ++dt)
#pragma unroll
        for (int r = 0; r < 16; ++r) o[dt][r] = 0.f;
    float lsum = 0.f;
    bf16x8 pf[4];
    const int nb = (((t0 + 127) >> 6) & 3) + 1;
    __syncthreads();
    att_stage<8>(kb, msrc(256 * own, 0), rc, wid);
    for (int i = 0; i < nb; ++i) {
        const int pos0 = 256 * own + 64 * i;
        asm volatile("s_waitcnt vmcnt(0)" ::: "memory"); ATT_BAR();
        att_stage<8>(vb, msrc(pos0, 512), rc, wid);
        const bool active = pos0 <= tw + 31;
        if (active) {
            int dq = tw + q - pos0 - 4 * hh; dq = dq < -1 ? -1 : dq;
            att_qk<4, 128, 1, true, false>(kb, L, qf, pf, lsum, c1, 0.f, gtab + (unsigned)(dq + 1) * 4u, 0, nullptr, 0.f);
        }
        asm volatile("s_waitcnt vmcnt(0) lgkmcnt(0)" ::: "memory"); ATT_BAR();
        if (i + 1 < nb) att_stage<8>(kb, msrc(pos0 + 64, 0), rc, wid);
        if (active) att_pv<2, 128>(vb, L, pf, o);
    }
    float lt = lsum + __shfl_xor(lsum, 32);
    const int npick = own < 3 ? own : 3;
    const size_t row = (size_t)bh * SEQ + tw + q;
#pragma unroll 1
    for (int sI = 0; sI < npick; ++sI) {
        lt += p.mpl[(size_t)sI * 131072 + row];
        const bf16_t* pp = moba_part(p, sI, row) + 4 * hh;
#pragma unroll
        for (int dt = 0; dt < 2; ++dt)
#pragma unroll
            for (int rq = 0; rq < 4; ++rq) {
                const u32x2 w = *(const u32x2*)(pp + 32 * dt + 8 * rq);
                o[dt][4 * rq] += __uint_as_float(w[0] << 16); o[dt][4 * rq + 1] += __uint_as_float(w[0] & 0xffff0000u);
                o[dt][4 * rq + 2] += __uint_as_float(w[1] << 16); o[dt][4 * rq + 3] += __uint_as_float(w[1] & 0xffff0000u);
            }
    }
    const float inv = 1.0f / lt;
    bf16_t* op = p.o + rowq * DM + 512 + h * 64 + 4 * hh;
    ATT_STORE_O(op, o, inv);
}
__device__ __forceinline__ void st_moba_own(const P& p, int wg, int nwg, LDSP char* lds) {
    const int tid0 = otid();
    for (int item = wg; item < 1024; item += nwg) moba_own_item(p, item, lds, tid0);
}
#define A0_PRE 62736
__device__ __forceinline__ void st_attn0(const P& p, LDSP char* lds) {
    const int tid0 = otid();
    LDSP int* slot = (LDSP int*)(lds + A0_SLOT); LDSP int* pre = (LDSP int*)(lds + A0_PRE);
    LDSP int* tmp = (LDSP int*)lds;
    for (int i = tid0; i < 496; i += 256) { const int bh = i / 31, j = i - bh * 31; tmp[i] = (p.mcnt[bh * 32 + j] + 127) >> 7; }
    __syncthreads();
    for (int i = tid0; i < 497; i += 256) { int s = 0; for (int k = 0; k < i; ++k) s += tmp[k]; pre[i] = s; }
    __syncthreads();
    const int ninv = pre[496];
    for (;;) {
        const int item = wq_next(p.wq + 1, slot, tid0);
        const int ntail = 5 * 768 + (ninv > 3072 ? ninv - 3072 : 0);
        if (item >= 1024 + ntail) break;
        if (item < 1024) nsa_item(p, item, lds, tid0);
        else {
            const int r = item - 1024, g = r / 5, ps = r - g * 5;
            if (g < 768 && ps == 4) { moe_conv_item(p, 0, g, lds, tid0); continue; }
            const int idx = (g < 768) ? g * 4 + ps : 3072 + (r - 5 * 768);
            if (idx >= ninv) continue;
            int lo = 0, hi = 495;
            while (lo < hi) { const int mid = (lo + hi + 1) >> 1; if (pre[mid] <= idx) lo = mid; else hi = mid - 1; }
            moba_inv_item(p, lo, idx - pre[lo], lds, tid0);
        }
    }
}

#define XB_TMO      128
#define XB_XCNT(j)  (256  + 64 * (j))
#define XB_XSUB(j)  (1280 + 64 * (j))
#define XB_XGEN(j)  (2304 + 64 * (j))
#define XB_TOP      3328
#define XB_TOPGEN   3392
#define XCD_BAR_WORDS 3456
#define XB_SPIN_CAP (1u << 20)
#define LAS __attribute__((address_space(3)))

__device__ __forceinline__ unsigned xb_ld(unsigned* p)              { return __hip_atomic_load(p, __ATOMIC_RELAXED, __HIP_MEMORY_SCOPE_AGENT); }
__device__ __forceinline__ unsigned xb_add(unsigned* p, unsigned v) { return __hip_atomic_fetch_add(p, v, __ATOMIC_RELAXED, __HIP_MEMORY_SCOPE_AGENT); }
__device__ __forceinline__ unsigned xb_xcc_id() { return (unsigned)__builtin_amdgcn_s_getreg((3 << 11) | 20) & 0xFu; }
#define XB_SPIN(cond, bar) do { unsigned _sp = 0; while (cond) { __builtin_amdgcn_s_sleep(1); \
    if ((++_sp & 255u) == 0u) { if (xb_ld(&(bar)[XB_TMO])) break; if (_sp > XB_SPIN_CAP) { atomicAdd(&(bar)[XB_TMO], 1u); break; } } } } while (0)

struct XcdBarrier {
    unsigned* bar; unsigned x;
    volatile LAS unsigned* st;
};

__device__ __forceinline__ XcdBarrier xcd_barrier_post(unsigned* bar, volatile LAS unsigned* st) {
    XcdBarrier b; b.bar = bar; b.x = xb_xcc_id(); b.st = st;
    if (threadIdx.x == 0) (void)xb_add(&bar[XB_XCNT(b.x)], 1u);
    return b;
}
__device__ __forceinline__ void xcd_barrier_complete(unsigned* bar, unsigned x, unsigned& nloc, unsigned& nx) {
    const unsigned G = gridDim.x * gridDim.y * gridDim.z;
    unsigned sum, cnt, mine, sp = 0u;
    for (;;) {
        sum = 0u; cnt = 0u; mine = 0u;
#pragma unroll
        for (unsigned j = 0; j < 16; ++j) { const unsigned c = xb_ld(&bar[XB_XCNT(j)]); sum += c; cnt += (c > 0u) ? 1u : 0u; mine = (j == x) ? c : mine; }
        if (sum == G) break;
        __builtin_amdgcn_s_sleep(1);
        if ((++sp & 255u) == 0u) { if (xb_ld(&bar[XB_TMO])) break; if (sp > XB_SPIN_CAP) { atomicAdd(&bar[XB_TMO], 1u); break; } }
    }
    nloc = mine > 0u ? mine : 1u; nx = cnt > 0u ? cnt : 1u;
}

__device__ __forceinline__ void xcd_barrier(const XcdBarrier& b) {
    asm volatile("s_waitcnt vmcnt(0)" ::: "memory");
    __syncthreads();
    if (threadIdx.x == 0) {
        unsigned* bar = b.bar;
        __builtin_amdgcn_s_waitcnt(0);
        unsigned nloc = b.st[0], nx = b.st[1];
        if (nloc == 0u) { xcd_barrier_complete(bar, b.x, nloc, nx); b.st[0] = nloc; b.st[1] = nx; }
        const unsigned old = xb_add(&bar[XB_XSUB(b.x)], 1u);
        const unsigned gen = old / nloc;
        if (old + 1u == (gen + 1u) * nloc) {
            __builtin_amdgcn_fence(__ATOMIC_RELEASE, "agent");
            asm volatile("s_waitcnt vmcnt(0)" ::: "memory");
            const unsigned og = xb_add(&bar[XB_TOP], 1u);
            const unsigned tg = og / nx;
            if (og + 1u == (tg + 1u) * nx) xb_add(&bar[XB_TOPGEN], 1u);
            else XB_SPIN(xb_ld(&bar[XB_TOPGEN]) == tg, bar);
            __builtin_amdgcn_fence(__ATOMIC_ACQUIRE, "agent");
            xb_add(&bar[XB_XGEN(b.x)], 1u);
            asm volatile("s_waitcnt vmcnt(0)" ::: "memory");
        } else {
            XB_SPIN(xb_ld(&bar[XB_XGEN(b.x)]) == gen, bar);
            __builtin_amdgcn_fence(__ATOMIC_ACQUIRE, "agent");
            asm volatile("s_waitcnt vmcnt(0)" ::: "memory");
        }
    }
    __syncthreads();
}


#define PHASE_SYNC() do { PP qb_ = (PP)__builtin_amdgcn_kernarg_segment_ptr(); asm volatile("" : "+s"(qb_)); XcdBarrier b_; b_.bar = qb_->bar; b_.x = xb_xcc_id(); \
        b_.st = (volatile LAS unsigned*)(dlds + GEMM_LDS_BYTES); xcd_barrier(b_); } while (0)
typedef const __attribute__((address_space(4))) P* PP;
#define PHASE_ARGS() PP q_ = (PP)__builtin_amdgcn_kernarg_segment_ptr(); int wg = blockIdx.x, nwg = gridDim.x; asm volatile("" : "+s"(q_), "+s"(wg), "+s"(nwg)); P p; { const __attribute__((address_space(4))) unsigned long long* s64_ = (const __attribute__((address_space(4))) unsigned long long*)q_; unsigned long long* d64_ = (unsigned long long*)&p; _Pragma("unroll") for (int i_ = 0; i_ < (int)(sizeof(P) / 8); ++i_) d64_[i_] = s64_[i_]; } float* sm = (float*)dlds; LDSP char* lds = (LDSP char*)dlds; (void)sm; (void)lds
#define KERNEL_LDS_BYTES (GEMM_LDS_BYTES + 64)
__global__ void __launch_bounds__(256, 2) k_mega(P pk) {
    extern __shared__ __attribute__((aligned(16))) unsigned char dlds[];
    if (threadIdx.x == 0) *(uint4*)(dlds + GEMM_LDS_BYTES) = make_uint4(0u, 0u, 0u, 0u);
    __syncthreads();
    (void)xcd_barrier_post(pk.bar, (volatile LAS unsigned*)(dlds + GEMM_LDS_BYTES));
    { PHASE_ARGS(); st_prologue(p, wg, nwg, sm); st_convert(p, wg, nwg, sm); } PHASE_SYNC();
    { PHASE_ARGS(); st_norm<0>(p, 0, wg, nwg, sm); st_c1_reduce(p, wg, nwg); } PHASE_SYNC();
    { PHASE_ARGS(); st_inproj0_mf(p, wg, nwg, lds); } PHASE_SYNC();
    { PHASE_ARGS(); st_cmp1_mf(p, wg, nwg, lds); st_kmean(p, wg, nwg, sm); } PHASE_SYNC();
    { PHASE_ARGS(); st_cmp2_mf(p, wg, nwg, lds); st_moba_gate(p, wg, nwg, lds); } PHASE_SYNC();
    { PHASE_ARGS(); st_attn0(p, lds); } PHASE_SYNC();
    { PHASE_ARGS(); st_moba_own(p, wg, nwg, lds); } PHASE_SYNC();
    { PHASE_ARGS(); st_outproj_mf(p, 0, wg, nwg, lds); } PHASE_SYNC();
    { PHASE_ARGS(); st_norm<1>(p, 0, wg, nwg, sm); } PHASE_SYNC();
    { PHASE_ARGS(); st_moe_up_mf(p, 0, wg, nwg, lds); } PHASE_SYNC();
    { PHASE_ARGS(); st_moe_down_mf(p, 0, wg, nwg, lds); } PHASE_SYNC();
    { PHASE_ARGS(); st_norm<2>(p, 1, wg, nwg, sm); } PHASE_SYNC();
    { PHASE_ARGS(); st_inproj1_mf(p, wg, nwg, lds); } PHASE_SYNC();
    { PHASE_ARGS(); st_mla_prep(p, wg, nwg); } PHASE_SYNC();
    { PHASE_ARGS(); st_mla_up_mf(p, wg, nwg, lds); } PHASE_SYNC();
    { PHASE_ARGS(); st_attn1(p, lds); } PHASE_SYNC();
    { PHASE_ARGS(); st_mla_combine(p, wg, nwg); } PHASE_SYNC();
    { PHASE_ARGS(); st_outproj_mf(p, 1, wg, nwg, lds); } PHASE_SYNC();
    { PHASE_ARGS(); st_norm<1>(p, 1, wg, nwg, sm); } PHASE_SYNC();
    { PHASE_ARGS(); st_moe_up_mf(p, 1, wg, nwg, lds); } PHASE_SYNC();
    { PHASE_ARGS(); st_moe_down_mf(p, 1, wg, nwg, lds); } PHASE_SYNC();
    { PHASE_ARGS(); st_norm<3>(p, 1, wg, nwg, sm); }
}

extern "C" void kernel_launch(void* const* d_in, const int* in_sizes, int n_in, void* d_out, int out_size, void* d_ws, size_t ws_size,
                              hipStream_t stream) {
    (void)in_sizes; (void)n_in; (void)out_size; (void)ws_size;
    P p{};
    const float* const* in = (const float* const*)d_in;
    p.x = in[0]; p.c = in[1]; p.rel = in[2]; p.router_w = in[3]; p.router_b = in[4]; p.final_norm = in[5]; p.norm_mix = in[6]; p.norm_ffn = in[7];
    p.ada_w = in[8]; p.ada_b = in[9]; p.moe_wg = in[10]; p.moe_wu = in[11]; p.moe_wd = in[12]; p.ev_w_in = in[13]; p.ev_w_out = in[14];
    p.pos_k = in[15]; p.pos_v = in[16]; p.ck_w1 = in[17]; p.ck_w2 = in[18]; p.cv_w1 = in[19]; p.cv_w2 = in[20]; p.od_w_in = in[21]; p.od_w_out = in[22];
    p.q_norm = in[23]; p.kv_norm = in[24]; p.w_q_up = in[25]; p.w_kv_up = in[26]; p.sinks = in[27];
    p.out = (float*)d_out;
    char* ws = (char*)d_ws; size_t off = 0;
    auto take = [&](size_t bytes) { char* r = ws + off; off += (bytes + 255) & ~(size_t)255; return r; };
    p.bar = (unsigned*)take(16384);
    p.cnt = (int*)take(4096);
    p.wq = (int*)take(256);
    p.mcnt = (int*)take(512 * 4);
    p.modv = (float*)take(2 * 2 * 6144 * 4);
    p.zrow = (bf16_t*)take(256);
    const size_t zero_bytes = off;
    p.ropec = (float*)take(SEQ * 32 * 4); p.ropes = (float*)take(SEQ * 32 * 4);
    p.blut = (float*)take(8 * 1024 * 4);
    p.gates = (float*)take((size_t)T_TOK * 24 * 4);
    p.kmean = (float*)take(2 * 8 * 32 * 64 * 4);
    p.tokw = (float*)take((size_t)T_TOK * 2 * 4);
    p.list = (int*)take((size_t)16 * T_TOK * 4);
    p.cqn = (bf16_t*)take((size_t)T_TOK * 384 * 2);
    p.krope = (bf16_t*)take((size_t)T_TOK * 64 * 2);
    p.h = (bf16_t*)take((size_t)T_TOK * DM * 2);
    p.o = (bf16_t*)take((size_t)T_TOK * DM * 2);
    p.mlap = p.h;
    p.mlal = (float*)(p.h + (size_t)2 * 8 * (SEQ / 2) * 128);
    p.mp01 = p.h;
    p.mp2 = (bf16_t*)take((size_t)131072 * 64 * 2);
    p.mpl = (float*)take((size_t)3 * 131072 * 4);
    p.mlist = (unsigned short*)take((size_t)16 * 32 * 8192 * 2);
    p.hid = p.o;
    char* region = take((size_t)100 * 1024 * 1024);
    p.proj = (bf16_t*)region;
    p.proj1 = (bf16_t*)region;
    p.qmla = (bf16_t*)(region + (size_t)T_TOK * 1216 * 2);
    p.kvmla = (bf16_t*)(region + (size_t)T_TOK * (1216 + 768) * 2);
    p.y = (bf16_t*)region;
    p.chidb = (bf16_t*)take((size_t)2 * 2048 * 256 * 2);
    p.kcmpb = (bf16_t*)take((size_t)8 * 512 * 64 * 2);
    p.kmeanb = (bf16_t*)take((size_t)2 * 8 * 32 * 64 * 2);
    p.c1 = (float*)take(512 * 4);
    p.c1p = (float*)take((size_t)2 * 64 * 256 * 4);
    p.wt_gu = (bf16_t*)take((size_t)32 * 1024 * 1024 * 2);
    p.wt_d = (bf16_t*)take((size_t)32 * 1024 * 512 * 2);
    p.wt_in0 = (bf16_t*)take((size_t)2840 * 1024 * 2);
    p.wt_out0 = (bf16_t*)take((size_t)1024 * 1024 * 2);
    p.wt_c1 = (bf16_t*)take((size_t)2 * 256 * 2048 * 2);
    p.wt_c2 = (bf16_t*)take((size_t)2 * 64 * 256 * 2);
    p.wt_in1 = (bf16_t*)take((size_t)1216 * 1024 * 2);
    p.wt_out1 = (bf16_t*)take((size_t)1024 * 1024 * 2);
    p.wt_qup = (bf16_t*)take((size_t)768 * 256 * 2);
    p.wt_kvup = (bf16_t*)take((size_t)1024 * 128 * 2);
    static int grid = 0;
    if (!grid) {
        int dev = 0, cus = 0, per_cu = 0;
        (void)hipGetDevice(&dev);
        (void)hipDeviceGetAttribute(&cus, hipDeviceAttributeMultiprocessorCount, dev);
        (void)hipFuncSetAttribute((const void*)k_mega, hipFuncAttributeMaxDynamicSharedMemorySize, KERNEL_LDS_BYTES);
        (void)hipOccupancyMaxActiveBlocksPerMultiprocessor(&per_cu, k_mega, 256, KERNEL_LDS_BYTES);
        if (cus <= 0) cus = 256;
        if (per_cu < 1) per_cu = 1;
        grid = cus * (per_cu < 2 ? per_cu : 2);
    }
    (void)hipMemsetAsync(d_ws, 0, zero_bytes, stream);
    hipLaunchKernelGGL(k_mega, dim3(grid), dim3(256), KERNEL_LDS_BYTES, stream, p);
}
```

```cpp
#include <hip/hip_runtime.h>
#include <stdint.h>

#define T_TOK 16384
#define SEQ 8192
#define DM 1024
#define NEGF (-1e30f)
#define BIGF (1e30f)

typedef unsigned short bf16_t;

__device__ __forceinline__ float bf2f(bf16_t v) { return __uint_as_float(((unsigned)v) << 16); }
__device__ __forceinline__ bf16_t f2bf(float f) {
    unsigned u = __float_as_uint(f);
    u += 0x7fffu + ((u >> 16) & 1u);
    return (bf16_t)(u >> 16);
}
typedef __bf16 bf16x2_t __attribute__((ext_vector_type(2)));
typedef float f32x2_t __attribute__((ext_vector_type(2)));
__device__ __forceinline__ unsigned cvtpk(float lo, float hi) { const f32x2_t f = {lo, hi}; return __builtin_bit_cast(unsigned, __builtin_convertvector(f, bf16x2_t)); }
__device__ __forceinline__ unsigned cvtpk_valu(float lo, float hi) { unsigned r; asm("s_nop 0\n\tv_cvt_pk_bf16_f32 %0, %1, %2" : "=v"(r) : "v"(lo), "v"(hi)); return r; }
__device__ __forceinline__ float wsum(float v) {
#pragma unroll
    for (int o = 32; o > 0; o >>= 1) v += __shfl_xor(v, o);
    return v;
}
__device__ __forceinline__ float siluf(float v) { return v / (1.0f + __expf(-v)); }
__device__ __forceinline__ float sigmf(float v) { return 1.0f / (1.0f + __expf(-v)); }
__device__ __forceinline__ float gelu_tanh(float x) {
    const float k0 = 0.7978845608028654f, k1 = 0.044715f;
    float u = k0 * (x + k1 * x * x * x);
    return 0.5f * x * (1.0f + tanhf(u));
}
__device__ __forceinline__ int rel_bucket(int d) {
    if (d < 16) return d < 0 ? 0 : d;
    int b = 16;
    b += (d >= 21); b += (d >= 27); b += (d >= 35); b += (d >= 46); b += (d >= 59); b += (d >= 77); b += (d >= 99); b += (d >= 128);
    b += (d >= 166); b += (d >= 216); b += (d >= 280); b += (d >= 363); b += (d >= 470); b += (d >= 609); b += (d >= 790);
    return b;
}

__device__ __forceinline__ int otid() { int t = threadIdx.x; asm volatile("" : "+v"(t)); return t; }

struct P {
    const float *x, *c, *rel, *router_w, *router_b, *final_norm, *norm_mix, *norm_ffn, *ada_w, *ada_b, *moe_wg, *moe_wu, *moe_wd,
        *ev_w_in, *ev_w_out, *pos_k, *pos_v, *ck_w1, *ck_w2, *cv_w1, *cv_w2, *od_w_in, *od_w_out, *q_norm, *kv_norm, *w_q_up, *w_kv_up, *sinks;
    float* out;
    unsigned* bar; int* cnt;
    float *modv, *ropec, *ropes, *blut, *gates, *kcmp, *vcmp, *chid, *kmean, *tokw;
    bf16_t *h, *proj, *o, *hid, *y, *proj1, *qmla, *kvmla, *krope, *cqn;
    int* list;
    bf16_t *wt_gu, *wt_d, *wt_in0, *wt_out0, *wt_c1, *wt_c2, *wt_in1, *wt_out1, *wt_qup, *wt_kvup, *chidb;
    float *c1, *c1p;
    int* wq;
    bf16_t* zrow;
    bf16_t *kcmpb, *kmeanb, *mlap;
    float* mlal;
    int* mcnt; unsigned short* mlist; bf16_t *mp01, *mp2; float* mpl;
};


__device__ __forceinline__ void st_prologue(const P& p, int wg, int nwg, float* sm) {
    const int TIDX = otid();
    const int tid = TIDX;
    {
        for (int i = tid; i < 2048; i += 256) sm[i] = siluf(p.c[i]);
        __syncthreads();
        const int wid = tid >> 6, lane = tid & 63;
        for (int w = wg; w < 192; w += nwg) {
            const int l = w / 96, cg = w % 96, col = cg * 64 + lane;
            const float* W = p.ada_w + (size_t)l * 1024 * 6144 + (size_t)(wid * 256) * 6144 + col;
            float a0 = 0.f, a1 = 0.f;
#pragma unroll 32
            for (int k = 0; k < 256; ++k) { const float wv = W[(size_t)k * 6144]; a0 += sm[wid * 256 + k] * wv; a1 += sm[1024 + wid * 256 + k] * wv; }
            sm[2048 + tid] = a0; sm[2304 + tid] = a1;
            __syncthreads();
            if (tid < 64) {
                const float bb = p.ada_b[l * 6144 + col];
                p.modv[(l * 2 + 0) * 6144 + col] = ((sm[2048 + tid] + sm[2048 + 64 + tid]) + (sm[2048 + 128 + tid] + sm[2048 + 192 + tid])) + bb;
                p.modv[(l * 2 + 1) * 6144 + col] = ((sm[2304 + tid] + sm[2304 + 64 + tid]) + (sm[2304 + 128 + tid] + sm[2304 + 192 + tid])) + bb;
            }
            __syncthreads();
        }
        __syncthreads();
    }
    for (int i = wg * 256 + tid; i < SEQ * 32; i += nwg * 256) {
        const int t = i >> 5, j = i & 31;
        const float inv = powf(10000.0f, -(float)(2 * j) / 64.0f);
        const float ang = (float)t * inv;
        p.ropec[i] = cosf(ang); p.ropes[i] = sinf(ang);
    }
    for (int i = wg * 256 + tid; i < 8 * 1024; i += nwg * 256) { const int h = i >> 10, d = i & 1023; p.blut[i] = p.rel[rel_bucket(d) * 8 + h]; }
}

template <int MODE>
__device__ __forceinline__ void st_norm(const P& p, int layer, int wg, int nwg, float* sm) {
    const int TIDX = otid();
    const int wid = TIDX >> 6, lane = TIDX & 63;
    int* rl_cnt = (int*)sm; int* rl_base = rl_cnt + 16; int* rl_ent = rl_cnt + 32;
    if (MODE == 1) { if (TIDX < 16) rl_cnt[TIDX] = 0; for (int i = TIDX; i < 64; i += 256) rl_ent[i] = -1; __syncthreads(); }
    const int niter = (T_TOK + nwg * 4 - 1) / (nwg * 4);
    const float* xin = (MODE == 0) ? p.x : p.out;
    float4 pre4[4];
    {
        const int row0 = wg * 4 + wid;
#pragma unroll
        for (int i = 0; i < 4; ++i) pre4[i] = (row0 < T_TOK) ? *(const float4*)(xin + (size_t)row0 * DM + i * 256 + lane * 4) : make_float4(0.f, 0.f, 0.f, 0.f);
    }
    for (int it = 0; it < niter; ++it) {
        const int row = wg * 4 + wid + it * nwg * 4;
        if (MODE != 1 && row >= T_TOK) break;
        float v[16];
#pragma unroll
        for (int i = 0; i < 4; ++i) { v[i * 4 + 0] = pre4[i].x; v[i * 4 + 1] = pre4[i].y; v[i * 4 + 2] = pre4[i].z; v[i * 4 + 3] = pre4[i].w; }
        {
            const int rown = row + nwg * 4;
            if (rown < T_TOK) {
#pragma unroll
                for (int i = 0; i < 4; ++i) pre4[i] = *(const float4*)(xin + (size_t)rown * DM + i * 256 + lane * 4);
            }
        }
        if (MODE != 1 || row < T_TOK) {
        const int b = row >> 13;
        if (MODE >= 2) {
            const int lp = (MODE == 2) ? layer - 1 : 1;
            const float* gf = p.modv + (size_t)(lp * 2 + b) * 6144 + 5 * 1024;
#pragma unroll
            for (int i = 0; i < 4; ++i)
#pragma unroll
                for (int j = 0; j < 4; ++j) {
                    const int col = i * 256 + lane * 4 + j;
                    const float y0 = bf2f(p.y[(size_t)(2 * row) * DM + col]), y1 = bf2f(p.y[(size_t)(2 * row + 1) * DM + col]);
                    v[i * 4 + j] += gf[col] * (y0 + y1);
                }
            if (MODE == 2) {
#pragma unroll
                for (int i = 0; i < 4; ++i)
                    *(float4*)(p.out + (size_t)row * DM + i * 256 + lane * 4) = make_float4(v[i * 4], v[i * 4 + 1], v[i * 4 + 2], v[i * 4 + 3]);
            }
        }
        float ss = 0.f;
#pragma unroll
        for (int i = 0; i < 16; ++i) ss += v[i] * v[i];
        ss = wsum(ss);
        const float r = rsqrtf(ss * (1.0f / 1024.0f) + 1e-6f);
        if (MODE == 3) {
#pragma unroll
            for (int i = 0; i < 4; ++i) {
                const float4 g4 = *(const float4*)(p.final_norm + i * 256 + lane * 4);
                *(float4*)(p.out + (size_t)row * DM + i * 256 + lane * 4) =
                    make_float4(v[i * 4] * r * g4.x, v[i * 4 + 1] * r * g4.y, v[i * 4 + 2] * r * g4.z, v[i * 4 + 3] * r * g4.w);
            }
            continue;
        }
        const float* g = ((MODE == 1) ? p.norm_ffn : p.norm_mix) + layer * 1024;
        const float* mv = p.modv + (size_t)(layer * 2 + b) * 6144;
        const float* shift = mv + ((MODE == 1) ? 3 : 0) * 1024;
        const float* scale = mv + ((MODE == 1) ? 4 : 1) * 1024;
        float hv[16];
#pragma unroll
        for (int i = 0; i < 4; ++i)
#pragma unroll
            for (int j = 0; j < 4; ++j) {
                const int col = i * 256 + lane * 4 + j;
                hv[i * 4 + j] = v[i * 4 + j] * r * g[col] * (1.0f + scale[col]) + shift[col];
                p.h[(size_t)row * DM + col] = f2bf(hv[i * 4 + j]);
            }
        if (MODE == 1) {
            float lg[16];
#pragma unroll
            for (int e = 0; e < 16; ++e) lg[e] = 0.f;
#pragma unroll
            for (int i = 0; i < 4; ++i)
#pragma unroll
                for (int j = 0; j < 4; ++j) {
                    const int col = i * 256 + lane * 4 + j;
                    const float* rw = p.router_w + col * 16;
#pragma unroll
                    for (int e = 0; e < 16; ++e) lg[e] += hv[i * 4 + j] * rw[e];
                    asm volatile("" ::: "memory");
                }
#pragma unroll
            for (int e = 0; e < 16; ++e) lg[e] = wsum(lg[e]);
            float aff[16], bi[16];
#pragma unroll
            for (int e = 0; e < 16; ++e) { aff[e] = 1.0f / (1.0f + expf(-lg[e])); bi[e] = aff[e] + p.router_b[e]; }
            float bestsc = -3e38f; int be0 = 0, be1 = 1; float bw0 = 0.f, bw1 = 0.f;
#pragma unroll
            for (int gI = 0; gI < 4; ++gI) {
                int i1 = 0; float m1 = bi[gI * 4];
#pragma unroll
                for (int i = 1; i < 4; ++i) if (bi[gI * 4 + i] > m1) { m1 = bi[gI * 4 + i]; i1 = i; }
                int i2 = -1; float m2 = -3e38f;
#pragma unroll
                for (int i = 0; i < 4; ++i) if (i != i1 && bi[gI * 4 + i] > m2) { m2 = bi[gI * 4 + i]; i2 = i; }
                const float sc = m1 + m2;
                float a1 = 0.f, a2 = 0.f;
#pragma unroll
                for (int i = 0; i < 4; ++i) { a1 = (i == i1) ? aff[gI * 4 + i] : a1; a2 = (i == i2) ? aff[gI * 4 + i] : a2; }
                if (sc > bestsc) { bestsc = sc; be0 = gI * 4 + i1; be1 = gI * 4 + i2; bw0 = a1; bw1 = a2; }
            }
            if (lane == 0) {
                const float ws = bw0 + bw1;
                p.tokw[row * 2] = bw0 / ws; p.tokw[row * 2 + 1] = bw1 / ws;
                const int s_ = (it & 7) * 4 + wid;
                const int r0 = atomicAdd(&rl_cnt[be0], 1), r1 = atomicAdd(&rl_cnt[be1], 1);
                rl_ent[s_ * 2] = (row << 12) | (be0 << 8) | r0;
                rl_ent[s_ * 2 + 1] = (row << 12) | (be1 << 8) | r1;
            }
        }
        }
        if (MODE == 1 && ((it & 7) == 7 || it == niter - 1)) {
            __syncthreads();
            if (TIDX < 16) { const int c = rl_cnt[TIDX]; rl_base[TIDX] = c ? atomicAdd(&p.cnt[(layer * 16 + TIDX) * 32], c) : 0; rl_cnt[TIDX] = 0; }
            __syncthreads();
            if (TIDX < 64) {
                const int en = rl_ent[TIDX];
                if (en >= 0) { const int e = (en >> 8) & 15; p.list[e * T_TOK + rl_base[e] + (en & 255)] = (en >> 12) * 2 + (TIDX & 1); rl_ent[TIDX] = -1; }
            }
            __syncthreads();
        }
    }
}

__device__ __forceinline__ void st_kmean(const P& p, int wg, int nwg, float* sm) {
    const int TIDX = otid();
    const int wid = TIDX >> 6, lane = TIDX & 63;
    for (int w = wg; w < 2 * 8 * 32; w += nwg) {
        const int b = w >> 8, h = (w >> 5) & 7, j = w & 31;
        const bf16_t* kp = p.proj + (size_t)(b * SEQ + j * 256 + wid * 64) * 2840 + 1816 + h * 64 + lane;
        float s = 0.f;
#pragma unroll 16
        for (int i = 0; i < 64; ++i) s += bf2f(kp[(size_t)i * 2840]);
        __syncthreads();
        sm[TIDX] = s;
        __syncthreads();
        if (TIDX < 64) {
            const float m = ((sm[TIDX] + sm[64 + TIDX]) + (sm[128 + TIDX] + sm[192 + TIDX])) * (1.0f / 256.0f);
            p.kmean[(size_t)w * 64 + TIDX] = m;
            p.kmeanb[(size_t)w * 64 + TIDX] = f2bf(m);
        }
    }
}
__device__ __forceinline__ void st_mla_prep(const P& p, int wg, int nwg) {
    const int TIDX = otid();
    const int wid = TIDX >> 6, lane = TIDX & 63;
    for (int row = wg * 4 + wid; row < T_TOK; row += nwg * 4) {
        const int t = row & (SEQ - 1);
        const bf16_t* pr = p.proj1 + (size_t)row * 1216;
        float q[4], ss = 0.f;
#pragma unroll
        for (int i = 0; i < 4; ++i) { q[i] = bf2f(pr[i * 64 + lane]); ss += q[i] * q[i]; }
        ss = wsum(ss);
        float r = rsqrtf(ss * (1.0f / 256.0f) + 1e-6f);
#pragma unroll
        for (int i = 0; i < 4; ++i) p.cqn[(size_t)row * 384 + i * 64 + lane] = f2bf(q[i] * r * p.q_norm[i * 64 + lane]);
        float kvv[2]; ss = 0.f;
#pragma unroll
        for (int i = 0; i < 2; ++i) { kvv[i] = bf2f(pr[256 + i * 64 + lane]); ss += kvv[i] * kvv[i]; }
        ss = wsum(ss);
        r = rsqrtf(ss * (1.0f / 128.0f) + 1e-6f);
#pragma unroll
        for (int i = 0; i < 2; ++i) p.cqn[(size_t)row * 384 + 256 + i * 64 + lane] = f2bf(kvv[i] * r * p.kv_norm[i * 64 + lane]);
        if (lane < 32) {
            const float x1 = bf2f(pr[384 + lane]), x2 = bf2f(pr[384 + 32 + lane]);
            const float cs = p.ropec[t * 32 + lane], sn = p.ropes[t * 32 + lane];
            p.krope[(size_t)row * 64 + lane] = f2bf(x1 * cs - x2 * sn);
            p.krope[(size_t)row * 64 + 32 + lane] = f2bf(x1 * sn + x2 * cs);
        }
    }
}


typedef short bf16x8 __attribute__((ext_vector_type(8)));
typedef float f32x4 __attribute__((ext_vector_type(4)));
typedef unsigned u32x2 __attribute__((ext_vector_type(2)));
typedef unsigned u32x4v __attribute__((ext_vector_type(4)));
#define LDSP __attribute__((address_space(3)))
#define GEMM_LDS_BYTES 65536

__device__ __forceinline__ unsigned pack_bf16(float lo, float hi) { return cvtpk(lo, hi); }

template <class AR, class BR, class Epi, class NX>
__device__ __forceinline__ void gemm128x(const int nk, const size_t akstep, const size_t bkstep, AR arow, BR brow, Epi epi, LDSP char* lds, const int tid, const bool staged, NX next) {
    const int wid = tid >> 6, lane = tid & 63, wr = wid >> 1, wc = wid & 1, fr = lane & 15, fq = lane >> 4;
    const int srow = tid >> 3, gch = ((tid & 7) ^ (srow & 7)) * 8;
    const bf16_t* ap0 = arow(srow) + gch; const bf16_t* ap1 = arow(32 + srow) + gch; const bf16_t* ap2 = arow(64 + srow) + gch; const bf16_t* ap3 = arow(96 + srow) + gch;
    const bf16_t* bp0 = brow(srow) + gch; const bf16_t* bp1 = brow(32 + srow) + gch; const bf16_t* bp2 = brow(64 + srow) + gch; const bf16_t* bp3 = brow(96 + srow) + gch;
    LDSP char* lw = lds + wid * 1024;
#define G128_ISSUE(st, kt) do { LDSP char* la_ = lw + (st) * 32768; const size_t ao_ = (size_t)(kt) * akstep, bo_ = (size_t)(kt) * bkstep; \
        __builtin_amdgcn_global_load_lds((const unsigned*)(ap0 + ao_), (LDSP unsigned*)(la_), 16, 0, 0); \
        __builtin_amdgcn_global_load_lds((const unsigned*)(ap1 + ao_), (LDSP unsigned*)(la_ + 4096), 16, 0, 0); \
        __builtin_amdgcn_global_load_lds((const unsigned*)(ap2 + ao_), (LDSP unsigned*)(la_ + 8192), 16, 0, 0); \
        __builtin_amdgcn_global_load_lds((const unsigned*)(ap3 + ao_), (LDSP unsigned*)(la_ + 12288), 16, 0, 0); \
        __builtin_amdgcn_global_load_lds((const unsigned*)(bp0 + bo_), (LDSP unsigned*)(la_ + 16384), 16, 0, 0); \
        __builtin_amdgcn_global_load_lds((const unsigned*)(bp1 + bo_), (LDSP unsigned*)(la_ + 16384 + 4096), 16, 0, 0); \
        __builtin_amdgcn_global_load_lds((const unsigned*)(bp2 + bo_), (LDSP unsigned*)(la_ + 16384 + 8192), 16, 0, 0); \
        __builtin_amdgcn_global_load_lds((const unsigned*)(bp3 + bo_), (LDSP unsigned*)(la_ + 16384 + 12288), 16, 0, 0); } while (0)
    f32x4 acc[4][4];
#pragma unroll
    for (int m = 0; m < 4; ++m)
#pragma unroll
        for (int n = 0; n < 4; ++n) acc[m][n] = (f32x4){0.f, 0.f, 0.f, 0.f};
    const int aoff = (wr * 64 + fr) * 128, boff = 16384 + (wc * 64 + fr) * 128, c0 = (fq ^ (fr & 7)) * 16;
    if (!staged) G128_ISSUE(0, 0);
    for (int kt = 0; kt < nk; ++kt) {
        const int cur = kt & 1;
        asm volatile("s_waitcnt vmcnt(0)" ::: "memory");
        __builtin_amdgcn_s_barrier();
        asm volatile("" ::: "memory");
        if (kt + 1 < nk) G128_ISSUE(cur ^ 1, kt + 1);
        LDSP char* sb = lds + cur * 32768;
#pragma unroll
        for (int kk = 0; kk < 2; ++kk) {
            const int cc = kk ? (c0 ^ 64) : c0;
            bf16x8 af[4], bf[4];
#pragma unroll
            for (int m = 0; m < 4; ++m) af[m] = *(const LDSP bf16x8*)(sb + aoff + m * 2048 + cc);
#pragma unroll
            for (int n = 0; n < 4; ++n) bf[n] = *(const LDSP bf16x8*)(sb + boff + n * 2048 + cc);
#pragma unroll
            for (int m = 0; m < 4; ++m)
#pragma unroll
                for (int n = 0; n < 4; ++n) acc[m][n] = __builtin_amdgcn_mfma_f32_16x16x32_bf16(bf[n], af[m], acc[m][n], 0, 0, 0);
        }
    }
    asm volatile("s_waitcnt lgkmcnt(0)" ::: "memory");
    __builtin_amdgcn_s_barrier();
    asm volatile("" ::: "memory");
    next();
#undef G128_ISSUE
#pragma unroll
    for (int m = 0; m < 4; ++m) epi(wr * 64 + m * 16 + fr, wc * 64 + fq * 4, acc[m], m);
}

template <class AR, class BR>
__device__ __forceinline__ void g128_stage0(AR arow, BR brow, LDSP char* lds, const int tid) {
    const int wid = tid >> 6, srow = tid >> 3, gch = ((tid & 7) ^ (srow & 7)) * 8;
    LDSP char* lw = lds + wid * 1024;
#pragma unroll
    for (int i = 0; i < 4; ++i) {
        __builtin_amdgcn_global_load_lds((const unsigned*)(arow(32 * i + srow) + gch), (LDSP unsigned*)(lw + 4096 * i), 16, 0, 0);
    }
#pragma unroll
    for (int i = 0; i < 4; ++i) {
        __builtin_amdgcn_global_load_lds((const unsigned*)(brow(32 * i + srow) + gch), (LDSP unsigned*)(lw + 16384 + 4096 * i), 16, 0, 0);
    }
}
template <class AR, class BR, class Epi>
__device__ __forceinline__ void gemm128(const int nk, const size_t akstep, const size_t bkstep, AR arow, BR brow, Epi epi, LDSP char* lds, const int tid) {
    gemm128x(nk, akstep, bkstep, arow, brow, epi, lds, tid, false, [] {});
}

template <int MAP> __device__ __forceinline__ int conv_rowmap(int n) {
    if (MAP == 0) return n;
    const int tile = n >> 6, cc = n & 63, wc = cc >> 5, i16 = (cc >> 4) & 1, i = cc & 15;
    return tile * 128 + wc * 64 + ((MAP == 1 ? 0 : 2) + i16) * 16 + i;
}
template <int MAP>
__device__ __forceinline__ void conv_batched(const float* src, int nmat, int K, int N, size_t sstride, bf16_t* dst, size_t dstride, int wg, int nwg, float* sm, int tid, int wend = 0x7fffffff) {
    float(*t)[65] = (float(*)[65])sm;
    const int tk = K >> 6, tn = (N + 63) >> 6, per = tk * tn, total = (nmat * per < wend) ? nmat * per : wend;
    f32x4 v[4];
    auto ld = [&](int w) {
        const int mat = w / per, r = w % per, kt = r / tn, nt = r % tn;
        const float* s = src + (size_t)mat * sstride;
#pragma unroll
        for (int i = 0; i < 4; ++i) {
            const int idx = tid + 256 * i, k = idx >> 4, n = (idx & 15) * 4;
            v[i] = (f32x4){0.f, 0.f, 0.f, 0.f};
            if (nt * 64 + n < N) v[i] = *(const f32x4*)(s + (size_t)(kt * 64 + k) * N + nt * 64 + n);
        }
    };
    if (wg < total) ld(wg);
    for (int w = wg; w < total; w += nwg) {
        const int mat = w / per, r = w % per, kt = r / tn, nt = r % tn;
        bf16_t* d = dst + (size_t)mat * dstride;
#pragma unroll
        for (int i = 0; i < 4; ++i) {
            const int idx = tid + 256 * i, k = idx >> 4, n = (idx & 15) * 4;
            t[k][n] = v[i][0]; t[k][n + 1] = v[i][1]; t[k][n + 2] = v[i][2]; t[k][n + 3] = v[i][3];
        }
        __syncthreads();
        if (w + nwg < total) ld(w + nwg);
        {
            const int n = tid >> 2, kq = (tid & 3) * 16;
            if (nt * 64 + n < N) {
                unsigned pk[8];
#pragma unroll
                for (int j = 0; j < 8; ++j) pk[j] = cvtpk(t[kq + 2 * j][n], t[kq + 2 * j + 1][n]);
                bf16_t* o = d + (size_t)conv_rowmap<MAP>(nt * 64 + n) * K + kt * 64 + kq;
                *(u32x4v*)o = (u32x4v){pk[0], pk[1], pk[2], pk[3]};
                *(u32x4v*)(o + 8) = (u32x4v){pk[4], pk[5], pk[6], pk[7]};
            }
        }
        __syncthreads();
    }
}
__device__ __forceinline__ void st_convert(const P& p, int wg, int nwg, float* sm) {
    const int tid = otid();
    conv_batched<0>(p.ev_w_in, 1, 1024, 2840, 0, p.wt_in0, 0, wg, nwg, sm, tid);
    conv_batched<0>(p.ev_w_out, 1, 1024, 1024, 0, p.wt_out0, 0, wg, nwg, sm, tid);
    conv_batched<0>(p.ck_w1, 1, 2048, 256, 0, p.wt_c1, 0, wg, nwg, sm, tid);
    conv_batched<0>(p.cv_w1, 1, 2048, 256, 0, p.wt_c1 + 256 * 2048, 0, wg, nwg, sm, tid);
    conv_batched<0>(p.ck_w2, 1, 256, 64, 0, p.wt_c2, 0, wg, nwg, sm, tid);
    conv_batched<0>(p.cv_w2, 1, 256, 64, 0, p.wt_c2 + 64 * 256, 0, wg, nwg, sm, tid);
    conv_batched<0>(p.od_w_in, 1, 1024, 1216, 0, p.wt_in1, 0, wg, nwg, sm, tid);
    conv_batched<0>(p.od_w_out, 1, 1024, 1024, 0, p.wt_out1, 0, wg, nwg, sm, tid);
    conv_batched<0>(p.w_q_up, 1, 256, 768, 0, p.wt_qup, 0, wg, nwg, sm, tid);
    conv_batched<0>(p.w_kv_up, 1, 128, 1024, 0, p.wt_kvup, 0, wg, nwg, sm, tid);
    {
        const int wid = tid >> 6, lane = tid & 63;
        for (int w = wg * 4 + wid; w < 512; w += nwg * 4) {
            const int which = w >> 8, cg = (w >> 6) & 3, ks = w & 63, col = cg * 64 + lane;
            const float* w1 = (which ? p.cv_w1 : p.ck_w1) + (size_t)(ks * 32) * 256 + col; const float* pos = (which ? p.pos_v : p.pos_k) + ks * 32;
            float a = 0.f;
#pragma unroll
            for (int k = 0; k < 32; ++k) a += pos[k] * w1[(size_t)k * 256];
            p.c1p[(which * 64 + ks) * 256 + col] = a;
        }
    }
}
__device__ __forceinline__ void st_c1_reduce(const P& p, int wg, int nwg) {
    const int tid = otid();
    for (int i = wg * 256 + tid; i < 512; i += nwg * 256) {
        const int which = i >> 8, col = i & 255;
        float a = 0.f;
#pragma unroll 16
        for (int ks = 0; ks < 64; ++ks) a += p.c1p[(which * 64 + ks) * 256 + col];
        p.c1[i] = a;
    }
}


struct XcdOrder {
    int xcd, lw, nlw, tn, per;
    __device__ __forceinline__ XcdOrder(int wg, int nwg, int nM, int tn_) : xcd(wg & 7), lw(wg >> 3), nlw(nwg >> 3), tn(tn_), per((nM >> 3) * tn_) {}
    __device__ __forceinline__ bool get(int k, int& mt, int& nt) const { const int lt = lw + k * nlw; if (lt >= per) return false; mt = xcd + 8 * (lt / tn); nt = lt % tn; return true; }
};
__device__ __forceinline__ void st_inproj0_mf(const P& p, int wg, int nwg, LDSP char* lds) {
    const int tid = otid();
    const XcdOrder ord(wg, nwg, 128, 23);
    auto Af = [&](int mt_) { return [=](int r) { return p.h + (size_t)(mt_ * 128 + r) * DM; }; };
    auto Bf = [&](int nt_) { return [=](int r) { int n = nt_ * 128 + r; n = n < 2840 ? n : 2839; return p.wt_in0 + (size_t)n * 1024; }; };
    bool staged = false;
    for (int k = 0;; ++k) {
        int mt, nt, mt2 = 0, nt2 = 0;
        if (!ord.get(k, mt, nt)) break;
        const bool has2 = ord.get(k + 1, mt2, nt2);
        const bool st_ = staged; staged = has2;
        gemm128x(16, 64, 64, Af(mt), Bf(nt),
            [&](int rl, int cl, const f32x4 (&a)[4], int mfrag) {
                const int row = mt * 128 + rl;
#pragma unroll
                for (int n = 0; n < 4; ++n) {
                    const int col = nt * 128 + cl + n * 16;
                    if (col < 2840) {
                        *(u32x2*)(p.proj + (size_t)row * 2840 + col) = (u32x2){pack_bf16(a[n][0], a[n][1]), pack_bf16(a[n][2], a[n][3])};
                        if (col >= 1280 && col < 1304)
                            *(f32x4*)(p.gates + (size_t)row * 24 + (col - 1280)) = (f32x4){sigmf(a[n][0]), sigmf(a[n][1]), sigmf(a[n][2]), sigmf(a[n][3])};
                    }
                }
            }, lds, tid, st_, [&] { if (has2) g128_stage0(Af(mt2), Bf(nt2), lds, tid); });
    }
}
__device__ __forceinline__ void st_cmp1_mf(const P& p, int wg, int nwg, LDSP char* lds) {
    const int tid = otid();
    for (int w = wg; w < 2 * 16 * 2; w += nwg) {
        const int which = w >> 5, mt = (w >> 1) & 15, nt = w & 1;
        const int colbase = which ? 640 : 512;
        gemm128(32, 2840, 64,
            [&](int r) { int m = mt * 128 + r; m = m < 2044 ? m : 2043; const int bk = m / 511, n = m % 511, b = bk >> 1, kv = bk & 1;
                         return p.proj + (size_t)(b * SEQ + 16 * n) * 2840 + colbase + kv * 64; },
            [&](int r) { return p.wt_c1 + (size_t)(which * 256 + nt * 128 + r) * 2048; },
            [&](int rl, int cl, const f32x4 (&a)[4], int mfrag) {
                const int m = mt * 128 + rl;
                if (m < 2044) {
#pragma unroll
                    for (int n = 0; n < 4; ++n) {
                        const int col = nt * 128 + cl + n * 16;
                        const f32x4 cb = *(const f32x4*)(p.c1 + which * 256 + col);
                        *(u32x2*)(p.chidb + (size_t)(which * 2048 + m) * 256 + col) =
                            (u32x2){pack_bf16(gelu_tanh(a[n][0] + cb[0]), gelu_tanh(a[n][1] + cb[1])), pack_bf16(gelu_tanh(a[n][2] + cb[2]), gelu_tanh(a[n][3] + cb[3]))};
                    }
                }
            }, lds, tid);
    }
}
__device__ __forceinline__ void st_cmp2_mf(const P& p, int wg, int nwg, LDSP char* lds) {
    const int tid = otid();
    for (int w = wg; w < 2 * 16; w += nwg) {
        const int which = w >> 4, mt = w & 15;
        gemm128(4, 64, 64,
            [&](int r) { int m = mt * 128 + r; m = m < 2044 ? m : 2043; return p.chidb + (size_t)(which * 2048 + m) * 256; },
            [&](int r) { return p.wt_c2 + (size_t)(which * 64 + (r & 63)) * 256; },
            [&](int rl, int cl, const f32x4 (&a)[4], int mfrag) {
                const int m = mt * 128 + rl;
                if (m < 2044) {
#pragma unroll
                    for (int n = 0; n < 4; ++n) { const int col = cl + n * 16; if (col < 64) {
                        const int bk = m / 511, nn = m % 511;
                        *(u32x2*)(p.kcmpb + ((size_t)((which * 4 + bk) * 512 + nn)) * 64 + col) = (u32x2){cvtpk(a[n][0], a[n][1]), cvtpk(a[n][2], a[n][3])}; } }
                }
            }, lds, tid);
    }
}
__device__ __forceinline__ void st_outproj_mf(const P& p, int layer, int wg, int nwg, LDSP char* lds) {
    const int tid = otid();
    const bf16_t* W = layer ? p.wt_out1 : p.wt_out0;
    const float* xin = layer ? p.out : p.x;
    const XcdOrder ord(wg, nwg, 128, 8);
    auto Af = [&](int mt_) { return [=](int r) { return p.o + (size_t)(mt_ * 128 + r) * DM; }; };
    auto Bf = [&](int nt_) { return [=](int r) { return W + (size_t)(nt_ * 128 + r) * 1024; }; };
    bool staged = false;
    for (int k = 0;; ++k) {
        int mt, nt, mt2 = 0, nt2 = 0;
        if (!ord.get(k, mt, nt)) break;
        const bool has2 = ord.get(k + 1, mt2, nt2);
        const bool st_ = staged; staged = has2;
        gemm128x(16, 64, 64, Af(mt), Bf(nt),
            [&](int rl, int cl, const f32x4 (&a)[4], int mfrag) {
                const int row = mt * 128 + rl, b = row >> 13;
                const float* g = p.modv + (size_t)(layer * 2 + b) * 6144 + 2 * 1024;
#pragma unroll
                for (int n = 0; n < 4; ++n) {
                    const int col = nt * 128 + cl + n * 16;
                    const f32x4 xv = *(const f32x4*)(xin + (size_t)row * DM + col), gv = *(const f32x4*)(g + col);
                    *(f32x4*)(p.out + (size_t)row * DM + col) = xv + gv * a[n];
                }
            }, lds, tid, st_, [&] { if (has2) g128_stage0(Af(mt2), Bf(nt2), lds, tid); });
    }
}
__device__ __forceinline__ bool moe_tile128(const int* cnt, int tt, int& e, int& i0, int& off) {
    int acc = 0, o = 0;
    for (int q = 0; q < 16; ++q) {
        const int c = cnt[q * 32], nt = (c + 127) >> 7;
        if (tt < acc + nt) { e = q; i0 = (tt - acc) * 128; off = o; return true; }
        acc += nt; o += c;
    }
    return false;
}
struct MoeTile { int e, i0, off, nt, ce; bool ok; };
__device__ __forceinline__ MoeTile moe_get(const int* cnt, int w) {
    MoeTile t; t.ok = moe_tile128(cnt, w >> 3, t.e, t.i0, t.off); t.nt = w & 7; t.ce = t.ok ? cnt[t.e * 32] : 0; return t;
}
__device__ __forceinline__ void st_moe_up_mf(const P& p, int layer, int wg, int nwg, LDSP char* lds) {
    const int tid = otid();
    const int* cnt = p.cnt + layer * 512;
    auto Af = [&](const MoeTile& t) { const int* lst = p.list + t.e * T_TOK; const int i0 = t.i0, ce = t.ce;
                                      return [=](int r) { const int i = (i0 + r < ce) ? i0 + r : i0; return p.h + (size_t)(lst[i] >> 1) * DM; }; };
    auto Bf = [&](const MoeTile& t) { const bf16_t* B = p.wt_gu + ((size_t)(layer * 16 + t.e) * 1024 + t.nt * 128) * 1024; return [=](int r) { return B + (size_t)r * 1024; }; };
    MoeTile cur = moe_get(cnt, wg);
    bool staged = false;
    for (int w = wg; cur.ok; w += nwg) {
        const MoeTile nx = moe_get(cnt, w + nwg);
        const bool st_ = staged; staged = nx.ok;
        const int i0 = cur.i0, ce = cur.ce, off = cur.off, nt = cur.nt;
        gemm128x(16, 64, 64, Af(cur), Bf(cur),
            [&](int rl, int cl, const f32x4 (&a)[4], int mfrag) {
                if (i0 + rl < ce) {
                    const int wc = cl >> 6, fq4 = cl & 63;
#pragma unroll
                    for (int n = 0; n < 2; ++n) {
                        const int col = nt * 64 + wc * 32 + n * 16 + fq4;
                        const f32x4 g = a[n], u = a[n + 2];
                        *(u32x2*)(p.hid + (size_t)(off + i0 + rl) * 512 + col) =
                            (u32x2){pack_bf16(siluf(g[0]) * u[0], siluf(g[1]) * u[1]), pack_bf16(siluf(g[2]) * u[2], siluf(g[3]) * u[3])};
                    }
                }
            }, lds, tid, st_, [&] { if (nx.ok) g128_stage0(Af(nx), Bf(nx), lds, tid); });
        cur = nx;
    }
}
__device__ __forceinline__ void st_moe_down_mf(const P& p, int layer, int wg, int nwg, LDSP char* lds) {
    const int tid = otid();
    const int* cnt = p.cnt + layer * 512;
    auto Af = [&](const MoeTile& t) { const int i0 = t.i0, ce = t.ce, off = t.off; return [=](int r) { const int i = (i0 + r < ce) ? i0 + r : i0; return p.hid + (size_t)(off + i) * 512; }; };
    auto Bf = [&](const MoeTile& t) { const bf16_t* B = p.wt_d + ((size_t)(layer * 16 + t.e) * 1024 + t.nt * 128) * 512; return [=](int r) { return B + (size_t)r * 512; }; };
    MoeTile cur = moe_get(cnt, wg);
    bool staged = false;
    for (int w = wg; cur.ok; w += nwg) {
        const MoeTile nx = moe_get(cnt, w + nwg);
        const bool st_ = staged; staged = nx.ok;
        const int i0 = cur.i0, ce = cur.ce, nt = cur.nt;
        const int* lst = p.list + cur.e * T_TOK;
        int ids[4]; float wts[4];
#pragma unroll
        for (int m = 0; m < 4; ++m) { const int rl = ((tid >> 7) & 1) * 64 + m * 16 + (tid & 15); ids[m] = (i0 + rl < ce) ? lst[i0 + rl] : -1; }
#pragma unroll
        for (int m = 0; m < 4; ++m) wts[m] = ids[m] >= 0 ? p.tokw[ids[m]] : 0.f;
        gemm128x(8, 64, 64, Af(cur), Bf(cur),
            [&](int rl, int cl, const f32x4 (&a)[4], int mfrag) {
                if (i0 + rl < ce) {
                    const int id = ids[mfrag]; const float wt = wts[mfrag];
#pragma unroll
                    for (int n = 0; n < 4; ++n) {
                        const int col = nt * 128 + cl + n * 16;
                        *(u32x2*)(p.y + (size_t)id * DM + col) = (u32x2){pack_bf16(wt * a[n][0], wt * a[n][1]), pack_bf16(wt * a[n][2], wt * a[n][3])};
                    }
                }
            }, lds, tid, st_, [&] { if (nx.ok) g128_stage0(Af(nx), Bf(nx), lds, tid); });
        cur = nx;
    }
}
__device__ __forceinline__ void st_inproj1_mf(const P& p, int wg, int nwg, LDSP char* lds) {
    const int tid = otid();
    const XcdOrder ord(wg, nwg, 128, 10);
    auto Af = [&](int mt_) { return [=](int r) { return p.h + (size_t)(mt_ * 128 + r) * DM; }; };
    auto Bf = [&](int nt_) { return [=](int r) { int n = nt_ * 128 + r; n = n < 1216 ? n : 1215; return p.wt_in1 + (size_t)n * 1024; }; };
    bool staged = false;
    for (int k = 0;; ++k) {
        int mt, nt, mt2 = 0, nt2 = 0;
        if (!ord.get(k, mt, nt)) break;
        const bool has2 = ord.get(k + 1, mt2, nt2);
        const bool st_ = staged; staged = has2;
        gemm128x(16, 64, 64, Af(mt), Bf(nt),
            [&](int rl, int cl, const f32x4 (&a)[4], int mfrag) {
                const int row = mt * 128 + rl;
#pragma unroll
                for (int n = 0; n < 4; ++n) {
                    const int col = nt * 128 + cl + n * 16;
                    if (col < 1216) *(u32x2*)(p.proj1 + (size_t)row * 1216 + col) = (u32x2){pack_bf16(a[n][0], a[n][1]), pack_bf16(a[n][2], a[n][3])};
                }
            }, lds, tid, st_, [&] { if (has2) g128_stage0(Af(mt2), Bf(nt2), lds, tid); });
    }
}
__device__ __forceinline__ void st_mla_up_mf(const P& p, int wg, int nwg, LDSP char* lds) {
    const int tid = otid();
    const XcdOrder ord(wg, nwg, 128, 14);
    for (int k = 0;; ++k) {
        int mt, c;
        if (!ord.get(k, mt, c)) break;
        if (c < 6) {
            gemm128(4, 64, 64,
                [&](int r) { return p.cqn + (size_t)(mt * 128 + r) * 384; },
                [&](int r) { return p.wt_qup + (size_t)(c * 128 + r) * 256; },
                [&](int rl, int cl, const f32x4 (&a)[4], int mfrag) {
                    const int row = mt * 128 + rl, wc = cl >> 6;
                    f32x4 v[4] = {a[0], a[1], a[2], a[3]};
                    if (((c == 1 || c == 4) && wc == 0) || ((c == 2 || c == 5) && wc == 1)) {
                        const int t = row & (SEQ - 1), i0 = cl & 63;
#pragma unroll
                        for (int n = 0; n < 2; ++n) {
                            const f32x4 cs = *(const f32x4*)(p.ropec + t * 32 + n * 16 + i0), sn = *(const f32x4*)(p.ropes + t * 32 + n * 16 + i0);
                            v[n] = a[n] * cs - a[n + 2] * sn; v[n + 2] = a[n] * sn + a[n + 2] * cs;
                        }
                    }
#pragma unroll
                    for (int n = 0; n < 4; ++n) *(u32x2*)(p.qmla + (size_t)row * 768 + c * 128 + cl + n * 16) = (u32x2){cvtpk(v[n][0], v[n][1]), cvtpk(v[n][2], v[n][3])};
                }, lds, tid);
        } else {
            gemm128(2, 64, 64,
                [&](int r) { return p.cqn + (size_t)(mt * 128 + r) * 384 + 256; },
                [&](int r) { return p.wt_kvup + (size_t)((c - 6) * 128 + r) * 128; },
                [&](int rl, int cl, const f32x4 (&a)[4], int mfrag) {
                    const int row = mt * 128 + rl;
#pragma unroll
                    for (int n = 0; n < 4; ++n) *(u32x2*)(p.kvmla + (size_t)row * 1024 + (c - 6) * 128 + cl + n * 16) = (u32x2){pack_bf16(a[n][0], a[n][1]), pack_bf16(a[n][2], a[n][3])};
                }, lds, tid);
        }
    }
}

typedef float f32x16 __attribute__((ext_vector_type(16)));
typedef short s16x4 __attribute__((ext_vector_type(4)));
#define ATT_NEG (-1e30f)
#define ATT_SHIFT (-16.0f)
#define LOG2E 1.4426950408889634f

__device__ __forceinline__ int swz128(int row) { return (((row >> 1) & 1) << 2) | ((row >> 2) & 3); }
__device__ __forceinline__ int swz256(int row) { return ((row & 3) << 2) | ((row >> 2) & 3); }

struct AttLane {
    int kbase;
    int v0[2];
};
template <int KROWB, int VROWB, int DT>
__device__ __forceinline__ void att_lane_init(AttLane& L, int lane) {
    const int q = lane & 31, hh = lane >> 5, x = hh ^ swz128(q);
    L.kbase = q * KROWB + x * 16;
    const int rl = 4 * hh + ((lane & 15) >> 2), blk = (lane >> 4) & 1, pp = lane & 3;
#pragma unroll
    for (int t = 0; t < 2; ++t) {
        const int g = (VROWB == 256) ? (((rl & 3) << 2) | ((2 * t + hh) & 3)) : ((((rl >> 1) & 1) << 2) | ((2 * t + hh) & 3));
        L.v0[t] = rl * VROWB + (((2 * blk + (pp >> 1)) ^ g) * 16) + 8 * (pp & 1);
    }
}
template <int KS, int KROWB, int MODE, bool WANT_P, bool IMP>
__device__ __forceinline__ void att_qk(LDSP const char* kb, const AttLane& L, const bf16x8 (&qf)[KS], bf16x8 (&pf)[4], float& lsum, const float c1, const float cadd,
                                       const unsigned lutv, const int dq16, LDSP float* improw, const float invl) {
    float la = 0.f, lb = 0.f, lc = 0.f, ld = 0.f;
#pragma unroll
    for (int kt = 0; kt < 2; ++kt) {
        f32x16 s;
#pragma unroll
        for (int r = 0; r < 16; ++r) s[r] = 0.f;
        constexpr int KG = (KS > 4) ? 2 : 4;
#pragma unroll
        for (int k4 = 0; k4 < KS; k4 += KG) {
            bf16x8 a[KG];
#pragma unroll
            for (int j = 0; j < KG; ++j) { const int ks = k4 + j; a[j] = *(const LDSP bf16x8*)(kb + (L.kbase ^ (32 * (ks & 3))) + (ks >> 2) * 128 + kt * 32 * KROWB); }
#pragma unroll
            for (int j = 0; j < KG; ++j) s = __builtin_amdgcn_mfma_f32_32x32x16_bf16(a[j], qf[k4 + j], s, 0, 0, 0);
            asm volatile("" ::: "memory");
        }
        float pr[16];
#pragma unroll
        for (int r = 0; r < 16; ++r) {
            const int koff = 32 * kt + (r & 3) + 8 * (r >> 2);
            float add = cadd;
            if (MODE == 1) add = *(const LDSP float*)(lutv + (63 - koff) * 4);
            if (MODE == 2) { int d = dq16 - 16 * koff; d = d < -1 ? -1 : d; d = d > 1087 ? 1087 : d; add = *(const LDSP float*)(lutv + (unsigned)(64 + d) * 4u); }
            pr[r] = __builtin_amdgcn_exp2f(__builtin_fmaf(s[r], c1, add));
        }
#pragma unroll
        for (int r = 0; r < 16; r += 4) { la += pr[r]; lb += pr[r + 1]; lc += pr[r + 2]; ld += pr[r + 3]; }
        if (IMP) {
#pragma unroll
            for (int g = 0; g < 4; ++g) {
                (void)__hip_atomic_fetch_add((LDSP unsigned*)improw + 8 * kt + 2 * g, (unsigned)(((pr[4 * g] + pr[4 * g + 1]) + (pr[4 * g + 2] + pr[4 * g + 3])) * invl + 0.5f), __ATOMIC_RELAXED, __HIP_MEMORY_SCOPE_WORKGROUP);
                (void)__hip_atomic_fetch_add((LDSP unsigned*)improw + 8 * kt + 2 * g + 1, (unsigned)(pr[4 * g + 3] * invl + 0.5f), __ATOMIC_RELAXED, __HIP_MEMORY_SCOPE_WORKGROUP);
            }
        }
        if (WANT_P) {
#pragma unroll
            for (int sI = 0; sI < 2; ++sI) {
                union { unsigned u[4]; bf16x8 v; } cv;
#pragma unroll
                for (int i = 0; i < 4; ++i) cv.u[i] = cvtpk_valu(pr[8 * sI + 2 * i], pr[8 * sI + 2 * i + 1]);
                pf[kt * 2 + sI] = cv.v;
            }
        }
    }
    lsum += (la + lb) + (lc + ld);
}
template <int DT, int VROWB>
__device__ __forceinline__ void att_pv(LDSP const char* vb, const AttLane& L, const bf16x8 (&pf)[4], f32x16 (&o)[DT]) {
    const unsigned vba = (unsigned)(size_t)vb;
#pragma unroll
    for (int ks2 = 0; ks2 < 4; ++ks2) {
#pragma unroll
        for (int d0 = 0; d0 < DT; d0 += 2) {
            s16x4 lo[2], hi[2];
#pragma unroll
            for (int j = 0; j < 2; ++j) {
                asm volatile("ds_read_b64_tr_b16 %0, %1 offset:%2" : "=v"(lo[j]) : "v"(vba + (L.v0[0] ^ ((d0 + j) << 6))), "i"((16 * ks2) * VROWB) : "memory");
                asm volatile("ds_read_b64_tr_b16 %0, %1 offset:%2" : "=v"(hi[j]) : "v"(vba + (L.v0[1] ^ ((d0 + j) << 6))), "i"((16 * ks2 + 8) * VROWB) : "memory");
            }
            asm volatile("s_waitcnt lgkmcnt(0)" ::: "memory");
#pragma unroll
            for (int j = 0; j < 2; ++j) {
                asm volatile("" : "+v"(lo[j]), "+v"(hi[j]));
                const bf16x8 vf = __builtin_shufflevector(lo[j], hi[j], 0, 1, 2, 3, 4, 5, 6, 7);
                o[d0 + j] = __builtin_amdgcn_mfma_f32_32x32x16_bf16(vf, pf[ks2], o[d0 + j], 0, 0, 0);
            }
        }
    }
}
template <int CPR>
__device__ __forceinline__ void att_stage_map(int (&rowc)[(CPR == 24) ? 6 : 1], int tid) {
    if (CPR == 24) {
#pragma unroll
        for (int i = 0; i < 6; ++i) {
            const int c = tid + 256 * i, row = c / 24, cc = c % 24;
            rowc[i % ((CPR == 24) ? 6 : 1)] = (row << 8) | ((cc & ~7) | ((cc & 7) ^ swz128(row)));
        }
    } else if (CPR == 16) {
        const int row = tid >> 4; rowc[0] = (row << 8) | ((tid & 15) ^ swz256(row));
    } else {
        const int row = tid >> 3; rowc[0] = (row << 8) | ((tid & 7) ^ swz128(row));
    }
}
template <int CPR, class SRC>
__device__ __forceinline__ void att_stage(LDSP char* dst, SRC src, const int (&rowc)[(CPR == 24) ? 6 : 1], int wid) {
#pragma unroll
    for (int i = 0; i < CPR / 4; ++i) {
        const int rc = rowc[(CPR == 24) ? i : 0];
        const int row = (rc >> 8) + ((CPR == 24) ? 0 : i * (256 / CPR));
        __builtin_amdgcn_global_load_lds((const unsigned*)src(row, rc & 255), (LDSP unsigned*)(dst + (256 * i + 64 * wid) * 16), 16, 0, 0);
    }
}
__device__ __forceinline__ int wq_next(int* ctr, LDSP int* slot, int tid) {
    __syncthreads();
    if (tid == 0) *slot = atomicAdd(ctr, 1);
    __syncthreads();
    return *slot;
}

__device__ __forceinline__ void build_lut(LDSP float* tab, const float* blut_h, int n, int wlimit, int tid) {
    for (int i = tid; i < n; i += 256) { const int d = i - 64; tab[i] = (d < 0 || d >= wlimit) ? ATT_NEG : blut_h[d > 1023 ? 1023 : d] * LOG2E + ATT_SHIFT; }
}
#define ATT_BAR() do { __builtin_amdgcn_s_barrier(); asm volatile("" ::: "memory"); } while (0)

__device__ __forceinline__ void mla_item(const P& p, const int item, LDSP char* lds, const int tid0) {
    LDSP char* kb = lds; LDSP char* vb = lds + 24576; LDSP float* lut = (LDSP float*)(lds + 40960);
    const float c1 = 0.07216878364870322f * LOG2E;
    int tid = tid0; asm volatile("" : "+v"(tid));
    const int wid = tid >> 6, lane = tid & 63, q = lane & 31, hh = lane >> 5;
    AttLane L; att_lane_init<384, 256, 4>(L, lane);
    int krc[6], vrc[1];
    att_stage_map<24>(krc, tid); att_stage_map<16>(vrc, tid);
    int qt, bh, part;
    if (item >= 640) { const int r = item - 640; qt = 15 - (r >> 3); bh = r & 7; part = 0; }
    else {
        int g = 0; while (16 * (g + 1) + 8 * ((g + 2) >> 1) <= item) ++g;
        const int r = item - (16 * g + 8 * ((g + 1) >> 1)), Ln = 64 - g;
        if (r < 16) { qt = Ln - 1; bh = r & 7; part = 1 + (r >> 3); } else { qt = (Ln >> 1) - 1; bh = (r - 16) & 7; part = 0; }
    }
    const int b = bh >> 2, h = bh & 3;
    const int tw = qt * 128 + wid * 32;
    bf16x8 qf[12];
    {
        const bf16_t* qp = p.qmla + (size_t)(b * SEQ + tw + q) * 768 + h * 192 + 8 * hh;
#pragma unroll
        for (int ks = 0; ks < 12; ++ks) qf[ks] = *(const bf16x8*)(qp + 16 * ks);
    }
    f32x16 o[4];
#pragma unroll
    for (int dt = 0; dt < 4; ++dt)
#pragma unroll
        for (int r = 0; r < 16; ++r) o[dt][r] = 0.f;
    float lsum = 0.f;
    const int i0 = (part == 2) ? qt + 1 : 0, ntiles = (part == 1) ? qt + 1 : 2 * qt + 2;
    const bf16_t* kvb = p.kvmla + (size_t)b * SEQ * 1024 + h * 256;
    const bf16_t* krb = p.krope + (size_t)b * SEQ * 64;
    auto ksrc = [&](int pos0) { return [=](int row, int gc) { return gc < 16 ? kvb + (size_t)(pos0 + row) * 1024 + gc * 8 : krb + (size_t)(pos0 + row) * 64 + (gc - 16) * 8; }; };
    auto vsrc = [&](int pos0) { return [=](int row, int gc) { return kvb + (size_t)(pos0 + row) * 1024 + 128 + gc * 8; }; };
    att_stage<24>(kb, ksrc(i0 * 64), krc, wid);
    for (int i = i0; i < ntiles; ++i) {
        const int pos0 = i * 64;
        asm volatile("s_waitcnt vmcnt(0)" ::: "memory"); ATT_BAR();
        att_stage<16>(vb, vsrc(pos0), vrc, wid);
        const bool active = pos0 <= tw + 31, diag = pos0 + 63 > tw;
        bf16x8 pf[4];
        if (active) {
            if (diag) {
                int dq = tw + q - pos0 - 4 * hh; dq = dq < -1 ? -1 : dq;
                att_qk<12, 384, 1, true, false>(kb, L, qf, pf, lsum, c1, 0.f, (unsigned)(size_t)lut + (unsigned)(dq + 1) * 4u, 0, nullptr, 0.f);
            } else att_qk<12, 384, 0, true, false>(kb, L, qf, pf, lsum, c1, ATT_SHIFT, 0u, 0, nullptr, 0.f);
        }
        asm volatile("s_waitcnt vmcnt(0) lgkmcnt(0)" ::: "memory"); ATT_BAR();
        if (i + 1 < ntiles) att_stage<24>(kb, ksrc(pos0 + 64), krc, wid);
        if (active) att_pv<4, 256>(vb, L, pf, o);
    }
    const float lt = lsum + __shfl_xor(lsum, 32);
    int tid2 = tid0; asm volatile("" : "+v"(tid2));
    const int lane2 = tid2 & 63, trow = qt * 128 + (tid2 >> 6) * 32 + (lane2 & 31);
    bf16_t* op; float inv;
    if (part == 0) { inv = 1.0f / lt; op = p.o + (size_t)(b * SEQ + trow) * DM + h * 128 + 4 * (lane2 >> 5); }
    else {
        const size_t rec = (size_t)((part - 1) * 8 + bh) * (SEQ / 2) + (trow - SEQ / 2);
        inv = 1.0f; op = p.mlap + rec * 128 + 4 * (lane2 >> 5);
        if (lane2 < 32) p.mlal[rec] = lt;
    }
#pragma unroll
    for (int dt = 0; dt < 4; ++dt)
#pragma unroll
        for (int rq = 0; rq < 4; ++rq)
            *(u32x2*)(op + 32 * dt + 8 * rq) = (u32x2){cvtpk(o[dt][4 * rq] * inv, o[dt][4 * rq + 1] * inv), cvtpk(o[dt][4 * rq + 2] * inv, o[dt][4 * rq + 3] * inv)};
}
__device__ __forceinline__ void st_mla_combine(const P& p, int wg, int nwg) {
    const int TIDX = otid();
    const int wid = TIDX >> 6, lane = TIDX & 63;
    for (int w = wg * 4 + wid; w < 8 * (SEQ / 2); w += nwg * 4) {
        const int bh = w / (SEQ / 2), t = SEQ / 2 + w % (SEQ / 2), b = bh >> 2, h = bh & 3;
        const size_t r0 = (size_t)w, r1 = (size_t)(8 * (SEQ / 2) + w);
        const float inv = 1.0f / (p.mlal[r0] + p.mlal[r1]);
        const unsigned a = *(const unsigned*)(p.mlap + r0 * 128 + lane * 2), c = *(const unsigned*)(p.mlap + r1 * 128 + lane * 2);
        const float x0 = __uint_as_float(a << 16) + __uint_as_float(c << 16), x1 = __uint_as_float(a & 0xffff0000u) + __uint_as_float(c & 0xffff0000u);
        *(unsigned*)(p.o + (size_t)(b * SEQ + t) * DM + h * 128 + lane * 2) = cvtpk(x0 * inv, x1 * inv);
    }
}

__device__ __forceinline__ void swa_item(const P& p, const int item, LDSP char* lds, const int tid0) {
    LDSP char* kb = lds; LDSP char* vb = lds + 8192; LDSP float* luts = (LDSP float*)(lds + 46080);
    const float c1 = 0.125f * LOG2E;
    int tid = tid0; asm volatile("" : "+v"(tid));
    const int wid = tid >> 6, lane = tid & 63, q = lane & 31, hh = lane >> 5;
    AttLane L; att_lane_init<128, 128, 2>(L, lane);
    int rc[1]; att_stage_map<8>(rc, tid);
    const int b = item >> 9, kvh = (item >> 8) & 1, t0 = (item & 255) * 32, head = kvh * 4 + wid;
    bf16x8 qf[4];
    {
        const bf16_t* qp = p.proj1 + (size_t)(b * SEQ + t0 + q) * 1216 + 448 + head * 64 + 8 * hh;
#pragma unroll
        for (int ks = 0; ks < 4; ++ks) qf[ks] = *(const bf16x8*)(qp + 16 * ks);
    }
    f32x16 o[2];
#pragma unroll
    for (int dt = 0; dt < 2; ++dt)
#pragma unroll
        for (int r = 0; r < 16; ++r) o[dt][r] = 0.f;
    float lsum = 0.f;
    const bf16_t* kbp = p.proj1 + (size_t)b * SEQ * 1216 + 960 + kvh * 64;
    const bf16_t* zr = p.zrow;
    auto ksrc = [&](int pos0) { return [=](int row, int gc) { const int pos = pos0 + row; return (pos >= 0 && pos < SEQ) ? kbp + (size_t)pos * 1216 + gc * 8 : zr + gc * 8; }; };
    auto vsrc = [&](int pos0) { return [=](int row, int gc) { const int pos = pos0 + row; return (pos >= 0 && pos < SEQ) ? kbp + (size_t)pos * 1216 + 128 + gc * 8 : zr + gc * 8; }; };
    const unsigned tab = (unsigned)(size_t)(luts + head * 256);
    att_stage<8>(kb, ksrc(t0 - 128), rc, wid);
    for (int i = 0; i < 3; ++i) {
        const int pos0 = t0 - 128 + 64 * i;
        asm volatile("s_waitcnt vmcnt(0)" ::: "memory"); ATT_BAR();
        att_stage<8>(vb, vsrc(pos0), rc, wid);
        bf16x8 pf[4];
        int dq = t0 + q - pos0 - 4 * hh; dq = dq < -1 ? -1 : dq;
        att_qk<4, 128, 1, true, false>(kb, L, qf, pf, lsum, c1, 0.f, tab + (unsigned)(dq + 1) * 4u, 0, nullptr, 0.f);
        asm volatile("s_waitcnt vmcnt(0) lgkmcnt(0)" ::: "memory"); ATT_BAR();
        if (i + 1 < 3) att_stage<8>(kb, ksrc(pos0 + 64), rc, wid);
        att_pv<2, 128>(vb, L, pf, o);
    }
    const float lt = lsum + __shfl_xor(lsum, 32) + __builtin_amdgcn_exp2f(p.sinks[head] * LOG2E + ATT_SHIFT);
    const float inv = 1.0f / lt;
    bf16_t* op = p.o + (size_t)(b * SEQ + t0 + q) * DM + 512 + head * 64 + 4 * hh;
#pragma unroll
    for (int dt = 0; dt < 2; ++dt)
#pragma unroll
        for (int rq = 0; rq < 4; ++rq)
            *(u32x2*)(op + 32 * dt + 8 * rq) = (u32x2){cvtpk(o[dt][4 * rq] * inv, o[dt][4 * rq + 1] * inv), cvtpk(o[dt][4 * rq + 2] * inv, o[dt][4 * rq + 3] * inv)};
}
__device__ __forceinline__ void moe_conv_item(const P& p, const int layer, const int item, LDSP char* lds, const int tid0) {
    float* sm = (float*)lds;
    const int set = item >> 8, t0 = (item & 255) * 8;
    if (set == 0) conv_batched<1>(p.moe_wg + (size_t)layer * 16 * 1024 * 512, 16, 1024, 512, (size_t)1024 * 512, p.wt_gu + (size_t)layer * 16 * 1024 * 1024, (size_t)1024 * 1024, t0, 1, sm, tid0, t0 + 8);
    else if (set == 1) conv_batched<2>(p.moe_wu + (size_t)layer * 16 * 1024 * 512, 16, 1024, 512, (size_t)1024 * 512, p.wt_gu + (size_t)layer * 16 * 1024 * 1024, (size_t)1024 * 1024, t0, 1, sm, tid0, t0 + 8);
    else conv_batched<0>(p.moe_wd + (size_t)layer * 16 * 512 * 1024, 16, 512, 1024, (size_t)512 * 1024, p.wt_d + (size_t)layer * 16 * 1024 * 512, (size_t)1024 * 512, t0, 1, sm, tid0, t0 + 8);
}
__device__ __forceinline__ void st_attn1(const P& p, LDSP char* lds) {
    const int tid0 = otid();
    LDSP float* lut = (LDSP float*)(lds + 40960); LDSP int* slot = (LDSP int*)(lds + 45568); LDSP float* luts = (LDSP float*)(lds + 46080);
    for (int i = tid0; i < 1152; i += 256) lut[i] = (i < 64) ? ATT_NEG : ATT_SHIFT;
#pragma unroll 1
    for (int h = 0; h < 8; ++h) build_lut(luts + h * 256, p.blut + h * 1024, 256, 128, tid0);
    for (;;) {
        const int item = wq_next(p.wq + 0, slot, tid0);
        if (item >= 768 + 1024 + 768) break;
        if (item < 768) mla_item(p, item, lds, tid0);
        else { const int r = item - 768, g = r / 7, ps = r - g * 7;
               if (ps < 4) swa_item(p, g * 4 + ps, lds, tid0); else moe_conv_item(p, 1, g * 3 + ps - 4, lds, tid0); }
    }
}

#define A0_GLUT 16384
#define A0_WLUT 34816
#define A0_IMP 45056
#define A0_SEL 61568
#define A0_UN 62080
#define A0_LIST 62144
#define A0_SLOT 62720
__device__ __forceinline__ unsigned wmax_u32(unsigned v) {
#pragma unroll
    for (int o = 32; o > 0; o >>= 1) { const unsigned t = (unsigned)__shfl_xor((int)v, o); v = t > v ? t : v; }
    return v;
}
#define ATT_STORE_O(op, o, sc) do { _Pragma("unroll") for (int dt_ = 0; dt_ < 2; ++dt_) _Pragma("unroll") for (int rq_ = 0; rq_ < 4; ++rq_) \
        *(u32x2*)((op) + 32 * dt_ + 8 * rq_) = (u32x2){cvtpk((o)[dt_][4 * rq_] * (sc), (o)[dt_][4 * rq_ + 1] * (sc)), cvtpk((o)[dt_][4 * rq_ + 2] * (sc), (o)[dt_][4 * rq_ + 3] * (sc))}; } while (0)

__device__ __forceinline__ void nsa_item(const P& p, const int item, LDSP char* lds, const int tid0) {
    LDSP char* kb = lds; LDSP char* vb = lds + 8192;
    LDSP float* glut = (LDSP float*)(lds + A0_GLUT); LDSP float* wlut = (LDSP float*)(lds + A0_WLUT); LDSP float* imp = (LDSP float*)(lds + A0_IMP);
    LDSP unsigned* sel = (LDSP unsigned*)(lds + A0_SEL); LDSP unsigned* un = (LDSP unsigned*)(lds + A0_UN); LDSP unsigned short* blist = (LDSP unsigned short*)(lds + A0_LIST);
    const float c1 = 0.125f * LOG2E;
    int tid = tid0; asm volatile("" : "+v"(tid));
    const int wid = tid >> 6, lane = tid & 63, q = lane & 31, hh = lane >> 5;
    const int tile = 255 - (item >> 2), b = (item >> 1) & 1, kvh = item & 1, t0 = tile * 32, blk_t = t0 >> 6, head = kvh * 4 + wid;
#pragma unroll 1
    for (int h = 0; h < 4; ++h) { build_lut(glut + h * 1152, p.blut + (kvh * 4 + h) * 1024, 1152, 1 << 30, tid); build_lut(wlut + h * 640, p.blut + (kvh * 4 + h) * 1024, 640, 512, tid); }
    for (int i = tid; i < 32 * 129; i += 256) imp[i] = 0.f;
    AttLane L; att_lane_init<128, 128, 2>(L, lane);
    int rc[1]; att_stage_map<8>(rc, tid);
    const size_t rowq = (size_t)(b * SEQ + t0 + q);
    bf16x8 qf[4];
    {
        const bf16_t* qp = p.proj + rowq * 2840 + head * 64 + 8 * hh;
#pragma unroll
        for (int ks = 0; ks < 4; ++ks) qf[ks] = *(const bf16x8*)(qp + 16 * ks);
    }
    const float gc = p.gates[rowq * 24 + head * 3 + 0], gs = p.gates[rowq * 24 + head * 3 + 1], gw = p.gates[rowq * 24 + head * 3 + 2];
    const unsigned gtab = (unsigned)(size_t)(glut + wid * 1152), wtab = (unsigned)(size_t)(wlut + wid * 640);
    const bf16_t* zr = p.zrow;
    const bf16_t* pb = p.proj + (size_t)b * SEQ * 2840;
    f32x16 of[2], o[2];
#pragma unroll
    for (int dt = 0; dt < 2; ++dt)
#pragma unroll
        for (int r = 0; r < 16; ++r) { of[dt][r] = 0.f; o[dt][r] = 0.f; }
    bf16x8 pf[4];
    __syncthreads();
    const float cfar = glut[wid * 1152 + 64 + 1023];
    {
        int nvm = (t0 >> 4) + 1; nvm = nvm > 511 ? 511 : nvm;
        const int ntc = (nvm + 63) >> 6;
        const bf16_t* kcb = p.kcmpb + (size_t)((b * 2 + kvh) * 512) * 64;
        const bf16_t* vcb = p.kcmpb + (size_t)((4 + b * 2 + kvh) * 512) * 64;
        auto csrc = [&](const bf16_t* base, int n0) { return [=](int row, int gcx) { const int n = n0 + row; return n < 511 ? base + (size_t)n * 64 + gcx * 8 : zr + gcx * 8; }; };
        float lsum = 0.f;
        for (int nt = 0; nt < ntc; ++nt) {
            att_stage<8>(kb, csrc(kcb, nt * 64), rc, wid);
            asm volatile("s_waitcnt vmcnt(0)" ::: "memory"); ATT_BAR();
            const int dq16 = t0 + q - 31 - 1024 * nt - 64 * hh;
            if (t0 - 31 - 16 * (nt * 64 + 63) >= 1023) att_qk<4, 128, 0, false, false>(kb, L, qf, pf, lsum, c1, cfar, 0u, 0, nullptr, 0.f);
            else att_qk<4, 128, 2, false, false>(kb, L, qf, pf, lsum, c1, 0.f, gtab, dq16, nullptr, 0.f);
            asm volatile("s_waitcnt lgkmcnt(0)" ::: "memory"); ATT_BAR();
        }
        const float lc = lsum + __shfl_xor(lsum, 32);
        const float invl = lc > 0.f ? 1.0f / lc : 0.f;
        float dummy = 0.f;
        for (int nt = 0; nt < ntc; ++nt) {
            att_stage<8>(kb, csrc(kcb, nt * 64), rc, wid);
            att_stage<8>(vb, csrc(vcb, nt * 64), rc, wid);
            asm volatile("s_waitcnt vmcnt(0)" ::: "memory"); ATT_BAR();
            const int dq16 = t0 + q - 31 - 1024 * nt - 64 * hh;
            LDSP float* improw = imp + q * 129 + 16 * nt + hh;
            if (t0 - 31 - 16 * (nt * 64 + 63) >= 1023) att_qk<4, 128, 0, true, true>(kb, L, qf, pf, dummy, c1, cfar, 0u, 0, improw, invl * 524288.0f);
            else att_qk<4, 128, 2, true, true>(kb, L, qf, pf, dummy, c1, 0.f, gtab, dq16, improw, invl * 524288.0f);
            att_pv<2, 128>(vb, L, pf, o);
            asm volatile("s_waitcnt lgkmcnt(0)" ::: "memory"); ATT_BAR();
        }
        const float sc = gc * invl;
#pragma unroll
        for (int dt = 0; dt < 2; ++dt)
#pragma unroll
            for (int r = 0; r < 16; ++r) { of[dt][r] = o[dt][r] * sc; o[dt][r] = 0.f; }
    }
    __syncthreads();
    {
        unsigned u0 = 0u, u1 = 0u, u2 = 0u, u3 = 0u;
        for (int i = 0; i < 8; ++i) {
            const int tok = wid * 8 + i;
            const unsigned v0 = ((LDSP const unsigned*)imp)[tok * 129 + lane], v1 = ((LDSP const unsigned*)imp)[tok * 129 + 64 + lane];
            const int j0 = lane, j1 = lane + 64;
            const bool f0 = (j0 == 0) || (j0 == blk_t) || (j0 == blk_t - 1), f1 = (j1 == blk_t) || (j1 == blk_t - 1);
            unsigned k0 = f0 ? (0xFFFFFF80u | (unsigned)(127 - j0)) : (j0 <= blk_t ? ((v0 << 7) | (unsigned)(127 - j0)) : 0u);
            unsigned k1 = f1 ? (0xFFFFFF80u | (unsigned)(127 - j1)) : (j1 <= blk_t ? ((v1 << 7) | (unsigned)(127 - j1)) : 0u);
            unsigned thr = 0u;
#pragma unroll 1
            for (int bit = 31; bit >= 0; --bit) {
                const unsigned cand = thr | (1u << bit);
                const int c = __popcll(__ballot(k0 >= cand)) + __popcll(__ballot(k1 >= cand));
                thr = (c >= 16) ? cand : thr;
            }
            thr = thr ? thr : 1u;
            const unsigned long long b0 = __ballot(k0 >= thr), b1 = __ballot(k1 >= thr);
            const unsigned m0 = (unsigned)b0, m1 = (unsigned)(b0 >> 32), m2 = (unsigned)b1, m3 = (unsigned)(b1 >> 32);
            if (lane == 0) { sel[tok * 4 + 0] = m0; sel[tok * 4 + 1] = m1; sel[tok * 4 + 2] = m2; sel[tok * 4 + 3] = m3; }
            u0 |= m0; u1 |= m1; u2 |= m2; u3 |= m3;
        }
        if (lane == 0) { un[wid * 4 + 0] = u0; un[wid * 4 + 1] = u1; un[wid * 4 + 2] = u2; un[wid * 4 + 3] = u3; }
    }
    __syncthreads();
    {
        unsigned uw[4];
#pragma unroll
        for (int k = 0; k < 4; ++k) uw[k] = (unsigned)__builtin_amdgcn_readfirstlane((int)(un[k] | un[4 + k] | un[8 + k] | un[12 + k]));
        if (tid < 128) {
            const int k = tid >> 5, jb = tid & 31;
            unsigned wv = 0u; int below = 0;
#pragma unroll
            for (int kk = 0; kk < 4; ++kk) { if (kk == k) wv = uw[kk]; if (kk < k) below += __popc(uw[kk]); }
            if ((wv >> jb) & 1u) blist[below + __popc(wv & ((1u << jb) - 1u))] = (unsigned short)tid;
        }
        const int nb = __popc(uw[0]) + __popc(uw[1]) + __popc(uw[2]) + __popc(uw[3]);
        unsigned sq[4];
#pragma unroll
        for (int k = 0; k < 4; ++k) sq[k] = sel[q * 4 + k];
        __syncthreads();
        const bf16_t* ksb = pb + 768 + kvh * 64;
        auto ssrc = [&](int pos0, int colo) { return [=](int row, int gcx) { return ksb + (size_t)(pos0 + row) * 2840 + colo + gcx * 8; }; };
        float lsum = 0.f;
        att_stage<8>(kb, ssrc(64 * (int)blist[0], 0), rc, wid);
        for (int i = 0; i < nb; ++i) {
            const int j = __builtin_amdgcn_readfirstlane((int)blist[i]), pos0 = 64 * j;
            asm volatile("s_waitcnt vmcnt(0)" ::: "memory"); ATT_BAR();
            att_stage<8>(vb, ssrc(pos0, 128), rc, wid);
            unsigned sw = 0u;
#pragma unroll
            for (int k = 0; k < 4; ++k) if ((j >> 5) == k) sw = sq[k];
            const bool selq = (sw >> (j & 31)) & 1u;
            if (t0 - (pos0 + 63) >= 1023) att_qk<4, 128, 0, true, false>(kb, L, qf, pf, lsum, c1, selq ? cfar : ATT_NEG, 0u, 0, nullptr, 0.f);
            else {
                int dq = t0 + q - pos0 - 4 * hh; dq = dq > 1087 ? 1087 : dq; dq = (dq < -1 || !selq) ? -1 : dq;
                att_qk<4, 128, 1, true, false>(kb, L, qf, pf, lsum, c1, 0.f, gtab + (unsigned)(dq + 1) * 4u, 0, nullptr, 0.f);
            }
            asm volatile("s_waitcnt vmcnt(0) lgkmcnt(0)" ::: "memory"); ATT_BAR();
            if (i + 1 < nb) att_stage<8>(kb, ssrc(64 * (int)blist[i + 1], 0), rc, wid);
            att_pv<2, 128>(vb, L, pf, o);
        }
        const float ls = lsum + __shfl_xor(lsum, 32);
        const float sc = gs / ls;
#pragma unroll
        for (int dt = 0; dt < 2; ++dt)
#pragma unroll
            for (int r = 0; r < 16; ++r) { of[dt][r] += o[dt][r] * sc; o[dt][r] = 0.f; }
    }
    {
        const bf16_t* kwb = pb + 1024 + kvh * 64;
        auto wsrc = [&](int pos0, int colo) { return [=](int row, int gcx) { const int pos = pos0 + row; return (pos >= 0 && pos < SEQ) ? kwb + (size_t)pos * 2840 + colo + gcx * 8 : zr + gcx * 8; }; };
        float lsum = 0.f;
        asm volatile("s_waitcnt lgkmcnt(0)" ::: "memory"); ATT_BAR();
        att_stage<8>(kb, wsrc(t0 - 512, 0), rc, wid);
        for (int i = 0; i < 9; ++i) {
            const int pos0 = t0 - 512 + 64 * i;
            asm volatile("s_waitcnt vmcnt(0)" ::: "memory"); ATT_BAR();
            att_stage<8>(vb, wsrc(pos0, 128), rc, wid);
            int dq = t0 + q - pos0 - 4 * hh; dq = dq < -1 ? -1 : dq;
            att_qk<4, 128, 1, true, false>(kb, L, qf, pf, lsum, c1, 0.f, wtab + (unsigned)(dq + 1) * 4u, 0, nullptr, 0.f);
            asm volatile("s_waitcnt vmcnt(0) lgkmcnt(0)" ::: "memory"); ATT_BAR();
            if (i + 1 < 9) att_stage<8>(kb, wsrc(pos0 + 64, 0), rc, wid);
            att_pv<2, 128>(vb, L, pf, o);
        }
        const float lw = lsum + __shfl_xor(lsum, 32);
        const float sc = gw / lw;
#pragma unroll
        for (int dt = 0; dt < 2; ++dt)
#pragma unroll
            for (int r = 0; r < 16; ++r) of[dt][r] += o[dt][r] * sc;
    }
    bf16_t* op = p.o + rowq * DM + head * 64 + 4 * hh;
    ATT_STORE_O(op, of, 1.0f);
}

#define MG_CNT 8192
#define MG_BASE 8320
#define MG_ENT 8448
__device__ __forceinline__ void st_moba_gate(const P& p, int wg, int nwg, LDSP char* lds) {
    const int tid = otid();
    const int wid = tid >> 6, lane = tid & 63, q = lane & 31, hh = lane >> 5;
    LDSP char* kmt = lds; LDSP int* lcnt = (LDSP int*)(lds + MG_CNT); LDSP int* lbase = (LDSP int*)(lds + MG_BASE); LDSP int* ent = (LDSP int*)(lds + MG_ENT);
    AttLane L; att_lane_init<128, 128, 2>(L, lane);
    int rc[1]; att_stage_map<8>(rc, tid);
    const bf16_t* zr = p.zrow;
    for (int item = wg; item < 1024; item += nwg) {
        const int tile = item >> 4, b = (item >> 3) & 1, h = item & 7, t0 = tile * 128, own = t0 >> 8, tw = t0 + wid * 32, bh = b * 8 + h;
        if (own == 0) continue;
        __syncthreads();
        if (tid < 32) lcnt[tid] = 0;
        bf16x8 qf[4];
        {
            const bf16_t* qp = p.proj + (size_t)(b * SEQ + tw + q) * 2840 + 1304 + h * 64 + 8 * hh;
#pragma unroll
            for (int ks = 0; ks < 4; ++ks) qf[ks] = *(const bf16x8*)(qp + 16 * ks);
        }
        const bf16_t* kmb = p.kmeanb + (size_t)(bh * 32) * 64;
        att_stage<8>(kmt, [=](int row, int gcx) { return row < 32 ? kmb + (size_t)row * 64 + gcx * 8 : zr + gcx * 8; }, rc, wid);
        asm volatile("s_waitcnt vmcnt(0)" ::: "memory");
        __syncthreads();
        f32x16 s;
#pragma unroll
        for (int r = 0; r < 16; ++r) s[r] = 0.f;
#pragma unroll
        for (int ks = 0; ks < 4; ++ks) {
            const bf16x8 a = *(const LDSP bf16x8*)(kmt + (L.kbase ^ (32 * (ks & 3))));
            s = __builtin_amdgcn_mfma_f32_32x32x16_bf16(a, qf[ks], s, 0, 0, 0);
        }
        unsigned key[16];
#pragma unroll
        for (int r = 0; r < 16; ++r) {
            const int j = (r & 3) + 8 * (r >> 2) + 4 * hh;
            const unsigned bits = __float_as_uint(s[r]);
            const unsigned srt = (bits & 0x80000000u) ? ~bits : (bits | 0x80000000u);
            key[r] = (j < own) ? ((srt & ~31u) | (unsigned)(31 - j)) : 0u;
        }
        unsigned selm = 0u;
#pragma unroll 1
        for (int rnd = 0; rnd < 3; ++rnd) {
            unsigned m = 0u;
#pragma unroll
            for (int r = 0; r < 16; ++r) m = key[r] > m ? key[r] : m;
            const unsigned mo = (unsigned)__shfl_xor((int)m, 32);
            const unsigned wk = mo > m ? mo : m;
            if (wk != 0u) selm |= 1u << (31 - (wk & 31u));
#pragma unroll
            for (int r = 0; r < 16; ++r) key[r] = (key[r] == wk) ? 0u : key[r];
        }
        if (hh == 0) {
            unsigned mm = selm;
#pragma unroll
            for (int sI = 0; sI < 3; ++sI) {
                int en = -1;
                if (mm) { const int j = __builtin_ctz(mm); mm &= mm - 1u; const int lp = __hip_atomic_fetch_add(lcnt + j, 1, __ATOMIC_RELAXED, __HIP_MEMORY_SCOPE_WORKGROUP); en = (j << 8) | lp; }
                ent[(wid * 32 + q) * 3 + sI] = en;
            }
        }
        __syncthreads();
        if (tid < 32) { const int c = lcnt[tid]; lbase[tid] = c ? atomicAdd(p.mcnt + bh * 32 + tid, c) : 0; }
        __syncthreads();
        for (int e = tid; e < 384; e += 256) {
            const int en = ent[e];
            if (en >= 0) { const int j = en >> 8, tokl = e / 3, sI = e - tokl * 3; p.mlist[(size_t)(bh * 32 + j) * 8192 + lbase[j] + (en & 255)] = (unsigned short)((t0 + tokl) | (sI << 13)); }
        }
    }
}
__device__ __forceinline__ bf16_t* moba_part(const P& p, int slot, size_t row) { return (slot < 2 ? p.mp01 + (size_t)slot * 131072 * 64 : p.mp2) + row * 64; }

__device__ __forceinline__ void moba_inv_item(const P& p, const int lid, const int chunk, LDSP char* lds, const int tid0) {
    LDSP char* kb = lds; LDSP char* vb = lds + 8192; LDSP float* glut = (LDSP float*)(lds + A0_GLUT);
    const float c1 = 0.125f * LOG2E;
    int tid = tid0; asm volatile("" : "+v"(tid));
    const int wid = tid >> 6, lane = tid & 63, q = lane & 31, hh = lane >> 5;
    const int bh = lid / 31, j = lid - bh * 31, b = bh >> 3, h = bh & 7;
    build_lut(glut, p.blut + h * 1024, 1152, 1 << 30, tid);
    AttLane L; att_lane_init<128, 128, 2>(L, lane);
    int rc[1]; att_stage_map<8>(rc, tid);
    const int n = p.mcnt[bh * 32 + j], idx = chunk * 128 + wid * 32 + q;
    const bool valid = idx < n;
    const unsigned en = valid ? (unsigned)p.mlist[(size_t)(bh * 32 + j) * 8192 + idx] : (unsigned)(256 * (j + 1));
    const int tok = (int)(en & 8191u), slot = (int)(en >> 13);
    bf16x8 qf[4];
    {
        const bf16_t* qp = p.proj + (size_t)(b * SEQ + tok) * 2840 + 1304 + h * 64 + 8 * hh;
#pragma unroll
        for (int ks = 0; ks < 4; ++ks) qf[ks] = *(const bf16x8*)(qp + 16 * ks);
    }
    const unsigned gtab = (unsigned)(size_t)glut;
    const bf16_t* kbb = p.proj + (size_t)b * SEQ * 2840 + 1816 + h * 64;
    auto msrc = [&](int pos0, int colo) { return [=](int row, int gcx) { return kbb + (size_t)(pos0 + row) * 2840 + colo + gcx * 8; }; };
    f32x16 o[2];
#pragma unroll
    for (int dt = 0; dt < 2; ++dt)
#pragma unroll
        for (int r = 0; r < 16; ++r) o[dt][r] = 0.f;
    float lsum = 0.f;
    bf16x8 pf[4];
    __syncthreads();
    att_stage<8>(kb, msrc(256 * j, 0), rc, wid);
    for (int i = 0; i < 4; ++i) {
        const int pos0 = 256 * j + 64 * i;
        asm volatile("s_waitcnt vmcnt(0)" ::: "memory"); ATT_BAR();
        att_stage<8>(vb, msrc(pos0, 512), rc, wid);
        {
            int dq = tok - pos0 - 4 * hh; dq = dq > 1087 ? 1087 : dq; dq = valid ? dq : -1;
            att_qk<4, 128, 1, true, false>(kb, L, qf, pf, lsum, c1, 0.f, gtab + (unsigned)(dq + 1) * 4u, 0, nullptr, 0.f);
        }
        asm volatile("s_waitcnt vmcnt(0) lgkmcnt(0)" ::: "memory"); ATT_BAR();
        if (i + 1 < 4) att_stage<8>(kb, msrc(pos0 + 64, 0), rc, wid);
        att_pv<2, 128>(vb, L, pf, o);
    }
    const float lt = lsum + __shfl_xor(lsum, 32);
    if (valid) {
        const size_t row = (size_t)bh * SEQ + tok;
        bf16_t* op = moba_part(p, slot, row) + 4 * hh;
        ATT_STORE_O(op, o, 1.0f);
        if (hh == 0) p.mpl[(size_t)slot * 131072 + row] = lt;
    }
}
__device__ __forceinline__ void moba_own_item(const P& p, const int item, LDSP char* lds, const int tid0) {
    LDSP char* kb = lds; LDSP char* vb = lds + 8192; LDSP float* glut = (LDSP float*)(lds + A0_GLUT);
    const float c1 = 0.125f * LOG2E;
    int tid = tid0; asm volatile("" : "+v"(tid));
    const int wid = tid >> 6, lane = tid & 63, q = lane & 31, hh = lane >> 5;
    const int tile = item >> 4, b = (item >> 3) & 1, h = item & 7, t0 = tile * 128, own = t0 >> 8, tw = t0 + wid * 32, bh = b * 8 + h;
    __syncthreads();
    build_lut(glut, p.blut + h * 1024, 1152, 1 << 30, tid);
    AttLane L; att_lane_init<128, 128, 2>(L, lane);
    int rc[1]; att_stage_map<8>(rc, tid);
    const size_t rowq = (size_t)(b * SEQ + tw + q);
    bf16x8 qf[4];
    {
        const bf16_t* qp = p.proj + rowq * 2840 + 1304 + h * 64 + 8 * hh;
#pragma unroll
        for (int ks = 0; ks < 4; ++ks) qf[ks] = *(const bf16x8*)(qp + 16 * ks);
    }
    const unsigned gtab = (unsigned)(size_t)glut;
    const bf16_t* kbb = p.proj + (size_t)b * SEQ * 2840 + 1816 + h * 64;
    auto msrc = [&](int pos0, int colo) { return [=](int row, int gcx) { return kbb + (size_t)(pos0 + row) * 2840 + colo + gcx * 8; }; };
    f32x16 o[2];
#pragma unroll
    for (int dt = 0; dt < 2; ++dt)
#pragma unroll
        for (int r = 0; r < 16; ++r) o[dt][r] = 0.f;
    float lsum = 0.f;
    bf16x8 pf[4];
    const int nb = (((t0 + 127) >> 6) & 3) + 1;
    __syncthreads();
    att_stage<8>(kb, msrc(256 * own, 0), rc, wid);
    for (int i = 0; i < nb; ++i) {
        const int pos0 = 256 * own + 64 * i;
        asm volatile("s_waitcnt vmcnt(0)" ::: "memory"); ATT_BAR();
        att_stage<8>(vb, msrc(pos0, 512), rc, wid);
        const bool active = pos0 <= tw + 31;
        if (active) {
            int dq = tw + q - pos0 - 4 * hh; dq = dq < -1 ? -1 : dq;
            att_qk<4, 128, 1, true, false>(kb, L, qf, pf, lsum, c1, 0.f, gtab + (unsigned)(dq + 1) * 4u, 0, nullptr, 0.f);
        }
        asm volatile("s_waitcnt vmcnt(0) lgkmcnt(0)" ::: "memory"); ATT_BAR();
        if (i + 1 < nb) att_stage<8>(kb, msrc(pos0 + 64, 0), rc, wid);
        if (active) att_pv<2, 128>(vb, L, pf, o);
    }
    float lt = lsum + __shfl_xor(lsum, 32);
    const int npick = own < 3 ? own : 3;
    const size_t row = (size_t)bh * SEQ + tw + q;
#pragma unroll 1
    for (int sI = 0; sI < npick; ++sI) {
        lt += p.mpl[(size_t)sI * 131072 + row];
        const bf16_t* pp = moba_part(p, sI, row) + 4 * hh;
#pragma unroll
        for (int dt = 0; dt < 2; ++dt)
#pragma unroll
            for (int rq = 0; rq < 4; ++rq) {
                const u32x2 w = *(const u32x2*)(pp + 32 * dt + 8 * rq);
                o[dt][4 * rq] += __uint_as_float(w[0] << 16); o[dt][4 * rq + 1] += __uint_as_float(w[0] & 0xffff0000u);
                o[dt][4 * rq + 2] += __uint_as_float(w[1] << 16); o[dt][4 * rq + 3] += __uint_as_float(w[1] & 0xffff0000u);
            }
    }
    const float inv = 1.0f / lt;
    bf16_t* op = p.o + rowq * DM + 512 + h * 64 + 4 * hh;
    ATT_STORE_O(op, o, inv);
}
__device__ __forceinline__ void st_moba_own(const P& p, int wg, int nwg, LDSP char* lds) {
    const int tid0 = otid();
    for (int item = wg; item < 1024; item += nwg) moba_own_item(p, item, lds, tid0);
}
#define A0_PRE 62736
__device__ __forceinline__ void st_attn0(const P& p, LDSP char* lds) {
    const int tid0 = otid();
    LDSP int* slot = (LDSP int*)(lds + A0_SLOT); LDSP int* pre = (LDSP int*)(lds + A0_PRE);
    LDSP int* tmp = (LDSP int*)lds;
    for (int i = tid0; i < 496; i += 256) { const int bh = i / 31, j = i - bh * 31; tmp[i] = (p.mcnt[bh * 32 + j] + 127) >> 7; }
    __syncthreads();
    for (int i = tid0; i < 497; i += 256) { int s = 0; for (int k = 0; k < i; ++k) s += tmp[k]; pre[i] = s; }
    __syncthreads();
    const int ninv = pre[496];
    for (;;) {
        const int item = wq_next(p.wq + 1, slot, tid0);
        const int ntail = 5 * 768 + (ninv > 3072 ? ninv - 3072 : 0);
        if (item >= 1024 + ntail) break;
        if (item < 1024) nsa_item(p, item, lds, tid0);
        else {
            const int r = item - 1024, g = r / 5, ps = r - g * 5;
            if (g < 768 && ps == 4) { moe_conv_item(p, 0, g, lds, tid0); continue; }
            const int idx = (g < 768) ? g * 4 + ps : 3072 + (r - 5 * 768);
            if (idx >= ninv) continue;
            int lo = 0, hi = 495;
            while (lo < hi) { const int mid = (lo + hi + 1) >> 1; if (pre[mid] <= idx) lo = mid; else hi = mid - 1; }
            moba_inv_item(p, lo, idx - pre[lo], lds, tid0);
        }
    }
}

#define XB_TMO      128
#define XB_XCNT(j)  (256  + 64 * (j))
#define XB_XSUB(j)  (1280 + 64 * (j))
#define XB_XGEN(j)  (2304 + 64 * (j))
#define XB_TOP      3328
#define XB_TOPGEN   3392
#define XCD_BAR_WORDS 3456
#define XB_SPIN_CAP (1u << 20)
#define LAS __attribute__((address_space(3)))

__device__ __forceinline__ unsigned xb_ld(unsigned* p)              { return __hip_atomic_load(p, __ATOMIC_RELAXED, __HIP_MEMORY_SCOPE_AGENT); }
__device__ __forceinline__ unsigned xb_add(unsigned* p, unsigned v) { return __hip_atomic_fetch_add(p, v, __ATOMIC_RELAXED, __HIP_MEMORY_SCOPE_AGENT); }
__device__ __forceinline__ unsigned xb_xcc_id() { return (unsigned)__builtin_amdgcn_s_getreg((3 << 11) | 20) & 0xFu; }
#define XB_SPIN(cond, bar) do { unsigned _sp = 0; while (cond) { __builtin_amdgcn_s_sleep(1); \
    if ((++_sp & 255u) == 0u) { if (xb_ld(&(bar)[XB_TMO])) break; if (_sp > XB_SPIN_CAP) { atomicAdd(&(bar)[XB_TMO], 1u); break; } } } } while (0)

struct XcdBarrier {
    unsigned* bar; unsigned x;
    volatile LAS unsigned* st;
};

__device__ __forceinline__ XcdBarrier xcd_barrier_post(unsigned* bar, volatile LAS unsigned* st) {
    XcdBarrier b; b.bar = bar; b.x = xb_xcc_id(); b.st = st;
    if (threadIdx.x == 0) (void)xb_add(&bar[XB_XCNT(b.x)], 1u);
    return b;
}
__device__ __forceinline__ void xcd_barrier_complete(unsigned* bar, unsigned x, unsigned& nloc, unsigned& nx) {
    const unsigned G = gridDim.x * gridDim.y * gridDim.z;
    unsigned sum, cnt, mine, sp = 0u;
    for (;;) {
        sum = 0u; cnt = 0u; mine = 0u;
#pragma unroll
        for (unsigned j = 0; j < 16; ++j) { const unsigned c = xb_ld(&bar[XB_XCNT(j)]); sum += c; cnt += (c > 0u) ? 1u : 0u; mine = (j == x) ? c : mine; }
        if (sum == G) break;
        __builtin_amdgcn_s_sleep(1);
        if ((++sp & 255u) == 0u) { if (xb_ld(&bar[XB_TMO])) break; if (sp > XB_SPIN_CAP) { atomicAdd(&bar[XB_TMO], 1u); break; } }
    }
    nloc = mine > 0u ? mine : 1u; nx = cnt > 0u ? cnt : 1u;
}

__device__ __forceinline__ void xcd_barrier(const XcdBarrier& b) {
    asm volatile("s_waitcnt vmcnt(0)" ::: "memory");
    __syncthreads();
    if (threadIdx.x == 0) {
        unsigned* bar = b.bar;
        __builtin_amdgcn_s_waitcnt(0);
        unsigned nloc = b.st[0], nx = b.st[1];
        if (nloc == 0u) { xcd_barrier_complete(bar, b.x, nloc, nx); b.st[0] = nloc; b.st[1] = nx; }
        const unsigned old = xb_add(&bar[XB_XSUB(b.x)], 1u);
        const unsigned gen = old / nloc;
        if (old + 1u == (gen + 1u) * nloc) {
            __builtin_amdgcn_fence(__ATOMIC_RELEASE, "agent");
            asm volatile("s_waitcnt vmcnt(0)" ::: "memory");
            const unsigned og = xb_add(&bar[XB_TOP], 1u);
            const unsigned tg = og / nx;
            if (og + 1u == (tg + 1u) * nx) xb_add(&bar[XB_TOPGEN], 1u);
            else XB_SPIN(xb_ld(&bar[XB_TOPGEN]) == tg, bar);
            __builtin_amdgcn_fence(__ATOMIC_ACQUIRE, "agent");
            xb_add(&bar[XB_XGEN(b.x)], 1u);
            asm volatile("s_waitcnt vmcnt(0)" ::: "memory");
        } else {
            XB_SPIN(xb_ld(&bar[XB_XGEN(b.x)]) == gen, bar);
            __builtin_amdgcn_fence(__ATOMIC_ACQUIRE, "agent");
            asm volatile("s_waitcnt vmcnt(0)" ::: "memory");
        }
    }
    __syncthreads();
}


#define PHASE_SYNC() do { PP qb_ = (PP)__builtin_amdgcn_kernarg_segment_ptr(); asm volatile("" : "+s"(qb_)); XcdBarrier b_; b_.bar = qb_->bar; b_.x = xb_xcc_id(); \
        b_.st = (volatile LAS unsigned*)(dlds + GEMM_LDS_BYTES); xcd_barrier(b_); } while (0)
typedef const __attribute__((address_space(4))) P* PP;
#define PHASE_ARGS() PP q_ = (PP)__builtin_amdgcn_kernarg_segment_ptr(); int wg = blockIdx.x, nwg = gridDim.x; asm volatile("" : "+s"(q_), "+s"(wg), "+s"(nwg)); P p; { const __attribute__((address_space(4))) unsigned long long* s64_ = (const __attribute__((address_space(4))) unsigned long long*)q_; unsigned long long* d64_ = (unsigned long long*)&p; _Pragma("unroll") for (int i_ = 0; i_ < (int)(sizeof(P) / 8); ++i_) d64_[i_] = s64_[i_]; } float* sm = (float*)dlds; LDSP char* lds = (LDSP char*)dlds; (void)sm; (void)lds
#define KERNEL_LDS_BYTES (GEMM_LDS_BYTES + 64)
__global__ void __launch_bounds__(256, 2) k_mega(P pk) {
    extern __shared__ __attribute__((aligned(16))) unsigned char dlds[];
    if (threadIdx.x == 0) *(uint4*)(dlds + GEMM_LDS_BYTES) = make_uint4(0u, 0u, 0u, 0u);
    __syncthreads();
    (void)xcd_barrier_post(pk.bar, (volatile LAS unsigned*)(dlds + GEMM_LDS_BYTES));
    { PHASE_ARGS(); st_prologue(p, wg, nwg, sm); st_convert(p, wg, nwg, sm); } PHASE_SYNC();
    { PHASE_ARGS(); st_norm<0>(p, 0, wg, nwg, sm); st_c1_reduce(p, wg, nwg); } PHASE_SYNC();
    { PHASE_ARGS(); st_inproj0_mf(p, wg, nwg, lds); } PHASE_SYNC();
    { PHASE_ARGS(); st_cmp1_mf(p, wg, nwg, lds); st_kmean(p, wg, nwg, sm); } PHASE_SYNC();
    { PHASE_ARGS(); st_cmp2_mf(p, wg, nwg, lds); st_moba_gate(p, wg, nwg, lds); } PHASE_SYNC();
    { PHASE_ARGS(); st_attn0(p, lds); } PHASE_SYNC();
    { PHASE_ARGS(); st_moba_own(p, wg, nwg, lds); } PHASE_SYNC();
    { PHASE_ARGS(); st_outproj_mf(p, 0, wg, nwg, lds); } PHASE_SYNC();
    { PHASE_ARGS(); st_norm<1>(p, 0, wg, nwg, sm); } PHASE_SYNC();
    { PHASE_ARGS(); st_moe_up_mf(p, 0, wg, nwg, lds); } PHASE_SYNC();
    { PHASE_ARGS(); st_moe_down_mf(p, 0, wg, nwg, lds); } PHASE_SYNC();
    { PHASE_ARGS(); st_norm<2>(p, 1, wg, nwg, sm); } PHASE_SYNC();
    { PHASE_ARGS(); st_inproj1_mf(p, wg, nwg, lds); } PHASE_SYNC();
    { PHASE_ARGS(); st_mla_prep(p, wg, nwg); } PHASE_SYNC();
    { PHASE_ARGS(); st_mla_up_mf(p, wg, nwg, lds); } PHASE_SYNC();
    { PHASE_ARGS(); st_attn1(p, lds); } PHASE_SYNC();
    { PHASE_ARGS(); st_mla_combine(p, wg, nwg); } PHASE_SYNC();
    { PHASE_ARGS(); st_outproj_mf(p, 1, wg, nwg, lds); } PHASE_SYNC();
    { PHASE_ARGS(); st_norm<1>(p, 1, wg, nwg, sm); } PHASE_SYNC();
    { PHASE_ARGS(); st_moe_up_mf(p, 1, wg, nwg, lds); } PHASE_SYNC();
    { PHASE_ARGS(); st_moe_down_mf(p, 1, wg, nwg, lds); } PHASE_SYNC();
    { PHASE_ARGS(); st_norm<3>(p, 1, wg, nwg, sm); }
}

extern "C" void kernel_launch(void* const* d_in, const int* in_sizes, int n_in, void* d_out, int out_size, void* d_ws, size_t ws_size,
                              hipStream_t stream) {
    (void)in_sizes; (void)n_in; (void)out_size; (void)ws_size;
    P p{};
    const float* const* in = (const float* const*)d_in;
    p.x = in[0]; p.c = in[1]; p.rel = in[2]; p.router_w = in[3]; p.router_b = in[4]; p.final_norm = in[5]; p.norm_mix = in[6]; p.norm_ffn = in[7];
    p.ada_w = in[8]; p.ada_b = in[9]; p.moe_wg = in[10]; p.moe_wu = in[11]; p.moe_wd = in[12]; p.ev_w_in = in[13]; p.ev_w_out = in[14];
    p.pos_k = in[15]; p.pos_v = in[16]; p.ck_w1 = in[17]; p.ck_w2 = in[18]; p.cv_w1 = in[19]; p.cv_w2 = in[20]; p.od_w_in = in[21]; p.od_w_out = in[22];
    p.q_norm = in[23]; p.kv_norm = in[24]; p.w_q_up = in[25]; p.w_kv_up = in[26]; p.sinks = in[27];
    p.out = (float*)d_out;
    char* ws = (char*)d_ws; size_t off = 0;
    auto take = [&](size_t bytes) { char* r = ws + off; off += (bytes + 255) & ~(size_t)255; return r; };
    p.bar = (unsigned*)take(16384);
    p.cnt = (int*)take(4096);
    p.wq = (int*)take(256);
    p.mcnt = (int*)take(512 * 4);
    p.modv = (float*)take(2 * 2 * 6144 * 4);
    p.zrow = (bf16_t*)take(256);
    const size_t zero_bytes = off;
    p.ropec = (float*)take(SEQ * 32 * 4); p.ropes = (float*)take(SEQ * 32 * 4);
    p.blut = (float*)take(8 * 1024 * 4);
    p.gates = (float*)take((size_t)T_TOK * 24 * 4);
    p.kmean = (float*)take(2 * 8 * 32 * 64 * 4);
    p.tokw = (float*)take((size_t)T_TOK * 2 * 4);
    p.list = (int*)take((size_t)16 * T_TOK * 4);
    p.cqn = (bf16_t*)take((size_t)T_TOK * 384 * 2);
    p.krope = (bf16_t*)take((size_t)T_TOK * 64 * 2);
    p.h = (bf16_t*)take((size_t)T_TOK * DM * 2);
    p.o = (bf16_t*)take((size_t)T_TOK * DM * 2);
    p.mlap = p.h;
    p.mlal = (float*)(p.h + (size_t)2 * 8 * (SEQ / 2) * 128);
    p.mp01 = p.h;
    p.mp2 = (bf16_t*)take((size_t)131072 * 64 * 2);
    p.mpl = (float*)take((size_t)3 * 131072 * 4);
    p.mlist = (unsigned short*)take((size_t)16 * 32 * 8192 * 2);
    p.hid = p.o;
    char* region = take((size_t)100 * 1024 * 1024);
    p.proj = (bf16_t*)region;
    p.proj1 = (bf16_t*)region;
    p.qmla = (bf16_t*)(region + (size_t)T_TOK * 1216 * 2);
    p.kvmla = (bf16_t*)(region + (size_t)T_TOK * (1216 + 768) * 2);
    p.y = (bf16_t*)region;
    p.chidb = (bf16_t*)take((size_t)2 * 2048 * 256 * 2);
    p.kcmpb = (bf16_t*)take((size_t)8 * 512 * 64 * 2);
    p.kmeanb = (bf16_t*)take((size_t)2 * 8 * 32 * 64 * 2);
    p.c1 = (float*)take(512 * 4);
    p.c1p = (float*)take((size_t)2 * 64 * 256 * 4);
    p.wt_gu = (bf16_t*)take((size_t)32 * 1024 * 1024 * 2);
    p.wt_d = (bf16_t*)take((size_t)32 * 1024 * 512 * 2);
    p.wt_in0 = (bf16_t*)take((size_t)2840 * 1024 * 2);
    p.wt_out0 = (bf16_t*)take((size_t)1024 * 1024 * 2);
    p.wt_c1 = (bf16_t*)take((size_t)2 * 256 * 2048 * 2);
    p.wt_c2 = (bf16_t*)take((size_t)2 * 64 * 256 * 2);
    p.wt_in1 = (bf16_t*)take((size_t)1216 * 1024 * 2);
    p.wt_out1 = (bf16_t*)take((size_t)1024 * 1024 * 2);
    p.wt_qup = (bf16_t*)take((size_t)768 * 256 * 2);
    p.wt_kvup = (bf16_t*)take((size_t)1024 * 128 * 2);
    static int grid = 0;
    if (!grid) {
        int dev = 0, cus = 0, per_cu = 0;
        (void)hipGetDevice(&dev);
        (void)hipDeviceGetAttribute(&cus, hipDeviceAttributeMultiprocessorCount, dev);
        (void)hipFuncSetAttribute((const void*)k_mega, hipFuncAttributeMaxDynamicSharedMemorySize, KERNEL_LDS_BYTES);
        (void)hipOccupancyMaxActiveBlocksPerMultiprocessor(&per_cu, k_mega, 256, KERNEL_LDS_BYTES);
        if (cus <= 0) cus = 256;
        if (per_cu < 1) per_cu = 1;
        grid = cus * (per_cu < 2 ? per_cu : 2);
    }
    (void)hipMemsetAsync(d_ws, 0, zero_bytes, stream);
    hipLaunchKernelGGL(k_mega, dim3(grid), dim3(256), KERNEL_LDS_BYTES, stream, p);
}
```

```cpp
#include <hip/hip_runtime.h>
#include <stdint.h>

#define T_TOK 16384
#define SEQ 8192
#define DM 1024
#define NEGF (-1e30f)
#define BIGF (1e30f)

typedef unsigned short bf16_t;

__device__ __forceinline__ float bf2f(bf16_t v) { return __uint_as_float(((unsigned)v) << 16); }
__device__ __forceinline__ bf16_t f2bf(float f) {
    unsigned u = __float_as_uint(f);
    u += 0x7fffu + ((u >> 16) & 1u);
    return (bf16_t)(u >> 16);
}
typedef __bf16 bf16x2_t __attribute__((ext_vector_type(2)));
typedef float f32x2_t __attribute__((ext_vector_type(2)));
__device__ __forceinline__ unsigned cvtpk(float lo, float hi) { const f32x2_t f = {lo, hi}; return __builtin_bit_cast(unsigned, __builtin_convertvector(f, bf16x2_t)); }
__device__ __forceinline__ unsigned cvtpk_valu(float lo, float hi) { unsigned r; asm("s_nop 0\n\tv_cvt_pk_bf16_f32 %0, %1, %2" : "=v"(r) : "v"(lo), "v"(hi)); return r; }
__device__ __forceinline__ float wsum(float v) {
#pragma unroll
    for (int o = 32; o > 0; o >>= 1) v += __shfl_xor(v, o);
    return v;
}
__device__ __forceinline__ float siluf(float v) { return v / (1.0f + __expf(-v)); }
__device__ __forceinline__ float sigmf(float v) { return 1.0f / (1.0f + __expf(-v)); }
__device__ __forceinline__ float gelu_tanh(float x) {
    const float k0 = 0.7978845608028654f, k1 = 0.044715f;
    float u = k0 * (x + k1 * x * x * x);
    return 0.5f * x * (1.0f + tanhf(u));
}
__device__ __forceinline__ int rel_bucket(int d) {
    if (d < 16) return d < 0 ? 0 : d;
    int b = 16;
    b += (d >= 21); b += (d >= 27); b += (d >= 35); b += (d >= 46); b += (d >= 59); b += (d >= 77); b += (d >= 99); b += (d >= 128);
    b += (d >= 166); b += (d >= 216); b += (d >= 280); b += (d >= 363); b += (d >= 470); b += (d >= 609); b += (d >= 790);
    return b;
}

__device__ __forceinline__ int otid() { int t = threadIdx.x; asm volatile("" : "+v"(t)); return t; }

struct P {
    const float *x, *c, *rel, *router_w, *router_b, *final_norm, *norm_mix, *norm_ffn, *ada_w, *ada_b, *moe_wg, *moe_wu, *moe_wd,
        *ev_w_in, *ev_w_out, *pos_k, *pos_v, *ck_w1, *ck_w2, *cv_w1, *cv_w2, *od_w_in, *od_w_out, *q_norm, *kv_norm, *w_q_up, *w_kv_up, *sinks;
    float* out;
    unsigned* bar; int* cnt;
    float *modv, *ropec, *ropes, *blut, *gates, *kcmp, *vcmp, *chid, *kmean, *tokw;
    bf16_t *h, *proj, *o, *hid, *y, *proj1, *qmla, *kvmla, *krope, *cqn;
    int* list;
    bf16_t *wt_gu, *wt_d, *wt_in0, *wt_out0, *wt_c1, *wt_c2, *wt_in1, *wt_out1, *wt_qup, *wt_kvup, *chidb;
    float *c1, *c1p;
    int* wq;
    bf16_t* zrow;
    bf16_t *kcmpb, *kmeanb, *mlap;
    float* mlal;
    int* mcnt; unsigned short* mlist; bf16_t *mp01, *mp2; float* mpl;
};


__device__ __forceinline__ void st_prologue(const P& p, int wg, int nwg, float* sm) {
    const int TIDX = otid();
    const int tid = TIDX;
    {
        for (int i = tid; i < 2048; i += 256) sm[i] = siluf(p.c[i]);
        __syncthreads();
        const int wid = tid >> 6, lane = tid & 63;
        for (int w = wg; w < 192; w += nwg) {
            const int l = w / 96, cg = w % 96, col = cg * 64 + lane;
            const float* W = p.ada_w + (size_t)l * 1024 * 6144 + (size_t)(wid * 256) * 6144 + col;
            float a0 = 0.f, a1 = 0.f;
#pragma unroll 32
            for (int k = 0; k < 256; ++k) { const float wv = W[(size_t)k * 6144]; a0 += sm[wid * 256 + k] * wv; a1 += sm[1024 + wid * 256 + k] * wv; }
            sm[2048 + tid] = a0; sm[2304 + tid] = a1;
            __syncthreads();
            if (tid < 64) {
                const float bb = p.ada_b[l * 6144 + col];
                p.modv[(l * 2 + 0) * 6144 + col] = ((sm[2048 + tid] + sm[2048 + 64 + tid]) + (sm[2048 + 128 + tid] + sm[2048 + 192 + tid])) + bb;
                p.modv[(l * 2 + 1) * 6144 + col] = ((sm[2304 + tid] + sm[2304 + 64 + tid]) + (sm[2304 + 128 + tid] + sm[2304 + 192 + tid])) + bb;
            }
            __syncthreads();
        }
        __syncthreads();
    }
    for (int i = wg * 256 + tid; i < SEQ * 32; i += nwg * 256) {
        const int t = i >> 5, j = i & 31;
        const float inv = powf(10000.0f, -(float)(2 * j) / 64.0f);
        const float ang = (float)t * inv;
        p.ropec[i] = cosf(ang); p.ropes[i] = sinf(ang);
    }
    for (int i = wg * 256 + tid; i < 8 * 1024; i += nwg * 256) { const int h = i >> 10, d = i & 1023; p.blut[i] = p.rel[rel_bucket(d) * 8 + h]; }
}

template <int MODE>
__device__ __forceinline__ void st_norm(const P& p, int layer, int wg, int nwg, float* sm) {
    const int TIDX = otid();
    const int wid = TIDX >> 6, lane = TIDX & 63;
    int* rl_cnt = (int*)sm; int* rl_base = rl_cnt + 16; int* rl_ent = rl_cnt + 32;
    if (MODE == 1) { if (TIDX < 16) rl_cnt[TIDX] = 0; for (int i = TIDX; i < 64; i += 256) rl_ent[i] = -1; __syncthreads(); }
    const int niter = (T_TOK + nwg * 4 - 1) / (nwg * 4);
    const float* xin = (MODE == 0) ? p.x : p.out;
    float4 pre4[4];
    {
        const int row0 = wg * 4 + wid;
#pragma unroll
        for (int i = 0; i < 4; ++i) pre4[i] = (row0 < T_TOK) ? *(const float4*)(xin + (size_t)row0 * DM + i * 256 + lane * 4) : make_float4(0.f, 0.f, 0.f, 0.f);
    }
    for (int it = 0; it < niter; ++it) {
        const int row = wg * 4 + wid + it * nwg * 4;
        if (MODE != 1 && row >= T_TOK) break;
        float v[16];
#pragma unroll
        for (int i = 0; i < 4; ++i) { v[i * 4 + 0] = pre4[i].x; v[i * 4 + 1] = pre4[i].y; v[i * 4 + 2] = pre4[i].z; v[i * 4 + 3] = pre4[i].w; }
        {
            const int rown = row + nwg * 4;
            if (rown < T_TOK) {
#pragma unroll
                for (int i = 0; i < 4; ++i) pre4[i] = *(const float4*)(xin + (size_t)rown * DM + i * 256 + lane * 4);
            }
        }
        if (MODE != 1 || row < T_TOK) {
        const int b = row >> 13;
        if (MODE >= 2) {
            const int lp = (MODE == 2) ? layer - 1 : 1;
            const float* gf = p.modv + (size_t)(lp * 2 + b) * 6144 + 5 * 1024;
#pragma unroll
            for (int i = 0; i < 4; ++i)
#pragma unroll
                for (int j = 0; j < 4; ++j) {
                    const int col = i * 256 + lane * 4 + j;
                    const float y0 = bf2f(p.y[(size_t)(2 * row) * DM + col]), y1 = bf2f(p.y[(size_t)(2 * row + 1) * DM + col]);
                    v[i * 4 + j] += gf[col] * (y0 + y1);
                }
            if (MODE == 2) {
#pragma unroll
                for (int i = 0; i < 4; ++i)
                    *(float4*)(p.out + (size_t)row * DM + i * 256 + lane * 4) = make_float4(v[i * 4], v[i * 4 + 1], v[i * 4 + 2], v[i * 4 + 3]);
            }
        }
        float ss = 0.f;
#pragma unroll
        for (int i = 0; i < 16; ++i) ss += v[i] * v[i];
        ss = wsum(ss);
        const float r = rsqrtf(ss * (1.0f / 1024.0f) + 1e-6f);
        if (MODE == 3) {
#pragma unroll
            for (int i = 0; i < 4; ++i) {
                const float4 g4 = *(const float4*)(p.final_norm + i * 256 + lane * 4);
                *(float4*)(p.out + (size_t)row * DM + i * 256 + lane * 4) =
                    make_float4(v[i * 4] * r * g4.x, v[i * 4 + 1] * r * g4.y, v[i * 4 + 2] * r * g4.z, v[i * 4 + 3] * r * g4.w);
            }
            continue;
        }
        const float* g = ((MODE == 1) ? p.norm_ffn : p.norm_mix) + layer * 1024;
        const float* mv = p.modv + (size_t)(layer * 2 + b) * 6144;
        const float* shift = mv + ((MODE == 1) ? 3 : 0) * 1024;
        const float* scale = mv + ((MODE == 1) ? 4 : 1) * 1024;
        float hv[16];
#pragma unroll
        for (int i = 0; i < 4; ++i)
#pragma unroll
            for (int j = 0; j < 4; ++j) {
                const int col = i * 256 + lane * 4 + j;
                hv[i * 4 + j] = v[i * 4 + j] * r * g[col] * (1.0f + scale[col]) + shift[col];
                p.h[(size_t)row * DM + col] = f2bf(hv[i * 4 + j]);
            }
        if (MODE == 1) {
            float lg[16];
#pragma unroll
            for (int e = 0; e < 16; ++e) lg[e] = 0.f;
#pragma unroll
            for (int i = 0; i < 4; ++i)
#pragma unroll
                for (int j = 0; j < 4; ++j) {
                    const int col = i * 256 + lane * 4 + j;
                    const float* rw = p.router_w + col * 16;
#pragma unroll
                    for (int e = 0; e < 16; ++e) lg[e] += hv[i * 4 + j] * rw[e];
                    asm volatile("" ::: "memory");
                }
#pragma unroll
            for (int e = 0; e < 16; ++e) lg[e] = wsum(lg[e]);
            float aff[16], bi[16];
#pragma unroll
            for (int e = 0; e < 16; ++e) { aff[e] = 1.0f / (1.0f + expf(-lg[e])); bi[e] = aff[e] + p.router_b[e]; }
            float bestsc = -3e38f; int be0 = 0, be1 = 1; float bw0 = 0.f, bw1 = 0.f;
#pragma unroll
            for (int gI = 0; gI < 4; ++gI) {
                int i1 = 0; float m1 = bi[gI * 4];
#pragma unroll
                for (int i = 1; i < 4; ++i) if (bi[gI * 4 + i] > m1) { m1 = bi[gI * 4 + i]; i1 = i; }
                int i2 = -1; float m2 = -3e38f;
#pragma unroll
                for (int i = 0; i < 4; ++i) if (i != i1 && bi[gI * 4 + i] > m2) { m2 = bi[gI * 4 + i]; i2 = i; }
                const float sc = m1 + m2;
                float a1 = 0.f, a2 = 0.f;
#pragma unroll
                for (int i = 0; i < 4; ++i) { a1 = (i == i1) ? aff[gI * 4 + i] : a1; a2 = (i == i2) ? aff[gI * 4 + i] : a2; }
                if (sc > bestsc) { bestsc = sc; be0 = gI * 4 + i1; be1 = gI * 4 + i2; bw0 = a1; bw1 = a2; }
            }
            if (lane == 0) {
                const float ws = bw0 + bw1;
                p.tokw[row * 2] = bw0 / ws; p.tokw[row * 2 + 1] = bw1 / ws;
                const int s_ = (it & 7) * 4 + wid;
                const int r0 = atomicAdd(&rl_cnt[be0], 1), r1 = atomicAdd(&rl_cnt[be1], 1);
                rl_ent[s_ * 2] = (row << 12) | (be0 << 8) | r0;
                rl_ent[s_ * 2 + 1] = (row << 12) | (be1 << 8) | r1;
            }
        }
        }
        if (MODE == 1 && ((it & 7) == 7 || it == niter - 1)) {
            __syncthreads();
            if (TIDX < 16) { const int c = rl_cnt[TIDX]; rl_base[TIDX] = c ? atomicAdd(&p.cnt[(layer * 16 + TIDX) * 32], c) : 0; rl_cnt[TIDX] = 0; }
            __syncthreads();
            if (TIDX < 64) {
                const int en = rl_ent[TIDX];
                if (en >= 0) { const int e = (en >> 8) & 15; p.list[e * T_TOK + rl_base[e] + (en & 255)] = (en >> 12) * 2 + (TIDX & 1); rl_ent[TIDX] = -1; }
            }
            __syncthreads();
        }
    }
}

__device__ __forceinline__ void st_kmean(const P& p, int wg, int nwg, float* sm) {
    const int TIDX = otid();
    const int wid = TIDX >> 6, lane = TIDX & 63;
    for (int w = wg; w < 2 * 8 * 32; w += nwg) {
        const int b = w >> 8, h = (w >> 5) & 7, j = w & 31;
        const bf16_t* kp = p.proj + (size_t)(b * SEQ + j * 256 + wid * 64) * 2840 + 1816 + h * 64 + lane;
        float s = 0.f;
#pragma unroll 16
        for (int i = 0; i < 64; ++i) s += bf2f(kp[(size_t)i * 2840]);
        __syncthreads();
        sm[TIDX] = s;
        __syncthreads();
        if (TIDX < 64) {
            const float m = ((sm[TIDX] + sm[64 + TIDX]) + (sm[128 + TIDX] + sm[192 + TIDX])) * (1.0f / 256.0f);
            p.kmean[(size_t)w * 64 + TIDX] = m;
            p.kmeanb[(size_t)w * 64 + TIDX] = f2bf(m);
        }
    }
}
__device__ __forceinline__ void st_mla_prep(const P& p, int wg, int nwg) {
    const int TIDX = otid();
    const int wid = TIDX >> 6, lane = TIDX & 63;
    for (int row = wg * 4 + wid; row < T_TOK; row += nwg * 4) {
        const int t = row & (SEQ - 1);
        const bf16_t* pr = p.proj1 + (size_t)row * 1216;
        float q[4], ss = 0.f;
#pragma unroll
        for (int i = 0; i < 4; ++i) { q[i] = bf2f(pr[i * 64 + lane]); ss += q[i] * q[i]; }
        ss = wsum(ss);
        float r = rsqrtf(ss * (1.0f / 256.0f) + 1e-6f);
#pragma unroll
        for (int i = 0; i < 4; ++i) p.cqn[(size_t)row * 384 + i * 64 + lane] = f2bf(q[i] * r * p.q_norm[i * 64 + lane]);
        float kvv[2]; ss = 0.f;
#pragma unroll
        for (int i = 0; i < 2; ++i) { kvv[i] = bf2f(pr[256 + i * 64 + lane]); ss += kvv[i] * kvv[i]; }
        ss = wsum(ss);
        r = rsqrtf(ss * (1.0f / 128.0f) + 1e-6f);
#pragma unroll
        for (int i = 0; i < 2; ++i) p.cqn[(size_t)row * 384 + 256 + i * 64 + lane] = f2bf(kvv[i] * r * p.kv_norm[i * 64 + lane]);
        if (lane < 32) {
            const float x1 = bf2f(pr[384 + lane]), x2 = bf2f(pr[384 + 32 + lane]);
            const float cs = p.ropec[t * 32 + lane], sn = p.ropes[t * 32 + lane];
            p.krope[(size_t)row * 64 + lane] = f2bf(x1 * cs - x2 * sn);
            p.krope[(size_t)row * 64 + 32 + lane] = f2bf(x1 * sn + x2 * cs);
        }
    }
}


typedef short bf16x8 __attribute__((ext_vector_type(8)));
typedef float f32x4 __attribute__((ext_vector_type(4)));
typedef unsigned u32x2 __attribute__((ext_vector_type(2)));
typedef unsigned u32x4v __attribute__((ext_vector_type(4)));
#define LDSP __attribute__((address_space(3)))
#define GEMM_LDS_BYTES 73728
#define KERNEL_LDS_BYTES 81920
#define BAR_LDS_OFF (KERNEL_LDS_BYTES - 16)

__device__ __forceinline__ unsigned pack_bf16(float lo, float hi) { return cvtpk(lo, hi); }

template <int MF, class AR, class BR, class Epi, class NX>
__device__ __forceinline__ void gemm128x(const int nk, const size_t akstep, const size_t bkstep, AR arow, BR brow, Epi epi, LDSP char* lds, const int tid, const bool staged, NX next) {
    constexpr int SS = MF * 4096 + 16384, BO = MF * 4096;
    const int wid = tid >> 6, lane = tid & 63, wr = wid >> 1, wc = wid & 1, fr = lane & 15, fq = lane >> 4;
    const int srow = tid >> 3, gch = ((tid & 7) ^ (srow & 7)) * 8;
    const bf16_t* ap[MF]; const bf16_t* bp[4];
#pragma unroll
    for (int i = 0; i < MF; ++i) ap[i] = arow(32 * i + srow) + gch;
#pragma unroll
    for (int i = 0; i < 4; ++i) bp[i] = brow(32 * i + srow) + gch;
    LDSP char* lw = lds + wid * 1024;
#define G128_ISSUE(st, kt) do { LDSP char* la_ = lw + (st) * SS; const size_t ao_ = (size_t)(kt) * akstep, bo_ = (size_t)(kt) * bkstep; \
        _Pragma("unroll") for (int i_ = 0; i_ < MF; ++i_) __builtin_amdgcn_global_load_lds((const unsigned*)(ap[i_] + ao_), (LDSP unsigned*)(la_ + 4096 * i_), 16, 0, 0); \
        _Pragma("unroll") for (int i_ = 0; i_ < 4; ++i_) __builtin_amdgcn_global_load_lds((const unsigned*)(bp[i_] + bo_), (LDSP unsigned*)(la_ + BO + 4096 * i_), 16, 0, 0); } while (0)
    f32x4 acc[MF][4];
#pragma unroll
    for (int m = 0; m < MF; ++m)
#pragma unroll
        for (int n = 0; n < 4; ++n) acc[m][n] = (f32x4){0.f, 0.f, 0.f, 0.f};
    const int aoff = (wr * 16 * MF + fr) * 128, boff = BO + (wc * 64 + fr) * 128, c0 = (fq ^ (fr & 7)) * 16;
    if (!staged) G128_ISSUE(0, 0);
    for (int kt = 0; kt < nk; ++kt) {
        const int cur = kt & 1;
        asm volatile("s_waitcnt vmcnt(0)" ::: "memory");
        __builtin_amdgcn_s_barrier();
        asm volatile("" ::: "memory");
        if (kt + 1 < nk) G128_ISSUE(cur ^ 1, kt + 1);
        LDSP char* sb = lds + cur * SS;
#pragma unroll
        for (int kk = 0; kk < 2; ++kk) {
            const int cc = kk ? (c0 ^ 64) : c0;
            bf16x8 af[MF], bf[4];
#pragma unroll
            for (int m = 0; m < MF; ++m) af[m] = *(const LDSP bf16x8*)(sb + aoff + m * 2048 + cc);
#pragma unroll
            for (int n = 0; n < 4; ++n) bf[n] = *(const LDSP bf16x8*)(sb + boff + n * 2048 + cc);
#pragma unroll
            for (int m = 0; m < MF; ++m)
#pragma unroll
                for (int n = 0; n < 4; ++n) acc[m][n] = __builtin_amdgcn_mfma_f32_16x16x32_bf16(bf[n], af[m], acc[m][n], 0, 0, 0);
        }
    }
    asm volatile("s_waitcnt lgkmcnt(0)" ::: "memory");
    __builtin_amdgcn_s_barrier();
    asm volatile("" ::: "memory");
    next();
#undef G128_ISSUE
#pragma unroll
    for (int m = 0; m < MF; ++m) epi(wr * 16 * MF + m * 16 + fr, wc * 64 + fq * 4, acc[m], m);
}

template <int MF, class AR, class BR>
__device__ __forceinline__ void g128_stage0(AR arow, BR brow, LDSP char* lds, const int tid) {
    const int wid = tid >> 6, srow = tid >> 3, gch = ((tid & 7) ^ (srow & 7)) * 8;
    LDSP char* lw = lds + wid * 1024;
#pragma unroll
    for (int i = 0; i < MF; ++i) {
        __builtin_amdgcn_global_load_lds((const unsigned*)(arow(32 * i + srow) + gch), (LDSP unsigned*)(lw + 4096 * i), 16, 0, 0);
    }
#pragma unroll
    for (int i = 0; i < 4; ++i) {
        __builtin_amdgcn_global_load_lds((const unsigned*)(brow(32 * i + srow) + gch), (LDSP unsigned*)(lw + MF * 4096 + 4096 * i), 16, 0, 0);
    }
}
template <class AR, class BR, class Epi>
__device__ __forceinline__ void gemm128(const int nk, const size_t akstep, const size_t bkstep, AR arow, BR brow, Epi epi, LDSP char* lds, const int tid) {
    gemm128x<4>(nk, akstep, bkstep, arow, brow, epi, lds, tid, false, [] {});
}

template <int MAP> __device__ __forceinline__ int conv_rowmap(int n) {
    if (MAP == 0) return n;
    const int tile = n >> 6, cc = n & 63, wc = cc >> 5, i16 = (cc >> 4) & 1, i = cc & 15;
    return tile * 128 + wc * 64 + ((MAP == 1 ? 0 : 2) + i16) * 16 + i;
}
template <int MAP>
__device__ __forceinline__ void conv_batched(const float* src, int nmat, int K, int N, size_t sstride, bf16_t* dst, size_t dstride, int wg, int nwg, float* sm, int tid, int wend = 0x7fffffff) {
    float(*t)[65] = (float(*)[65])sm;
    const int tk = K >> 6, tn = (N + 63) >> 6, per = tk * tn, total = (nmat * per < wend) ? nmat * per : wend;
    f32x4 v[4];
    auto ld = [&](int w) {
        const int mat = w / per, r = w % per, kt = r / tn, nt = r % tn;
        const float* s = src + (size_t)mat * sstride;
#pragma unroll
        for (int i = 0; i < 4; ++i) {
            const int idx = tid + 256 * i, k = idx >> 4, n = (idx & 15) * 4;
            v[i] = (f32x4){0.f, 0.f, 0.f, 0.f};
            if (nt * 64 + n < N) v[i] = *(const f32x4*)(s + (size_t)(kt * 64 + k) * N + nt * 64 + n);
        }
    };
    if (wg < total) ld(wg);
    for (int w = wg; w < total; w += nwg) {
        const int mat = w / per, r = w % per, kt = r / tn, nt = r % tn;
        bf16_t* d = dst + (size_t)mat * dstride;
#pragma unroll
        for (int i = 0; i < 4; ++i) {
            const int idx = tid + 256 * i, k = idx >> 4, n = (idx & 15) * 4;
            t[k][n] = v[i][0]; t[k][n + 1] = v[i][1]; t[k][n + 2] = v[i][2]; t[k][n + 3] = v[i][3];
        }
        __syncthreads();
        if (w + nwg < total) ld(w + nwg);
        {
            const int n = tid >> 2, kq = (tid & 3) * 16;
            if (nt * 64 + n < N) {
                unsigned pk[8];
#pragma unroll
                for (int j = 0; j < 8; ++j) pk[j] = cvtpk(t[kq + 2 * j][n], t[kq + 2 * j + 1][n]);
                bf16_t* o = d + (size_t)conv_rowmap<MAP>(nt * 64 + n) * K + kt * 64 + kq;
                *(u32x4v*)o = (u32x4v){pk[0], pk[1], pk[2], pk[3]};
                *(u32x4v*)(o + 8) = (u32x4v){pk[4], pk[5], pk[6], pk[7]};
            }
        }
        __syncthreads();
    }
}
__device__ __forceinline__ void st_convert(const P& p, int wg, int nwg, float* sm) {
    const int tid = otid();
    conv_batched<0>(p.ev_w_in, 1, 1024, 2840, 0, p.wt_in0, 0, wg, nwg, sm, tid);
    conv_batched<0>(p.ev_w_out, 1, 1024, 1024, 0, p.wt_out0, 0, wg, nwg, sm, tid);
    conv_batched<0>(p.ck_w1, 1, 2048, 256, 0, p.wt_c1, 0, wg, nwg, sm, tid);
    conv_batched<0>(p.cv_w1, 1, 2048, 256, 0, p.wt_c1 + 256 * 2048, 0, wg, nwg, sm, tid);
    conv_batched<0>(p.ck_w2, 1, 256, 64, 0, p.wt_c2, 0, wg, nwg, sm, tid);
    conv_batched<0>(p.cv_w2, 1, 256, 64, 0, p.wt_c2 + 64 * 256, 0, wg, nwg, sm, tid);
    conv_batched<0>(p.od_w_in, 1, 1024, 1216, 0, p.wt_in1, 0, wg, nwg, sm, tid);
    conv_batched<0>(p.od_w_out, 1, 1024, 1024, 0, p.wt_out1, 0, wg, nwg, sm, tid);
    conv_batched<0>(p.w_q_up, 1, 256, 768, 0, p.wt_qup, 0, wg, nwg, sm, tid);
    conv_batched<0>(p.w_kv_up, 1, 128, 1024, 0, p.wt_kvup, 0, wg, nwg, sm, tid);
    {
        const int wid = tid >> 6, lane = tid & 63;
        for (int w = wg * 4 + wid; w < 512; w += nwg * 4) {
            const int which = w >> 8, cg = (w >> 6) & 3, ks = w & 63, col = cg * 64 + lane;
            const float* w1 = (which ? p.cv_w1 : p.ck_w1) + (size_t)(ks * 32) * 256 + col; const float* pos = (which ? p.pos_v : p.pos_k) + ks * 32;
            float a = 0.f;
#pragma unroll
            for (int k = 0; k < 32; ++k) a += pos[k] * w1[(size_t)k * 256];
            p.c1p[(which * 64 + ks) * 256 + col] = a;
        }
    }
}
__device__ __forceinline__ void st_c1_reduce(const P& p, int wg, int nwg) {
    const int tid = otid();
    for (int i = wg * 256 + tid; i < 512; i += nwg * 256) {
        const int which = i >> 8, col = i & 255;
        float a = 0.f;
#pragma unroll 16
        for (int ks = 0; ks < 64; ++ks) a += p.c1p[(which * 64 + ks) * 256 + col];
        p.c1[i] = a;
    }
}


struct XcdOrder {
    int xcd, lw, nlw, tn, per;
    __device__ __forceinline__ XcdOrder(int wg, int nwg, int nM, int tn_) : xcd(wg & 7), lw(wg >> 3), nlw(nwg >> 3), tn(tn_), per((nM >> 3) * tn_) {}
    __device__ __forceinline__ bool get(int k, int& mt, int& nt) const { const int lt = lw + k * nlw; if (lt >= per) return false; mt = xcd + 8 * (lt / tn); nt = lt % tn; return true; }
};
template <int MF>
__device__ __forceinline__ void st_inproj0_mf(const P& p, int wg, int nwg, LDSP char* lds) {
    const int tid = otid();
    const XcdOrder ord(wg, nwg, (MF == 4) ? 128 : 104, 23);
    auto Af = [&](int mt_) { return [=](int r) { int row = mt_ * (32 * MF) + r; row = row < T_TOK ? row : T_TOK - 1; return p.h + (size_t)row * DM; }; };
    auto Bf = [&](int nt_) { return [=](int r) { int n = nt_ * 128 + r; n = n < 2840 ? n : 2839; return p.wt_in0 + (size_t)n * 1024; }; };
    bool staged = false;
    for (int k = 0;; ++k) {
        int mt, nt, mt2 = 0, nt2 = 0;
        if (!ord.get(k, mt, nt)) break;
        if (mt * (32 * MF) >= T_TOK) break;
        const bool has2 = ord.get(k + 1, mt2, nt2) && mt2 * (32 * MF) < T_TOK;
        const bool st_ = staged; staged = has2;
        gemm128x<MF>(16, 64, 64, Af(mt), Bf(nt),
            [&](int rl, int cl, const f32x4 (&a)[4], int mfrag) {
                const int row = mt * (32 * MF) + rl;
#pragma unroll
                for (int n = 0; n < 4; ++n) {
                    const int col = nt * 128 + cl + n * 16;
                    if (col < 2840 && row < T_TOK) {
                        *(u32x2*)(p.proj + (size_t)row * 2840 + col) = (u32x2){pack_bf16(a[n][0], a[n][1]), pack_bf16(a[n][2], a[n][3])};
                        if (col >= 1280 && col < 1304)
                            *(f32x4*)(p.gates + (size_t)row * 24 + (col - 1280)) = (f32x4){sigmf(a[n][0]), sigmf(a[n][1]), sigmf(a[n][2]), sigmf(a[n][3])};
                    }
                }
            }, lds, tid, st_, [&] { if (has2) g128_stage0<MF>(Af(mt2), Bf(nt2), lds, tid); });
    }
}
__device__ __forceinline__ void st_cmp1_mf(const P& p, int wg, int nwg, LDSP char* lds) {
    const int tid = otid();
    for (int w = wg; w < 2 * 16 * 2; w += nwg) {
        const int which = w >> 5, mt = (w >> 1) & 15, nt = w & 1;
        const int colbase = which ? 640 : 512;
        gemm128(32, 2840, 64,
            [&](int r) { int m = mt * 128 + r; m = m < 2044 ? m : 2043; const int bk = m / 511, n = m % 511, b = bk >> 1, kv = bk & 1;
                         return p.proj + (size_t)(b * SEQ + 16 * n) * 2840 + colbase + kv * 64; },
            [&](int r) { return p.wt_c1 + (size_t)(which * 256 + nt * 128 + r) * 2048; },
            [&](int rl, int cl, const f32x4 (&a)[4], int mfrag) {
                const int m = mt * 128 + rl;
                if (m < 2044) {
#pragma unroll
                    for (int n = 0; n < 4; ++n) {
                        const int col = nt * 128 + cl + n * 16;
                        const f32x4 cb = *(const f32x4*)(p.c1 + which * 256 + col);
                        *(u32x2*)(p.chidb + (size_t)(which * 2048 + m) * 256 + col) =
                            (u32x2){pack_bf16(gelu_tanh(a[n][0] + cb[0]), gelu_tanh(a[n][1] + cb[1])), pack_bf16(gelu_tanh(a[n][2] + cb[2]), gelu_tanh(a[n][3] + cb[3]))};
                    }
                }
            }, lds, tid);
    }
}
__device__ __forceinline__ void st_cmp2_mf(const P& p, int wg, int nwg, LDSP char* lds) {
    const int tid = otid();
    for (int w = wg; w < 2 * 16; w += nwg) {
        const int which = w >> 4, mt = w & 15;
        gemm128(4, 64, 64,
            [&](int r) { int m = mt * 128 + r; m = m < 2044 ? m : 2043; return p.chidb + (size_t)(which * 2048 + m) * 256; },
            [&](int r) { return p.wt_c2 + (size_t)(which * 64 + (r & 63)) * 256; },
            [&](int rl, int cl, const f32x4 (&a)[4], int mfrag) {
                const int m = mt * 128 + rl;
                if (m < 2044) {
#pragma unroll
                    for (int n = 0; n < 4; ++n) { const int col = cl + n * 16; if (col < 64) {
                        const int bk = m / 511, nn = m % 511;
                        *(u32x2*)(p.kcmpb + ((size_t)((which * 4 + bk) * 512 + nn)) * 64 + col) = (u32x2){cvtpk(a[n][0], a[n][1]), cvtpk(a[n][2], a[n][3])}; } }
                }
            }, lds, tid);
    }
}
template <int MF>
__device__ __forceinline__ void st_outproj_mf(const P& p, int layer, int wg, int nwg, LDSP char* lds) {
    const int tid = otid();
    const bf16_t* W = layer ? p.wt_out1 : p.wt_out0;
    const float* xin = layer ? p.out : p.x;
    const XcdOrder ord(wg, nwg, (MF == 4) ? 128 : 104, 8);
    auto Af = [&](int mt_) { return [=](int r) { int row = mt_ * (32 * MF) + r; row = row < T_TOK ? row : T_TOK - 1; return p.o + (size_t)row * DM; }; };
    auto Bf = [&](int nt_) { return [=](int r) { return W + (size_t)(nt_ * 128 + r) * 1024; }; };
    bool staged = false;
    for (int k = 0;; ++k) {
        int mt, nt, mt2 = 0, nt2 = 0;
        if (!ord.get(k, mt, nt)) break;
        if (mt * (32 * MF) >= T_TOK) break;
        const bool has2 = ord.get(k + 1, mt2, nt2) && mt2 * (32 * MF) < T_TOK;
        const bool st_ = staged; staged = has2;
        gemm128x<MF>(16, 64, 64, Af(mt), Bf(nt),
            [&](int rl, int cl, const f32x4 (&a)[4], int mfrag) {
                const int row = mt * (32 * MF) + rl, b = row >> 13;
                const float* g = p.modv + (size_t)(layer * 2 + (b & 1)) * 6144 + 2 * 1024;
                if (row < T_TOK)
#pragma unroll
                for (int n = 0; n < 4; ++n) {
                    const int col = nt * 128 + cl + n * 16;
                    const f32x4 xv = *(const f32x4*)(xin + (size_t)row * DM + col), gv = *(const f32x4*)(g + col);
                    *(f32x4*)(p.out + (size_t)row * DM + col) = xv + gv * a[n];
                }
            }, lds, tid, st_, [&] { if (has2) g128_stage0<MF>(Af(mt2), Bf(nt2), lds, tid); });
    }
}
template <int BM>
__device__ __forceinline__ bool moe_tile128(const int* cnt, int tt, int& e, int& i0, int& off) {
    int acc = 0, o = 0;
    for (int q = 0; q < 16; ++q) {
        const int c = cnt[q * 32], nt = (c + BM - 1) / BM;
        if (tt < acc + nt) { e = q; i0 = (tt - acc) * BM; off = o; return true; }
        acc += nt; o += c;
    }
    return false;
}
struct MoeTile { int e, i0, off, nt, ce; bool ok; };
template <int BM>
__device__ __forceinline__ MoeTile moe_get(const int* cnt, int w) {
    MoeTile t; t.ok = moe_tile128<BM>(cnt, w >> 3, t.e, t.i0, t.off); t.nt = w & 7; t.ce = t.ok ? cnt[t.e * 32] : 0; return t;
}
template <int MF>
__device__ __forceinline__ void st_moe_up_mf(const P& p, int layer, int wg, int nwg, LDSP char* lds) {
    const int tid = otid();
    const int* cnt = p.cnt + layer * 512;
    auto Af = [&](const MoeTile& t) { const int* lst = p.list + t.e * T_TOK; const int i0 = t.i0, ce = t.ce;
                                      return [=](int r) { const int i = (i0 + r < ce) ? i0 + r : i0; return p.h + (size_t)(lst[i] >> 1) * DM; }; };
    auto Bf = [&](const MoeTile& t) { const bf16_t* B = p.wt_gu + ((size_t)(layer * 16 + t.e) * 1024 + t.nt * 128) * 1024; return [=](int r) { return B + (size_t)r * 1024; }; };
    MoeTile cur = moe_get<32 * MF>(cnt, wg);
    bool staged = false;
    for (int w = wg; cur.ok; w += nwg) {
        const MoeTile nx = moe_get<32 * MF>(cnt, w + nwg);
        const bool st_ = staged; staged = nx.ok;
        const int i0 = cur.i0, ce = cur.ce, off = cur.off, nt = cur.nt;
        gemm128x<MF>(16, 64, 64, Af(cur), Bf(cur),
            [&](int rl, int cl, const f32x4 (&a)[4], int mfrag) {
                if (i0 + rl < ce) {
                    const int wc = cl >> 6, fq4 = cl & 63;
#pragma unroll
                    for (int n = 0; n < 2; ++n) {
                        const int col = nt * 64 + wc * 32 + n * 16 + fq4;
                        const f32x4 g = a[n], u = a[n + 2];
                        *(u32x2*)(p.hid + (size_t)(off + i0 + rl) * 512 + col) =
                            (u32x2){pack_bf16(siluf(g[0]) * u[0], siluf(g[1]) * u[1]), pack_bf16(siluf(g[2]) * u[2], siluf(g[3]) * u[3])};
                    }
                }
            }, lds, tid, st_, [&] { if (nx.ok) g128_stage0<MF>(Af(nx), Bf(nx), lds, tid); });
        cur = nx;
    }
}
template <int MF>
__device__ __forceinline__ void st_moe_down_mf(const P& p, int layer, int wg, int nwg, LDSP char* lds) {
    const int tid = otid();
    const int* cnt = p.cnt + layer * 512;
    auto Af = [&](const MoeTile& t) { const int i0 = t.i0, ce = t.ce, off = t.off; return [=](int r) { const int i = (i0 + r < ce) ? i0 + r : i0; return p.hid + (size_t)(off + i) * 512; }; };
    auto Bf = [&](const MoeTile& t) { const bf16_t* B = p.wt_d + ((size_t)(layer * 16 + t.e) * 1024 + t.nt * 128) * 512; return [=](int r) { return B + (size_t)r * 512; }; };
    MoeTile cur = moe_get<32 * MF>(cnt, wg);
    bool staged = false;
    for (int w = wg; cur.ok; w += nwg) {
        const MoeTile nx = moe_get<32 * MF>(cnt, w + nwg);
        const bool st_ = staged; staged = nx.ok;
        const int i0 = cur.i0, ce = cur.ce, nt = cur.nt;
        const int* lst = p.list + cur.e * T_TOK;
        int ids[MF]; float wts[MF];
#pragma unroll
        for (int m = 0; m < MF; ++m) { const int rl = ((tid >> 7) & 1) * (16 * MF) + m * 16 + (tid & 15); ids[m] = (i0 + rl < ce) ? lst[i0 + rl] : -1; }
#pragma unroll
        for (int m = 0; m < MF; ++m) wts[m] = ids[m] >= 0 ? p.tokw[ids[m]] : 0.f;
        gemm128x<MF>(8, 64, 64, Af(cur), Bf(cur),
            [&](int rl, int cl, const f32x4 (&a)[4], int mfrag) {
                if (i0 + rl < ce) {
                    const int id = ids[mfrag]; const float wt = wts[mfrag];
#pragma unroll
                    for (int n = 0; n < 4; ++n) {
                        const int col = nt * 128 + cl + n * 16;
                        *(u32x2*)(p.y + (size_t)id * DM + col) = (u32x2){pack_bf16(wt * a[n][0], wt * a[n][1]), pack_bf16(wt * a[n][2], wt * a[n][3])};
                    }
                }
            }, lds, tid, st_, [&] { if (nx.ok) g128_stage0<MF>(Af(nx), Bf(nx), lds, tid); });
        cur = nx;
    }
}
template <int MF>
__device__ __forceinline__ void st_inproj1_mf(const P& p, int wg, int nwg, LDSP char* lds) {
    const int tid = otid();
    const XcdOrder ord(wg, nwg, (MF == 4) ? 128 : 104, 10);
    auto Af = [&](int mt_) { return [=](int r) { int row = mt_ * (32 * MF) + r; row = row < T_TOK ? row : T_TOK - 1; return p.h + (size_t)row * DM; }; };
    auto Bf = [&](int nt_) { return [=](int r) { int n = nt_ * 128 + r; n = n < 1216 ? n : 1215; return p.wt_in1 + (size_t)n * 1024; }; };
    bool staged = false;
    for (int k = 0;; ++k) {
        int mt, nt, mt2 = 0, nt2 = 0;
        if (!ord.get(k, mt, nt)) break;
        if (mt * (32 * MF) >= T_TOK) break;
        const bool has2 = ord.get(k + 1, mt2, nt2) && mt2 * (32 * MF) < T_TOK;
        const bool st_ = staged; staged = has2;
        gemm128x<MF>(16, 64, 64, Af(mt), Bf(nt),
            [&](int rl, int cl, const f32x4 (&a)[4], int mfrag) {
                const int row = mt * (32 * MF) + rl;
#pragma unroll
                for (int n = 0; n < 4; ++n) {
                    const int col = nt * 128 + cl + n * 16;
                    if (col < 1216 && row < T_TOK) *(u32x2*)(p.proj1 + (size_t)row * 1216 + col) = (u32x2){pack_bf16(a[n][0], a[n][1]), pack_bf16(a[n][2], a[n][3])};
                }
            }, lds, tid, st_, [&] { if (has2) g128_stage0<MF>(Af(mt2), Bf(nt2), lds, tid); });
    }
}
__device__ __forceinline__ void st_mla_up_mf(const P& p, int wg, int nwg, LDSP char* lds) {
    const int tid = otid();
    const XcdOrder ord(wg, nwg, 128, 14);
    for (int k = 0;; ++k) {
        int mt, c;
        if (!ord.get(k, mt, c)) break;
        if (c < 6) {
            gemm128(4, 64, 64,
                [&](int r) { return p.cqn + (size_t)(mt * 128 + r) * 384; },
                [&](int r) { return p.wt_qup + (size_t)(c * 128 + r) * 256; },
                [&](int rl, int cl, const f32x4 (&a)[4], int mfrag) {
                    const int row = mt * 128 + rl, wc = cl >> 6;
                    f32x4 v[4] = {a[0], a[1], a[2], a[3]};
                    if (((c == 1 || c == 4) && wc == 0) || ((c == 2 || c == 5) && wc == 1)) {
                        const int t = row & (SEQ - 1), i0 = cl & 63;
#pragma unroll
                        for (int n = 0; n < 2; ++n) {
                            const f32x4 cs = *(const f32x4*)(p.ropec + t * 32 + n * 16 + i0), sn = *(const f32x4*)(p.ropes + t * 32 + n * 16 + i0);
                            v[n] = a[n] * cs - a[n + 2] * sn; v[n + 2] = a[n] * sn + a[n + 2] * cs;
                        }
                    }
#pragma unroll
                    for (int n = 0; n < 4; ++n) *(u32x2*)(p.qmla + (size_t)row * 768 + c * 128 + cl + n * 16) = (u32x2){cvtpk(v[n][0], v[n][1]), cvtpk(v[n][2], v[n][3])};
                }, lds, tid);
        } else {
            gemm128(2, 64, 64,
                [&](int r) { return p.cqn + (size_t)(mt * 128 + r) * 384 + 256; },
                [&](int r) { return p.wt_kvup + (size_t)((c - 6) * 128 + r) * 128; },
                [&](int rl, int cl, const f32x4 (&a)[4], int mfrag) {
                    const int row = mt * 128 + rl;
#pragma unroll
                    for (int n = 0; n < 4; ++n) *(u32x2*)(p.kvmla + (size_t)row * 1024 + (c - 6) * 128 + cl + n * 16) = (u32x2){pack_bf16(a[n][0], a[n][1]), pack_bf16(a[n][2], a[n][3])};
                }, lds, tid);
        }
    }
}

typedef float f32x16 __attribute__((ext_vector_type(16)));
typedef short s16x4 __attribute__((ext_vector_type(4)));
#define ATT_NEG (-1e30f)
#define ATT_SHIFT (-16.0f)
#define LOG2E 1.4426950408889634f

__device__ __forceinline__ int swz128(int row) { return (((row >> 1) & 1) << 2) | ((row >> 2) & 3); }
__device__ __forceinline__ int swz256(int row) { return ((row & 3) << 2) | ((row >> 2) & 3); }

struct AttLane {
    int kbase;
    int v0[2];
};
template <int KROWB, int VROWB, int DT>
__device__ __forceinline__ void att_lane_init(AttLane& L, int lane) {
    const int q = lane & 31, hh = lane >> 5, x = hh ^ swz128(q);
    L.kbase = q * KROWB + x * 16;
    const int rl = 4 * hh + ((lane & 15) >> 2), blk = (lane >> 4) & 1, pp = lane & 3;
#pragma unroll
    for (int t = 0; t < 2; ++t) {
        const int g = (VROWB == 256) ? (((rl & 3) << 2) | ((2 * t + hh) & 3)) : ((((rl >> 1) & 1) << 2) | ((2 * t + hh) & 3));
        L.v0[t] = rl * VROWB + (((2 * blk + (pp >> 1)) ^ g) * 16) + 8 * (pp & 1);
    }
}
template <int KS, int KROWB, int MODE, bool WANT_P, bool IMP>
__device__ __forceinline__ void att_qk(LDSP const char* kb, const AttLane& L, const bf16x8 (&qf)[KS], bf16x8 (&pf)[4], float& lsum, const float c1, const float cadd,
                                       const unsigned lutv, const int dq16, LDSP float* improw, const float invl) {
    float la = 0.f, lb = 0.f, lc = 0.f, ld = 0.f;
#pragma unroll
    for (int kt = 0; kt < 2; ++kt) {
        f32x16 s;
#pragma unroll
        for (int r = 0; r < 16; ++r) s[r] = 0.f;
        constexpr int KG = (KS > 4) ? 2 : 4;
#pragma unroll
        for (int k4 = 0; k4 < KS; k4 += KG) {
            bf16x8 a[KG];
#pragma unroll
            for (int j = 0; j < KG; ++j) { const int ks = k4 + j; a[j] = *(const LDSP bf16x8*)(kb + (L.kbase ^ (32 * (ks & 3))) + (ks >> 2) * 128 + kt * 32 * KROWB); }
#pragma unroll
            for (int j = 0; j < KG; ++j) s = __builtin_amdgcn_mfma_f32_32x32x16_bf16(a[j], qf[k4 + j], s, 0, 0, 0);
            asm volatile("" ::: "memory");
        }
        float pr[16];
#pragma unroll
        for (int r = 0; r < 16; ++r) {
            const int koff = 32 * kt + (r & 3) + 8 * (r >> 2);
            float add = cadd;
            if (MODE == 1) add = *(const LDSP float*)(lutv + (63 - koff) * 4);
            if (MODE == 2) { int d = dq16 - 16 * koff; d = d < -1 ? -1 : d; d = d > 1087 ? 1087 : d; add = *(const LDSP float*)(lutv + (unsigned)(64 + d) * 4u); }
            pr[r] = __builtin_amdgcn_exp2f(__builtin_fmaf(s[r], c1, add));
        }
#pragma unroll
        for (int r = 0; r < 16; r += 4) { la += pr[r]; lb += pr[r + 1]; lc += pr[r + 2]; ld += pr[r + 3]; }
        if (IMP) {
#pragma unroll
            for (int g = 0; g < 4; ++g) {
                (void)__hip_atomic_fetch_add((LDSP unsigned*)improw + 8 * kt + 2 * g, (unsigned)(((pr[4 * g] + pr[4 * g + 1]) + (pr[4 * g + 2] + pr[4 * g + 3])) * invl + 0.5f), __ATOMIC_RELAXED, __HIP_MEMORY_SCOPE_WORKGROUP);
                (void)__hip_atomic_fetch_add((LDSP unsigned*)improw + 8 * kt + 2 * g + 1, (unsigned)(pr[4 * g + 3] * invl + 0.5f), __ATOMIC_RELAXED, __HIP_MEMORY_SCOPE_WORKGROUP);
            }
        }
        if (WANT_P) {
#pragma unroll
            for (int sI = 0; sI < 2; ++sI) {
                union { unsigned u[4]; bf16x8 v; } cv;
#pragma unroll
                for (int i = 0; i < 4; ++i) cv.u[i] = cvtpk_valu(pr[8 * sI + 2 * i], pr[8 * sI + 2 * i + 1]);
                pf[kt * 2 + sI] = cv.v;
            }
        }
    }
    lsum += (la + lb) + (lc + ld);
}
template <int DT, int VROWB>
__device__ __forceinline__ void att_pv(LDSP const char* vb, const AttLane& L, const bf16x8 (&pf)[4], f32x16 (&o)[DT]) {
    const unsigned vba = (unsigned)(size_t)vb;
#pragma unroll
    for (int ks2 = 0; ks2 < 4; ++ks2) {
#pragma unroll
        for (int d0 = 0; d0 < DT; d0 += 2) {
            s16x4 lo[2], hi[2];
#pragma unroll
            for (int j = 0; j < 2; ++j) {
                asm volatile("ds_read_b64_tr_b16 %0, %1 offset:%2" : "=v"(lo[j]) : "v"(vba + (L.v0[0] ^ ((d0 + j) << 6))), "i"((16 * ks2) * VROWB) : "memory");
                asm volatile("ds_read_b64_tr_b16 %0, %1 offset:%2" : "=v"(hi[j]) : "v"(vba + (L.v0[1] ^ ((d0 + j) << 6))), "i"((16 * ks2 + 8) * VROWB) : "memory");
            }
            asm volatile("s_waitcnt lgkmcnt(0)" ::: "memory");
#pragma unroll
            for (int j = 0; j < 2; ++j) {
                asm volatile("" : "+v"(lo[j]), "+v"(hi[j]));
                const bf16x8 vf = __builtin_shufflevector(lo[j], hi[j], 0, 1, 2, 3, 4, 5, 6, 7);
                o[d0 + j] = __builtin_amdgcn_mfma_f32_32x32x16_bf16(vf, pf[ks2], o[d0 + j], 0, 0, 0);
            }
        }
    }
}
template <int CPR>
__device__ __forceinline__ void att_stage_map(int (&rowc)[(CPR == 24) ? 6 : 1], int tid) {
    if (CPR == 24) {
#pragma unroll
        for (int i = 0; i < 6; ++i) {
            const int c = tid + 256 * i, row = c / 24, cc = c % 24;
            rowc[i % ((CPR == 24) ? 6 : 1)] = (row << 8) | ((cc & ~7) | ((cc & 7) ^ swz128(row)));
        }
    } else if (CPR == 16) {
        const int row = tid >> 4; rowc[0] = (row << 8) | ((tid & 15) ^ swz256(row));
    } else {
        const int row = tid >> 3; rowc[0] = (row << 8) | ((tid & 7) ^ swz128(row));
    }
}
template <int CPR, class SRC>
__device__ __forceinline__ void att_stage(LDSP char* dst, SRC src, const int (&rowc)[(CPR == 24) ? 6 : 1], int wid) {
#pragma unroll
    for (int i = 0; i < CPR / 4; ++i) {
        const int rc = rowc[(CPR == 24) ? i : 0];
        const int row = (rc >> 8) + ((CPR == 24) ? 0 : i * (256 / CPR));
        __builtin_amdgcn_global_load_lds((const unsigned*)src(row, rc & 255), (LDSP unsigned*)(dst + (256 * i + 64 * wid) * 16), 16, 0, 0);
    }
}
__device__ __forceinline__ int wq_next(int* ctr, LDSP int* slot, int tid) {
    __syncthreads();
    if (tid == 0) *slot = atomicAdd(ctr, 1);
    __syncthreads();
    return *slot;
}

__device__ __forceinline__ void build_lut(LDSP float* tab, const float* blut_h, int n, int wlimit, int tid) {
    for (int i = tid; i < n; i += 256) { const int d = i - 64; tab[i] = (d < 0 || d >= wlimit) ? ATT_NEG : blut_h[d > 1023 ? 1023 : d] * LOG2E + ATT_SHIFT; }
}
#define ATT_BAR() do { __builtin_amdgcn_s_barrier(); asm volatile("" ::: "memory"); } while (0)

__device__ __forceinline__ void mla_item(const P& p, const int item, LDSP char* lds, const int tid0) {
    LDSP char* kb = lds; LDSP char* vb = lds + 24576; LDSP float* lut = (LDSP float*)(lds + 40960);
    const float c1 = 0.07216878364870322f * LOG2E;
    int tid = tid0; asm volatile("" : "+v"(tid));
    const int wid = tid >> 6, lane = tid & 63, q = lane & 31, hh = lane >> 5;
    AttLane L; att_lane_init<384, 256, 4>(L, lane);
    int krc[6], vrc[1];
    att_stage_map<24>(krc, tid); att_stage_map<16>(vrc, tid);
    int qt, bh, part;
    if (item >= 640) { const int r = item - 640; qt = 15 - (r >> 3); bh = r & 7; part = 0; }
    else {
        int g = 0; while (16 * (g + 1) + 8 * ((g + 2) >> 1) <= item) ++g;
        const int r = item - (16 * g + 8 * ((g + 1) >> 1)), Ln = 64 - g;
        if (r < 16) { qt = Ln - 1; bh = r & 7; part = 1 + (r >> 3); } else { qt = (Ln >> 1) - 1; bh = (r - 16) & 7; part = 0; }
    }
    const int b = bh >> 2, h = bh & 3;
    const int tw = qt * 128 + wid * 32;
    bf16x8 qf[12];
    {
        const bf16_t* qp = p.qmla + (size_t)(b * SEQ + tw + q) * 768 + h * 192 + 8 * hh;
#pragma unroll
        for (int ks = 0; ks < 12; ++ks) qf[ks] = *(const bf16x8*)(qp + 16 * ks);
    }
    f32x16 o[4];
#pragma unroll
    for (int dt = 0; dt < 4; ++dt)
#pragma unroll
        for (int r = 0; r < 16; ++r) o[dt][r] = 0.f;
    float lsum = 0.f;
    const int i0 = (part == 2) ? qt + 1 : 0, ntiles = (part == 1) ? qt + 1 : 2 * qt + 2;
    const bf16_t* kvb = p.kvmla + (size_t)b * SEQ * 1024 + h * 256;
    const bf16_t* krb = p.krope + (size_t)b * SEQ * 64;
    auto ksrc = [&](int pos0) { return [=](int row, int gc) { return gc < 16 ? kvb + (size_t)(pos0 + row) * 1024 + gc * 8 : krb + (size_t)(pos0 + row) * 64 + (gc - 16) * 8; }; };
    auto vsrc = [&](int pos0) { return [=](int row, int gc) { return kvb + (size_t)(pos0 + row) * 1024 + 128 + gc * 8; }; };
    att_stage<24>(kb, ksrc(i0 * 64), krc, wid);
    for (int i = i0; i < ntiles; ++i) {
        const int pos0 = i * 64;
        asm volatile("s_waitcnt vmcnt(0)" ::: "memory"); ATT_BAR();
        att_stage<16>(vb, vsrc(pos0), vrc, wid);
        const bool active = pos0 <= tw + 31, diag = pos0 + 63 > tw;
        bf16x8 pf[4];
        if (active) {
            if (diag) {
                int dq = tw + q - pos0 - 4 * hh; dq = dq < -1 ? -1 : dq;
                att_qk<12, 384, 1, true, false>(kb, L, qf, pf, lsum, c1, 0.f, (unsigned)(size_t)lut + (unsigned)(dq + 1) * 4u, 0, nullptr, 0.f);
            } else att_qk<12, 384, 0, true, false>(kb, L, qf, pf, lsum, c1, ATT_SHIFT, 0u, 0, nullptr, 0.f);
        }
        asm volatile("s_waitcnt vmcnt(0) lgkmcnt(0)" ::: "memory"); ATT_BAR();
        if (i + 1 < ntiles) att_stage<24>(kb, ksrc(pos0 + 64), krc, wid);
        if (active) att_pv<4, 256>(vb, L, pf, o);
    }
    const float lt = lsum + __shfl_xor(lsum, 32);
    int tid2 = tid0; asm volatile("" : "+v"(tid2));
    const int lane2 = tid2 & 63, trow = qt * 128 + (tid2 >> 6) * 32 + (lane2 & 31);
    bf16_t* op; float inv;
    if (part == 0) { inv = 1.0f / lt; op = p.o + (size_t)(b * SEQ + trow) * DM + h * 128 + 4 * (lane2 >> 5); }
    else {
        const size_t rec = (size_t)((part - 1) * 8 + bh) * (SEQ / 2) + (trow - SEQ / 2);
        inv = 1.0f; op = p.mlap + rec * 128 + 4 * (lane2 >> 5);
        if (lane2 < 32) p.mlal[rec] = lt;
    }
#pragma unroll
    for (int dt = 0; dt < 4; ++dt)
#pragma unroll
        for (int rq = 0; rq < 4; ++rq)
            *(u32x2*)(op + 32 * dt + 8 * rq) = (u32x2){cvtpk(o[dt][4 * rq] * inv, o[dt][4 * rq + 1] * inv), cvtpk(o[dt][4 * rq + 2] * inv, o[dt][4 * rq + 3] * inv)};
}
__device__ __forceinline__ void st_mla_combine(const P& p, int wg, int nwg) {
    const int TIDX = otid();
    const int wid = TIDX >> 6, lane = TIDX & 63;
    for (int w = wg * 4 + wid; w < 8 * (SEQ / 2); w += nwg * 4) {
        const int bh = w / (SEQ / 2), t = SEQ / 2 + w % (SEQ / 2), b = bh >> 2, h = bh & 3;
        const size_t r0 = (size_t)w, r1 = (size_t)(8 * (SEQ / 2) + w);
        const float inv = 1.0f / (p.mlal[r0] + p.mlal[r1]);
        const unsigned a = *(const unsigned*)(p.mlap + r0 * 128 + lane * 2), c = *(const unsigned*)(p.mlap + r1 * 128 + lane * 2);
        const float x0 = __uint_as_float(a << 16) + __uint_as_float(c << 16), x1 = __uint_as_float(a & 0xffff0000u) + __uint_as_float(c & 0xffff0000u);
        *(unsigned*)(p.o + (size_t)(b * SEQ + t) * DM + h * 128 + lane * 2) = cvtpk(x0 * inv, x1 * inv);
    }
}

__device__ __forceinline__ void swa_item(const P& p, const int item, LDSP char* lds, const int tid0) {
    LDSP char* kb = lds; LDSP char* vb = lds + 8192; LDSP float* luts = (LDSP float*)(lds + 46080);
    const float c1 = 0.125f * LOG2E;
    int tid = tid0; asm volatile("" : "+v"(tid));
    const int wid = tid >> 6, lane = tid & 63, q = lane & 31, hh = lane >> 5;
    AttLane L; att_lane_init<128, 128, 2>(L, lane);
    int rc[1]; att_stage_map<8>(rc, tid);
    const int b = item >> 9, kvh = (item >> 8) & 1, t0 = (item & 255) * 32, head = kvh * 4 + wid;
    bf16x8 qf[4];
    {
        const bf16_t* qp = p.proj1 + (size_t)(b * SEQ + t0 + q) * 1216 + 448 + head * 64 + 8 * hh;
#pragma unroll
        for (int ks = 0; ks < 4; ++ks) qf[ks] = *(const bf16x8*)(qp + 16 * ks);
    }
    f32x16 o[2];
#pragma unroll
    for (int dt = 0; dt < 2; ++dt)
#pragma unroll
        for (int r = 0; r < 16; ++r) o[dt][r] = 0.f;
    float lsum = 0.f;
    const bf16_t* kbp = p.proj1 + (size_t)b * SEQ * 1216 + 960 + kvh * 64;
    const bf16_t* zr = p.zrow;
    auto ksrc = [&](int pos0) { return [=](int row, int gc) { const int pos = pos0 + row; return (pos >= 0 && pos < SEQ) ? kbp + (size_t)pos * 1216 + gc * 8 : zr + gc * 8; }; };
    auto vsrc = [&](int pos0) { return [=](int row, int gc) { const int pos = pos0 + row; return (pos >= 0 && pos < SEQ) ? kbp + (size_t)pos * 1216 + 128 + gc * 8 : zr + gc * 8; }; };
    const unsigned tab = (unsigned)(size_t)(luts + head * 256);
    att_stage<8>(kb, ksrc(t0 - 128), rc, wid);
    for (int i = 0; i < 3; ++i) {
        const int pos0 = t0 - 128 + 64 * i;
        asm volatile("s_waitcnt vmcnt(0)" ::: "memory"); ATT_BAR();
        att_stage<8>(vb, vsrc(pos0), rc, wid);
        bf16x8 pf[4];
        int dq = t0 + q - pos0 - 4 * hh; dq = dq < -1 ? -1 : dq;
        att_qk<4, 128, 1, true, false>(kb, L, qf, pf, lsum, c1, 0.f, tab + (unsigned)(dq + 1) * 4u, 0, nullptr, 0.f);
        asm volatile("s_waitcnt vmcnt(0) lgkmcnt(0)" ::: "memory"); ATT_BAR();
        if (i + 1 < 3) att_stage<8>(kb, ksrc(pos0 + 64), rc, wid);
        att_pv<2, 128>(vb, L, pf, o);
    }
    const float lt = lsum + __shfl_xor(lsum, 32) + __builtin_amdgcn_exp2f(p.sinks[head] * LOG2E + ATT_SHIFT);
    const float inv = 1.0f / lt;
    bf16_t* op = p.o + (size_t)(b * SEQ + t0 + q) * DM + 512 + head * 64 + 4 * hh;
#pragma unroll
    for (int dt = 0; dt < 2; ++dt)
#pragma unroll
        for (int rq = 0; rq < 4; ++rq)
            *(u32x2*)(op + 32 * dt + 8 * rq) = (u32x2){cvtpk(o[dt][4 * rq] * inv, o[dt][4 * rq + 1] * inv), cvtpk(o[dt][4 * rq + 2] * inv, o[dt][4 * rq + 3] * inv)};
}
__device__ __forceinline__ void moe_conv_item(const P& p, const int layer, const int item, LDSP char* lds, const int tid0) {
    float* sm = (float*)lds;
    const int set = item >> 8, t0 = (item & 255) * 8;
    if (set == 0) conv_batched<1>(p.moe_wg + (size_t)layer * 16 * 1024 * 512, 16, 1024, 512, (size_t)1024 * 512, p.wt_gu + (size_t)layer * 16 * 1024 * 1024, (size_t)1024 * 1024, t0, 1, sm, tid0, t0 + 8);
    else if (set == 1) conv_batched<2>(p.moe_wu + (size_t)layer * 16 * 1024 * 512, 16, 1024, 512, (size_t)1024 * 512, p.wt_gu + (size_t)layer * 16 * 1024 * 1024, (size_t)1024 * 1024, t0, 1, sm, tid0, t0 + 8);
    else conv_batched<0>(p.moe_wd + (size_t)layer * 16 * 512 * 1024, 16, 512, 1024, (size_t)512 * 1024, p.wt_d + (size_t)layer * 16 * 1024 * 512, (size_t)1024 * 512, t0, 1, sm, tid0, t0 + 8);
}
__device__ __forceinline__ void st_attn1(const P& p, LDSP char* lds) {
    const int tid0 = otid();
    LDSP float* lut = (LDSP float*)(lds + 40960); LDSP int* slot = (LDSP int*)(lds + 45568); LDSP float* luts = (LDSP float*)(lds + 46080);
    for (int i = tid0; i < 1152; i += 256) lut[i] = (i < 64) ? ATT_NEG : ATT_SHIFT;
#pragma unroll 1
    for (int h = 0; h < 8; ++h) build_lut(luts + h * 256, p.blut + h * 1024, 256, 128, tid0);
    for (;;) {
        const int item = wq_next(p.wq + 0, slot, tid0);
        if (item >= 768 + 1024 + 768) break;
        if (item < 768) mla_item(p, item, lds, tid0);
        else { const int r = item - 768, g = r / 7, ps = r - g * 7;
               if (ps < 4) swa_item(p, g * 4 + ps, lds, tid0); else moe_conv_item(p, 1, g * 3 + ps - 4, lds, tid0); }
    }
}

#define A0_GLUT 16384
#define A0_WLUT 34816
#define A0_IMP 45056
#define A0_SEL 61568
#define A0_UN 62080
#define A0_LIST 62144
#define A0_SLOT 62720
__device__ __forceinline__ unsigned wmax_u32(unsigned v) {
#pragma unroll
    for (int o = 32; o > 0; o >>= 1) { const unsigned t = (unsigned)__shfl_xor((int)v, o); v = t > v ? t : v; }
    return v;
}
#define ATT_STORE_O(op, o, sc) do { _Pragma("unroll") for (int dt_ = 0; dt_ < 2; ++dt_) _Pragma("unroll") for (int rq_ = 0; rq_ < 4; ++rq_) \
        *(u32x2*)((op) + 32 * dt_ + 8 * rq_) = (u32x2){cvtpk((o)[dt_][4 * rq_] * (sc), (o)[dt_][4 * rq_ + 1] * (sc)), cvtpk((o)[dt_][4 * rq_ + 2] * (sc), (o)[dt_][4 * rq_ + 3] * (sc))}; } while (0)

__device__ __forceinline__ void nsa_item(const P& p, const int item, LDSP char* lds, const int tid0) {
    LDSP char* kb = lds; LDSP char* vb = lds + 8192;
    LDSP float* glut = (LDSP float*)(lds + A0_GLUT); LDSP float* wlut = (LDSP float*)(lds + A0_WLUT); LDSP float* imp = (LDSP float*)(lds + A0_IMP);
    LDSP unsigned* sel = (LDSP unsigned*)(lds + A0_SEL); LDSP unsigned* un = (LDSP unsigned*)(lds + A0_UN); LDSP unsigned short* blist = (LDSP unsigned short*)(lds + A0_LIST);
    const float c1 = 0.125f * LOG2E;
    int tid = tid0; asm volatile("" : "+v"(tid));
    const int wid = tid >> 6, lane = tid & 63, q = lane & 31, hh = lane >> 5;
    const int tile = 255 - (item >> 2), b = (item >> 1) & 1, kvh = item & 1, t0 = tile * 32, blk_t = t0 >> 6, head = kvh * 4 + wid;
#pragma unroll 1
    for (int h = 0; h < 4; ++h) { build_lut(glut + h * 1152, p.blut + (kvh * 4 + h) * 1024, 1152, 1 << 30, tid); build_lut(wlut + h * 640, p.blut + (kvh * 4 + h) * 1024, 640, 512, tid); }
    for (int i = tid; i < 32 * 129; i += 256) imp[i] = 0.f;
    AttLane L; att_lane_init<128, 128, 2>(L, lane);
    int rc[1]; att_stage_map<8>(rc, tid);
    const size_t rowq = (size_t)(b * SEQ + t0 + q);
    bf16x8 qf[4];
    {
        const bf16_t* qp = p.proj + rowq * 2840 + head * 64 + 8 * hh;
#pragma unroll
        for (int ks = 0; ks < 4; ++ks) qf[ks] = *(const bf16x8*)(qp + 16 * ks);
    }
    const float gc = p.gates[rowq * 24 + head * 3 + 0], gs = p.gates[rowq * 24 + head * 3 + 1], gw = p.gates[rowq * 24 + head * 3 + 2];
    const unsigned gtab = (unsigned)(size_t)(glut + wid * 1152), wtab = (unsigned)(size_t)(wlut + wid * 640);
    const bf16_t* zr = p.zrow;
    const bf16_t* pb = p.proj + (size_t)b * SEQ * 2840;
    f32x16 of[2], o[2];
#pragma unroll
    for (int dt = 0; dt < 2; ++dt)
#pragma unroll
        for (int r = 0; r < 16; ++r) { of[dt][r] = 0.f; o[dt][r] = 0.f; }
    bf16x8 pf[4];
    __syncthreads();
    const float cfar = glut[wid * 1152 + 64 + 1023];
    {
        int nvm = (t0 >> 4) + 1; nvm = nvm > 511 ? 511 : nvm;
        const int ntc = (nvm + 63) >> 6;
        const bf16_t* kcb = p.kcmpb + (size_t)((b * 2 + kvh) * 512) * 64;
        const bf16_t* vcb = p.kcmpb + (size_t)((4 + b * 2 + kvh) * 512) * 64;
        auto csrc = [&](const bf16_t* base, int n0) { return [=](int row, int gcx) { const int n = n0 + row; return n < 511 ? base + (size_t)n * 64 + gcx * 8 : zr + gcx * 8; }; };
        float lsum = 0.f;
        for (int nt = 0; nt < ntc; ++nt) {
            att_stage<8>(kb, csrc(kcb, nt * 64), rc, wid);
            asm volatile("s_waitcnt vmcnt(0)" ::: "memory"); ATT_BAR();
            const int dq16 = t0 + q - 31 - 1024 * nt - 64 * hh;
            if (t0 - 31 - 16 * (nt * 64 + 63) >= 1023) att_qk<4, 128, 0, false, false>(kb, L, qf, pf, lsum, c1, cfar, 0u, 0, nullptr, 0.f);
            else att_qk<4, 128, 2, false, false>(kb, L, qf, pf, lsum, c1, 0.f, gtab, dq16, nullptr, 0.f);
            asm volatile("s_waitcnt lgkmcnt(0)" ::: "memory"); ATT_BAR();
        }
        const float lc = lsum + __shfl_xor(lsum, 32);
        const float invl = lc > 0.f ? 1.0f / lc : 0.f;
        float dummy = 0.f;
        for (int nt = 0; nt < ntc; ++nt) {
            att_stage<8>(kb, csrc(kcb, nt * 64), rc, wid);
            att_stage<8>(vb, csrc(vcb, nt * 64), rc, wid);
            asm volatile("s_waitcnt vmcnt(0)" ::: "memory"); ATT_BAR();
            const int dq16 = t0 + q - 31 - 1024 * nt - 64 * hh;
            LDSP float* improw = imp + q * 129 + 16 * nt + hh;
            if (t0 - 31 - 16 * (nt * 64 + 63) >= 1023) att_qk<4, 128, 0, true, true>(kb, L, qf, pf, dummy, c1, cfar, 0u, 0, improw, invl * 524288.0f);
            else att_qk<4, 128, 2, true, true>(kb, L, qf, pf, dummy, c1, 0.f, gtab, dq16, improw, invl * 524288.0f);
            att_pv<2, 128>(vb, L, pf, o);
            asm volatile("s_waitcnt lgkmcnt(0)" ::: "memory"); ATT_BAR();
        }
        const float sc = gc * invl;
#pragma unroll
        for (int dt = 0; dt < 2; ++dt)
#pragma unroll
            for (int r = 0; r < 16; ++r) { of[dt][r] = o[dt][r] * sc; o[dt][r] = 0.f; }
    }
    __syncthreads();
    {
        unsigned u0 = 0u, u1 = 0u, u2 = 0u, u3 = 0u;
        for (int i = 0; i < 8; ++i) {
            const int tok = wid * 8 + i;
            const unsigned v0 = ((LDSP const unsigned*)imp)[tok * 129 + lane], v1 = ((LDSP const unsigned*)imp)[tok * 129 + 64 + lane];
            const int j0 = lane, j1 = lane + 64;
            const bool f0 = (j0 == 0) || (j0 == blk_t) || (j0 == blk_t - 1), f1 = (j1 == blk_t) || (j1 == blk_t - 1);
            unsigned k0 = f0 ? (0xFFFFFF80u | (unsigned)(127 - j0)) : (j0 <= blk_t ? ((v0 << 7) | (unsigned)(127 - j0)) : 0u);
            unsigned k1 = f1 ? (0xFFFFFF80u | (unsigned)(127 - j1)) : (j1 <= blk_t ? ((v1 << 7) | (unsigned)(127 - j1)) : 0u);
            unsigned thr = 0u;
#pragma unroll 1
            for (int bit = 31; bit >= 0; --bit) {
                const unsigned cand = thr | (1u << bit);
                const int c = __popcll(__ballot(k0 >= cand)) + __popcll(__ballot(k1 >= cand));
                thr = (c >= 16) ? cand : thr;
            }
            thr = thr ? thr : 1u;
            const unsigned long long b0 = __ballot(k0 >= thr), b1 = __ballot(k1 >= thr);
            const unsigned m0 = (unsigned)b0, m1 = (unsigned)(b0 >> 32), m2 = (unsigned)b1, m3 = (unsigned)(b1 >> 32);
            if (lane == 0) { sel[tok * 4 + 0] = m0; sel[tok * 4 + 1] = m1; sel[tok * 4 + 2] = m2; sel[tok * 4 + 3] = m3; }
            u0 |= m0; u1 |= m1; u2 |= m2; u3 |= m3;
        }
        if (lane == 0) { un[wid * 4 + 0] = u0; un[wid * 4 + 1] = u1; un[wid * 4 + 2] = u2; un[wid * 4 + 3] = u3; }
    }
    __syncthreads();
    {
        unsigned uw[4];
#pragma unroll
        for (int k = 0; k < 4; ++k) uw[k] = (unsigned)__builtin_amdgcn_readfirstlane((int)(un[k] | un[4 + k] | un[8 + k] | un[12 + k]));
        if (tid < 128) {
            const int k = tid >> 5, jb = tid & 31;
            unsigned wv = 0u; int below = 0;
#pragma unroll
            for (int kk = 0; kk < 4; ++kk) { if (kk == k) wv = uw[kk]; if (kk < k) below += __popc(uw[kk]); }
            if ((wv >> jb) & 1u) blist[below + __popc(wv & ((1u << jb) - 1u))] = (unsigned short)tid;
        }
        const int nb = __popc(uw[0]) + __popc(uw[1]) + __popc(uw[2]) + __popc(uw[3]);
        unsigned sq[4];
#pragma unroll
        for (int k = 0; k < 4; ++k) sq[k] = sel[q * 4 + k];
        __syncthreads();
        const bf16_t* ksb = pb + 768 + kvh * 64;
        auto ssrc = [&](int pos0, int colo) { return [=](int row, int gcx) { return ksb + (size_t)(pos0 + row) * 2840 + colo + gcx * 8; }; };
        float lsum = 0.f;
        att_stage<8>(kb, ssrc(64 * (int)blist[0], 0), rc, wid);
        for (int i = 0; i < nb; ++i) {
            const int j = __builtin_amdgcn_readfirstlane((int)blist[i]), pos0 = 64 * j;
            asm volatile("s_waitcnt vmcnt(0)" ::: "memory"); ATT_BAR();
            att_stage<8>(vb, ssrc(pos0, 128), rc, wid);
            unsigned sw = 0u;
#pragma unroll
            for (int k = 0; k < 4; ++k) if ((j >> 5) == k) sw = sq[k];
            const bool selq = (sw >> (j & 31)) & 1u;
            if (t0 - (pos0 + 63) >= 1023) att_qk<4, 128, 0, true, false>(kb, L, qf, pf, lsum, c1, selq ? cfar : ATT_NEG, 0u, 0, nullptr, 0.f);
            else {
                int dq = t0 + q - pos0 - 4 * hh; dq = dq > 1087 ? 1087 : dq; dq = (dq < -1 || !selq) ? -1 : dq;
                att_qk<4, 128, 1, true, false>(kb, L, qf, pf, lsum, c1, 0.f, gtab + (unsigned)(dq + 1) * 4u, 0, nullptr, 0.f);
            }
            asm volatile("s_waitcnt vmcnt(0) lgkmcnt(0)" ::: "memory"); ATT_BAR();
            if (i + 1 < nb) att_stage<8>(kb, ssrc(64 * (int)blist[i + 1], 0), rc, wid);
            att_pv<2, 128>(vb, L, pf, o);
        }
        const float ls = lsum + __shfl_xor(lsum, 32);
        const float sc = gs / ls;
#pragma unroll
        for (int dt = 0; dt < 2; ++dt)
#pragma unroll
            for (int r = 0; r < 16; ++r) { of[dt][r] += o[dt][r] * sc; o[dt][r] = 0.f; }
    }
    {
        const bf16_t* kwb = pb + 1024 + kvh * 64;
        auto wsrc = [&](int pos0, int colo) { return [=](int row, int gcx) { const int pos = pos0 + row; return (pos >= 0 && pos < SEQ) ? kwb + (size_t)pos * 2840 + colo + gcx * 8 : zr + gcx * 8; }; };
        float lsum = 0.f;
        asm volatile("s_waitcnt lgkmcnt(0)" ::: "memory"); ATT_BAR();
        att_stage<8>(kb, wsrc(t0 - 512, 0), rc, wid);
        for (int i = 0; i < 9; ++i) {
            const int pos0 = t0 - 512 + 64 * i;
            asm volatile("s_waitcnt vmcnt(0)" ::: "memory"); ATT_BAR();
            att_stage<8>(vb, wsrc(pos0, 128), rc, wid);
            int dq = t0 + q - pos0 - 4 * hh; dq = dq < -1 ? -1 : dq;
            att_qk<4, 128, 1, true, false>(kb, L, qf, pf, lsum, c1, 0.f, wtab + (unsigned)(dq + 1) * 4u, 0, nullptr, 0.f);
            asm volatile("s_waitcnt vmcnt(0) lgkmcnt(0)" ::: "memory"); ATT_BAR();
            if (i + 1 < 9) att_stage<8>(kb, wsrc(pos0 + 64, 0), rc, wid);
            att_pv<2, 128>(vb, L, pf, o);
        }
        const float lw = lsum + __shfl_xor(lsum, 32);
        const float sc = gw / lw;
#pragma unroll
        for (int dt = 0; dt < 2; ++dt)
#pragma unroll
            for (int r = 0; r < 16; ++r) of[dt][r] += o[dt][r] * sc;
    }
    bf16_t* op = p.o + rowq * DM + head * 64 + 4 * hh;
    ATT_STORE_O(op, of, 1.0f);
}

#define MG_CNT 8192
#define MG_BASE 8320
#define MG_ENT 8448
__device__ __forceinline__ void st_moba_gate(const P& p, int wg, int nwg, LDSP char* lds) {
    const int tid = otid();
    const int wid = tid >> 6, lane = tid & 63, q = lane & 31, hh = lane >> 5;
    LDSP char* kmt = lds; LDSP int* lcnt = (LDSP int*)(lds + MG_CNT); LDSP int* lbase = (LDSP int*)(lds + MG_BASE); LDSP int* ent = (LDSP int*)(lds + MG_ENT);
    AttLane L; att_lane_init<128, 128, 2>(L, lane);
    int rc[1]; att_stage_map<8>(rc, tid);
    const bf16_t* zr = p.zrow;
    for (int item = wg; item < 1024; item += nwg) {
        const int tile = item >> 4, b = (item >> 3) & 1, h = item & 7, t0 = tile * 128, own = t0 >> 8, tw = t0 + wid * 32, bh = b * 8 + h;
        if (own == 0) continue;
        __syncthreads();
        if (tid < 32) lcnt[tid] = 0;
        bf16x8 qf[4];
        {
            const bf16_t* qp = p.proj + (size_t)(b * SEQ + tw + q) * 2840 + 1304 + h * 64 + 8 * hh;
#pragma unroll
            for (int ks = 0; ks < 4; ++ks) qf[ks] = *(const bf16x8*)(qp + 16 * ks);
        }
        const bf16_t* kmb = p.kmeanb + (size_t)(bh * 32) * 64;
        att_stage<8>(kmt, [=](int row, int gcx) { return row < 32 ? kmb + (size_t)row * 64 + gcx * 8 : zr + gcx * 8; }, rc, wid);
        asm volatile("s_waitcnt vmcnt(0)" ::: "memory");
        __syncthreads();
        f32x16 s;
#pragma unroll
        for (int r = 0; r < 16; ++r) s[r] = 0.f;
#pragma unroll
        for (int ks = 0; ks < 4; ++ks) {
            const bf16x8 a = *(const LDSP bf16x8*)(kmt + (L.kbase ^ (32 * (ks & 3))));
            s = __builtin_amdgcn_mfma_f32_32x32x16_bf16(a, qf[ks], s, 0, 0, 0);
        }
        unsigned key[16];
#pragma unroll
        for (int r = 0; r < 16; ++r) {
            const int j = (r & 3) + 8 * (r >> 2) + 4 * hh;
            const unsigned bits = __float_as_uint(s[r]);
            const unsigned srt = (bits & 0x80000000u) ? ~bits : (bits | 0x80000000u);
            key[r] = (j < own) ? ((srt & ~31u) | (unsigned)(31 - j)) : 0u;
        }
        unsigned selm = 0u;
#pragma unroll 1
        for (int rnd = 0; rnd < 3; ++rnd) {
            unsigned m = 0u;
#pragma unroll
            for (int r = 0; r < 16; ++r) m = key[r] > m ? key[r] : m;
            const unsigned mo = (unsigned)__shfl_xor((int)m, 32);
            const unsigned wk = mo > m ? mo : m;
            if (wk != 0u) selm |= 1u << (31 - (wk & 31u));
#pragma unroll
            for (int r = 0; r < 16; ++r) key[r] = (key[r] == wk) ? 0u : key[r];
        }
        if (hh == 0) {
            unsigned mm = selm;
#pragma unroll
            for (int sI = 0; sI < 3; ++sI) {
                int en = -1;
                if (mm) { const int j = __builtin_ctz(mm); mm &= mm - 1u; const int lp = __hip_atomic_fetch_add(lcnt + j, 1, __ATOMIC_RELAXED, __HIP_MEMORY_SCOPE_WORKGROUP); en = (j << 8) | lp; }
                ent[(wid * 32 + q) * 3 + sI] = en;
            }
        }
        __syncthreads();
        if (tid < 32) { const int c = lcnt[tid]; lbase[tid] = c ? atomicAdd(p.mcnt + bh * 32 + tid, c) : 0; }
        __syncthreads();
        for (int e = tid; e < 384; e += 256) {
            const int en = ent[e];
            if (en >= 0) { const int j = en >> 8, tokl = e / 3, sI = e - tokl * 3; p.mlist[(size_t)(bh * 32 + j) * 8192 + lbase[j] + (en & 255)] = (unsigned short)((t0 + tokl) | (sI << 13)); }
        }
    }
}
__device__ __forceinline__ bf16_t* moba_part(const P& p, int slot, size_t row) { return (slot < 2 ? p.mp01 + (size_t)slot * 131072 * 64 : p.mp2) + row * 64; }

__device__ __forceinline__ void moba_inv_item(const P& p, const int lid, const int chunk, LDSP char* lds, const int tid0) {
    LDSP char* kb = lds; LDSP char* vb = lds + 8192; LDSP float* glut = (LDSP float*)(lds + A0_GLUT);
    const float c1 = 0.125f * LOG2E;
    int tid = tid0; asm volatile("" : "+v"(tid));
    const int wid = tid >> 6, lane = tid & 63, q = lane & 31, hh = lane >> 5;
    const int bh = lid / 31, j = lid - bh * 31, b = bh >> 3, h = bh & 7;
    build_lut(glut, p.blut + h * 1024, 1152, 1 << 30, tid);
    AttLane L; att_lane_init<128, 128, 2>(L, lane);
    int rc[1]; att_stage_map<8>(rc, tid);
    const int n = p.mcnt[bh * 32 + j], idx = chunk * 128 + wid * 32 + q;
    const bool valid = idx < n;
    const unsigned en = valid ? (unsigned)p.mlist[(size_t)(bh * 32 + j) * 8192 + idx] : (unsigned)(256 * (j + 1));
    const int tok = (int)(en & 8191u), slot = (int)(en >> 13);
    bf16x8 qf[4];
    {
        const bf16_t* qp = p.proj + (size_t)(b * SEQ + tok) * 2840 + 1304 + h * 64 + 8 * hh;
#pragma unroll
        for (int ks = 0; ks < 4; ++ks) qf[ks] = *(const bf16x8*)(qp + 16 * ks);
    }
    const unsigned gtab = (unsigned)(size_t)glut;
    const bf16_t* kbb = p.proj + (size_t)b * SEQ * 2840 + 1816 + h * 64;
    auto msrc = [&](int pos0, int colo) { return [=](int row, int gcx) { return kbb + (size_t)(pos0 + row) * 2840 + colo + gcx * 8; }; };
    f32x16 o[2];
#pragma unroll
    for (int dt = 0; dt < 2; ++dt)
#pragma unroll
        for (int r = 0; r < 16; ++r) o[dt][r] = 0.f;
    float lsum = 0.f;
    bf16x8 pf[4];
    __syncthreads();
    att_stage<8>(kb, msrc(256 * j, 0), rc, wid);
    for (int i = 0; i < 4; ++i) {
        const int pos0 = 256 * j + 64 * i;
        asm volatile("s_waitcnt vmcnt(0)" ::: "memory"); ATT_BAR();
        att_stage<8>(vb, msrc(pos0, 512), rc, wid);
        {
            int dq = tok - pos0 - 4 * hh; dq = dq > 1087 ? 1087 : dq; dq = valid ? dq : -1;
            att_qk<4, 128, 1, true, false>(kb, L, qf, pf, lsum, c1, 0.f, gtab + (unsigned)(dq + 1) * 4u, 0, nullptr, 0.f);
        }
        asm volatile("s_waitcnt vmcnt(0) lgkmcnt(0)" ::: "memory"); ATT_BAR();
        if (i + 1 < 4) att_stage<8>(kb, msrc(pos0 + 64, 0), rc, wid);
        att_pv<2, 128>(vb, L, pf, o);
    }
    const float lt = lsum + __shfl_xor(lsum, 32);
    if (valid) {
        const size_t row = (size_t)bh * SEQ + tok;
        bf16_t* op = moba_part(p, slot, row) + 4 * hh;
        ATT_STORE_O(op, o, 1.0f);
        if (hh == 0) p.mpl[(size_t)slot * 131072 + row] = lt;
    }
}
__device__ __forceinline__ void moba_own_item(const P& p, const int item, LDSP char* lds, const int tid0) {
    LDSP char* kb = lds; LDSP char* vb = lds + 8192; LDSP float* glut = (LDSP float*)(lds + A0_GLUT);
    const float c1 = 0.125f * LOG2E;
    int tid = tid0; asm volatile("" : "+v"(tid));
    const int wid = tid >> 6, lane = tid & 63, q = lane & 31, hh = lane >> 5;
    const int tile = item >> 4, b = (item >> 3) & 1, h = item & 7, t0 = tile * 128, own = t0 >> 8, tw = t0 + wid * 32, bh = b * 8 + h;
    __syncthreads();
    build_lut(glut, p.blut + h * 1024, 1152, 1 << 30, tid);
    AttLane L; att_lane_init<128, 128, 2>(L, lane);
    int rc[1]; att_stage_map<8>(rc, tid);
    const size_t rowq = (size_t)(b * SEQ + tw + q);
    bf16x8 qf[4];
    {
        const bf16_t* qp = p.proj + rowq * 2840 + 1304 + h * 64 + 8 * hh;
#pragma unroll
        for (int ks = 0; ks < 4; ++ks) qf[ks] = *(const bf16x8*)(qp + 16 * ks);
    }
    const unsigned gtab = (unsigned)(size_t)glut;
    const bf16_t* kbb = p.proj + (size_t)b * SEQ * 2840 + 1816 + h * 64;
    auto msrc = [&](int pos0, int colo) { return [=](int row, int gcx) { return kbb + (size_t)(pos0 + row) * 2840 + colo + gcx * 8; }; };
    f32x16 o[2];
#pragma unroll
    for (int dt = 0; dt < 2; ++dt)
#pragma unroll
        for (int r = 0; r < 16; ++r) o[dt][r] = 0.f;
    float lsum = 0.f;
    bf16x8 pf[4];
    const int nb = (((t0 + 127) >> 6) & 3) + 1;
    __syncthreads();
    att_stage<8>(kb, msrc(256 * own, 0), rc, wid);
    for (int i = 0; i < nb; ++i) {
        const int pos0 = 256 * own + 64 * i;
        asm volatile("s_waitcnt vmcnt(0)" ::: "memory"); ATT_BAR();
        att_stage<8>(vb, msrc(pos0, 512), rc, wid);
        const bool active = pos0 <= tw + 31;
        if (active) {
            int dq = tw + q - pos0 - 4 * hh; dq = dq < -1 ? -1 : dq;
            att_qk<4, 128, 1, true, false>(kb, L, qf, pf, lsum, c1, 0.f, gtab + (unsigned)(dq + 1) * 4u, 0, nullptr, 0.f);
        }
        asm volatile("s_waitcnt vmcnt(0) lgkmcnt(0)" ::: "memory"); ATT_BAR();
        if (i + 1 < nb) att_stage<8>(kb, msrc(pos0 + 64, 0), rc, wid);
        if (active) att_pv<2, 128>(vb, L, pf, o);
    }
    float lt = lsum + __shfl_xor(lsum, 32);
    const int npick = own < 3 ? own : 3;
    const size_t row = (size_t)bh * SEQ + tw + q;
#pragma unroll 1
    for (int sI = 0; sI < npick; ++sI) {
        lt += p.mpl[(size_t)sI * 131072 + row];
        const bf16_t* pp = moba_part(p, sI, row) + 4 * hh;
#pragma unroll
        for (int dt = 0; dt < 2; ++dt)
#pragma unroll
            for (int rq = 0; rq < 4; ++rq) {
                const u32x2 w = *(const u32x2*)(pp + 32 * dt + 8 * rq);
                o[dt][4 * rq] += __uint_as_float(w[0] << 16); o[dt][4 * rq + 1] += __uint_as_float(w[0] & 0xffff0000u);
                o[dt][4 * rq + 2] += __uint_as_float(w[1] << 16); o[dt][4 * rq + 3] += __uint_as_float(w[1] & 0xffff0000u);
            }
    }
    const float inv = 1.0f / lt;
    bf16_t* op = p.o + rowq * DM + 512 + h * 64 + 4 * hh;
    ATT_STORE_O(op, o, inv);
}
__device__ __forceinline__ void st_moba_own(const P& p, int wg, int nwg, LDSP char* lds) {
    const int tid0 = otid();
    for (int item = wg; item < 1024; item += nwg) moba_own_item(p, item, lds, tid0);
}
#define A0_PRE 62736
__device__ __forceinline__ void st_attn0(const P& p, LDSP char* lds) {
    const int tid0 = otid();
    LDSP int* slot = (LDSP int*)(lds + A0_SLOT); LDSP int* pre = (LDSP int*)(lds + A0_PRE);
    LDSP int* tmp = (LDSP int*)lds;
    for (int i = tid0; i < 496; i += 256) { const int bh = i / 31, j = i - bh * 31; tmp[i] = (p.mcnt[bh * 32 + j] + 127) >> 7; }
    __syncthreads();
    for (int i = tid0; i < 497; i += 256) { int s = 0; for (int k = 0; k < i; ++k) s += tmp[k]; pre[i] = s; }
    __syncthreads();
    const int ninv = pre[496];
    for (;;) {
        const int item = wq_next(p.wq + 1, slot, tid0);
        const int ntail = 5 * 768 + (ninv > 3072 ? ninv - 3072 : 0);
        if (item >= 1024 + ntail) break;
        if (item < 1024) nsa_item(p, item, lds, tid0);
        else {
            const int r = item - 1024, g = r / 5, ps = r - g * 5;
            if (g < 768 && ps == 4) { moe_conv_item(p, 0, g, lds, tid0); continue; }
            const int idx = (g < 768) ? g * 4 + ps : 3072 + (r - 5 * 768);
            if (idx >= ninv) continue;
            int lo = 0, hi = 495;
            while (lo < hi) { const int mid = (lo + hi + 1) >> 1; if (pre[mid] <= idx) lo = mid; else hi = mid - 1; }
            moba_inv_item(p, lo, idx - pre[lo], lds, tid0);
        }
    }
}

#define XB_TMO      128
#define XB_XCNT(j)  (256  + 64 * (j))
#define XB_XSUB(j)  (1280 + 64 * (j))
#define XB_XGEN(j)  (2304 + 64 * (j))
#define XB_TOP      3328
#define XB_TOPGEN   3392
#define XCD_BAR_WORDS 3456
#define XB_SPIN_CAP (1u << 20)
#define LAS __attribute__((address_space(3)))

__device__ __forceinline__ unsigned xb_ld(unsigned* p)              { return __hip_atomic_load(p, __ATOMIC_RELAXED, __HIP_MEMORY_SCOPE_AGENT); }
__device__ __forceinline__ unsigned xb_add(unsigned* p, unsigned v) { return __hip_atomic_fetch_add(p, v, __ATOMIC_RELAXED, __HIP_MEMORY_SCOPE_AGENT); }
__device__ __forceinline__ unsigned xb_xcc_id() { return (unsigned)__builtin_amdgcn_s_getreg((3 << 11) | 20) & 0xFu; }
#define XB_SPIN(cond, bar) do { unsigned _sp = 0; while (cond) { __builtin_amdgcn_s_sleep(1); \
    if ((++_sp & 255u) == 0u) { if (xb_ld(&(bar)[XB_TMO])) break; if (_sp > XB_SPIN_CAP) { atomicAdd(&(bar)[XB_TMO], 1u); break; } } } } while (0)

struct XcdBarrier {
    unsigned* bar; unsigned x;
    volatile LAS unsigned* st;
};

__device__ __forceinline__ XcdBarrier xcd_barrier_post(unsigned* bar, volatile LAS unsigned* st) {
    XcdBarrier b; b.bar = bar; b.x = xb_xcc_id(); b.st = st;
    if (threadIdx.x == 0) (void)xb_add(&bar[XB_XCNT(b.x)], 1u);
    return b;
}
__device__ __forceinline__ void xcd_barrier_complete(unsigned* bar, unsigned x, unsigned& nloc, unsigned& nx) {
    const unsigned G = gridDim.x * gridDim.y * gridDim.z;
    unsigned sum, cnt, mine, sp = 0u;
    for (;;) {
        sum = 0u; cnt = 0u; mine = 0u;
#pragma unroll
        for (unsigned j = 0; j < 16; ++j) { const unsigned c = xb_ld(&bar[XB_XCNT(j)]); sum += c; cnt += (c > 0u) ? 1u : 0u; mine = (j == x) ? c : mine; }
        if (sum == G) break;
        __builtin_amdgcn_s_sleep(1);
        if ((++sp & 255u) == 0u) { if (xb_ld(&bar[XB_TMO])) break; if (sp > XB_SPIN_CAP) { atomicAdd(&bar[XB_TMO], 1u); break; } }
    }
    nloc = mine > 0u ? mine : 1u; nx = cnt > 0u ? cnt : 1u;
}

__device__ __forceinline__ void xcd_barrier(const XcdBarrier& b) {
    asm volatile("s_waitcnt vmcnt(0)" ::: "memory");
    __syncthreads();
    if (threadIdx.x == 0) {
        unsigned* bar = b.bar;
        __builtin_amdgcn_s_waitcnt(0);
        unsigned nloc = b.st[0], nx = b.st[1];
        if (nloc == 0u) { xcd_barrier_complete(bar, b.x, nloc, nx); b.st[0] = nloc; b.st[1] = nx; }
        const unsigned old = xb_add(&bar[XB_XSUB(b.x)], 1u);
        const unsigned gen = old / nloc;
        if (old + 1u == (gen + 1u) * nloc) {
            __builtin_amdgcn_fence(__ATOMIC_RELEASE, "agent");
            asm volatile("s_waitcnt vmcnt(0)" ::: "memory");
            const unsigned og = xb_add(&bar[XB_TOP], 1u);
            const unsigned tg = og / nx;
            if (og + 1u == (tg + 1u) * nx) xb_add(&bar[XB_TOPGEN], 1u);
            else XB_SPIN(xb_ld(&bar[XB_TOPGEN]) == tg, bar);
            __builtin_amdgcn_fence(__ATOMIC_ACQUIRE, "agent");
            xb_add(&bar[XB_XGEN(b.x)], 1u);
            asm volatile("s_waitcnt vmcnt(0)" ::: "memory");
        } else {
            XB_SPIN(xb_ld(&bar[XB_XGEN(b.x)]) == gen, bar);
            __builtin_amdgcn_fence(__ATOMIC_ACQUIRE, "agent");
            asm volatile("s_waitcnt vmcnt(0)" ::: "memory");
        }
    }
    __syncthreads();
}


#define PHASE_SYNC() do { PP qb_ = (PP)__builtin_amdgcn_kernarg_segment_ptr(); asm volatile("" : "+s"(qb_)); XcdBarrier b_; b_.bar = qb_->bar; b_.x = xb_xcc_id(); \
        b_.st = (volatile LAS unsigned*)(dlds + BAR_LDS_OFF); xcd_barrier(b_); } while (0)
typedef const __attribute__((address_space(4))) P* PP;
#define PHASE_ARGS() PP q_ = (PP)__builtin_amdgcn_kernarg_segment_ptr(); int wg = blockIdx.x, nwg = gridDim.x; asm volatile("" : "+s"(q_), "+s"(wg), "+s"(nwg)); P p; { const __attribute__((address_space(4))) unsigned long long* s64_ = (const __attribute__((address_space(4))) unsigned long long*)q_; unsigned long long* d64_ = (unsigned long long*)&p; _Pragma("unroll") for (int i_ = 0; i_ < (int)(sizeof(P) / 8); ++i_) d64_[i_] = s64_[i_]; } float* sm = (float*)dlds; LDSP char* lds = (LDSP char*)dlds; (void)sm; (void)lds
__global__ void __launch_bounds__(256, 2) k_mega(P pk) {
    extern __shared__ __attribute__((aligned(16))) unsigned char dlds[];
    if (threadIdx.x == 0) *(uint4*)(dlds + BAR_LDS_OFF) = make_uint4(0u, 0u, 0u, 0u);
    __syncthreads();
    (void)xcd_barrier_post(pk.bar, (volatile LAS unsigned*)(dlds + BAR_LDS_OFF));
    { PHASE_ARGS(); st_prologue(p, wg, nwg, sm); st_convert(p, wg, nwg, sm); } PHASE_SYNC();
    { PHASE_ARGS(); st_norm<0>(p, 0, wg, nwg, sm); st_c1_reduce(p, wg, nwg); } PHASE_SYNC();
    { PHASE_ARGS(); st_inproj0_mf<5>(p, wg, nwg, lds); } PHASE_SYNC();
    { PHASE_ARGS(); st_cmp1_mf(p, wg, nwg, lds); st_kmean(p, wg, nwg, sm); } PHASE_SYNC();
    { PHASE_ARGS(); st_cmp2_mf(p, wg, nwg, lds); st_moba_gate(p, wg, nwg, lds); } PHASE_SYNC();
    { PHASE_ARGS(); st_attn0(p, lds); } PHASE_SYNC();
    { PHASE_ARGS(); st_moba_own(p, wg, nwg, lds); } PHASE_SYNC();
    { PHASE_ARGS(); st_outproj_mf<4>(p, 0, wg, nwg, lds); } PHASE_SYNC();
    { PHASE_ARGS(); st_norm<1>(p, 0, wg, nwg, sm); } PHASE_SYNC();
    { PHASE_ARGS(); st_moe_up_mf<5>(p, 0, wg, nwg, lds); } PHASE_SYNC();
    { PHASE_ARGS(); st_moe_down_mf<5>(p, 0, wg, nwg, lds); } PHASE_SYNC();
    { PHASE_ARGS(); st_norm<2>(p, 1, wg, nwg, sm); } PHASE_SYNC();
    { PHASE_ARGS(); st_inproj1_mf<4>(p, wg, nwg, lds); } PHASE_SYNC();
    { PHASE_ARGS(); st_mla_prep(p, wg, nwg); } PHASE_SYNC();
    { PHASE_ARGS(); st_mla_up_mf(p, wg, nwg, lds); } PHASE_SYNC();
    { PHASE_ARGS(); st_attn1(p, lds); } PHASE_SYNC();
    { PHASE_ARGS(); st_mla_combine(p, wg, nwg); } PHASE_SYNC();
    { PHASE_ARGS(); st_outproj_mf<4>(p, 1, wg, nwg, lds); } PHASE_SYNC();
    { PHASE_ARGS(); st_norm<1>(p, 1, wg, nwg, sm); } PHASE_SYNC();
    { PHASE_ARGS(); st_moe_up_mf<5>(p, 1, wg, nwg, lds); } PHASE_SYNC();
    { PHASE_ARGS(); st_moe_down_mf<5>(p, 1, wg, nwg, lds); } PHASE_SYNC();
    { PHASE_ARGS(); st_norm<3>(p, 1, wg, nwg, sm); }
}

extern "C" void kernel_launch(void* const* d_in, const int* in_sizes, int n_in, void* d_out, int out_size, void* d_ws, size_t ws_size,
                              hipStream_t stream) {
    (void)in_sizes; (void)n_in; (void)out_size; (void)ws_size;
    P p{};
    const float* const* in = (const float* const*)d_in;
    p.x = in[0]; p.c = in[1]; p.rel = in[2]; p.router_w = in[3]; p.router_b = in[4]; p.final_norm = in[5]; p.norm_mix = in[6]; p.norm_ffn = in[7];
    p.ada_w = in[8]; p.ada_b = in[9]; p.moe_wg = in[10]; p.moe_wu = in[11]; p.moe_wd = in[12]; p.ev_w_in = in[13]; p.ev_w_out = in[14];
    p.pos_k = in[15]; p.pos_v = in[16]; p.ck_w1 = in[17]; p.ck_w2 = in[18]; p.cv_w1 = in[19]; p.cv_w2 = in[20]; p.od_w_in = in[21]; p.od_w_out = in[22];
    p.q_norm = in[23]; p.kv_norm = in[24]; p.w_q_up = in[25]; p.w_kv_up = in[26]; p.sinks = in[27];
    p.out = (float*)d_out;
    char* ws = (char*)d_ws; size_t off = 0;
    auto take = [&](size_t bytes) { char* r = ws + off; off += (bytes + 255) & ~(size_t)255; return r; };
    p.bar = (unsigned*)take(16384);
    p.cnt = (int*)take(4096);
    p.wq = (int*)take(256);
    p.mcnt = (int*)take(512 * 4);
    p.modv = (float*)take(2 * 2 * 6144 * 4);
    p.zrow = (bf16_t*)take(256);
    const size_t zero_bytes = off;
    p.ropec = (float*)take(SEQ * 32 * 4); p.ropes = (float*)take(SEQ * 32 * 4);
    p.blut = (float*)take(8 * 1024 * 4);
    p.gates = (float*)take((size_t)T_TOK * 24 * 4);
    p.kmean = (float*)take(2 * 8 * 32 * 64 * 4);
    p.tokw = (float*)take((size_t)T_TOK * 2 * 4);
    p.list = (int*)take((size_t)16 * T_TOK * 4);
    p.cqn = (bf16_t*)take((size_t)T_TOK * 384 * 2);
    p.krope = (bf16_t*)take((size_t)T_TOK * 64 * 2);
    p.h = (bf16_t*)take((size_t)T_TOK * DM * 2);
    p.o = (bf16_t*)take((size_t)T_TOK * DM * 2);
    p.mlap = p.h;
    p.mlal = (float*)(p.h + (size_t)2 * 8 * (SEQ / 2) * 128);
    p.mp01 = p.h;
    p.mp2 = (bf16_t*)take((size_t)131072 * 64 * 2);
    p.mpl = (float*)take((size_t)3 * 131072 * 4);
    p.mlist = (unsigned short*)take((size_t)16 * 32 * 8192 * 2);
    p.hid = p.o;
    char* region = take((size_t)100 * 1024 * 1024);
    p.proj = (bf16_t*)region;
    p.proj1 = (bf16_t*)region;
    p.qmla = (bf16_t*)(region + (size_t)T_TOK * 1216 * 2);
    p.kvmla = (bf16_t*)(region + (size_t)T_TOK * (1216 + 768) * 2);
    p.y = (bf16_t*)region;
    p.chidb = (bf16_t*)take((size_t)2 * 2048 * 256 * 2);
    p.kcmpb = (bf16_t*)take((size_t)8 * 512 * 64 * 2);
    p.kmeanb = (bf16_t*)take((size_t)2 * 8 * 32 * 64 * 2);
    p.c1 = (float*)take(512 * 4);
    p.c1p = (float*)take((size_t)2 * 64 * 256 * 4);
    p.wt_gu = (bf16_t*)take((size_t)32 * 1024 * 1024 * 2);
    p.wt_d = (bf16_t*)take((size_t)32 * 1024 * 512 * 2);
    p.wt_in0 = (bf16_t*)take((size_t)2840 * 1024 * 2);
    p.wt_out0 = (bf16_t*)take((size_t)1024 * 1024 * 2);
    p.wt_c1 = (bf16_t*)take((size_t)2 * 256 * 2048 * 2);
    p.wt_c2 = (bf16_t*)take((size_t)2 * 64 * 256 * 2);
    p.wt_in1 = (bf16_t*)take((size_t)1216 * 1024 * 2);
    p.wt_out1 = (bf16_t*)take((size_t)1024 * 1024 * 2);
    p.wt_qup = (bf16_t*)take((size_t)768 * 256 * 2);
    p.wt_kvup = (bf16_t*)take((size_t)1024 * 128 * 2);
    static int grid = 0;
    if (!grid) {
        int dev = 0, cus = 0, per_cu = 0;
        (void)hipGetDevice(&dev);
        (void)hipDeviceGetAttribute(&cus, hipDeviceAttributeMultiprocessorCount, dev);
        (void)hipFuncSetAttribute((const void*)k_mega, hipFuncAttributeMaxDynamicSharedMemorySize, KERNEL_LDS_BYTES);
        (void)hipOccupancyMaxActiveBlocksPerMultiprocessor(&per_cu, k_mega, 256, KERNEL_LDS_BYTES);
        if (cus <= 0) cus = 256;
        if (per_cu < 1) per_cu = 1;
        grid = cus * (per_cu < 2 ? per_cu : 2);
    }
    (void)hipMemsetAsync(d_ws, 0, zero_bytes, stream);
    hipLaunchKernelGGL(k_mega, dim3(grid), dim3(256), KERNEL_LDS_BYTES, stream, p);
}
```

```cpp
#include <hip/hip_runtime.h>
#include <stdint.h>

#define T_TOK 16384
#define SEQ 8192
#define DM 1024
#define NEGF (-1e30f)
#define BIGF (1e30f)

typedef unsigned short bf16_t;

__device__ __forceinline__ float bf2f(bf16_t v) { return __uint_as_float(((unsigned)v) << 16); }
__device__ __forceinline__ bf16_t f2bf(float f) {
    unsigned u = __float_as_uint(f);
    u += 0x7fffu + ((u >> 16) & 1u);
    return (bf16_t)(u >> 16);
}
typedef __bf16 bf16x2_t __attribute__((ext_vector_type(2)));
typedef float f32x2_t __attribute__((ext_vector_type(2)));
__device__ __forceinline__ unsigned cvtpk(float lo, float hi) { const f32x2_t f = {lo, hi}; return __builtin_bit_cast(unsigned, __builtin_convertvector(f, bf16x2_t)); }
__device__ __forceinline__ unsigned cvtpk_valu(float lo, float hi) { unsigned r; asm("s_nop 0\n\tv_cvt_pk_bf16_f32 %0, %1, %2" : "=v"(r) : "v"(lo), "v"(hi)); return r; }
__device__ __forceinline__ float wsum(float v) {
#pragma unroll
    for (int o = 32; o > 0; o >>= 1) v += __shfl_xor(v, o);
    return v;
}
__device__ __forceinline__ float siluf(float v) { return v / (1.0f + __expf(-v)); }
__device__ __forceinline__ float sigmf(float v) { return 1.0f / (1.0f + __expf(-v)); }
__device__ __forceinline__ float gelu_tanh(float x) {
    const float k0 = 0.7978845608028654f, k1 = 0.044715f;
    float u = k0 * (x + k1 * x * x * x);
    return 0.5f * x * (1.0f + tanhf(u));
}
__device__ __forceinline__ int rel_bucket(int d) {
    if (d < 16) return d < 0 ? 0 : d;
    int b = 16;
    b += (d >= 21); b += (d >= 27); b += (d >= 35); b += (d >= 46); b += (d >= 59); b += (d >= 77); b += (d >= 99); b += (d >= 128);
    b += (d >= 166); b += (d >= 216); b += (d >= 280); b += (d >= 363); b += (d >= 470); b += (d >= 609); b += (d >= 790);
    return b;
}

__device__ __forceinline__ int otid() { int t = threadIdx.x; asm volatile("" : "+v"(t)); return t; }

struct P {
    const float *x, *c, *rel, *router_w, *router_b, *final_norm, *norm_mix, *norm_ffn, *ada_w, *ada_b, *moe_wg, *moe_wu, *moe_wd,
        *ev_w_in, *ev_w_out, *pos_k, *pos_v, *ck_w1, *ck_w2, *cv_w1, *cv_w2, *od_w_in, *od_w_out, *q_norm, *kv_norm, *w_q_up, *w_kv_up, *sinks;
    float* out;
    unsigned* bar; int* cnt;
    float *modv, *ropec, *ropes, *blut, *gates, *kcmp, *vcmp, *chid, *kmean, *tokw;
    bf16_t *h, *proj, *o, *hid, *y, *proj1, *qmla, *kvmla, *krope, *cqn;
    int* list;
    bf16_t *wt_gu, *wt_d, *wt_in0, *wt_out0, *wt_c1, *wt_c2, *wt_in1, *wt_out1, *wt_qup, *wt_kvup, *chidb;
    float *c1, *c1p;
    int* wq;
    bf16_t* zrow;
    bf16_t *kcmpb, *kmeanb, *mlap;
    float* mlal;
    int* mcnt; unsigned short* mlist; bf16_t *mp01, *mp2; float* mpl;
};


__device__ __forceinline__ void st_prologue(const P& p, int wg, int nwg, float* sm) {
    const int TIDX = otid();
    const int tid = TIDX;
    {
        for (int i = tid; i < 2048; i += 256) sm[i] = siluf(p.c[i]);
        __syncthreads();
        const int wid = tid >> 6, lane = tid & 63;
        for (int w = wg; w < 192; w += nwg) {
            const int l = w / 96, cg = w % 96, col = cg * 64 + lane;
            const float* W = p.ada_w + (size_t)l * 1024 * 6144 + (size_t)(wid * 256) * 6144 + col;
            float a0 = 0.f, a1 = 0.f;
#pragma unroll 32
            for (int k = 0; k < 256; ++k) { const float wv = W[(size_t)k * 6144]; a0 += sm[wid * 256 + k] * wv; a1 += sm[1024 + wid * 256 + k] * wv; }
            sm[2048 + tid] = a0; sm[2304 + tid] = a1;
            __syncthreads();
            if (tid < 64) {
                const float bb = p.ada_b[l * 6144 + col];
                p.modv[(l * 2 + 0) * 6144 + col] = ((sm[2048 + tid] + sm[2048 + 64 + tid]) + (sm[2048 + 128 + tid] + sm[2048 + 192 + tid])) + bb;
                p.modv[(l * 2 + 1) * 6144 + col] = ((sm[2304 + tid] + sm[2304 + 64 + tid]) + (sm[2304 + 128 + tid] + sm[2304 + 192 + tid])) + bb;
            }
            __syncthreads();
        }
        __syncthreads();
    }
    for (int i = wg * 256 + tid; i < SEQ * 32; i += nwg * 256) {
        const int t = i >> 5, j = i & 31;
        const float inv = powf(10000.0f, -(float)(2 * j) / 64.0f);
        const float ang = (float)t * inv;
        p.ropec[i] = cosf(ang); p.ropes[i] = sinf(ang);
    }
    for (int i = wg * 256 + tid; i < 8 * 1024; i += nwg * 256) { const int h = i >> 10, d = i & 1023; p.blut[i] = p.rel[rel_bucket(d) * 8 + h]; }
}

#define RT_OFF 1024
template <int MODE>
__device__ __forceinline__ void st_norm(const P& p, int layer, int wg, int nwg, float* sm) {
    const int TIDX = otid();
    const int wid = TIDX >> 6, lane = TIDX & 63;
    int* rl_cnt = (int*)sm; int* rl_base = rl_cnt + 16; int* rl_ent = rl_cnt + 32;
    if (MODE == 1) {
        if (TIDX < 16) rl_cnt[TIDX] = 0;
        for (int i = TIDX; i < 64; i += 256) rl_ent[i] = -1;
        for (int idx = TIDX; idx < 4096; idx += 256) {
            const int col = idx >> 2, q = idx & 3;
            *(float4*)((char*)sm + RT_OFF + q * 16384 + (col & 3) * 4096 + ((col >> 8) * 64 + ((col >> 2) & 63)) * 16) = *(const float4*)(p.router_w + idx * 4);
        }
        __syncthreads();
    }
    const int niter = (T_TOK + nwg * 4 - 1) / (nwg * 4);
    const float* xin = (MODE == 0) ? p.x : p.out;
    float4 pre4[4];
    {
        const int row0 = wg * 4 + wid;
#pragma unroll
        for (int i = 0; i < 4; ++i) pre4[i] = (row0 < T_TOK) ? *(const float4*)(xin + (size_t)row0 * DM + i * 256 + lane * 4) : make_float4(0.f, 0.f, 0.f, 0.f);
    }
    for (int it = 0; it < niter; ++it) {
        const int row = wg * 4 + wid + it * nwg * 4;
        if (MODE != 1 && row >= T_TOK) break;
        float v[16];
#pragma unroll
        for (int i = 0; i < 4; ++i) { v[i * 4 + 0] = pre4[i].x; v[i * 4 + 1] = pre4[i].y; v[i * 4 + 2] = pre4[i].z; v[i * 4 + 3] = pre4[i].w; }
        {
            const int rown = row + nwg * 4;
            if (rown < T_TOK) {
#pragma unroll
                for (int i = 0; i < 4; ++i) pre4[i] = *(const float4*)(xin + (size_t)rown * DM + i * 256 + lane * 4);
            }
        }
        if (MODE != 1 || row < T_TOK) {
        const int b = row >> 13;
        if (MODE >= 2) {
            const int lp = (MODE == 2) ? layer - 1 : 1;
            const float* gf = p.modv + (size_t)(lp * 2 + b) * 6144 + 5 * 1024;
#pragma unroll
            for (int i = 0; i < 4; ++i)
#pragma unroll
                for (int j = 0; j < 4; ++j) {
                    const int col = i * 256 + lane * 4 + j;
                    const float y0 = bf2f(p.y[(size_t)(2 * row) * DM + col]), y1 = bf2f(p.y[(size_t)(2 * row + 1) * DM + col]);
                    v[i * 4 + j] += gf[col] * (y0 + y1);
                }
            if (MODE == 2) {
#pragma unroll
                for (int i = 0; i < 4; ++i)
                    *(float4*)(p.out + (size_t)row * DM + i * 256 + lane * 4) = make_float4(v[i * 4], v[i * 4 + 1], v[i * 4 + 2], v[i * 4 + 3]);
            }
        }
        float ss = 0.f;
#pragma unroll
        for (int i = 0; i < 16; ++i) ss += v[i] * v[i];
        ss = wsum(ss);
        const float r = rsqrtf(ss * (1.0f / 1024.0f) + 1e-6f);
        if (MODE == 3) {
#pragma unroll
            for (int i = 0; i < 4; ++i) {
                const float4 g4 = *(const float4*)(p.final_norm + i * 256 + lane * 4);
                *(float4*)(p.out + (size_t)row * DM + i * 256 + lane * 4) =
                    make_float4(v[i * 4] * r * g4.x, v[i * 4 + 1] * r * g4.y, v[i * 4 + 2] * r * g4.z, v[i * 4 + 3] * r * g4.w);
            }
            continue;
        }
        const float* g = ((MODE == 1) ? p.norm_ffn : p.norm_mix) + layer * 1024;
        const float* mv = p.modv + (size_t)(layer * 2 + b) * 6144;
        const float* shift = mv + ((MODE == 1) ? 3 : 0) * 1024;
        const float* scale = mv + ((MODE == 1) ? 4 : 1) * 1024;
        float hv[16];
#pragma unroll
        for (int i = 0; i < 4; ++i)
#pragma unroll
            for (int j = 0; j < 4; ++j) {
                const int col = i * 256 + lane * 4 + j;
                hv[i * 4 + j] = v[i * 4 + j] * r * g[col] * (1.0f + scale[col]) + shift[col];
                p.h[(size_t)row * DM + col] = f2bf(hv[i * 4 + j]);
            }
        if (MODE == 1) {
            float lg[16];
#pragma unroll
            for (int e = 0; e < 16; ++e) lg[e] = 0.f;
#pragma unroll
            for (int i = 0; i < 4; ++i)
#pragma unroll
                for (int j = 0; j < 4; ++j) {
                    const char* rw = (const char*)sm + RT_OFF + lane * 16 + j * 4096 + i * 1024;
#pragma unroll
                    for (int q = 0; q < 4; ++q) {
                        const float4 w4 = *(const float4*)(rw + q * 16384);
                        lg[4 * q] += hv[i * 4 + j] * w4.x; lg[4 * q + 1] += hv[i * 4 + j] * w4.y; lg[4 * q + 2] += hv[i * 4 + j] * w4.z; lg[4 * q + 3] += hv[i * 4 + j] * w4.w;
                    }
                    asm volatile("" ::: "memory");
                }
#pragma unroll
            for (int e = 0; e < 16; ++e) lg[e] = wsum(lg[e]);
            float aff[16], bi[16];
#pragma unroll
            for (int e = 0; e < 16; ++e) { aff[e] = 1.0f / (1.0f + expf(-lg[e])); bi[e] = aff[e] + p.router_b[e]; }
            float bestsc = -3e38f; int be0 = 0, be1 = 1; float bw0 = 0.f, bw1 = 0.f;
#pragma unroll
            for (int gI = 0; gI < 4; ++gI) {
                int i1 = 0; float m1 = bi[gI * 4];
#pragma unroll
                for (int i = 1; i < 4; ++i) if (bi[gI * 4 + i] > m1) { m1 = bi[gI * 4 + i]; i1 = i; }
                int i2 = -1; float m2 = -3e38f;
#pragma unroll
                for (int i = 0; i < 4; ++i) if (i != i1 && bi[gI * 4 + i] > m2) { m2 = bi[gI * 4 + i]; i2 = i; }
                const float sc = m1 + m2;
                float a1 = 0.f, a2 = 0.f;
#pragma unroll
                for (int i = 0; i < 4; ++i) { a1 = (i == i1) ? aff[gI * 4 + i] : a1; a2 = (i == i2) ? aff[gI * 4 + i] : a2; }
                if (sc > bestsc) { bestsc = sc; be0 = gI * 4 + i1; be1 = gI * 4 + i2; bw0 = a1; bw1 = a2; }
            }
            if (lane == 0) {
                const float ws = bw0 + bw1;
                p.tokw[row * 2] = bw0 / ws; p.tokw[row * 2 + 1] = bw1 / ws;
                const int s_ = (it & 7) * 4 + wid;
                const int r0 = atomicAdd(&rl_cnt[be0], 1), r1 = atomicAdd(&rl_cnt[be1], 1);
                rl_ent[s_ * 2] = (row << 12) | (be0 << 8) | r0;
                rl_ent[s_ * 2 + 1] = (row << 12) | (be1 << 8) | r1;
            }
        }
        }
        if (MODE == 1 && ((it & 7) == 7 || it == niter - 1)) {
            __syncthreads();
            if (TIDX < 16) { const int c = rl_cnt[TIDX]; rl_base[TIDX] = c ? atomicAdd(&p.cnt[(layer * 16 + TIDX) * 32], c) : 0; rl_cnt[TIDX] = 0; }
            __syncthreads();
            if (TIDX < 64) {
                const int en = rl_ent[TIDX];
                if (en >= 0) { const int e = (en >> 8) & 15; p.list[e * T_TOK + rl_base[e] + (en & 255)] = (en >> 12) * 2 + (TIDX & 1); rl_ent[TIDX] = -1; }
            }
            __syncthreads();
        }
    }
}

__device__ __forceinline__ void st_kmean(const P& p, int wg, int nwg, float* sm) {
    const int TIDX = otid();
    const int wid = TIDX >> 6, lane = TIDX & 63;
    for (int w = wg; w < 2 * 8 * 32; w += nwg) {
        const int b = w >> 8, h = (w >> 5) & 7, j = w & 31;
        const bf16_t* kp = p.proj + (size_t)(b * SEQ + j * 256 + wid * 64) * 2840 + 1816 + h * 64 + lane;
        float s = 0.f;
#pragma unroll 16
        for (int i = 0; i < 64; ++i) s += bf2f(kp[(size_t)i * 2840]);
        __syncthreads();
        sm[TIDX] = s;
        __syncthreads();
        if (TIDX < 64) {
            const float m = ((sm[TIDX] + sm[64 + TIDX]) + (sm[128 + TIDX] + sm[192 + TIDX])) * (1.0f / 256.0f);
            p.kmean[(size_t)w * 64 + TIDX] = m;
            p.kmeanb[(size_t)w * 64 + TIDX] = f2bf(m);
        }
    }
}
__device__ __forceinline__ void st_mla_prep(const P& p, int wg, int nwg) {
    const int TIDX = otid();
    const int wid = TIDX >> 6, lane = TIDX & 63;
    for (int row = wg * 4 + wid; row < T_TOK; row += nwg * 4) {
        const int t = row & (SEQ - 1);
        const bf16_t* pr = p.proj1 + (size_t)row * 1216;
        float q[4], ss = 0.f;
#pragma unroll
        for (int i = 0; i < 4; ++i) { q[i] = bf2f(pr[i * 64 + lane]); ss += q[i] * q[i]; }
        ss = wsum(ss);
        float r = rsqrtf(ss * (1.0f / 256.0f) + 1e-6f);
#pragma unroll
        for (int i = 0; i < 4; ++i) p.cqn[(size_t)row * 384 + i * 64 + lane] = f2bf(q[i] * r * p.q_norm[i * 64 + lane]);
        float kvv[2]; ss = 0.f;
#pragma unroll
        for (int i = 0; i < 2; ++i) { kvv[i] = bf2f(pr[256 + i * 64 + lane]); ss += kvv[i] * kvv[i]; }
        ss = wsum(ss);
        r = rsqrtf(ss * (1.0f / 128.0f) + 1e-6f);
#pragma unroll
        for (int i = 0; i < 2; ++i) p.cqn[(size_t)row * 384 + 256 + i * 64 + lane] = f2bf(kvv[i] * r * p.kv_norm[i * 64 + lane]);
        if (lane < 32) {
            const float x1 = bf2f(pr[384 + lane]), x2 = bf2f(pr[384 + 32 + lane]);
            const float cs = p.ropec[t * 32 + lane], sn = p.ropes[t * 32 + lane];
            p.krope[(size_t)row * 64 + lane] = f2bf(x1 * cs - x2 * sn);
            p.krope[(size_t)row * 64 + 32 + lane] = f2bf(x1 * sn + x2 * cs);
        }
    }
}


typedef short bf16x8 __attribute__((ext_vector_type(8)));
typedef float f32x4 __attribute__((ext_vector_type(4)));
typedef unsigned u32x2 __attribute__((ext_vector_type(2)));
typedef unsigned u32x4v __attribute__((ext_vector_type(4)));
#define LDSP __attribute__((address_space(3)))
#define GEMM_LDS_BYTES 81920
#define KERNEL_LDS_BYTES 81920
#define BAR_LDS_OFF (KERNEL_LDS_BYTES - 16)

__device__ __forceinline__ unsigned pack_bf16(float lo, float hi) { return cvtpk(lo, hi); }

template <int MF, class AR, class BR, class Epi, class NX>
__device__ __forceinline__ void gemm128x(const int nk, const size_t akstep, const size_t bkstep, AR arow, BR brow, Epi epi, LDSP char* lds, const int tid, const bool staged, NX next) {
    constexpr int SS = MF * 4096 + 16384, BO = MF * 4096;
    const int wid = tid >> 6, lane = tid & 63, wr = wid >> 1, wc = wid & 1, fr = lane & 15, fq = lane >> 4;
    const int srow = tid >> 3, gch = ((tid & 7) ^ (srow & 7)) * 8;
    const bf16_t* ap[MF]; const bf16_t* bp[4];
#pragma unroll
    for (int i = 0; i < MF; ++i) ap[i] = arow(32 * i + srow) + gch;
#pragma unroll
    for (int i = 0; i < 4; ++i) bp[i] = brow(32 * i + srow) + gch;
    LDSP char* lw = lds + wid * 1024;
#define G128_ISSUE(st, kt) do { LDSP char* la_ = lw + (st) * SS; const size_t ao_ = (size_t)(kt) * akstep, bo_ = (size_t)(kt) * bkstep; \
        _Pragma("unroll") for (int i_ = 0; i_ < MF; ++i_) __builtin_amdgcn_global_load_lds((const unsigned*)(ap[i_] + ao_), (LDSP unsigned*)(la_ + 4096 * i_), 16, 0, 0); \
        _Pragma("unroll") for (int i_ = 0; i_ < 4; ++i_) __builtin_amdgcn_global_load_lds((const unsigned*)(bp[i_] + bo_), (LDSP unsigned*)(la_ + BO + 4096 * i_), 16, 0, 0); } while (0)
    f32x4 acc[MF][4];
#pragma unroll
    for (int m = 0; m < MF; ++m)
#pragma unroll
        for (int n = 0; n < 4; ++n) acc[m][n] = (f32x4){0.f, 0.f, 0.f, 0.f};
    const int aoff = (wr * 16 * MF + fr) * 128, boff = BO + (wc * 64 + fr) * 128, c0 = (fq ^ (fr & 7)) * 16;
    if (!staged) G128_ISSUE(0, 0);
    for (int kt = 0; kt < nk; ++kt) {
        const int cur = kt & 1;
        asm volatile("s_waitcnt vmcnt(0)" ::: "memory");
        __builtin_amdgcn_s_barrier();
        asm volatile("" ::: "memory");
        LDSP char* sb = lds + cur * SS;
        constexpr int NG = 2 * MF, PD = 3;
        bf16x8 af[NG], bf[2][4];
#define G128_AF(s_) (*(const LDSP bf16x8*)(sb + aoff + ((s_) % MF) * 2048 + (((s_) / MF) ? (c0 ^ 64) : c0)))
#pragma unroll
        for (int n = 0; n < 4; ++n) bf[0][n] = *(const LDSP bf16x8*)(sb + boff + n * 2048 + c0);
#pragma unroll
        for (int s = 0; s < PD; ++s) af[s] = G128_AF(s);
        __builtin_amdgcn_sched_barrier(0);
        if (kt + 1 < nk) G128_ISSUE(cur ^ 1, kt + 1);
        __builtin_amdgcn_sched_barrier(0);
#pragma unroll
        for (int s = 0; s < NG; ++s) {
            if (s + PD < NG) af[s + PD] = G128_AF(s + PD);
            if (s == MF - PD) {
#pragma unroll
                for (int n = 0; n < 4; ++n) bf[1][n] = *(const LDSP bf16x8*)(sb + boff + n * 2048 + (c0 ^ 64));
            }
#pragma unroll
            for (int n = 0; n < 4; ++n) acc[s % MF][n] = __builtin_amdgcn_mfma_f32_16x16x32_bf16(bf[s / MF][n], af[s], acc[s % MF][n], 0, 0, 0);
            __builtin_amdgcn_sched_barrier(0);
        }
#undef G128_AF
    }
    asm volatile("s_waitcnt lgkmcnt(0)" ::: "memory");
    __builtin_amdgcn_s_barrier();
    asm volatile("" ::: "memory");
    next();
#undef G128_ISSUE
#pragma unroll
    for (int m = 0; m < MF; ++m) epi(wr * 16 * MF + m * 16 + fr, wc * 64 + fq * 4, acc[m], m);
}

template <int MF, class AR, class BR>
__device__ __forceinline__ void g128_stage0(AR arow, BR brow, LDSP char* lds, const int tid) {
    const int wid = tid >> 6, srow = tid >> 3, gch = ((tid & 7) ^ (srow & 7)) * 8;
    LDSP char* lw = lds + wid * 1024;
#pragma unroll
    for (int i = 0; i < MF; ++i) {
        __builtin_amdgcn_global_load_lds((const unsigned*)(arow(32 * i + srow) + gch), (LDSP unsigned*)(lw + 4096 * i), 16, 0, 0);
    }
#pragma unroll
    for (int i = 0; i < 4; ++i) {
        __builtin_amdgcn_global_load_lds((const unsigned*)(brow(32 * i + srow) + gch), (LDSP unsigned*)(lw + MF * 4096 + 4096 * i), 16, 0, 0);
    }
}
template <class AR, class BR, class Epi>
__device__ __forceinline__ void gemm128(const int nk, const size_t akstep, const size_t bkstep, AR arow, BR brow, Epi epi, LDSP char* lds, const int tid) {
    gemm128x<4>(nk, akstep, bkstep, arow, brow, epi, lds, tid, false, [] {});
}

template <int MAP> __device__ __forceinline__ int conv_rowmap(int n) {
    if (MAP == 0) return n;
    const int tile = n >> 6, cc = n & 63, wc = cc >> 5, i16 = (cc >> 4) & 1, i = cc & 15;
    return tile * 128 + wc * 64 + ((MAP == 1 ? 0 : 2) + i16) * 16 + i;
}
template <int MAP>
__device__ __forceinline__ void conv_batched(const float* src, int nmat, int K, int N, size_t sstride, bf16_t* dst, size_t dstride, int wg, int nwg, float* sm, int tid, int wend = 0x7fffffff) {
    float(*t)[65] = (float(*)[65])sm;
    const int tk = K >> 6, tn = (N + 63) >> 6, per = tk * tn, total = (nmat * per < wend) ? nmat * per : wend;
    f32x4 v[4];
    auto ld = [&](int w) {
        const int mat = w / per, r = w % per, kt = r / tn, nt = r % tn;
        const float* s = src + (size_t)mat * sstride;
#pragma unroll
        for (int i = 0; i < 4; ++i) {
            const int idx = tid + 256 * i, k = idx >> 4, n = (idx & 15) * 4;
            v[i] = (f32x4){0.f, 0.f, 0.f, 0.f};
            if (nt * 64 + n < N) v[i] = *(const f32x4*)(s + (size_t)(kt * 64 + k) * N + nt * 64 + n);
        }
    };
    if (wg < total) ld(wg);
    for (int w = wg; w < total; w += nwg) {
        const int mat = w / per, r = w % per, kt = r / tn, nt = r % tn;
        bf16_t* d = dst + (size_t)mat * dstride;
#pragma unroll
        for (int i = 0; i < 4; ++i) {
            const int idx = tid + 256 * i, k = idx >> 4, n = (idx & 15) * 4;
            t[k][n] = v[i][0]; t[k][n + 1] = v[i][1]; t[k][n + 2] = v[i][2]; t[k][n + 3] = v[i][3];
        }
        __syncthreads();
        if (w + nwg < total) ld(w + nwg);
        {
            const int n = tid >> 2, kq = (tid & 3) * 16;
            if (nt * 64 + n < N) {
                unsigned pk[8];
#pragma unroll
                for (int j = 0; j < 8; ++j) pk[j] = cvtpk(t[kq + 2 * j][n], t[kq + 2 * j + 1][n]);
                bf16_t* o = d + (size_t)conv_rowmap<MAP>(nt * 64 + n) * K + kt * 64 + kq;
                *(u32x4v*)o = (u32x4v){pk[0], pk[1], pk[2], pk[3]};
                *(u32x4v*)(o + 8) = (u32x4v){pk[4], pk[5], pk[6], pk[7]};
            }
        }
        __syncthreads();
    }
}
__device__ __forceinline__ void st_convert(const P& p, int wg, int nwg, float* sm) {
    const int tid = otid();
    conv_batched<0>(p.ev_w_in, 1, 1024, 2840, 0, p.wt_in0, 0, wg, nwg, sm, tid);
    conv_batched<0>(p.ev_w_out, 1, 1024, 1024, 0, p.wt_out0, 0, wg, nwg, sm, tid);
    conv_batched<0>(p.ck_w1, 1, 2048, 256, 0, p.wt_c1, 0, wg, nwg, sm, tid);
    conv_batched<0>(p.cv_w1, 1, 2048, 256, 0, p.wt_c1 + 256 * 2048, 0, wg, nwg, sm, tid);
    conv_batched<0>(p.ck_w2, 1, 256, 64, 0, p.wt_c2, 0, wg, nwg, sm, tid);
    conv_batched<0>(p.cv_w2, 1, 256, 64, 0, p.wt_c2 + 64 * 256, 0, wg, nwg, sm, tid);
    conv_batched<0>(p.od_w_in, 1, 1024, 1216, 0, p.wt_in1, 0, wg, nwg, sm, tid);
    conv_batched<0>(p.od_w_out, 1, 1024, 1024, 0, p.wt_out1, 0, wg, nwg, sm, tid);
    conv_batched<0>(p.w_q_up, 1, 256, 768, 0, p.wt_qup, 0, wg, nwg, sm, tid);
    conv_batched<0>(p.w_kv_up, 1, 128, 1024, 0, p.wt_kvup, 0, wg, nwg, sm, tid);
    {
        const int wid = tid >> 6, lane = tid & 63;
        for (int w = wg * 4 + wid; w < 512; w += nwg * 4) {
            const int which = w >> 8, cg = (w >> 6) & 3, ks = w & 63, col = cg * 64 + lane;
            const float* w1 = (which ? p.cv_w1 : p.ck_w1) + (size_t)(ks * 32) * 256 + col; const float* pos = (which ? p.pos_v : p.pos_k) + ks * 32;
            float a = 0.f;
#pragma unroll
            for (int k = 0; k < 32; ++k) a += pos[k] * w1[(size_t)k * 256];
            p.c1p[(which * 64 + ks) * 256 + col] = a;
        }
    }
}
__device__ __forceinline__ void st_c1_reduce(const P& p, int wg, int nwg) {
    const int tid = otid();
    for (int i = wg * 256 + tid; i < 512; i += nwg * 256) {
        const int which = i >> 8, col = i & 255;
        float a = 0.f;
#pragma unroll 16
        for (int ks = 0; ks < 64; ++ks) a += p.c1p[(which * 64 + ks) * 256 + col];
        p.c1[i] = a;
    }
}


struct XcdOrder {
    int xcd, lw, nlw, tn, per;
    __device__ __forceinline__ XcdOrder(int wg, int nwg, int nM, int tn_) : xcd(wg & 7), lw(wg >> 3), nlw(nwg >> 3), tn(tn_), per((nM >> 3) * tn_) {}
    __device__ __forceinline__ bool get(int k, int& mt, int& nt) const { const int lt = lw + k * nlw; if (lt >= per) return false; mt = xcd + 8 * (lt / tn); nt = lt % tn; return true; }
};
template <int MF>
__device__ __forceinline__ void st_inproj0_mf(const P& p, int wg, int nwg, LDSP char* lds) {
    const int tid = otid();
    const XcdOrder ord(wg, nwg, ((T_TOK + 32 * MF - 1) / (32 * MF) + 7) & ~7, 23);
    auto Af = [&](int mt_) { return [=](int r) { int row = mt_ * (32 * MF) + r; row = row < T_TOK ? row : T_TOK - 1; return p.h + (size_t)row * DM; }; };
    auto Bf = [&](int nt_) { return [=](int r) { int n = nt_ * 128 + r; n = n < 2840 ? n : 2839; return p.wt_in0 + (size_t)n * 1024; }; };
    bool staged = false;
    for (int k = 0;; ++k) {
        int mt, nt, mt2 = 0, nt2 = 0;
        if (!ord.get(k, mt, nt)) break;
        if (mt * (32 * MF) >= T_TOK) break;
        const bool has2 = ord.get(k + 1, mt2, nt2) && mt2 * (32 * MF) < T_TOK;
        const bool st_ = staged; staged = has2;
        gemm128x<MF>(16, 64, 64, Af(mt), Bf(nt),
            [&](int rl, int cl, const f32x4 (&a)[4], int mfrag) {
                const int row = mt * (32 * MF) + rl;
#pragma unroll
                for (int n = 0; n < 4; ++n) {
                    const int col = nt * 128 + cl + n * 16;
                    if (col < 2840 && row < T_TOK) {
                        *(u32x2*)(p.proj + (size_t)row * 2840 + col) = (u32x2){pack_bf16(a[n][0], a[n][1]), pack_bf16(a[n][2], a[n][3])};
                        if (col >= 1280 && col < 1304)
                            *(f32x4*)(p.gates + (size_t)row * 24 + (col - 1280)) = (f32x4){sigmf(a[n][0]), sigmf(a[n][1]), sigmf(a[n][2]), sigmf(a[n][3])};
                    }
                }
            }, lds, tid, st_, [&] { if (has2) g128_stage0<MF>(Af(mt2), Bf(nt2), lds, tid); });
    }
}
__device__ __forceinline__ void st_cmp1_mf(const P& p, int wg, int nwg, LDSP char* lds) {
    const int tid = otid();
    for (int w = wg; w < 2 * 16 * 2; w += nwg) {
        const int which = w >> 5, mt = (w >> 1) & 15, nt = w & 1;
        const int colbase = which ? 640 : 512;
        gemm128(32, 2840, 64,
            [&](int r) { int m = mt * 128 + r; m = m < 2044 ? m : 2043; const int bk = m / 511, n = m % 511, b = bk >> 1, kv = bk & 1;
                         return p.proj + (size_t)(b * SEQ + 16 * n) * 2840 + colbase + kv * 64; },
            [&](int r) { return p.wt_c1 + (size_t)(which * 256 + nt * 128 + r) * 2048; },
            [&](int rl, int cl, const f32x4 (&a)[4], int mfrag) {
                const int m = mt * 128 + rl;
                if (m < 2044) {
#pragma unroll
                    for (int n = 0; n < 4; ++n) {
                        const int col = nt * 128 + cl + n * 16;
                        const f32x4 cb = *(const f32x4*)(p.c1 + which * 256 + col);
                        *(u32x2*)(p.chidb + (size_t)(which * 2048 + m) * 256 + col) =
                            (u32x2){pack_bf16(gelu_tanh(a[n][0] + cb[0]), gelu_tanh(a[n][1] + cb[1])), pack_bf16(gelu_tanh(a[n][2] + cb[2]), gelu_tanh(a[n][3] + cb[3]))};
                    }
                }
            }, lds, tid);
    }
}
__device__ __forceinline__ void st_cmp2_mf(const P& p, int wg, int nwg, LDSP char* lds) {
    const int tid = otid();
    for (int w = wg; w < 2 * 16; w += nwg) {
        const int which = w >> 4, mt = w & 15;
        gemm128(4, 64, 64,
            [&](int r) { int m = mt * 128 + r; m = m < 2044 ? m : 2043; return p.chidb + (size_t)(which * 2048 + m) * 256; },
            [&](int r) { return p.wt_c2 + (size_t)(which * 64 + (r & 63)) * 256; },
            [&](int rl, int cl, const f32x4 (&a)[4], int mfrag) {
                const int m = mt * 128 + rl;
                if (m < 2044) {
#pragma unroll
                    for (int n = 0; n < 4; ++n) { const int col = cl + n * 16; if (col < 64) {
                        const int bk = m / 511, nn = m % 511;
                        *(u32x2*)(p.kcmpb + ((size_t)((which * 4 + bk) * 512 + nn)) * 64 + col) = (u32x2){cvtpk(a[n][0], a[n][1]), cvtpk(a[n][2], a[n][3])}; } }
                }
            }, lds, tid);
    }
}
template <int MF>
__device__ __forceinline__ void st_outproj_mf(const P& p, int layer, int wg, int nwg, LDSP char* lds) {
    const int tid = otid();
    const bf16_t* W = layer ? p.wt_out1 : p.wt_out0;
    const float* xin = layer ? p.out : p.x;
    const XcdOrder ord(wg, nwg, ((T_TOK + 32 * MF - 1) / (32 * MF) + 7) & ~7, 8);
    auto Af = [&](int mt_) { return [=](int r) { int row = mt_ * (32 * MF) + r; row = row < T_TOK ? row : T_TOK - 1; return p.o + (size_t)row * DM; }; };
    auto Bf = [&](int nt_) { return [=](int r) { return W + (size_t)(nt_ * 128 + r) * 1024; }; };
    bool staged = false;
    for (int k = 0;; ++k) {
        int mt, nt, mt2 = 0, nt2 = 0;
        if (!ord.get(k, mt, nt)) break;
        if (mt * (32 * MF) >= T_TOK) break;
        const bool has2 = ord.get(k + 1, mt2, nt2) && mt2 * (32 * MF) < T_TOK;
        const bool st_ = staged; staged = has2;
        gemm128x<MF>(16, 64, 64, Af(mt), Bf(nt),
            [&](int rl, int cl, const f32x4 (&a)[4], int mfrag) {
                const int row = mt * (32 * MF) + rl, b = row >> 13;
                const float* g = p.modv + (size_t)(layer * 2 + (b & 1)) * 6144 + 2 * 1024;
                if (row < T_TOK)
#pragma unroll
                for (int n = 0; n < 4; ++n) {
                    const int col = nt * 128 + cl + n * 16;
                    const f32x4 xv = *(const f32x4*)(xin + (size_t)row * DM + col), gv = *(const f32x4*)(g + col);
                    *(f32x4*)(p.out + (size_t)row * DM + col) = xv + gv * a[n];
                }
            }, lds, tid, st_, [&] { if (has2) g128_stage0<MF>(Af(mt2), Bf(nt2), lds, tid); });
    }
}
template <int BM>
__device__ __forceinline__ bool moe_tile128(const int* cnt, int tt, int& e, int& i0, int& off) {
    int acc = 0, o = 0;
    for (int q = 0; q < 16; ++q) {
        const int c = cnt[q * 32], nt = (c + BM - 1) / BM;
        if (tt < acc + nt) { e = q; i0 = (tt - acc) * BM; off = o; return true; }
        acc += nt; o += c;
    }
    return false;
}
struct MoeTile { int e, i0, off, nt, ce; bool ok; };
template <int BM>
__device__ __forceinline__ MoeTile moe_get(const int* cnt, int w) {
    MoeTile t; t.ok = moe_tile128<BM>(cnt, w >> 3, t.e, t.i0, t.off); t.nt = w & 7; t.ce = t.ok ? cnt[t.e * 32] : 0; return t;
}
template <int MF>
__device__ __forceinline__ void st_moe_up_mf(const P& p, int layer, int wg, int nwg, LDSP char* lds) {
    const int tid = otid();
    const int* cnt = p.cnt + layer * 512;
    auto Af = [&](const MoeTile& t) { const int* lst = p.list + t.e * T_TOK; const int i0 = t.i0, ce = t.ce;
                                      return [=](int r) { const int i = (i0 + r < ce) ? i0 + r : i0; return p.h + (size_t)(lst[i] >> 1) * DM; }; };
    auto Bf = [&](const MoeTile& t) { const bf16_t* B = p.wt_gu + ((size_t)(layer * 16 + t.e) * 1024 + t.nt * 128) * 1024; return [=](int r) { return B + (size_t)r * 1024; }; };
    MoeTile cur = moe_get<32 * MF>(cnt, wg);
    bool staged = false;
    for (int w = wg; cur.ok; w += nwg) {
        const MoeTile nx = moe_get<32 * MF>(cnt, w + nwg);
        const bool st_ = staged; staged = nx.ok;
        const int i0 = cur.i0, ce = cur.ce, off = cur.off, nt = cur.nt;
        gemm128x<MF>(16, 64, 64, Af(cur), Bf(cur),
            [&](int rl, int cl, const f32x4 (&a)[4], int mfrag) {
                if (i0 + rl < ce) {
                    const int wc = cl >> 6, fq4 = cl & 63;
#pragma unroll
                    for (int n = 0; n < 2; ++n) {
                        const int col = nt * 64 + wc * 32 + n * 16 + fq4;
                        const f32x4 g = a[n], u = a[n + 2];
                        *(u32x2*)(p.hid + (size_t)(off + i0 + rl) * 512 + col) =
                            (u32x2){pack_bf16(siluf(g[0]) * u[0], siluf(g[1]) * u[1]), pack_bf16(siluf(g[2]) * u[2], siluf(g[3]) * u[3])};
                    }
                }
            }, lds, tid, st_, [&] { if (nx.ok) g128_stage0<MF>(Af(nx), Bf(nx), lds, tid); });
        cur = nx;
    }
}
template <int MF>
__device__ __forceinline__ void st_moe_down_mf(const P& p, int layer, int wg, int nwg, LDSP char* lds) {
    const int tid = otid();
    const int* cnt = p.cnt + layer * 512;
    auto Af = [&](const MoeTile& t) { const int i0 = t.i0, ce = t.ce, off = t.off; return [=](int r) { const int i = (i0 + r < ce) ? i0 + r : i0; return p.hid + (size_t)(off + i) * 512; }; };
    auto Bf = [&](const MoeTile& t) { const bf16_t* B = p.wt_d + ((size_t)(layer * 16 + t.e) * 1024 + t.nt * 128) * 512; return [=](int r) { return B + (size_t)r * 512; }; };
    MoeTile cur = moe_get<32 * MF>(cnt, wg);
    bool staged = false;
    for (int w = wg; cur.ok; w += nwg) {
        const MoeTile nx = moe_get<32 * MF>(cnt, w + nwg);
        const bool st_ = staged; staged = nx.ok;
        const int i0 = cur.i0, ce = cur.ce, nt = cur.nt;
        const int* lst = p.list + cur.e * T_TOK;
        int ids[MF]; float wts[MF];
#pragma unroll
        for (int m = 0; m < MF; ++m) { const int rl = ((tid >> 7) & 1) * (16 * MF) + m * 16 + (tid & 15); ids[m] = (i0 + rl < ce) ? lst[i0 + rl] : -1; }
#pragma unroll
        for (int m = 0; m < MF; ++m) wts[m] = ids[m] >= 0 ? p.tokw[ids[m]] : 0.f;
        gemm128x<MF>(8, 64, 64, Af(cur), Bf(cur),
            [&](int rl, int cl, const f32x4 (&a)[4], int mfrag) {
                if (i0 + rl < ce) {
                    const int id = ids[mfrag]; const float wt = wts[mfrag];
#pragma unroll
                    for (int n = 0; n < 4; ++n) {
                        const int col = nt * 128 + cl + n * 16;
                        *(u32x2*)(p.y + (size_t)id * DM + col) = (u32x2){pack_bf16(wt * a[n][0], wt * a[n][1]), pack_bf16(wt * a[n][2], wt * a[n][3])};
                    }
                }
            }, lds, tid, st_, [&] { if (nx.ok) g128_stage0<MF>(Af(nx), Bf(nx), lds, tid); });
        cur = nx;
    }
}
template <int MF>
__device__ __forceinline__ void st_inproj1_mf(const P& p, int wg, int nwg, LDSP char* lds) {
    const int tid = otid();
    const XcdOrder ord(wg, nwg, ((T_TOK + 32 * MF - 1) / (32 * MF) + 7) & ~7, 10);
    auto Af = [&](int mt_) { return [=](int r) { int row = mt_ * (32 * MF) + r; row = row < T_TOK ? row : T_TOK - 1; return p.h + (size_t)row * DM; }; };
    auto Bf = [&](int nt_) { return [=](int r) { int n = nt_ * 128 + r; n = n < 1216 ? n : 1215; return p.wt_in1 + (size_t)n * 1024; }; };
    bool staged = false;
    for (int k = 0;; ++k) {
        int mt, nt, mt2 = 0, nt2 = 0;
        if (!ord.get(k, mt, nt)) break;
        if (mt * (32 * MF) >= T_TOK) break;
        const bool has2 = ord.get(k + 1, mt2, nt2) && mt2 * (32 * MF) < T_TOK;
        const bool st_ = staged; staged = has2;
        gemm128x<MF>(16, 64, 64, Af(mt), Bf(nt),
            [&](int rl, int cl, const f32x4 (&a)[4], int mfrag) {
                const int row = mt * (32 * MF) + rl;
#pragma unroll
                for (int n = 0; n < 4; ++n) {
                    const int col = nt * 128 + cl + n * 16;
                    if (col < 1216 && row < T_TOK) *(u32x2*)(p.proj1 + (size_t)row * 1216 + col) = (u32x2){pack_bf16(a[n][0], a[n][1]), pack_bf16(a[n][2], a[n][3])};
                }
            }, lds, tid, st_, [&] { if (has2) g128_stage0<MF>(Af(mt2), Bf(nt2), lds, tid); });
    }
}
__device__ __forceinline__ void st_mla_up_mf(const P& p, int wg, int nwg, LDSP char* lds) {
    const int tid = otid();
    const XcdOrder ord(wg, nwg, 128, 14);
    for (int k = 0;; ++k) {
        int mt, c;
        if (!ord.get(k, mt, c)) break;
        if (c < 6) {
            gemm128(4, 64, 64,
                [&](int r) { return p.cqn + (size_t)(mt * 128 + r) * 384; },
                [&](int r) { return p.wt_qup + (size_t)(c * 128 + r) * 256; },
                [&](int rl, int cl, const f32x4 (&a)[4], int mfrag) {
                    const int row = mt * 128 + rl, wc = cl >> 6;
                    f32x4 v[4] = {a[0], a[1], a[2], a[3]};
                    if (((c == 1 || c == 4) && wc == 0) || ((c == 2 || c == 5) && wc == 1)) {
                        const int t = row & (SEQ - 1), i0 = cl & 63;
#pragma unroll
                        for (int n = 0; n < 2; ++n) {
                            const f32x4 cs = *(const f32x4*)(p.ropec + t * 32 + n * 16 + i0), sn = *(const f32x4*)(p.ropes + t * 32 + n * 16 + i0);
                            v[n] = a[n] * cs - a[n + 2] * sn; v[n + 2] = a[n] * sn + a[n + 2] * cs;
                        }
                    }
#pragma unroll
                    for (int n = 0; n < 4; ++n) *(u32x2*)(p.qmla + (size_t)row * 768 + c * 128 + cl + n * 16) = (u32x2){cvtpk(v[n][0], v[n][1]), cvtpk(v[n][2], v[n][3])};
                }, lds, tid);
        } else {
            gemm128(2, 64, 64,
                [&](int r) { return p.cqn + (size_t)(mt * 128 + r) * 384 + 256; },
                [&](int r) { return p.wt_kvup + (size_t)((c - 6) * 128 + r) * 128; },
                [&](int rl, int cl, const f32x4 (&a)[4], int mfrag) {
                    const int row = mt * 128 + rl;
#pragma unroll
                    for (int n = 0; n < 4; ++n) *(u32x2*)(p.kvmla + (size_t)row * 1024 + (c - 6) * 128 + cl + n * 16) = (u32x2){pack_bf16(a[n][0], a[n][1]), pack_bf16(a[n][2], a[n][3])};
                }, lds, tid);
        }
    }
}

typedef float f32x16 __attribute__((ext_vector_type(16)));
typedef short s16x4 __attribute__((ext_vector_type(4)));
#define ATT_NEG (-1e30f)
#define ATT_SHIFT (-16.0f)
#define LOG2E 1.4426950408889634f

__device__ __forceinline__ int swz128(int row) { return (((row >> 1) & 1) << 2) | ((row >> 2) & 3); }
__device__ __forceinline__ int swz256(int row) { return ((row & 3) << 2) | ((row >> 2) & 3); }

struct AttLane {
    int kbase;
    int v0[2];
};
template <int KROWB, int VROWB, int DT>
__device__ __forceinline__ void att_lane_init(AttLane& L, int lane) {
    const int q = lane & 31, hh = lane >> 5, x = hh ^ swz128(q);
    L.kbase = q * KROWB + x * 16;
    const int rl = 4 * hh + ((lane & 15) >> 2), blk = (lane >> 4) & 1, pp = lane & 3;
#pragma unroll
    for (int t = 0; t < 2; ++t) {
        const int g = (VROWB == 256) ? (((rl & 3) << 2) | ((2 * t + hh) & 3)) : ((((rl >> 1) & 1) << 2) | ((2 * t + hh) & 3));
        L.v0[t] = rl * VROWB + (((2 * blk + (pp >> 1)) ^ g) * 16) + 8 * (pp & 1);
    }
}
template <int KS, int KROWB, int MODE, bool WANT_P, bool IMP>
__device__ __forceinline__ void att_qk(LDSP const char* kb, const AttLane& L, const bf16x8 (&qf)[KS], bf16x8 (&pf)[4], float& lsum, const float c1, const float cadd,
                                       const unsigned lutv, const int dq16, LDSP float* improw, const float invl) {
    float la = 0.f, lb = 0.f, lc = 0.f, ld = 0.f;
#pragma unroll
    for (int kt = 0; kt < 2; ++kt) {
        f32x16 s;
#pragma unroll
        for (int r = 0; r < 16; ++r) s[r] = 0.f;
        constexpr int KG = (KS > 4) ? 2 : 4;
#pragma unroll
        for (int k4 = 0; k4 < KS; k4 += KG) {
            bf16x8 a[KG];
#pragma unroll
            for (int j = 0; j < KG; ++j) { const int ks = k4 + j; a[j] = *(const LDSP bf16x8*)(kb + (L.kbase ^ (32 * (ks & 3))) + (ks >> 2) * 128 + kt * 32 * KROWB); }
#pragma unroll
            for (int j = 0; j < KG; ++j) s = __builtin_amdgcn_mfma_f32_32x32x16_bf16(a[j], qf[k4 + j], s, 0, 0, 0);
            asm volatile("" ::: "memory");
        }
        float pr[16];
#pragma unroll
        for (int r = 0; r < 16; ++r) {
            const int koff = 32 * kt + (r & 3) + 8 * (r >> 2);
            float add = cadd;
            if (MODE == 1) add = *(const LDSP float*)(lutv + (63 - koff) * 4);
            if (MODE == 2) { int d = dq16 - 16 * koff; d = d < -1 ? -1 : d; d = d > 1087 ? 1087 : d; add = *(const LDSP float*)(lutv + (unsigned)(64 + d) * 4u); }
            pr[r] = __builtin_amdgcn_exp2f(__builtin_fmaf(s[r], c1, add));
        }
#pragma unroll
        for (int r = 0; r < 16; r += 4) { la += pr[r]; lb += pr[r + 1]; lc += pr[r + 2]; ld += pr[r + 3]; }
        if (IMP) {
#pragma unroll
            for (int g = 0; g < 4; ++g) {
                (void)__hip_atomic_fetch_add((LDSP unsigned*)improw + 8 * kt + 2 * g, (unsigned)(((pr[4 * g] + pr[4 * g + 1]) + (pr[4 * g + 2] + pr[4 * g + 3])) * invl + 0.5f), __ATOMIC_RELAXED, __HIP_MEMORY_SCOPE_WORKGROUP);
                (void)__hip_atomic_fetch_add((LDSP unsigned*)improw + 8 * kt + 2 * g + 1, (unsigned)(pr[4 * g + 3] * invl + 0.5f), __ATOMIC_RELAXED, __HIP_MEMORY_SCOPE_WORKGROUP);
            }
        }
        if (WANT_P) {
#pragma unroll
            for (int sI = 0; sI < 2; ++sI) {
                union { unsigned u[4]; bf16x8 v; } cv;
#pragma unroll
                for (int i = 0; i < 4; ++i) cv.u[i] = cvtpk_valu(pr[8 * sI + 2 * i], pr[8 * sI + 2 * i + 1]);
                pf[kt * 2 + sI] = cv.v;
            }
        }
    }
    lsum += (la + lb) + (lc + ld);
}
template <int DT, int VROWB>
__device__ __forceinline__ void att_pv(LDSP const char* vb, const AttLane& L, const bf16x8 (&pf)[4], f32x16 (&o)[DT]) {
    const unsigned vba = (unsigned)(size_t)vb;
#pragma unroll
    for (int ks2 = 0; ks2 < 4; ++ks2) {
#pragma unroll
        for (int d0 = 0; d0 < DT; d0 += 2) {
            s16x4 lo[2], hi[2];
#pragma unroll
            for (int j = 0; j < 2; ++j) {
                asm volatile("ds_read_b64_tr_b16 %0, %1 offset:%2" : "=v"(lo[j]) : "v"(vba + (L.v0[0] ^ ((d0 + j) << 6))), "i"((16 * ks2) * VROWB) : "memory");
                asm volatile("ds_read_b64_tr_b16 %0, %1 offset:%2" : "=v"(hi[j]) : "v"(vba + (L.v0[1] ^ ((d0 + j) << 6))), "i"((16 * ks2 + 8) * VROWB) : "memory");
            }
            asm volatile("s_waitcnt lgkmcnt(0)" ::: "memory");
#pragma unroll
            for (int j = 0; j < 2; ++j) {
                asm volatile("" : "+v"(lo[j]), "+v"(hi[j]));
                const bf16x8 vf = __builtin_shufflevector(lo[j], hi[j], 0, 1, 2, 3, 4, 5, 6, 7);
                o[d0 + j] = __builtin_amdgcn_mfma_f32_32x32x16_bf16(vf, pf[ks2], o[d0 + j], 0, 0, 0);
            }
        }
    }
}
template <int CPR>
__device__ __forceinline__ void att_stage_map(int (&rowc)[(CPR == 24) ? 6 : 1], int tid) {
    if (CPR == 24) {
#pragma unroll
        for (int i = 0; i < 6; ++i) {
            const int c = tid + 256 * i, row = c / 24, cc = c % 24;
            rowc[i % ((CPR == 24) ? 6 : 1)] = (row << 8) | ((cc & ~7) | ((cc & 7) ^ swz128(row)));
        }
    } else if (CPR == 16) {
        const int row = tid >> 4; rowc[0] = (row << 8) | ((tid & 15) ^ swz256(row));
    } else {
        const int row = tid >> 3; rowc[0] = (row << 8) | ((tid & 7) ^ swz128(row));
    }
}
template <int CPR, class SRC>
__device__ __forceinline__ void att_stage(LDSP char* dst, SRC src, const int (&rowc)[(CPR == 24) ? 6 : 1], int wid) {
#pragma unroll
    for (int i = 0; i < CPR / 4; ++i) {
        const int rc = rowc[(CPR == 24) ? i : 0];
        const int row = (rc >> 8) + ((CPR == 24) ? 0 : i * (256 / CPR));
        __builtin_amdgcn_global_load_lds((const unsigned*)src(row, rc & 255), (LDSP unsigned*)(dst + (256 * i + 64 * wid) * 16), 16, 0, 0);
    }
}
__device__ __forceinline__ int wq_next(int* ctr, LDSP int* slot, int tid) {
    __syncthreads();
    if (tid == 0) *slot = atomicAdd(ctr, 1);
    __syncthreads();
    return *slot;
}

__device__ __forceinline__ void build_lut(LDSP float* tab, const float* blut_h, int n, int wlimit, int tid) {
    for (int i = tid; i < n; i += 256) { const int d = i - 64; tab[i] = (d < 0 || d >= wlimit) ? ATT_NEG : blut_h[d > 1023 ? 1023 : d] * LOG2E + ATT_SHIFT; }
}
#define ATT_BAR() do { __builtin_amdgcn_s_barrier(); asm volatile("" ::: "memory"); } while (0)

__device__ __forceinline__ void mla_item(const P& p, const int item, LDSP char* lds, const int tid0) {
    LDSP char* kb = lds; LDSP char* vb = lds + 24576; LDSP float* lut = (LDSP float*)(lds + 40960);
    const float c1 = 0.07216878364870322f * LOG2E;
    int tid = tid0; asm volatile("" : "+v"(tid));
    const int wid = tid >> 6, lane = tid & 63, q = lane & 31, hh = lane >> 5;
    AttLane L; att_lane_init<384, 256, 4>(L, lane);
    int krc[6], vrc[1];
    att_stage_map<24>(krc, tid); att_stage_map<16>(vrc, tid);
    int qt, bh, part;
    if (item >= 640) { const int r = item - 640; qt = 15 - (r >> 3); bh = r & 7; part = 0; }
    else {
        int g = 0; while (16 * (g + 1) + 8 * ((g + 2) >> 1) <= item) ++g;
        const int r = item - (16 * g + 8 * ((g + 1) >> 1)), Ln = 64 - g;
        if (r < 16) { qt = Ln - 1; bh = r & 7; part = 1 + (r >> 3); } else { qt = (Ln >> 1) - 1; bh = (r - 16) & 7; part = 0; }
    }
    const int b = bh >> 2, h = bh & 3;
    const int tw = qt * 128 + wid * 32;
    bf16x8 qf[12];
    {
        const bf16_t* qp = p.qmla + (size_t)(b * SEQ + tw + q) * 768 + h * 192 + 8 * hh;
#pragma unroll
        for (int ks = 0; ks < 12; ++ks) qf[ks] = *(const bf16x8*)(qp + 16 * ks);
    }
    f32x16 o[4];
#pragma unroll
    for (int dt = 0; dt < 4; ++dt)
#pragma unroll
        for (int r = 0; r < 16; ++r) o[dt][r] = 0.f;
    float lsum = 0.f;
    const int i0 = (part == 2) ? qt + 1 : 0, ntiles = (part == 1) ? qt + 1 : 2 * qt + 2;
    const bf16_t* kvb = p.kvmla + (size_t)b * SEQ * 1024 + h * 256;
    const bf16_t* krb = p.krope + (size_t)b * SEQ * 64;
    auto ksrc = [&](int pos0) { return [=](int row, int gc) { return gc < 16 ? kvb + (size_t)(pos0 + row) * 1024 + gc * 8 : krb + (size_t)(pos0 + row) * 64 + (gc - 16) * 8; }; };
    auto vsrc = [&](int pos0) { return [=](int row, int gc) { return kvb + (size_t)(pos0 + row) * 1024 + 128 + gc * 8; }; };
    att_stage<24>(kb, ksrc(i0 * 64), krc, wid);
    for (int i = i0; i < ntiles; ++i) {
        const int pos0 = i * 64;
        asm volatile("s_waitcnt vmcnt(0)" ::: "memory"); ATT_BAR();
        att_stage<16>(vb, vsrc(pos0), vrc, wid);
        const bool active = pos0 <= tw + 31, diag = pos0 + 63 > tw;
        bf16x8 pf[4];
        if (active) {
            if (diag) {
                int dq = tw + q - pos0 - 4 * hh; dq = dq < -1 ? -1 : dq;
                att_qk<12, 384, 1, true, false>(kb, L, qf, pf, lsum, c1, 0.f, (unsigned)(size_t)lut + (unsigned)(dq + 1) * 4u, 0, nullptr, 0.f);
            } else att_qk<12, 384, 0, true, false>(kb, L, qf, pf, lsum, c1, ATT_SHIFT, 0u, 0, nullptr, 0.f);
        }
        asm volatile("s_waitcnt vmcnt(0) lgkmcnt(0)" ::: "memory"); ATT_BAR();
        if (i + 1 < ntiles) att_stage<24>(kb, ksrc(pos0 + 64), krc, wid);
        if (active) att_pv<4, 256>(vb, L, pf, o);
    }
    const float lt = lsum + __shfl_xor(lsum, 32);
    int tid2 = tid0; asm volatile("" : "+v"(tid2));
    const int lane2 = tid2 & 63, trow = qt * 128 + (tid2 >> 6) * 32 + (lane2 & 31);
    bf16_t* op; float inv;
    if (part == 0) { inv = 1.0f / lt; op = p.o + (size_t)(b * SEQ + trow) * DM + h * 128 + 4 * (lane2 >> 5); }
    else {
        const size_t rec = (size_t)((part - 1) * 8 + bh) * (SEQ / 2) + (trow - SEQ / 2);
        inv = 1.0f; op = p.mlap + rec * 128 + 4 * (lane2 >> 5);
        if (lane2 < 32) p.mlal[rec] = lt;
    }
#pragma unroll
    for (int dt = 0; dt < 4; ++dt)
#pragma unroll
        for (int rq = 0; rq < 4; ++rq)
            *(u32x2*)(op + 32 * dt + 8 * rq) = (u32x2){cvtpk(o[dt][4 * rq] * inv, o[dt][4 * rq + 1] * inv), cvtpk(o[dt][4 * rq + 2] * inv, o[dt][4 * rq + 3] * inv)};
}
__device__ __forceinline__ void st_mla_combine(const P& p, int wg, int nwg) {
    const int TIDX = otid();
    const int wid = TIDX >> 6, lane = TIDX & 63;
    for (int w = wg * 4 + wid; w < 8 * (SEQ / 2); w += nwg * 4) {
        const int bh = w / (SEQ / 2), t = SEQ / 2 + w % (SEQ / 2), b = bh >> 2, h = bh & 3;
        const size_t r0 = (size_t)w, r1 = (size_t)(8 * (SEQ / 2) + w);
        const float inv = 1.0f / (p.mlal[r0] + p.mlal[r1]);
        const unsigned a = *(const unsigned*)(p.mlap + r0 * 128 + lane * 2), c = *(const unsigned*)(p.mlap + r1 * 128 + lane * 2);
        const float x0 = __uint_as_float(a << 16) + __uint_as_float(c << 16), x1 = __uint_as_float(a & 0xffff0000u) + __uint_as_float(c & 0xffff0000u);
        *(unsigned*)(p.o + (size_t)(b * SEQ + t) * DM + h * 128 + lane * 2) = cvtpk(x0 * inv, x1 * inv);
    }
}

__device__ __forceinline__ void swa_item(const P& p, const int item, LDSP char* lds, const int tid0) {
    LDSP char* kb = lds; LDSP char* vb = lds + 8192; LDSP float* luts = (LDSP float*)(lds + 46080);
    const float c1 = 0.125f * LOG2E;
    int tid = tid0; asm volatile("" : "+v"(tid));
    const int wid = tid >> 6, lane = tid & 63, q = lane & 31, hh = lane >> 5;
    AttLane L; att_lane_init<128, 128, 2>(L, lane);
    int rc[1]; att_stage_map<8>(rc, tid);
    const int b = item >> 9, kvh = (item >> 8) & 1, t0 = (item & 255) * 32, head = kvh * 4 + wid;
    bf16x8 qf[4];
    {
        const bf16_t* qp = p.proj1 + (size_t)(b * SEQ + t0 + q) * 1216 + 448 + head * 64 + 8 * hh;
#pragma unroll
        for (int ks = 0; ks < 4; ++ks) qf[ks] = *(const bf16x8*)(qp + 16 * ks);
    }
    f32x16 o[2];
#pragma unroll
    for (int dt = 0; dt < 2; ++dt)
#pragma unroll
        for (int r = 0; r < 16; ++r) o[dt][r] = 0.f;
    float lsum = 0.f;
    const bf16_t* kbp = p.proj1 + (size_t)b * SEQ * 1216 + 960 + kvh * 64;
    const bf16_t* zr = p.zrow;
    auto ksrc = [&](int pos0) { return [=](int row, int gc) { const int pos = pos0 + row; return (pos >= 0 && pos < SEQ) ? kbp + (size_t)pos * 1216 + gc * 8 : zr + gc * 8; }; };
    auto vsrc = [&](int pos0) { return [=](int row, int gc) { const int pos = pos0 + row; return (pos >= 0 && pos < SEQ) ? kbp + (size_t)pos * 1216 + 128 + gc * 8 : zr + gc * 8; }; };
    const unsigned tab = (unsigned)(size_t)(luts + head * 256);
    att_stage<8>(kb, ksrc(t0 - 128), rc, wid);
    for (int i = 0; i < 3; ++i) {
        const int pos0 = t0 - 128 + 64 * i;
        asm volatile("s_waitcnt vmcnt(0)" ::: "memory"); ATT_BAR();
        att_stage<8>(vb, vsrc(pos0), rc, wid);
        bf16x8 pf[4];
        int dq = t0 + q - pos0 - 4 * hh; dq = dq < -1 ? -1 : dq;
        att_qk<4, 128, 1, true, false>(kb, L, qf, pf, lsum, c1, 0.f, tab + (unsigned)(dq + 1) * 4u, 0, nullptr, 0.f);
        asm volatile("s_waitcnt vmcnt(0) lgkmcnt(0)" ::: "memory"); ATT_BAR();
        if (i + 1 < 3) att_stage<8>(kb, ksrc(pos0 + 64), rc, wid);
        att_pv<2, 128>(vb, L, pf, o);
    }
    const float lt = lsum + __shfl_xor(lsum, 32) + __builtin_amdgcn_exp2f(p.sinks[head] * LOG2E + ATT_SHIFT);
    const float inv = 1.0f / lt;
    bf16_t* op = p.o + (size_t)(b * SEQ + t0 + q) * DM + 512 + head * 64 + 4 * hh;
#pragma unroll
    for (int dt = 0; dt < 2; ++dt)
#pragma unroll
        for (int rq = 0; rq < 4; ++rq)
            *(u32x2*)(op + 32 * dt + 8 * rq) = (u32x2){cvtpk(o[dt][4 * rq] * inv, o[dt][4 * rq + 1] * inv), cvtpk(o[dt][4 * rq + 2] * inv, o[dt][4 * rq + 3] * inv)};
}
__device__ __forceinline__ void moe_conv_item(const P& p, const int layer, const int item, LDSP char* lds, const int tid0) {
    float* sm = (float*)lds;
    const int set = item >> 8, t0 = (item & 255) * 8;
    if (set == 0) conv_batched<1>(p.moe_wg + (size_t)layer * 16 * 1024 * 512, 16, 1024, 512, (size_t)1024 * 512, p.wt_gu + (size_t)layer * 16 * 1024 * 1024, (size_t)1024 * 1024, t0, 1, sm, tid0, t0 + 8);
    else if (set == 1) conv_batched<2>(p.moe_wu + (size_t)layer * 16 * 1024 * 512, 16, 1024, 512, (size_t)1024 * 512, p.wt_gu + (size_t)layer * 16 * 1024 * 1024, (size_t)1024 * 1024, t0, 1, sm, tid0, t0 + 8);
    else conv_batched<0>(p.moe_wd + (size_t)layer * 16 * 512 * 1024, 16, 512, 1024, (size_t)512 * 1024, p.wt_d + (size_t)layer * 16 * 1024 * 512, (size_t)1024 * 512, t0, 1, sm, tid0, t0 + 8);
}
__device__ __forceinline__ void st_attn1(const P& p, LDSP char* lds) {
    const int tid0 = otid();
    LDSP float* lut = (LDSP float*)(lds + 40960); LDSP int* slot = (LDSP int*)(lds + 45568); LDSP float* luts = (LDSP float*)(lds + 46080);
    for (int i = tid0; i < 1152; i += 256) lut[i] = (i < 64) ? ATT_NEG : ATT_SHIFT;
#pragma unroll 1
    for (int h = 0; h < 8; ++h) build_lut(luts + h * 256, p.blut + h * 1024, 256, 128, tid0);
    for (;;) {
        const int item = wq_next(p.wq + 0, slot, tid0);
        if (item >= 768 + 1024 + 768) break;
        if (item < 768) mla_item(p, item, lds, tid0);
        else { const int r = item - 768, g = r / 7, ps = r - g * 7;
               if (ps < 4) swa_item(p, g * 4 + ps, lds, tid0); else moe_conv_item(p, 1, g * 3 + ps - 4, lds, tid0); }
    }
}

#define A0_GLUT 16384
#define A0_WLUT 34816
#define A0_IMP 45056
#define A0_SEL 61568
#define A0_UN 62080
#define A0_LIST 62144
#define A0_SLOT 62720
__device__ __forceinline__ unsigned wmax_u32(unsigned v) {
#pragma unroll
    for (int o = 32; o > 0; o >>= 1) { const unsigned t = (unsigned)__shfl_xor((int)v, o); v = t > v ? t : v; }
    return v;
}
#define ATT_STORE_O(op, o, sc) do { _Pragma("unroll") for (int dt_ = 0; dt_ < 2; ++dt_) _Pragma("unroll") for (int rq_ = 0; rq_ < 4; ++rq_) \
        *(u32x2*)((op) + 32 * dt_ + 8 * rq_) = (u32x2){cvtpk((o)[dt_][4 * rq_] * (sc), (o)[dt_][4 * rq_ + 1] * (sc)), cvtpk((o)[dt_][4 * rq_ + 2] * (sc), (o)[dt_][4 * rq_ + 3] * (sc))}; } while (0)

__device__ __forceinline__ void nsa_item(const P& p, const int item, LDSP char* lds, const int tid0) {
    LDSP char* kb = lds; LDSP char* vb = lds + 8192;
    LDSP float* glut = (LDSP float*)(lds + A0_GLUT); LDSP float* wlut = (LDSP float*)(lds + A0_WLUT); LDSP float* imp = (LDSP float*)(lds + A0_IMP);
    LDSP unsigned* sel = (LDSP unsigned*)(lds + A0_SEL); LDSP unsigned* un = (LDSP unsigned*)(lds + A0_UN); LDSP unsigned short* blist = (LDSP unsigned short*)(lds + A0_LIST);
    const float c1 = 0.125f * LOG2E;
    int tid = tid0; asm volatile("" : "+v"(tid));
    const int wid = tid >> 6, lane = tid & 63, q = lane & 31, hh = lane >> 5;
    const int tile = 255 - (item >> 2), b = (item >> 1) & 1, kvh = item & 1, t0 = tile * 32, blk_t = t0 >> 6, head = kvh * 4 + wid;
#pragma unroll 1
    for (int h = 0; h < 4; ++h) { build_lut(glut + h * 1152, p.blut + (kvh * 4 + h) * 1024, 1152, 1 << 30, tid); build_lut(wlut + h * 640, p.blut + (kvh * 4 + h) * 1024, 640, 512, tid); }
    for (int i = tid; i < 32 * 129; i += 256) imp[i] = 0.f;
    AttLane L; att_lane_init<128, 128, 2>(L, lane);
    int rc[1]; att_stage_map<8>(rc, tid);
    const size_t rowq = (size_t)(b * SEQ + t0 + q);
    bf16x8 qf[4];
    {
        const bf16_t* qp = p.proj + rowq * 2840 + head * 64 + 8 * hh;
#pragma unroll
        for (int ks = 0; ks < 4; ++ks) qf[ks] = *(const bf16x8*)(qp + 16 * ks);
    }
    const float gc = p.gates[rowq * 24 + head * 3 + 0], gs = p.gates[rowq * 24 + head * 3 + 1], gw = p.gates[rowq * 24 + head * 3 + 2];
    const unsigned gtab = (unsigned)(size_t)(glut + wid * 1152), wtab = (unsigned)(size_t)(wlut + wid * 640);
    const bf16_t* zr = p.zrow;
    const bf16_t* pb = p.proj + (size_t)b * SEQ * 2840;
    f32x16 of[2], o[2];
#pragma unroll
    for (int dt = 0; dt < 2; ++dt)
#pragma unroll
        for (int r = 0; r < 16; ++r) { of[dt][r] = 0.f; o[dt][r] = 0.f; }
    bf16x8 pf[4];
    __syncthreads();
    const float cfar = glut[wid * 1152 + 64 + 1023];
    {
        int nvm = (t0 >> 4) + 1; nvm = nvm > 511 ? 511 : nvm;
        const int ntc = (nvm + 63) >> 6;
        const bf16_t* kcb = p.kcmpb + (size_t)((b * 2 + kvh) * 512) * 64;
        const bf16_t* vcb = p.kcmpb + (size_t)((4 + b * 2 + kvh) * 512) * 64;
        auto csrc = [&](const bf16_t* base, int n0) { return [=](int row, int gcx) { const int n = n0 + row; return n < 511 ? base + (size_t)n * 64 + gcx * 8 : zr + gcx * 8; }; };
        float lsum = 0.f;
        for (int nt = 0; nt < ntc; ++nt) {
            att_stage<8>(kb, csrc(kcb, nt * 64), rc, wid);
            asm volatile("s_waitcnt vmcnt(0)" ::: "memory"); ATT_BAR();
            const int dq16 = t0 + q - 31 - 1024 * nt - 64 * hh;
            if (t0 - 31 - 16 * (nt * 64 + 63) >= 1023) att_qk<4, 128, 0, false, false>(kb, L, qf, pf, lsum, c1, cfar, 0u, 0, nullptr, 0.f);
            else att_qk<4, 128, 2, false, false>(kb, L, qf, pf, lsum, c1, 0.f, gtab, dq16, nullptr, 0.f);
            asm volatile("s_waitcnt lgkmcnt(0)" ::: "memory"); ATT_BAR();
        }
        const float lc = lsum + __shfl_xor(lsum, 32);
        const float invl = lc > 0.f ? 1.0f / lc : 0.f;
        float dummy = 0.f;
        for (int nt = 0; nt < ntc; ++nt) {
            att_stage<8>(kb, csrc(kcb, nt * 64), rc, wid);
            att_stage<8>(vb, csrc(vcb, nt * 64), rc, wid);
            asm volatile("s_waitcnt vmcnt(0)" ::: "memory"); ATT_BAR();
            const int dq16 = t0 + q - 31 - 1024 * nt - 64 * hh;
            LDSP float* improw = imp + q * 129 + 16 * nt + hh;
            if (t0 - 31 - 16 * (nt * 64 + 63) >= 1023) att_qk<4, 128, 0, true, true>(kb, L, qf, pf, dummy, c1, cfar, 0u, 0, improw, invl * 524288.0f);
            else att_qk<4, 128, 2, true, true>(kb, L, qf, pf, dummy, c1, 0.f, gtab, dq16, improw, invl * 524288.0f);
            att_pv<2, 128>(vb, L, pf, o);
            asm volatile("s_waitcnt lgkmcnt(0)" ::: "memory"); ATT_BAR();
        }
        const float sc = gc * invl;
#pragma unroll
        for (int dt = 0; dt < 2; ++dt)
#pragma unroll
            for (int r = 0; r < 16; ++r) { of[dt][r] = o[dt][r] * sc; o[dt][r] = 0.f; }
    }
    __syncthreads();
    {
        unsigned u0 = 0u, u1 = 0u, u2 = 0u, u3 = 0u;
        for (int i = 0; i < 8; ++i) {
            const int tok = wid * 8 + i;
            const unsigned v0 = ((LDSP const unsigned*)imp)[tok * 129 + lane], v1 = ((LDSP const unsigned*)imp)[tok * 129 + 64 + lane];
            const int j0 = lane, j1 = lane + 64;
            const bool f0 = (j0 == 0) || (j0 == blk_t) || (j0 == blk_t - 1), f1 = (j1 == blk_t) || (j1 == blk_t - 1);
            unsigned k0 = f0 ? (0xFFFFFF80u | (unsigned)(127 - j0)) : (j0 <= blk_t ? ((v0 << 7) | (unsigned)(127 - j0)) : 0u);
            unsigned k1 = f1 ? (0xFFFFFF80u | (unsigned)(127 - j1)) : (j1 <= blk_t ? ((v1 << 7) | (unsigned)(127 - j1)) : 0u);
            unsigned thr = 0u;
#pragma unroll 1
            for (int bit = 31; bit >= 0; --bit) {
                const unsigned cand = thr | (1u << bit);
                const int c = __popcll(__ballot(k0 >= cand)) + __popcll(__ballot(k1 >= cand));
                thr = (c >= 16) ? cand : thr;
            }
            thr = thr ? thr : 1u;
            const unsigned long long b0 = __ballot(k0 >= thr), b1 = __ballot(k1 >= thr);
            const unsigned m0 = (unsigned)b0, m1 = (unsigned)(b0 >> 32), m2 = (unsigned)b1, m3 = (unsigned)(b1 >> 32);
            if (lane == 0) { sel[tok * 4 + 0] = m0; sel[tok * 4 + 1] = m1; sel[tok * 4 + 2] = m2; sel[tok * 4 + 3] = m3; }
            u0 |= m0; u1 |= m1; u2 |= m2; u3 |= m3;
        }
        if (lane == 0) { un[wid * 4 + 0] = u0; un[wid * 4 + 1] = u1; un[wid * 4 + 2] = u2; un[wid * 4 + 3] = u3; }
    }
    __syncthreads();
    {
        unsigned uw[4];
#pragma unroll
        for (int k = 0; k < 4; ++k) uw[k] = (unsigned)__builtin_amdgcn_readfirstlane((int)(un[k] | un[4 + k] | un[8 + k] | un[12 + k]));
        if (tid < 128) {
            const int k = tid >> 5, jb = tid & 31;
            unsigned wv = 0u; int below = 0;
#pragma unroll
            for (int kk = 0; kk < 4; ++kk) { if (kk == k) wv = uw[kk]; if (kk < k) below += __popc(uw[kk]); }
            if ((wv >> jb) & 1u) blist[below + __popc(wv & ((1u << jb) - 1u))] = (unsigned short)tid;
        }
        const int nb = __popc(uw[0]) + __popc(uw[1]) + __popc(uw[2]) + __popc(uw[3]);
        unsigned sq[4];
#pragma unroll
        for (int k = 0; k < 4; ++k) sq[k] = sel[q * 4 + k];
        __syncthreads();
        const bf16_t* ksb = pb + 768 + kvh * 64;
        auto ssrc = [&](int pos0, int colo) { return [=](int row, int gcx) { return ksb + (size_t)(pos0 + row) * 2840 + colo + gcx * 8; }; };
        float lsum = 0.f;
        att_stage<8>(kb, ssrc(64 * (int)blist[0], 0), rc, wid);
        for (int i = 0; i < nb; ++i) {
            const int j = __builtin_amdgcn_readfirstlane((int)blist[i]), pos0 = 64 * j;
            asm volatile("s_waitcnt vmcnt(0)" ::: "memory"); ATT_BAR();
            att_stage<8>(vb, ssrc(pos0, 128), rc, wid);
            unsigned sw = 0u;
#pragma unroll
            for (int k = 0; k < 4; ++k) if ((j >> 5) == k) sw = sq[k];
            const bool selq = (sw >> (j & 31)) & 1u;
            if (t0 - (pos0 + 63) >= 1023) att_qk<4, 128, 0, true, false>(kb, L, qf, pf, lsum, c1, selq ? cfar : ATT_NEG, 0u, 0, nullptr, 0.f);
            else {
                int dq = t0 + q - pos0 - 4 * hh; dq = dq > 1087 ? 1087 : dq; dq = (dq < -1 || !selq) ? -1 : dq;
                att_qk<4, 128, 1, true, false>(kb, L, qf, pf, lsum, c1, 0.f, gtab + (unsigned)(dq + 1) * 4u, 0, nullptr, 0.f);
            }
            asm volatile("s_waitcnt vmcnt(0) lgkmcnt(0)" ::: "memory"); ATT_BAR();
            if (i + 1 < nb) att_stage<8>(kb, ssrc(64 * (int)blist[i + 1], 0), rc, wid);
            att_pv<2, 128>(vb, L, pf, o);
        }
        const float ls = lsum + __shfl_xor(lsum, 32);
        const float sc = gs / ls;
#pragma unroll
        for (int dt = 0; dt < 2; ++dt)
#pragma unroll
            for (int r = 0; r < 16; ++r) { of[dt][r] += o[dt][r] * sc; o[dt][r] = 0.f; }
    }
    {
        const bf16_t* kwb = pb + 1024 + kvh * 64;
        auto wsrc = [&](int pos0, int colo) { return [=](int row, int gcx) { const int pos = pos0 + row; return (pos >= 0 && pos < SEQ) ? kwb + (size_t)pos * 2840 + colo + gcx * 8 : zr + gcx * 8; }; };
        float lsum = 0.f;
        asm volatile("s_waitcnt lgkmcnt(0)" ::: "memory"); ATT_BAR();
        att_stage<8>(kb, wsrc(t0 - 512, 0), rc, wid);
        for (int i = 0; i < 9; ++i) {
            const int pos0 = t0 - 512 + 64 * i;
            asm volatile("s_waitcnt vmcnt(0)" ::: "memory"); ATT_BAR();
            att_stage<8>(vb, wsrc(pos0, 128), rc, wid);
            int dq = t0 + q - pos0 - 4 * hh; dq = dq < -1 ? -1 : dq;
            att_qk<4, 128, 1, true, false>(kb, L, qf, pf, lsum, c1, 0.f, wtab + (unsigned)(dq + 1) * 4u, 0, nullptr, 0.f);
            asm volatile("s_waitcnt vmcnt(0) lgkmcnt(0)" ::: "memory"); ATT_BAR();
            if (i + 1 < 9) att_stage<8>(kb, wsrc(pos0 + 64, 0), rc, wid);
            att_pv<2, 128>(vb, L, pf, o);
        }
        const float lw = lsum + __shfl_xor(lsum, 32);
        const float sc = gw / lw;
#pragma unroll
        for (int dt = 0; dt < 2; ++dt)
#pragma unroll
            for (int r = 0; r < 16; ++r) of[dt][r] += o[dt][r] * sc;
    }
    bf16_t* op = p.o + rowq * DM + head * 64 + 4 * hh;
    ATT_STORE_O(op, of, 1.0f);
}

#define MG_CNT 8192
#define MG_BASE 8320
#define MG_ENT 8448
__device__ __forceinline__ void st_moba_gate(const P& p, int wg, int nwg, LDSP char* lds) {
    const int tid = otid();
    const int wid = tid >> 6, lane = tid & 63, q = lane & 31, hh = lane >> 5;
    LDSP char* kmt = lds; LDSP int* lcnt = (LDSP int*)(lds + MG_CNT); LDSP int* lbase = (LDSP int*)(lds + MG_BASE); LDSP int* ent = (LDSP int*)(lds + MG_ENT);
    AttLane L; att_lane_init<128, 128, 2>(L, lane);
    int rc[1]; att_stage_map<8>(rc, tid);
    const bf16_t* zr = p.zrow;
    for (int item = wg; item < 1024; item += nwg) {
        const int tile = item >> 4, b = (item >> 3) & 1, h = item & 7, t0 = tile * 128, own = t0 >> 8, tw = t0 + wid * 32, bh = b * 8 + h;
        if (own == 0) continue;
        __syncthreads();
        if (tid < 32) lcnt[tid] = 0;
        bf16x8 qf[4];
        {
            const bf16_t* qp = p.proj + (size_t)(b * SEQ + tw + q) * 2840 + 1304 + h * 64 + 8 * hh;
#pragma unroll
            for (int ks = 0; ks < 4; ++ks) qf[ks] = *(const bf16x8*)(qp + 16 * ks);
        }
        const bf16_t* kmb = p.kmeanb + (size_t)(bh * 32) * 64;
        att_stage<8>(kmt, [=](int row, int gcx) { return row < 32 ? kmb + (size_t)row * 64 + gcx * 8 : zr + gcx * 8; }, rc, wid);
        asm volatile("s_waitcnt vmcnt(0)" ::: "memory");
        __syncthreads();
        f32x16 s;
#pragma unroll
        for (int r = 0; r < 16; ++r) s[r] = 0.f;
#pragma unroll
        for (int ks = 0; ks < 4; ++ks) {
            const bf16x8 a = *(const LDSP bf16x8*)(kmt + (L.kbase ^ (32 * (ks & 3))));
            s = __builtin_amdgcn_mfma_f32_32x32x16_bf16(a, qf[ks], s, 0, 0, 0);
        }
        unsigned key[16];
#pragma unroll
        for (int r = 0; r < 16; ++r) {
            const int j = (r & 3) + 8 * (r >> 2) + 4 * hh;
            const unsigned bits = __float_as_uint(s[r]);
            const unsigned srt = (bits & 0x80000000u) ? ~bits : (bits | 0x80000000u);
            key[r] = (j < own) ? ((srt & ~31u) | (unsigned)(31 - j)) : 0u;
        }
        unsigned selm = 0u;
#pragma unroll 1
        for (int rnd = 0; rnd < 3; ++rnd) {
            unsigned m = 0u;
#pragma unroll
            for (int r = 0; r < 16; ++r) m = key[r] > m ? key[r] : m;
            const unsigned mo = (unsigned)__shfl_xor((int)m, 32);
            const unsigned wk = mo > m ? mo : m;
            if (wk != 0u) selm |= 1u << (31 - (wk & 31u));
#pragma unroll
            for (int r = 0; r < 16; ++r) key[r] = (key[r] == wk) ? 0u : key[r];
        }
        if (hh == 0) {
            unsigned mm = selm;
#pragma unroll
            for (int sI = 0; sI < 3; ++sI) {
                int en = -1;
                if (mm) { const int j = __builtin_ctz(mm); mm &= mm - 1u; const int lp = __hip_atomic_fetch_add(lcnt + j, 1, __ATOMIC_RELAXED, __HIP_MEMORY_SCOPE_WORKGROUP); en = (j << 8) | lp; }
                ent[(wid * 32 + q) * 3 + sI] = en;
            }
        }
        __syncthreads();
        if (tid < 32) { const int c = lcnt[tid]; lbase[tid] = c ? atomicAdd(p.mcnt + bh * 32 + tid, c) : 0; }
        __syncthreads();
        for (int e = tid; e < 384; e += 256) {
            const int en = ent[e];
            if (en >= 0) { const int j = en >> 8, tokl = e / 3, sI = e - tokl * 3; p.mlist[(size_t)(bh * 32 + j) * 8192 + lbase[j] + (en & 255)] = (unsigned short)((t0 + tokl) | (sI << 13)); }
        }
    }
}
__device__ __forceinline__ bf16_t* moba_part(const P& p, int slot, size_t row) { return (slot < 2 ? p.mp01 + (size_t)slot * 131072 * 64 : p.mp2) + row * 64; }

__device__ __forceinline__ void moba_inv_item(const P& p, const int lid, const int chunk, LDSP char* lds, const int tid0) {
    LDSP char* kb = lds; LDSP char* vb = lds + 8192; LDSP float* glut = (LDSP float*)(lds + A0_GLUT);
    const float c1 = 0.125f * LOG2E;
    int tid = tid0; asm volatile("" : "+v"(tid));
    const int wid = tid >> 6, lane = tid & 63, q = lane & 31, hh = lane >> 5;
    const int bh = lid / 31, j = lid - bh * 31, b = bh >> 3, h = bh & 7;
    build_lut(glut, p.blut + h * 1024, 1152, 1 << 30, tid);
    AttLane L; att_lane_init<128, 128, 2>(L, lane);
    int rc[1]; att_stage_map<8>(rc, tid);
    const int n = p.mcnt[bh * 32 + j], idx = chunk * 128 + wid * 32 + q;
    const bool valid = idx < n;
    const unsigned en = valid ? (unsigned)p.mlist[(size_t)(bh * 32 + j) * 8192 + idx] : (unsigned)(256 * (j + 1));
    const int tok = (int)(en & 8191u), slot = (int)(en >> 13);
    bf16x8 qf[4];
    {
        const bf16_t* qp = p.proj + (size_t)(b * SEQ + tok) * 2840 + 1304 + h * 64 + 8 * hh;
#pragma unroll
        for (int ks = 0; ks < 4; ++ks) qf[ks] = *(const bf16x8*)(qp + 16 * ks);
    }
    const unsigned gtab = (unsigned)(size_t)glut;
    const bf16_t* kbb = p.proj + (size_t)b * SEQ * 2840 + 1816 + h * 64;
    auto msrc = [&](int pos0, int colo) { return [=](int row, int gcx) { return kbb + (size_t)(pos0 + row) * 2840 + colo + gcx * 8; }; };
    f32x16 o[2];
#pragma unroll
    for (int dt = 0; dt < 2; ++dt)
#pragma unroll
        for (int r = 0; r < 16; ++r) o[dt][r] = 0.f;
    float lsum = 0.f;
    bf16x8 pf[4];
    __syncthreads();
    att_stage<8>(kb, msrc(256 * j, 0), rc, wid);
    for (int i = 0; i < 4; ++i) {
        const int pos0 = 256 * j + 64 * i;
        asm volatile("s_waitcnt vmcnt(0)" ::: "memory"); ATT_BAR();
        att_stage<8>(vb, msrc(pos0, 512), rc, wid);
        {
            int dq = tok - pos0 - 4 * hh; dq = dq > 1087 ? 1087 : dq; dq = valid ? dq : -1;
            att_qk<4, 128, 1, true, false>(kb, L, qf, pf, lsum, c1, 0.f, gtab + (unsigned)(dq + 1) * 4u, 0, nullptr, 0.f);
        }
        asm volatile("s_waitcnt vmcnt(0) lgkmcnt(0)" ::: "memory"); ATT_BAR();
        if (i + 1 < 4) att_stage<8>(kb, msrc(pos0 + 64, 0), rc, wid);
        att_pv<2, 128>(vb, L, pf, o);
    }
    const float lt = lsum + __shfl_xor(lsum, 32);
    if (valid) {
        const size_t row = (size_t)bh * SEQ + tok;
        bf16_t* op = moba_part(p, slot, row) + 4 * hh;
        ATT_STORE_O(op, o, 1.0f);
        if (hh == 0) p.mpl[(size_t)slot * 131072 + row] = lt;
    }
}
__device__ __forceinline__ void moba_own_item(const P& p, const int item, LDSP char* lds, const int tid0) {
    LDSP char* kb = lds; LDSP char* vb = lds + 8192; LDSP float* glut = (LDSP float*)(lds + A0_GLUT);
    const float c1 = 0.125f * LOG2E;
    int tid = tid0; asm volatile("" : "+v"(tid));
    const int wid = tid >> 6, lane = tid & 63, q = lane & 31, hh = lane >> 5;
    const int tile = item >> 4, b = (item >> 3) & 1, h = item & 7, t0 = tile * 128, own = t0 >> 8, tw = t0 + wid * 32, bh = b * 8 + h;
    __syncthreads();
    build_lut(glut, p.blut + h * 1024, 1152, 1 << 30, tid);
    AttLane L; att_lane_init<128, 128, 2>(L, lane);
    int rc[1]; att_stage_map<8>(rc, tid);
    const size_t rowq = (size_t)(b * SEQ + tw + q);
    bf16x8 qf[4];
    {
        const bf16_t* qp = p.proj + rowq * 2840 + 1304 + h * 64 + 8 * hh;
#pragma unroll
        for (int ks = 0; ks < 4; ++ks) qf[ks] = *(const bf16x8*)(qp + 16 * ks);
    }
    const unsigned gtab = (unsigned)(size_t)glut;
    const bf16_t* kbb = p.proj + (size_t)b * SEQ * 2840 + 1816 + h * 64;
    auto msrc = [&](int pos0, int colo) { return [=](int row, int gcx) { return kbb + (size_t)(pos0 + row) * 2840 + colo + gcx * 8; }; };
    f32x16 o[2];
#pragma unroll
    for (int dt = 0; dt < 2; ++dt)
#pragma unroll
        for (int r = 0; r < 16; ++r) o[dt][r] = 0.f;
    float lsum = 0.f;
    bf16x8 pf[4];
    const int nb = (((t0 + 127) >> 6) & 3) + 1;
    __syncthreads();
    att_stage<8>(kb, msrc(256 * own, 0), rc, wid);
    for (int i = 0; i < nb; ++i) {
        const int pos0 = 256 * own + 64 * i;
        asm volatile("s_waitcnt vmcnt(0)" ::: "memory"); ATT_BAR();
        att_stage<8>(vb, msrc(pos0, 512), rc, wid);
        const bool active = pos0 <= tw + 31;
        if (active) {
            int dq = tw + q - pos0 - 4 * hh; dq = dq < -1 ? -1 : dq;
            att_qk<4, 128, 1, true, false>(kb, L, qf, pf, lsum, c1, 0.f, gtab + (unsigned)(dq + 1) * 4u, 0, nullptr, 0.f);
        }
        asm volatile("s_waitcnt vmcnt(0) lgkmcnt(0)" ::: "memory"); ATT_BAR();
        if (i + 1 < nb) att_stage<8>(kb, msrc(pos0 + 64, 0), rc, wid);
        if (active) att_pv<2, 128>(vb, L, pf, o);
    }
    float lt = lsum + __shfl_xor(lsum, 32);
    const int npick = own < 3 ? own : 3;
    const size_t row = (size_t)bh * SEQ + tw + q;
#pragma unroll 1
    for (int sI = 0; sI < npick; ++sI) {
        lt += p.mpl[(size_t)sI * 131072 + row];
        const bf16_t* pp = moba_part(p, sI, row) + 4 * hh;
#pragma unroll
        for (int dt = 0; dt < 2; ++dt)
#pragma unroll
            for (int rq = 0; rq < 4; ++rq) {
                const u32x2 w = *(const u32x2*)(pp + 32 * dt + 8 * rq);
                o[dt][4 * rq] += __uint_as_float(w[0] << 16); o[dt][4 * rq + 1] += __uint_as_float(w[0] & 0xffff0000u);
                o[dt][4 * rq + 2] += __uint_as_float(w[1] << 16); o[dt][4 * rq + 3] += __uint_as_float(w[1] & 0xffff0000u);
            }
    }
    const float inv = 1.0f / lt;
    bf16_t* op = p.o + rowq * DM + 512 + h * 64 + 4 * hh;
    ATT_STORE_O(op, o, inv);
}
__device__ __forceinline__ void st_moba_own(const P& p, int wg, int nwg, LDSP char* lds) {
    const int tid0 = otid();
    for (int item = wg; item < 1024; item += nwg) moba_own_item(p, item, lds, tid0);
}
#define A0_PRE 62736
__device__ __forceinline__ void st_attn0(const P& p, LDSP char* lds) {
    const int tid0 = otid();
    LDSP int* slot = (LDSP int*)(lds + A0_SLOT); LDSP int* pre = (LDSP int*)(lds + A0_PRE);
    LDSP int* tmp = (LDSP int*)lds;
    for (int i = tid0; i < 496; i += 256) { const int bh = i / 31, j = i - bh * 31; tmp[i] = (p.mcnt[bh * 32 + j] + 127) >> 7; }
    __syncthreads();
    for (int i = tid0; i < 497; i += 256) { int s = 0; for (int k = 0; k < i; ++k) s += tmp[k]; pre[i] = s; }
    __syncthreads();
    const int ninv = pre[496];
    for (;;) {
        const int item = wq_next(p.wq + 1, slot, tid0);
        const int ntail = 5 * 768 + (ninv > 3072 ? ninv - 3072 : 0);
        if (item >= 1024 + ntail) break;
        if (item < 1024) nsa_item(p, item, lds, tid0);
        else {
            const int r = item - 1024, g = r / 5, ps = r - g * 5;
            if (g < 768 && ps == 4) { moe_conv_item(p, 0, g, lds, tid0); continue; }
            const int idx = (g < 768) ? g * 4 + ps : 3072 + (r - 5 * 768);
            if (idx >= ninv) continue;
            int lo = 0, hi = 495;
            while (lo < hi) { const int mid = (lo + hi + 1) >> 1; if (pre[mid] <= idx) lo = mid; else hi = mid - 1; }
            moba_inv_item(p, lo, idx - pre[lo], lds, tid0);
        }
    }
}

#define XB_TMO      128
#define XB_XCNT(j)  (256  + 64 * (j))
#define XB_XSUB(j)  (1280 + 64 * (j))
#define XB_XGEN(j)  (2304 + 64 * (j))
#define XB_TOP      3328
#define XB_TOPGEN   3392
#define XCD_BAR_WORDS 3456
#define XB_SPIN_CAP (1u << 20)
#define LAS __attribute__((address_space(3)))

__device__ __forceinline__ unsigned xb_ld(unsigned* p)              { return __hip_atomic_load(p, __ATOMIC_RELAXED, __HIP_MEMORY_SCOPE_AGENT); }
__device__ __forceinline__ unsigned xb_add(unsigned* p, unsigned v) { return __hip_atomic_fetch_add(p, v, __ATOMIC_RELAXED, __HIP_MEMORY_SCOPE_AGENT); }
__device__ __forceinline__ unsigned xb_xcc_id() { return (unsigned)__builtin_amdgcn_s_getreg((3 << 11) | 20) & 0xFu; }
#define XB_SPIN(cond, bar) do { unsigned _sp = 0; while (cond) { __builtin_amdgcn_s_sleep(1); \
    if ((++_sp & 255u) == 0u) { if (xb_ld(&(bar)[XB_TMO])) break; if (_sp > XB_SPIN_CAP) { atomicAdd(&(bar)[XB_TMO], 1u); break; } } } } while (0)

struct XcdBarrier {
    unsigned* bar; unsigned x;
    volatile LAS unsigned* st;
};

__device__ __forceinline__ XcdBarrier xcd_barrier_post(unsigned* bar, volatile LAS unsigned* st) {
    XcdBarrier b; b.bar = bar; b.x = xb_xcc_id(); b.st = st;
    if (threadIdx.x == 0) (void)xb_add(&bar[XB_XCNT(b.x)], 1u);
    return b;
}
__device__ __forceinline__ void xcd_barrier_complete(unsigned* bar, unsigned x, unsigned& nloc, unsigned& nx) {
    const unsigned G = gridDim.x * gridDim.y * gridDim.z;
    unsigned sum, cnt, mine, sp = 0u;
    for (;;) {
        sum = 0u; cnt = 0u; mine = 0u;
#pragma unroll
        for (unsigned j = 0; j < 16; ++j) { const unsigned c = xb_ld(&bar[XB_XCNT(j)]); sum += c; cnt += (c > 0u) ? 1u : 0u; mine = (j == x) ? c : mine; }
        if (sum == G) break;
        __builtin_amdgcn_s_sleep(1);
        if ((++sp & 255u) == 0u) { if (xb_ld(&bar[XB_TMO])) break; if (sp > XB_SPIN_CAP) { atomicAdd(&bar[XB_TMO], 1u); break; } }
    }
    nloc = mine > 0u ? mine : 1u; nx = cnt > 0u ? cnt : 1u;
}

__device__ __forceinline__ void xcd_barrier(const XcdBarrier& b) {
    asm volatile("s_waitcnt vmcnt(0)" ::: "memory");
    __syncthreads();
    if (threadIdx.x == 0) {
        unsigned* bar = b.bar;
        __builtin_amdgcn_s_waitcnt(0);
        unsigned nloc = b.st[0], nx = b.st[1];
        if (nloc == 0u) { xcd_barrier_complete(bar, b.x, nloc, nx); b.st[0] = nloc; b.st[1] = nx; }
        const unsigned old = xb_add(&bar[XB_XSUB(b.x)], 1u);
        const unsigned gen = old / nloc;
        if (old + 1u == (gen + 1u) * nloc) {
            __builtin_amdgcn_fence(__ATOMIC_RELEASE, "agent");
            asm volatile("s_waitcnt vmcnt(0)" ::: "memory");
            const unsigned og = xb_add(&bar[XB_TOP], 1u);
            const unsigned tg = og / nx;
            if (og + 1u == (tg + 1u) * nx) xb_add(&bar[XB_TOPGEN], 1u);
            else XB_SPIN(xb_ld(&bar[XB_TOPGEN]) == tg, bar);
            __builtin_amdgcn_fence(__ATOMIC_ACQUIRE, "agent");
            xb_add(&bar[XB_XGEN(b.x)], 1u);
            asm volatile("s_waitcnt vmcnt(0)" ::: "memory");
        } else {
            XB_SPIN(xb_ld(&bar[XB_XGEN(b.x)]) == gen, bar);
            __builtin_amdgcn_fence(__ATOMIC_ACQUIRE, "agent");
            asm volatile("s_waitcnt vmcnt(0)" ::: "memory");
        }
    }
    __syncthreads();
}


#define PHASE_SYNC() do { PP qb_ = (PP)__builtin_amdgcn_kernarg_segment_ptr(); asm volatile("" : "+s"(qb_)); XcdBarrier b_; b_.bar = qb_->bar; b_.x = xb_xcc_id(); \
        b_.st = (volatile LAS unsigned*)(dlds + BAR_LDS_OFF); xcd_barrier(b_); } while (0)
typedef const __attribute__((address_space(4))) P* PP;
#define BAR_SAVE() const unsigned bs0_ = __builtin_amdgcn_readfirstlane(*(volatile LAS unsigned*)(dlds + BAR_LDS_OFF)), \
        bs1_ = __builtin_amdgcn_readfirstlane(*(volatile LAS unsigned*)(dlds + BAR_LDS_OFF + 4)); __syncthreads()
#define BAR_RESTORE() do { __syncthreads(); if (threadIdx.x == 0) { *(volatile LAS unsigned*)(dlds + BAR_LDS_OFF) = bs0_; *(volatile LAS unsigned*)(dlds + BAR_LDS_OFF + 4) = bs1_; } } while (0)
#define PHASE_ARGS() PP q_ = (PP)__builtin_amdgcn_kernarg_segment_ptr(); int wg = blockIdx.x, nwg = gridDim.x; asm volatile("" : "+s"(q_), "+s"(wg), "+s"(nwg)); P p; { const __attribute__((address_space(4))) unsigned long long* s64_ = (const __attribute__((address_space(4))) unsigned long long*)q_; unsigned long long* d64_ = (unsigned long long*)&p; _Pragma("unroll") for (int i_ = 0; i_ < (int)(sizeof(P) / 8); ++i_) d64_[i_] = s64_[i_]; } float* sm = (float*)dlds; LDSP char* lds = (LDSP char*)dlds; (void)sm; (void)lds
__global__ void __launch_bounds__(256, 2) k_mega(P pk) {
    extern __shared__ __attribute__((aligned(16))) unsigned char dlds[];
    if (threadIdx.x == 0) *(uint4*)(dlds + BAR_LDS_OFF) = make_uint4(0u, 0u, 0u, 0u);
    __syncthreads();
    (void)xcd_barrier_post(pk.bar, (volatile LAS unsigned*)(dlds + BAR_LDS_OFF));
    { PHASE_ARGS(); st_prologue(p, wg, nwg, sm); st_convert(p, wg, nwg, sm); } PHASE_SYNC();
    { PHASE_ARGS(); st_norm<0>(p, 0, wg, nwg, sm); st_c1_reduce(p, wg, nwg); } PHASE_SYNC();
    { PHASE_ARGS(); BAR_SAVE(); st_inproj0_mf<6>(p, wg, nwg, lds); BAR_RESTORE(); } PHASE_SYNC();
    { PHASE_ARGS(); st_cmp1_mf(p, wg, nwg, lds); st_kmean(p, wg, nwg, sm); } PHASE_SYNC();
    { PHASE_ARGS(); st_cmp2_mf(p, wg, nwg, lds); st_moba_gate(p, wg, nwg, lds); } PHASE_SYNC();
    { PHASE_ARGS(); st_attn0(p, lds); } PHASE_SYNC();
    { PHASE_ARGS(); st_moba_own(p, wg, nwg, lds); } PHASE_SYNC();
    { PHASE_ARGS(); st_outproj_mf<4>(p, 0, wg, nwg, lds); } PHASE_SYNC();
    { PHASE_ARGS(); st_norm<1>(p, 0, wg, nwg, sm); } PHASE_SYNC();
    { PHASE_ARGS(); BAR_SAVE(); st_moe_up_mf<6>(p, 0, wg, nwg, lds); BAR_RESTORE(); } PHASE_SYNC();
    { PHASE_ARGS(); BAR_SAVE(); st_moe_down_mf<6>(p, 0, wg, nwg, lds); BAR_RESTORE(); } PHASE_SYNC();
    { PHASE_ARGS(); st_norm<2>(p, 1, wg, nwg, sm); } PHASE_SYNC();
    { PHASE_ARGS(); BAR_SAVE(); st_inproj1_mf<6>(p, wg, nwg, lds); BAR_RESTORE(); } PHASE_SYNC();
    { PHASE_ARGS(); st_mla_prep(p, wg, nwg); } PHASE_SYNC();
    { PHASE_ARGS(); st_mla_up_mf(p, wg, nwg, lds); } PHASE_SYNC();
    { PHASE_ARGS(); st_attn1(p, lds); } PHASE_SYNC();
    { PHASE_ARGS(); st_mla_combine(p, wg, nwg); } PHASE_SYNC();
    { PHASE_ARGS(); st_outproj_mf<4>(p, 1, wg, nwg, lds); } PHASE_SYNC();
    { PHASE_ARGS(); st_norm<1>(p, 1, wg, nwg, sm); } PHASE_SYNC();
    { PHASE_ARGS(); BAR_SAVE(); st_moe_up_mf<6>(p, 1, wg, nwg, lds); BAR_RESTORE(); } PHASE_SYNC();
    { PHASE_ARGS(); BAR_SAVE(); st_moe_down_mf<6>(p, 1, wg, nwg, lds); BAR_RESTORE(); } PHASE_SYNC();
    { PHASE_ARGS(); st_norm<3>(p, 1, wg, nwg, sm); }
}

extern "C" void kernel_launch(void* const* d_in, const int* in_sizes, int n_in, void* d_out, int out_size, void* d_ws, size_t ws_size,
                              hipStream_t stream) {
    (void)in_sizes; (void)n_in; (void)out_size; (void)ws_size;
    P p{};
    const float* const* in = (const float* const*)d_in;
    p.x = in[0]; p.c = in[1]; p.rel = in[2]; p.router_w = in[3]; p.router_b = in[4]; p.final_norm = in[5]; p.norm_mix = in[6]; p.norm_ffn = in[7];
    p.ada_w = in[8]; p.ada_b = in[9]; p.moe_wg = in[10]; p.moe_wu = in[11]; p.moe_wd = in[12]; p.ev_w_in = in[13]; p.ev_w_out = in[14];
    p.pos_k = in[15]; p.pos_v = in[16]; p.ck_w1 = in[17]; p.ck_w2 = in[18]; p.cv_w1 = in[19]; p.cv_w2 = in[20]; p.od_w_in = in[21]; p.od_w_out = in[22];
    p.q_norm = in[23]; p.kv_norm = in[24]; p.w_q_up = in[25]; p.w_kv_up = in[26]; p.sinks = in[27];
    p.out = (float*)d_out;
    char* ws = (char*)d_ws; size_t off = 0;
    auto take = [&](size_t bytes) { char* r = ws + off; off += (bytes + 255) & ~(size_t)255; return r; };
    p.bar = (unsigned*)take(16384);
    p.cnt = (int*)take(4096);
    p.wq = (int*)take(256);
    p.mcnt = (int*)take(512 * 4);
    p.modv = (float*)take(2 * 2 * 6144 * 4);
    p.zrow = (bf16_t*)take(256);
    const size_t zero_bytes = off;
    p.ropec = (float*)take(SEQ * 32 * 4); p.ropes = (float*)take(SEQ * 32 * 4);
    p.blut = (float*)take(8 * 1024 * 4);
    p.gates = (float*)take((size_t)T_TOK * 24 * 4);
    p.kmean = (float*)take(2 * 8 * 32 * 64 * 4);
    p.tokw = (float*)take((size_t)T_TOK * 2 * 4);
    p.list = (int*)take((size_t)16 * T_TOK * 4);
    p.cqn = (bf16_t*)take((size_t)T_TOK * 384 * 2);
    p.krope = (bf16_t*)take((size_t)T_TOK * 64 * 2);
    p.h = (bf16_t*)take((size_t)T_TOK * DM * 2);
    p.o = (bf16_t*)take((size_t)T_TOK * DM * 2);
    p.mlap = p.h;
    p.mlal = (float*)(p.h + (size_t)2 * 8 * (SEQ / 2) * 128);
    p.mp01 = p.h;
    p.mp2 = (bf16_t*)take((size_t)131072 * 64 * 2);
    p.mpl = (float*)take((size_t)3 * 131072 * 4);
    p.mlist = (unsigned short*)take((size_t)16 * 32 * 8192 * 2);
    p.hid = p.o;
    char* region = take((size_t)100 * 1024 * 1024);
    p.proj = (bf16_t*)region;
    p.proj1 = (bf16_t*)region;
    p.qmla = (bf16_t*)(region + (size_t)T_TOK * 1216 * 2);
    p.kvmla = (bf16_t*)(region + (size_t)T_TOK * (1216 + 768) * 2);
    p.y = (bf16_t*)region;
    p.chidb = (bf16_t*)take((size_t)2 * 2048 * 256 * 2);
    p.kcmpb = (bf16_t*)take((size_t)8 * 512 * 64 * 2);
    p.kmeanb = (bf16_t*)take((size_t)2 * 8 * 32 * 64 * 2);
    p.c1 = (float*)take(512 * 4);
    p.c1p = (float*)take((size_t)2 * 64 * 256 * 4);
    p.wt_gu = (bf16_t*)take((size_t)32 * 1024 * 1024 * 2);
    p.wt_d = (bf16_t*)take((size_t)32 * 1024 * 512 * 2);
    p.wt_in0 = (bf16_t*)take((size_t)2840 * 1024 * 2);
    p.wt_out0 = (bf16_t*)take((size_t)1024 * 1024 * 2);
    p.wt_c1 = (bf16_t*)take((size_t)2 * 256 * 2048 * 2);
    p.wt_c2 = (bf16_t*)take((size_t)2 * 64 * 256 * 2);
    p.wt_in1 = (bf16_t*)take((size_t)1216 * 1024 * 2);
    p.wt_out1 = (bf16_t*)take((size_t)1024 * 1024 * 2);
    p.wt_qup = (bf16_t*)take((size_t)768 * 256 * 2);
    p.wt_kvup = (bf16_t*)take((size_t)1024 * 128 * 2);
    static int grid = 0;
    if (!grid) {
        int dev = 0, cus = 0, per_cu = 0;
        (void)hipGetDevice(&dev);
        (void)hipDeviceGetAttribute(&cus, hipDeviceAttributeMultiprocessorCount, dev);
        (void)hipFuncSetAttribute((const void*)k_mega, hipFuncAttributeMaxDynamicSharedMemorySize, KERNEL_LDS_BYTES);
        (void)hipOccupancyMaxActiveBlocksPerMultiprocessor(&per_cu, k_mega, 256, KERNEL_LDS_BYTES);
        if (cus <= 0) cus = 256;
        if (per_cu < 1) per_cu = 1;
        grid = cus * (per_cu < 2 ? per_cu : 2);
    }
    (void)hipMemsetAsync(d_ws, 0, zero_bytes, stream);
    hipLaunchKernelGGL(k_mega, dim3(grid), dim3(256), KERNEL_LDS_BYTES, stream, p);
}
```

```cpp
#include <hip/hip_runtime.h>
#include <stdint.h>

#define T_TOK 16384
#define SEQ 8192
#define DM 1024
#define NEGF (-1e30f)
#define BIGF (1e30f)

typedef unsigned short bf16_t;

__device__ __forceinline__ float bf2f(bf16_t v) { return __uint_as_float(((unsigned)v) << 16); }
__device__ __forceinline__ bf16_t f2bf(float f) {
    unsigned u = __float_as_uint(f);
    u += 0x7fffu + ((u >> 16) & 1u);
    return (bf16_t)(u >> 16);
}
typedef __bf16 bf16x2_t __attribute__((ext_vector_type(2)));
typedef float f32x2_t __attribute__((ext_vector_type(2)));
__device__ __forceinline__ unsigned cvtpk(float lo, float hi) { const f32x2_t f = {lo, hi}; return __builtin_bit_cast(unsigned, __builtin_convertvector(f, bf16x2_t)); }
__device__ __forceinline__ unsigned cvtpk_valu(float lo, float hi) { unsigned r; asm("s_nop 0\n\tv_cvt_pk_bf16_f32 %0, %1, %2" : "=v"(r) : "v"(lo), "v"(hi)); return r; }
__device__ __forceinline__ float wsum(float v) {
#pragma unroll
    for (int o = 32; o > 0; o >>= 1) v += __shfl_xor(v, o);
    return v;
}
__device__ __forceinline__ float siluf(float v) { return v / (1.0f + __expf(-v)); }
__device__ __forceinline__ float sigmf(float v) { return 1.0f / (1.0f + __expf(-v)); }
__device__ __forceinline__ float gelu_tanh(float x) {
    const float k0 = 0.7978845608028654f, k1 = 0.044715f;
    float u = k0 * (x + k1 * x * x * x);
    return 0.5f * x * (1.0f + tanhf(u));
}
__device__ __forceinline__ int rel_bucket(int d) {
    if (d < 16) return d < 0 ? 0 : d;
    int b = 16;
    b += (d >= 21); b += (d >= 27); b += (d >= 35); b += (d >= 46); b += (d >= 59); b += (d >= 77); b += (d >= 99); b += (d >= 128);
    b += (d >= 166); b += (d >= 216); b += (d >= 280); b += (d >= 363); b += (d >= 470); b += (d >= 609); b += (d >= 790);
    return b;
}

__device__ __forceinline__ int otid() { int t = threadIdx.x; asm volatile("" : "+v"(t)); return t; }

struct P {
    const float *x, *c, *rel, *router_w, *router_b, *final_norm, *norm_mix, *norm_ffn, *ada_w, *ada_b, *moe_wg, *moe_wu, *moe_wd,
        *ev_w_in, *ev_w_out, *pos_k, *pos_v, *ck_w1, *ck_w2, *cv_w1, *cv_w2, *od_w_in, *od_w_out, *q_norm, *kv_norm, *w_q_up, *w_kv_up, *sinks;
    float* out;
    unsigned* bar; int* cnt;
    float *modv, *ropec, *ropes, *blut, *gates, *kcmp, *vcmp, *chid, *kmean, *tokw;
    bf16_t *h, *proj, *o, *hid, *y, *proj1, *qmla, *kvmla, *krope, *cqn;
    int* list;
    bf16_t *wt_gu, *wt_d, *wt_in0, *wt_out0, *wt_c1, *wt_c2, *wt_in1, *wt_out1, *wt_qup, *wt_kvup, *chidb;
    float *c1, *c1p;
    int* wq;
    bf16_t* zrow;
    bf16_t *kcmpb, *kmeanb, *mlap;
    float* mlal;
    int* mcnt; unsigned short* mlist; bf16_t *mp01, *mp2; float* mpl;
};


__device__ __forceinline__ void st_prologue(const P& p, int wg, int nwg, float* sm) {
    const int TIDX = otid();
    const int tid = TIDX;
    {
        for (int i = tid; i < 2048; i += 256) sm[i] = siluf(p.c[i]);
        __syncthreads();
        const int wid = tid >> 6, lane = tid & 63;
        for (int w = wg; w < 192; w += nwg) {
            const int l = w / 96, cg = w % 96, col = cg * 64 + lane;
            const float* W = p.ada_w + (size_t)l * 1024 * 6144 + (size_t)(wid * 256) * 6144 + col;
            float a0 = 0.f, a1 = 0.f;
#pragma unroll 32
            for (int k = 0; k < 256; ++k) { const float wv = W[(size_t)k * 6144]; a0 += sm[wid * 256 + k] * wv; a1 += sm[1024 + wid * 256 + k] * wv; }
            sm[2048 + tid] = a0; sm[2304 + tid] = a1;
            __syncthreads();
            if (tid < 64) {
                const float bb = p.ada_b[l * 6144 + col];
                p.modv[(l * 2 + 0) * 6144 + col] = ((sm[2048 + tid] + sm[2048 + 64 + tid]) + (sm[2048 + 128 + tid] + sm[2048 + 192 + tid])) + bb;
                p.modv[(l * 2 + 1) * 6144 + col] = ((sm[2304 + tid] + sm[2304 + 64 + tid]) + (sm[2304 + 128 + tid] + sm[2304 + 192 + tid])) + bb;
            }
            __syncthreads();
        }
        __syncthreads();
    }
    for (int i = wg * 256 + tid; i < SEQ * 32; i += nwg * 256) {
        const int t = i >> 5, j = i & 31;
        const float inv = powf(10000.0f, -(float)(2 * j) / 64.0f);
        const float ang = (float)t * inv;
        p.ropec[i] = cosf(ang); p.ropes[i] = sinf(ang);
    }
    for (int i = wg * 256 + tid; i < 8 * 1024; i += nwg * 256) { const int h = i >> 10, d = i & 1023; p.blut[i] = p.rel[rel_bucket(d) * 8 + h]; }
}

#define RT_OFF 1024
template <int MODE>
__device__ __forceinline__ void st_norm(const P& p, int layer, int wg, int nwg, float* sm) {
    const int TIDX = otid();
    const int wid = TIDX >> 6, lane = TIDX & 63;
    int* rl_cnt = (int*)sm; int* rl_base = rl_cnt + 16; int* rl_ent = rl_cnt + 32;
    if (MODE == 1) {
        if (TIDX < 16) rl_cnt[TIDX] = 0;
        for (int i = TIDX; i < 64; i += 256) rl_ent[i] = -1;
        for (int idx = TIDX; idx < 4096; idx += 256) {
            const int col = idx >> 2, q = idx & 3;
            *(float4*)((char*)sm + RT_OFF + q * 16384 + (col & 3) * 4096 + ((col >> 8) * 64 + ((col >> 2) & 63)) * 16) = *(const float4*)(p.router_w + idx * 4);
        }
        __syncthreads();
    }
    const int niter = (T_TOK + nwg * 4 - 1) / (nwg * 4);
    const float* xin = (MODE == 0) ? p.x : p.out;
    float4 pre4[4];
    {
        const int row0 = wg * 4 + wid;
#pragma unroll
        for (int i = 0; i < 4; ++i) pre4[i] = (row0 < T_TOK) ? *(const float4*)(xin + (size_t)row0 * DM + i * 256 + lane * 4) : make_float4(0.f, 0.f, 0.f, 0.f);
    }
    for (int it = 0; it < niter; ++it) {
        const int row = wg * 4 + wid + it * nwg * 4;
        if (MODE != 1 && row >= T_TOK) break;
        float v[16];
#pragma unroll
        for (int i = 0; i < 4; ++i) { v[i * 4 + 0] = pre4[i].x; v[i * 4 + 1] = pre4[i].y; v[i * 4 + 2] = pre4[i].z; v[i * 4 + 3] = pre4[i].w; }
        {
            const int rown = row + nwg * 4;
            if (rown < T_TOK) {
#pragma unroll
                for (int i = 0; i < 4; ++i) pre4[i] = *(const float4*)(xin + (size_t)rown * DM + i * 256 + lane * 4);
            }
        }
        if (MODE != 1 || row < T_TOK) {
        const int b = row >> 13;
        if (MODE >= 2) {
            const int lp = (MODE == 2) ? layer - 1 : 1;
            const float* gf = p.modv + (size_t)(lp * 2 + b) * 6144 + 5 * 1024;
#pragma unroll
            for (int i = 0; i < 4; ++i)
#pragma unroll
                for (int j = 0; j < 4; ++j) {
                    const int col = i * 256 + lane * 4 + j;
                    const float y0 = bf2f(p.y[(size_t)(2 * row) * DM + col]), y1 = bf2f(p.y[(size_t)(2 * row + 1) * DM + col]);
                    v[i * 4 + j] += gf[col] * (y0 + y1);
                }
            if (MODE == 2) {
#pragma unroll
                for (int i = 0; i < 4; ++i)
                    *(float4*)(p.out + (size_t)row * DM + i * 256 + lane * 4) = make_float4(v[i * 4], v[i * 4 + 1], v[i * 4 + 2], v[i * 4 + 3]);
            }
        }
        float ss = 0.f;
#pragma unroll
        for (int i = 0; i < 16; ++i) ss += v[i] * v[i];
        ss = wsum(ss);
        const float r = rsqrtf(ss * (1.0f / 1024.0f) + 1e-6f);
        if (MODE == 3) {
#pragma unroll
            for (int i = 0; i < 4; ++i) {
                const float4 g4 = *(const float4*)(p.final_norm + i * 256 + lane * 4);
                *(float4*)(p.out + (size_t)row * DM + i * 256 + lane * 4) =
                    make_float4(v[i * 4] * r * g4.x, v[i * 4 + 1] * r * g4.y, v[i * 4 + 2] * r * g4.z, v[i * 4 + 3] * r * g4.w);
            }
            continue;
        }
        const float* g = ((MODE == 1) ? p.norm_ffn : p.norm_mix) + layer * 1024;
        const float* mv = p.modv + (size_t)(layer * 2 + b) * 6144;
        const float* shift = mv + ((MODE == 1) ? 3 : 0) * 1024;
        const float* scale = mv + ((MODE == 1) ? 4 : 1) * 1024;
        float hv[16];
#pragma unroll
        for (int i = 0; i < 4; ++i)
#pragma unroll
            for (int j = 0; j < 4; ++j) {
                const int col = i * 256 + lane * 4 + j;
                hv[i * 4 + j] = v[i * 4 + j] * r * g[col] * (1.0f + scale[col]) + shift[col];
                p.h[(size_t)row * DM + col] = f2bf(hv[i * 4 + j]);
            }
        if (MODE == 1) {
            float lg[16];
#pragma unroll
            for (int e = 0; e < 16; ++e) lg[e] = 0.f;
#pragma unroll
            for (int i = 0; i < 4; ++i)
#pragma unroll
                for (int j = 0; j < 4; ++j) {
                    const char* rw = (const char*)sm + RT_OFF + lane * 16 + j * 4096 + i * 1024;
#pragma unroll
                    for (int q = 0; q < 4; ++q) {
                        const float4 w4 = *(const float4*)(rw + q * 16384);
                        lg[4 * q] += hv[i * 4 + j] * w4.x; lg[4 * q + 1] += hv[i * 4 + j] * w4.y; lg[4 * q + 2] += hv[i * 4 + j] * w4.z; lg[4 * q + 3] += hv[i * 4 + j] * w4.w;
                    }
                    asm volatile("" ::: "memory");
                }
#pragma unroll
            for (int e = 0; e < 16; ++e) lg[e] = wsum(lg[e]);
            float aff[16], bi[16];
#pragma unroll
            for (int e = 0; e < 16; ++e) { aff[e] = 1.0f / (1.0f + expf(-lg[e])); bi[e] = aff[e] + p.router_b[e]; }
            float bestsc = -3e38f; int be0 = 0, be1 = 1; float bw0 = 0.f, bw1 = 0.f;
#pragma unroll
            for (int gI = 0; gI < 4; ++gI) {
                int i1 = 0; float m1 = bi[gI * 4];
#pragma unroll
                for (int i = 1; i < 4; ++i) if (bi[gI * 4 + i] > m1) { m1 = bi[gI * 4 + i]; i1 = i; }
                int i2 = -1; float m2 = -3e38f;
#pragma unroll
                for (int i = 0; i < 4; ++i) if (i != i1 && bi[gI * 4 + i] > m2) { m2 = bi[gI * 4 + i]; i2 = i; }
                const float sc = m1 + m2;
                float a1 = 0.f, a2 = 0.f;
#pragma unroll
                for (int i = 0; i < 4; ++i) { a1 = (i == i1) ? aff[gI * 4 + i] : a1; a2 = (i == i2) ? aff[gI * 4 + i] : a2; }
                if (sc > bestsc) { bestsc = sc; be0 = gI * 4 + i1; be1 = gI * 4 + i2; bw0 = a1; bw1 = a2; }
            }
            if (lane == 0) {
                const float ws = bw0 + bw1;
                p.tokw[row * 2] = bw0 / ws; p.tokw[row * 2 + 1] = bw1 / ws;
                const int s_ = (it & 7) * 4 + wid;
                const int r0 = atomicAdd(&rl_cnt[be0], 1), r1 = atomicAdd(&rl_cnt[be1], 1);
                rl_ent[s_ * 2] = (row << 12) | (be0 << 8) | r0;
                rl_ent[s_ * 2 + 1] = (row << 12) | (be1 << 8) | r1;
            }
        }
        }
        if (MODE == 1 && ((it & 7) == 7 || it == niter - 1)) {
            __syncthreads();
            if (TIDX < 16) { const int c = rl_cnt[TIDX]; rl_base[TIDX] = c ? atomicAdd(&p.cnt[(layer * 16 + TIDX) * 32], c) : 0; rl_cnt[TIDX] = 0; }
            __syncthreads();
            if (TIDX < 64) {
                const int en = rl_ent[TIDX];
                if (en >= 0) { const int e = (en >> 8) & 15; p.list[e * T_TOK + rl_base[e] + (en & 255)] = (en >> 12) * 2 + (TIDX & 1); rl_ent[TIDX] = -1; }
            }
            __syncthreads();
        }
    }
}

__device__ __forceinline__ void st_kmean(const P& p, int wg, int nwg, float* sm) {
    const int TIDX = otid();
    const int wid = TIDX >> 6, lane = TIDX & 63;
    for (int w = wg; w < 2 * 8 * 32; w += nwg) {
        const int b = w >> 8, h = (w >> 5) & 7, j = w & 31;
        const bf16_t* kp = p.proj + (size_t)(b * SEQ + j * 256 + wid * 64) * 2840 + 1816 + h * 64 + lane;
        float s = 0.f;
#pragma unroll 16
        for (int i = 0; i < 64; ++i) s += bf2f(kp[(size_t)i * 2840]);
        __syncthreads();
        sm[TIDX] = s;
        __syncthreads();
        if (TIDX < 64) {
            const float m = ((sm[TIDX] + sm[64 + TIDX]) + (sm[128 + TIDX] + sm[192 + TIDX])) * (1.0f / 256.0f);
            p.kmean[(size_t)w * 64 + TIDX] = m;
            p.kmeanb[(size_t)w * 64 + TIDX] = f2bf(m);
        }
    }
}
__device__ __forceinline__ void st_mla_prep(const P& p, int wg, int nwg) {
    const int TIDX = otid();
    const int wid = TIDX >> 6, lane = TIDX & 63;
    for (int row = wg * 4 + wid; row < T_TOK; row += nwg * 4) {
        const int t = row & (SEQ - 1);
        const bf16_t* pr = p.proj1 + (size_t)row * 1216;
        float q[4], ss = 0.f;
#pragma unroll
        for (int i = 0; i < 4; ++i) { q[i] = bf2f(pr[i * 64 + lane]); ss += q[i] * q[i]; }
        ss = wsum(ss);
        float r = rsqrtf(ss * (1.0f / 256.0f) + 1e-6f);
#pragma unroll
        for (int i = 0; i < 4; ++i) p.cqn[(size_t)row * 384 + i * 64 + lane] = f2bf(q[i] * r * p.q_norm[i * 64 + lane]);
        float kvv[2]; ss = 0.f;
#pragma unroll
        for (int i = 0; i < 2; ++i) { kvv[i] = bf2f(pr[256 + i * 64 + lane]); ss += kvv[i] * kvv[i]; }
        ss = wsum(ss);
        r = rsqrtf(ss * (1.0f / 128.0f) + 1e-6f);
#pragma unroll
        for (int i = 0; i < 2; ++i) p.cqn[(size_t)row * 384 + 256 + i * 64 + lane] = f2bf(kvv[i] * r * p.kv_norm[i * 64 + lane]);
        if (lane < 32) {
            const float x1 = bf2f(pr[384 + lane]), x2 = bf2f(pr[384 + 32 + lane]);
            const float cs = p.ropec[t * 32 + lane], sn = p.ropes[t * 32 + lane];
            p.krope[(size_t)row * 64 + lane] = f2bf(x1 * cs - x2 * sn);
            p.krope[(size_t)row * 64 + 32 + lane] = f2bf(x1 * sn + x2 * cs);
        }
    }
}


typedef short bf16x8 __attribute__((ext_vector_type(8)));
typedef float f32x4 __attribute__((ext_vector_type(4)));
typedef unsigned u32x2 __attribute__((ext_vector_type(2)));
typedef unsigned u32x4v __attribute__((ext_vector_type(4)));
#define LDSP __attribute__((address_space(3)))
#define GEMM_LDS_BYTES 81920
#define KERNEL_LDS_BYTES 81920
#define BAR_LDS_OFF (KERNEL_LDS_BYTES - 16)

__device__ __forceinline__ unsigned pack_bf16(float lo, float hi) { return cvtpk(lo, hi); }

template <int MF, class AR, class BR, class Epi, class NX>
__device__ __forceinline__ void gemm128x(const int nk, const size_t akstep, const size_t bkstep, AR arow, BR brow, Epi epi, LDSP char* lds, const int tid, const bool staged, NX next) {
    constexpr int SS = MF * 4096 + 16384, BO = MF * 4096;
    const int wid = tid >> 6, lane = tid & 63, wr = wid >> 1, wc = wid & 1, fr = lane & 15, fq = lane >> 4;
    const int srow = tid >> 3, gch = ((tid & 7) ^ (srow & 7)) * 8;
    const bf16_t* ap[MF]; const bf16_t* bp[4];
#pragma unroll
    for (int i = 0; i < MF; ++i) ap[i] = arow(32 * i + srow) + gch;
#pragma unroll
    for (int i = 0; i < 4; ++i) bp[i] = brow(32 * i + srow) + gch;
    LDSP char* lw = lds + wid * 1024;
#define G128_ISSUE(st, kt) do { LDSP char* la_ = lw + (st) * SS; const size_t ao_ = (size_t)(kt) * akstep, bo_ = (size_t)(kt) * bkstep; \
        _Pragma("unroll") for (int i_ = 0; i_ < MF; ++i_) __builtin_amdgcn_global_load_lds((const unsigned*)(ap[i_] + ao_), (LDSP unsigned*)(la_ + 4096 * i_), 16, 0, 0); \
        _Pragma("unroll") for (int i_ = 0; i_ < 4; ++i_) __builtin_amdgcn_global_load_lds((const unsigned*)(bp[i_] + bo_), (LDSP unsigned*)(la_ + BO + 4096 * i_), 16, 0, 0); } while (0)
    f32x4 acc[MF][4];
#pragma unroll
    for (int m = 0; m < MF; ++m)
#pragma unroll
        for (int n = 0; n < 4; ++n) acc[m][n] = (f32x4){0.f, 0.f, 0.f, 0.f};
    const int aoff = (wr * 16 * MF + fr) * 128, boff = BO + (wc * 64 + fr) * 128, c0 = (fq ^ (fr & 7)) * 16;
    if (!staged) G128_ISSUE(0, 0);
    for (int kt = 0; kt < nk; ++kt) {
        const int cur = kt & 1;
        asm volatile("s_waitcnt vmcnt(0)" ::: "memory");
        __builtin_amdgcn_s_barrier();
        asm volatile("" ::: "memory");
        LDSP char* sb = lds + cur * SS;
        constexpr int NG = 2 * MF, PD = 3;
        bf16x8 af[NG], bf[2][4];
#define G128_AF(s_) (*(const LDSP bf16x8*)(sb + aoff + ((s_) % MF) * 2048 + (((s_) / MF) ? (c0 ^ 64) : c0)))
#pragma unroll
        for (int n = 0; n < 4; ++n) bf[0][n] = *(const LDSP bf16x8*)(sb + boff + n * 2048 + c0);
#pragma unroll
        for (int s = 0; s < PD; ++s) af[s] = G128_AF(s);
        __builtin_amdgcn_sched_barrier(0);
        if (kt + 1 < nk) G128_ISSUE(cur ^ 1, kt + 1);
        __builtin_amdgcn_sched_barrier(0);
#pragma unroll
        for (int s = 0; s < NG; ++s) {
            if (s + PD < NG) af[s + PD] = G128_AF(s + PD);
            if (s == MF - PD) {
#pragma unroll
                for (int n = 0; n < 4; ++n) bf[1][n] = *(const LDSP bf16x8*)(sb + boff + n * 2048 + (c0 ^ 64));
            }
#pragma unroll
            for (int n = 0; n < 4; ++n) acc[s % MF][n] = __builtin_amdgcn_mfma_f32_16x16x32_bf16(bf[s / MF][n], af[s], acc[s % MF][n], 0, 0, 0);
            __builtin_amdgcn_sched_barrier(0);
        }
#undef G128_AF
    }
    asm volatile("s_waitcnt lgkmcnt(0)" ::: "memory");
    __builtin_amdgcn_s_barrier();
    asm volatile("" ::: "memory");
    next();
#undef G128_ISSUE
#pragma unroll
    for (int m = 0; m < MF; ++m) epi(wr * 16 * MF + m * 16 + fr, wc * 64 + fq * 4, acc[m], m);
}

template <int MF, class AR, class BR>
__device__ __forceinline__ void g128_stage0(AR arow, BR brow, LDSP char* lds, const int tid) {
    const int wid = tid >> 6, srow = tid >> 3, gch = ((tid & 7) ^ (srow & 7)) * 8;
    LDSP char* lw = lds + wid * 1024;
#pragma unroll
    for (int i = 0; i < MF; ++i) {
        __builtin_amdgcn_global_load_lds((const unsigned*)(arow(32 * i + srow) + gch), (LDSP unsigned*)(lw + 4096 * i), 16, 0, 0);
    }
#pragma unroll
    for (int i = 0; i < 4; ++i) {
        __builtin_amdgcn_global_load_lds((const unsigned*)(brow(32 * i + srow) + gch), (LDSP unsigned*)(lw + MF * 4096 + 4096 * i), 16, 0, 0);
    }
}
template <class AR, class BR, class Epi>
__device__ __forceinline__ void gemm128(const int nk, const size_t akstep, const size_t bkstep, AR arow, BR brow, Epi epi, LDSP char* lds, const int tid) {
    gemm128x<4>(nk, akstep, bkstep, arow, brow, epi, lds, tid, false, [] {});
}

template <int MAP> __device__ __forceinline__ int conv_rowmap(int n) {
    if (MAP == 0) return n;
    const int tile = n >> 6, cc = n & 63, wc = cc >> 5, i16 = (cc >> 4) & 1, i = cc & 15;
    return tile * 128 + wc * 64 + ((MAP == 1 ? 0 : 2) + i16) * 16 + i;
}
template <int MAP>
__device__ __forceinline__ void conv_batched(const float* src, int nmat, int K, int N, size_t sstride, bf16_t* dst, size_t dstride, int wg, int nwg, float* sm, int tid, int wend = 0x7fffffff) {
    float(*t)[65] = (float(*)[65])sm;
    const int tk = K >> 6, tn = (N + 63) >> 6, per = tk * tn, total = (nmat * per < wend) ? nmat * per : wend;
    f32x4 v[4];
    auto ld = [&](int w) {
        const int mat = w / per, r = w % per, kt = r / tn, nt = r % tn;
        const float* s = src + (size_t)mat * sstride;
#pragma unroll
        for (int i = 0; i < 4; ++i) {
            const int idx = tid + 256 * i, k = idx >> 4, n = (idx & 15) * 4;
            v[i] = (f32x4){0.f, 0.f, 0.f, 0.f};
            if (nt * 64 + n < N) v[i] = *(const f32x4*)(s + (size_t)(kt * 64 + k) * N + nt * 64 + n);
        }
    };
    if (wg < total) ld(wg);
    for (int w = wg; w < total; w += nwg) {
        const int mat = w / per, r = w % per, kt = r / tn, nt = r % tn;
        bf16_t* d = dst + (size_t)mat * dstride;
#pragma unroll
        for (int i = 0; i < 4; ++i) {
            const int idx = tid + 256 * i, k = idx >> 4, n = (idx & 15) * 4;
            t[k][n] = v[i][0]; t[k][n + 1] = v[i][1]; t[k][n + 2] = v[i][2]; t[k][n + 3] = v[i][3];
        }
        __syncthreads();
        if (w + nwg < total) ld(w + nwg);
        {
            const int n = tid >> 2, kq = (tid & 3) * 16;
            if (nt * 64 + n < N) {
                unsigned pk[8];
#pragma unroll
                for (int j = 0; j < 8; ++j) pk[j] = cvtpk(t[kq + 2 * j][n], t[kq + 2 * j + 1][n]);
                bf16_t* o = d + (size_t)conv_rowmap<MAP>(nt * 64 + n) * K + kt * 64 + kq;
                *(u32x4v*)o = (u32x4v){pk[0], pk[1], pk[2], pk[3]};
                *(u32x4v*)(o + 8) = (u32x4v){pk[4], pk[5], pk[6], pk[7]};
            }
        }
        __syncthreads();
    }
}
__device__ __forceinline__ void st_convert(const P& p, int wg, int nwg, float* sm) {
    const int tid = otid();
    conv_batched<0>(p.ev_w_in, 1, 1024, 2840, 0, p.wt_in0, 0, wg, nwg, sm, tid);
    conv_batched<0>(p.ev_w_out, 1, 1024, 1024, 0, p.wt_out0, 0, wg, nwg, sm, tid);
    conv_batched<0>(p.ck_w1, 1, 2048, 256, 0, p.wt_c1, 0, wg, nwg, sm, tid);
    conv_batched<0>(p.cv_w1, 1, 2048, 256, 0, p.wt_c1 + 256 * 2048, 0, wg, nwg, sm, tid);
    conv_batched<0>(p.ck_w2, 1, 256, 64, 0, p.wt_c2, 0, wg, nwg, sm, tid);
    conv_batched<0>(p.cv_w2, 1, 256, 64, 0, p.wt_c2 + 64 * 256, 0, wg, nwg, sm, tid);
    conv_batched<0>(p.od_w_in, 1, 1024, 1216, 0, p.wt_in1, 0, wg, nwg, sm, tid);
    conv_batched<0>(p.od_w_out, 1, 1024, 1024, 0, p.wt_out1, 0, wg, nwg, sm, tid);
    conv_batched<0>(p.w_q_up, 1, 256, 768, 0, p.wt_qup, 0, wg, nwg, sm, tid);
    conv_batched<0>(p.w_kv_up, 1, 128, 1024, 0, p.wt_kvup, 0, wg, nwg, sm, tid);
    {
        const int wid = tid >> 6, lane = tid & 63;
        for (int w = wg * 4 + wid; w < 512; w += nwg * 4) {
            const int which = w >> 8, cg = (w >> 6) & 3, ks = w & 63, col = cg * 64 + lane;
            const float* w1 = (which ? p.cv_w1 : p.ck_w1) + (size_t)(ks * 32) * 256 + col; const float* pos = (which ? p.pos_v : p.pos_k) + ks * 32;
            float a = 0.f;
#pragma unroll
            for (int k = 0; k < 32; ++k) a += pos[k] * w1[(size_t)k * 256];
            p.c1p[(which * 64 + ks) * 256 + col] = a;
        }
    }
}
__device__ __forceinline__ void st_c1_reduce(const P& p, int wg, int nwg) {
    const int tid = otid();
    for (int i = wg * 256 + tid; i < 512; i += nwg * 256) {
        const int which = i >> 8, col = i & 255;
        float a = 0.f;
#pragma unroll 16
        for (int ks = 0; ks < 64; ++ks) a += p.c1p[(which * 64 + ks) * 256 + col];
        p.c1[i] = a;
    }
}


struct XcdOrder {
    int xcd, lw, nlw, tn, per;
    __device__ __forceinline__ XcdOrder(int wg, int nwg, int nM, int tn_) : xcd(wg & 7), lw(wg >> 3), nlw(nwg >> 3), tn(tn_), per((nM >> 3) * tn_) {}
    __device__ __forceinline__ bool get(int k, int& mt, int& nt) const { const int lt = lw + k * nlw; if (lt >= per) return false; mt = xcd + 8 * (lt / tn); nt = lt % tn; return true; }
};
template <int MF>
__device__ __forceinline__ void st_inproj0_mf(const P& p, int wg, int nwg, LDSP char* lds) {
    const int tid = otid();
    const XcdOrder ord(wg, nwg, ((T_TOK + 32 * MF - 1) / (32 * MF) + 7) & ~7, 23);
    auto Af = [&](int mt_) { return [=](int r) { int row = mt_ * (32 * MF) + r; row = row < T_TOK ? row : T_TOK - 1; return p.h + (size_t)row * DM; }; };
    auto Bf = [&](int nt_) { return [=](int r) { int n = nt_ * 128 + r; n = n < 2840 ? n : 2839; return p.wt_in0 + (size_t)n * 1024; }; };
    bool staged = false;
    for (int k = 0;; ++k) {
        int mt, nt, mt2 = 0, nt2 = 0;
        if (!ord.get(k, mt, nt)) break;
        if (mt * (32 * MF) >= T_TOK) break;
        const bool has2 = ord.get(k + 1, mt2, nt2) && mt2 * (32 * MF) < T_TOK;
        const bool st_ = staged; staged = has2;
        gemm128x<MF>(16, 64, 64, Af(mt), Bf(nt),
            [&](int rl, int cl, const f32x4 (&a)[4], int mfrag) {
                const int row = mt * (32 * MF) + rl;
#pragma unroll
                for (int n = 0; n < 4; ++n) {
                    const int col = nt * 128 + cl + n * 16;
                    if (col < 2840 && row < T_TOK) {
                        *(u32x2*)(p.proj + (size_t)row * 2840 + col) = (u32x2){pack_bf16(a[n][0], a[n][1]), pack_bf16(a[n][2], a[n][3])};
                        if (col >= 1280 && col < 1304)
                            *(f32x4*)(p.gates + (size_t)row * 24 + (col - 1280)) = (f32x4){sigmf(a[n][0]), sigmf(a[n][1]), sigmf(a[n][2]), sigmf(a[n][3])};
                    }
                }
            }, lds, tid, st_, [&] { if (has2) g128_stage0<MF>(Af(mt2), Bf(nt2), lds, tid); });
    }
}
__device__ __forceinline__ void st_cmp1_mf(const P& p, int wg, int nwg, LDSP char* lds) {
    const int tid = otid();
    for (int w = wg; w < 2 * 16 * 2; w += nwg) {
        const int which = w >> 5, mt = (w >> 1) & 15, nt = w & 1;
        const int colbase = which ? 640 : 512;
        gemm128(32, 2840, 64,
            [&](int r) { int m = mt * 128 + r; m = m < 2044 ? m : 2043; const int bk = m / 511, n = m % 511, b = bk >> 1, kv = bk & 1;
                         return p.proj + (size_t)(b * SEQ + 16 * n) * 2840 + colbase + kv * 64; },
            [&](int r) { return p.wt_c1 + (size_t)(which * 256 + nt * 128 + r) * 2048; },
            [&](int rl, int cl, const f32x4 (&a)[4], int mfrag) {
                const int m = mt * 128 + rl;
                if (m < 2044) {
#pragma unroll
                    for (int n = 0; n < 4; ++n) {
                        const int col = nt * 128 + cl + n * 16;
                        const f32x4 cb = *(const f32x4*)(p.c1 + which * 256 + col);
                        *(u32x2*)(p.chidb + (size_t)(which * 2048 + m) * 256 + col) =
                            (u32x2){pack_bf16(gelu_tanh(a[n][0] + cb[0]), gelu_tanh(a[n][1] + cb[1])), pack_bf16(gelu_tanh(a[n][2] + cb[2]), gelu_tanh(a[n][3] + cb[3]))};
                    }
                }
            }, lds, tid);
    }
}
__device__ __forceinline__ void st_cmp2_mf(const P& p, int wg, int nwg, LDSP char* lds) {
    const int tid = otid();
    for (int w = wg; w < 2 * 16; w += nwg) {
        const int which = w >> 4, mt = w & 15;
        gemm128(4, 64, 64,
            [&](int r) { int m = mt * 128 + r; m = m < 2044 ? m : 2043; return p.chidb + (size_t)(which * 2048 + m) * 256; },
            [&](int r) { return p.wt_c2 + (size_t)(which * 64 + (r & 63)) * 256; },
            [&](int rl, int cl, const f32x4 (&a)[4], int mfrag) {
                const int m = mt * 128 + rl;
                if (m < 2044) {
#pragma unroll
                    for (int n = 0; n < 4; ++n) { const int col = cl + n * 16; if (col < 64) {
                        const int bk = m / 511, nn = m % 511;
                        *(u32x2*)(p.kcmpb + ((size_t)((which * 4 + bk) * 512 + nn)) * 64 + col) = (u32x2){cvtpk(a[n][0], a[n][1]), cvtpk(a[n][2], a[n][3])}; } }
                }
            }, lds, tid);
    }
}
template <int MF>
__device__ __forceinline__ void st_outproj_mf(const P& p, int layer, int wg, int nwg, LDSP char* lds) {
    const int tid = otid();
    const bf16_t* W = layer ? p.wt_out1 : p.wt_out0;
    const float* xin = layer ? p.out : p.x;
    const XcdOrder ord(wg, nwg, ((T_TOK + 32 * MF - 1) / (32 * MF) + 7) & ~7, 8);
    auto Af = [&](int mt_) { return [=](int r) { int row = mt_ * (32 * MF) + r; row = row < T_TOK ? row : T_TOK - 1; return p.o + (size_t)row * DM; }; };
    auto Bf = [&](int nt_) { return [=](int r) { return W + (size_t)(nt_ * 128 + r) * 1024; }; };
    bool staged = false;
    for (int k = 0;; ++k) {
        int mt, nt, mt2 = 0, nt2 = 0;
        if (!ord.get(k, mt, nt)) break;
        if (mt * (32 * MF) >= T_TOK) break;
        const bool has2 = ord.get(k + 1, mt2, nt2) && mt2 * (32 * MF) < T_TOK;
        const bool st_ = staged; staged = has2;
        gemm128x<MF>(16, 64, 64, Af(mt), Bf(nt),
            [&](int rl, int cl, const f32x4 (&a)[4], int mfrag) {
                const int row = mt * (32 * MF) + rl, b = row >> 13;
                const float* g = p.modv + (size_t)(layer * 2 + (b & 1)) * 6144 + 2 * 1024;
                if (row < T_TOK)
#pragma unroll
                for (int n = 0; n < 4; ++n) {
                    const int col = nt * 128 + cl + n * 16;
                    const f32x4 xv = *(const f32x4*)(xin + (size_t)row * DM + col), gv = *(const f32x4*)(g + col);
                    *(f32x4*)(p.out + (size_t)row * DM + col) = xv + gv * a[n];
                }
            }, lds, tid, st_, [&] { if (has2) g128_stage0<MF>(Af(mt2), Bf(nt2), lds, tid); });
    }
}
template <int BM>
__device__ __forceinline__ bool moe_tile128(const int* cnt, int tt, int& e, int& i0, int& off) {
    int acc = 0, o = 0;
    for (int q = 0; q < 16; ++q) {
        const int c = cnt[q * 32], nt = (c + BM - 1) / BM;
        if (tt < acc + nt) { e = q; i0 = (tt - acc) * BM; off = o; return true; }
        acc += nt; o += c;
    }
    return false;
}
struct MoeTile { int e, i0, off, nt, ce; bool ok; };
template <int BM>
__device__ __forceinline__ MoeTile moe_get(const int* cnt, int w) {
    MoeTile t; t.ok = moe_tile128<BM>(cnt, w >> 3, t.e, t.i0, t.off); t.nt = w & 7; t.ce = t.ok ? cnt[t.e * 32] : 0; return t;
}
template <int MF>
__device__ __forceinline__ void st_moe_up_mf(const P& p, int layer, int wg, int nwg, LDSP char* lds) {
    const int tid = otid();
    const int* cnt = p.cnt + layer * 512;
    auto Af = [&](const MoeTile& t) { const int* lst = p.list + t.e * T_TOK; const int i0 = t.i0, ce = t.ce;
                                      return [=](int r) { const int i = (i0 + r < ce) ? i0 + r : i0; return p.h + (size_t)(lst[i] >> 1) * DM; }; };
    auto Bf = [&](const MoeTile& t) { const bf16_t* B = p.wt_gu + ((size_t)(layer * 16 + t.e) * 1024 + t.nt * 128) * 1024; return [=](int r) { return B + (size_t)r * 1024; }; };
    MoeTile cur = moe_get<32 * MF>(cnt, wg);
    bool staged = false;
    for (int w = wg; cur.ok; w += nwg) {
        const MoeTile nx = moe_get<32 * MF>(cnt, w + nwg);
        const bool st_ = staged; staged = nx.ok;
        const int i0 = cur.i0, ce = cur.ce, off = cur.off, nt = cur.nt;
        gemm128x<MF>(16, 64, 64, Af(cur), Bf(cur),
            [&](int rl, int cl, const f32x4 (&a)[4], int mfrag) {
                if (i0 + rl < ce) {
                    const int wc = cl >> 6, fq4 = cl & 63;
#pragma unroll
                    for (int n = 0; n < 2; ++n) {
                        const int col = nt * 64 + wc * 32 + n * 16 + fq4;
                        const f32x4 g = a[n], u = a[n + 2];
                        *(u32x2*)(p.hid + (size_t)(off + i0 + rl) * 512 + col) =
                            (u32x2){pack_bf16(siluf(g[0]) * u[0], siluf(g[1]) * u[1]), pack_bf16(siluf(g[2]) * u[2], siluf(g[3]) * u[3])};
                    }
                }
            }, lds, tid, st_, [&] { if (nx.ok) g128_stage0<MF>(Af(nx), Bf(nx), lds, tid); });
        cur = nx;
    }
}
template <int MF>
__device__ __forceinline__ void st_moe_down_mf(const P& p, int layer, int wg, int nwg, LDSP char* lds) {
    const int tid = otid();
    const int* cnt = p.cnt + layer * 512;
    auto Af = [&](const MoeTile& t) { const int i0 = t.i0, ce = t.ce, off = t.off; return [=](int r) { const int i = (i0 + r < ce) ? i0 + r : i0; return p.hid + (size_t)(off + i) * 512; }; };
    auto Bf = [&](const MoeTile& t) { const bf16_t* B = p.wt_d + ((size_t)(layer * 16 + t.e) * 1024 + t.nt * 128) * 512; return [=](int r) { return B + (size_t)r * 512; }; };
    MoeTile cur = moe_get<32 * MF>(cnt, wg);
    bool staged = false;
    for (int w = wg; cur.ok; w += nwg) {
        const MoeTile nx = moe_get<32 * MF>(cnt, w + nwg);
        const bool st_ = staged; staged = nx.ok;
        const int i0 = cur.i0, ce = cur.ce, nt = cur.nt;
        const int* lst = p.list + cur.e * T_TOK;
        int ids[MF]; float wts[MF];
#pragma unroll
        for (int m = 0; m < MF; ++m) { const int rl = ((tid >> 7) & 1) * (16 * MF) + m * 16 + (tid & 15); ids[m] = (i0 + rl < ce) ? lst[i0 + rl] : -1; }
#pragma unroll
        for (int m = 0; m < MF; ++m) wts[m] = ids[m] >= 0 ? p.tokw[ids[m]] : 0.f;
        gemm128x<MF>(8, 64, 64, Af(cur), Bf(cur),
            [&](int rl, int cl, const f32x4 (&a)[4], int mfrag) {
                if (i0 + rl < ce) {
                    const int id = ids[mfrag]; const float wt = wts[mfrag];
#pragma unroll
                    for (int n = 0; n < 4; ++n) {
                        const int col = nt * 128 + cl + n * 16;
                        *(u32x2*)(p.y + (size_t)id * DM + col) = (u32x2){pack_bf16(wt * a[n][0], wt * a[n][1]), pack_bf16(wt * a[n][2], wt * a[n][3])};
                    }
                }
            }, lds, tid, st_, [&] { if (nx.ok) g128_stage0<MF>(Af(nx), Bf(nx), lds, tid); });
        cur = nx;
    }
}
template <int MF>
__device__ __forceinline__ void st_inproj1_mf(const P& p, int wg, int nwg, LDSP char* lds) {
    const int tid = otid();
    const XcdOrder ord(wg, nwg, ((T_TOK + 32 * MF - 1) / (32 * MF) + 7) & ~7, 10);
    auto Af = [&](int mt_) { return [=](int r) { int row = mt_ * (32 * MF) + r; row = row < T_TOK ? row : T_TOK - 1; return p.h + (size_t)row * DM; }; };
    auto Bf = [&](int nt_) { return [=](int r) { int n = nt_ * 128 + r; n = n < 1216 ? n : 1215; return p.wt_in1 + (size_t)n * 1024; }; };
    bool staged = false;
    for (int k = 0;; ++k) {
        int mt, nt, mt2 = 0, nt2 = 0;
        if (!ord.get(k, mt, nt)) break;
        if (mt * (32 * MF) >= T_TOK) break;
        const bool has2 = ord.get(k + 1, mt2, nt2) && mt2 * (32 * MF) < T_TOK;
        const bool st_ = staged; staged = has2;
        gemm128x<MF>(16, 64, 64, Af(mt), Bf(nt),
            [&](int rl, int cl, const f32x4 (&a)[4], int mfrag) {
                const int row = mt * (32 * MF) + rl;
#pragma unroll
                for (int n = 0; n < 4; ++n) {
                    const int col = nt * 128 + cl + n * 16;
                    if (col < 1216 && row < T_TOK) *(u32x2*)(p.proj1 + (size_t)row * 1216 + col) = (u32x2){pack_bf16(a[n][0], a[n][1]), pack_bf16(a[n][2], a[n][3])};
                }
            }, lds, tid, st_, [&] { if (has2) g128_stage0<MF>(Af(mt2), Bf(nt2), lds, tid); });
    }
}
__device__ __forceinline__ void st_mla_up_mf(const P& p, int wg, int nwg, LDSP char* lds) {
    const int tid = otid();
    const XcdOrder ord(wg, nwg, 128, 14);
    for (int k = 0;; ++k) {
        int mt, c;
        if (!ord.get(k, mt, c)) break;
        if (c < 6) {
            gemm128(4, 64, 64,
                [&](int r) { return p.cqn + (size_t)(mt * 128 + r) * 384; },
                [&](int r) { return p.wt_qup + (size_t)(c * 128 + r) * 256; },
                [&](int rl, int cl, const f32x4 (&a)[4], int mfrag) {
                    const int row = mt * 128 + rl, wc = cl >> 6;
                    f32x4 v[4] = {a[0], a[1], a[2], a[3]};
                    if (((c == 1 || c == 4) && wc == 0) || ((c == 2 || c == 5) && wc == 1)) {
                        const int t = row & (SEQ - 1), i0 = cl & 63;
#pragma unroll
                        for (int n = 0; n < 2; ++n) {
                            const f32x4 cs = *(const f32x4*)(p.ropec + t * 32 + n * 16 + i0), sn = *(const f32x4*)(p.ropes + t * 32 + n * 16 + i0);
                            v[n] = a[n] * cs - a[n + 2] * sn; v[n + 2] = a[n] * sn + a[n + 2] * cs;
                        }
                    }
#pragma unroll
                    for (int n = 0; n < 4; ++n) *(u32x2*)(p.qmla + (size_t)row * 768 + c * 128 + cl + n * 16) = (u32x2){cvtpk(v[n][0], v[n][1]), cvtpk(v[n][2], v[n][3])};
                }, lds, tid);
        } else {
            gemm128(2, 64, 64,
                [&](int r) { return p.cqn + (size_t)(mt * 128 + r) * 384 + 256; },
                [&](int r) { return p.wt_kvup + (size_t)((c - 6) * 128 + r) * 128; },
                [&](int rl, int cl, const f32x4 (&a)[4], int mfrag) {
                    const int row = mt * 128 + rl;
#pragma unroll
                    for (int n = 0; n < 4; ++n) *(u32x2*)(p.kvmla + (size_t)row * 1024 + (c - 6) * 128 + cl + n * 16) = (u32x2){pack_bf16(a[n][0], a[n][1]), pack_bf16(a[n][2], a[n][3])};
                }, lds, tid);
        }
    }
}

typedef float f32x16 __attribute__((ext_vector_type(16)));
typedef short s16x4 __attribute__((ext_vector_type(4)));
#define ATT_NEG (-1e30f)
#define ATT_SHIFT (-16.0f)
#define LOG2E 1.4426950408889634f

__device__ __forceinline__ int swz128(int row) { return (((row >> 1) & 1) << 2) | ((row >> 2) & 3); }
__device__ __forceinline__ int swz256(int row) { return ((row & 3) << 2) | ((row >> 2) & 3); }

struct AttLane {
    int kbase;
    int v0[2];
};
template <int KROWB, int VROWB, int DT>
__device__ __forceinline__ void att_lane_init(AttLane& L, int lane) {
    const int q = lane & 31, hh = lane >> 5, x = hh ^ swz128(q);
    L.kbase = q * KROWB + x * 16;
    const int rl = 4 * hh + ((lane & 15) >> 2), blk = (lane >> 4) & 1, pp = lane & 3;
#pragma unroll
    for (int t = 0; t < 2; ++t) {
        const int g = (VROWB == 256) ? (((rl & 3) << 2) | ((2 * t + hh) & 3)) : ((((rl >> 1) & 1) << 2) | ((2 * t + hh) & 3));
        L.v0[t] = rl * VROWB + (((2 * blk + (pp >> 1)) ^ g) * 16) + 8 * (pp & 1);
    }
}
template <int KS, int KROWB, int MODE, bool WANT_P, bool IMP>
__device__ __forceinline__ void att_qk(LDSP const char* kb, const AttLane& L, const bf16x8 (&qf)[KS], bf16x8 (&pf)[4], float& lsum, const float c1, const float cadd,
                                       const unsigned lutv, const int dq16, LDSP float* improw, const float invl) {
    float la = 0.f, lb = 0.f, lc = 0.f, ld = 0.f;
#pragma unroll
    for (int kt = 0; kt < 2; ++kt) {
        f32x16 s;
#pragma unroll
        for (int r = 0; r < 16; ++r) s[r] = 0.f;
        constexpr int KG = (KS > 4) ? 2 : 4;
#pragma unroll
        for (int k4 = 0; k4 < KS; k4 += KG) {
            bf16x8 a[KG];
#pragma unroll
            for (int j = 0; j < KG; ++j) { const int ks = k4 + j; a[j] = *(const LDSP bf16x8*)(kb + (L.kbase ^ (32 * (ks & 3))) + (ks >> 2) * 128 + kt * 32 * KROWB); }
#pragma unroll
            for (int j = 0; j < KG; ++j) s = __builtin_amdgcn_mfma_f32_32x32x16_bf16(a[j], qf[k4 + j], s, 0, 0, 0);
            asm volatile("" ::: "memory");
        }
        float pr[16];
#pragma unroll
        for (int r = 0; r < 16; ++r) {
            const int koff = 32 * kt + (r & 3) + 8 * (r >> 2);
            float add = cadd;
            if (MODE == 1) add = *(const LDSP float*)(lutv + (63 - koff) * 4);
            if (MODE == 2) { int d = dq16 - 16 * koff; d = d < -1 ? -1 : d; d = d > 1087 ? 1087 : d; add = *(const LDSP float*)(lutv + (unsigned)(64 + d) * 4u); }
            pr[r] = __builtin_amdgcn_exp2f(__builtin_fmaf(s[r], c1, add));
        }
#pragma unroll
        for (int r = 0; r < 16; r += 4) { la += pr[r]; lb += pr[r + 1]; lc += pr[r + 2]; ld += pr[r + 3]; }
        if (IMP) {
#pragma unroll
            for (int g = 0; g < 4; ++g) {
                (void)__hip_atomic_fetch_add((LDSP unsigned*)improw + 8 * kt + 2 * g, (unsigned)(((pr[4 * g] + pr[4 * g + 1]) + (pr[4 * g + 2] + pr[4 * g + 3])) * invl + 0.5f), __ATOMIC_RELAXED, __HIP_MEMORY_SCOPE_WORKGROUP);
                (void)__hip_atomic_fetch_add((LDSP unsigned*)improw + 8 * kt + 2 * g + 1, (unsigned)(pr[4 * g + 3] * invl + 0.5f), __ATOMIC_RELAXED, __HIP_MEMORY_SCOPE_WORKGROUP);
            }
        }
        if (WANT_P) {
#pragma unroll
            for (int sI = 0; sI < 2; ++sI) {
                union { unsigned u[4]; bf16x8 v; } cv;
#pragma unroll
                for (int i = 0; i < 4; ++i) cv.u[i] = cvtpk_valu(pr[8 * sI + 2 * i], pr[8 * sI + 2 * i + 1]);
                pf[kt * 2 + sI] = cv.v;
            }
        }
    }
    lsum += (la + lb) + (lc + ld);
}
template <int DT, int VROWB>
__device__ __forceinline__ void att_pv(LDSP const char* vb, const AttLane& L, const bf16x8 (&pf)[4], f32x16 (&o)[DT]) {
    const unsigned vba = (unsigned)(size_t)vb;
#pragma unroll
    for (int ks2 = 0; ks2 < 4; ++ks2) {
#pragma unroll
        for (int d0 = 0; d0 < DT; d0 += 2) {
            s16x4 lo[2], hi[2];
#pragma unroll
            for (int j = 0; j < 2; ++j) {
                asm volatile("ds_read_b64_tr_b16 %0, %1 offset:%2" : "=v"(lo[j]) : "v"(vba + (L.v0[0] ^ ((d0 + j) << 6))), "i"((16 * ks2) * VROWB) : "memory");
                asm volatile("ds_read_b64_tr_b16 %0, %1 offset:%2" : "=v"(hi[j]) : "v"(vba + (L.v0[1] ^ ((d0 + j) << 6))), "i"((16 * ks2 + 8) * VROWB) : "memory");
            }
            asm volatile("s_waitcnt lgkmcnt(0)" ::: "memory");
#pragma unroll
            for (int j = 0; j < 2; ++j) {
                asm volatile("" : "+v"(lo[j]), "+v"(hi[j]));
                const bf16x8 vf = __builtin_shufflevector(lo[j], hi[j], 0, 1, 2, 3, 4, 5, 6, 7);
                o[d0 + j] = __builtin_amdgcn_mfma_f32_32x32x16_bf16(vf, pf[ks2], o[d0 + j], 0, 0, 0);
            }
        }
    }
}
template <int CPR>
__device__ __forceinline__ void att_stage_map(int (&rowc)[(CPR == 24) ? 6 : 1], int tid) {
    if (CPR == 24) {
#pragma unroll
        for (int i = 0; i < 6; ++i) {
            const int c = tid + 256 * i, row = c / 24, cc = c % 24;
            rowc[i % ((CPR == 24) ? 6 : 1)] = (row << 8) | ((cc & ~7) | ((cc & 7) ^ swz128(row)));
        }
    } else if (CPR == 16) {
        const int row = tid >> 4; rowc[0] = (row << 8) | ((tid & 15) ^ swz256(row));
    } else {
        const int row = tid >> 3; rowc[0] = (row << 8) | ((tid & 7) ^ swz128(row));
    }
}
template <int CPR, class SRC>
__device__ __forceinline__ void att_stage(LDSP char* dst, SRC src, const int (&rowc)[(CPR == 24) ? 6 : 1], int wid) {
#pragma unroll
    for (int i = 0; i < CPR / 4; ++i) {
        const int rc = rowc[(CPR == 24) ? i : 0];
        const int row = (rc >> 8) + ((CPR == 24) ? 0 : i * (256 / CPR));
        __builtin_amdgcn_global_load_lds((const unsigned*)src(row, rc & 255), (LDSP unsigned*)(dst + (256 * i + 64 * wid) * 16), 16, 0, 0);
    }
}
__device__ __forceinline__ int wq_next(int* ctr, LDSP int* slot, int tid) {
    __syncthreads();
    if (tid == 0) *slot = atomicAdd(ctr, 1);
    __syncthreads();
    return *slot;
}

__device__ __forceinline__ void build_lut(LDSP float* tab, const float* blut_h, int n, int wlimit, int tid) {
    for (int i = tid; i < n; i += 256) { const int d = i - 64; tab[i] = (d < 0 || d >= wlimit) ? ATT_NEG : blut_h[d > 1023 ? 1023 : d] * LOG2E + ATT_SHIFT; }
}
#define ATT_BAR() do { __builtin_amdgcn_s_barrier(); asm volatile("" ::: "memory"); } while (0)

__device__ __forceinline__ void mla_item(const P& p, const int item, LDSP char* lds, const int tid0) {
    LDSP char* kb = lds; LDSP char* vb = lds + 24576; LDSP float* lut = (LDSP float*)(lds + 40960);
    const float c1 = 0.07216878364870322f * LOG2E;
    int tid = tid0; asm volatile("" : "+v"(tid));
    const int wid = tid >> 6, lane = tid & 63, q = lane & 31, hh = lane >> 5;
    AttLane L; att_lane_init<384, 256, 4>(L, lane);
    int krc[6], vrc[1];
    att_stage_map<24>(krc, tid); att_stage_map<16>(vrc, tid);
    int qt, bh, part;
    if (item >= 640) { const int r = item - 640; qt = 15 - (r >> 3); bh = r & 7; part = 0; }
    else {
        int g = 0; while (16 * (g + 1) + 8 * ((g + 2) >> 1) <= item) ++g;
        const int r = item - (16 * g + 8 * ((g + 1) >> 1)), Ln = 64 - g;
        if (r < 16) { qt = Ln - 1; bh = r & 7; part = 1 + (r >> 3); } else { qt = (Ln >> 1) - 1; bh = (r - 16) & 7; part = 0; }
    }
    const int b = bh >> 2, h = bh & 3;
    const int tw = qt * 128 + wid * 32;
    bf16x8 qf[12];
    {
        const bf16_t* qp = p.qmla + (size_t)(b * SEQ + tw + q) * 768 + h * 192 + 8 * hh;
#pragma unroll
        for (int ks = 0; ks < 12; ++ks) qf[ks] = *(const bf16x8*)(qp + 16 * ks);
    }
    f32x16 o[4];
#pragma unroll
    for (int dt = 0; dt < 4; ++dt)
#pragma unroll
        for (int r = 0; r < 16; ++r) o[dt][r] = 0.f;
    float lsum = 0.f;
    const int i0 = (part == 2) ? qt + 1 : 0, ntiles = (part == 1) ? qt + 1 : 2 * qt + 2;
    const bf16_t* kvb = p.kvmla + (size_t)b * SEQ * 1024 + h * 256;
    const bf16_t* krb = p.krope + (size_t)b * SEQ * 64;
    auto ksrc = [&](int pos0) { return [=](int row, int gc) { return gc < 16 ? kvb + (size_t)(pos0 + row) * 1024 + gc * 8 : krb + (size_t)(pos0 + row) * 64 + (gc - 16) * 8; }; };
    auto vsrc = [&](int pos0) { return [=](int row, int gc) { return kvb + (size_t)(pos0 + row) * 1024 + 128 + gc * 8; }; };
    att_stage<24>(kb, ksrc(i0 * 64), krc, wid);
    for (int i = i0; i < ntiles; ++i) {
        const int pos0 = i * 64;
        asm volatile("s_waitcnt vmcnt(0)" ::: "memory"); ATT_BAR();
        att_stage<16>(vb, vsrc(pos0), vrc, wid);
        const bool active = pos0 <= tw + 31, diag = pos0 + 63 > tw;
        bf16x8 pf[4];
        if (active) {
            if (diag) {
                int dq = tw + q - pos0 - 4 * hh; dq = dq < -1 ? -1 : dq;
                att_qk<12, 384, 1, true, false>(kb, L, qf, pf, lsum, c1, 0.f, (unsigned)(size_t)lut + (unsigned)(dq + 1) * 4u, 0, nullptr, 0.f);
            } else att_qk<12, 384, 0, true, false>(kb, L, qf, pf, lsum, c1, ATT_SHIFT, 0u, 0, nullptr, 0.f);
        }
        asm volatile("s_waitcnt vmcnt(0) lgkmcnt(0)" ::: "memory"); ATT_BAR();
        if (i + 1 < ntiles) att_stage<24>(kb, ksrc(pos0 + 64), krc, wid);
        if (active) att_pv<4, 256>(vb, L, pf, o);
    }
    const float lt = lsum + __shfl_xor(lsum, 32);
    int tid2 = tid0; asm volatile("" : "+v"(tid2));
    const int lane2 = tid2 & 63, trow = qt * 128 + (tid2 >> 6) * 32 + (lane2 & 31);
    bf16_t* op; float inv;
    if (part == 0) { inv = 1.0f / lt; op = p.o + (size_t)(b * SEQ + trow) * DM + h * 128 + 4 * (lane2 >> 5); }
    else {
        const size_t rec = (size_t)((part - 1) * 8 + bh) * (SEQ / 2) + (trow - SEQ / 2);
        inv = 1.0f; op = p.mlap + rec * 128 + 4 * (lane2 >> 5);
        if (lane2 < 32) p.mlal[rec] = lt;
    }
#pragma unroll
    for (int dt = 0; dt < 4; ++dt)
#pragma unroll
        for (int rq = 0; rq < 4; ++rq)
            *(u32x2*)(op + 32 * dt + 8 * rq) = (u32x2){cvtpk(o[dt][4 * rq] * inv, o[dt][4 * rq + 1] * inv), cvtpk(o[dt][4 * rq + 2] * inv, o[dt][4 * rq + 3] * inv)};
}
__device__ __forceinline__ void st_mla_combine(const P& p, int wg, int nwg) {
    const int TIDX = otid();
    const int wid = TIDX >> 6, lane = TIDX & 63;
    for (int w = wg * 4 + wid; w < 8 * (SEQ / 2); w += nwg * 4) {
        const int bh = w / (SEQ / 2), t = SEQ / 2 + w % (SEQ / 2), b = bh >> 2, h = bh & 3;
        const size_t r0 = (size_t)w, r1 = (size_t)(8 * (SEQ / 2) + w);
        const float inv = 1.0f / (p.mlal[r0] + p.mlal[r1]);
        const unsigned a = *(const unsigned*)(p.mlap + r0 * 128 + lane * 2), c = *(const unsigned*)(p.mlap + r1 * 128 + lane * 2);
        const float x0 = __uint_as_float(a << 16) + __uint_as_float(c << 16), x1 = __uint_as_float(a & 0xffff0000u) + __uint_as_float(c & 0xffff0000u);
        *(unsigned*)(p.o + (size_t)(b * SEQ + t) * DM + h * 128 + lane * 2) = cvtpk(x0 * inv, x1 * inv);
    }
}

__device__ __forceinline__ void swa_item(const P& p, const int item, LDSP char* lds, const int tid0) {
    LDSP char* kb = lds; LDSP char* vb = lds + 8192; LDSP float* luts = (LDSP float*)(lds + 46080);
    const float c1 = 0.125f * LOG2E;
    int tid = tid0; asm volatile("" : "+v"(tid));
    const int wid = tid >> 6, lane = tid & 63, q = lane & 31, hh = lane >> 5;
    AttLane L; att_lane_init<128, 128, 2>(L, lane);
    int rc[1]; att_stage_map<8>(rc, tid);
    const int b = item >> 9, kvh = (item >> 8) & 1, t0 = (item & 255) * 32, head = kvh * 4 + wid;
    bf16x8 qf[4];
    {
        const bf16_t* qp = p.proj1 + (size_t)(b * SEQ + t0 + q) * 1216 + 448 + head * 64 + 8 * hh;
#pragma unroll
        for (int ks = 0; ks < 4; ++ks) qf[ks] = *(const bf16x8*)(qp + 16 * ks);
    }
    f32x16 o[2];
#pragma unroll
    for (int dt = 0; dt < 2; ++dt)
#pragma unroll
        for (int r = 0; r < 16; ++r) o[dt][r] = 0.f;
    float lsum = 0.f;
    const bf16_t* kbp = p.proj1 + (size_t)b * SEQ * 1216 + 960 + kvh * 64;
    const bf16_t* zr = p.zrow;
    auto ksrc = [&](int pos0) { return [=](int row, int gc) { const int pos = pos0 + row; return (pos >= 0 && pos < SEQ) ? kbp + (size_t)pos * 1216 + gc * 8 : zr + gc * 8; }; };
    auto vsrc = [&](int pos0) { return [=](int row, int gc) { const int pos = pos0 + row; return (pos >= 0 && pos < SEQ) ? kbp + (size_t)pos * 1216 + 128 + gc * 8 : zr + gc * 8; }; };
    const unsigned tab = (unsigned)(size_t)(luts + head * 256);
    att_stage<8>(kb, ksrc(t0 - 128), rc, wid);
    for (int i = 0; i < 3; ++i) {
        const int pos0 = t0 - 128 + 64 * i;
        asm volatile("s_waitcnt vmcnt(0)" ::: "memory"); ATT_BAR();
        att_stage<8>(vb, vsrc(pos0), rc, wid);
        bf16x8 pf[4];
        int dq = t0 + q - pos0 - 4 * hh; dq = dq < -1 ? -1 : dq;
        att_qk<4, 128, 1, true, false>(kb, L, qf, pf, lsum, c1, 0.f, tab + (unsigned)(dq + 1) * 4u, 0, nullptr, 0.f);
        asm volatile("s_waitcnt vmcnt(0) lgkmcnt(0)" ::: "memory"); ATT_BAR();
        if (i + 1 < 3) att_stage<8>(kb, ksrc(pos0 + 64), rc, wid);
        att_pv<2, 128>(vb, L, pf, o);
    }
    const float lt = lsum + __shfl_xor(lsum, 32) + __builtin_amdgcn_exp2f(p.sinks[head] * LOG2E + ATT_SHIFT);
    const float inv = 1.0f / lt;
    bf16_t* op = p.o + (size_t)(b * SEQ + t0 + q) * DM + 512 + head * 64 + 4 * hh;
#pragma unroll
    for (int dt = 0; dt < 2; ++dt)
#pragma unroll
        for (int rq = 0; rq < 4; ++rq)
            *(u32x2*)(op + 32 * dt + 8 * rq) = (u32x2){cvtpk(o[dt][4 * rq] * inv, o[dt][4 * rq + 1] * inv), cvtpk(o[dt][4 * rq + 2] * inv, o[dt][4 * rq + 3] * inv)};
}
__device__ __forceinline__ void moe_conv_item(const P& p, const int layer, const int item, LDSP char* lds, const int tid0) {
    float* sm = (float*)lds;
    const int set = item >> 8, t0 = (item & 255) * 8;
    if (set == 0) conv_batched<1>(p.moe_wg + (size_t)layer * 16 * 1024 * 512, 16, 1024, 512, (size_t)1024 * 512, p.wt_gu + (size_t)layer * 16 * 1024 * 1024, (size_t)1024 * 1024, t0, 1, sm, tid0, t0 + 8);
    else if (set == 1) conv_batched<2>(p.moe_wu + (size_t)layer * 16 * 1024 * 512, 16, 1024, 512, (size_t)1024 * 512, p.wt_gu + (size_t)layer * 16 * 1024 * 1024, (size_t)1024 * 1024, t0, 1, sm, tid0, t0 + 8);
    else conv_batched<0>(p.moe_wd + (size_t)layer * 16 * 512 * 1024, 16, 512, 1024, (size_t)512 * 1024, p.wt_d + (size_t)layer * 16 * 1024 * 512, (size_t)1024 * 512, t0, 1, sm, tid0, t0 + 8);
}
__device__ __forceinline__ void st_attn1(const P& p, LDSP char* lds) {
    const int tid0 = otid();
    LDSP float* lut = (LDSP float*)(lds + 40960); LDSP int* slot = (LDSP int*)(lds + 45568); LDSP float* luts = (LDSP float*)(lds + 46080);
    for (int i = tid0; i < 1152; i += 256) lut[i] = (i < 64) ? ATT_NEG : ATT_SHIFT;
#pragma unroll 1
    for (int h = 0; h < 8; ++h) build_lut(luts + h * 256, p.blut + h * 1024, 256, 128, tid0);
    for (;;) {
        const int item = wq_next(p.wq + 0, slot, tid0);
        if (item >= 768 + 1024 + 768) break;
        if (item < 768) mla_item(p, item, lds, tid0);
        else { const int r = item - 768, g = r / 7, ps = r - g * 7;
               if (ps < 4) swa_item(p, g * 4 + ps, lds, tid0); else moe_conv_item(p, 1, g * 3 + ps - 4, lds, tid0); }
    }
}

#define A0_GLUT 16384
#define A0_WLUT 34816
#define A0_IMP 45056
#define A0_SEL 61568
#define A0_UN 62080
#define A0_LIST 62144
#define A0_SLOT 62720
__device__ __forceinline__ unsigned wmax_u32(unsigned v) {
#pragma unroll
    for (int o = 32; o > 0; o >>= 1) { const unsigned t = (unsigned)__shfl_xor((int)v, o); v = t > v ? t : v; }
    return v;
}
#define ATT_STORE_O(op, o, sc) do { _Pragma("unroll") for (int dt_ = 0; dt_ < 2; ++dt_) _Pragma("unroll") for (int rq_ = 0; rq_ < 4; ++rq_) \
        *(u32x2*)((op) + 32 * dt_ + 8 * rq_) = (u32x2){cvtpk((o)[dt_][4 * rq_] * (sc), (o)[dt_][4 * rq_ + 1] * (sc)), cvtpk((o)[dt_][4 * rq_ + 2] * (sc), (o)[dt_][4 * rq_ + 3] * (sc))}; } while (0)

__device__ __forceinline__ void nsa_item(const P& p, const int item, LDSP char* lds, const int tid0) {
    LDSP char* kb = lds; LDSP char* vb = lds + 8192;
    LDSP float* glut = (LDSP float*)(lds + A0_GLUT); LDSP float* wlut = (LDSP float*)(lds + A0_WLUT); LDSP float* imp = (LDSP float*)(lds + A0_IMP);
    LDSP unsigned* sel = (LDSP unsigned*)(lds + A0_SEL); LDSP unsigned* un = (LDSP unsigned*)(lds + A0_UN); LDSP unsigned short* blist = (LDSP unsigned short*)(lds + A0_LIST);
    const float c1 = 0.125f * LOG2E;
    int tid = tid0; asm volatile("" : "+v"(tid));
    const int wid = tid >> 6, lane = tid & 63, q = lane & 31, hh = lane >> 5;
    const int tile = 255 - (item >> 2), b = (item >> 1) & 1, kvh = item & 1, t0 = tile * 32, blk_t = t0 >> 6, head = kvh * 4 + wid;
#pragma unroll 1
    for (int h = 0; h < 4; ++h) { build_lut(glut + h * 1152, p.blut + (kvh * 4 + h) * 1024, 1152, 1 << 30, tid); build_lut(wlut + h * 640, p.blut + (kvh * 4 + h) * 1024, 640, 512, tid); }
    for (int i = tid; i < 32 * 129; i += 256) imp[i] = 0.f;
    AttLane L; att_lane_init<128, 128, 2>(L, lane);
    int rc[1]; att_stage_map<8>(rc, tid);
    const size_t rowq = (size_t)(b * SEQ + t0 + q);
    bf16x8 qf[4];
    {
        const bf16_t* qp = p.proj + rowq * 2840 + head * 64 + 8 * hh;
#pragma unroll
        for (int ks = 0; ks < 4; ++ks) qf[ks] = *(const bf16x8*)(qp + 16 * ks);
    }
    const float gc = p.gates[rowq * 24 + head * 3 + 0], gs = p.gates[rowq * 24 + head * 3 + 1], gw = p.gates[rowq * 24 + head * 3 + 2];
    const unsigned gtab = (unsigned)(size_t)(glut + wid * 1152), wtab = (unsigned)(size_t)(wlut + wid * 640);
    const bf16_t* zr = p.zrow;
    const bf16_t* pb = p.proj + (size_t)b * SEQ * 2840;
    f32x16 of[2], o[2];
#pragma unroll
    for (int dt = 0; dt < 2; ++dt)
#pragma unroll
        for (int r = 0; r < 16; ++r) { of[dt][r] = 0.f; o[dt][r] = 0.f; }
    bf16x8 pf[4];
    __syncthreads();
    const float cfar = glut[wid * 1152 + 64 + 1023];
    {
        int nvm = (t0 >> 4) + 1; nvm = nvm > 511 ? 511 : nvm;
        const int ntc = (nvm + 63) >> 6;
        const bf16_t* kcb = p.kcmpb + (size_t)((b * 2 + kvh) * 512) * 64;
        const bf16_t* vcb = p.kcmpb + (size_t)((4 + b * 2 + kvh) * 512) * 64;
        auto csrc = [&](const bf16_t* base, int n0) { return [=](int row, int gcx) { const int n = n0 + row; return n < 511 ? base + (size_t)n * 64 + gcx * 8 : zr + gcx * 8; }; };
        float lsum = 0.f;
        for (int nt = 0; nt < ntc; ++nt) {
            att_stage<8>(kb, csrc(kcb, nt * 64), rc, wid);
            asm volatile("s_waitcnt vmcnt(0)" ::: "memory"); ATT_BAR();
            const int dq16 = t0 + q - 31 - 1024 * nt - 64 * hh;
            if (t0 - 31 - 16 * (nt * 64 + 63) >= 1023) att_qk<4, 128, 0, false, false>(kb, L, qf, pf, lsum, c1, cfar, 0u, 0, nullptr, 0.f);
            else att_qk<4, 128, 2, false, false>(kb, L, qf, pf, lsum, c1, 0.f, gtab, dq16, nullptr, 0.f);
            asm volatile("s_waitcnt lgkmcnt(0)" ::: "memory"); ATT_BAR();
        }
        const float lc = lsum + __shfl_xor(lsum, 32);
        const float invl = lc > 0.f ? 1.0f / lc : 0.f;
        float dummy = 0.f;
        for (int nt = 0; nt < ntc; ++nt) {
            att_stage<8>(kb, csrc(kcb, nt * 64), rc, wid);
            att_stage<8>(vb, csrc(vcb, nt * 64), rc, wid);
            asm volatile("s_waitcnt vmcnt(0)" ::: "memory"); ATT_BAR();
            const int dq16 = t0 + q - 31 - 1024 * nt - 64 * hh;
            LDSP float* improw = imp + q * 129 + 16 * nt + hh;
            if (t0 - 31 - 16 * (nt * 64 + 63) >= 1023) att_qk<4, 128, 0, true, true>(kb, L, qf, pf, dummy, c1, cfar, 0u, 0, improw, invl * 524288.0f);
            else att_qk<4, 128, 2, true, true>(kb, L, qf, pf, dummy, c1, 0.f, gtab, dq16, improw, invl * 524288.0f);
            att_pv<2, 128>(vb, L, pf, o);
            asm volatile("s_waitcnt lgkmcnt(0)" ::: "memory"); ATT_BAR();
        }
        const float sc = gc * invl;
#pragma unroll
        for (int dt = 0; dt < 2; ++dt)
#pragma unroll
            for (int r = 0; r < 16; ++r) { of[dt][r] = o[dt][r] * sc; o[dt][r] = 0.f; }
    }
    __syncthreads();
    {
        unsigned u0 = 0u, u1 = 0u, u2 = 0u, u3 = 0u;
        for (int i = 0; i < 8; ++i) {
            const int tok = wid * 8 + i;
            const unsigned v0 = ((LDSP const unsigned*)imp)[tok * 129 + lane], v1 = ((LDSP const unsigned*)imp)[tok * 129 + 64 + lane];
            const int j0 = lane, j1 = lane + 64;
            const bool f0 = (j0 == 0) || (j0 == blk_t) || (j0 == blk_t - 1), f1 = (j1 == blk_t) || (j1 == blk_t - 1);
            unsigned k0 = f0 ? (0xFFFFFF80u | (unsigned)(127 - j0)) : (j0 <= blk_t ? ((v0 << 7) | (unsigned)(127 - j0)) : 0u);
            unsigned k1 = f1 ? (0xFFFFFF80u | (unsigned)(127 - j1)) : (j1 <= blk_t ? ((v1 << 7) | (unsigned)(127 - j1)) : 0u);
            unsigned thr = 0u;
#pragma unroll 1
            for (int bit = 31; bit >= 0; --bit) {
                const unsigned cand = thr | (1u << bit);
                const int c = __popcll(__ballot(k0 >= cand)) + __popcll(__ballot(k1 >= cand));
                thr = (c >= 16) ? cand : thr;
            }
            thr = thr ? thr : 1u;
            const unsigned long long b0 = __ballot(k0 >= thr), b1 = __ballot(k1 >= thr);
            const unsigned m0 = (unsigned)b0, m1 = (unsigned)(b0 >> 32), m2 = (unsigned)b1, m3 = (unsigned)(b1 >> 32);
            if (lane == 0) { sel[tok * 4 + 0] = m0; sel[tok * 4 + 1] = m1; sel[tok * 4 + 2] = m2; sel[tok * 4 + 3] = m3; }
            u0 |= m0; u1 |= m1; u2 |= m2; u3 |= m3;
        }
        if (lane == 0) { un[wid * 4 + 0] = u0; un[wid * 4 + 1] = u1; un[wid * 4 + 2] = u2; un[wid * 4 + 3] = u3; }
    }
    __syncthreads();
    {
        unsigned uw[4];
#pragma unroll
        for (int k = 0; k < 4; ++k) uw[k] = (unsigned)__builtin_amdgcn_readfirstlane((int)(un[k] | un[4 + k] | un[8 + k] | un[12 + k]));
        if (tid < 128) {
            const int k = tid >> 5, jb = tid & 31;
            unsigned wv = 0u; int below = 0;
#pragma unroll
            for (int kk = 0; kk < 4; ++kk) { if (kk == k) wv = uw[kk]; if (kk < k) below += __popc(uw[kk]); }
            if ((wv >> jb) & 1u) blist[below + __popc(wv & ((1u << jb) - 1u))] = (unsigned short)tid;
        }
        const int nb = __popc(uw[0]) + __popc(uw[1]) + __popc(uw[2]) + __popc(uw[3]);
        unsigned sq[4];
#pragma unroll
        for (int k = 0; k < 4; ++k) sq[k] = sel[q * 4 + k];
        __syncthreads();
        const bf16_t* ksb = pb + 768 + kvh * 64;
        auto ssrc = [&](int pos0, int colo) { return [=](int row, int gcx) { return ksb + (size_t)(pos0 + row) * 2840 + colo + gcx * 8; }; };
        float lsum = 0.f;
        att_stage<8>(kb, ssrc(64 * (int)blist[0], 0), rc, wid);
        for (int i = 0; i < nb; ++i) {
            const int j = __builtin_amdgcn_readfirstlane((int)blist[i]), pos0 = 64 * j;
            asm volatile("s_waitcnt vmcnt(0)" ::: "memory"); ATT_BAR();
            att_stage<8>(vb, ssrc(pos0, 128), rc, wid);
            unsigned sw = 0u;
#pragma unroll
            for (int k = 0; k < 4; ++k) if ((j >> 5) == k) sw = sq[k];
            const bool selq = (sw >> (j & 31)) & 1u;
            if (t0 - (pos0 + 63) >= 1023) att_qk<4, 128, 0, true, false>(kb, L, qf, pf, lsum, c1, selq ? cfar : ATT_NEG, 0u, 0, nullptr, 0.f);
            else {
                int dq = t0 + q - pos0 - 4 * hh; dq = dq > 1087 ? 1087 : dq; dq = (dq < -1 || !selq) ? -1 : dq;
                att_qk<4, 128, 1, true, false>(kb, L, qf, pf, lsum, c1, 0.f, gtab + (unsigned)(dq + 1) * 4u, 0, nullptr, 0.f);
            }
            asm volatile("s_waitcnt vmcnt(0) lgkmcnt(0)" ::: "memory"); ATT_BAR();
            if (i + 1 < nb) att_stage<8>(kb, ssrc(64 * (int)blist[i + 1], 0), rc, wid);
            att_pv<2, 128>(vb, L, pf, o);
        }
        const float ls = lsum + __shfl_xor(lsum, 32);
        const float sc = gs / ls;
#pragma unroll
        for (int dt = 0; dt < 2; ++dt)
#pragma unroll
            for (int r = 0; r < 16; ++r) { of[dt][r] += o[dt][r] * sc; o[dt][r] = 0.f; }
    }
    {
        const bf16_t* kwb = pb + 1024 + kvh * 64;
        auto wsrc = [&](int pos0, int colo) { return [=](int row, int gcx) { const int pos = pos0 + row; return (pos >= 0 && pos < SEQ) ? kwb + (size_t)pos * 2840 + colo + gcx * 8 : zr + gcx * 8; }; };
        float lsum = 0.f;
        asm volatile("s_waitcnt lgkmcnt(0)" ::: "memory"); ATT_BAR();
        att_stage<8>(kb, wsrc(t0 - 512, 0), rc, wid);
        for (int i = 0; i < 9; ++i) {
            const int pos0 = t0 - 512 + 64 * i;
            asm volatile("s_waitcnt vmcnt(0)" ::: "memory"); ATT_BAR();
            att_stage<8>(vb, wsrc(pos0, 128), rc, wid);
            int dq = t0 + q - pos0 - 4 * hh; dq = dq < -1 ? -1 : dq;
            att_qk<4, 128, 1, true, false>(kb, L, qf, pf, lsum, c1, 0.f, wtab + (unsigned)(dq + 1) * 4u, 0, nullptr, 0.f);
            asm volatile("s_waitcnt vmcnt(0) lgkmcnt(0)" ::: "memory"); ATT_BAR();
            if (i + 1 < 9) att_stage<8>(kb, wsrc(pos0 + 64, 0), rc, wid);
            att_pv<2, 128>(vb, L, pf, o);
        }
        const float lw = lsum + __shfl_xor(lsum, 32);
        const float sc = gw / lw;
#pragma unroll
        for (int dt = 0; dt < 2; ++dt)
#pragma unroll
            for (int r = 0; r < 16; ++r) of[dt][r] += o[dt][r] * sc;
    }
    bf16_t* op = p.o + rowq * DM + head * 64 + 4 * hh;
    ATT_STORE_O(op, of, 1.0f);
}

#define MG_CNT 8192
#define MG_BASE 8320
#define MG_ENT 8448
__device__ __forceinline__ void st_moba_gate(const P& p, int wg, int nwg, LDSP char* lds) {
    const int tid = otid();
    const int wid = tid >> 6, lane = tid & 63, q = lane & 31, hh = lane >> 5;
    LDSP char* kmt = lds; LDSP int* lcnt = (LDSP int*)(lds + MG_CNT); LDSP int* lbase = (LDSP int*)(lds + MG_BASE); LDSP int* ent = (LDSP int*)(lds + MG_ENT);
    AttLane L; att_lane_init<128, 128, 2>(L, lane);
    int rc[1]; att_stage_map<8>(rc, tid);
    const bf16_t* zr = p.zrow;
    for (int item = wg; item < 1024; item += nwg) {
        const int tile = item >> 4, b = (item >> 3) & 1, h = item & 7, t0 = tile * 128, own = t0 >> 8, tw = t0 + wid * 32, bh = b * 8 + h;
        if (own == 0) continue;
        __syncthreads();
        if (tid < 32) lcnt[tid] = 0;
        bf16x8 qf[4];
        {
            const bf16_t* qp = p.proj + (size_t)(b * SEQ + tw + q) * 2840 + 1304 + h * 64 + 8 * hh;
#pragma unroll
            for (int ks = 0; ks < 4; ++ks) qf[ks] = *(const bf16x8*)(qp + 16 * ks);
        }
        const bf16_t* kmb = p.kmeanb + (size_t)(bh * 32) * 64;
        att_stage<8>(kmt, [=](int row, int gcx) { return row < 32 ? kmb + (size_t)row * 64 + gcx * 8 : zr + gcx * 8; }, rc, wid);
        asm volatile("s_waitcnt vmcnt(0)" ::: "memory");
        __syncthreads();
        f32x16 s;
#pragma unroll
        for (int r = 0; r < 16; ++r) s[r] = 0.f;
#pragma unroll
        for (int ks = 0; ks < 4; ++ks) {
            const bf16x8 a = *(const LDSP bf16x8*)(kmt + (L.kbase ^ (32 * (ks & 3))));
            s = __builtin_amdgcn_mfma_f32_32x32x16_bf16(a, qf[ks], s, 0, 0, 0);
        }
        unsigned key[16];
#pragma unroll
        for (int r = 0; r < 16; ++r) {
            const int j = (r & 3) + 8 * (r >> 2) + 4 * hh;
            const unsigned bits = __float_as_uint(s[r]);
            const unsigned srt = (bits & 0x80000000u) ? ~bits : (bits | 0x80000000u);
            key[r] = (j < own) ? ((srt & ~31u) | (unsigned)(31 - j)) : 0u;
        }
        unsigned selm = 0u;
#pragma unroll 1
        for (int rnd = 0; rnd < 3; ++rnd) {
            unsigned m = 0u;
#pragma unroll
            for (int r = 0; r < 16; ++r) m = key[r] > m ? key[r] : m;
            const unsigned mo = (unsigned)__shfl_xor((int)m, 32);
            const unsigned wk = mo > m ? mo : m;
            if (wk != 0u) selm |= 1u << (31 - (wk & 31u));
#pragma unroll
            for (int r = 0; r < 16; ++r) key[r] = (key[r] == wk) ? 0u : key[r];
        }
        if (hh == 0) {
            unsigned mm = selm;
#pragma unroll
            for (int sI = 0; sI < 3; ++sI) {
                int en = -1;
                if (mm) { const int j = __builtin_ctz(mm); mm &= mm - 1u; const int lp = __hip_atomic_fetch_add(lcnt + j, 1, __ATOMIC_RELAXED, __HIP_MEMORY_SCOPE_WORKGROUP); en = (j << 8) | lp; }
                ent[(wid * 32 + q) * 3 + sI] = en;
            }
        }
        __syncthreads();
        if (tid < 32) { const int c = lcnt[tid]; lbase[tid] = c ? atomicAdd(p.mcnt + bh * 32 + tid, c) : 0; }
        __syncthreads();
        for (int e = tid; e < 384; e += 256) {
            const int en = ent[e];
            if (en >= 0) { const int j = en >> 8, tokl = e / 3, sI = e - tokl * 3; p.mlist[(size_t)(bh * 32 + j) * 8192 + lbase[j] + (en & 255)] = (unsigned short)((t0 + tokl) | (sI << 13)); }
        }
    }
}
__device__ __forceinline__ bf16_t* moba_part(const P& p, int slot, size_t row) { return (slot < 2 ? p.mp01 + (size_t)slot * 131072 * 64 : p.mp2) + row * 64; }

__device__ __forceinline__ void moba_inv_item(const P& p, const int lid, const int chunk, LDSP char* lds, const int tid0) {
    LDSP char* kb = lds; LDSP char* vb = lds + 8192; LDSP float* glut = (LDSP float*)(lds + A0_GLUT);
    const float c1 = 0.125f * LOG2E;
    int tid = tid0; asm volatile("" : "+v"(tid));
    const int wid = tid >> 6, lane = tid & 63, q = lane & 31, hh = lane >> 5;
    const int bh = lid / 31, j = lid - bh * 31, b = bh >> 3, h = bh & 7;
    build_lut(glut, p.blut + h * 1024, 1152, 1 << 30, tid);
    AttLane L; att_lane_init<128, 128, 2>(L, lane);
    int rc[1]; att_stage_map<8>(rc, tid);
    const int n = p.mcnt[bh * 32 + j], idx = chunk * 128 + wid * 32 + q;
    const bool valid = idx < n;
    const unsigned en = valid ? (unsigned)p.mlist[(size_t)(bh * 32 + j) * 8192 + idx] : (unsigned)(256 * (j + 1));
    const int tok = (int)(en & 8191u), slot = (int)(en >> 13);
    bf16x8 qf[4];
    {
        const bf16_t* qp = p.proj + (size_t)(b * SEQ + tok) * 2840 + 1304 + h * 64 + 8 * hh;
#pragma unroll
        for (int ks = 0; ks < 4; ++ks) qf[ks] = *(const bf16x8*)(qp + 16 * ks);
    }
    const unsigned gtab = (unsigned)(size_t)glut;
    const bf16_t* kbb = p.proj + (size_t)b * SEQ * 2840 + 1816 + h * 64;
    auto msrc = [&](int pos0, int colo) { return [=](int row, int gcx) { return kbb + (size_t)(pos0 + row) * 2840 + colo + gcx * 8; }; };
    f32x16 o[2];
#pragma unroll
    for (int dt = 0; dt < 2; ++dt)
#pragma unroll
        for (int r = 0; r < 16; ++r) o[dt][r] = 0.f;
    float lsum = 0.f;
    bf16x8 pf[4];
    __syncthreads();
    att_stage<8>(kb, msrc(256 * j, 0), rc, wid);
    for (int i = 0; i < 4; ++i) {
        const int pos0 = 256 * j + 64 * i;
        asm volatile("s_waitcnt vmcnt(0)" ::: "memory"); ATT_BAR();
        att_stage<8>(vb, msrc(pos0, 512), rc, wid);
        {
            int dq = tok - pos0 - 4 * hh; dq = dq > 1087 ? 1087 : dq; dq = valid ? dq : -1;
            att_qk<4, 128, 1, true, false>(kb, L, qf, pf, lsum, c1, 0.f, gtab + (unsigned)(dq + 1) * 4u, 0, nullptr, 0.f);
        }
        asm volatile("s_waitcnt vmcnt(0) lgkmcnt(0)" ::: "memory"); ATT_BAR();
        if (i + 1 < 4) att_stage<8>(kb, msrc(pos0 + 64, 0), rc, wid);
        att_pv<2, 128>(vb, L, pf, o);
    }
    const float lt = lsum + __shfl_xor(lsum, 32);
    if (valid) {
        const size_t row = (size_t)bh * SEQ + tok;
        bf16_t* op = moba_part(p, slot, row) + 4 * hh;
        ATT_STORE_O(op, o, 1.0f);
        if (hh == 0) p.mpl[(size_t)slot * 131072 + row] = lt;
    }
}
__device__ __forceinline__ void moba_own_item(const P& p, const int item, LDSP char* lds, const int tid0) {
    LDSP char* kb = lds; LDSP char* vb = lds + 8192; LDSP float* glut = (LDSP float*)(lds + A0_GLUT);
    const float c1 = 0.125f * LOG2E;
    int tid = tid0; asm volatile("" : "+v"(tid));
    const int wid = tid >> 6, lane = tid & 63, q = lane & 31, hh = lane >> 5;
    const int tile = item >> 4, b = (item >> 3) & 1, h = item & 7, t0 = tile * 128, own = t0 >> 8, tw = t0 + wid * 32, bh = b * 8 + h;
    __syncthreads();
    build_lut(glut, p.blut + h * 1024, 1152, 1 << 30, tid);
    AttLane L; att_lane_init<128, 128, 2>(L, lane);
    int rc[1]; att_stage_map<8>(rc, tid);
    const size_t rowq = (size_t)(b * SEQ + tw + q);
    bf16x8 qf[4];
    {
        const bf16_t* qp = p.proj + rowq * 2840 + 1304 + h * 64 + 8 * hh;
#pragma unroll
        for (int ks = 0; ks < 4; ++ks) qf[ks] = *(const bf16x8*)(qp + 16 * ks);
    }
    const unsigned gtab = (unsigned)(size_t)glut;
    const bf16_t* kbb = p.proj + (size_t)b * SEQ * 2840 + 1816 + h * 64;
    auto msrc = [&](int pos0, int colo) { return [=](int row, int gcx) { return kbb + (size_t)(pos0 + row) * 2840 + colo + gcx * 8; }; };
    f32x16 o[2];
#pragma unroll
    for (int dt = 0; dt < 2; ++dt)
#pragma unroll
        for (int r = 0; r < 16; ++r) o[dt][r] = 0.f;
    float lsum = 0.f;
    bf16x8 pf[4];
    const int nb = (((t0 + 127) >> 6) & 3) + 1;
    __syncthreads();
    att_stage<8>(kb, msrc(256 * own, 0), rc, wid);
    for (int i = 0; i < nb; ++i) {
        const int pos0 = 256 * own + 64 * i;
        asm volatile("s_waitcnt vmcnt(0)" ::: "memory"); ATT_BAR();
        att_stage<8>(vb, msrc(pos0, 512), rc, wid);
        const bool active = pos0 <= tw + 31;
        if (active) {
            int dq = tw + q - pos0 - 4 * hh; dq = dq < -1 ? -1 : dq;
            att_qk<4, 128, 1, true, false>(kb, L, qf, pf, lsum, c1, 0.f, gtab + (unsigned)(dq + 1) * 4u, 0, nullptr, 0.f);
        }
        asm volatile("s_waitcnt vmcnt(0) lgkmcnt(0)" ::: "memory"); ATT_BAR();
        if (i + 1 < nb) att_stage<8>(kb, msrc(pos0 + 64, 0), rc, wid);
        if (active) att_pv<2, 128>(vb, L, pf, o);
    }
    float lt = lsum + __shfl_xor(lsum, 32);
    const int npick = own < 3 ? own : 3;
    const size_t row = (size_t)bh * SEQ + tw + q;
#pragma unroll 1
    for (int sI = 0; sI < npick; ++sI) {
        lt += p.mpl[(size_t)sI * 131072 + row];
        const bf16_t* pp = moba_part(p, sI, row) + 4 * hh;
#pragma unroll
        for (int dt = 0; dt < 2; ++dt)
#pragma unroll
            for (int rq = 0; rq < 4; ++rq) {
                const u32x2 w = *(const u32x2*)(pp + 32 * dt + 8 * rq);
                o[dt][4 * rq] += __uint_as_float(w[0] << 16); o[dt][4 * rq + 1] += __uint_as_float(w[0] & 0xffff0000u);
                o[dt][4 * rq + 2] += __uint_as_float(w[1] << 16); o[dt][4 * rq + 3] += __uint_as_float(w[1] & 0xffff0000u);
            }
    }
    const float inv = 1.0f / lt;
    bf16_t* op = p.o + rowq * DM + 512 + h * 64 + 4 * hh;
    ATT_STORE_O(op, o, inv);
}
__device__ __forceinline__ void st_moba_own(const P& p, int wg, int nwg, LDSP char* lds) {
    const int tid0 = otid();
    for (int item = wg; item < 1024; item += nwg) moba_own_item(p, item, lds, tid0);
}
#define A0_PRE 62736
__device__ __forceinline__ void st_attn0(const P& p, LDSP char* lds) {
    const int tid0 = otid();
    LDSP int* slot = (LDSP int*)(lds + A0_SLOT); LDSP int* pre = (LDSP int*)(lds + A0_PRE);
    LDSP int* tmp = (LDSP int*)lds;
    for (int i = tid0; i < 496; i += 256) { const int bh = i / 31, j = i - bh * 31; tmp[i] = (p.mcnt[bh * 32 + j] + 127) >> 7; }
    __syncthreads();
    for (int i = tid0; i < 497; i += 256) { int s = 0; for (int k = 0; k < i; ++k) s += tmp[k]; pre[i] = s; }
    __syncthreads();
    const int ninv = pre[496];
    for (;;) {
        const int item = wq_next(p.wq + 1, slot, tid0);
        const int ntail = 5 * 768 + (ninv > 3072 ? ninv - 3072 : 0);
        if (item >= 1024 + ntail) break;
        if (item < 1024) nsa_item(p, item, lds, tid0);
        else {
            const int r = item - 1024, g = r / 5, ps = r - g * 5;
            if (g < 768 && ps == 4) { moe_conv_item(p, 0, g, lds, tid0); continue; }
            const int idx = (g < 768) ? g * 4 + ps : 3072 + (r - 5 * 768);
            if (idx >= ninv) continue;
            int lo = 0, hi = 495;
            while (lo < hi) { const int mid = (lo + hi + 1) >> 1; if (pre[mid] <= idx) lo = mid; else hi = mid - 1; }
            moba_inv_item(p, lo, idx - pre[lo], lds, tid0);
        }
    }
}

#define XB_TMO      128
#define XB_XCNT(j)  (256  + 64 * (j))
#define XB_XSUB(j)  (1280 + 64 * (j))
#define XB_XGEN(j)  (2304 + 64 * (j))
#define XB_TOP      3328
#define XB_TOPGEN   3392
#define XCD_BAR_WORDS 3456
#define XB_SPIN_CAP (1u << 20)
#define LAS __attribute__((address_space(3)))

__device__ __forceinline__ unsigned xb_ld(unsigned* p)              { return __hip_atomic_load(p, __ATOMIC_RELAXED, __HIP_MEMORY_SCOPE_AGENT); }
__device__ __forceinline__ unsigned xb_add(unsigned* p, unsigned v) { return __hip_atomic_fetch_add(p, v, __ATOMIC_RELAXED, __HIP_MEMORY_SCOPE_AGENT); }
__device__ __forceinline__ unsigned xb_xcc_id() { return (unsigned)__builtin_amdgcn_s_getreg((3 << 11) | 20) & 0xFu; }
#define XB_SPIN(cond, bar) do { unsigned _sp = 0; while (cond) { __builtin_amdgcn_s_sleep(1); \
    if ((++_sp & 255u) == 0u) { if (xb_ld(&(bar)[XB_TMO])) break; if (_sp > XB_SPIN_CAP) { atomicAdd(&(bar)[XB_TMO], 1u); break; } } } } while (0)

struct XcdBarrier {
    unsigned* bar; unsigned x;
    volatile LAS unsigned* st;
};

__device__ __forceinline__ XcdBarrier xcd_barrier_post(unsigned* bar, volatile LAS unsigned* st) {
    XcdBarrier b; b.bar = bar; b.x = xb_xcc_id(); b.st = st;
    if (threadIdx.x == 0) (void)xb_add(&bar[XB_XCNT(b.x)], 1u);
    return b;
}
__device__ __forceinline__ void xcd_barrier_complete(unsigned* bar, unsigned x, unsigned& nloc, unsigned& nx) {
    const unsigned G = gridDim.x * gridDim.y * gridDim.z;
    unsigned sum, cnt, mine, sp = 0u;
    for (;;) {
        sum = 0u; cnt = 0u; mine = 0u;
#pragma unroll
        for (unsigned j = 0; j < 16; ++j) { const unsigned c = xb_ld(&bar[XB_XCNT(j)]); sum += c; cnt += (c > 0u) ? 1u : 0u; mine = (j == x) ? c : mine; }
        if (sum == G) break;
        __builtin_amdgcn_s_sleep(1);
        if ((++sp & 255u) == 0u) { if (xb_ld(&bar[XB_TMO])) break; if (sp > XB_SPIN_CAP) { atomicAdd(&bar[XB_TMO], 1u); break; } }
    }
    nloc = mine > 0u ? mine : 1u; nx = cnt > 0u ? cnt : 1u;
}

__device__ __forceinline__ void xcd_barrier(const XcdBarrier& b) {
    asm volatile("s_waitcnt vmcnt(0)" ::: "memory");
    __syncthreads();
    if (threadIdx.x == 0) {
        unsigned* bar = b.bar;
        __builtin_amdgcn_s_waitcnt(0);
        unsigned nloc = b.st[0], nx = b.st[1];
        if (nloc == 0u) { xcd_barrier_complete(bar, b.x, nloc, nx); b.st[0] = nloc; b.st[1] = nx; }
        const unsigned old = xb_add(&bar[XB_XSUB(b.x)], 1u);
        const unsigned gen = old / nloc;
        if (old + 1u == (gen + 1u) * nloc) {
            __builtin_amdgcn_fence(__ATOMIC_RELEASE, "agent");
            asm volatile("s_waitcnt vmcnt(0)" ::: "memory");
            const unsigned og = xb_add(&bar[XB_TOP], 1u);
            const unsigned tg = og / nx;
            if (og + 1u == (tg + 1u) * nx) xb_add(&bar[XB_TOPGEN], 1u);
            else XB_SPIN(xb_ld(&bar[XB_TOPGEN]) == tg, bar);
            __builtin_amdgcn_fence(__ATOMIC_ACQUIRE, "agent");
            xb_add(&bar[XB_XGEN(b.x)], 1u);
            asm volatile("s_waitcnt vmcnt(0)" ::: "memory");
        } else {
            XB_SPIN(xb_ld(&bar[XB_XGEN(b.x)]) == gen, bar);
            __builtin_amdgcn_fence(__ATOMIC_ACQUIRE, "agent");
            asm volatile("s_waitcnt vmcnt(0)" ::: "memory");
        }
    }
    __syncthreads();
}


#define PHASE_SYNC() do { PP qb_ = (PP)__builtin_amdgcn_kernarg_segment_ptr(); asm volatile("" : "+s"(qb_)); XcdBarrier b_; b_.bar = qb_->bar; b_.x = xb_xcc_id(); \
        b_.st = (volatile LAS unsigned*)(dlds + BAR_LDS_OFF); xcd_barrier(b_); } while (0)
typedef const __attribute__((address_space(4))) P* PP;
#define BAR_SAVE() const unsigned bs0_ = __builtin_amdgcn_readfirstlane(*(volatile LAS unsigned*)(dlds + BAR_LDS_OFF)), \
        bs1_ = __builtin_amdgcn_readfirstlane(*(volatile LAS unsigned*)(dlds + BAR_LDS_OFF + 4)); __syncthreads()
#define BAR_RESTORE() do { __syncthreads(); if (threadIdx.x == 0) { *(volatile LAS unsigned*)(dlds + BAR_LDS_OFF) = bs0_; *(volatile LAS unsigned*)(dlds + BAR_LDS_OFF + 4) = bs1_; } } while (0)
#define PHASE_ARGS() PP q_ = (PP)__builtin_amdgcn_kernarg_segment_ptr(); int wg = blockIdx.x, nwg = gridDim.x; asm volatile("" : "+s"(q_), "+s"(wg), "+s"(nwg)); P p; { const __attribute__((address_space(4))) unsigned long long* s64_ = (const __attribute__((address_space(4))) unsigned long long*)q_; void** d64_ = (void**)&p; _Pragma("unroll") for (int i_ = 0; i_ < (int)(sizeof(P) / 8); ++i_) d64_[i_] = (void*)(__attribute__((address_space(1))) void*)s64_[i_]; } float* sm = (float*)dlds; LDSP char* lds = (LDSP char*)dlds; (void)sm; (void)lds
__global__ void __launch_bounds__(256, 2) k_mega(P pk) {
    extern __shared__ __attribute__((aligned(16))) unsigned char dlds[];
    if (threadIdx.x == 0) *(uint4*)(dlds + BAR_LDS_OFF) = make_uint4(0u, 0u, 0u, 0u);
    __syncthreads();
    (void)xcd_barrier_post(pk.bar, (volatile LAS unsigned*)(dlds + BAR_LDS_OFF));
    { PHASE_ARGS(); st_prologue(p, wg, nwg, sm); st_convert(p, wg, nwg, sm); } PHASE_SYNC();
    { PHASE_ARGS(); st_norm<0>(p, 0, wg, nwg, sm); st_c1_reduce(p, wg, nwg); } PHASE_SYNC();
    { PHASE_ARGS(); BAR_SAVE(); st_inproj0_mf<6>(p, wg, nwg, lds); BAR_RESTORE(); } PHASE_SYNC();
    { PHASE_ARGS(); st_cmp1_mf(p, wg, nwg, lds); st_kmean(p, wg, nwg, sm); } PHASE_SYNC();
    { PHASE_ARGS(); st_cmp2_mf(p, wg, nwg, lds); st_moba_gate(p, wg, nwg, lds); } PHASE_SYNC();
    { PHASE_ARGS(); st_attn0(p, lds); } PHASE_SYNC();
    { PHASE_ARGS(); st_moba_own(p, wg, nwg, lds); } PHASE_SYNC();
    { PHASE_ARGS(); st_outproj_mf<4>(p, 0, wg, nwg, lds); } PHASE_SYNC();
    { PHASE_ARGS(); st_norm<1>(p, 0, wg, nwg, sm); } PHASE_SYNC();
    { PHASE_ARGS(); BAR_SAVE(); st_moe_up_mf<6>(p, 0, wg, nwg, lds); BAR_RESTORE(); } PHASE_SYNC();
    { PHASE_ARGS(); BAR_SAVE(); st_moe_down_mf<6>(p, 0, wg, nwg, lds); BAR_RESTORE(); } PHASE_SYNC();
    { PHASE_ARGS(); st_norm<2>(p, 1, wg, nwg, sm); } PHASE_SYNC();
    { PHASE_ARGS(); BAR_SAVE(); st_inproj1_mf<6>(p, wg, nwg, lds); BAR_RESTORE(); } PHASE_SYNC();
    { PHASE_ARGS(); st_mla_prep(p, wg, nwg); } PHASE_SYNC();
    { PHASE_ARGS(); st_mla_up_mf(p, wg, nwg, lds); } PHASE_SYNC();
    { PHASE_ARGS(); st_attn1(p, lds); } PHASE_SYNC();
    { PHASE_ARGS(); st_mla_combine(p, wg, nwg); } PHASE_SYNC();
    { PHASE_ARGS(); st_outproj_mf<4>(p, 1, wg, nwg, lds); } PHASE_SYNC();
    { PHASE_ARGS(); st_norm<1>(p, 1, wg, nwg, sm); } PHASE_SYNC();
    { PHASE_ARGS(); BAR_SAVE(); st_moe_up_mf<6>(p, 1, wg, nwg, lds); BAR_RESTORE(); } PHASE_SYNC();
    { PHASE_ARGS(); BAR_SAVE(); st_moe_down_mf<6>(p, 1, wg, nwg, lds); BAR_RESTORE(); } PHASE_SYNC();
    { PHASE_ARGS(); st_norm<3>(p, 1, wg, nwg, sm); }
}

extern "C" void kernel_launch(void* const* d_in, const int* in_sizes, int n_in, void* d_out, int out_size, void* d_ws, size_t ws_size,
                              hipStream_t stream) {
    (void)in_sizes; (void)n_in; (void)out_size; (void)ws_size;
    P p{};
    const float* const* in = (const float* const*)d_in;
    p.x = in[0]; p.c = in[1]; p.rel = in[2]; p.router_w = in[3]; p.router_b = in[4]; p.final_norm = in[5]; p.norm_mix = in[6]; p.norm_ffn = in[7];
    p.ada_w = in[8]; p.ada_b = in[9]; p.moe_wg = in[10]; p.moe_wu = in[11]; p.moe_wd = in[12]; p.ev_w_in = in[13]; p.ev_w_out = in[14];
    p.pos_k = in[15]; p.pos_v = in[16]; p.ck_w1 = in[17]; p.ck_w2 = in[18]; p.cv_w1 = in[19]; p.cv_w2 = in[20]; p.od_w_in = in[21]; p.od_w_out = in[22];
    p.q_norm = in[23]; p.kv_norm = in[24]; p.w_q_up = in[25]; p.w_kv_up = in[26]; p.sinks = in[27];
    p.out = (float*)d_out;
    char* ws = (char*)d_ws; size_t off = 0;
    auto take = [&](size_t bytes) { char* r = ws + off; off += (bytes + 255) & ~(size_t)255; return r; };
    p.bar = (unsigned*)take(16384);
    p.cnt = (int*)take(4096);
    p.wq = (int*)take(256);
    p.mcnt = (int*)take(512 * 4);
    p.modv = (float*)take(2 * 2 * 6144 * 4);
    p.zrow = (bf16_t*)take(256);
    const size_t zero_bytes = off;
    p.ropec = (float*)take(SEQ * 32 * 4); p.ropes = (float*)take(SEQ * 32 * 4);
    p.blut = (float*)take(8 * 1024 * 4);
    p.gates = (float*)take((size_t)T_TOK * 24 * 4);
    p.kmean = (float*)take(2 * 8 * 32 * 64 * 4);
    p.tokw = (float*)take((size_t)T_TOK * 2 * 4);
    p.list = (int*)take((size_t)16 * T_TOK * 4);
    p.cqn = (bf16_t*)take((size_t)T_TOK * 384 * 2);
    p.krope = (bf16_t*)take((size_t)T_TOK * 64 * 2);
    p.h = (bf16_t*)take((size_t)T_TOK * DM * 2);
    p.o = (bf16_t*)take((size_t)T_TOK * DM * 2);
    p.mlap = p.h;
    p.mlal = (float*)(p.h + (size_t)2 * 8 * (SEQ / 2) * 128);
    p.mp01 = p.h;
    p.mp2 = (bf16_t*)take((size_t)131072 * 64 * 2);
    p.mpl = (float*)take((size_t)3 * 131072 * 4);
    p.mlist = (unsigned short*)take((size_t)16 * 32 * 8192 * 2);
    p.hid = p.o;
    char* region = take((size_t)100 * 1024 * 1024);
    p.proj = (bf16_t*)region;
    p.proj1 = (bf16_t*)region;
    p.qmla = (bf16_t*)(region + (size_t)T_TOK * 1216 * 2);
    p.kvmla = (bf16_t*)(region + (size_t)T_TOK * (1216 + 768) * 2);
    p.y = (bf16_t*)region;
    p.chidb = (bf16_t*)take((size_t)2 * 2048 * 256 * 2);
    p.kcmpb = (bf16_t*)take((size_t)8 * 512 * 64 * 2);
    p.kmeanb = (bf16_t*)take((size_t)2 * 8 * 32 * 64 * 2);
    p.c1 = (float*)take(512 * 4);
    p.c1p = (float*)take((size_t)2 * 64 * 256 * 4);
    p.wt_gu = (bf16_t*)take((size_t)32 * 1024 * 1024 * 2);
    p.wt_d = (bf16_t*)take((size_t)32 * 1024 * 512 * 2);
    p.wt_in0 = (bf16_t*)take((size_t)2840 * 1024 * 2);
    p.wt_out0 = (bf16_t*)take((size_t)1024 * 1024 * 2);
    p.wt_c1 = (bf16_t*)take((size_t)2 * 256 * 2048 * 2);
    p.wt_c2 = (bf16_t*)take((size_t)2 * 64 * 256 * 2);
    p.wt_in1 = (bf16_t*)take((size_t)1216 * 1024 * 2);
    p.wt_out1 = (bf16_t*)take((size_t)1024 * 1024 * 2);
    p.wt_qup = (bf16_t*)take((size_t)768 * 256 * 2);
    p.wt_kvup = (bf16_t*)take((size_t)1024 * 128 * 2);
    static int grid = 0;
    if (!grid) {
        int dev = 0, cus = 0, per_cu = 0;
        (void)hipGetDevice(&dev);
        (void)hipDeviceGetAttribute(&cus, hipDeviceAttributeMultiprocessorCount, dev);
        (void)hipFuncSetAttribute((const void*)k_mega, hipFuncAttributeMaxDynamicSharedMemorySize, KERNEL_LDS_BYTES);
        (void)hipOccupancyMaxActiveBlocksPerMultiprocessor(&per_cu, k_mega, 256, KERNEL_LDS_BYTES);
        if (cus <= 0) cus = 256;
        if (per_cu < 1) per_cu = 1;
        grid = cus * (per_cu < 2 ? per_cu : 2);
    }
    (void)hipMemsetAsync(d_ws, 0, zero_bytes, stream);
    hipLaunchKernelGGL(k_mega, dim3(grid), dim3(256), KERNEL_LDS_BYTES, stream, p);
}
```

```cpp
#include <hip/hip_runtime.h>
#include <stdint.h>

#define T_TOK 16384
#define SEQ 8192
#define DM 1024
#define NEGF (-1e30f)
#define BIGF (1e30f)

typedef unsigned short bf16_t;

__device__ __forceinline__ float bf2f(bf16_t v) { return __uint_as_float(((unsigned)v) << 16); }
__device__ __forceinline__ bf16_t f2bf(float f) {
    unsigned u = __float_as_uint(f);
    u += 0x7fffu + ((u >> 16) & 1u);
    return (bf16_t)(u >> 16);
}
typedef __bf16 bf16x2_t __attribute__((ext_vector_type(2)));
typedef float f32x2_t __attribute__((ext_vector_type(2)));
__device__ __forceinline__ unsigned cvtpk(float lo, float hi) { const f32x2_t f = {lo, hi}; return __builtin_bit_cast(unsigned, __builtin_convertvector(f, bf16x2_t)); }
__device__ __forceinline__ unsigned cvtpk_valu(float lo, float hi) { unsigned r; asm("s_nop 0\n\tv_cvt_pk_bf16_f32 %0, %1, %2" : "=v"(r) : "v"(lo), "v"(hi)); return r; }
__device__ __forceinline__ float wsum(float v) {
#pragma unroll
    for (int o = 32; o > 0; o >>= 1) v += __shfl_xor(v, o);
    return v;
}
__device__ __forceinline__ float siluf(float v) { return v / (1.0f + __expf(-v)); }
__device__ __forceinline__ float sigmf(float v) { return 1.0f / (1.0f + __expf(-v)); }
__device__ __forceinline__ float gelu_tanh(float x) {
    const float k0 = 0.7978845608028654f, k1 = 0.044715f;
    float u = k0 * (x + k1 * x * x * x);
    return 0.5f * x * (1.0f + tanhf(u));
}
__device__ __forceinline__ int rel_bucket(int d) {
    if (d < 16) return d < 0 ? 0 : d;
    int b = 16;
    b += (d >= 21); b += (d >= 27); b += (d >= 35); b += (d >= 46); b += (d >= 59); b += (d >= 77); b += (d >= 99); b += (d >= 128);
    b += (d >= 166); b += (d >= 216); b += (d >= 280); b += (d >= 363); b += (d >= 470); b += (d >= 609); b += (d >= 790);
    return b;
}

__device__ __forceinline__ int otid() { int t = threadIdx.x; asm volatile("" : "+v"(t)); return t; }

struct P {
    const float *x, *c, *rel, *router_w, *router_b, *final_norm, *norm_mix, *norm_ffn, *ada_w, *ada_b, *moe_wg, *moe_wu, *moe_wd,
        *ev_w_in, *ev_w_out, *pos_k, *pos_v, *ck_w1, *ck_w2, *cv_w1, *cv_w2, *od_w_in, *od_w_out, *q_norm, *kv_norm, *w_q_up, *w_kv_up, *sinks;
    float* out;
    unsigned* bar; int* cnt;
    float *modv, *ropec, *ropes, *blut, *gates, *kcmp, *vcmp, *chid, *kmean, *tokw;
    bf16_t *h, *proj, *o, *hid, *y, *proj1, *qmla, *kvmla, *krope, *cqn;
    int* list;
    bf16_t *wt_gu, *wt_d, *wt_in0, *wt_out0, *wt_c1, *wt_c2, *wt_in1, *wt_out1, *wt_qup, *wt_kvup, *chidb;
    float *c1, *c1p;
    int* wq;
    bf16_t* zrow;
    bf16_t *kcmpb, *kmeanb, *mlap;
    float* mlal;
    int* mcnt; unsigned short* mlist; bf16_t *mp01, *mp2; float* mpl;
};


__device__ __forceinline__ void st_prologue(const P& p, int wg, int nwg, float* sm) {
    const int TIDX = otid();
    const int tid = TIDX;
    {
        for (int i = tid; i < 2048; i += 256) sm[i] = siluf(p.c[i]);
        __syncthreads();
        const int wid = tid >> 6, lane = tid & 63;
        for (int w = wg; w < 192; w += nwg) {
            const int l = w / 96, cg = w % 96, col = cg * 64 + lane;
            const float* W = p.ada_w + (size_t)l * 1024 * 6144 + (size_t)(wid * 256) * 6144 + col;
            float a0 = 0.f, a1 = 0.f;
#pragma unroll 32
            for (int k = 0; k < 256; ++k) { const float wv = W[(size_t)k * 6144]; a0 += sm[wid * 256 + k] * wv; a1 += sm[1024 + wid * 256 + k] * wv; }
            sm[2048 + tid] = a0; sm[2304 + tid] = a1;
            __syncthreads();
            if (tid < 64) {
                const float bb = p.ada_b[l * 6144 + col];
                p.modv[(l * 2 + 0) * 6144 + col] = ((sm[2048 + tid] + sm[2048 + 64 + tid]) + (sm[2048 + 128 + tid] + sm[2048 + 192 + tid])) + bb;
                p.modv[(l * 2 + 1) * 6144 + col] = ((sm[2304 + tid] + sm[2304 + 64 + tid]) + (sm[2304 + 128 + tid] + sm[2304 + 192 + tid])) + bb;
            }
            __syncthreads();
        }
        __syncthreads();
    }
    for (int i = wg * 256 + tid; i < SEQ * 32; i += nwg * 256) {
        const int t = i >> 5, j = i & 31;
        const float inv = powf(10000.0f, -(float)(2 * j) / 64.0f);
        const float ang = (float)t * inv;
        p.ropec[i] = cosf(ang); p.ropes[i] = sinf(ang);
    }
    for (int i = wg * 256 + tid; i < 8 * 1024; i += nwg * 256) { const int h = i >> 10, d = i & 1023; p.blut[i] = p.rel[rel_bucket(d) * 8 + h]; }
}

#define RT_OFF 1024
template <int MODE>
__device__ __forceinline__ void st_norm(const P& p, int layer, int wg, int nwg, float* sm) {
    const int TIDX = otid();
    const int wid = TIDX >> 6, lane = TIDX & 63;
    int* rl_cnt = (int*)sm; int* rl_base = rl_cnt + 16; int* rl_ent = rl_cnt + 32;
    if (MODE == 1) {
        if (TIDX < 16) rl_cnt[TIDX] = 0;
        for (int i = TIDX; i < 64; i += 256) rl_ent[i] = -1;
        for (int idx = TIDX; idx < 4096; idx += 256) {
            const int col = idx >> 2, q = idx & 3;
            *(float4*)((char*)sm + RT_OFF + q * 16384 + (col & 3) * 4096 + ((col >> 8) * 64 + ((col >> 2) & 63)) * 16) = *(const float4*)(p.router_w + idx * 4);
        }
        __syncthreads();
    }
    const int niter = (T_TOK + nwg * 4 - 1) / (nwg * 4);
    const float* xin = (MODE == 0) ? p.x : p.out;
    float4 pre4[4];
    {
        const int row0 = wg * 4 + wid;
#pragma unroll
        for (int i = 0; i < 4; ++i) pre4[i] = (row0 < T_TOK) ? *(const float4*)(xin + (size_t)row0 * DM + i * 256 + lane * 4) : make_float4(0.f, 0.f, 0.f, 0.f);
    }
    for (int it = 0; it < niter; ++it) {
        const int row = wg * 4 + wid + it * nwg * 4;
        if (MODE != 1 && row >= T_TOK) break;
        float v[16];
#pragma unroll
        for (int i = 0; i < 4; ++i) { v[i * 4 + 0] = pre4[i].x; v[i * 4 + 1] = pre4[i].y; v[i * 4 + 2] = pre4[i].z; v[i * 4 + 3] = pre4[i].w; }
        {
            const int rown = row + nwg * 4;
            if (rown < T_TOK) {
#pragma unroll
                for (int i = 0; i < 4; ++i) pre4[i] = *(const float4*)(xin + (size_t)rown * DM + i * 256 + lane * 4);
            }
        }
        if (MODE != 1 || row < T_TOK) {
        const int b = row >> 13;
        if (MODE >= 2) {
            const int lp = (MODE == 2) ? layer - 1 : 1;
            const float* gf = p.modv + (size_t)(lp * 2 + b) * 6144 + 5 * 1024;
#pragma unroll
            for (int i = 0; i < 4; ++i)
#pragma unroll
                for (int j = 0; j < 4; ++j) {
                    const int col = i * 256 + lane * 4 + j;
                    const float y0 = bf2f(p.y[(size_t)(2 * row) * DM + col]), y1 = bf2f(p.y[(size_t)(2 * row + 1) * DM + col]);
                    v[i * 4 + j] += gf[col] * (y0 + y1);
                }
            if (MODE == 2) {
#pragma unroll
                for (int i = 0; i < 4; ++i)
                    *(float4*)(p.out + (size_t)row * DM + i * 256 + lane * 4) = make_float4(v[i * 4], v[i * 4 + 1], v[i * 4 + 2], v[i * 4 + 3]);
            }
        }
        float ss = 0.f;
#pragma unroll
        for (int i = 0; i < 16; ++i) ss += v[i] * v[i];
        ss = wsum(ss);
        const float r = rsqrtf(ss * (1.0f / 1024.0f) + 1e-6f);
        if (MODE == 3) {
#pragma unroll
            for (int i = 0; i < 4; ++i) {
                const float4 g4 = *(const float4*)(p.final_norm + i * 256 + lane * 4);
                *(float4*)(p.out + (size_t)row * DM + i * 256 + lane * 4) =
                    make_float4(v[i * 4] * r * g4.x, v[i * 4 + 1] * r * g4.y, v[i * 4 + 2] * r * g4.z, v[i * 4 + 3] * r * g4.w);
            }
            continue;
        }
        const float* g = ((MODE == 1) ? p.norm_ffn : p.norm_mix) + layer * 1024;
        const float* mv = p.modv + (size_t)(layer * 2 + b) * 6144;
        const float* shift = mv + ((MODE == 1) ? 3 : 0) * 1024;
        const float* scale = mv + ((MODE == 1) ? 4 : 1) * 1024;
        float hv[16];
#pragma unroll
        for (int i = 0; i < 4; ++i)
#pragma unroll
            for (int j = 0; j < 4; ++j) {
                const int col = i * 256 + lane * 4 + j;
                hv[i * 4 + j] = v[i * 4 + j] * r * g[col] * (1.0f + scale[col]) + shift[col];
                p.h[(size_t)row * DM + col] = f2bf(hv[i * 4 + j]);
            }
        if (MODE == 1) {
            float lg[16];
#pragma unroll
            for (int e = 0; e < 16; ++e) lg[e] = 0.f;
#pragma unroll
            for (int i = 0; i < 4; ++i)
#pragma unroll
                for (int j = 0; j < 4; ++j) {
                    const char* rw = (const char*)sm + RT_OFF + lane * 16 + j * 4096 + i * 1024;
#pragma unroll
                    for (int q = 0; q < 4; ++q) {
                        const float4 w4 = *(const float4*)(rw + q * 16384);
                        lg[4 * q] += hv[i * 4 + j] * w4.x; lg[4 * q + 1] += hv[i * 4 + j] * w4.y; lg[4 * q + 2] += hv[i * 4 + j] * w4.z; lg[4 * q + 3] += hv[i * 4 + j] * w4.w;
                    }
                    asm volatile("" ::: "memory");
                }
#pragma unroll
            for (int e = 0; e < 16; ++e) lg[e] = wsum(lg[e]);
            float aff[16], bi[16];
#pragma unroll
            for (int e = 0; e < 16; ++e) { aff[e] = 1.0f / (1.0f + expf(-lg[e])); bi[e] = aff[e] + p.router_b[e]; }
            float bestsc = -3e38f; int be0 = 0, be1 = 1; float bw0 = 0.f, bw1 = 0.f;
#pragma unroll
            for (int gI = 0; gI < 4; ++gI) {
                int i1 = 0; float m1 = bi[gI * 4];
#pragma unroll
                for (int i = 1; i < 4; ++i) if (bi[gI * 4 + i] > m1) { m1 = bi[gI * 4 + i]; i1 = i; }
                int i2 = -1; float m2 = -3e38f;
#pragma unroll
                for (int i = 0; i < 4; ++i) if (i != i1 && bi[gI * 4 + i] > m2) { m2 = bi[gI * 4 + i]; i2 = i; }
                const float sc = m1 + m2;
                float a1 = 0.f, a2 = 0.f;
#pragma unroll
                for (int i = 0; i < 4; ++i) { a1 = (i == i1) ? aff[gI * 4 + i] : a1; a2 = (i == i2) ? aff[gI * 4 + i] : a2; }
                if (sc > bestsc) { bestsc = sc; be0 = gI * 4 + i1; be1 = gI * 4 + i2; bw0 = a1; bw1 = a2; }
            }
            if (lane == 0) {
                const float ws = bw0 + bw1;
                p.tokw[row * 2] = bw0 / ws; p.tokw[row * 2 + 1] = bw1 / ws;
                const int s_ = (it & 7) * 4 + wid;
                const int r0 = atomicAdd(&rl_cnt[be0], 1), r1 = atomicAdd(&rl_cnt[be1], 1);
                rl_ent[s_ * 2] = (row << 12) | (be0 << 8) | r0;
                rl_ent[s_ * 2 + 1] = (row << 12) | (be1 << 8) | r1;
            }
        }
        }
        if (MODE == 1 && ((it & 7) == 7 || it == niter - 1)) {
            __syncthreads();
            if (TIDX < 16) { const int c = rl_cnt[TIDX]; rl_base[TIDX] = c ? atomicAdd(&p.cnt[(layer * 16 + TIDX) * 32], c) : 0; rl_cnt[TIDX] = 0; }
            __syncthreads();
            if (TIDX < 64) {
                const int en = rl_ent[TIDX];
                if (en >= 0) { const int e = (en >> 8) & 15; p.list[e * T_TOK + rl_base[e] + (en & 255)] = (en >> 12) * 2 + (TIDX & 1); rl_ent[TIDX] = -1; }
            }
            __syncthreads();
        }
    }
}

__device__ __forceinline__ void st_kmean(const P& p, int wg, int nwg, float* sm) {
    const int TIDX = otid();
    const int wid = TIDX >> 6, lane = TIDX & 63;
    for (int w = wg; w < 2 * 8 * 32; w += nwg) {
        const int b = w >> 8, h = (w >> 5) & 7, j = w & 31;
        const bf16_t* kp = p.proj + (size_t)(b * SEQ + j * 256 + wid * 64) * 2840 + 1816 + h * 64 + lane;
        float s = 0.f;
#pragma unroll 16
        for (int i = 0; i < 64; ++i) s += bf2f(kp[(size_t)i * 2840]);
        __syncthreads();
        sm[TIDX] = s;
        __syncthreads();
        if (TIDX < 64) {
            const float m = ((sm[TIDX] + sm[64 + TIDX]) + (sm[128 + TIDX] + sm[192 + TIDX])) * (1.0f / 256.0f);
            p.kmean[(size_t)w * 64 + TIDX] = m;
            p.kmeanb[(size_t)w * 64 + TIDX] = f2bf(m);
        }
    }
}
__device__ __forceinline__ void st_mla_prep(const P& p, int wg, int nwg) {
    const int TIDX = otid();
    const int wid = TIDX >> 6, lane = TIDX & 63;
    for (int row = wg * 4 + wid; row < T_TOK; row += nwg * 4) {
        const int t = row & (SEQ - 1);
        const bf16_t* pr = p.proj1 + (size_t)row * 1216;
        float q[4], ss = 0.f;
#pragma unroll
        for (int i = 0; i < 4; ++i) { q[i] = bf2f(pr[i * 64 + lane]); ss += q[i] * q[i]; }
        ss = wsum(ss);
        float r = rsqrtf(ss * (1.0f / 256.0f) + 1e-6f);
#pragma unroll
        for (int i = 0; i < 4; ++i) p.cqn[(size_t)row * 384 + i * 64 + lane] = f2bf(q[i] * r * p.q_norm[i * 64 + lane]);
        float kvv[2]; ss = 0.f;
#pragma unroll
        for (int i = 0; i < 2; ++i) { kvv[i] = bf2f(pr[256 + i * 64 + lane]); ss += kvv[i] * kvv[i]; }
        ss = wsum(ss);
        r = rsqrtf(ss * (1.0f / 128.0f) + 1e-6f);
#pragma unroll
        for (int i = 0; i < 2; ++i) p.cqn[(size_t)row * 384 + 256 + i * 64 + lane] = f2bf(kvv[i] * r * p.kv_norm[i * 64 + lane]);
        if (lane < 32) {
            const float x1 = bf2f(pr[384 + lane]), x2 = bf2f(pr[384 + 32 + lane]);
            const float cs = p.ropec[t * 32 + lane], sn = p.ropes[t * 32 + lane];
            p.krope[(size_t)row * 64 + lane] = f2bf(x1 * cs - x2 * sn);
            p.krope[(size_t)row * 64 + 32 + lane] = f2bf(x1 * sn + x2 * cs);
        }
    }
}


typedef short bf16x8 __attribute__((ext_vector_type(8)));
typedef float f32x4 __attribute__((ext_vector_type(4)));
typedef unsigned u32x2 __attribute__((ext_vector_type(2)));
typedef unsigned u32x4v __attribute__((ext_vector_type(4)));
#define LDSP __attribute__((address_space(3)))
#define GEMM_LDS_BYTES 81920
#define KERNEL_LDS_BYTES 81920
#define BAR_LDS_OFF (KERNEL_LDS_BYTES - 16)

__device__ __forceinline__ unsigned pack_bf16(float lo, float hi) { return cvtpk(lo, hi); }

template <int MF, class AR, class BR, class Epi, class NX>
__device__ __forceinline__ void gemm128x(const int nk, const size_t akstep, const size_t bkstep, AR arow, BR brow, Epi epi, LDSP char* lds, const int tid, const bool staged, NX next) {
    constexpr int SS = MF * 4096 + 16384, BO = MF * 4096;
    const int wid = tid >> 6, lane = tid & 63, wr = wid >> 1, wc = wid & 1, fr = lane & 15, fq = lane >> 4;
    const int srow = tid >> 3, gch = ((tid & 7) ^ (srow & 7)) * 8;
    const bf16_t* ap[MF]; const bf16_t* bp[4];
#pragma unroll
    for (int i = 0; i < MF; ++i) ap[i] = arow(32 * i + srow) + gch;
#pragma unroll
    for (int i = 0; i < 4; ++i) bp[i] = brow(32 * i + srow) + gch;
    LDSP char* lw = lds + wid * 1024;
#define G128_ISSUE(st, kt) do { LDSP char* la_ = lw + (st) * SS; const size_t ao_ = (size_t)(kt) * akstep, bo_ = (size_t)(kt) * bkstep; \
        _Pragma("unroll") for (int i_ = 0; i_ < MF; ++i_) __builtin_amdgcn_global_load_lds((const unsigned*)(ap[i_] + ao_), (LDSP unsigned*)(la_ + 4096 * i_), 16, 0, 0); \
        _Pragma("unroll") for (int i_ = 0; i_ < 4; ++i_) __builtin_amdgcn_global_load_lds((const unsigned*)(bp[i_] + bo_), (LDSP unsigned*)(la_ + BO + 4096 * i_), 16, 0, 0); } while (0)
    f32x4 acc[MF][4];
#pragma unroll
    for (int m = 0; m < MF; ++m)
#pragma unroll
        for (int n = 0; n < 4; ++n) acc[m][n] = (f32x4){0.f, 0.f, 0.f, 0.f};
    const int aoff = (wr * 16 * MF + fr) * 128, boff = BO + (wc * 64 + fr) * 128, c0 = (fq ^ (fr & 7)) * 16;
    if (!staged) G128_ISSUE(0, 0);
    for (int kt = 0; kt < nk; ++kt) {
        const int cur = kt & 1;
        asm volatile("s_waitcnt vmcnt(0)" ::: "memory");
        __builtin_amdgcn_s_barrier();
        asm volatile("" ::: "memory");
        LDSP char* sb = lds + cur * SS;
        constexpr int NG = 2 * MF, PD = 3;
        bf16x8 af[NG], bf[2][4];
#define G128_AF(s_) (*(const LDSP bf16x8*)(sb + aoff + ((s_) % MF) * 2048 + (((s_) / MF) ? (c0 ^ 64) : c0)))
#pragma unroll
        for (int n = 0; n < 4; ++n) bf[0][n] = *(const LDSP bf16x8*)(sb + boff + n * 2048 + c0);
#pragma unroll
        for (int s = 0; s < PD; ++s) af[s] = G128_AF(s);
        __builtin_amdgcn_sched_barrier(0);
        if (kt + 1 < nk) G128_ISSUE(cur ^ 1, kt + 1);
        __builtin_amdgcn_sched_barrier(0);
#pragma unroll
        for (int s = 0; s < NG; ++s) {
            if (s + PD < NG) af[s + PD] = G128_AF(s + PD);
            if (s == MF - PD) {
#pragma unroll
                for (int n = 0; n < 4; ++n) bf[1][n] = *(const LDSP bf16x8*)(sb + boff + n * 2048 + (c0 ^ 64));
            }
#pragma unroll
            for (int n = 0; n < 4; ++n) acc[s % MF][n] = __builtin_amdgcn_mfma_f32_16x16x32_bf16(bf[s / MF][n], af[s], acc[s % MF][n], 0, 0, 0);
            __builtin_amdgcn_sched_barrier(0);
        }
#undef G128_AF
    }
    asm volatile("s_waitcnt lgkmcnt(0)" ::: "memory");
    __builtin_amdgcn_s_barrier();
    asm volatile("" ::: "memory");
    next();
#undef G128_ISSUE
#pragma unroll
    for (int m = 0; m < MF; ++m) epi(wr * 16 * MF + m * 16 + fr, wc * 64 + fq * 4, acc[m], m);
}

template <int MF, class AR, class BR>
__device__ __forceinline__ void g128_stage0(AR arow, BR brow, LDSP char* lds, const int tid) {
    const int wid = tid >> 6, srow = tid >> 3, gch = ((tid & 7) ^ (srow & 7)) * 8;
    LDSP char* lw = lds + wid * 1024;
#pragma unroll
    for (int i = 0; i < MF; ++i) {
        __builtin_amdgcn_global_load_lds((const unsigned*)(arow(32 * i + srow) + gch), (LDSP unsigned*)(lw + 4096 * i), 16, 0, 0);
    }
#pragma unroll
    for (int i = 0; i < 4; ++i) {
        __builtin_amdgcn_global_load_lds((const unsigned*)(brow(32 * i + srow) + gch), (LDSP unsigned*)(lw + MF * 4096 + 4096 * i), 16, 0, 0);
    }
}
template <class AR, class BR, class Epi>
__device__ __forceinline__ void gemm128(const int nk, const size_t akstep, const size_t bkstep, AR arow, BR brow, Epi epi, LDSP char* lds, const int tid) {
    gemm128x<4>(nk, akstep, bkstep, arow, brow, epi, lds, tid, false, [] {});
}

template <int MAP> __device__ __forceinline__ int conv_rowmap(int n) {
    if (MAP == 0) return n;
    const int tile = n >> 6, cc = n & 63, wc = cc >> 5, i16 = (cc >> 4) & 1, i = cc & 15;
    return tile * 128 + wc * 64 + ((MAP == 1 ? 0 : 2) + i16) * 16 + i;
}
template <int MAP>
__device__ __forceinline__ void conv_batched(const float* src, int nmat, int K, int N, size_t sstride, bf16_t* dst, size_t dstride, int wg, int nwg, float* sm, int tid, int wend = 0x7fffffff) {
    float(*t)[65] = (float(*)[65])sm;
    const int tk = K >> 6, tn = (N + 63) >> 6, per = tk * tn, total = (nmat * per < wend) ? nmat * per : wend;
    f32x4 v[4];
    auto ld = [&](int w) {
        const int mat = w / per, r = w % per, kt = r / tn, nt = r % tn;
        const float* s = src + (size_t)mat * sstride;
#pragma unroll
        for (int i = 0; i < 4; ++i) {
            const int idx = tid + 256 * i, k = idx >> 4, n = (idx & 15) * 4;
            v[i] = (f32x4){0.f, 0.f, 0.f, 0.f};
            if (nt * 64 + n < N) v[i] = *(const f32x4*)(s + (size_t)(kt * 64 + k) * N + nt * 64 + n);
        }
    };
    if (wg < total) ld(wg);
    for (int w = wg; w < total; w += nwg) {
        const int mat = w / per, r = w % per, kt = r / tn, nt = r % tn;
        bf16_t* d = dst + (size_t)mat * dstride;
#pragma unroll
        for (int i = 0; i < 4; ++i) {
            const int idx = tid + 256 * i, k = idx >> 4, n = (idx & 15) * 4;
            t[k][n] = v[i][0]; t[k][n + 1] = v[i][1]; t[k][n + 2] = v[i][2]; t[k][n + 3] = v[i][3];
        }
        __syncthreads();
        if (w + nwg < total) ld(w + nwg);
        {
            const int n = tid >> 2, kq = (tid & 3) * 16;
            if (nt * 64 + n < N) {
                unsigned pk[8];
#pragma unroll
                for (int j = 0; j < 8; ++j) pk[j] = cvtpk(t[kq + 2 * j][n], t[kq + 2 * j + 1][n]);
                bf16_t* o = d + (size_t)conv_rowmap<MAP>(nt * 64 + n) * K + kt * 64 + kq;
                *(u32x4v*)o = (u32x4v){pk[0], pk[1], pk[2], pk[3]};
                *(u32x4v*)(o + 8) = (u32x4v){pk[4], pk[5], pk[6], pk[7]};
            }
        }
        __syncthreads();
    }
}
__device__ __forceinline__ void st_convert(const P& p, int wg, int nwg, float* sm) {
    const int tid = otid();
    conv_batched<0>(p.ev_w_in, 1, 1024, 2840, 0, p.wt_in0, 0, wg, nwg, sm, tid);
    conv_batched<0>(p.ev_w_out, 1, 1024, 1024, 0, p.wt_out0, 0, wg, nwg, sm, tid);
    conv_batched<0>(p.ck_w1, 1, 2048, 256, 0, p.wt_c1, 0, wg, nwg, sm, tid);
    conv_batched<0>(p.cv_w1, 1, 2048, 256, 0, p.wt_c1 + 256 * 2048, 0, wg, nwg, sm, tid);
    conv_batched<0>(p.ck_w2, 1, 256, 64, 0, p.wt_c2, 0, wg, nwg, sm, tid);
    conv_batched<0>(p.cv_w2, 1, 256, 64, 0, p.wt_c2 + 64 * 256, 0, wg, nwg, sm, tid);
    conv_batched<0>(p.od_w_in, 1, 1024, 1216, 0, p.wt_in1, 0, wg, nwg, sm, tid);
    conv_batched<0>(p.od_w_out, 1, 1024, 1024, 0, p.wt_out1, 0, wg, nwg, sm, tid);
    conv_batched<0>(p.w_q_up, 1, 256, 768, 0, p.wt_qup, 0, wg, nwg, sm, tid);
    conv_batched<0>(p.w_kv_up, 1, 128, 1024, 0, p.wt_kvup, 0, wg, nwg, sm, tid);
    {
        const int wid = tid >> 6, lane = tid & 63;
        for (int w = wg * 4 + wid; w < 512; w += nwg * 4) {
            const int which = w >> 8, cg = (w >> 6) & 3, ks = w & 63, col = cg * 64 + lane;
            const float* w1 = (which ? p.cv_w1 : p.ck_w1) + (size_t)(ks * 32) * 256 + col; const float* pos = (which ? p.pos_v : p.pos_k) + ks * 32;
            float a = 0.f;
#pragma unroll
            for (int k = 0; k < 32; ++k) a += pos[k] * w1[(size_t)k * 256];
            p.c1p[(which * 64 + ks) * 256 + col] = a;
        }
    }
}
__device__ __forceinline__ void st_c1_reduce(const P& p, int wg, int nwg) {
    const int tid = otid();
    for (int i = wg * 256 + tid; i < 512; i += nwg * 256) {
        const int which = i >> 8, col = i & 255;
        float a = 0.f;
#pragma unroll 16
        for (int ks = 0; ks < 64; ++ks) a += p.c1p[(which * 64 + ks) * 256 + col];
        p.c1[i] = a;
    }
}


struct XcdOrder {
    int xcd, lw, nlw, tn, per;
    __device__ __forceinline__ XcdOrder(int wg, int nwg, int nM, int tn_) : xcd(wg & 7), lw(wg >> 3), nlw(nwg >> 3), tn(tn_), per((nM >> 3) * tn_) {}
    __device__ __forceinline__ bool get(int k, int& mt, int& nt) const { const int lt = lw + k * nlw; if (lt >= per) return false; mt = xcd + 8 * (lt / tn); nt = lt % tn; return true; }
};
template <int MF>
__device__ __forceinline__ void st_inproj0_mf(const P& p, int wg, int nwg, LDSP char* lds) {
    const int tid = otid();
    const XcdOrder ord(wg, nwg, ((T_TOK + 32 * MF - 1) / (32 * MF) + 7) & ~7, 23);
    auto Af = [&](int mt_) { return [=](int r) { int row = mt_ * (32 * MF) + r; row = row < T_TOK ? row : T_TOK - 1; return p.h + (size_t)row * DM; }; };
    auto Bf = [&](int nt_) { return [=](int r) { int n = nt_ * 128 + r; n = n < 2840 ? n : 2839; return p.wt_in0 + (size_t)n * 1024; }; };
    bool staged = false;
    for (int k = 0;; ++k) {
        int mt, nt, mt2 = 0, nt2 = 0;
        if (!ord.get(k, mt, nt)) break;
        if (mt * (32 * MF) >= T_TOK) break;
        const bool has2 = ord.get(k + 1, mt2, nt2) && mt2 * (32 * MF) < T_TOK;
        const bool st_ = staged; staged = has2;
        gemm128x<MF>(16, 64, 64, Af(mt), Bf(nt),
            [&](int rl, int cl, const f32x4 (&a)[4], int mfrag) {
                const int row = mt * (32 * MF) + rl;
#pragma unroll
                for (int n = 0; n < 4; ++n) {
                    const int col = nt * 128 + cl + n * 16;
                    if (col < 2840 && row < T_TOK) {
                        *(u32x2*)(p.proj + (size_t)row * 2840 + col) = (u32x2){pack_bf16(a[n][0], a[n][1]), pack_bf16(a[n][2], a[n][3])};
                        if (col >= 1280 && col < 1304)
                            *(f32x4*)(p.gates + (size_t)row * 24 + (col - 1280)) = (f32x4){sigmf(a[n][0]), sigmf(a[n][1]), sigmf(a[n][2]), sigmf(a[n][3])};
                    }
                }
            }, lds, tid, st_, [&] { if (has2) g128_stage0<MF>(Af(mt2), Bf(nt2), lds, tid); });
    }
}
__device__ __forceinline__ void st_cmp1_mf(const P& p, int wg, int nwg, LDSP char* lds) {
    const int tid = otid();
    for (int w = wg; w < 2 * 16 * 2; w += nwg) {
        const int which = w >> 5, mt = (w >> 1) & 15, nt = w & 1;
        const int colbase = which ? 640 : 512;
        gemm128(32, 2840, 64,
            [&](int r) { int m = mt * 128 + r; m = m < 2044 ? m : 2043; const int bk = m / 511, n = m % 511, b = bk >> 1, kv = bk & 1;
                         return p.proj + (size_t)(b * SEQ + 16 * n) * 2840 + colbase + kv * 64; },
            [&](int r) { return p.wt_c1 + (size_t)(which * 256 + nt * 128 + r) * 2048; },
            [&](int rl, int cl, const f32x4 (&a)[4], int mfrag) {
                const int m = mt * 128 + rl;
                if (m < 2044) {
#pragma unroll
                    for (int n = 0; n < 4; ++n) {
                        const int col = nt * 128 + cl + n * 16;
                        const f32x4 cb = *(const f32x4*)(p.c1 + which * 256 + col);
                        *(u32x2*)(p.chidb + (size_t)(which * 2048 + m) * 256 + col) =
                            (u32x2){pack_bf16(gelu_tanh(a[n][0] + cb[0]), gelu_tanh(a[n][1] + cb[1])), pack_bf16(gelu_tanh(a[n][2] + cb[2]), gelu_tanh(a[n][3] + cb[3]))};
                    }
                }
            }, lds, tid);
    }
}
__device__ __forceinline__ void st_cmp2_mf(const P& p, int wg, int nwg, LDSP char* lds) {
    const int tid = otid();
    for (int w = wg; w < 2 * 16; w += nwg) {
        const int which = w >> 4, mt = w & 15;
        gemm128(4, 64, 64,
            [&](int r) { int m = mt * 128 + r; m = m < 2044 ? m : 2043; return p.chidb + (size_t)(which * 2048 + m) * 256; },
            [&](int r) { return p.wt_c2 + (size_t)(which * 64 + (r & 63)) * 256; },
            [&](int rl, int cl, const f32x4 (&a)[4], int mfrag) {
                const int m = mt * 128 + rl;
                if (m < 2044) {
#pragma unroll
                    for (int n = 0; n < 4; ++n) { const int col = cl + n * 16; if (col < 64) {
                        const int bk = m / 511, nn = m % 511;
                        *(u32x2*)(p.kcmpb + ((size_t)((which * 4 + bk) * 512 + nn)) * 64 + col) = (u32x2){cvtpk(a[n][0], a[n][1]), cvtpk(a[n][2], a[n][3])}; } }
                }
            }, lds, tid);
    }
}
template <int MF>
__device__ __forceinline__ void st_outproj_mf(const P& p, int layer, int wg, int nwg, LDSP char* lds) {
    const int tid = otid();
    const bf16_t* W = layer ? p.wt_out1 : p.wt_out0;
    const float* xin = layer ? p.out : p.x;
    const XcdOrder ord(wg, nwg, ((T_TOK + 32 * MF - 1) / (32 * MF) + 7) & ~7, 8);
    auto Af = [&](int mt_) { return [=](int r) { int row = mt_ * (32 * MF) + r; row = row < T_TOK ? row : T_TOK - 1; return p.o + (size_t)row * DM; }; };
    auto Bf = [&](int nt_) { return [=](int r) { return W + (size_t)(nt_ * 128 + r) * 1024; }; };
    bool staged = false;
    for (int k = 0;; ++k) {
        int mt, nt, mt2 = 0, nt2 = 0;
        if (!ord.get(k, mt, nt)) break;
        if (mt * (32 * MF) >= T_TOK) break;
        const bool has2 = ord.get(k + 1, mt2, nt2) && mt2 * (32 * MF) < T_TOK;
        const bool st_ = staged; staged = has2;
        gemm128x<MF>(16, 64, 64, Af(mt), Bf(nt),
            [&](int rl, int cl, const f32x4 (&a)[4], int mfrag) {
                const int row = mt * (32 * MF) + rl, b = row >> 13;
                const float* g = p.modv + (size_t)(layer * 2 + (b & 1)) * 6144 + 2 * 1024;
                if (row < T_TOK)
#pragma unroll
                for (int n = 0; n < 4; ++n) {
                    const int col = nt * 128 + cl + n * 16;
                    const f32x4 xv = *(const f32x4*)(xin + (size_t)row * DM + col), gv = *(const f32x4*)(g + col);
                    *(f32x4*)(p.out + (size_t)row * DM + col) = xv + gv * a[n];
                }
            }, lds, tid, st_, [&] { if (has2) g128_stage0<MF>(Af(mt2), Bf(nt2), lds, tid); });
    }
}
template <int BM>
__device__ __forceinline__ bool moe_tile128(const int* cnt, int tt, int& e, int& i0, int& off) {
    int acc = 0, o = 0;
    for (int q = 0; q < 16; ++q) {
        const int c = cnt[q * 32], nt = (c + BM - 1) / BM;
        if (tt < acc + nt) { e = q; i0 = (tt - acc) * BM; off = o; return true; }
        acc += nt; o += c;
    }
    return false;
}
struct MoeTile { int e, i0, off, nt, ce; bool ok; };
template <int BM>
__device__ __forceinline__ MoeTile moe_get(const int* cnt, int wg, int nwg, int k) {
    int mtot = 0;
    for (int q = 0; q < 16; ++q) mtot += (cnt[q * 32] + BM - 1) / BM;
    const int per = (mtot + 7) >> 3, lt = (wg >> 3) + k * (nwg >> 3), lm = lt >> 3;
    MoeTile t; t.nt = lt & 7; t.e = 0; t.i0 = 0; t.off = 0;
    t.ok = (lm < per) && moe_tile128<BM>(cnt, (wg & 7) * per + lm, t.e, t.i0, t.off);
    t.ce = t.ok ? cnt[t.e * 32] : 0; return t;
}
template <int MF>
__device__ __forceinline__ void st_moe_up_mf(const P& p, int layer, int wg, int nwg, LDSP char* lds) {
    const int tid = otid();
    const int* cnt = p.cnt + layer * 512;
    auto Af = [&](const MoeTile& t) { const int* lst = p.list + t.e * T_TOK; const int i0 = t.i0, ce = t.ce;
                                      return [=](int r) { const int i = (i0 + r < ce) ? i0 + r : i0; return p.h + (size_t)(lst[i] >> 1) * DM; }; };
    auto Bf = [&](const MoeTile& t) { const bf16_t* B = p.wt_gu + ((size_t)(layer * 16 + t.e) * 1024 + t.nt * 128) * 1024; return [=](int r) { return B + (size_t)r * 1024; }; };
    MoeTile cur = moe_get<32 * MF>(cnt, wg, nwg, 0);
    bool staged = false;
    for (int k = 0; cur.ok; ++k) {
        const MoeTile nx = moe_get<32 * MF>(cnt, wg, nwg, k + 1);
        const bool st_ = staged; staged = nx.ok;
        const int i0 = cur.i0, ce = cur.ce, off = cur.off, nt = cur.nt;
        gemm128x<MF>(16, 64, 64, Af(cur), Bf(cur),
            [&](int rl, int cl, const f32x4 (&a)[4], int mfrag) {
                if (i0 + rl < ce) {
                    const int wc = cl >> 6, fq4 = cl & 63;
#pragma unroll
                    for (int n = 0; n < 2; ++n) {
                        const int col = nt * 64 + wc * 32 + n * 16 + fq4;
                        const f32x4 g = a[n], u = a[n + 2];
                        *(u32x2*)(p.hid + (size_t)(off + i0 + rl) * 512 + col) =
                            (u32x2){pack_bf16(siluf(g[0]) * u[0], siluf(g[1]) * u[1]), pack_bf16(siluf(g[2]) * u[2], siluf(g[3]) * u[3])};
                    }
                }
            }, lds, tid, st_, [&] { if (nx.ok) g128_stage0<MF>(Af(nx), Bf(nx), lds, tid); });
        cur = nx;
    }
}
template <int MF>
__device__ __forceinline__ void st_moe_down_mf(const P& p, int layer, int wg, int nwg, LDSP char* lds) {
    const int tid = otid();
    const int* cnt = p.cnt + layer * 512;
    auto Af = [&](const MoeTile& t) { const int i0 = t.i0, ce = t.ce, off = t.off; return [=](int r) { const int i = (i0 + r < ce) ? i0 + r : i0; return p.hid + (size_t)(off + i) * 512; }; };
    auto Bf = [&](const MoeTile& t) { const bf16_t* B = p.wt_d + ((size_t)(layer * 16 + t.e) * 1024 + t.nt * 128) * 512; return [=](int r) { return B + (size_t)r * 512; }; };
    MoeTile cur = moe_get<32 * MF>(cnt, wg, nwg, 0);
    bool staged = false;
    for (int k = 0; cur.ok; ++k) {
        const MoeTile nx = moe_get<32 * MF>(cnt, wg, nwg, k + 1);
        const bool st_ = staged; staged = nx.ok;
        const int i0 = cur.i0, ce = cur.ce, nt = cur.nt;
        const int* lst = p.list + cur.e * T_TOK;
        int ids[MF]; float wts[MF];
#pragma unroll
        for (int m = 0; m < MF; ++m) { const int rl = ((tid >> 7) & 1) * (16 * MF) + m * 16 + (tid & 15); ids[m] = (i0 + rl < ce) ? lst[i0 + rl] : -1; }
#pragma unroll
        for (int m = 0; m < MF; ++m) wts[m] = ids[m] >= 0 ? p.tokw[ids[m]] : 0.f;
        gemm128x<MF>(8, 64, 64, Af(cur), Bf(cur),
            [&](int rl, int cl, const f32x4 (&a)[4], int mfrag) {
                if (i0 + rl < ce) {
                    const int id = ids[mfrag]; const float wt = wts[mfrag];
#pragma unroll
                    for (int n = 0; n < 4; ++n) {
                        const int col = nt * 128 + cl + n * 16;
                        *(u32x2*)(p.y + (size_t)id * DM + col) = (u32x2){pack_bf16(wt * a[n][0], wt * a[n][1]), pack_bf16(wt * a[n][2], wt * a[n][3])};
                    }
                }
            }, lds, tid, st_, [&] { if (nx.ok) g128_stage0<MF>(Af(nx), Bf(nx), lds, tid); });
        cur = nx;
    }
}
template <int MF>
__device__ __forceinline__ void st_inproj1_mf(const P& p, int wg, int nwg, LDSP char* lds) {
    const int tid = otid();
    const XcdOrder ord(wg, nwg, ((T_TOK + 32 * MF - 1) / (32 * MF) + 7) & ~7, 10);
    auto Af = [&](int mt_) { return [=](int r) { int row = mt_ * (32 * MF) + r; row = row < T_TOK ? row : T_TOK - 1; return p.h + (size_t)row * DM; }; };
    auto Bf = [&](int nt_) { return [=](int r) { int n = nt_ * 128 + r; n = n < 1216 ? n : 1215; return p.wt_in1 + (size_t)n * 1024; }; };
    bool staged = false;
    for (int k = 0;; ++k) {
        int mt, nt, mt2 = 0, nt2 = 0;
        if (!ord.get(k, mt, nt)) break;
        if (mt * (32 * MF) >= T_TOK) break;
        const bool has2 = ord.get(k + 1, mt2, nt2) && mt2 * (32 * MF) < T_TOK;
        const bool st_ = staged; staged = has2;
        gemm128x<MF>(16, 64, 64, Af(mt), Bf(nt),
            [&](int rl, int cl, const f32x4 (&a)[4], int mfrag) {
                const int row = mt * (32 * MF) + rl;
#pragma unroll
                for (int n = 0; n < 4; ++n) {
                    const int col = nt * 128 + cl + n * 16;
                    if (col < 1216 && row < T_TOK) *(u32x2*)(p.proj1 + (size_t)row * 1216 + col) = (u32x2){pack_bf16(a[n][0], a[n][1]), pack_bf16(a[n][2], a[n][3])};
                }
            }, lds, tid, st_, [&] { if (has2) g128_stage0<MF>(Af(mt2), Bf(nt2), lds, tid); });
    }
}
__device__ __forceinline__ void st_mla_up_mf(const P& p, int wg, int nwg, LDSP char* lds) {
    const int tid = otid();
    const XcdOrder ord(wg, nwg, 128, 14);
    for (int k = 0;; ++k) {
        int mt, c;
        if (!ord.get(k, mt, c)) break;
        if (c < 6) {
            gemm128(4, 64, 64,
                [&](int r) { return p.cqn + (size_t)(mt * 128 + r) * 384; },
                [&](int r) { return p.wt_qup + (size_t)(c * 128 + r) * 256; },
                [&](int rl, int cl, const f32x4 (&a)[4], int mfrag) {
                    const int row = mt * 128 + rl, wc = cl >> 6;
                    f32x4 v[4] = {a[0], a[1], a[2], a[3]};
                    if (((c == 1 || c == 4) && wc == 0) || ((c == 2 || c == 5) && wc == 1)) {
                        const int t = row & (SEQ - 1), i0 = cl & 63;
#pragma unroll
                        for (int n = 0; n < 2; ++n) {
                            const f32x4 cs = *(const f32x4*)(p.ropec + t * 32 + n * 16 + i0), sn = *(const f32x4*)(p.ropes + t * 32 + n * 16 + i0);
                            v[n] = a[n] * cs - a[n + 2] * sn; v[n + 2] = a[n] * sn + a[n + 2] * cs;
                        }
                    }
#pragma unroll
                    for (int n = 0; n < 4; ++n) *(u32x2*)(p.qmla + (size_t)row * 768 + c * 128 + cl + n * 16) = (u32x2){cvtpk(v[n][0], v[n][1]), cvtpk(v[n][2], v[n][3])};
                }, lds, tid);
        } else {
            gemm128(2, 64, 64,
                [&](int r) { return p.cqn + (size_t)(mt * 128 + r) * 384 + 256; },
                [&](int r) { return p.wt_kvup + (size_t)((c - 6) * 128 + r) * 128; },
                [&](int rl, int cl, const f32x4 (&a)[4], int mfrag) {
                    const int row = mt * 128 + rl;
#pragma unroll
                    for (int n = 0; n < 4; ++n) *(u32x2*)(p.kvmla + (size_t)row * 1024 + (c - 6) * 128 + cl + n * 16) = (u32x2){pack_bf16(a[n][0], a[n][1]), pack_bf16(a[n][2], a[n][3])};
                }, lds, tid);
        }
    }
}

typedef float f32x16 __attribute__((ext_vector_type(16)));
typedef short s16x4 __attribute__((ext_vector_type(4)));
#define ATT_NEG (-1e30f)
#define ATT_SHIFT (-16.0f)
#define LOG2E 1.4426950408889634f

__device__ __forceinline__ int swz128(int row) { return (((row >> 1) & 1) << 2) | ((row >> 2) & 3); }
__device__ __forceinline__ int swz256(int row) { return ((row & 3) << 2) | ((row >> 2) & 3); }

struct AttLane {
    int kbase;
    int v0[2];
};
template <int KROWB, int VROWB, int DT>
__device__ __forceinline__ void att_lane_init(AttLane& L, int lane) {
    const int q = lane & 31, hh = lane >> 5, x = hh ^ swz128(q);
    L.kbase = q * KROWB + x * 16;
    const int rl = 4 * hh + ((lane & 15) >> 2), blk = (lane >> 4) & 1, pp = lane & 3;
#pragma unroll
    for (int t = 0; t < 2; ++t) {
        const int g = (VROWB == 256) ? (((rl & 3) << 2) | ((2 * t + hh) & 3)) : ((((rl >> 1) & 1) << 2) | ((2 * t + hh) & 3));
        L.v0[t] = rl * VROWB + (((2 * blk + (pp >> 1)) ^ g) * 16) + 8 * (pp & 1);
    }
}
template <int KS, int KROWB, int MODE, bool WANT_P, bool IMP>
__device__ __forceinline__ void att_qk(LDSP const char* kb, const AttLane& L, const bf16x8 (&qf)[KS], bf16x8 (&pf)[4], float& lsum, const float c1, const float cadd,
                                       const unsigned lutv, const int dq16, LDSP float* improw, const float invl) {
    float la = 0.f, lb = 0.f, lc = 0.f, ld = 0.f;
#pragma unroll
    for (int kt = 0; kt < 2; ++kt) {
        f32x16 s;
#pragma unroll
        for (int r = 0; r < 16; ++r) s[r] = 0.f;
        constexpr int KG = (KS > 4) ? 2 : 4;
#pragma unroll
        for (int k4 = 0; k4 < KS; k4 += KG) {
            bf16x8 a[KG];
#pragma unroll
            for (int j = 0; j < KG; ++j) { const int ks = k4 + j; a[j] = *(const LDSP bf16x8*)(kb + (L.kbase ^ (32 * (ks & 3))) + (ks >> 2) * 128 + kt * 32 * KROWB); }
#pragma unroll
            for (int j = 0; j < KG; ++j) s = __builtin_amdgcn_mfma_f32_32x32x16_bf16(a[j], qf[k4 + j], s, 0, 0, 0);
            asm volatile("" ::: "memory");
        }
        float pr[16];
#pragma unroll
        for (int r = 0; r < 16; ++r) {
            const int koff = 32 * kt + (r & 3) + 8 * (r >> 2);
            float add = cadd;
            if (MODE == 1) add = *(const LDSP float*)(lutv + (63 - koff) * 4);
            if (MODE == 2) { int d = dq16 - 16 * koff; d = d < -1 ? -1 : d; d = d > 1087 ? 1087 : d; add = *(const LDSP float*)(lutv + (unsigned)(64 + d) * 4u); }
            pr[r] = __builtin_amdgcn_exp2f(__builtin_fmaf(s[r], c1, add));
        }
#pragma unroll
        for (int r = 0; r < 16; r += 4) { la += pr[r]; lb += pr[r + 1]; lc += pr[r + 2]; ld += pr[r + 3]; }
        if (IMP) {
#pragma unroll
            for (int g = 0; g < 4; ++g) {
                (void)__hip_atomic_fetch_add((LDSP unsigned*)improw + 8 * kt + 2 * g, (unsigned)(((pr[4 * g] + pr[4 * g + 1]) + (pr[4 * g + 2] + pr[4 * g + 3])) * invl + 0.5f), __ATOMIC_RELAXED, __HIP_MEMORY_SCOPE_WORKGROUP);
                (void)__hip_atomic_fetch_add((LDSP unsigned*)improw + 8 * kt + 2 * g + 1, (unsigned)(pr[4 * g + 3] * invl + 0.5f), __ATOMIC_RELAXED, __HIP_MEMORY_SCOPE_WORKGROUP);
            }
        }
        if (WANT_P) {
#pragma unroll
            for (int sI = 0; sI < 2; ++sI) {
                union { unsigned u[4]; bf16x8 v; } cv;
#pragma unroll
                for (int i = 0; i < 4; ++i) cv.u[i] = cvtpk_valu(pr[8 * sI + 2 * i], pr[8 * sI + 2 * i + 1]);
                pf[kt * 2 + sI] = cv.v;
            }
        }
    }
    lsum += (la + lb) + (lc + ld);
}
template <int DT, int VROWB>
__device__ __forceinline__ void att_pv(LDSP const char* vb, const AttLane& L, const bf16x8 (&pf)[4], f32x16 (&o)[DT]) {
    const unsigned vba = (unsigned)(size_t)vb;
#pragma unroll
    for (int ks2 = 0; ks2 < 4; ++ks2) {
#pragma unroll
        for (int d0 = 0; d0 < DT; d0 += 2) {
            s16x4 lo[2], hi[2];
#pragma unroll
            for (int j = 0; j < 2; ++j) {
                asm volatile("ds_read_b64_tr_b16 %0, %1 offset:%2" : "=v"(lo[j]) : "v"(vba + (L.v0[0] ^ ((d0 + j) << 6))), "i"((16 * ks2) * VROWB) : "memory");
                asm volatile("ds_read_b64_tr_b16 %0, %1 offset:%2" : "=v"(hi[j]) : "v"(vba + (L.v0[1] ^ ((d0 + j) << 6))), "i"((16 * ks2 + 8) * VROWB) : "memory");
            }
            asm volatile("s_waitcnt lgkmcnt(0)" ::: "memory");
#pragma unroll
            for (int j = 0; j < 2; ++j) {
                asm volatile("" : "+v"(lo[j]), "+v"(hi[j]));
                const bf16x8 vf = __builtin_shufflevector(lo[j], hi[j], 0, 1, 2, 3, 4, 5, 6, 7);
                o[d0 + j] = __builtin_amdgcn_mfma_f32_32x32x16_bf16(vf, pf[ks2], o[d0 + j], 0, 0, 0);
            }
        }
    }
}
template <int CPR>
__device__ __forceinline__ void att_stage_map(int (&rowc)[(CPR == 24) ? 6 : 1], int tid) {
    if (CPR == 24) {
#pragma unroll
        for (int i = 0; i < 6; ++i) {
            const int c = tid + 256 * i, row = c / 24, cc = c % 24;
            rowc[i % ((CPR == 24) ? 6 : 1)] = (row << 8) | ((cc & ~7) | ((cc & 7) ^ swz128(row)));
        }
    } else if (CPR == 16) {
        const int row = tid >> 4; rowc[0] = (row << 8) | ((tid & 15) ^ swz256(row));
    } else {
        const int row = tid >> 3; rowc[0] = (row << 8) | ((tid & 7) ^ swz128(row));
    }
}
template <int CPR, class SRC>
__device__ __forceinline__ void att_stage(LDSP char* dst, SRC src, const int (&rowc)[(CPR == 24) ? 6 : 1], int wid) {
#pragma unroll
    for (int i = 0; i < CPR / 4; ++i) {
        const int rc = rowc[(CPR == 24) ? i : 0];
        const int row = (rc >> 8) + ((CPR == 24) ? 0 : i * (256 / CPR));
        __builtin_amdgcn_global_load_lds((const unsigned*)src(row, rc & 255), (LDSP unsigned*)(dst + (256 * i + 64 * wid) * 16), 16, 0, 0);
    }
}
__device__ __forceinline__ int wq_next(int* ctr, LDSP int* slot, int tid) {
    __syncthreads();
    if (tid == 0) *slot = atomicAdd(ctr, 1);
    __syncthreads();
    return *slot;
}

__device__ __forceinline__ void build_lut(LDSP float* tab, const float* blut_h, int n, int wlimit, int tid) {
    for (int i = tid; i < n; i += 256) { const int d = i - 64; tab[i] = (d < 0 || d >= wlimit) ? ATT_NEG : blut_h[d > 1023 ? 1023 : d] * LOG2E + ATT_SHIFT; }
}
#define ATT_BAR() do { __builtin_amdgcn_s_barrier(); asm volatile("" ::: "memory"); } while (0)

__device__ __forceinline__ void mla_item(const P& p, const int item, LDSP char* lds, const int tid0) {
    LDSP char* kb = lds; LDSP char* vb = lds + 24576; LDSP float* lut = (LDSP float*)(lds + 40960);
    const float c1 = 0.07216878364870322f * LOG2E;
    int tid = tid0; asm volatile("" : "+v"(tid));
    const int wid = tid >> 6, lane = tid & 63, q = lane & 31, hh = lane >> 5;
    AttLane L; att_lane_init<384, 256, 4>(L, lane);
    int krc[6], vrc[1];
    att_stage_map<24>(krc, tid); att_stage_map<16>(vrc, tid);
    int qt, bh, part;
    if (item >= 640) { const int r = item - 640; qt = 15 - (r >> 3); bh = r & 7; part = 0; }
    else {
        int g = 0; while (16 * (g + 1) + 8 * ((g + 2) >> 1) <= item) ++g;
        const int r = item - (16 * g + 8 * ((g + 1) >> 1)), Ln = 64 - g;
        if (r < 16) { qt = Ln - 1; bh = r & 7; part = 1 + (r >> 3); } else { qt = (Ln >> 1) - 1; bh = (r - 16) & 7; part = 0; }
    }
    const int b = bh >> 2, h = bh & 3;
    const int tw = qt * 128 + wid * 32;
    bf16x8 qf[12];
    {
        const bf16_t* qp = p.qmla + (size_t)(b * SEQ + tw + q) * 768 + h * 192 + 8 * hh;
#pragma unroll
        for (int ks = 0; ks < 12; ++ks) qf[ks] = *(const bf16x8*)(qp + 16 * ks);
    }
    f32x16 o[4];
#pragma unroll
    for (int dt = 0; dt < 4; ++dt)
#pragma unroll
        for (int r = 0; r < 16; ++r) o[dt][r] = 0.f;
    float lsum = 0.f;
    const int i0 = (part == 2) ? qt + 1 : 0, ntiles = (part == 1) ? qt + 1 : 2 * qt + 2;
    const bf16_t* kvb = p.kvmla + (size_t)b * SEQ * 1024 + h * 256;
    const bf16_t* krb = p.krope + (size_t)b * SEQ * 64;
    auto ksrc = [&](int pos0) { return [=](int row, int gc) { return gc < 16 ? kvb + (size_t)(pos0 + row) * 1024 + gc * 8 : krb + (size_t)(pos0 + row) * 64 + (gc - 16) * 8; }; };
    auto vsrc = [&](int pos0) { return [=](int row, int gc) { return kvb + (size_t)(pos0 + row) * 1024 + 128 + gc * 8; }; };
    att_stage<24>(kb, ksrc(i0 * 64), krc, wid);
    for (int i = i0; i < ntiles; ++i) {
        const int pos0 = i * 64;
        asm volatile("s_waitcnt vmcnt(0)" ::: "memory"); ATT_BAR();
        att_stage<16>(vb, vsrc(pos0), vrc, wid);
        const bool active = pos0 <= tw + 31, diag = pos0 + 63 > tw;
        bf16x8 pf[4];
        if (active) {
            if (diag) {
                int dq = tw + q - pos0 - 4 * hh; dq = dq < -1 ? -1 : dq;
                att_qk<12, 384, 1, true, false>(kb, L, qf, pf, lsum, c1, 0.f, (unsigned)(size_t)lut + (unsigned)(dq + 1) * 4u, 0, nullptr, 0.f);
            } else att_qk<12, 384, 0, true, false>(kb, L, qf, pf, lsum, c1, ATT_SHIFT, 0u, 0, nullptr, 0.f);
        }
        asm volatile("s_waitcnt vmcnt(0) lgkmcnt(0)" ::: "memory"); ATT_BAR();
        if (i + 1 < ntiles) att_stage<24>(kb, ksrc(pos0 + 64), krc, wid);
        if (active) att_pv<4, 256>(vb, L, pf, o);
    }
    const float lt = lsum + __shfl_xor(lsum, 32);
    int tid2 = tid0; asm volatile("" : "+v"(tid2));
    const int lane2 = tid2 & 63, trow = qt * 128 + (tid2 >> 6) * 32 + (lane2 & 31);
    bf16_t* op; float inv;
    if (part == 0) { inv = 1.0f / lt; op = p.o + (size_t)(b * SEQ + trow) * DM + h * 128 + 4 * (lane2 >> 5); }
    else {
        const size_t rec = (size_t)((part - 1) * 8 + bh) * (SEQ / 2) + (trow - SEQ / 2);
        inv = 1.0f; op = p.mlap + rec * 128 + 4 * (lane2 >> 5);
        if (lane2 < 32) p.mlal[rec] = lt;
    }
#pragma unroll
    for (int dt = 0; dt < 4; ++dt)
#pragma unroll
        for (int rq = 0; rq < 4; ++rq)
            *(u32x2*)(op + 32 * dt + 8 * rq) = (u32x2){cvtpk(o[dt][4 * rq] * inv, o[dt][4 * rq + 1] * inv), cvtpk(o[dt][4 * rq + 2] * inv, o[dt][4 * rq + 3] * inv)};
}
__device__ __forceinline__ void st_mla_combine(const P& p, int wg, int nwg) {
    const int TIDX = otid();
    const int wid = TIDX >> 6, lane = TIDX & 63;
    for (int w = wg * 4 + wid; w < 8 * (SEQ / 2); w += nwg * 4) {
        const int bh = w / (SEQ / 2), t = SEQ / 2 + w % (SEQ / 2), b = bh >> 2, h = bh & 3;
        const size_t r0 = (size_t)w, r1 = (size_t)(8 * (SEQ / 2) + w);
        const float inv = 1.0f / (p.mlal[r0] + p.mlal[r1]);
        const unsigned a = *(const unsigned*)(p.mlap + r0 * 128 + lane * 2), c = *(const unsigned*)(p.mlap + r1 * 128 + lane * 2);
        const float x0 = __uint_as_float(a << 16) + __uint_as_float(c << 16), x1 = __uint_as_float(a & 0xffff0000u) + __uint_as_float(c & 0xffff0000u);
        *(unsigned*)(p.o + (size_t)(b * SEQ + t) * DM + h * 128 + lane * 2) = cvtpk(x0 * inv, x1 * inv);
    }
}

__device__ __forceinline__ void swa_item(const P& p, const int item, LDSP char* lds, const int tid0) {
    LDSP char* kb = lds; LDSP char* vb = lds + 8192; LDSP float* luts = (LDSP float*)(lds + 46080);
    const float c1 = 0.125f * LOG2E;
    int tid = tid0; asm volatile("" : "+v"(tid));
    const int wid = tid >> 6, lane = tid & 63, q = lane & 31, hh = lane >> 5;
    AttLane L; att_lane_init<128, 128, 2>(L, lane);
    int rc[1]; att_stage_map<8>(rc, tid);
    const int b = item >> 9, kvh = (item >> 8) & 1, t0 = (item & 255) * 32, head = kvh * 4 + wid;
    bf16x8 qf[4];
    {
        const bf16_t* qp = p.proj1 + (size_t)(b * SEQ + t0 + q) * 1216 + 448 + head * 64 + 8 * hh;
#pragma unroll
        for (int ks = 0; ks < 4; ++ks) qf[ks] = *(const bf16x8*)(qp + 16 * ks);
    }
    f32x16 o[2];
#pragma unroll
    for (int dt = 0; dt < 2; ++dt)
#pragma unroll
        for (int r = 0; r < 16; ++r) o[dt][r] = 0.f;
    float lsum = 0.f;
    const bf16_t* kbp = p.proj1 + (size_t)b * SEQ * 1216 + 960 + kvh * 64;
    const bf16_t* zr = p.zrow;
    auto ksrc = [&](int pos0) { return [=](int row, int gc) { const int pos = pos0 + row; return (pos >= 0 && pos < SEQ) ? kbp + (size_t)pos * 1216 + gc * 8 : zr + gc * 8; }; };
    auto vsrc = [&](int pos0) { return [=](int row, int gc) { const int pos = pos0 + row; return (pos >= 0 && pos < SEQ) ? kbp + (size_t)pos * 1216 + 128 + gc * 8 : zr + gc * 8; }; };
    const unsigned tab = (unsigned)(size_t)(luts + head * 256);
    att_stage<8>(kb, ksrc(t0 - 128), rc, wid);
    for (int i = 0; i < 3; ++i) {
        const int pos0 = t0 - 128 + 64 * i;
        asm volatile("s_waitcnt vmcnt(0)" ::: "memory"); ATT_BAR();
        att_stage<8>(vb, vsrc(pos0), rc, wid);
        bf16x8 pf[4];
        int dq = t0 + q - pos0 - 4 * hh; dq = dq < -1 ? -1 : dq;
        att_qk<4, 128, 1, true, false>(kb, L, qf, pf, lsum, c1, 0.f, tab + (unsigned)(dq + 1) * 4u, 0, nullptr, 0.f);
        asm volatile("s_waitcnt vmcnt(0) lgkmcnt(0)" ::: "memory"); ATT_BAR();
        if (i + 1 < 3) att_stage<8>(kb, ksrc(pos0 + 64), rc, wid);
        att_pv<2, 128>(vb, L, pf, o);
    }
    const float lt = lsum + __shfl_xor(lsum, 32) + __builtin_amdgcn_exp2f(p.sinks[head] * LOG2E + ATT_SHIFT);
    const float inv = 1.0f / lt;
    bf16_t* op = p.o + (size_t)(b * SEQ + t0 + q) * DM + 512 + head * 64 + 4 * hh;
#pragma unroll
    for (int dt = 0; dt < 2; ++dt)
#pragma unroll
        for (int rq = 0; rq < 4; ++rq)
            *(u32x2*)(op + 32 * dt + 8 * rq) = (u32x2){cvtpk(o[dt][4 * rq] * inv, o[dt][4 * rq + 1] * inv), cvtpk(o[dt][4 * rq + 2] * inv, o[dt][4 * rq + 3] * inv)};
}
__device__ __forceinline__ void moe_conv_item(const P& p, const int layer, const int item, LDSP char* lds, const int tid0) {
    float* sm = (float*)lds;
    const int set = item >> 8, t0 = (item & 255) * 8;
    if (set == 0) conv_batched<1>(p.moe_wg + (size_t)layer * 16 * 1024 * 512, 16, 1024, 512, (size_t)1024 * 512, p.wt_gu + (size_t)layer * 16 * 1024 * 1024, (size_t)1024 * 1024, t0, 1, sm, tid0, t0 + 8);
    else if (set == 1) conv_batched<2>(p.moe_wu + (size_t)layer * 16 * 1024 * 512, 16, 1024, 512, (size_t)1024 * 512, p.wt_gu + (size_t)layer * 16 * 1024 * 1024, (size_t)1024 * 1024, t0, 1, sm, tid0, t0 + 8);
    else conv_batched<0>(p.moe_wd + (size_t)layer * 16 * 512 * 1024, 16, 512, 1024, (size_t)512 * 1024, p.wt_d + (size_t)layer * 16 * 1024 * 512, (size_t)1024 * 512, t0, 1, sm, tid0, t0 + 8);
}
__device__ __forceinline__ void st_attn1(const P& p, LDSP char* lds) {
    const int tid0 = otid();
    LDSP float* lut = (LDSP float*)(lds + 40960); LDSP int* slot = (LDSP int*)(lds + 45568); LDSP float* luts = (LDSP float*)(lds + 46080);
    for (int i = tid0; i < 1152; i += 256) lut[i] = (i < 64) ? ATT_NEG : ATT_SHIFT;
#pragma unroll 1
    for (int h = 0; h < 8; ++h) build_lut(luts + h * 256, p.blut + h * 1024, 256, 128, tid0);
    for (;;) {
        const int item = wq_next(p.wq + 0, slot, tid0);
        if (item >= 768 + 1024 + 768) break;
        if (item < 768) mla_item(p, item, lds, tid0);
        else { const int r = item - 768, g = r / 7, ps = r - g * 7;
               if (ps < 4) swa_item(p, g * 4 + ps, lds, tid0); else moe_conv_item(p, 1, g * 3 + ps - 4, lds, tid0); }
    }
}

#define A0_GLUT 16384
#define A0_WLUT 34816
#define A0_IMP 45056
#define A0_SEL 61568
#define A0_UN 62080
#define A0_LIST 62144
#define A0_SLOT 62720
__device__ __forceinline__ unsigned wmax_u32(unsigned v) {
#pragma unroll
    for (int o = 32; o > 0; o >>= 1) { const unsigned t = (unsigned)__shfl_xor((int)v, o); v = t > v ? t : v; }
    return v;
}
#define ATT_STORE_O(op, o, sc) do { _Pragma("unroll") for (int dt_ = 0; dt_ < 2; ++dt_) _Pragma("unroll") for (int rq_ = 0; rq_ < 4; ++rq_) \
        *(u32x2*)((op) + 32 * dt_ + 8 * rq_) = (u32x2){cvtpk((o)[dt_][4 * rq_] * (sc), (o)[dt_][4 * rq_ + 1] * (sc)), cvtpk((o)[dt_][4 * rq_ + 2] * (sc), (o)[dt_][4 * rq_ + 3] * (sc))}; } while (0)

__device__ __forceinline__ void nsa_item(const P& p, const int item, LDSP char* lds, const int tid0) {
    LDSP char* kb = lds; LDSP char* vb = lds + 8192;
    LDSP float* glut = (LDSP float*)(lds + A0_GLUT); LDSP float* wlut = (LDSP float*)(lds + A0_WLUT); LDSP float* imp = (LDSP float*)(lds + A0_IMP);
    LDSP unsigned* sel = (LDSP unsigned*)(lds + A0_SEL); LDSP unsigned* un = (LDSP unsigned*)(lds + A0_UN); LDSP unsigned short* blist = (LDSP unsigned short*)(lds + A0_LIST);
    const float c1 = 0.125f * LOG2E;
    int tid = tid0; asm volatile("" : "+v"(tid));
    const int wid = tid >> 6, lane = tid & 63, q = lane & 31, hh = lane >> 5;
    const int tile = 255 - (item >> 2), b = (item >> 1) & 1, kvh = item & 1, t0 = tile * 32, blk_t = t0 >> 6, head = kvh * 4 + wid;
#pragma unroll 1
    for (int h = 0; h < 4; ++h) { build_lut(glut + h * 1152, p.blut + (kvh * 4 + h) * 1024, 1152, 1 << 30, tid); build_lut(wlut + h * 640, p.blut + (kvh * 4 + h) * 1024, 640, 512, tid); }
    for (int i = tid; i < 32 * 129; i += 256) imp[i] = 0.f;
    AttLane L; att_lane_init<128, 128, 2>(L, lane);
    int rc[1]; att_stage_map<8>(rc, tid);
    const size_t rowq = (size_t)(b * SEQ + t0 + q);
    bf16x8 qf[4];
    {
        const bf16_t* qp = p.proj + rowq * 2840 + head * 64 + 8 * hh;
#pragma unroll
        for (int ks = 0; ks < 4; ++ks) qf[ks] = *(const bf16x8*)(qp + 16 * ks);
    }
    const float gc = p.gates[rowq * 24 + head * 3 + 0], gs = p.gates[rowq * 24 + head * 3 + 1], gw = p.gates[rowq * 24 + head * 3 + 2];
    const unsigned gtab = (unsigned)(size_t)(glut + wid * 1152), wtab = (unsigned)(size_t)(wlut + wid * 640);
    const bf16_t* zr = p.zrow;
    const bf16_t* pb = p.proj + (size_t)b * SEQ * 2840;
    f32x16 of[2], o[2];
#pragma unroll
    for (int dt = 0; dt < 2; ++dt)
#pragma unroll
        for (int r = 0; r < 16; ++r) { of[dt][r] = 0.f; o[dt][r] = 0.f; }
    bf16x8 pf[4];
    __syncthreads();
    const float cfar = glut[wid * 1152 + 64 + 1023];
    {
        int nvm = (t0 >> 4) + 1; nvm = nvm > 511 ? 511 : nvm;
        const int ntc = (nvm + 63) >> 6;
        const bf16_t* kcb = p.kcmpb + (size_t)((b * 2 + kvh) * 512) * 64;
        const bf16_t* vcb = p.kcmpb + (size_t)((4 + b * 2 + kvh) * 512) * 64;
        auto csrc = [&](const bf16_t* base, int n0) { return [=](int row, int gcx) { const int n = n0 + row; return n < 511 ? base + (size_t)n * 64 + gcx * 8 : zr + gcx * 8; }; };
        float lsum = 0.f;
        for (int nt = 0; nt < ntc; ++nt) {
            att_stage<8>(kb, csrc(kcb, nt * 64), rc, wid);
            asm volatile("s_waitcnt vmcnt(0)" ::: "memory"); ATT_BAR();
            const int dq16 = t0 + q - 31 - 1024 * nt - 64 * hh;
            if (t0 - 31 - 16 * (nt * 64 + 63) >= 1023) att_qk<4, 128, 0, false, false>(kb, L, qf, pf, lsum, c1, cfar, 0u, 0, nullptr, 0.f);
            else att_qk<4, 128, 2, false, false>(kb, L, qf, pf, lsum, c1, 0.f, gtab, dq16, nullptr, 0.f);
            asm volatile("s_waitcnt lgkmcnt(0)" ::: "memory"); ATT_BAR();
        }
        const float lc = lsum + __shfl_xor(lsum, 32);
        const float invl = lc > 0.f ? 1.0f / lc : 0.f;
        float dummy = 0.f;
        for (int nt = 0; nt < ntc; ++nt) {
            att_stage<8>(kb, csrc(kcb, nt * 64), rc, wid);
            att_stage<8>(vb, csrc(vcb, nt * 64), rc, wid);
            asm volatile("s_waitcnt vmcnt(0)" ::: "memory"); ATT_BAR();
            const int dq16 = t0 + q - 31 - 1024 * nt - 64 * hh;
            LDSP float* improw = imp + q * 129 + 16 * nt + hh;
            if (t0 - 31 - 16 * (nt * 64 + 63) >= 1023) att_qk<4, 128, 0, true, true>(kb, L, qf, pf, dummy, c1, cfar, 0u, 0, improw, invl * 524288.0f);
            else att_qk<4, 128, 2, true, true>(kb, L, qf, pf, dummy, c1, 0.f, gtab, dq16, improw, invl * 524288.0f);
            att_pv<2, 128>(vb, L, pf, o);
            asm volatile("s_waitcnt lgkmcnt(0)" ::: "memory"); ATT_BAR();
        }
        const float sc = gc * invl;
#pragma unroll
        for (int dt = 0; dt < 2; ++dt)
#pragma unroll
            for (int r = 0; r < 16; ++r) { of[dt][r] = o[dt][r] * sc; o[dt][r] = 0.f; }
    }
    __syncthreads();
    {
        unsigned u0 = 0u, u1 = 0u, u2 = 0u, u3 = 0u;
        for (int i = 0; i < 8; ++i) {
            const int tok = wid * 8 + i;
            const unsigned v0 = ((LDSP const unsigned*)imp)[tok * 129 + lane], v1 = ((LDSP const unsigned*)imp)[tok * 129 + 64 + lane];
            const int j0 = lane, j1 = lane + 64;
            const bool f0 = (j0 == 0) || (j0 == blk_t) || (j0 == blk_t - 1), f1 = (j1 == blk_t) || (j1 == blk_t - 1);
            unsigned k0 = f0 ? (0xFFFFFF80u | (unsigned)(127 - j0)) : (j0 <= blk_t ? ((v0 << 7) | (unsigned)(127 - j0)) : 0u);
            unsigned k1 = f1 ? (0xFFFFFF80u | (unsigned)(127 - j1)) : (j1 <= blk_t ? ((v1 << 7) | (unsigned)(127 - j1)) : 0u);
            unsigned thr = 0u;
#pragma unroll 1
            for (int bit = 31; bit >= 0; --bit) {
                const unsigned cand = thr | (1u << bit);
                const int c = __popcll(__ballot(k0 >= cand)) + __popcll(__ballot(k1 >= cand));
                thr = (c >= 16) ? cand : thr;
            }
            thr = thr ? thr : 1u;
            const unsigned long long b0 = __ballot(k0 >= thr), b1 = __ballot(k1 >= thr);
            const unsigned m0 = (unsigned)b0, m1 = (unsigned)(b0 >> 32), m2 = (unsigned)b1, m3 = (unsigned)(b1 >> 32);
            if (lane == 0) { sel[tok * 4 + 0] = m0; sel[tok * 4 + 1] = m1; sel[tok * 4 + 2] = m2; sel[tok * 4 + 3] = m3; }
            u0 |= m0; u1 |= m1; u2 |= m2; u3 |= m3;
        }
        if (lane == 0) { un[wid * 4 + 0] = u0; un[wid * 4 + 1] = u1; un[wid * 4 + 2] = u2; un[wid * 4 + 3] = u3; }
    }
    __syncthreads();
    {
        unsigned uw[4];
#pragma unroll
        for (int k = 0; k < 4; ++k) uw[k] = (unsigned)__builtin_amdgcn_readfirstlane((int)(un[k] | un[4 + k] | un[8 + k] | un[12 + k]));
        if (tid < 128) {
            const int k = tid >> 5, jb = tid & 31;
            unsigned wv = 0u; int below = 0;
#pragma unroll
            for (int kk = 0; kk < 4; ++kk) { if (kk == k) wv = uw[kk]; if (kk < k) below += __popc(uw[kk]); }
            if ((wv >> jb) & 1u) blist[below + __popc(wv & ((1u << jb) - 1u))] = (unsigned short)tid;
        }
        const int nb = __popc(uw[0]) + __popc(uw[1]) + __popc(uw[2]) + __popc(uw[3]);
        unsigned sq[4];
#pragma unroll
        for (int k = 0; k < 4; ++k) sq[k] = sel[q * 4 + k];
        __syncthreads();
        const bf16_t* ksb = pb + 768 + kvh * 64;
        auto ssrc = [&](int pos0, int colo) { return [=](int row, int gcx) { return ksb + (size_t)(pos0 + row) * 2840 + colo + gcx * 8; }; };
        float lsum = 0.f;
        att_stage<8>(kb, ssrc(64 * (int)blist[0], 0), rc, wid);
        for (int i = 0; i < nb; ++i) {
            const int j = __builtin_amdgcn_readfirstlane((int)blist[i]), pos0 = 64 * j;
            asm volatile("s_waitcnt vmcnt(0)" ::: "memory"); ATT_BAR();
            att_stage<8>(vb, ssrc(pos0, 128), rc, wid);
            unsigned sw = 0u;
#pragma unroll
            for (int k = 0; k < 4; ++k) if ((j >> 5) == k) sw = sq[k];
            const bool selq = (sw >> (j & 31)) & 1u;
            if (t0 - (pos0 + 63) >= 1023) att_qk<4, 128, 0, true, false>(kb, L, qf, pf, lsum, c1, selq ? cfar : ATT_NEG, 0u, 0, nullptr, 0.f);
            else {
                int dq = t0 + q - pos0 - 4 * hh; dq = dq > 1087 ? 1087 : dq; dq = (dq < -1 || !selq) ? -1 : dq;
                att_qk<4, 128, 1, true, false>(kb, L, qf, pf, lsum, c1, 0.f, gtab + (unsigned)(dq + 1) * 4u, 0, nullptr, 0.f);
            }
            asm volatile("s_waitcnt vmcnt(0) lgkmcnt(0)" ::: "memory"); ATT_BAR();
            if (i + 1 < nb) att_stage<8>(kb, ssrc(64 * (int)blist[i + 1], 0), rc, wid);
            att_pv<2, 128>(vb, L, pf, o);
        }
        const float ls = lsum + __shfl_xor(lsum, 32);
        const float sc = gs / ls;
#pragma unroll
        for (int dt = 0; dt < 2; ++dt)
#pragma unroll
            for (int r = 0; r < 16; ++r) { of[dt][r] += o[dt][r] * sc; o[dt][r] = 0.f; }
    }
    {
        const bf16_t* kwb = pb + 1024 + kvh * 64;
        auto wsrc = [&](int pos0, int colo) { return [=](int row, int gcx) { const int pos = pos0 + row; return (pos >= 0 && pos < SEQ) ? kwb + (size_t)pos * 2840 + colo + gcx * 8 : zr + gcx * 8; }; };
        float lsum = 0.f;
        asm volatile("s_waitcnt lgkmcnt(0)" ::: "memory"); ATT_BAR();
        att_stage<8>(kb, wsrc(t0 - 512, 0), rc, wid);
        for (int i = 0; i < 9; ++i) {
            const int pos0 = t0 - 512 + 64 * i;
            asm volatile("s_waitcnt vmcnt(0)" ::: "memory"); ATT_BAR();
            att_stage<8>(vb, wsrc(pos0, 128), rc, wid);
            int dq = t0 + q - pos0 - 4 * hh; dq = dq < -1 ? -1 : dq;
            att_qk<4, 128, 1, true, false>(kb, L, qf, pf, lsum, c1, 0.f, wtab + (unsigned)(dq + 1) * 4u, 0, nullptr, 0.f);
            asm volatile("s_waitcnt vmcnt(0) lgkmcnt(0)" ::: "memory"); ATT_BAR();
            if (i + 1 < 9) att_stage<8>(kb, wsrc(pos0 + 64, 0), rc, wid);
            att_pv<2, 128>(vb, L, pf, o);
        }
        const float lw = lsum + __shfl_xor(lsum, 32);
        const float sc = gw / lw;
#pragma unroll
        for (int dt = 0; dt < 2; ++dt)
#pragma unroll
            for (int r = 0; r < 16; ++r) of[dt][r] += o[dt][r] * sc;
    }
    bf16_t* op = p.o + rowq * DM + head * 64 + 4 * hh;
    ATT_STORE_O(op, of, 1.0f);
}

#define MG_CNT 8192
#define MG_BASE 8320
#define MG_ENT 8448
__device__ __forceinline__ void st_moba_gate(const P& p, int wg, int nwg, LDSP char* lds) {
    const int tid = otid();
    const int wid = tid >> 6, lane = tid & 63, q = lane & 31, hh = lane >> 5;
    LDSP char* kmt = lds; LDSP int* lcnt = (LDSP int*)(lds + MG_CNT); LDSP int* lbase = (LDSP int*)(lds + MG_BASE); LDSP int* ent = (LDSP int*)(lds + MG_ENT);
    AttLane L; att_lane_init<128, 128, 2>(L, lane);
    int rc[1]; att_stage_map<8>(rc, tid);
    const bf16_t* zr = p.zrow;
    for (int item = wg; item < 1024; item += nwg) {
        const int tile = item >> 4, b = (item >> 3) & 1, h = item & 7, t0 = tile * 128, own = t0 >> 8, tw = t0 + wid * 32, bh = b * 8 + h;
        if (own == 0) continue;
        __syncthreads();
        if (tid < 32) lcnt[tid] = 0;
        bf16x8 qf[4];
        {
            const bf16_t* qp = p.proj + (size_t)(b * SEQ + tw + q) * 2840 + 1304 + h * 64 + 8 * hh;
#pragma unroll
            for (int ks = 0; ks < 4; ++ks) qf[ks] = *(const bf16x8*)(qp + 16 * ks);
        }
        const bf16_t* kmb = p.kmeanb + (size_t)(bh * 32) * 64;
        att_stage<8>(kmt, [=](int row, int gcx) { return row < 32 ? kmb + (size_t)row * 64 + gcx * 8 : zr + gcx * 8; }, rc, wid);
        asm volatile("s_waitcnt vmcnt(0)" ::: "memory");
        __syncthreads();
        f32x16 s;
#pragma unroll
        for (int r = 0; r < 16; ++r) s[r] = 0.f;
#pragma unroll
        for (int ks = 0; ks < 4; ++ks) {
            const bf16x8 a = *(const LDSP bf16x8*)(kmt + (L.kbase ^ (32 * (ks & 3))));
            s = __builtin_amdgcn_mfma_f32_32x32x16_bf16(a, qf[ks], s, 0, 0, 0);
        }
        unsigned key[16];
#pragma unroll
        for (int r = 0; r < 16; ++r) {
            const int j = (r & 3) + 8 * (r >> 2) + 4 * hh;
            const unsigned bits = __float_as_uint(s[r]);
            const unsigned srt = (bits & 0x80000000u) ? ~bits : (bits | 0x80000000u);
            key[r] = (j < own) ? ((srt & ~31u) | (unsigned)(31 - j)) : 0u;
        }
        unsigned selm = 0u;
#pragma unroll 1
        for (int rnd = 0; rnd < 3; ++rnd) {
            unsigned m = 0u;
#pragma unroll
            for (int r = 0; r < 16; ++r) m = key[r] > m ? key[r] : m;
            const unsigned mo = (unsigned)__shfl_xor((int)m, 32);
            const unsigned wk = mo > m ? mo : m;
            if (wk != 0u) selm |= 1u << (31 - (wk & 31u));
#pragma unroll
            for (int r = 0; r < 16; ++r) key[r] = (key[r] == wk) ? 0u : key[r];
        }
        if (hh == 0) {
            unsigned mm = selm;
#pragma unroll
            for (int sI = 0; sI < 3; ++sI) {
                int en = -1;
                if (mm) { const int j = __builtin_ctz(mm); mm &= mm - 1u; const int lp = __hip_atomic_fetch_add(lcnt + j, 1, __ATOMIC_RELAXED, __HIP_MEMORY_SCOPE_WORKGROUP); en = (j << 8) | lp; }
                ent[(wid * 32 + q) * 3 + sI] = en;
            }
        }
        __syncthreads();
        if (tid < 32) { const int c = lcnt[tid]; lbase[tid] = c ? atomicAdd(p.mcnt + bh * 32 + tid, c) : 0; }
        __syncthreads();
        for (int e = tid; e < 384; e += 256) {
            const int en = ent[e];
            if (en >= 0) { const int j = en >> 8, tokl = e / 3, sI = e - tokl * 3; p.mlist[(size_t)(bh * 32 + j) * 8192 + lbase[j] + (en & 255)] = (unsigned short)((t0 + tokl) | (sI << 13)); }
        }
    }
}
__device__ __forceinline__ bf16_t* moba_part(const P& p, int slot, size_t row) { return (slot < 2 ? p.mp01 + (size_t)slot * 131072 * 64 : p.mp2) + row * 64; }

__device__ __forceinline__ void moba_inv_item(const P& p, const int lid, const int chunk, LDSP char* lds, const int tid0) {
    LDSP char* kb = lds; LDSP char* vb = lds + 8192; LDSP float* glut = (LDSP float*)(lds + A0_GLUT);
    const float c1 = 0.125f * LOG2E;
    int tid = tid0; asm volatile("" : "+v"(tid));
    const int wid = tid >> 6, lane = tid & 63, q = lane & 31, hh = lane >> 5;
    const int bh = lid / 31, j = lid - bh * 31, b = bh >> 3, h = bh & 7;
    build_lut(glut, p.blut + h * 1024, 1152, 1 << 30, tid);
    AttLane L; att_lane_init<128, 128, 2>(L, lane);
    int rc[1]; att_stage_map<8>(rc, tid);
    const int n = p.mcnt[bh * 32 + j], idx = chunk * 128 + wid * 32 + q;
    const bool valid = idx < n;
    const unsigned en = valid ? (unsigned)p.mlist[(size_t)(bh * 32 + j) * 8192 + idx] : (unsigned)(256 * (j + 1));
    const int tok = (int)(en & 8191u), slot = (int)(en >> 13);
    bf16x8 qf[4];
    {
        const bf16_t* qp = p.proj + (size_t)(b * SEQ + tok) * 2840 + 1304 + h * 64 + 8 * hh;
#pragma unroll
        for (int ks = 0; ks < 4; ++ks) qf[ks] = *(const bf16x8*)(qp + 16 * ks);
    }
    const unsigned gtab = (unsigned)(size_t)glut;
    const bf16_t* kbb = p.proj + (size_t)b * SEQ * 2840 + 1816 + h * 64;
    auto msrc = [&](int pos0, int colo) { return [=](int row, int gcx) { return kbb + (size_t)(pos0 + row) * 2840 + colo + gcx * 8; }; };
    f32x16 o[2];
#pragma unroll
    for (int dt = 0; dt < 2; ++dt)
#pragma unroll
        for (int r = 0; r < 16; ++r) o[dt][r] = 0.f;
    float lsum = 0.f;
    bf16x8 pf[4];
    __syncthreads();
    att_stage<8>(kb, msrc(256 * j, 0), rc, wid);
    for (int i = 0; i < 4; ++i) {
        const int pos0 = 256 * j + 64 * i;
        asm volatile("s_waitcnt vmcnt(0)" ::: "memory"); ATT_BAR();
        att_stage<8>(vb, msrc(pos0, 512), rc, wid);
        {
            int dq = tok - pos0 - 4 * hh; dq = dq > 1087 ? 1087 : dq; dq = valid ? dq : -1;
            att_qk<4, 128, 1, true, false>(kb, L, qf, pf, lsum, c1, 0.f, gtab + (unsigned)(dq + 1) * 4u, 0, nullptr, 0.f);
        }
        asm volatile("s_waitcnt vmcnt(0) lgkmcnt(0)" ::: "memory"); ATT_BAR();
        if (i + 1 < 4) att_stage<8>(kb, msrc(pos0 + 64, 0), rc, wid);
        att_pv<2, 128>(vb, L, pf, o);
    }
    const float lt = lsum + __shfl_xor(lsum, 32);
    if (valid) {
        const size_t row = (size_t)bh * SEQ + tok;
        bf16_t* op = moba_part(p, slot, row) + 4 * hh;
        ATT_STORE_O(op, o, 1.0f);
        if (hh == 0) p.mpl[(size_t)slot * 131072 + row] = lt;
    }
}
__device__ __forceinline__ void moba_own_item(const P& p, const int item, LDSP char* lds, const int tid0) {
    LDSP char* kb = lds; LDSP char* vb = lds + 8192; LDSP float* glut = (LDSP float*)(lds + A0_GLUT);
    const float c1 = 0.125f * LOG2E;
    int tid = tid0; asm volatile("" : "+v"(tid));
    const int wid = tid >> 6, lane = tid & 63, q = lane & 31, hh = lane >> 5;
    const int tile = item >> 4, b = (item >> 3) & 1, h = item & 7, t0 = tile * 128, own = t0 >> 8, tw = t0 + wid * 32, bh = b * 8 + h;
    __syncthreads();
    build_lut(glut, p.blut + h * 1024, 1152, 1 << 30, tid);
    AttLane L; att_lane_init<128, 128, 2>(L, lane);
    int rc[1]; att_stage_map<8>(rc, tid);
    const size_t rowq = (size_t)(b * SEQ + tw + q);
    bf16x8 qf[4];
    {
        const bf16_t* qp = p.proj + rowq * 2840 + 1304 + h * 64 + 8 * hh;
#pragma unroll
        for (int ks = 0; ks < 4; ++ks) qf[ks] = *(const bf16x8*)(qp + 16 * ks);
    }
    const unsigned gtab = (unsigned)(size_t)glut;
    const bf16_t* kbb = p.proj + (size_t)b * SEQ * 2840 + 1816 + h * 64;
    auto msrc = [&](int pos0, int colo) { return [=](int row, int gcx) { return kbb + (size_t)(pos0 + row) * 2840 + colo + gcx * 8; }; };
    f32x16 o[2];
#pragma unroll
    for (int dt = 0; dt < 2; ++dt)
#pragma unroll
        for (int r = 0; r < 16; ++r) o[dt][r] = 0.f;
    float lsum = 0.f;
    bf16x8 pf[4];
    const int nb = (((t0 + 127) >> 6) & 3) + 1;
    __syncthreads();
    att_stage<8>(kb, msrc(256 * own, 0), rc, wid);
    for (int i = 0; i < nb; ++i) {
        const int pos0 = 256 * own + 64 * i;
        asm volatile("s_waitcnt vmcnt(0)" ::: "memory"); ATT_BAR();
        att_stage<8>(vb, msrc(pos0, 512), rc, wid);
        const bool active = pos0 <= tw + 31;
        if (active) {
            int dq = tw + q - pos0 - 4 * hh; dq = dq < -1 ? -1 : dq;
            att_qk<4, 128, 1, true, false>(kb, L, qf, pf, lsum, c1, 0.f, gtab + (unsigned)(dq + 1) * 4u, 0, nullptr, 0.f);
        }
        asm volatile("s_waitcnt vmcnt(0) lgkmcnt(0)" ::: "memory"); ATT_BAR();
        if (i + 1 < nb) att_stage<8>(kb, msrc(pos0 + 64, 0), rc, wid);
        if (active) att_pv<2, 128>(vb, L, pf, o);
    }
    float lt = lsum + __shfl_xor(lsum, 32);
    const int npick = own < 3 ? own : 3;
    const size_t row = (size_t)bh * SEQ + tw + q;
#pragma unroll 1
    for (int sI = 0; sI < npick; ++sI) {
        lt += p.mpl[(size_t)sI * 131072 + row];
        const bf16_t* pp = moba_part(p, sI, row) + 4 * hh;
#pragma unroll
        for (int dt = 0; dt < 2; ++dt)
#pragma unroll
            for (int rq = 0; rq < 4; ++rq) {
                const u32x2 w = *(const u32x2*)(pp + 32 * dt + 8 * rq);
                o[dt][4 * rq] += __uint_as_float(w[0] << 16); o[dt][4 * rq + 1] += __uint_as_float(w[0] & 0xffff0000u);
                o[dt][4 * rq + 2] += __uint_as_float(w[1] << 16); o[dt][4 * rq + 3] += __uint_as_float(w[1] & 0xffff0000u);
            }
    }
    const float inv = 1.0f / lt;
    bf16_t* op = p.o + rowq * DM + 512 + h * 64 + 4 * hh;
    ATT_STORE_O(op, o, inv);
}
__device__ __forceinline__ void st_moba_own(const P& p, int wg, int nwg, LDSP char* lds) {
    const int tid0 = otid();
    for (int item = wg; item < 1024; item += nwg) moba_own_item(p, item, lds, tid0);
}
#define A0_PRE 62736
__device__ __forceinline__ void st_attn0(const P& p, LDSP char* lds) {
    const int tid0 = otid();
    LDSP int* slot = (LDSP int*)(lds + A0_SLOT); LDSP int* pre = (LDSP int*)(lds + A0_PRE);
    LDSP int* tmp = (LDSP int*)lds;
    for (int i = tid0; i < 496; i += 256) { const int bh = i / 31, j = i - bh * 31; tmp[i] = (p.mcnt[bh * 32 + j] + 127) >> 7; }
    __syncthreads();
    for (int i = tid0; i < 497; i += 256) { int s = 0; for (int k = 0; k < i; ++k) s += tmp[k]; pre[i] = s; }
    __syncthreads();
    const int ninv = pre[496];
    for (;;) {
        const int item = wq_next(p.wq + 1, slot, tid0);
        const int ntail = 5 * 768 + (ninv > 3072 ? ninv - 3072 : 0);
        if (item >= 1024 + ntail) break;
        if (item < 1024) nsa_item(p, item, lds, tid0);
        else {
            const int r = item - 1024, g = r / 5, ps = r - g * 5;
            if (g < 768 && ps == 4) { moe_conv_item(p, 0, g, lds, tid0); continue; }
            const int idx = (g < 768) ? g * 4 + ps : 3072 + (r - 5 * 768);
            if (idx >= ninv) continue;
            int lo = 0, hi = 495;
            while (lo < hi) { const int mid = (lo + hi + 1) >> 1; if (pre[mid] <= idx) lo = mid; else hi = mid - 1; }
            moba_inv_item(p, lo, idx - pre[lo], lds, tid0);
        }
    }
}

#define XB_TMO      128
#define XB_XCNT(j)  (256  + 64 * (j))
#define XB_XSUB(j)  (1280 + 64 * (j))
#define XB_XGEN(j)  (2304 + 64 * (j))
#define XB_TOP      3328
#define XB_TOPGEN   3392
#define XCD_BAR_WORDS 3456
#define XB_SPIN_CAP (1u << 20)
#define LAS __attribute__((address_space(3)))

__device__ __forceinline__ unsigned xb_ld(unsigned* p)              { return __hip_atomic_load(p, __ATOMIC_RELAXED, __HIP_MEMORY_SCOPE_AGENT); }
__device__ __forceinline__ unsigned xb_add(unsigned* p, unsigned v) { return __hip_atomic_fetch_add(p, v, __ATOMIC_RELAXED, __HIP_MEMORY_SCOPE_AGENT); }
__device__ __forceinline__ unsigned xb_xcc_id() { return (unsigned)__builtin_amdgcn_s_getreg((3 << 11) | 20) & 0xFu; }
#define XB_SPIN(cond, bar) do { unsigned _sp = 0; while (cond) { __builtin_amdgcn_s_sleep(1); \
    if ((++_sp & 255u) == 0u) { if (xb_ld(&(bar)[XB_TMO])) break; if (_sp > XB_SPIN_CAP) { atomicAdd(&(bar)[XB_TMO], 1u); break; } } } } while (0)

struct XcdBarrier {
    unsigned* bar; unsigned x;
    volatile LAS unsigned* st;
};

__device__ __forceinline__ XcdBarrier xcd_barrier_post(unsigned* bar, volatile LAS unsigned* st) {
    XcdBarrier b; b.bar = bar; b.x = xb_xcc_id(); b.st = st;
    if (threadIdx.x == 0) (void)xb_add(&bar[XB_XCNT(b.x)], 1u);
    return b;
}
__device__ __forceinline__ void xcd_barrier_complete(unsigned* bar, unsigned x, unsigned& nloc, unsigned& nx) {
    const unsigned G = gridDim.x * gridDim.y * gridDim.z;
    unsigned sum, cnt, mine, sp = 0u;
    for (;;) {
        sum = 0u; cnt = 0u; mine = 0u;
#pragma unroll
        for (unsigned j = 0; j < 16; ++j) { const unsigned c = xb_ld(&bar[XB_XCNT(j)]); sum += c; cnt += (c > 0u) ? 1u : 0u; mine = (j == x) ? c : mine; }
        if (sum == G) break;
        __builtin_amdgcn_s_sleep(1);
        if ((++sp & 255u) == 0u) { if (xb_ld(&bar[XB_TMO])) break; if (sp > XB_SPIN_CAP) { atomicAdd(&bar[XB_TMO], 1u); break; } }
    }
    nloc = mine > 0u ? mine : 1u; nx = cnt > 0u ? cnt : 1u;
}

__device__ __forceinline__ void xcd_barrier(const XcdBarrier& b) {
    asm volatile("s_waitcnt vmcnt(0)" ::: "memory");
    __syncthreads();
    if (threadIdx.x == 0) {
        unsigned* bar = b.bar;
        __builtin_amdgcn_s_waitcnt(0);
        unsigned nloc = b.st[0], nx = b.st[1];
        if (nloc == 0u) { xcd_barrier_complete(bar, b.x, nloc, nx); b.st[0] = nloc; b.st[1] = nx; }
        const unsigned old = xb_add(&bar[XB_XSUB(b.x)], 1u);
        const unsigned gen = old / nloc;
        if (old + 1u == (gen + 1u) * nloc) {
            __builtin_amdgcn_fence(__ATOMIC_RELEASE, "agent");
            asm volatile("s_waitcnt vmcnt(0)" ::: "memory");
            const unsigned og = xb_add(&bar[XB_TOP], 1u);
            const unsigned tg = og / nx;
            if (og + 1u == (tg + 1u) * nx) xb_add(&bar[XB_TOPGEN], 1u);
            else XB_SPIN(xb_ld(&bar[XB_TOPGEN]) == tg, bar);
            __builtin_amdgcn_fence(__ATOMIC_ACQUIRE, "agent");
            xb_add(&bar[XB_XGEN(b.x)], 1u);
            asm volatile("s_waitcnt vmcnt(0)" ::: "memory");
        } else {
            XB_SPIN(xb_ld(&bar[XB_XGEN(b.x)]) == gen, bar);
            __builtin_amdgcn_fence(__ATOMIC_ACQUIRE, "agent");
            asm volatile("s_waitcnt vmcnt(0)" ::: "memory");
        }
    }
    __syncthreads();
}


#define PHASE_SYNC() do { PP qb_ = (PP)__builtin_amdgcn_kernarg_segment_ptr(); asm volatile("" : "+s"(qb_)); XcdBarrier b_; b_.bar = qb_->bar; b_.x = xb_xcc_id(); \
        b_.st = (volatile LAS unsigned*)(dlds + BAR_LDS_OFF); xcd_barrier(b_); } while (0)
typedef const __attribute__((address_space(4))) P* PP;
#define BAR_SAVE() const unsigned bs0_ = __builtin_amdgcn_readfirstlane(*(volatile LAS unsigned*)(dlds + BAR_LDS_OFF)), \
        bs1_ = __builtin_amdgcn_readfirstlane(*(volatile LAS unsigned*)(dlds + BAR_LDS_OFF + 4)); __syncthreads()
#define BAR_RESTORE() do { __syncthreads(); if (threadIdx.x == 0) { *(volatile LAS unsigned*)(dlds + BAR_LDS_OFF) = bs0_; *(volatile LAS unsigned*)(dlds + BAR_LDS_OFF + 4) = bs1_; } } while (0)
#define PHASE_ARGS() PP q_ = (PP)__builtin_amdgcn_kernarg_segment_ptr(); int wg = blockIdx.x, nwg = gridDim.x; asm volatile("" : "+s"(q_), "+s"(wg), "+s"(nwg)); P p; { const __attribute__((address_space(4))) unsigned long long* s64_ = (const __attribute__((address_space(4))) unsigned long long*)q_; void** d64_ = (void**)&p; _Pragma("unroll") for (int i_ = 0; i_ < (int)(sizeof(P) / 8); ++i_) d64_[i_] = (void*)(__attribute__((address_space(1))) void*)s64_[i_]; } float* sm = (float*)dlds; LDSP char* lds = (LDSP char*)dlds; (void)sm; (void)lds
__global__ void __launch_bounds__(256, 2) k_mega(P pk) {
    extern __shared__ __attribute__((aligned(16))) unsigned char dlds[];
    if (threadIdx.x == 0) *(uint4*)(dlds + BAR_LDS_OFF) = make_uint4(0u, 0u, 0u, 0u);
    __syncthreads();
    (void)xcd_barrier_post(pk.bar, (volatile LAS unsigned*)(dlds + BAR_LDS_OFF));
    { PHASE_ARGS(); st_prologue(p, wg, nwg, sm); st_convert(p, wg, nwg, sm); } PHASE_SYNC();
    { PHASE_ARGS(); st_norm<0>(p, 0, wg, nwg, sm); st_c1_reduce(p, wg, nwg); } PHASE_SYNC();
    { PHASE_ARGS(); BAR_SAVE(); st_inproj0_mf<6>(p, wg, nwg, lds); BAR_RESTORE(); } PHASE_SYNC();
    { PHASE_ARGS(); st_cmp1_mf(p, wg, nwg, lds); st_kmean(p, wg, nwg, sm); } PHASE_SYNC();
    { PHASE_ARGS(); st_cmp2_mf(p, wg, nwg, lds); st_moba_gate(p, wg, nwg, lds); } PHASE_SYNC();
    { PHASE_ARGS(); st_attn0(p, lds); } PHASE_SYNC();
    { PHASE_ARGS(); st_moba_own(p, wg, nwg, lds); } PHASE_SYNC();
    { PHASE_ARGS(); st_outproj_mf<4>(p, 0, wg, nwg, lds); } PHASE_SYNC();
    { PHASE_ARGS(); st_norm<1>(p, 0, wg, nwg, sm); } PHASE_SYNC();
    { PHASE_ARGS(); BAR_SAVE(); st_moe_up_mf<6>(p, 0, wg, nwg, lds); BAR_RESTORE(); } PHASE_SYNC();
    { PHASE_ARGS(); BAR_SAVE(); st_moe_down_mf<6>(p, 0, wg, nwg, lds); BAR_RESTORE(); } PHASE_SYNC();
    { PHASE_ARGS(); st_norm<2>(p, 1, wg, nwg, sm); } PHASE_SYNC();
    { PHASE_ARGS(); BAR_SAVE(); st_inproj1_mf<6>(p, wg, nwg, lds); BAR_RESTORE(); } PHASE_SYNC();
    { PHASE_ARGS(); st_mla_prep(p, wg, nwg); } PHASE_SYNC();
    { PHASE_ARGS(); st_mla_up_mf(p, wg, nwg, lds); } PHASE_SYNC();
    { PHASE_ARGS(); st_attn1(p, lds); } PHASE_SYNC();
    { PHASE_ARGS(); st_mla_combine(p, wg, nwg); } PHASE_SYNC();
    { PHASE_ARGS(); st_outproj_mf<4>(p, 1, wg, nwg, lds); } PHASE_SYNC();
    { PHASE_ARGS(); st_norm<1>(p, 1, wg, nwg, sm); } PHASE_SYNC();
    { PHASE_ARGS(); BAR_SAVE(); st_moe_up_mf<6>(p, 1, wg, nwg, lds); BAR_RESTORE(); } PHASE_SYNC();
    { PHASE_ARGS(); BAR_SAVE(); st_moe_down_mf<6>(p, 1, wg, nwg, lds); BAR_RESTORE(); } PHASE_SYNC();
    { PHASE_ARGS(); st_norm<3>(p, 1, wg, nwg, sm); }
}

extern "C" void kernel_launch(void* const* d_in, const int* in_sizes, int n_in, void* d_out, int out_size, void* d_ws, size_t ws_size,
                              hipStream_t stream) {
    (void)in_sizes; (void)n_in; (void)out_size; (void)ws_size;
    P p{};
    const float* const* in = (const float* const*)d_in;
    p.x = in[0]; p.c = in[1]; p.rel = in[2]; p.router_w = in[3]; p.router_b = in[4]; p.final_norm = in[5]; p.norm_mix = in[6]; p.norm_ffn = in[7];
    p.ada_w = in[8]; p.ada_b = in[9]; p.moe_wg = in[10]; p.moe_wu = in[11]; p.moe_wd = in[12]; p.ev_w_in = in[13]; p.ev_w_out = in[14];
    p.pos_k = in[15]; p.pos_v = in[16]; p.ck_w1 = in[17]; p.ck_w2 = in[18]; p.cv_w1 = in[19]; p.cv_w2 = in[20]; p.od_w_in = in[21]; p.od_w_out = in[22];
    p.q_norm = in[23]; p.kv_norm = in[24]; p.w_q_up = in[25]; p.w_kv_up = in[26]; p.sinks = in[27];
    p.out = (float*)d_out;
    char* ws = (char*)d_ws; size_t off = 0;
    auto take = [&](size_t bytes) { char* r = ws + off; off += (bytes + 255) & ~(size_t)255; return r; };
    p.bar = (unsigned*)take(16384);
    p.cnt = (int*)take(4096);
    p.wq = (int*)take(256);
    p.mcnt = (int*)take(512 * 4);
    p.modv = (float*)take(2 * 2 * 6144 * 4);
    p.zrow = (bf16_t*)take(256);
    const size_t zero_bytes = off;
    p.ropec = (float*)take(SEQ * 32 * 4); p.ropes = (float*)take(SEQ * 32 * 4);
    p.blut = (float*)take(8 * 1024 * 4);
    p.gates = (float*)take((size_t)T_TOK * 24 * 4);
    p.kmean = (float*)take(2 * 8 * 32 * 64 * 4);
    p.tokw = (float*)take((size_t)T_TOK * 2 * 4);
    p.list = (int*)take((size_t)16 * T_TOK * 4);
    p.cqn = (bf16_t*)take((size_t)T_TOK * 384 * 2);
    p.krope = (bf16_t*)take((size_t)T_TOK * 64 * 2);
    p.h = (bf16_t*)take((size_t)T_TOK * DM * 2);
    p.o = (bf16_t*)take((size_t)T_TOK * DM * 2);
    p.mlap = p.h;
    p.mlal = (float*)(p.h + (size_t)2 * 8 * (SEQ / 2) * 128);
    p.mp01 = p.h;
    p.mp2 = (bf16_t*)take((size_t)131072 * 64 * 2);
    p.mpl = (float*)take((size_t)3 * 131072 * 4);
    p.mlist = (unsigned short*)take((size_t)16 * 32 * 8192 * 2);
    p.hid = p.o;
    char* region = take((size_t)100 * 1024 * 1024);
    p.proj = (bf16_t*)region;
    p.proj1 = (bf16_t*)region;
    p.qmla = (bf16_t*)(region + (size_t)T_TOK * 1216 * 2);
    p.kvmla = (bf16_t*)(region + (size_t)T_TOK * (1216 + 768) * 2);
    p.y = (bf16_t*)region;
    p.chidb = (bf16_t*)take((size_t)2 * 2048 * 256 * 2);
    p.kcmpb = (bf16_t*)take((size_t)8 * 512 * 64 * 2);
    p.kmeanb = (bf16_t*)take((size_t)2 * 8 * 32 * 64 * 2);
    p.c1 = (float*)take(512 * 4);
    p.c1p = (float*)take((size_t)2 * 64 * 256 * 4);
    p.wt_gu = (bf16_t*)take((size_t)32 * 1024 * 1024 * 2);
    p.wt_d = (bf16_t*)take((size_t)32 * 1024 * 512 * 2);
    p.wt_in0 = (bf16_t*)take((size_t)2840 * 1024 * 2);
    p.wt_out0 = (bf16_t*)take((size_t)1024 * 1024 * 2);
    p.wt_c1 = (bf16_t*)take((size_t)2 * 256 * 2048 * 2);
    p.wt_c2 = (bf16_t*)take((size_t)2 * 64 * 256 * 2);
    p.wt_in1 = (bf16_t*)take((size_t)1216 * 1024 * 2);
    p.wt_out1 = (bf16_t*)take((size_t)1024 * 1024 * 2);
    p.wt_qup = (bf16_t*)take((size_t)768 * 256 * 2);
    p.wt_kvup = (bf16_t*)take((size_t)1024 * 128 * 2);
    static int grid = 0;
    if (!grid) {
        int dev = 0, cus = 0, per_cu = 0;
        (void)hipGetDevice(&dev);
        (void)hipDeviceGetAttribute(&cus, hipDeviceAttributeMultiprocessorCount, dev);
        (void)hipFuncSetAttribute((const void*)k_mega, hipFuncAttributeMaxDynamicSharedMemorySize, KERNEL_LDS_BYTES);
        (void)hipOccupancyMaxActiveBlocksPerMultiprocessor(&per_cu, k_mega, 256, KERNEL_LDS_BYTES);
        if (cus <= 0) cus = 256;
        if (per_cu < 1) per_cu = 1;
        grid = cus * (per_cu < 2 ? per_cu : 2);
    }
    (void)hipMemsetAsync(d_ws, 0, zero_bytes, stream);
    hipLaunchKernelGGL(k_mega, dim3(grid), dim3(256), KERNEL_LDS_BYTES, stream, p);
}
```

```cpp
#include <hip/hip_runtime.h>
#include <stdint.h>

typedef unsigned u32x2n __attribute__((ext_vector_type(2)));
#define T_TOK 16384
#define SEQ 8192
#define DM 1024
#define NEGF (-1e30f)
#define BIGF (1e30f)

typedef unsigned short bf16_t;

__device__ __forceinline__ float bf2f(bf16_t v) { return __uint_as_float(((unsigned)v) << 16); }
__device__ __forceinline__ bf16_t f2bf(float f) {
    unsigned u = __float_as_uint(f);
    u += 0x7fffu + ((u >> 16) & 1u);
    return (bf16_t)(u >> 16);
}
typedef __bf16 bf16x2_t __attribute__((ext_vector_type(2)));
typedef float f32x2_t __attribute__((ext_vector_type(2)));
__device__ __forceinline__ unsigned cvtpk(float lo, float hi) { const f32x2_t f = {lo, hi}; return __builtin_bit_cast(unsigned, __builtin_convertvector(f, bf16x2_t)); }
__device__ __forceinline__ unsigned cvtpk_valu(float lo, float hi) { unsigned r; asm("s_nop 0\n\tv_cvt_pk_bf16_f32 %0, %1, %2" : "=v"(r) : "v"(lo), "v"(hi)); return r; }
__device__ __forceinline__ float wsum(float v) {
    v += __builtin_bit_cast(float, __builtin_amdgcn_update_dpp(0, __builtin_bit_cast(int, v), 0xB1, 0xF, 0xF, true));
    v += __builtin_bit_cast(float, __builtin_amdgcn_update_dpp(0, __builtin_bit_cast(int, v), 0x4E, 0xF, 0xF, true));
    v += __builtin_bit_cast(float, __builtin_amdgcn_update_dpp(0, __builtin_bit_cast(int, v), 0x124, 0xF, 0xF, true));
    v += __builtin_bit_cast(float, __builtin_amdgcn_update_dpp(0, __builtin_bit_cast(int, v), 0x128, 0xF, 0xF, true));
    const int iv = __builtin_bit_cast(int, v);
    const float r0 = __builtin_bit_cast(float, __builtin_amdgcn_readlane(iv, 0)), r1 = __builtin_bit_cast(float, __builtin_amdgcn_readlane(iv, 16));
    const float r2 = __builtin_bit_cast(float, __builtin_amdgcn_readlane(iv, 32)), r3 = __builtin_bit_cast(float, __builtin_amdgcn_readlane(iv, 48));
    return (r0 + r1) + (r2 + r3);
}
__device__ __forceinline__ float siluf(float v) { return v / (1.0f + __expf(-v)); }
__device__ __forceinline__ float sigmf(float v) { return 1.0f / (1.0f + __expf(-v)); }
__device__ __forceinline__ float gelu_tanh(float x) {
    const float k0 = 0.7978845608028654f, k1 = 0.044715f;
    float u = k0 * (x + k1 * x * x * x);
    return 0.5f * x * (1.0f + tanhf(u));
}
__device__ __forceinline__ int rel_bucket(int d) {
    if (d < 16) return d < 0 ? 0 : d;
    int b = 16;
    b += (d >= 21); b += (d >= 27); b += (d >= 35); b += (d >= 46); b += (d >= 59); b += (d >= 77); b += (d >= 99); b += (d >= 128);
    b += (d >= 166); b += (d >= 216); b += (d >= 280); b += (d >= 363); b += (d >= 470); b += (d >= 609); b += (d >= 790);
    return b;
}

__device__ __forceinline__ int otid() { int t = threadIdx.x; asm volatile("" : "+v"(t)); return t; }

struct P {
    const float *x, *c, *rel, *router_w, *router_b, *final_norm, *norm_mix, *norm_ffn, *ada_w, *ada_b, *moe_wg, *moe_wu, *moe_wd,
        *ev_w_in, *ev_w_out, *pos_k, *pos_v, *ck_w1, *ck_w2, *cv_w1, *cv_w2, *od_w_in, *od_w_out, *q_norm, *kv_norm, *w_q_up, *w_kv_up, *sinks;
    float* out;
    unsigned* bar; int* cnt;
    float *modv, *ropec, *ropes, *blut, *gates, *kcmp, *vcmp, *chid, *kmean, *tokw;
    bf16_t *h, *proj, *o, *hid, *y, *proj1, *qmla, *kvmla, *krope, *cqn;
    int* list;
    bf16_t *wt_gu, *wt_d, *wt_in0, *wt_out0, *wt_c1, *wt_c2, *wt_in1, *wt_out1, *wt_qup, *wt_kvup, *chidb;
    float *c1, *c1p;
    int* wq;
    bf16_t* zrow;
    bf16_t *kcmpb, *kmeanb, *mlap;
    float* mlal;
    int* mcnt; unsigned short* mlist; bf16_t *mp01, *mp2; float* mpl;
    bf16_t *xr1, *xr2, *xr3;
};


__device__ __forceinline__ void st_prologue(const P& p, int wg, int nwg, float* sm) {
    const int TIDX = otid();
    const int tid = TIDX;
    {
        for (int i = tid; i < 2048; i += 256) sm[i] = siluf(p.c[i]);
        __syncthreads();
        const int wid = tid >> 6, lane = tid & 63;
        for (int w = wg; w < 192; w += nwg) {
            const int l = w / 96, cg = w % 96, col = cg * 64 + lane;
            const float* W = p.ada_w + (size_t)l * 1024 * 6144 + (size_t)(wid * 256) * 6144 + col;
            float a0 = 0.f, a1 = 0.f;
#pragma unroll 32
            for (int k = 0; k < 256; ++k) { const float wv = W[(size_t)k * 6144]; a0 += sm[wid * 256 + k] * wv; a1 += sm[1024 + wid * 256 + k] * wv; }
            sm[2048 + tid] = a0; sm[2304 + tid] = a1;
            __syncthreads();
            if (tid < 64) {
                const float bb = p.ada_b[l * 6144 + col];
                p.modv[(l * 2 + 0) * 6144 + col] = ((sm[2048 + tid] + sm[2048 + 64 + tid]) + (sm[2048 + 128 + tid] + sm[2048 + 192 + tid])) + bb;
                p.modv[(l * 2 + 1) * 6144 + col] = ((sm[2304 + tid] + sm[2304 + 64 + tid]) + (sm[2304 + 128 + tid] + sm[2304 + 192 + tid])) + bb;
            }
            __syncthreads();
        }
        __syncthreads();
    }
    for (int i = wg * 256 + tid; i < SEQ * 32; i += nwg * 256) {
        const int t = i >> 5, j = i & 31;
        const float inv = powf(10000.0f, -(float)(2 * j) / 64.0f);
        const float ang = (float)t * inv;
        p.ropec[i] = cosf(ang); p.ropes[i] = sinf(ang);
    }
    for (int i = wg * 256 + tid; i < 8 * 1024; i += nwg * 256) { const int h = i >> 10, d = i & 1023; p.blut[i] = p.rel[rel_bucket(d) * 8 + h]; }
}

#define RT_OFF 4096
template <int MODE>
__device__ __forceinline__ void st_norm(const P& p, int layer, int wg, int nwg, float* sm) {
    const int TIDX = otid();
    const int wid = TIDX >> 6, lane = TIDX & 63;
    int* rl_cnt = (int*)sm; int* rl_base = rl_cnt + 16; int* rl_ent = rl_cnt + 32; float* rl_lg = sm + 256;
    if (MODE == 1) {
        if (TIDX < 16) rl_cnt[TIDX] = 0;
        for (int i = TIDX; i < 64; i += 256) rl_ent[i] = -1;
        for (int idx = TIDX; idx < 4096; idx += 256) {
            const int col = idx >> 2, q = idx & 3;
            *(float4*)((char*)sm + RT_OFF + q * 16384 + (col & 3) * 4096 + ((col >> 8) * 64 + ((col >> 2) & 63)) * 16) = *(const float4*)(p.router_w + idx * 4);
        }
        __syncthreads();
    }
    const int niter = (T_TOK + nwg * 4 - 1) / (nwg * 4);
    constexpr bool XB = (MODE != 0);
    const float* xin = p.x;
    const bf16_t* xinb = (MODE == 1) ? (layer ? p.xr3 : p.xr1) : (MODE == 2) ? p.xr1 : p.xr3;
    float4 pre4[4]; u32x2n pre2[4];
    {
        const int row0 = wg * 4 + wid;
#pragma unroll
        for (int i = 0; i < 4; ++i) {
            if (XB) pre2[i] = (row0 < T_TOK) ? *(const u32x2n*)(xinb + (size_t)row0 * DM + i * 256 + lane * 4) : (u32x2n){0u, 0u};
            else pre4[i] = (row0 < T_TOK) ? *(const float4*)(xin + (size_t)row0 * DM + i * 256 + lane * 4) : make_float4(0.f, 0.f, 0.f, 0.f);
        }
    }
    for (int it = 0; it < niter; ++it) {
        const int row = wg * 4 + wid + it * nwg * 4;
        if (MODE != 1 && row >= T_TOK) break;
        float v[16];
#pragma unroll
        for (int i = 0; i < 4; ++i) {
            if (XB) { v[i * 4 + 0] = __uint_as_float(pre2[i][0] << 16); v[i * 4 + 1] = __uint_as_float(pre2[i][0] & 0xffff0000u); v[i * 4 + 2] = __uint_as_float(pre2[i][1] << 16); v[i * 4 + 3] = __uint_as_float(pre2[i][1] & 0xffff0000u); }
            else { v[i * 4 + 0] = pre4[i].x; v[i * 4 + 1] = pre4[i].y; v[i * 4 + 2] = pre4[i].z; v[i * 4 + 3] = pre4[i].w; }
        }
        {
            const int rown = row + nwg * 4;
            if (rown < T_TOK) {
#pragma unroll
                for (int i = 0; i < 4; ++i) {
                    if (XB) pre2[i] = *(const u32x2n*)(xinb + (size_t)rown * DM + i * 256 + lane * 4);
                    else pre4[i] = *(const float4*)(xin + (size_t)rown * DM + i * 256 + lane * 4);
                }
            }
        }
        if (MODE != 1 || row < T_TOK) {
        const int b = row >> 13;
        if (MODE >= 2) {
            const int lp = (MODE == 2) ? layer - 1 : 1;
            const float* gf = p.modv + (size_t)(lp * 2 + b) * 6144 + 5 * 1024;
#pragma unroll
            for (int i = 0; i < 4; ++i)
#pragma unroll
                for (int j = 0; j < 4; ++j) {
                    const int col = i * 256 + lane * 4 + j;
                    const float y0 = bf2f(p.y[(size_t)(2 * row) * DM + col]), y1 = bf2f(p.y[(size_t)(2 * row + 1) * DM + col]);
                    v[i * 4 + j] += gf[col] * (y0 + y1);
                }
            if (MODE == 2) {
#pragma unroll
                for (int i = 0; i < 4; ++i) {
                    const u32x2n xo = {cvtpk(v[i * 4], v[i * 4 + 1]), cvtpk(v[i * 4 + 2], v[i * 4 + 3])};
                    *(u32x2n*)(p.xr2 + (size_t)row * DM + i * 256 + lane * 4) = xo;
#pragma unroll
                    for (int j = 0; j < 4; ++j) v[i * 4 + j] = __uint_as_float((j & 1) ? (xo[j >> 1] & 0xffff0000u) : (xo[j >> 1] << 16));
                }
            }
        }
        float ss = 0.f;
#pragma unroll
        for (int i = 0; i < 16; ++i) ss += v[i] * v[i];
        ss = wsum(ss);
        const float r = rsqrtf(ss * (1.0f / 1024.0f) + 1e-6f);
        if (MODE == 3) {
#pragma unroll
            for (int i = 0; i < 4; ++i) {
                const float4 g4 = *(const float4*)(p.final_norm + i * 256 + lane * 4);
                *(float4*)(p.out + (size_t)row * DM + i * 256 + lane * 4) =
                    make_float4(v[i * 4] * r * g4.x, v[i * 4 + 1] * r * g4.y, v[i * 4 + 2] * r * g4.z, v[i * 4 + 3] * r * g4.w);
            }
            continue;
        }
        const float* g = ((MODE == 1) ? p.norm_ffn : p.norm_mix) + layer * 1024;
        const float* mv = p.modv + (size_t)(layer * 2 + b) * 6144;
        const float* shift = mv + ((MODE == 1) ? 3 : 0) * 1024;
        const float* scale = mv + ((MODE == 1) ? 4 : 1) * 1024;
        float hv[16];
#pragma unroll
        for (int i = 0; i < 4; ++i)
#pragma unroll
            for (int j = 0; j < 4; ++j) {
                const int col = i * 256 + lane * 4 + j;
                hv[i * 4 + j] = v[i * 4 + j] * r * g[col] * (1.0f + scale[col]) + shift[col];
                p.h[(size_t)row * DM + col] = f2bf(hv[i * 4 + j]);
            }
        if (MODE == 1) {
            float lg[16];
#pragma unroll
            for (int e = 0; e < 16; ++e) lg[e] = 0.f;
#pragma unroll
            for (int i = 0; i < 4; ++i)
#pragma unroll
                for (int j = 0; j < 4; ++j) {
                    const char* rw = (const char*)sm + RT_OFF + lane * 16 + j * 4096 + i * 1024;
#pragma unroll
                    for (int q = 0; q < 4; ++q) {
                        const float4 w4 = *(const float4*)(rw + q * 16384);
                        lg[4 * q] += hv[i * 4 + j] * w4.x; lg[4 * q + 1] += hv[i * 4 + j] * w4.y; lg[4 * q + 2] += hv[i * 4 + j] * w4.z; lg[4 * q + 3] += hv[i * 4 + j] * w4.w;
                    }
                    asm volatile("" ::: "memory");
                }
            float r8[8], r4[4], r2[2], r1;
#pragma unroll
            for (int k = 0; k < 8; ++k) {
                float sa = lg[k], sb = lg[8 + k];
                asm("s_nop 1\n\tv_permlane32_swap_b32 %0, %1\n\ts_nop 0" : "+v"(sa), "+v"(sb));
                r8[k] = sa + sb;
            }
#pragma unroll
            for (int k = 0; k < 4; ++k) {
                float sa = r8[k], sb = r8[4 + k];
                asm("s_nop 1\n\tv_permlane16_swap_b32 %0, %1\n\ts_nop 0" : "+v"(sa), "+v"(sb));
                r4[k] = sa + sb;
            }
            { const bool hi = (lane & 8) != 0;
#pragma unroll
              for (int k = 0; k < 2; ++k) { const float keep = hi ? r4[2 + k] : r4[k], send = hi ? r4[k] : r4[2 + k];
                                            r2[k] = keep + __builtin_bit_cast(float, __builtin_amdgcn_update_dpp(0, __builtin_bit_cast(int, send), 0x128, 0xF, 0xF, true)); } }
            { const bool hi = (lane & 4) != 0; const float keep = hi ? r2[1] : r2[0], send = hi ? r2[0] : r2[1]; r1 = keep + __shfl_xor(send, 4); }
            r1 += __builtin_bit_cast(float, __builtin_amdgcn_update_dpp(0, __builtin_bit_cast(int, r1), 0x4E, 0xF, 0xF, true));
            r1 += __builtin_bit_cast(float, __builtin_amdgcn_update_dpp(0, __builtin_bit_cast(int, r1), 0xB1, 0xF, 0xF, true));
            int t32a = 0, k32 = 1, t16a = 0, k16 = 1;
            asm("s_nop 1\n\tv_permlane32_swap_b32 %0, %1\n\ts_nop 0" : "+v"(t32a), "+v"(k32));
            asm("s_nop 1\n\tv_permlane16_swap_b32 %0, %1\n\ts_nop 0" : "+v"(t16a), "+v"(k16));
            if ((lane & 3) == 0) rl_lg[((it & 7) * 4 + wid) * 16 + (k32 * 8 + k16 * 4 + ((lane >> 3) & 1) * 2 + ((lane >> 2) & 1))] = r1;
        }
        }
        if (MODE == 1 && ((it & 7) == 7 || it == niter - 1)) {
            __syncthreads();
            if (TIDX < 32) {
                const int its = (it & ~7) + (TIDX >> 2), row = wg * 4 + (TIDX & 3) + its * nwg * 4;
                if (its <= it && row < T_TOK) {
                    float lg[16];
#pragma unroll
                    for (int e = 0; e < 16; ++e) lg[e] = rl_lg[TIDX * 16 + e];
                    float aff[16], bi[16];
        #pragma unroll
                    for (int e = 0; e < 16; ++e) { aff[e] = 1.0f / (1.0f + expf(-lg[e])); bi[e] = aff[e] + p.router_b[e]; }
                    float bestsc = -3e38f; int be0 = 0, be1 = 1; float bw0 = 0.f, bw1 = 0.f;
        #pragma unroll
                    for (int gI = 0; gI < 4; ++gI) {
                        int i1 = 0; float m1 = bi[gI * 4];
        #pragma unroll
                        for (int i = 1; i < 4; ++i) if (bi[gI * 4 + i] > m1) { m1 = bi[gI * 4 + i]; i1 = i; }
                        int i2 = -1; float m2 = -3e38f;
        #pragma unroll
                        for (int i = 0; i < 4; ++i) if (i != i1 && bi[gI * 4 + i] > m2) { m2 = bi[gI * 4 + i]; i2 = i; }
                        const float sc = m1 + m2;
                        float a1 = 0.f, a2 = 0.f;
        #pragma unroll
                        for (int i = 0; i < 4; ++i) { a1 = (i == i1) ? aff[gI * 4 + i] : a1; a2 = (i == i2) ? aff[gI * 4 + i] : a2; }
                        if (sc > bestsc) { bestsc = sc; be0 = gI * 4 + i1; be1 = gI * 4 + i2; bw0 = a1; bw1 = a2; }
                    }
                    const float ws = bw0 + bw1;
                    p.tokw[row * 2] = bw0 / ws; p.tokw[row * 2 + 1] = bw1 / ws;
                    const int r0 = atomicAdd(&rl_cnt[be0], 1), r1 = atomicAdd(&rl_cnt[be1], 1);
                    rl_ent[TIDX * 2] = (row << 12) | (be0 << 8) | r0;
                    rl_ent[TIDX * 2 + 1] = (row << 12) | (be1 << 8) | r1;
                }
            }
            __syncthreads();
            if (TIDX < 16) { const int c = rl_cnt[TIDX]; rl_base[TIDX] = c ? atomicAdd(&p.cnt[(layer * 16 + TIDX) * 32], c) : 0; rl_cnt[TIDX] = 0; }
            __syncthreads();
            if (TIDX < 64) {
                const int en = rl_ent[TIDX];
                if (en >= 0) { const int e = (en >> 8) & 15; p.list[e * T_TOK + rl_base[e] + (en & 255)] = (en >> 12) * 2 + (TIDX & 1); rl_ent[TIDX] = -1; }
            }
            __syncthreads();
        }
    }
}

__device__ __forceinline__ void st_kmean(const P& p, int wg, int nwg, float* sm) {
    const int TIDX = otid();
    const int wid = TIDX >> 6, lane = TIDX & 63;
    for (int w = wg; w < 2 * 8 * 32; w += nwg) {
        const int b = w >> 8, h = (w >> 5) & 7, j = w & 31;
        const bf16_t* kp = p.proj + (size_t)(b * SEQ + j * 256 + wid * 64) * 2840 + 1816 + h * 64 + lane;
        float s = 0.f;
#pragma unroll 16
        for (int i = 0; i < 64; ++i) s += bf2f(kp[(size_t)i * 2840]);
        __syncthreads();
        sm[TIDX] = s;
        __syncthreads();
        if (TIDX < 64) {
            const float m = ((sm[TIDX] + sm[64 + TIDX]) + (sm[128 + TIDX] + sm[192 + TIDX])) * (1.0f / 256.0f);
            p.kmean[(size_t)w * 64 + TIDX] = m;
            p.kmeanb[(size_t)w * 64 + TIDX] = f2bf(m);
        }
    }
}
__device__ __forceinline__ void st_mla_prep(const P& p, int wg, int nwg) {
    const int TIDX = otid();
    const int wid = TIDX >> 6, lane = TIDX & 63;
    for (int row = wg * 4 + wid; row < T_TOK; row += nwg * 4) {
        const int t = row & (SEQ - 1);
        const bf16_t* pr = p.proj1 + (size_t)row * 1216;
        float q[4], ss = 0.f;
#pragma unroll
        for (int i = 0; i < 4; ++i) { q[i] = bf2f(pr[i * 64 + lane]); ss += q[i] * q[i]; }
        ss = wsum(ss);
        float r = rsqrtf(ss * (1.0f / 256.0f) + 1e-6f);
#pragma unroll
        for (int i = 0; i < 4; ++i) p.cqn[(size_t)row * 384 + i * 64 + lane] = f2bf(q[i] * r * p.q_norm[i * 64 + lane]);
        float kvv[2]; ss = 0.f;
#pragma unroll
        for (int i = 0; i < 2; ++i) { kvv[i] = bf2f(pr[256 + i * 64 + lane]); ss += kvv[i] * kvv[i]; }
        ss = wsum(ss);
        r = rsqrtf(ss * (1.0f / 128.0f) + 1e-6f);
#pragma unroll
        for (int i = 0; i < 2; ++i) p.cqn[(size_t)row * 384 + 256 + i * 64 + lane] = f2bf(kvv[i] * r * p.kv_norm[i * 64 + lane]);
        if (lane < 32) {
            const float x1 = bf2f(pr[384 + lane]), x2 = bf2f(pr[384 + 32 + lane]);
            const float cs = p.ropec[t * 32 + lane], sn = p.ropes[t * 32 + lane];
            p.krope[(size_t)row * 64 + lane] = f2bf(x1 * cs - x2 * sn);
            p.krope[(size_t)row * 64 + 32 + lane] = f2bf(x1 * sn + x2 * cs);
        }
    }
}


typedef short bf16x8 __attribute__((ext_vector_type(8)));
typedef float f32x4 __attribute__((ext_vector_type(4)));
typedef unsigned u32x2 __attribute__((ext_vector_type(2)));
typedef unsigned u32x4v __attribute__((ext_vector_type(4)));
#define LDSP __attribute__((address_space(3)))
#define GEMM_LDS_BYTES 81920
#define KERNEL_LDS_BYTES 81920
#define BAR_LDS_OFF (KERNEL_LDS_BYTES - 16)

__device__ __forceinline__ unsigned pack_bf16(float lo, float hi) { return cvtpk(lo, hi); }

template <int MF, class AR, class BR, class Epi, class NX>
__device__ __forceinline__ void gemm128x(const int nk, const size_t akstep, const size_t bkstep, AR arow, BR brow, Epi epi, LDSP char* lds, const int tid, const bool staged, NX next) {
    constexpr int SS = MF * 4096 + 16384, BO = MF * 4096;
    const int wid = tid >> 6, lane = tid & 63, wr = wid >> 1, wc = wid & 1, fr = lane & 15, fq = lane >> 4;
    const int srow = tid >> 3, gch = ((tid & 7) ^ (srow & 7)) * 8;
    const bf16_t* ap[MF]; const bf16_t* bp[4];
#pragma unroll
    for (int i = 0; i < MF; ++i) ap[i] = arow(32 * i + srow) + gch;
#pragma unroll
    for (int i = 0; i < 4; ++i) bp[i] = brow(32 * i + srow) + gch;
    LDSP char* lw = lds + wid * 1024;
#define G128_ISSUE(st, kt) do { LDSP char* la_ = lw + (st) * SS; const size_t ao_ = (size_t)(kt) * akstep, bo_ = (size_t)(kt) * bkstep; \
        _Pragma("unroll") for (int i_ = 0; i_ < MF; ++i_) __builtin_amdgcn_global_load_lds((const unsigned*)(ap[i_] + ao_), (LDSP unsigned*)(la_ + 4096 * i_), 16, 0, 0); \
        _Pragma("unroll") for (int i_ = 0; i_ < 4; ++i_) __builtin_amdgcn_global_load_lds((const unsigned*)(bp[i_] + bo_), (LDSP unsigned*)(la_ + BO + 4096 * i_), 16, 0, 0); } while (0)
    f32x4 acc[MF][4];
#pragma unroll
    for (int m = 0; m < MF; ++m)
#pragma unroll
        for (int n = 0; n < 4; ++n) acc[m][n] = (f32x4){0.f, 0.f, 0.f, 0.f};
    const int aoff = (wr * 16 * MF + fr) * 128, boff = BO + (wc * 64 + fr) * 128, c0 = (fq ^ (fr & 7)) * 16;
    if (!staged) G128_ISSUE(0, 0);
    for (int kt = 0; kt < nk; ++kt) {
        const int cur = kt & 1;
        asm volatile("s_waitcnt vmcnt(0)" ::: "memory");
        __builtin_amdgcn_s_barrier();
        asm volatile("" ::: "memory");
        LDSP char* sb = lds + cur * SS;
        constexpr int NG = 2 * MF, PD = 3;
        bf16x8 af[NG], bf[2][4];
#define G128_AF(s_) (*(const LDSP bf16x8*)(sb + aoff + ((s_) % MF) * 2048 + (((s_) / MF) ? (c0 ^ 64) : c0)))
#pragma unroll
        for (int n = 0; n < 4; ++n) bf[0][n] = *(const LDSP bf16x8*)(sb + boff + n * 2048 + c0);
#pragma unroll
        for (int s = 0; s < PD; ++s) af[s] = G128_AF(s);
        __builtin_amdgcn_sched_barrier(0);
        if (kt + 1 < nk) G128_ISSUE(cur ^ 1, kt + 1);
        __builtin_amdgcn_sched_barrier(0);
#pragma unroll
        for (int s = 0; s < NG; ++s) {
            if (s + PD < NG) af[s + PD] = G128_AF(s + PD);
            if (s == MF - PD) {
#pragma unroll
                for (int n = 0; n < 4; ++n) bf[1][n] = *(const LDSP bf16x8*)(sb + boff + n * 2048 + (c0 ^ 64));
            }
#pragma unroll
            for (int n = 0; n < 4; ++n) acc[s % MF][n] = __builtin_amdgcn_mfma_f32_16x16x32_bf16(bf[s / MF][n], af[s], acc[s % MF][n], 0, 0, 0);
            __builtin_amdgcn_sched_barrier(0);
        }
#undef G128_AF
    }
    asm volatile("s_waitcnt lgkmcnt(0)" ::: "memory");
    __builtin_amdgcn_s_barrier();
    asm volatile("" ::: "memory");
    next();
#undef G128_ISSUE
#pragma unroll
    for (int m = 0; m < MF; ++m) epi(wr * 16 * MF + m * 16 + fr, wc * 64 + fq * 4, acc[m], m);
}

template <int MF, class AR, class BR>
__device__ __forceinline__ void g128_stage0(AR arow, BR brow, LDSP char* lds, const int tid) {
    const int wid = tid >> 6, srow = tid >> 3, gch = ((tid & 7) ^ (srow & 7)) * 8;
    LDSP char* lw = lds + wid * 1024;
#pragma unroll
    for (int i = 0; i < MF; ++i) {
        __builtin_amdgcn_global_load_lds((const unsigned*)(arow(32 * i + srow) + gch), (LDSP unsigned*)(lw + 4096 * i), 16, 0, 0);
    }
#pragma unroll
    for (int i = 0; i < 4; ++i) {
        __builtin_amdgcn_global_load_lds((const unsigned*)(brow(32 * i + srow) + gch), (LDSP unsigned*)(lw + MF * 4096 + 4096 * i), 16, 0, 0);
    }
}
template <class AR, class BR, class Epi>
__device__ __forceinline__ void gemm128(const int nk, const size_t akstep, const size_t bkstep, AR arow, BR brow, Epi epi, LDSP char* lds, const int tid) {
    gemm128x<4>(nk, akstep, bkstep, arow, brow, epi, lds, tid, false, [] {});
}

template <int MAP> __device__ __forceinline__ int conv_rowmap(int n) {
    if (MAP == 0) return n;
    const int tile = n >> 6, cc = n & 63, wc = cc >> 5, i16 = (cc >> 4) & 1, i = cc & 15;
    return tile * 128 + wc * 64 + ((MAP == 1 ? 0 : 2) + i16) * 16 + i;
}
template <int MAP>
__device__ __forceinline__ void conv_batched(const float* src, int nmat, int K, int N, size_t sstride, bf16_t* dst, size_t dstride, int wg, int nwg, float* sm, int tid, int wend = 0x7fffffff) {
    float(*t)[65] = (float(*)[65])sm;
    const int tk = K >> 6, tn = (N + 63) >> 6, per = tk * tn, total = (nmat * per < wend) ? nmat * per : wend;
    f32x4 v[4];
    auto ld = [&](int w) {
        const int mat = w / per, r = w % per, kt = r / tn, nt = r % tn;
        const float* s = src + (size_t)mat * sstride;
#pragma unroll
        for (int i = 0; i < 4; ++i) {
            const int idx = tid + 256 * i, k = idx >> 4, n = (idx & 15) * 4;
            v[i] = (f32x4){0.f, 0.f, 0.f, 0.f};
            if (nt * 64 + n < N) v[i] = *(const f32x4*)(s + (size_t)(kt * 64 + k) * N + nt * 64 + n);
        }
    };
    if (wg < total) ld(wg);
    for (int w = wg; w < total; w += nwg) {
        const int mat = w / per, r = w % per, kt = r / tn, nt = r % tn;
        bf16_t* d = dst + (size_t)mat * dstride;
#pragma unroll
        for (int i = 0; i < 4; ++i) {
            const int idx = tid + 256 * i, k = idx >> 4, n = (idx & 15) * 4;
            t[k][n] = v[i][0]; t[k][n + 1] = v[i][1]; t[k][n + 2] = v[i][2]; t[k][n + 3] = v[i][3];
        }
        __syncthreads();
        if (w + nwg < total) ld(w + nwg);
        {
            const int n = tid >> 2, kq = (tid & 3) * 16;
            if (nt * 64 + n < N) {
                unsigned pk[8];
#pragma unroll
                for (int j = 0; j < 8; ++j) pk[j] = cvtpk(t[kq + 2 * j][n], t[kq + 2 * j + 1][n]);
                bf16_t* o = d + (size_t)conv_rowmap<MAP>(nt * 64 + n) * K + kt * 64 + kq;
                *(u32x4v*)o = (u32x4v){pk[0], pk[1], pk[2], pk[3]};
                *(u32x4v*)(o + 8) = (u32x4v){pk[4], pk[5], pk[6], pk[7]};
            }
        }
        __syncthreads();
    }
}
__device__ __forceinline__ void st_convert(const P& p, int wg, int nwg, float* sm) {
    const int tid = otid();
    conv_batched<0>(p.ev_w_in, 1, 1024, 2840, 0, p.wt_in0, 0, wg, nwg, sm, tid);
    conv_batched<0>(p.ev_w_out, 1, 1024, 1024, 0, p.wt_out0, 0, wg, nwg, sm, tid);
    conv_batched<0>(p.ck_w1, 1, 2048, 256, 0, p.wt_c1, 0, wg, nwg, sm, tid);
    conv_batched<0>(p.cv_w1, 1, 2048, 256, 0, p.wt_c1 + 256 * 2048, 0, wg, nwg, sm, tid);
    conv_batched<0>(p.ck_w2, 1, 256, 64, 0, p.wt_c2, 0, wg, nwg, sm, tid);
    conv_batched<0>(p.cv_w2, 1, 256, 64, 0, p.wt_c2 + 64 * 256, 0, wg, nwg, sm, tid);
    conv_batched<0>(p.od_w_in, 1, 1024, 1216, 0, p.wt_in1, 0, wg, nwg, sm, tid);
    conv_batched<0>(p.od_w_out, 1, 1024, 1024, 0, p.wt_out1, 0, wg, nwg, sm, tid);
    conv_batched<0>(p.w_q_up, 1, 256, 768, 0, p.wt_qup, 0, wg, nwg, sm, tid);
    conv_batched<0>(p.w_kv_up, 1, 128, 1024, 0, p.wt_kvup, 0, wg, nwg, sm, tid);
    {
        const int wid = tid >> 6, lane = tid & 63;
        for (int w = wg * 4 + wid; w < 512; w += nwg * 4) {
            const int which = w >> 8, cg = (w >> 6) & 3, ks = w & 63, col = cg * 64 + lane;
            const float* w1 = (which ? p.cv_w1 : p.ck_w1) + (size_t)(ks * 32) * 256 + col; const float* pos = (which ? p.pos_v : p.pos_k) + ks * 32;
            float a = 0.f;
#pragma unroll
            for (int k = 0; k < 32; ++k) a += pos[k] * w1[(size_t)k * 256];
            p.c1p[(which * 64 + ks) * 256 + col] = a;
        }
    }
}
__device__ __forceinline__ void st_c1_reduce(const P& p, int wg, int nwg) {
    const int tid = otid();
    for (int i = wg * 256 + tid; i < 512; i += nwg * 256) {
        const int which = i >> 8, col = i & 255;
        float a = 0.f;
#pragma unroll 16
        for (int ks = 0; ks < 64; ++ks) a += p.c1p[(which * 64 + ks) * 256 + col];
        p.c1[i] = a;
    }
}


struct XcdOrder {
    int xcd, lw, nlw, tn, per;
    __device__ __forceinline__ XcdOrder(int wg, int nwg, int nM, int tn_) : xcd(wg & 7), lw(wg >> 3), nlw(nwg >> 3), tn(tn_), per((nM >> 3) * tn_) {}
    __device__ __forceinline__ bool get(int k, int& mt, int& nt) const { const int lt = lw + k * nlw; if (lt >= per) return false; mt = xcd + 8 * (lt / tn); nt = lt % tn; return true; }
};
template <int MF>
__device__ __forceinline__ void st_inproj0_mf(const P& p, int wg, int nwg, LDSP char* lds) {
    const int tid = otid();
    const XcdOrder ord(wg, nwg, ((T_TOK + 32 * MF - 1) / (32 * MF) + 7) & ~7, 23);
    auto Af = [&](int mt_) { return [=](int r) { int row = mt_ * (32 * MF) + r; row = row < T_TOK ? row : T_TOK - 1; return p.h + (size_t)row * DM; }; };
    auto Bf = [&](int nt_) { return [=](int r) { int n = nt_ * 128 + r; n = n < 2840 ? n : 2839; return p.wt_in0 + (size_t)n * 1024; }; };
    bool staged = false;
    for (int k = 0;; ++k) {
        int mt, nt, mt2 = 0, nt2 = 0;
        if (!ord.get(k, mt, nt)) break;
        if (mt * (32 * MF) >= T_TOK) break;
        const bool has2 = ord.get(k + 1, mt2, nt2) && mt2 * (32 * MF) < T_TOK;
        const bool st_ = staged; staged = has2;
        gemm128x<MF>(16, 64, 64, Af(mt), Bf(nt),
            [&](int rl, int cl, const f32x4 (&a)[4], int mfrag) {
                const int row = mt * (32 * MF) + rl;
#pragma unroll
                for (int n = 0; n < 4; ++n) {
                    const int col = nt * 128 + cl + n * 16;
                    if (col < 2840 && row < T_TOK) {
                        *(u32x2*)(p.proj + (size_t)row * 2840 + col) = (u32x2){pack_bf16(a[n][0], a[n][1]), pack_bf16(a[n][2], a[n][3])};
                        if (col >= 1280 && col < 1304)
                            *(f32x4*)(p.gates + (size_t)row * 24 + (col - 1280)) = (f32x4){sigmf(a[n][0]), sigmf(a[n][1]), sigmf(a[n][2]), sigmf(a[n][3])};
                    }
                }
            }, lds, tid, st_, [&] { if (has2) g128_stage0<MF>(Af(mt2), Bf(nt2), lds, tid); });
    }
}
__device__ __forceinline__ void st_cmp1_mf(const P& p, int wg, int nwg, LDSP char* lds) {
    const int tid = otid();
    for (int w = wg; w < 2 * 16 * 2; w += nwg) {
        const int which = w >> 5, mt = (w >> 1) & 15, nt = w & 1;
        const int colbase = which ? 640 : 512;
        gemm128(32, 2840, 64,
            [&](int r) { int m = mt * 128 + r; m = m < 2044 ? m : 2043; const int bk = m / 511, n = m % 511, b = bk >> 1, kv = bk & 1;
                         return p.proj + (size_t)(b * SEQ + 16 * n) * 2840 + colbase + kv * 64; },
            [&](int r) { return p.wt_c1 + (size_t)(which * 256 + nt * 128 + r) * 2048; },
            [&](int rl, int cl, const f32x4 (&a)[4], int mfrag) {
                const int m = mt * 128 + rl;
                if (m < 2044) {
#pragma unroll
                    for (int n = 0; n < 4; ++n) {
                        const int col = nt * 128 + cl + n * 16;
                        const f32x4 cb = *(const f32x4*)(p.c1 + which * 256 + col);
                        *(u32x2*)(p.chidb + (size_t)(which * 2048 + m) * 256 + col) =
                            (u32x2){pack_bf16(gelu_tanh(a[n][0] + cb[0]), gelu_tanh(a[n][1] + cb[1])), pack_bf16(gelu_tanh(a[n][2] + cb[2]), gelu_tanh(a[n][3] + cb[3]))};
                    }
                }
            }, lds, tid);
    }
}
__device__ __forceinline__ void st_cmp2_mf(const P& p, int wg, int nwg, LDSP char* lds) {
    const int tid = otid();
    for (int w = wg; w < 2 * 16; w += nwg) {
        const int which = w >> 4, mt = w & 15;
        gemm128(4, 64, 64,
            [&](int r) { int m = mt * 128 + r; m = m < 2044 ? m : 2043; return p.chidb + (size_t)(which * 2048 + m) * 256; },
            [&](int r) { return p.wt_c2 + (size_t)(which * 64 + (r & 63)) * 256; },
            [&](int rl, int cl, const f32x4 (&a)[4], int mfrag) {
                const int m = mt * 128 + rl;
                if (m < 2044) {
#pragma unroll
                    for (int n = 0; n < 4; ++n) { const int col = cl + n * 16; if (col < 64) {
                        const int bk = m / 511, nn = m % 511;
                        *(u32x2*)(p.kcmpb + ((size_t)((which * 4 + bk) * 512 + nn)) * 64 + col) = (u32x2){cvtpk(a[n][0], a[n][1]), cvtpk(a[n][2], a[n][3])}; } }
                }
            }, lds, tid);
    }
}
template <int MF>
__device__ __forceinline__ void st_outproj_mf(const P& p, int layer, int wg, int nwg, LDSP char* lds) {
    const int tid = otid();
    const bf16_t* W = layer ? p.wt_out1 : p.wt_out0;
    bf16_t* xout = layer ? p.xr3 : p.xr1;
    const XcdOrder ord(wg, nwg, ((T_TOK + 32 * MF - 1) / (32 * MF) + 7) & ~7, 8);
    auto Af = [&](int mt_) { return [=](int r) { int row = mt_ * (32 * MF) + r; row = row < T_TOK ? row : T_TOK - 1; return p.o + (size_t)row * DM; }; };
    auto Bf = [&](int nt_) { return [=](int r) { return W + (size_t)(nt_ * 128 + r) * 1024; }; };
    bool staged = false;
    for (int k = 0;; ++k) {
        int mt, nt, mt2 = 0, nt2 = 0;
        if (!ord.get(k, mt, nt)) break;
        if (mt * (32 * MF) >= T_TOK) break;
        const bool has2 = ord.get(k + 1, mt2, nt2) && mt2 * (32 * MF) < T_TOK;
        const bool st_ = staged; staged = has2;
        gemm128x<MF>(16, 64, 64, Af(mt), Bf(nt),
            [&](int rl, int cl, const f32x4 (&a)[4], int mfrag) {
                const int row = mt * (32 * MF) + rl, b = row >> 13;
                const float* g = p.modv + (size_t)(layer * 2 + (b & 1)) * 6144 + 2 * 1024;
                if (row < T_TOK)
#pragma unroll
                for (int n = 0; n < 4; ++n) {
                    const int col = nt * 128 + cl + n * 16;
                    const f32x4 gv = *(const f32x4*)(g + col);
                    f32x4 xv;
                    if (layer) { const u32x2 xb = *(const u32x2*)(p.xr2 + (size_t)row * DM + col);
                                 xv = (f32x4){__uint_as_float(xb[0] << 16), __uint_as_float(xb[0] & 0xffff0000u), __uint_as_float(xb[1] << 16), __uint_as_float(xb[1] & 0xffff0000u)}; }
                    else xv = *(const f32x4*)(p.x + (size_t)row * DM + col);
                    const f32x4 r4 = xv + gv * a[n];
                    *(u32x2*)(xout + (size_t)row * DM + col) = (u32x2){pack_bf16(r4[0], r4[1]), pack_bf16(r4[2], r4[3])};
                }
            }, lds, tid, st_, [&] { if (has2) g128_stage0<MF>(Af(mt2), Bf(nt2), lds, tid); });
    }
}
template <int BM>
__device__ __forceinline__ bool moe_tile128(const int* cnt, int tt, int& e, int& i0, int& off) {
    int acc = 0, o = 0;
    for (int q = 0; q < 16; ++q) {
        const int c = cnt[q * 32], nt = (c + BM - 1) / BM;
        if (tt < acc + nt) { e = q; i0 = (tt - acc) * BM; off = o; return true; }
        acc += nt; o += c;
    }
    return false;
}
struct MoeTile { int e, i0, off, nt, ce; bool ok; };
template <int BM>
__device__ __forceinline__ MoeTile moe_get(const int* cnt, int wg, int nwg, int k) {
    int mtot = 0;
    for (int q = 0; q < 16; ++q) mtot += (cnt[q * 32] + BM - 1) / BM;
    const int per = (mtot + 7) >> 3, lt = (wg >> 3) + k * (nwg >> 3), lm = lt >> 3;
    MoeTile t; t.nt = lt & 7; t.e = 0; t.i0 = 0; t.off = 0;
    t.ok = (lm < per) && moe_tile128<BM>(cnt, (wg & 7) * per + lm, t.e, t.i0, t.off);
    t.ce = t.ok ? cnt[t.e * 32] : 0; return t;
}
template <int MF>
__device__ __forceinline__ void st_moe_up_mf(const P& p, int layer, int wg, int nwg, LDSP char* lds) {
    const int tid = otid();
    const int* cnt = p.cnt + layer * 512;
    auto Af = [&](const MoeTile& t) { const int* lst = p.list + t.e * T_TOK; const int i0 = t.i0, ce = t.ce;
                                      return [=](int r) { const int i = (i0 + r < ce) ? i0 + r : i0; return p.h + (size_t)(lst[i] >> 1) * DM; }; };
    auto Bf = [&](const MoeTile& t) { const bf16_t* B = p.wt_gu + ((size_t)(layer * 16 + t.e) * 1024 + t.nt * 128) * 1024; return [=](int r) { return B + (size_t)r * 1024; }; };
    MoeTile cur = moe_get<32 * MF>(cnt, wg, nwg, 0);
    bool staged = false;
    for (int k = 0; cur.ok; ++k) {
        const MoeTile nx = moe_get<32 * MF>(cnt, wg, nwg, k + 1);
        const bool st_ = staged; staged = nx.ok;
        const int i0 = cur.i0, ce = cur.ce, off = cur.off, nt = cur.nt;
        gemm128x<MF>(16, 64, 64, Af(cur), Bf(cur),
            [&](int rl, int cl, const f32x4 (&a)[4], int mfrag) {
                if (i0 + rl < ce) {
                    const int wc = cl >> 6, fq4 = cl & 63;
#pragma unroll
                    for (int n = 0; n < 2; ++n) {
                        const int col = nt * 64 + wc * 32 + n * 16 + fq4;
                        const f32x4 g = a[n], u = a[n + 2];
                        *(u32x2*)(p.hid + (size_t)(off + i0 + rl) * 512 + col) =
                            (u32x2){pack_bf16(siluf(g[0]) * u[0], siluf(g[1]) * u[1]), pack_bf16(siluf(g[2]) * u[2], siluf(g[3]) * u[3])};
                    }
                }
            }, lds, tid, st_, [&] { if (nx.ok) g128_stage0<MF>(Af(nx), Bf(nx), lds, tid); });
        cur = nx;
    }
}
template <int MF>
__device__ __forceinline__ void st_moe_down_mf(const P& p, int layer, int wg, int nwg, LDSP char* lds) {
    const int tid = otid();
    const int* cnt = p.cnt + layer * 512;
    auto Af = [&](const MoeTile& t) { const int i0 = t.i0, ce = t.ce, off = t.off; return [=](int r) { const int i = (i0 + r < ce) ? i0 + r : i0; return p.hid + (size_t)(off + i) * 512; }; };
    auto Bf = [&](const MoeTile& t) { const bf16_t* B = p.wt_d + ((size_t)(layer * 16 + t.e) * 1024 + t.nt * 128) * 512; return [=](int r) { return B + (size_t)r * 512; }; };
    MoeTile cur = moe_get<32 * MF>(cnt, wg, nwg, 0);
    bool staged = false;
    for (int k = 0; cur.ok; ++k) {
        const MoeTile nx = moe_get<32 * MF>(cnt, wg, nwg, k + 1);
        const bool st_ = staged; staged = nx.ok;
        const int i0 = cur.i0, ce = cur.ce, nt = cur.nt;
        const int* lst = p.list + cur.e * T_TOK;
        int ids[MF]; float wts[MF];
#pragma unroll
        for (int m = 0; m < MF; ++m) { const int rl = ((tid >> 7) & 1) * (16 * MF) + m * 16 + (tid & 15); ids[m] = (i0 + rl < ce) ? lst[i0 + rl] : -1; }
#pragma unroll
        for (int m = 0; m < MF; ++m) wts[m] = ids[m] >= 0 ? p.tokw[ids[m]] : 0.f;
        gemm128x<MF>(8, 64, 64, Af(cur), Bf(cur),
            [&](int rl, int cl, const f32x4 (&a)[4], int mfrag) {
                if (i0 + rl < ce) {
                    const int id = ids[mfrag]; const float wt = wts[mfrag];
#pragma unroll
                    for (int n = 0; n < 4; ++n) {
                        const int col = nt * 128 + cl + n * 16;
                        *(u32x2*)(p.y + (size_t)id * DM + col) = (u32x2){pack_bf16(wt * a[n][0], wt * a[n][1]), pack_bf16(wt * a[n][2], wt * a[n][3])};
                    }
                }
            }, lds, tid, st_, [&] { if (nx.ok) g128_stage0<MF>(Af(nx), Bf(nx), lds, tid); });
        cur = nx;
    }
}
template <int MF>
__device__ __forceinline__ void st_inproj1_mf(const P& p, int wg, int nwg, LDSP char* lds) {
    const int tid = otid();
    const XcdOrder ord(wg, nwg, ((T_TOK + 32 * MF - 1) / (32 * MF) + 7) & ~7, 10);
    auto Af = [&](int mt_) { return [=](int r) { int row = mt_ * (32 * MF) + r; row = row < T_TOK ? row : T_TOK - 1; return p.h + (size_t)row * DM; }; };
    auto Bf = [&](int nt_) { return [=](int r) { int n = nt_ * 128 + r; n = n < 1216 ? n : 1215; return p.wt_in1 + (size_t)n * 1024; }; };
    bool staged = false;
    for (int k = 0;; ++k) {
        int mt, nt, mt2 = 0, nt2 = 0;
        if (!ord.get(k, mt, nt)) break;
        if (mt * (32 * MF) >= T_TOK) break;
        const bool has2 = ord.get(k + 1, mt2, nt2) && mt2 * (32 * MF) < T_TOK;
        const bool st_ = staged; staged = has2;
        gemm128x<MF>(16, 64, 64, Af(mt), Bf(nt),
            [&](int rl, int cl, const f32x4 (&a)[4], int mfrag) {
                const int row = mt * (32 * MF) + rl;
#pragma unroll
                for (int n = 0; n < 4; ++n) {
                    const int col = nt * 128 + cl + n * 16;
                    if (col < 1216 && row < T_TOK) *(u32x2*)(p.proj1 + (size_t)row * 1216 + col) = (u32x2){pack_bf16(a[n][0], a[n][1]), pack_bf16(a[n][2], a[n][3])};
                }
            }, lds, tid, st_, [&] { if (has2) g128_stage0<MF>(Af(mt2), Bf(nt2), lds, tid); });
    }
}
__device__ __forceinline__ void st_mla_up_mf(const P& p, int wg, int nwg, LDSP char* lds) {
    const int tid = otid();
    const XcdOrder ord(wg, nwg, 128, 14);
    for (int k = 0;; ++k) {
        int mt, c;
        if (!ord.get(k, mt, c)) break;
        if (c < 6) {
            gemm128(4, 64, 64,
                [&](int r) { return p.cqn + (size_t)(mt * 128 + r) * 384; },
                [&](int r) { return p.wt_qup + (size_t)(c * 128 + r) * 256; },
                [&](int rl, int cl, const f32x4 (&a)[4], int mfrag) {
                    const int row = mt * 128 + rl, wc = cl >> 6;
                    f32x4 v[4] = {a[0], a[1], a[2], a[3]};
                    if (((c == 1 || c == 4) && wc == 0) || ((c == 2 || c == 5) && wc == 1)) {
                        const int t = row & (SEQ - 1), i0 = cl & 63;
#pragma unroll
                        for (int n = 0; n < 2; ++n) {
                            const f32x4 cs = *(const f32x4*)(p.ropec + t * 32 + n * 16 + i0), sn = *(const f32x4*)(p.ropes + t * 32 + n * 16 + i0);
                            v[n] = a[n] * cs - a[n + 2] * sn; v[n + 2] = a[n] * sn + a[n + 2] * cs;
                        }
                    }
#pragma unroll
                    for (int n = 0; n < 4; ++n) *(u32x2*)(p.qmla + (size_t)row * 768 + c * 128 + cl + n * 16) = (u32x2){cvtpk(v[n][0], v[n][1]), cvtpk(v[n][2], v[n][3])};
                }, lds, tid);
        } else {
            gemm128(2, 64, 64,
                [&](int r) { return p.cqn + (size_t)(mt * 128 + r) * 384 + 256; },
                [&](int r) { return p.wt_kvup + (size_t)((c - 6) * 128 + r) * 128; },
                [&](int rl, int cl, const f32x4 (&a)[4], int mfrag) {
                    const int row = mt * 128 + rl;
#pragma unroll
                    for (int n = 0; n < 4; ++n) *(u32x2*)(p.kvmla + (size_t)row * 1024 + (c - 6) * 128 + cl + n * 16) = (u32x2){pack_bf16(a[n][0], a[n][1]), pack_bf16(a[n][2], a[n][3])};
                }, lds, tid);
        }
    }
}

typedef float f32x16 __attribute__((ext_vector_type(16)));
typedef short s16x4 __attribute__((ext_vector_type(4)));
#define ATT_NEG (-1e30f)
#define ATT_SHIFT (-16.0f)
#define LOG2E 1.4426950408889634f

__device__ __forceinline__ int swz128(int row) { return (((row >> 1) & 1) << 2) | ((row >> 2) & 3); }
__device__ __forceinline__ int swz256(int row) { return ((row & 3) << 2) | ((row >> 2) & 3); }

struct AttLane {
    int kbase;
    int v0[2];
};
template <int KROWB, int VROWB, int DT>
__device__ __forceinline__ void att_lane_init(AttLane& L, int lane) {
    const int q = lane & 31, hh = lane >> 5, x = hh ^ swz128(q);
    L.kbase = q * KROWB + x * 16;
    const int rl = 4 * hh + ((lane & 15) >> 2), blk = (lane >> 4) & 1, pp = lane & 3;
#pragma unroll
    for (int t = 0; t < 2; ++t) {
        const int g = (VROWB == 256) ? (((rl & 3) << 2) | ((2 * t + hh) & 3)) : ((((rl >> 1) & 1) << 2) | ((2 * t + hh) & 3));
        L.v0[t] = rl * VROWB + (((2 * blk + (pp >> 1)) ^ g) * 16) + 8 * (pp & 1);
    }
}
template <int KS, int KROWB, int MODE, bool WANT_P, bool IMP>
__device__ __forceinline__ void att_qk(LDSP const char* kb, const AttLane& L, const bf16x8 (&qf)[KS], bf16x8 (&pf)[4], float& lsum, const float c1, const float cadd,
                                       const unsigned lutv, const int dq16, LDSP float* improw, const float invl) {
    float la = 0.f, lb = 0.f, lc = 0.f, ld = 0.f;
#pragma unroll
    for (int kt = 0; kt < 2; ++kt) {
        f32x16 s;
#pragma unroll
        for (int r = 0; r < 16; ++r) s[r] = 0.f;
        constexpr int KG = (KS > 4) ? 2 : 4;
#pragma unroll
        for (int k4 = 0; k4 < KS; k4 += KG) {
            bf16x8 a[KG];
#pragma unroll
            for (int j = 0; j < KG; ++j) { const int ks = k4 + j; a[j] = *(const LDSP bf16x8*)(kb + (L.kbase ^ (32 * (ks & 3))) + (ks >> 2) * 128 + kt * 32 * KROWB); }
#pragma unroll
            for (int j = 0; j < KG; ++j) s = __builtin_amdgcn_mfma_f32_32x32x16_bf16(a[j], qf[k4 + j], s, 0, 0, 0);
            asm volatile("" ::: "memory");
        }
        float pr[16];
#pragma unroll
        for (int r = 0; r < 16; ++r) {
            const int koff = 32 * kt + (r & 3) + 8 * (r >> 2);
            float add = cadd;
            if (MODE == 1) add = *(const LDSP float*)(lutv + (63 - koff) * 4);
            if (MODE == 2) { int d = dq16 - 16 * koff; d = d < -1 ? -1 : d; d = d > 1087 ? 1087 : d; add = *(const LDSP float*)(lutv + (unsigned)(64 + d) * 4u); }
            pr[r] = __builtin_amdgcn_exp2f(__builtin_fmaf(s[r], c1, add));
        }
#pragma unroll
        for (int r = 0; r < 16; r += 4) { la += pr[r]; lb += pr[r + 1]; lc += pr[r + 2]; ld += pr[r + 3]; }
        if (IMP) {
#pragma unroll
            for (int g = 0; g < 4; ++g) {
                (void)__hip_atomic_fetch_add((LDSP unsigned*)improw + 8 * kt + 2 * g, (unsigned)(((pr[4 * g] + pr[4 * g + 1]) + (pr[4 * g + 2] + pr[4 * g + 3])) * invl + 0.5f), __ATOMIC_RELAXED, __HIP_MEMORY_SCOPE_WORKGROUP);
                (void)__hip_atomic_fetch_add((LDSP unsigned*)improw + 8 * kt + 2 * g + 1, (unsigned)(pr[4 * g + 3] * invl + 0.5f), __ATOMIC_RELAXED, __HIP_MEMORY_SCOPE_WORKGROUP);
            }
        }
        if (WANT_P) {
#pragma unroll
            for (int sI = 0; sI < 2; ++sI) {
                union { unsigned u[4]; bf16x8 v; } cv;
#pragma unroll
                for (int i = 0; i < 4; ++i) cv.u[i] = cvtpk_valu(pr[8 * sI + 2 * i], pr[8 * sI + 2 * i + 1]);
                pf[kt * 2 + sI] = cv.v;
            }
        }
    }
    lsum += (la + lb) + (lc + ld);
}
template <int DT, int VROWB>
__device__ __forceinline__ void att_pv(LDSP const char* vb, const AttLane& L, const bf16x8 (&pf)[4], f32x16 (&o)[DT]) {
    const unsigned vba = (unsigned)(size_t)vb;
#pragma unroll
    for (int ks2 = 0; ks2 < 4; ++ks2) {
#pragma unroll
        for (int d0 = 0; d0 < DT; d0 += 2) {
            s16x4 lo[2], hi[2];
#pragma unroll
            for (int j = 0; j < 2; ++j) {
                asm volatile("ds_read_b64_tr_b16 %0, %1 offset:%2" : "=v"(lo[j]) : "v"(vba + (L.v0[0] ^ ((d0 + j) << 6))), "i"((16 * ks2) * VROWB) : "memory");
                asm volatile("ds_read_b64_tr_b16 %0, %1 offset:%2" : "=v"(hi[j]) : "v"(vba + (L.v0[1] ^ ((d0 + j) << 6))), "i"((16 * ks2 + 8) * VROWB) : "memory");
            }
            asm volatile("s_waitcnt lgkmcnt(0)" ::: "memory");
#pragma unroll
            for (int j = 0; j < 2; ++j) {
                asm volatile("" : "+v"(lo[j]), "+v"(hi[j]));
                const bf16x8 vf = __builtin_shufflevector(lo[j], hi[j], 0, 1, 2, 3, 4, 5, 6, 7);
                o[d0 + j] = __builtin_amdgcn_mfma_f32_32x32x16_bf16(vf, pf[ks2], o[d0 + j], 0, 0, 0);
            }
        }
    }
}
template <int CPR>
__device__ __forceinline__ void att_stage_map(int (&rowc)[(CPR == 24) ? 6 : 1], int tid) {
    if (CPR == 24) {
#pragma unroll
        for (int i = 0; i < 6; ++i) {
            const int c = tid + 256 * i, row = c / 24, cc = c % 24;
            rowc[i % ((CPR == 24) ? 6 : 1)] = (row << 8) | ((cc & ~7) | ((cc & 7) ^ swz128(row)));
        }
    } else if (CPR == 16) {
        const int row = tid >> 4; rowc[0] = (row << 8) | ((tid & 15) ^ swz256(row));
    } else {
        const int row = tid >> 3; rowc[0] = (row << 8) | ((tid & 7) ^ swz128(row));
    }
}
template <int CPR, class SRC>
__device__ __forceinline__ void att_stage(LDSP char* dst, SRC src, const int (&rowc)[(CPR == 24) ? 6 : 1], int wid) {
#pragma unroll
    for (int i = 0; i < CPR / 4; ++i) {
        const int rc = rowc[(CPR == 24) ? i : 0];
        const int row = (rc >> 8) + ((CPR == 24) ? 0 : i * (256 / CPR));
        __builtin_amdgcn_global_load_lds((const unsigned*)src(row, rc & 255), (LDSP unsigned*)(dst + (256 * i + 64 * wid) * 16), 16, 0, 0);
    }
}
__device__ __forceinline__ int wq_next(int* ctr, LDSP int* slot, int tid) {
    __syncthreads();
    if (tid == 0) *slot = atomicAdd(ctr, 1);
    __syncthreads();
    return *slot;
}

__device__ __forceinline__ void build_lut(LDSP float* tab, const float* blut_h, int n, int wlimit, int tid) {
    for (int i = tid; i < n; i += 256) { const int d = i - 64; tab[i] = (d < 0 || d >= wlimit) ? ATT_NEG : blut_h[d > 1023 ? 1023 : d] * LOG2E + ATT_SHIFT; }
}
#define ATT_BAR() do { __builtin_amdgcn_s_barrier(); asm volatile("" ::: "memory"); } while (0)

__device__ __forceinline__ void mla_item(const P& p, const int item, LDSP char* lds, const int tid0) {
    LDSP char* kb = lds; LDSP char* vb = lds + 24576; LDSP float* lut = (LDSP float*)(lds + 40960);
    const float c1 = 0.07216878364870322f * LOG2E;
    int tid = tid0; asm volatile("" : "+v"(tid));
    const int wid = tid >> 6, lane = tid & 63, q = lane & 31, hh = lane >> 5;
    AttLane L; att_lane_init<384, 256, 4>(L, lane);
    int krc[6], vrc[1];
    att_stage_map<24>(krc, tid); att_stage_map<16>(vrc, tid);
    int qt, bh, part;
    if (item >= 640) { const int r = item - 640; qt = 15 - (r >> 3); bh = r & 7; part = 0; }
    else {
        int g = 0; while (16 * (g + 1) + 8 * ((g + 2) >> 1) <= item) ++g;
        const int r = item - (16 * g + 8 * ((g + 1) >> 1)), Ln = 64 - g;
        if (r < 16) { qt = Ln - 1; bh = r & 7; part = 1 + (r >> 3); } else { qt = (Ln >> 1) - 1; bh = (r - 16) & 7; part = 0; }
    }
    const int b = bh >> 2, h = bh & 3;
    const int tw = qt * 128 + wid * 32;
    bf16x8 qf[12];
    {
        const bf16_t* qp = p.qmla + (size_t)(b * SEQ + tw + q) * 768 + h * 192 + 8 * hh;
#pragma unroll
        for (int ks = 0; ks < 12; ++ks) qf[ks] = *(const bf16x8*)(qp + 16 * ks);
    }
    f32x16 o[4];
#pragma unroll
    for (int dt = 0; dt < 4; ++dt)
#pragma unroll
        for (int r = 0; r < 16; ++r) o[dt][r] = 0.f;
    float lsum = 0.f;
    const int i0 = (part == 2) ? qt + 1 : 0, ntiles = (part == 1) ? qt + 1 : 2 * qt + 2;
    const bf16_t* kvb = p.kvmla + (size_t)b * SEQ * 1024 + h * 256;
    const bf16_t* krb = p.krope + (size_t)b * SEQ * 64;
    auto ksrc = [&](int pos0) { return [=](int row, int gc) { return gc < 16 ? kvb + (size_t)(pos0 + row) * 1024 + gc * 8 : krb + (size_t)(pos0 + row) * 64 + (gc - 16) * 8; }; };
    auto vsrc = [&](int pos0) { return [=](int row, int gc) { return kvb + (size_t)(pos0 + row) * 1024 + 128 + gc * 8; }; };
    att_stage<24>(kb, ksrc(i0 * 64), krc, wid);
    for (int i = i0; i < ntiles; ++i) {
        const int pos0 = i * 64;
        asm volatile("s_waitcnt vmcnt(0)" ::: "memory"); ATT_BAR();
        att_stage<16>(vb, vsrc(pos0), vrc, wid);
        const bool active = pos0 <= tw + 31, diag = pos0 + 63 > tw;
        bf16x8 pf[4];
        if (active) {
            if (diag) {
                int dq = tw + q - pos0 - 4 * hh; dq = dq < -1 ? -1 : dq;
                att_qk<12, 384, 1, true, false>(kb, L, qf, pf, lsum, c1, 0.f, (unsigned)(size_t)lut + (unsigned)(dq + 1) * 4u, 0, nullptr, 0.f);
            } else att_qk<12, 384, 0, true, false>(kb, L, qf, pf, lsum, c1, ATT_SHIFT, 0u, 0, nullptr, 0.f);
        }
        asm volatile("s_waitcnt vmcnt(0) lgkmcnt(0)" ::: "memory"); ATT_BAR();
        if (i + 1 < ntiles) att_stage<24>(kb, ksrc(pos0 + 64), krc, wid);
        if (active) att_pv<4, 256>(vb, L, pf, o);
    }
    const float lt = lsum + __shfl_xor(lsum, 32);
    int tid2 = tid0; asm volatile("" : "+v"(tid2));
    const int lane2 = tid2 & 63, trow = qt * 128 + (tid2 >> 6) * 32 + (lane2 & 31);
    bf16_t* op; float inv;
    if (part == 0) { inv = 1.0f / lt; op = p.o + (size_t)(b * SEQ + trow) * DM + h * 128 + 4 * (lane2 >> 5); }
    else {
        const size_t rec = (size_t)((part - 1) * 8 + bh) * (SEQ / 2) + (trow - SEQ / 2);
        inv = 1.0f; op = p.mlap + rec * 128 + 4 * (lane2 >> 5);
        if (lane2 < 32) p.mlal[rec] = lt;
    }
#pragma unroll
    for (int dt = 0; dt < 4; ++dt)
#pragma unroll
        for (int rq = 0; rq < 4; ++rq)
            *(u32x2*)(op + 32 * dt + 8 * rq) = (u32x2){cvtpk(o[dt][4 * rq] * inv, o[dt][4 * rq + 1] * inv), cvtpk(o[dt][4 * rq + 2] * inv, o[dt][4 * rq + 3] * inv)};
}
__device__ __forceinline__ void st_mla_combine(const P& p, int wg, int nwg) {
    const int TIDX = otid();
    const int wid = TIDX >> 6, lane = TIDX & 63;
    for (int w = wg * 4 + wid; w < 8 * (SEQ / 2); w += nwg * 4) {
        const int bh = w / (SEQ / 2), t = SEQ / 2 + w % (SEQ / 2), b = bh >> 2, h = bh & 3;
        const size_t r0 = (size_t)w, r1 = (size_t)(8 * (SEQ / 2) + w);
        const float inv = 1.0f / (p.mlal[r0] + p.mlal[r1]);
        const unsigned a = *(const unsigned*)(p.mlap + r0 * 128 + lane * 2), c = *(const unsigned*)(p.mlap + r1 * 128 + lane * 2);
        const float x0 = __uint_as_float(a << 16) + __uint_as_float(c << 16), x1 = __uint_as_float(a & 0xffff0000u) + __uint_as_float(c & 0xffff0000u);
        *(unsigned*)(p.o + (size_t)(b * SEQ + t) * DM + h * 128 + lane * 2) = cvtpk(x0 * inv, x1 * inv);
    }
}

__device__ __forceinline__ void swa_item(const P& p, const int item, LDSP char* lds, const int tid0) {
    LDSP char* kb = lds; LDSP char* vb = lds + 8192; LDSP float* luts = (LDSP float*)(lds + 46080);
    const float c1 = 0.125f * LOG2E;
    int tid = tid0; asm volatile("" : "+v"(tid));
    const int wid = tid >> 6, lane = tid & 63, q = lane & 31, hh = lane >> 5;
    AttLane L; att_lane_init<128, 128, 2>(L, lane);
    int rc[1]; att_stage_map<8>(rc, tid);
    const int b = item >> 9, kvh = (item >> 8) & 1, t0 = (item & 255) * 32, head = kvh * 4 + wid;
    bf16x8 qf[4];
    {
        const bf16_t* qp = p.proj1 + (size_t)(b * SEQ + t0 + q) * 1216 + 448 + head * 64 + 8 * hh;
#pragma unroll
        for (int ks = 0; ks < 4; ++ks) qf[ks] = *(const bf16x8*)(qp + 16 * ks);
    }
    f32x16 o[2];
#pragma unroll
    for (int dt = 0; dt < 2; ++dt)
#pragma unroll
        for (int r = 0; r < 16; ++r) o[dt][r] = 0.f;
    float lsum = 0.f;
    const bf16_t* kbp = p.proj1 + (size_t)b * SEQ * 1216 + 960 + kvh * 64;
    const bf16_t* zr = p.zrow;
    auto ksrc = [&](int pos0) { return [=](int row, int gc) { const int pos = pos0 + row; return (pos >= 0 && pos < SEQ) ? kbp + (size_t)pos * 1216 + gc * 8 : zr + gc * 8; }; };
    auto vsrc = [&](int pos0) { return [=](int row, int gc) { const int pos = pos0 + row; return (pos >= 0 && pos < SEQ) ? kbp + (size_t)pos * 1216 + 128 + gc * 8 : zr + gc * 8; }; };
    const unsigned tab = (unsigned)(size_t)(luts + head * 256);
    att_stage<8>(kb, ksrc(t0 - 128), rc, wid);
    for (int i = 0; i < 3; ++i) {
        const int pos0 = t0 - 128 + 64 * i;
        asm volatile("s_waitcnt vmcnt(0)" ::: "memory"); ATT_BAR();
        att_stage<8>(vb, vsrc(pos0), rc, wid);
        bf16x8 pf[4];
        int dq = t0 + q - pos0 - 4 * hh; dq = dq < -1 ? -1 : dq;
        att_qk<4, 128, 1, true, false>(kb, L, qf, pf, lsum, c1, 0.f, tab + (unsigned)(dq + 1) * 4u, 0, nullptr, 0.f);
        asm volatile("s_waitcnt vmcnt(0) lgkmcnt(0)" ::: "memory"); ATT_BAR();
        if (i + 1 < 3) att_stage<8>(kb, ksrc(pos0 + 64), rc, wid);
        att_pv<2, 128>(vb, L, pf, o);
    }
    const float lt = lsum + __shfl_xor(lsum, 32) + __builtin_amdgcn_exp2f(p.sinks[head] * LOG2E + ATT_SHIFT);
    const float inv = 1.0f / lt;
    bf16_t* op = p.o + (size_t)(b * SEQ + t0 + q) * DM + 512 + head * 64 + 4 * hh;
#pragma unroll
    for (int dt = 0; dt < 2; ++dt)
#pragma unroll
        for (int rq = 0; rq < 4; ++rq)
            *(u32x2*)(op + 32 * dt + 8 * rq) = (u32x2){cvtpk(o[dt][4 * rq] * inv, o[dt][4 * rq + 1] * inv), cvtpk(o[dt][4 * rq + 2] * inv, o[dt][4 * rq + 3] * inv)};
}
__device__ __forceinline__ void moe_conv_item(const P& p, const int layer, const int item, LDSP char* lds, const int tid0) {
    float* sm = (float*)lds;
    const int set = item >> 8, t0 = (item & 255) * 8;
    if (set == 0) conv_batched<1>(p.moe_wg + (size_t)layer * 16 * 1024 * 512, 16, 1024, 512, (size_t)1024 * 512, p.wt_gu + (size_t)layer * 16 * 1024 * 1024, (size_t)1024 * 1024, t0, 1, sm, tid0, t0 + 8);
    else if (set == 1) conv_batched<2>(p.moe_wu + (size_t)layer * 16 * 1024 * 512, 16, 1024, 512, (size_t)1024 * 512, p.wt_gu + (size_t)layer * 16 * 1024 * 1024, (size_t)1024 * 1024, t0, 1, sm, tid0, t0 + 8);
    else conv_batched<0>(p.moe_wd + (size_t)layer * 16 * 512 * 1024, 16, 512, 1024, (size_t)512 * 1024, p.wt_d + (size_t)layer * 16 * 1024 * 512, (size_t)1024 * 512, t0, 1, sm, tid0, t0 + 8);
}
__device__ __forceinline__ void st_attn1(const P& p, LDSP char* lds) {
    const int tid0 = otid();
    LDSP float* lut = (LDSP float*)(lds + 40960); LDSP int* slot = (LDSP int*)(lds + 45568); LDSP float* luts = (LDSP float*)(lds + 46080);
    for (int i = tid0; i < 1152; i += 256) lut[i] = (i < 64) ? ATT_NEG : ATT_SHIFT;
#pragma unroll 1
    for (int h = 0; h < 8; ++h) build_lut(luts + h * 256, p.blut + h * 1024, 256, 128, tid0);
    for (;;) {
        const int item = wq_next(p.wq + 0, slot, tid0);
        if (item >= 768 + 1024 + 768) break;
        if (item < 768) mla_item(p, item, lds, tid0);
        else { const int r = item - 768, g = r / 7, ps = r - g * 7;
               if (ps < 4) swa_item(p, g * 4 + ps, lds, tid0); else moe_conv_item(p, 1, g * 3 + ps - 4, lds, tid0); }
    }
}

#define A0_GLUT 16384
#define A0_WLUT 34816
#define A0_IMP 45056
#define A0_SEL 61568
#define A0_UN 62080
#define A0_LIST 62144
#define A0_SLOT 62720
__device__ __forceinline__ unsigned wmax_u32(unsigned v) {
#pragma unroll
    for (int o = 32; o > 0; o >>= 1) { const unsigned t = (unsigned)__shfl_xor((int)v, o); v = t > v ? t : v; }
    return v;
}
#define ATT_STORE_O(op, o, sc) do { _Pragma("unroll") for (int dt_ = 0; dt_ < 2; ++dt_) _Pragma("unroll") for (int rq_ = 0; rq_ < 4; ++rq_) \
        *(u32x2*)((op) + 32 * dt_ + 8 * rq_) = (u32x2){cvtpk((o)[dt_][4 * rq_] * (sc), (o)[dt_][4 * rq_ + 1] * (sc)), cvtpk((o)[dt_][4 * rq_ + 2] * (sc), (o)[dt_][4 * rq_ + 3] * (sc))}; } while (0)

__device__ __forceinline__ void nsa_item(const P& p, const int item, LDSP char* lds, const int tid0) {
    LDSP char* kb = lds; LDSP char* vb = lds + 8192;
    LDSP float* glut = (LDSP float*)(lds + A0_GLUT); LDSP float* wlut = (LDSP float*)(lds + A0_WLUT); LDSP float* imp = (LDSP float*)(lds + A0_IMP);
    LDSP unsigned* sel = (LDSP unsigned*)(lds + A0_SEL); LDSP unsigned* un = (LDSP unsigned*)(lds + A0_UN); LDSP unsigned short* blist = (LDSP unsigned short*)(lds + A0_LIST);
    const float c1 = 0.125f * LOG2E;
    int tid = tid0; asm volatile("" : "+v"(tid));
    const int wid = tid >> 6, lane = tid & 63, q = lane & 31, hh = lane >> 5;
    const int tile = 255 - (item >> 2), b = (item >> 1) & 1, kvh = item & 1, t0 = tile * 32, blk_t = t0 >> 6, head = kvh * 4 + wid;
#pragma unroll 1
    for (int h = 0; h < 4; ++h) { build_lut(glut + h * 1152, p.blut + (kvh * 4 + h) * 1024, 1152, 1 << 30, tid); build_lut(wlut + h * 640, p.blut + (kvh * 4 + h) * 1024, 640, 512, tid); }
    for (int i = tid; i < 32 * 129; i += 256) imp[i] = 0.f;
    AttLane L; att_lane_init<128, 128, 2>(L, lane);
    int rc[1]; att_stage_map<8>(rc, tid);
    const size_t rowq = (size_t)(b * SEQ + t0 + q);
    bf16x8 qf[4];
    {
        const bf16_t* qp = p.proj + rowq * 2840 + head * 64 + 8 * hh;
#pragma unroll
        for (int ks = 0; ks < 4; ++ks) qf[ks] = *(const bf16x8*)(qp + 16 * ks);
    }
    const float gc = p.gates[rowq * 24 + head * 3 + 0], gs = p.gates[rowq * 24 + head * 3 + 1], gw = p.gates[rowq * 24 + head * 3 + 2];
    const unsigned gtab = (unsigned)(size_t)(glut + wid * 1152), wtab = (unsigned)(size_t)(wlut + wid * 640);
    const bf16_t* zr = p.zrow;
    const bf16_t* pb = p.proj + (size_t)b * SEQ * 2840;
    f32x16 of[2], o[2];
#pragma unroll
    for (int dt = 0; dt < 2; ++dt)
#pragma unroll
        for (int r = 0; r < 16; ++r) { of[dt][r] = 0.f; o[dt][r] = 0.f; }
    bf16x8 pf[4];
    __syncthreads();
    const float cfar = glut[wid * 1152 + 64 + 1023];
    {
        int nvm = (t0 >> 4) + 1; nvm = nvm > 511 ? 511 : nvm;
        const int ntc = (nvm + 63) >> 6;
        const bf16_t* kcb = p.kcmpb + (size_t)((b * 2 + kvh) * 512) * 64;
        const bf16_t* vcb = p.kcmpb + (size_t)((4 + b * 2 + kvh) * 512) * 64;
        auto csrc = [&](const bf16_t* base, int n0) { return [=](int row, int gcx) { const int n = n0 + row; return n < 511 ? base + (size_t)n * 64 + gcx * 8 : zr + gcx * 8; }; };
        float lsum = 0.f;
        for (int nt = 0; nt < ntc; ++nt) {
            att_stage<8>(kb, csrc(kcb, nt * 64), rc, wid);
            asm volatile("s_waitcnt vmcnt(0)" ::: "memory"); ATT_BAR();
            const int dq16 = t0 + q - 31 - 1024 * nt - 64 * hh;
            if (t0 - 31 - 16 * (nt * 64 + 63) >= 1023) att_qk<4, 128, 0, false, false>(kb, L, qf, pf, lsum, c1, cfar, 0u, 0, nullptr, 0.f);
            else att_qk<4, 128, 2, false, false>(kb, L, qf, pf, lsum, c1, 0.f, gtab, dq16, nullptr, 0.f);
            asm volatile("s_waitcnt lgkmcnt(0)" ::: "memory"); ATT_BAR();
        }
        const float lc = lsum + __shfl_xor(lsum, 32);
        const float invl = lc > 0.f ? 1.0f / lc : 0.f;
        float dummy = 0.f;
        for (int nt = 0; nt < ntc; ++nt) {
            att_stage<8>(kb, csrc(kcb, nt * 64), rc, wid);
            att_stage<8>(vb, csrc(vcb, nt * 64), rc, wid);
            asm volatile("s_waitcnt vmcnt(0)" ::: "memory"); ATT_BAR();
            const int dq16 = t0 + q - 31 - 1024 * nt - 64 * hh;
            LDSP float* improw = imp + q * 129 + 16 * nt + hh;
            if (t0 - 31 - 16 * (nt * 64 + 63) >= 1023) att_qk<4, 128, 0, true, true>(kb, L, qf, pf, dummy, c1, cfar, 0u, 0, improw, invl * 524288.0f);
            else att_qk<4, 128, 2, true, true>(kb, L, qf, pf, dummy, c1, 0.f, gtab, dq16, improw, invl * 524288.0f);
            att_pv<2, 128>(vb, L, pf, o);
            asm volatile("s_waitcnt lgkmcnt(0)" ::: "memory"); ATT_BAR();
        }
        const float sc = gc * invl;
#pragma unroll
        for (int dt = 0; dt < 2; ++dt)
#pragma unroll
            for (int r = 0; r < 16; ++r) { of[dt][r] = o[dt][r] * sc; o[dt][r] = 0.f; }
    }
    __syncthreads();
    {
        unsigned u0 = 0u, u1 = 0u, u2 = 0u, u3 = 0u;
        for (int i = 0; i < 8; ++i) {
            const int tok = wid * 8 + i;
            const unsigned v0 = ((LDSP const unsigned*)imp)[tok * 129 + lane], v1 = ((LDSP const unsigned*)imp)[tok * 129 + 64 + lane];
            const int j0 = lane, j1 = lane + 64;
            const bool f0 = (j0 == 0) || (j0 == blk_t) || (j0 == blk_t - 1), f1 = (j1 == blk_t) || (j1 == blk_t - 1);
            unsigned k0 = f0 ? (0xFFFFFF80u | (unsigned)(127 - j0)) : (j0 <= blk_t ? ((v0 << 7) | (unsigned)(127 - j0)) : 0u);
            unsigned k1 = f1 ? (0xFFFFFF80u | (unsigned)(127 - j1)) : (j1 <= blk_t ? ((v1 << 7) | (unsigned)(127 - j1)) : 0u);
            unsigned thr = 0u;
#pragma unroll 1
            for (int bit = 31; bit >= 0; --bit) {
                const unsigned cand = thr | (1u << bit);
                const int c = __popcll(__ballot(k0 >= cand)) + __popcll(__ballot(k1 >= cand));
                thr = (c >= 16) ? cand : thr;
            }
            thr = thr ? thr : 1u;
            const unsigned long long b0 = __ballot(k0 >= thr), b1 = __ballot(k1 >= thr);
            const unsigned m0 = (unsigned)b0, m1 = (unsigned)(b0 >> 32), m2 = (unsigned)b1, m3 = (unsigned)(b1 >> 32);
            if (lane == 0) { sel[tok * 4 + 0] = m0; sel[tok * 4 + 1] = m1; sel[tok * 4 + 2] = m2; sel[tok * 4 + 3] = m3; }
            u0 |= m0; u1 |= m1; u2 |= m2; u3 |= m3;
        }
        if (lane == 0) { un[wid * 4 + 0] = u0; un[wid * 4 + 1] = u1; un[wid * 4 + 2] = u2; un[wid * 4 + 3] = u3; }
    }
    __syncthreads();
    {
        unsigned uw[4];
#pragma unroll
        for (int k = 0; k < 4; ++k) uw[k] = (unsigned)__builtin_amdgcn_readfirstlane((int)(un[k] | un[4 + k] | un[8 + k] | un[12 + k]));
        if (tid < 128) {
            const int k = tid >> 5, jb = tid & 31;
            unsigned wv = 0u; int below = 0;
#pragma unroll
            for (int kk = 0; kk < 4; ++kk) { if (kk == k) wv = uw[kk]; if (kk < k) below += __popc(uw[kk]); }
            if ((wv >> jb) & 1u) blist[below + __popc(wv & ((1u << jb) - 1u))] = (unsigned short)tid;
        }
        const int nb = __popc(uw[0]) + __popc(uw[1]) + __popc(uw[2]) + __popc(uw[3]);
        unsigned sq[4];
#pragma unroll
        for (int k = 0; k < 4; ++k) sq[k] = sel[q * 4 + k];
        __syncthreads();
        const bf16_t* ksb = pb + 768 + kvh * 64;
        auto ssrc = [&](int pos0, int colo) { return [=](int row, int gcx) { return ksb + (size_t)(pos0 + row) * 2840 + colo + gcx * 8; }; };
        float lsum = 0.f;
        att_stage<8>(kb, ssrc(64 * (int)blist[0], 0), rc, wid);
        for (int i = 0; i < nb; ++i) {
            const int j = __builtin_amdgcn_readfirstlane((int)blist[i]), pos0 = 64 * j;
            asm volatile("s_waitcnt vmcnt(0)" ::: "memory"); ATT_BAR();
            att_stage<8>(vb, ssrc(pos0, 128), rc, wid);
            unsigned sw = 0u;
#pragma unroll
            for (int k = 0; k < 4; ++k) if ((j >> 5) == k) sw = sq[k];
            const bool selq = (sw >> (j & 31)) & 1u;
            if (t0 - (pos0 + 63) >= 1023) att_qk<4, 128, 0, true, false>(kb, L, qf, pf, lsum, c1, selq ? cfar : ATT_NEG, 0u, 0, nullptr, 0.f);
            else {
                int dq = t0 + q - pos0 - 4 * hh; dq = dq > 1087 ? 1087 : dq; dq = (dq < -1 || !selq) ? -1 : dq;
                att_qk<4, 128, 1, true, false>(kb, L, qf, pf, lsum, c1, 0.f, gtab + (unsigned)(dq + 1) * 4u, 0, nullptr, 0.f);
            }
            asm volatile("s_waitcnt vmcnt(0) lgkmcnt(0)" ::: "memory"); ATT_BAR();
            if (i + 1 < nb) att_stage<8>(kb, ssrc(64 * (int)blist[i + 1], 0), rc, wid);
            att_pv<2, 128>(vb, L, pf, o);
        }
        const float ls = lsum + __shfl_xor(lsum, 32);
        const float sc = gs / ls;
#pragma unroll
        for (int dt = 0; dt < 2; ++dt)
#pragma unroll
            for (int r = 0; r < 16; ++r) { of[dt][r] += o[dt][r] * sc; o[dt][r] = 0.f; }
    }
    {
        const bf16_t* kwb = pb + 1024 + kvh * 64;
        auto wsrc = [&](int pos0, int colo) { return [=](int row, int gcx) { const int pos = pos0 + row; return (pos >= 0 && pos < SEQ) ? kwb + (size_t)pos * 2840 + colo + gcx * 8 : zr + gcx * 8; }; };
        float lsum = 0.f;
        asm volatile("s_waitcnt lgkmcnt(0)" ::: "memory"); ATT_BAR();
        att_stage<8>(kb, wsrc(t0 - 512, 0), rc, wid);
        for (int i = 0; i < 9; ++i) {
            const int pos0 = t0 - 512 + 64 * i;
            asm volatile("s_waitcnt vmcnt(0)" ::: "memory"); ATT_BAR();
            att_stage<8>(vb, wsrc(pos0, 128), rc, wid);
            int dq = t0 + q - pos0 - 4 * hh; dq = dq < -1 ? -1 : dq;
            att_qk<4, 128, 1, true, false>(kb, L, qf, pf, lsum, c1, 0.f, wtab + (unsigned)(dq + 1) * 4u, 0, nullptr, 0.f);
            asm volatile("s_waitcnt vmcnt(0) lgkmcnt(0)" ::: "memory"); ATT_BAR();
            if (i + 1 < 9) att_stage<8>(kb, wsrc(pos0 + 64, 0), rc, wid);
            att_pv<2, 128>(vb, L, pf, o);
        }
        const float lw = lsum + __shfl_xor(lsum, 32);
        const float sc = gw / lw;
#pragma unroll
        for (int dt = 0; dt < 2; ++dt)
#pragma unroll
            for (int r = 0; r < 16; ++r) of[dt][r] += o[dt][r] * sc;
    }
    bf16_t* op = p.o + rowq * DM + head * 64 + 4 * hh;
    ATT_STORE_O(op, of, 1.0f);
}

#define MG_CNT 8192
#define MG_BASE 8320
#define MG_ENT 8448
__device__ __forceinline__ void st_moba_gate(const P& p, int wg, int nwg, LDSP char* lds) {
    const int tid = otid();
    const int wid = tid >> 6, lane = tid & 63, q = lane & 31, hh = lane >> 5;
    LDSP char* kmt = lds; LDSP int* lcnt = (LDSP int*)(lds + MG_CNT); LDSP int* lbase = (LDSP int*)(lds + MG_BASE); LDSP int* ent = (LDSP int*)(lds + MG_ENT);
    AttLane L; att_lane_init<128, 128, 2>(L, lane);
    int rc[1]; att_stage_map<8>(rc, tid);
    const bf16_t* zr = p.zrow;
    for (int item = wg; item < 1024; item += nwg) {
        const int tile = item >> 4, b = (item >> 3) & 1, h = item & 7, t0 = tile * 128, own = t0 >> 8, tw = t0 + wid * 32, bh = b * 8 + h;
        if (own == 0) continue;
        __syncthreads();
        if (tid < 32) lcnt[tid] = 0;
        bf16x8 qf[4];
        {
            const bf16_t* qp = p.proj + (size_t)(b * SEQ + tw + q) * 2840 + 1304 + h * 64 + 8 * hh;
#pragma unroll
            for (int ks = 0; ks < 4; ++ks) qf[ks] = *(const bf16x8*)(qp + 16 * ks);
        }
        const bf16_t* kmb = p.kmeanb + (size_t)(bh * 32) * 64;
        att_stage<8>(kmt, [=](int row, int gcx) { return row < 32 ? kmb + (size_t)row * 64 + gcx * 8 : zr + gcx * 8; }, rc, wid);
        asm volatile("s_waitcnt vmcnt(0)" ::: "memory");
        __syncthreads();
        f32x16 s;
#pragma unroll
        for (int r = 0; r < 16; ++r) s[r] = 0.f;
#pragma unroll
        for (int ks = 0; ks < 4; ++ks) {
            const bf16x8 a = *(const LDSP bf16x8*)(kmt + (L.kbase ^ (32 * (ks & 3))));
            s = __builtin_amdgcn_mfma_f32_32x32x16_bf16(a, qf[ks], s, 0, 0, 0);
        }
        unsigned key[16];
#pragma unroll
        for (int r = 0; r < 16; ++r) {
            const int j = (r & 3) + 8 * (r >> 2) + 4 * hh;
            const unsigned bits = __float_as_uint(s[r]);
            const unsigned srt = (bits & 0x80000000u) ? ~bits : (bits | 0x80000000u);
            key[r] = (j < own) ? ((srt & ~31u) | (unsigned)(31 - j)) : 0u;
        }
        unsigned selm = 0u;
#pragma unroll 1
        for (int rnd = 0; rnd < 3; ++rnd) {
            unsigned m = 0u;
#pragma unroll
            for (int r = 0; r < 16; ++r) m = key[r] > m ? key[r] : m;
            const unsigned mo = (unsigned)__shfl_xor((int)m, 32);
            const unsigned wk = mo > m ? mo : m;
            if (wk != 0u) selm |= 1u << (31 - (wk & 31u));
#pragma unroll
            for (int r = 0; r < 16; ++r) key[r] = (key[r] == wk) ? 0u : key[r];
        }
        if (hh == 0) {
            unsigned mm = selm;
#pragma unroll
            for (int sI = 0; sI < 3; ++sI) {
                int en = -1;
                if (mm) { const int j = __builtin_ctz(mm); mm &= mm - 1u; const int lp = __hip_atomic_fetch_add(lcnt + j, 1, __ATOMIC_RELAXED, __HIP_MEMORY_SCOPE_WORKGROUP); en = (j << 8) | lp; }
                ent[(wid * 32 + q) * 3 + sI] = en;
            }
        }
        __syncthreads();
        if (tid < 32) { const int c = lcnt[tid]; lbase[tid] = c ? atomicAdd(p.mcnt + bh * 32 + tid, c) : 0; }
        __syncthreads();
        for (int e = tid; e < 384; e += 256) {
            const int en = ent[e];
            if (en >= 0) { const int j = en >> 8, tokl = e / 3, sI = e - tokl * 3; p.mlist[(size_t)(bh * 32 + j) * 8192 + lbase[j] + (en & 255)] = (unsigned short)((t0 + tokl) | (sI << 13)); }
        }
    }
}
__device__ __forceinline__ bf16_t* moba_part(const P& p, int slot, size_t row) { return (slot < 2 ? p.mp01 + (size_t)slot * 131072 * 64 : p.mp2) + row * 64; }

__device__ __forceinline__ void moba_inv_item(const P& p, const int lid, const int chunk, LDSP char* lds, const int tid0) {
    LDSP char* kb = lds; LDSP char* vb = lds + 8192; LDSP float* glut = (LDSP float*)(lds + A0_GLUT);
    const float c1 = 0.125f * LOG2E;
    int tid = tid0; asm volatile("" : "+v"(tid));
    const int wid = tid >> 6, lane = tid & 63, q = lane & 31, hh = lane >> 5;
    const int bh = lid / 31, j = lid - bh * 31, b = bh >> 3, h = bh & 7;
    build_lut(glut, p.blut + h * 1024, 1152, 1 << 30, tid);
    AttLane L; att_lane_init<128, 128, 2>(L, lane);
    int rc[1]; att_stage_map<8>(rc, tid);
    const int n = p.mcnt[bh * 32 + j], idx = chunk * 128 + wid * 32 + q;
    const bool valid = idx < n;
    const unsigned en = valid ? (unsigned)p.mlist[(size_t)(bh * 32 + j) * 8192 + idx] : (unsigned)(256 * (j + 1));
    const int tok = (int)(en & 8191u), slot = (int)(en >> 13);
    bf16x8 qf[4];
    {
        const bf16_t* qp = p.proj + (size_t)(b * SEQ + tok) * 2840 + 1304 + h * 64 + 8 * hh;
#pragma unroll
        for (int ks = 0; ks < 4; ++ks) qf[ks] = *(const bf16x8*)(qp + 16 * ks);
    }
    const unsigned gtab = (unsigned)(size_t)glut;
    const bf16_t* kbb = p.proj + (size_t)b * SEQ * 2840 + 1816 + h * 64;
    auto msrc = [&](int pos0, int colo) { return [=](int row, int gcx) { return kbb + (size_t)(pos0 + row) * 2840 + colo + gcx * 8; }; };
    f32x16 o[2];
#pragma unroll
    for (int dt = 0; dt < 2; ++dt)
#pragma unroll
        for (int r = 0; r < 16; ++r) o[dt][r] = 0.f;
    float lsum = 0.f;
    bf16x8 pf[4];
    __syncthreads();
    att_stage<8>(kb, msrc(256 * j, 0), rc, wid);
    for (int i = 0; i < 4; ++i) {
        const int pos0 = 256 * j + 64 * i;
        asm volatile("s_waitcnt vmcnt(0)" ::: "memory"); ATT_BAR();
        att_stage<8>(vb, msrc(pos0, 512), rc, wid);
        {
            int dq = tok - pos0 - 4 * hh; dq = dq > 1087 ? 1087 : dq; dq = valid ? dq : -1;
            att_qk<4, 128, 1, true, false>(kb, L, qf, pf, lsum, c1, 0.f, gtab + (unsigned)(dq + 1) * 4u, 0, nullptr, 0.f);
        }
        asm volatile("s_waitcnt vmcnt(0) lgkmcnt(0)" ::: "memory"); ATT_BAR();
        if (i + 1 < 4) att_stage<8>(kb, msrc(pos0 + 64, 0), rc, wid);
        att_pv<2, 128>(vb, L, pf, o);
    }
    const float lt = lsum + __shfl_xor(lsum, 32);
    if (valid) {
        const size_t row = (size_t)bh * SEQ + tok;
        bf16_t* op = moba_part(p, slot, row) + 4 * hh;
        ATT_STORE_O(op, o, 1.0f);
        if (hh == 0) p.mpl[(size_t)slot * 131072 + row] = lt;
    }
}
__device__ __forceinline__ void moba_own_item(const P& p, const int item, LDSP char* lds, const int tid0) {
    LDSP char* kb = lds; LDSP char* vb = lds + 8192; LDSP float* glut = (LDSP float*)(lds + A0_GLUT);
    const float c1 = 0.125f * LOG2E;
    int tid = tid0; asm volatile("" : "+v"(tid));
    const int wid = tid >> 6, lane = tid & 63, q = lane & 31, hh = lane >> 5;
    const int tile = item >> 4, b = (item >> 3) & 1, h = item & 7, t0 = tile * 128, own = t0 >> 8, tw = t0 + wid * 32, bh = b * 8 + h;
    __syncthreads();
    build_lut(glut, p.blut + h * 1024, 1152, 1 << 30, tid);
    AttLane L; att_lane_init<128, 128, 2>(L, lane);
    int rc[1]; att_stage_map<8>(rc, tid);
    const size_t rowq = (size_t)(b * SEQ + tw + q);
    bf16x8 qf[4];
    {
        const bf16_t* qp = p.proj + rowq * 2840 + 1304 + h * 64 + 8 * hh;
#pragma unroll
        for (int ks = 0; ks < 4; ++ks) qf[ks] = *(const bf16x8*)(qp + 16 * ks);
    }
    const unsigned gtab = (unsigned)(size_t)glut;
    const bf16_t* kbb = p.proj + (size_t)b * SEQ * 2840 + 1816 + h * 64;
    auto msrc = [&](int pos0, int colo) { return [=](int row, int gcx) { return kbb + (size_t)(pos0 + row) * 2840 + colo + gcx * 8; }; };
    f32x16 o[2];
#pragma unroll
    for (int dt = 0; dt < 2; ++dt)
#pragma unroll
        for (int r = 0; r < 16; ++r) o[dt][r] = 0.f;
    float lsum = 0.f;
    bf16x8 pf[4];
    const int nb = (((t0 + 127) >> 6) & 3) + 1;
    __syncthreads();
    att_stage<8>(kb, msrc(256 * own, 0), rc, wid);
    for (int i = 0; i < nb; ++i) {
        const int pos0 = 256 * own + 64 * i;
        asm volatile("s_waitcnt vmcnt(0)" ::: "memory"); ATT_BAR();
        att_stage<8>(vb, msrc(pos0, 512), rc, wid);
        const bool active = pos0 <= tw + 31;
        if (active) {
            int dq = tw + q - pos0 - 4 * hh; dq = dq < -1 ? -1 : dq;
            att_qk<4, 128, 1, true, false>(kb, L, qf, pf, lsum, c1, 0.f, gtab + (unsigned)(dq + 1) * 4u, 0, nullptr, 0.f);
        }
        asm volatile("s_waitcnt vmcnt(0) lgkmcnt(0)" ::: "memory"); ATT_BAR();
        if (i + 1 < nb) att_stage<8>(kb, msrc(pos0 + 64, 0), rc, wid);
        if (active) att_pv<2, 128>(vb, L, pf, o);
    }
    float lt = lsum + __shfl_xor(lsum, 32);
    const int npick = own < 3 ? own : 3;
    const size_t row = (size_t)bh * SEQ + tw + q;
#pragma unroll 1
    for (int sI = 0; sI < npick; ++sI) {
        lt += p.mpl[(size_t)sI * 131072 + row];
        const bf16_t* pp = moba_part(p, sI, row) + 4 * hh;
#pragma unroll
        for (int dt = 0; dt < 2; ++dt)
#pragma unroll
            for (int rq = 0; rq < 4; ++rq) {
                const u32x2 w = *(const u32x2*)(pp + 32 * dt + 8 * rq);
                o[dt][4 * rq] += __uint_as_float(w[0] << 16); o[dt][4 * rq + 1] += __uint_as_float(w[0] & 0xffff0000u);
                o[dt][4 * rq + 2] += __uint_as_float(w[1] << 16); o[dt][4 * rq + 3] += __uint_as_float(w[1] & 0xffff0000u);
            }
    }
    const float inv = 1.0f / lt;
    bf16_t* op = p.o + rowq * DM + 512 + h * 64 + 4 * hh;
    ATT_STORE_O(op, o, inv);
}
__device__ __forceinline__ void st_moba_own(const P& p, int wg, int nwg, LDSP char* lds) {
    const int tid0 = otid();
    for (int item = wg; item < 1024; item += nwg) moba_own_item(p, item, lds, tid0);
}
#define A0_PRE 62736
__device__ __forceinline__ void st_attn0(const P& p, LDSP char* lds) {
    const int tid0 = otid();
    LDSP int* slot = (LDSP int*)(lds + A0_SLOT); LDSP int* pre = (LDSP int*)(lds + A0_PRE);
    LDSP int* tmp = (LDSP int*)lds;
    for (int i = tid0; i < 496; i += 256) { const int bh = i / 31, j = i - bh * 31; tmp[i] = (p.mcnt[bh * 32 + j] + 127) >> 7; }
    __syncthreads();
    for (int i = tid0; i < 497; i += 256) { int s = 0; for (int k = 0; k < i; ++k) s += tmp[k]; pre[i] = s; }
    __syncthreads();
    const int ninv = pre[496];
    for (;;) {
        const int item = wq_next(p.wq + 1, slot, tid0);
        const int ntail = 5 * 768 + (ninv > 3072 ? ninv - 3072 : 0);
        if (item >= 1024 + ntail) break;
        if (item < 1024) nsa_item(p, item, lds, tid0);
        else {
            const int r = item - 1024, g = r / 5, ps = r - g * 5;
            if (g < 768 && ps == 4) { moe_conv_item(p, 0, g, lds, tid0); continue; }
            const int idx = (g < 768) ? g * 4 + ps : 3072 + (r - 5 * 768);
            if (idx >= ninv) continue;
            int lo = 0, hi = 495;
            while (lo < hi) { const int mid = (lo + hi + 1) >> 1; if (pre[mid] <= idx) lo = mid; else hi = mid - 1; }
            moba_inv_item(p, lo, idx - pre[lo], lds, tid0);
        }
    }
}

#define XB_TMO      128
#define XB_XCNT(j)  (256  + 64 * (j))
#define XB_XSUB(j)  (1280 + 64 * (j))
#define XB_XGEN(j)  (2304 + 64 * (j))
#define XB_TOP      3328
#define XB_TOPGEN   3392
#define XCD_BAR_WORDS 3456
#define XB_SPIN_CAP (1u << 20)
#define LAS __attribute__((address_space(3)))

__device__ __forceinline__ unsigned xb_ld(unsigned* p)              { return __hip_atomic_load(p, __ATOMIC_RELAXED, __HIP_MEMORY_SCOPE_AGENT); }
__device__ __forceinline__ unsigned xb_add(unsigned* p, unsigned v) { return __hip_atomic_fetch_add(p, v, __ATOMIC_RELAXED, __HIP_MEMORY_SCOPE_AGENT); }
__device__ __forceinline__ unsigned xb_xcc_id() { return (unsigned)__builtin_amdgcn_s_getreg((3 << 11) | 20) & 0xFu; }
#define XB_SPIN(cond, bar) do { unsigned _sp = 0; while (cond) { __builtin_amdgcn_s_sleep(1); \
    if ((++_sp & 255u) == 0u) { if (xb_ld(&(bar)[XB_TMO])) break; if (_sp > XB_SPIN_CAP) { atomicAdd(&(bar)[XB_TMO], 1u); break; } } } } while (0)

struct XcdBarrier {
    unsigned* bar; unsigned x;
    volatile LAS unsigned* st;
};

__device__ __forceinline__ XcdBarrier xcd_barrier_post(unsigned* bar, volatile LAS unsigned* st) {
    XcdBarrier b; b.bar = bar; b.x = xb_xcc_id(); b.st = st;
    if (threadIdx.x == 0) (void)xb_add(&bar[XB_XCNT(b.x)], 1u);
    return b;
}
__device__ __forceinline__ void xcd_barrier_complete(unsigned* bar, unsigned x, unsigned& nloc, unsigned& nx) {
    const unsigned G = gridDim.x * gridDim.y * gridDim.z;
    unsigned sum, cnt, mine, sp = 0u;
    for (;;) {
        sum = 0u; cnt = 0u; mine = 0u;
#pragma unroll
        for (unsigned j = 0; j < 16; ++j) { const unsigned c = xb_ld(&bar[XB_XCNT(j)]); sum += c; cnt += (c > 0u) ? 1u : 0u; mine = (j == x) ? c : mine; }
        if (sum == G) break;
        __builtin_amdgcn_s_sleep(1);
        if ((++sp & 255u) == 0u) { if (xb_ld(&bar[XB_TMO])) break; if (sp > XB_SPIN_CAP) { atomicAdd(&bar[XB_TMO], 1u); break; } }
    }
    nloc = mine > 0u ? mine : 1u; nx = cnt > 0u ? cnt : 1u;
}

__device__ __forceinline__ void xcd_barrier(const XcdBarrier& b) {
    asm volatile("s_waitcnt vmcnt(0)" ::: "memory");
    __syncthreads();
    if (threadIdx.x == 0) {
        unsigned* bar = b.bar;
        __builtin_amdgcn_s_waitcnt(0);
        unsigned nloc = b.st[0], nx = b.st[1];
        if (nloc == 0u) { xcd_barrier_complete(bar, b.x, nloc, nx); b.st[0] = nloc; b.st[1] = nx; }
        const unsigned old = xb_add(&bar[XB_XSUB(b.x)], 1u);
        const unsigned gen = old / nloc;
        if (old + 1u == (gen + 1u) * nloc) {
            __builtin_amdgcn_fence(__ATOMIC_RELEASE, "agent");
            asm volatile("s_waitcnt vmcnt(0)" ::: "memory");
            const unsigned og = xb_add(&bar[XB_TOP], 1u);
            const unsigned tg = og / nx;
            if (og + 1u == (tg + 1u) * nx) xb_add(&bar[XB_TOPGEN], 1u);
            else XB_SPIN(xb_ld(&bar[XB_TOPGEN]) == tg, bar);
            __builtin_amdgcn_fence(__ATOMIC_ACQUIRE, "agent");
            xb_add(&bar[XB_XGEN(b.x)], 1u);
            asm volatile("s_waitcnt vmcnt(0)" ::: "memory");
        } else {
            XB_SPIN(xb_ld(&bar[XB_XGEN(b.x)]) == gen, bar);
            __builtin_amdgcn_fence(__ATOMIC_ACQUIRE, "agent");
            asm volatile("s_waitcnt vmcnt(0)" ::: "memory");
        }
    }
    __syncthreads();
}


#define PHASE_SYNC() do { PP qb_ = (PP)__builtin_amdgcn_kernarg_segment_ptr(); asm volatile("" : "+s"(qb_)); XcdBarrier b_; b_.bar = qb_->bar; b_.x = xb_xcc_id(); \
        b_.st = (volatile LAS unsigned*)(dlds + BAR_LDS_OFF); xcd_barrier(b_); } while (0)
typedef const __attribute__((address_space(4))) P* PP;
#define BAR_SAVE() const unsigned bs0_ = __builtin_amdgcn_readfirstlane(*(volatile LAS unsigned*)(dlds + BAR_LDS_OFF)), \
        bs1_ = __builtin_amdgcn_readfirstlane(*(volatile LAS unsigned*)(dlds + BAR_LDS_OFF + 4)); __syncthreads()
#define BAR_RESTORE() do { __syncthreads(); if (threadIdx.x == 0) { *(volatile LAS unsigned*)(dlds + BAR_LDS_OFF) = bs0_; *(volatile LAS unsigned*)(dlds + BAR_LDS_OFF + 4) = bs1_; } } while (0)
#define PHASE_ARGS() PP q_ = (PP)__builtin_amdgcn_kernarg_segment_ptr(); int wg = blockIdx.x, nwg = gridDim.x; asm volatile("" : "+s"(q_), "+s"(wg), "+s"(nwg)); P p; { const __attribute__((address_space(4))) unsigned long long* s64_ = (const __attribute__((address_space(4))) unsigned long long*)q_; void** d64_ = (void**)&p; _Pragma("unroll") for (int i_ = 0; i_ < (int)(sizeof(P) / 8); ++i_) d64_[i_] = (void*)(__attribute__((address_space(1))) void*)s64_[i_]; } float* sm = (float*)dlds; LDSP char* lds = (LDSP char*)dlds; (void)sm; (void)lds
__global__ void __launch_bounds__(256, 2) k_mega(P pk) {
    extern __shared__ __attribute__((aligned(16))) unsigned char dlds[];
    if (threadIdx.x == 0) *(uint4*)(dlds + BAR_LDS_OFF) = make_uint4(0u, 0u, 0u, 0u);
    __syncthreads();
    (void)xcd_barrier_post(pk.bar, (volatile LAS unsigned*)(dlds + BAR_LDS_OFF));
    { PHASE_ARGS(); st_prologue(p, wg, nwg, sm); st_convert(p, wg, nwg, sm); } PHASE_SYNC();
    { PHASE_ARGS(); st_norm<0>(p, 0, wg, nwg, sm); st_c1_reduce(p, wg, nwg); } PHASE_SYNC();
    { PHASE_ARGS(); BAR_SAVE(); st_inproj0_mf<6>(p, wg, nwg, lds); BAR_RESTORE(); } PHASE_SYNC();
    { PHASE_ARGS(); st_cmp1_mf(p, wg, nwg, lds); st_kmean(p, wg, nwg, sm); } PHASE_SYNC();
    { PHASE_ARGS(); st_cmp2_mf(p, wg, nwg, lds); st_moba_gate(p, wg, nwg, lds); } PHASE_SYNC();
    { PHASE_ARGS(); st_attn0(p, lds); } PHASE_SYNC();
    { PHASE_ARGS(); st_moba_own(p, wg, nwg, lds); } PHASE_SYNC();
    { PHASE_ARGS(); st_outproj_mf<4>(p, 0, wg, nwg, lds); } PHASE_SYNC();
    { PHASE_ARGS(); st_norm<1>(p, 0, wg, nwg, sm); } PHASE_SYNC();
    { PHASE_ARGS(); BAR_SAVE(); st_moe_up_mf<6>(p, 0, wg, nwg, lds); BAR_RESTORE(); } PHASE_SYNC();
    { PHASE_ARGS(); BAR_SAVE(); st_moe_down_mf<6>(p, 0, wg, nwg, lds); BAR_RESTORE(); } PHASE_SYNC();
    { PHASE_ARGS(); st_norm<2>(p, 1, wg, nwg, sm); } PHASE_SYNC();
    { PHASE_ARGS(); BAR_SAVE(); st_inproj1_mf<6>(p, wg, nwg, lds); BAR_RESTORE(); } PHASE_SYNC();
    { PHASE_ARGS(); st_mla_prep(p, wg, nwg); } PHASE_SYNC();
    { PHASE_ARGS(); st_mla_up_mf(p, wg, nwg, lds); } PHASE_SYNC();
    { PHASE_ARGS(); st_attn1(p, lds); } PHASE_SYNC();
    { PHASE_ARGS(); st_mla_combine(p, wg, nwg); } PHASE_SYNC();
    { PHASE_ARGS(); st_outproj_mf<4>(p, 1, wg, nwg, lds); } PHASE_SYNC();
    { PHASE_ARGS(); st_norm<1>(p, 1, wg, nwg, sm); } PHASE_SYNC();
    { PHASE_ARGS(); BAR_SAVE(); st_moe_up_mf<6>(p, 1, wg, nwg, lds); BAR_RESTORE(); } PHASE_SYNC();
    { PHASE_ARGS(); BAR_SAVE(); st_moe_down_mf<6>(p, 1, wg, nwg, lds); BAR_RESTORE(); } PHASE_SYNC();
    { PHASE_ARGS(); st_norm<3>(p, 1, wg, nwg, sm); }
}

extern "C" void kernel_launch(void* const* d_in, const int* in_sizes, int n_in, void* d_out, int out_size, void* d_ws, size_t ws_size,
                              hipStream_t stream) {
    (void)in_sizes; (void)n_in; (void)out_size; (void)ws_size;
    P p{};
    const float* const* in = (const float* const*)d_in;
    p.x = in[0]; p.c = in[1]; p.rel = in[2]; p.router_w = in[3]; p.router_b = in[4]; p.final_norm = in[5]; p.norm_mix = in[6]; p.norm_ffn = in[7];
    p.ada_w = in[8]; p.ada_b = in[9]; p.moe_wg = in[10]; p.moe_wu = in[11]; p.moe_wd = in[12]; p.ev_w_in = in[13]; p.ev_w_out = in[14];
    p.pos_k = in[15]; p.pos_v = in[16]; p.ck_w1 = in[17]; p.ck_w2 = in[18]; p.cv_w1 = in[19]; p.cv_w2 = in[20]; p.od_w_in = in[21]; p.od_w_out = in[22];
    p.q_norm = in[23]; p.kv_norm = in[24]; p.w_q_up = in[25]; p.w_kv_up = in[26]; p.sinks = in[27];
    p.out = (float*)d_out;
    char* ws = (char*)d_ws; size_t off = 0;
    auto take = [&](size_t bytes) { char* r = ws + off; off += (bytes + 255) & ~(size_t)255; return r; };
    p.bar = (unsigned*)take(16384);
    p.cnt = (int*)take(4096);
    p.wq = (int*)take(256);
    p.mcnt = (int*)take(512 * 4);
    p.modv = (float*)take(2 * 2 * 6144 * 4);
    p.zrow = (bf16_t*)take(256);
    const size_t zero_bytes = off;
    p.ropec = (float*)take(SEQ * 32 * 4); p.ropes = (float*)take(SEQ * 32 * 4);
    p.blut = (float*)take(8 * 1024 * 4);
    p.gates = (float*)take((size_t)T_TOK * 24 * 4);
    p.kmean = (float*)take(2 * 8 * 32 * 64 * 4);
    p.tokw = (float*)take((size_t)T_TOK * 2 * 4);
    p.list = (int*)take((size_t)16 * T_TOK * 4);
    p.cqn = (bf16_t*)take((size_t)T_TOK * 384 * 2);
    p.krope = (bf16_t*)take((size_t)T_TOK * 64 * 2);
    p.h = (bf16_t*)take((size_t)T_TOK * DM * 2);
    p.o = (bf16_t*)take((size_t)T_TOK * DM * 2);
    p.mlap = p.h;
    p.mlal = (float*)(p.h + (size_t)2 * 8 * (SEQ / 2) * 128);
    p.mp01 = p.h;
    p.mp2 = (bf16_t*)take((size_t)131072 * 64 * 2);
    p.mpl = (float*)take((size_t)3 * 131072 * 4);
    p.mlist = (unsigned short*)take((size_t)16 * 32 * 8192 * 2);
    p.hid = p.o;
    char* region = take((size_t)100 * 1024 * 1024);
    p.proj = (bf16_t*)region;
    p.proj1 = (bf16_t*)region;
    p.qmla = (bf16_t*)(region + (size_t)T_TOK * 1216 * 2);
    p.kvmla = (bf16_t*)(region + (size_t)T_TOK * (1216 + 768) * 2);
    p.y = (bf16_t*)region;
    p.xr1 = (bf16_t*)d_out;
    p.xr2 = (bf16_t*)((char*)d_out + (size_t)T_TOK * DM * 2);
    p.xr3 = (bf16_t*)(region + (size_t)2 * T_TOK * DM * 2);
    p.chidb = (bf16_t*)take((size_t)2 * 2048 * 256 * 2);
    p.kcmpb = (bf16_t*)take((size_t)8 * 512 * 64 * 2);
    p.kmeanb = (bf16_t*)take((size_t)2 * 8 * 32 * 64 * 2);
    p.c1 = (float*)take(512 * 4);
    p.c1p = (float*)take((size_t)2 * 64 * 256 * 4);
    p.wt_gu = (bf16_t*)take((size_t)32 * 1024 * 1024 * 2);
    p.wt_d = (bf16_t*)take((size_t)32 * 1024 * 512 * 2);
    p.wt_in0 = (bf16_t*)take((size_t)2840 * 1024 * 2);
    p.wt_out0 = (bf16_t*)take((size_t)1024 * 1024 * 2);
    p.wt_c1 = (bf16_t*)take((size_t)2 * 256 * 2048 * 2);
    p.wt_c2 = (bf16_t*)take((size_t)2 * 64 * 256 * 2);
    p.wt_in1 = (bf16_t*)take((size_t)1216 * 1024 * 2);
    p.wt_out1 = (bf16_t*)take((size_t)1024 * 1024 * 2);
    p.wt_qup = (bf16_t*)take((size_t)768 * 256 * 2);
    p.wt_kvup = (bf16_t*)take((size_t)1024 * 128 * 2);
    static int grid = 0;
    if (!grid) {
        int dev = 0, cus = 0, per_cu = 0;
        (void)hipGetDevice(&dev);
        (void)hipDeviceGetAttribute(&cus, hipDeviceAttributeMultiprocessorCount, dev);
        (void)hipFuncSetAttribute((const void*)k_mega, hipFuncAttributeMaxDynamicSharedMemorySize, KERNEL_LDS_BYTES);
        (void)hipOccupancyMaxActiveBlocksPerMultiprocessor(&per_cu, k_mega, 256, KERNEL_LDS_BYTES);
        if (cus <= 0) cus = 256;
        if (per_cu < 1) per_cu = 1;
        grid = cus * (per_cu < 2 ? per_cu : 2);
    }
    (void)hipMemsetAsync(d_ws, 0, zero_bytes, stream);
    hipLaunchKernelGGL(k_mega, dim3(grid), dim3(256), KERNEL_LDS_BYTES, stream, p);
}
```

```cpp
#include <hip/hip_runtime.h>
#include <stdint.h>

typedef unsigned u32x2n __attribute__((ext_vector_type(2)));
#define T_TOK 16384
#define SEQ 8192
#define DM 1024
#define NEGF (-1e30f)
#define BIGF (1e30f)

typedef unsigned short bf16_t;

__device__ __forceinline__ float bf2f(bf16_t v) { return __uint_as_float(((unsigned)v) << 16); }
__device__ __forceinline__ bf16_t f2bf(float f) {
    unsigned u = __float_as_uint(f);
    u += 0x7fffu + ((u >> 16) & 1u);
    return (bf16_t)(u >> 16);
}
typedef __bf16 bf16x2_t __attribute__((ext_vector_type(2)));
typedef float f32x2_t __attribute__((ext_vector_type(2)));
__device__ __forceinline__ unsigned cvtpk(float lo, float hi) { const f32x2_t f = {lo, hi}; return __builtin_bit_cast(unsigned, __builtin_convertvector(f, bf16x2_t)); }
__device__ __forceinline__ unsigned cvtpk_valu(float lo, float hi) { unsigned r; asm("s_nop 0\n\tv_cvt_pk_bf16_f32 %0, %1, %2" : "=v"(r) : "v"(lo), "v"(hi)); return r; }
__device__ __forceinline__ float wsum(float v) {
    v += __builtin_bit_cast(float, __builtin_amdgcn_update_dpp(0, __builtin_bit_cast(int, v), 0xB1, 0xF, 0xF, true));
    v += __builtin_bit_cast(float, __builtin_amdgcn_update_dpp(0, __builtin_bit_cast(int, v), 0x4E, 0xF, 0xF, true));
    v += __builtin_bit_cast(float, __builtin_amdgcn_update_dpp(0, __builtin_bit_cast(int, v), 0x124, 0xF, 0xF, true));
    v += __builtin_bit_cast(float, __builtin_amdgcn_update_dpp(0, __builtin_bit_cast(int, v), 0x128, 0xF, 0xF, true));
    const int iv = __builtin_bit_cast(int, v);
    const float r0 = __builtin_bit_cast(float, __builtin_amdgcn_readlane(iv, 0)), r1 = __builtin_bit_cast(float, __builtin_amdgcn_readlane(iv, 16));
    const float r2 = __builtin_bit_cast(float, __builtin_amdgcn_readlane(iv, 32)), r3 = __builtin_bit_cast(float, __builtin_amdgcn_readlane(iv, 48));
    return (r0 + r1) + (r2 + r3);
}
__device__ __forceinline__ float siluf(float v) { return v / (1.0f + __expf(-v)); }
__device__ __forceinline__ float sigmf(float v) { return 1.0f / (1.0f + __expf(-v)); }
__device__ __forceinline__ float gelu_tanh(float x) {
    const float k0 = 0.7978845608028654f, k1 = 0.044715f;
    float u = k0 * (x + k1 * x * x * x);
    return 0.5f * x * (1.0f + tanhf(u));
}
__device__ __forceinline__ int rel_bucket(int d) {
    if (d < 16) return d < 0 ? 0 : d;
    int b = 16;
    b += (d >= 21); b += (d >= 27); b += (d >= 35); b += (d >= 46); b += (d >= 59); b += (d >= 77); b += (d >= 99); b += (d >= 128);
    b += (d >= 166); b += (d >= 216); b += (d >= 280); b += (d >= 363); b += (d >= 470); b += (d >= 609); b += (d >= 790);
    return b;
}

__device__ __forceinline__ int otid() { int t = threadIdx.x; asm volatile("" : "+v"(t)); return t; }

struct P {
    const float *x, *c, *rel, *router_w, *router_b, *final_norm, *norm_mix, *norm_ffn, *ada_w, *ada_b, *moe_wg, *moe_wu, *moe_wd,
        *ev_w_in, *ev_w_out, *pos_k, *pos_v, *ck_w1, *ck_w2, *cv_w1, *cv_w2, *od_w_in, *od_w_out, *q_norm, *kv_norm, *w_q_up, *w_kv_up, *sinks;
    float* out;
    unsigned* bar; int* cnt;
    float *modv, *ropec, *ropes, *blut, *gates, *kcmp, *vcmp, *chid, *kmean, *tokw;
    bf16_t *h, *proj, *o, *hid, *y, *proj1, *qmla, *kvmla, *krope, *cqn;
    int* list;
    bf16_t *wt_gu, *wt_d, *wt_in0, *wt_out0, *wt_c1, *wt_c2, *wt_in1, *wt_out1, *wt_qup, *wt_kvup, *chidb;
    float *c1, *c1p;
    int* wq;
    bf16_t* zrow;
    bf16_t *kcmpb, *kmeanb, *mlap;
    float* mlal;
    int* mcnt; unsigned short* mlist; bf16_t *mp01, *mp2; float* mpl;
    bf16_t *xr1, *xr2, *xr3;
};


__device__ __forceinline__ void st_prologue(const P& p, int wg, int nwg, float* sm) {
    const int TIDX = otid();
    const int tid = TIDX;
    {
        for (int i = tid; i < 2048; i += 256) sm[i] = siluf(p.c[i]);
        __syncthreads();
        const int wid = tid >> 6, lane = tid & 63;
        for (int w = wg; w < 192; w += nwg) {
            const int l = w / 96, cg = w % 96, col = cg * 64 + lane;
            const float* W = p.ada_w + (size_t)l * 1024 * 6144 + (size_t)(wid * 256) * 6144 + col;
            float a0 = 0.f, a1 = 0.f;
#pragma unroll 32
            for (int k = 0; k < 256; ++k) { const float wv = W[(size_t)k * 6144]; a0 += sm[wid * 256 + k] * wv; a1 += sm[1024 + wid * 256 + k] * wv; }
            sm[2048 + tid] = a0; sm[2304 + tid] = a1;
            __syncthreads();
            if (tid < 64) {
                const float bb = p.ada_b[l * 6144 + col];
                p.modv[(l * 2 + 0) * 6144 + col] = ((sm[2048 + tid] + sm[2048 + 64 + tid]) + (sm[2048 + 128 + tid] + sm[2048 + 192 + tid])) + bb;
                p.modv[(l * 2 + 1) * 6144 + col] = ((sm[2304 + tid] + sm[2304 + 64 + tid]) + (sm[2304 + 128 + tid] + sm[2304 + 192 + tid])) + bb;
            }
            __syncthreads();
        }
        __syncthreads();
    }
    for (int i = wg * 256 + tid; i < SEQ * 32; i += nwg * 256) {
        const int t = i >> 5, j = i & 31;
        const float inv = powf(10000.0f, -(float)(2 * j) / 64.0f);
        const float ang = (float)t * inv;
        p.ropec[i] = cosf(ang); p.ropes[i] = sinf(ang);
    }
    for (int i = wg * 256 + tid; i < 8 * 1024; i += nwg * 256) { const int h = i >> 10, d = i & 1023; p.blut[i] = p.rel[rel_bucket(d) * 8 + h]; }
}

#define RT_OFF 4096
template <int MODE>
__device__ __forceinline__ void st_norm(const P& p, int layer, int wg, int nwg, float* sm) {
    const int TIDX = otid();
    const int wid = TIDX >> 6, lane = TIDX & 63;
    int* rl_cnt = (int*)sm; int* rl_base = rl_cnt + 16; int* rl_ent = rl_cnt + 32; float* rl_lg = sm + 256;
    if (MODE == 1) {
        if (TIDX < 16) rl_cnt[TIDX] = 0;
        for (int i = TIDX; i < 64; i += 256) rl_ent[i] = -1;
        for (int idx = TIDX; idx < 4096; idx += 256) {
            const int col = idx >> 2, q = idx & 3;
            *(float4*)((char*)sm + RT_OFF + q * 16384 + (col & 3) * 4096 + ((col >> 8) * 64 + ((col >> 2) & 63)) * 16) = *(const float4*)(p.router_w + idx * 4);
        }
        __syncthreads();
    }
    const int niter = (T_TOK + nwg * 4 - 1) / (nwg * 4);
    constexpr bool XB = (MODE != 0);
    const float* xin = p.x;
    const bf16_t* xinb = (MODE == 1) ? (layer ? p.xr3 : p.xr1) : (MODE == 2) ? p.xr1 : p.xr3;
    float4 pre4[4]; u32x2n pre2[4];
    {
        const int row0 = wg * 4 + wid;
#pragma unroll
        for (int i = 0; i < 4; ++i) {
            if (XB) pre2[i] = (row0 < T_TOK) ? *(const u32x2n*)(xinb + (size_t)row0 * DM + i * 256 + lane * 4) : (u32x2n){0u, 0u};
            else pre4[i] = (row0 < T_TOK) ? *(const float4*)(xin + (size_t)row0 * DM + i * 256 + lane * 4) : make_float4(0.f, 0.f, 0.f, 0.f);
        }
    }
    for (int it = 0; it < niter; ++it) {
        const int row = wg * 4 + wid + it * nwg * 4;
        if (MODE != 1 && row >= T_TOK) break;
        float v[16];
#pragma unroll
        for (int i = 0; i < 4; ++i) {
            if (XB) { v[i * 4 + 0] = __uint_as_float(pre2[i][0] << 16); v[i * 4 + 1] = __uint_as_float(pre2[i][0] & 0xffff0000u); v[i * 4 + 2] = __uint_as_float(pre2[i][1] << 16); v[i * 4 + 3] = __uint_as_float(pre2[i][1] & 0xffff0000u); }
            else { v[i * 4 + 0] = pre4[i].x; v[i * 4 + 1] = pre4[i].y; v[i * 4 + 2] = pre4[i].z; v[i * 4 + 3] = pre4[i].w; }
        }
        {
            const int rown = row + nwg * 4;
            if (rown < T_TOK) {
#pragma unroll
                for (int i = 0; i < 4; ++i) {
                    if (XB) pre2[i] = *(const u32x2n*)(xinb + (size_t)rown * DM + i * 256 + lane * 4);
                    else pre4[i] = *(const float4*)(xin + (size_t)rown * DM + i * 256 + lane * 4);
                }
            }
        }
        if (MODE != 1 || row < T_TOK) {
        const int b = row >> 13;
        if (MODE >= 2) {
            const int lp = (MODE == 2) ? layer - 1 : 1;
            const float* gf = p.modv + (size_t)(lp * 2 + b) * 6144 + 5 * 1024;
#pragma unroll
            for (int i = 0; i < 4; ++i)
#pragma unroll
                for (int j = 0; j < 4; ++j) {
                    const int col = i * 256 + lane * 4 + j;
                    const float y0 = bf2f(p.y[(size_t)(2 * row) * DM + col]), y1 = bf2f(p.y[(size_t)(2 * row + 1) * DM + col]);
                    v[i * 4 + j] += gf[col] * (y0 + y1);
                }
            if (MODE == 2) {
#pragma unroll
                for (int i = 0; i < 4; ++i) {
                    const u32x2n xo = {cvtpk(v[i * 4], v[i * 4 + 1]), cvtpk(v[i * 4 + 2], v[i * 4 + 3])};
                    *(u32x2n*)(p.xr2 + (size_t)row * DM + i * 256 + lane * 4) = xo;
#pragma unroll
                    for (int j = 0; j < 4; ++j) v[i * 4 + j] = __uint_as_float((j & 1) ? (xo[j >> 1] & 0xffff0000u) : (xo[j >> 1] << 16));
                }
            }
        }
        float ss = 0.f;
#pragma unroll
        for (int i = 0; i < 16; ++i) ss += v[i] * v[i];
        ss = wsum(ss);
        const float r = rsqrtf(ss * (1.0f / 1024.0f) + 1e-6f);
        if (MODE == 3) {
#pragma unroll
            for (int i = 0; i < 4; ++i) {
                const float4 g4 = *(const float4*)(p.final_norm + i * 256 + lane * 4);
                *(float4*)(p.out + (size_t)row * DM + i * 256 + lane * 4) =
                    make_float4(v[i * 4] * r * g4.x, v[i * 4 + 1] * r * g4.y, v[i * 4 + 2] * r * g4.z, v[i * 4 + 3] * r * g4.w);
            }
            continue;
        }
        const float* g = ((MODE == 1) ? p.norm_ffn : p.norm_mix) + layer * 1024;
        const float* mv = p.modv + (size_t)(layer * 2 + b) * 6144;
        const float* shift = mv + ((MODE == 1) ? 3 : 0) * 1024;
        const float* scale = mv + ((MODE == 1) ? 4 : 1) * 1024;
        float hv[16];
#pragma unroll
        for (int i = 0; i < 4; ++i)
#pragma unroll
            for (int j = 0; j < 4; ++j) {
                const int col = i * 256 + lane * 4 + j;
                hv[i * 4 + j] = v[i * 4 + j] * r * g[col] * (1.0f + scale[col]) + shift[col];
                p.h[(size_t)row * DM + col] = f2bf(hv[i * 4 + j]);
            }
        if (MODE == 1) {
            float lg[16];
#pragma unroll
            for (int e = 0; e < 16; ++e) lg[e] = 0.f;
#pragma unroll
            for (int i = 0; i < 4; ++i)
#pragma unroll
                for (int j = 0; j < 4; ++j) {
                    const char* rw = (const char*)sm + RT_OFF + lane * 16 + j * 4096 + i * 1024;
#pragma unroll
                    for (int q = 0; q < 4; ++q) {
                        const float4 w4 = *(const float4*)(rw + q * 16384);
                        lg[4 * q] += hv[i * 4 + j] * w4.x; lg[4 * q + 1] += hv[i * 4 + j] * w4.y; lg[4 * q + 2] += hv[i * 4 + j] * w4.z; lg[4 * q + 3] += hv[i * 4 + j] * w4.w;
                    }
                    asm volatile("" ::: "memory");
                }
            float r8[8], r4[4], r2[2], r1;
#pragma unroll
            for (int k = 0; k < 8; ++k) {
                float sa = lg[k], sb = lg[8 + k];
                asm("s_nop 1\n\tv_permlane32_swap_b32 %0, %1\n\ts_nop 0" : "+v"(sa), "+v"(sb));
                r8[k] = sa + sb;
            }
#pragma unroll
            for (int k = 0; k < 4; ++k) {
                float sa = r8[k], sb = r8[4 + k];
                asm("s_nop 1\n\tv_permlane16_swap_b32 %0, %1\n\ts_nop 0" : "+v"(sa), "+v"(sb));
                r4[k] = sa + sb;
            }
            { const bool hi = (lane & 8) != 0;
#pragma unroll
              for (int k = 0; k < 2; ++k) { const float keep = hi ? r4[2 + k] : r4[k], send = hi ? r4[k] : r4[2 + k];
                                            r2[k] = keep + __builtin_bit_cast(float, __builtin_amdgcn_update_dpp(0, __builtin_bit_cast(int, send), 0x128, 0xF, 0xF, true)); } }
            { const bool hi = (lane & 4) != 0; const float keep = hi ? r2[1] : r2[0], send = hi ? r2[0] : r2[1]; r1 = keep + __shfl_xor(send, 4); }
            r1 += __builtin_bit_cast(float, __builtin_amdgcn_update_dpp(0, __builtin_bit_cast(int, r1), 0x4E, 0xF, 0xF, true));
            r1 += __builtin_bit_cast(float, __builtin_amdgcn_update_dpp(0, __builtin_bit_cast(int, r1), 0xB1, 0xF, 0xF, true));
            int t32a = 0, k32 = 1, t16a = 0, k16 = 1;
            asm("s_nop 1\n\tv_permlane32_swap_b32 %0, %1\n\ts_nop 0" : "+v"(t32a), "+v"(k32));
            asm("s_nop 1\n\tv_permlane16_swap_b32 %0, %1\n\ts_nop 0" : "+v"(t16a), "+v"(k16));
            if ((lane & 3) == 0) rl_lg[((it & 7) * 4 + wid) * 16 + (k32 * 8 + k16 * 4 + ((lane >> 3) & 1) * 2 + ((lane >> 2) & 1))] = r1;
        }
        }
        if (MODE == 1 && ((it & 7) == 7 || it == niter - 1)) {
            __syncthreads();
            if (TIDX < 32) {
                const int its = (it & ~7) + (TIDX >> 2), row = wg * 4 + (TIDX & 3) + its * nwg * 4;
                if (its <= it && row < T_TOK) {
                    float lg[16];
#pragma unroll
                    for (int e = 0; e < 16; ++e) lg[e] = rl_lg[TIDX * 16 + e];
                    float aff[16], bi[16];
        #pragma unroll
                    for (int e = 0; e < 16; ++e) { aff[e] = 1.0f / (1.0f + expf(-lg[e])); bi[e] = aff[e] + p.router_b[e]; }
                    float bestsc = -3e38f; int be0 = 0, be1 = 1; float bw0 = 0.f, bw1 = 0.f;
        #pragma unroll
                    for (int gI = 0; gI < 4; ++gI) {
                        int i1 = 0; float m1 = bi[gI * 4];
        #pragma unroll
                        for (int i = 1; i < 4; ++i) if (bi[gI * 4 + i] > m1) { m1 = bi[gI * 4 + i]; i1 = i; }
                        int i2 = -1; float m2 = -3e38f;
        #pragma unroll
                        for (int i = 0; i < 4; ++i) if (i != i1 && bi[gI * 4 + i] > m2) { m2 = bi[gI * 4 + i]; i2 = i; }
                        const float sc = m1 + m2;
                        float a1 = 0.f, a2 = 0.f;
        #pragma unroll
                        for (int i = 0; i < 4; ++i) { a1 = (i == i1) ? aff[gI * 4 + i] : a1; a2 = (i == i2) ? aff[gI * 4 + i] : a2; }
                        if (sc > bestsc) { bestsc = sc; be0 = gI * 4 + i1; be1 = gI * 4 + i2; bw0 = a1; bw1 = a2; }
                    }
                    const float ws = bw0 + bw1;
                    p.tokw[row * 2] = bw0 / ws; p.tokw[row * 2 + 1] = bw1 / ws;
                    const int r0 = atomicAdd(&rl_cnt[be0], 1), r1 = atomicAdd(&rl_cnt[be1], 1);
                    rl_ent[TIDX * 2] = (row << 12) | (be0 << 8) | r0;
                    rl_ent[TIDX * 2 + 1] = (row << 12) | (be1 << 8) | r1;
                }
            }
            __syncthreads();
            if (TIDX < 16) { const int c = rl_cnt[TIDX]; rl_base[TIDX] = c ? atomicAdd(&p.cnt[(layer * 16 + TIDX) * 32], c) : 0; rl_cnt[TIDX] = 0; }
            __syncthreads();
            if (TIDX < 64) {
                const int en = rl_ent[TIDX];
                if (en >= 0) { const int e = (en >> 8) & 15; p.list[e * T_TOK + rl_base[e] + (en & 255)] = (en >> 12) * 2 + (TIDX & 1); rl_ent[TIDX] = -1; }
            }
            __syncthreads();
        }
    }
}

__device__ __forceinline__ void st_kmean(const P& p, int wg, int nwg, float* sm) {
    const int TIDX = otid();
    const int wid = TIDX >> 6, lane = TIDX & 63;
    for (int w = wg; w < 2 * 8 * 32; w += nwg) {
        const int b = w >> 8, h = (w >> 5) & 7, j = w & 31;
        const bf16_t* kp = p.proj + (size_t)(b * SEQ + j * 256 + wid * 64) * 2840 + 1816 + h * 64 + lane;
        float s = 0.f;
#pragma unroll 16
        for (int i = 0; i < 64; ++i) s += bf2f(kp[(size_t)i * 2840]);
        __syncthreads();
        sm[TIDX] = s;
        __syncthreads();
        if (TIDX < 64) {
            const float m = ((sm[TIDX] + sm[64 + TIDX]) + (sm[128 + TIDX] + sm[192 + TIDX])) * (1.0f / 256.0f);
            p.kmean[(size_t)w * 64 + TIDX] = m;
            p.kmeanb[(size_t)w * 64 + TIDX] = f2bf(m);
        }
    }
}
__device__ __forceinline__ void st_mla_prep(const P& p, int wg, int nwg) {
    const int TIDX = otid();
    const int wid = TIDX >> 6, lane = TIDX & 63;
    for (int row = wg * 4 + wid; row < T_TOK; row += nwg * 4) {
        const int t = row & (SEQ - 1);
        const bf16_t* pr = p.proj1 + (size_t)row * 1216;
        float q[4], ss = 0.f;
#pragma unroll
        for (int i = 0; i < 4; ++i) { q[i] = bf2f(pr[i * 64 + lane]); ss += q[i] * q[i]; }
        ss = wsum(ss);
        float r = rsqrtf(ss * (1.0f / 256.0f) + 1e-6f);
#pragma unroll
        for (int i = 0; i < 4; ++i) p.cqn[(size_t)row * 384 + i * 64 + lane] = f2bf(q[i] * r * p.q_norm[i * 64 + lane]);
        float kvv[2]; ss = 0.f;
#pragma unroll
        for (int i = 0; i < 2; ++i) { kvv[i] = bf2f(pr[256 + i * 64 + lane]); ss += kvv[i] * kvv[i]; }
        ss = wsum(ss);
        r = rsqrtf(ss * (1.0f / 128.0f) + 1e-6f);
#pragma unroll
        for (int i = 0; i < 2; ++i) p.cqn[(size_t)row * 384 + 256 + i * 64 + lane] = f2bf(kvv[i] * r * p.kv_norm[i * 64 + lane]);
        if (lane < 32) {
            const float x1 = bf2f(pr[384 + lane]), x2 = bf2f(pr[384 + 32 + lane]);
            const float cs = p.ropec[t * 32 + lane], sn = p.ropes[t * 32 + lane];
            p.krope[(size_t)row * 64 + lane] = f2bf(x1 * cs - x2 * sn);
            p.krope[(size_t)row * 64 + 32 + lane] = f2bf(x1 * sn + x2 * cs);
        }
    }
}


typedef short bf16x8 __attribute__((ext_vector_type(8)));
typedef float f32x4 __attribute__((ext_vector_type(4)));
typedef unsigned u32x2 __attribute__((ext_vector_type(2)));
typedef unsigned u32x4v __attribute__((ext_vector_type(4)));
#define LDSP __attribute__((address_space(3)))
#define GEMM_LDS_BYTES 81920
#define KERNEL_LDS_BYTES 81920
#define BAR_LDS_OFF (KERNEL_LDS_BYTES - 16)

__device__ __forceinline__ unsigned pack_bf16(float lo, float hi) { return cvtpk(lo, hi); }
struct Pair8 { bool lo_is_a; int cadj; };
__device__ __forceinline__ void plswap16(unsigned& a, unsigned& b) { asm("s_nop 1\n\tv_permlane16_swap_b32 %0, %1\n\ts_nop 0" : "+v"(a), "+v"(b)); }
__device__ __forceinline__ Pair8 pair8_init(int tid) {
    const unsigned lane = (unsigned)tid & 63u; unsigned ia = lane, ib = lane, ga = 0u, gb = 1u;
    plswap16(ia, ib); plswap16(ga, gb);
    const bool ownv = (ia == lane), odd = ((lane >> 4) & 1u) != 0u;
    Pair8 r; r.lo_is_a = (odd != ownv); r.cadj = (int)ga * 16 - (odd ? 4 : 0);
    return r;
}
__device__ __forceinline__ u32x4v pair8(const Pair8& P8, const f32x4 va, const f32x4 vb) {
    unsigned ax = pack_bf16(va[0], va[1]), ay = pack_bf16(va[2], va[3]), bx = pack_bf16(vb[0], vb[1]), by = pack_bf16(vb[2], vb[3]);
    plswap16(ax, bx); plswap16(ay, by);
    return P8.lo_is_a ? (u32x4v){ax, ay, bx, by} : (u32x4v){bx, by, ax, ay};
}

template <int MF, class AR, class BR, class Epi, class NX>
__device__ __forceinline__ void gemm128x(const int nk, const size_t akstep, const size_t bkstep, AR arow, BR brow, Epi epi, LDSP char* lds, const int tid, const bool staged, NX next) {
    constexpr int SS = MF * 4096 + 16384, BO = MF * 4096;
    const int wid = tid >> 6, lane = tid & 63, wr = wid >> 1, wc = wid & 1, fr = lane & 15, fq = lane >> 4;
    const int srow = tid >> 3, gch = ((tid & 7) ^ (srow & 7)) * 8;
    const bf16_t* ap[MF]; const bf16_t* bp[4];
#pragma unroll
    for (int i = 0; i < MF; ++i) ap[i] = arow(32 * i + srow) + gch;
#pragma unroll
    for (int i = 0; i < 4; ++i) bp[i] = brow(32 * i + srow) + gch;
    LDSP char* lw = lds + wid * 1024;
#define G128_ISSUE(st, kt) do { LDSP char* la_ = lw + (st) * SS; const size_t ao_ = (size_t)(kt) * akstep, bo_ = (size_t)(kt) * bkstep; \
        _Pragma("unroll") for (int i_ = 0; i_ < MF; ++i_) __builtin_amdgcn_global_load_lds((const unsigned*)(ap[i_] + ao_), (LDSP unsigned*)(la_ + 4096 * i_), 16, 0, 0); \
        _Pragma("unroll") for (int i_ = 0; i_ < 4; ++i_) __builtin_amdgcn_global_load_lds((const unsigned*)(bp[i_] + bo_), (LDSP unsigned*)(la_ + BO + 4096 * i_), 16, 0, 0); } while (0)
    f32x4 acc[MF][4];
#pragma unroll
    for (int m = 0; m < MF; ++m)
#pragma unroll
        for (int n = 0; n < 4; ++n) acc[m][n] = (f32x4){0.f, 0.f, 0.f, 0.f};
    const int aoff = (wr * 16 * MF + fr) * 128, boff = BO + (wc * 64 + fr) * 128, c0 = (fq ^ (fr & 7)) * 16;
    if (!staged) G128_ISSUE(0, 0);
    for (int kt = 0; kt < nk; ++kt) {
        const int cur = kt & 1;
        asm volatile("s_waitcnt vmcnt(0)" ::: "memory");
        __builtin_amdgcn_s_barrier();
        asm volatile("" ::: "memory");
        LDSP char* sb = lds + cur * SS;
        constexpr int NG = 2 * MF, PD = 3;
        bf16x8 af[NG], bf[2][4];
#define G128_AF(s_) (*(const LDSP bf16x8*)(sb + aoff + ((s_) % MF) * 2048 + (((s_) / MF) ? (c0 ^ 64) : c0)))
#pragma unroll
        for (int n = 0; n < 4; ++n) bf[0][n] = *(const LDSP bf16x8*)(sb + boff + n * 2048 + c0);
#pragma unroll
        for (int s = 0; s < PD; ++s) af[s] = G128_AF(s);
        __builtin_amdgcn_sched_barrier(0);
        if (kt + 1 < nk) G128_ISSUE(cur ^ 1, kt + 1);
        __builtin_amdgcn_sched_barrier(0);
#pragma unroll
        for (int s = 0; s < NG; ++s) {
            if (s + PD < NG) af[s + PD] = G128_AF(s + PD);
            if (s == MF - PD) {
#pragma unroll
                for (int n = 0; n < 4; ++n) bf[1][n] = *(const LDSP bf16x8*)(sb + boff + n * 2048 + (c0 ^ 64));
            }
#pragma unroll
            for (int n = 0; n < 4; ++n) acc[s % MF][n] = __builtin_amdgcn_mfma_f32_16x16x32_bf16(bf[s / MF][n], af[s], acc[s % MF][n], 0, 0, 0);
            __builtin_amdgcn_sched_barrier(0);
        }
#undef G128_AF
    }
    asm volatile("s_waitcnt lgkmcnt(0)" ::: "memory");
    __builtin_amdgcn_s_barrier();
    asm volatile("" ::: "memory");
    next();
#undef G128_ISSUE
#pragma unroll
    for (int m = 0; m < MF; ++m) epi(wr * 16 * MF + m * 16 + fr, wc * 64 + fq * 4, acc[m], m);
}

template <int MF, class AR, class BR>
__device__ __forceinline__ void g128_stage0(AR arow, BR brow, LDSP char* lds, const int tid) {
    const int wid = tid >> 6, srow = tid >> 3, gch = ((tid & 7) ^ (srow & 7)) * 8;
    LDSP char* lw = lds + wid * 1024;
#pragma unroll
    for (int i = 0; i < MF; ++i) {
        __builtin_amdgcn_global_load_lds((const unsigned*)(arow(32 * i + srow) + gch), (LDSP unsigned*)(lw + 4096 * i), 16, 0, 0);
    }
#pragma unroll
    for (int i = 0; i < 4; ++i) {
        __builtin_amdgcn_global_load_lds((const unsigned*)(brow(32 * i + srow) + gch), (LDSP unsigned*)(lw + MF * 4096 + 4096 * i), 16, 0, 0);
    }
}
template <class AR, class BR, class Epi>
__device__ __forceinline__ void gemm128(const int nk, const size_t akstep, const size_t bkstep, AR arow, BR brow, Epi epi, LDSP char* lds, const int tid) {
    gemm128x<4>(nk, akstep, bkstep, arow, brow, epi, lds, tid, false, [] {});
}

template <int MAP> __device__ __forceinline__ int conv_rowmap(int n) {
    if (MAP == 0) return n;
    const int tile = n >> 6, cc = n & 63, wc = cc >> 5, i16 = (cc >> 4) & 1, i = cc & 15;
    return tile * 128 + wc * 64 + ((MAP == 1 ? 0 : 2) + i16) * 16 + i;
}
template <int MAP>
__device__ __forceinline__ void conv_batched(const float* src, int nmat, int K, int N, size_t sstride, bf16_t* dst, size_t dstride, int wg, int nwg, float* sm, int tid, int wend = 0x7fffffff) {
    float(*t)[65] = (float(*)[65])sm;
    const int tk = K >> 6, tn = (N + 63) >> 6, per = tk * tn, total = (nmat * per < wend) ? nmat * per : wend;
    f32x4 v[4];
    auto ld = [&](int w) {
        const int mat = w / per, r = w % per, kt = r / tn, nt = r % tn;
        const float* s = src + (size_t)mat * sstride;
#pragma unroll
        for (int i = 0; i < 4; ++i) {
            const int idx = tid + 256 * i, k = idx >> 4, n = (idx & 15) * 4;
            v[i] = (f32x4){0.f, 0.f, 0.f, 0.f};
            if (nt * 64 + n < N) v[i] = *(const f32x4*)(s + (size_t)(kt * 64 + k) * N + nt * 64 + n);
        }
    };
    if (wg < total) ld(wg);
    for (int w = wg; w < total; w += nwg) {
        const int mat = w / per, r = w % per, kt = r / tn, nt = r % tn;
        bf16_t* d = dst + (size_t)mat * dstride;
#pragma unroll
        for (int i = 0; i < 4; ++i) {
            const int idx = tid + 256 * i, k = idx >> 4, n = (idx & 15) * 4;
            t[k][n] = v[i][0]; t[k][n + 1] = v[i][1]; t[k][n + 2] = v[i][2]; t[k][n + 3] = v[i][3];
        }
        __syncthreads();
        if (w + nwg < total) ld(w + nwg);
        {
            const int n = tid >> 2, kq = (tid & 3) * 16;
            if (nt * 64 + n < N) {
                unsigned pk[8];
#pragma unroll
                for (int j = 0; j < 8; ++j) pk[j] = cvtpk(t[kq + 2 * j][n], t[kq + 2 * j + 1][n]);
                bf16_t* o = d + (size_t)conv_rowmap<MAP>(nt * 64 + n) * K + kt * 64 + kq;
                *(u32x4v*)o = (u32x4v){pk[0], pk[1], pk[2], pk[3]};
                *(u32x4v*)(o + 8) = (u32x4v){pk[4], pk[5], pk[6], pk[7]};
            }
        }
        __syncthreads();
    }
}
__device__ __forceinline__ void st_convert(const P& p, int wg, int nwg, float* sm) {
    const int tid = otid();
    conv_batched<0>(p.ev_w_in, 1, 1024, 2840, 0, p.wt_in0, 0, wg, nwg, sm, tid);
    conv_batched<0>(p.ev_w_out, 1, 1024, 1024, 0, p.wt_out0, 0, wg, nwg, sm, tid);
    conv_batched<0>(p.ck_w1, 1, 2048, 256, 0, p.wt_c1, 0, wg, nwg, sm, tid);
    conv_batched<0>(p.cv_w1, 1, 2048, 256, 0, p.wt_c1 + 256 * 2048, 0, wg, nwg, sm, tid);
    conv_batched<0>(p.ck_w2, 1, 256, 64, 0, p.wt_c2, 0, wg, nwg, sm, tid);
    conv_batched<0>(p.cv_w2, 1, 256, 64, 0, p.wt_c2 + 64 * 256, 0, wg, nwg, sm, tid);
    conv_batched<0>(p.od_w_in, 1, 1024, 1216, 0, p.wt_in1, 0, wg, nwg, sm, tid);
    conv_batched<0>(p.od_w_out, 1, 1024, 1024, 0, p.wt_out1, 0, wg, nwg, sm, tid);
    conv_batched<0>(p.w_q_up, 1, 256, 768, 0, p.wt_qup, 0, wg, nwg, sm, tid);
    conv_batched<0>(p.w_kv_up, 1, 128, 1024, 0, p.wt_kvup, 0, wg, nwg, sm, tid);
    {
        const int wid = tid >> 6, lane = tid & 63;
        for (int w = wg * 4 + wid; w < 512; w += nwg * 4) {
            const int which = w >> 8, cg = (w >> 6) & 3, ks = w & 63, col = cg * 64 + lane;
            const float* w1 = (which ? p.cv_w1 : p.ck_w1) + (size_t)(ks * 32) * 256 + col; const float* pos = (which ? p.pos_v : p.pos_k) + ks * 32;
            float a = 0.f;
#pragma unroll
            for (int k = 0; k < 32; ++k) a += pos[k] * w1[(size_t)k * 256];
            p.c1p[(which * 64 + ks) * 256 + col] = a;
        }
    }
}
__device__ __forceinline__ void st_c1_reduce(const P& p, int wg, int nwg) {
    const int tid = otid();
    for (int i = wg * 256 + tid; i < 512; i += nwg * 256) {
        const int which = i >> 8, col = i & 255;
        float a = 0.f;
#pragma unroll 16
        for (int ks = 0; ks < 64; ++ks) a += p.c1p[(which * 64 + ks) * 256 + col];
        p.c1[i] = a;
    }
}


struct XcdOrder {
    int xcd, lw, nlw, tn, per;
    __device__ __forceinline__ XcdOrder(int wg, int nwg, int nM, int tn_) : xcd(wg & 7), lw(wg >> 3), nlw(nwg >> 3), tn(tn_), per((nM >> 3) * tn_) {}
    __device__ __forceinline__ bool get(int k, int& mt, int& nt) const { const int lt = lw + k * nlw; if (lt >= per) return false; mt = xcd + 8 * (lt / tn); nt = lt % tn; return true; }
};
template <int MF>
__device__ __forceinline__ void st_inproj0_mf(const P& p, int wg, int nwg, LDSP char* lds) {
    const int tid = otid();
    const Pair8 P8 = pair8_init(tid);
    const XcdOrder ord(wg, nwg, ((T_TOK + 32 * MF - 1) / (32 * MF) + 7) & ~7, 23);
    auto Af = [&](int mt_) { return [=](int r) { int row = mt_ * (32 * MF) + r; row = row < T_TOK ? row : T_TOK - 1; return p.h + (size_t)row * DM; }; };
    auto Bf = [&](int nt_) { return [=](int r) { int n = nt_ * 128 + r; n = n < 2840 ? n : 2839; return p.wt_in0 + (size_t)n * 1024; }; };
    bool staged = false;
    for (int k = 0;; ++k) {
        int mt, nt, mt2 = 0, nt2 = 0;
        if (!ord.get(k, mt, nt)) break;
        if (mt * (32 * MF) >= T_TOK) break;
        const bool has2 = ord.get(k + 1, mt2, nt2) && mt2 * (32 * MF) < T_TOK;
        const bool st_ = staged; staged = has2;
        gemm128x<MF>(16, 64, 64, Af(mt), Bf(nt),
            [&](int rl, int cl, const f32x4 (&a)[4], int mfrag) {
                const int row = mt * (32 * MF) + rl;
#pragma unroll
                for (int n = 0; n < 4; n += 2) {
                    const u32x4v w8 = pair8(P8, a[n], a[n + 1]);
                    const int col8 = nt * 128 + cl + n * 16 + P8.cadj;
                    if (col8 < 2840 && row < T_TOK) *(u32x4v*)(p.proj + (size_t)row * 2840 + col8) = w8;
                }
#pragma unroll
                for (int n = 0; n < 4; ++n) {
                    const int col = nt * 128 + cl + n * 16;
                    if (col >= 1280 && col < 1304 && row < T_TOK)
                        *(f32x4*)(p.gates + (size_t)row * 24 + (col - 1280)) = (f32x4){sigmf(a[n][0]), sigmf(a[n][1]), sigmf(a[n][2]), sigmf(a[n][3])};
                }
            }, lds, tid, st_, [&] { if (has2) g128_stage0<MF>(Af(mt2), Bf(nt2), lds, tid); });
    }
}
__device__ __forceinline__ void st_cmp1_mf(const P& p, int wg, int nwg, LDSP char* lds) {
    const int tid = otid();
    for (int w = wg; w < 2 * 16 * 2; w += nwg) {
        const int which = w >> 5, mt = (w >> 1) & 15, nt = w & 1;
        const int colbase = which ? 640 : 512;
        gemm128(32, 2840, 64,
            [&](int r) { int m = mt * 128 + r; m = m < 2044 ? m : 2043; const int bk = m / 511, n = m % 511, b = bk >> 1, kv = bk & 1;
                         return p.proj + (size_t)(b * SEQ + 16 * n) * 2840 + colbase + kv * 64; },
            [&](int r) { return p.wt_c1 + (size_t)(which * 256 + nt * 128 + r) * 2048; },
            [&](int rl, int cl, const f32x4 (&a)[4], int mfrag) {
                const int m = mt * 128 + rl;
                if (m < 2044) {
#pragma unroll
                    for (int n = 0; n < 4; ++n) {
                        const int col = nt * 128 + cl + n * 16;
                        const f32x4 cb = *(const f32x4*)(p.c1 + which * 256 + col);
                        *(u32x2*)(p.chidb + (size_t)(which * 2048 + m) * 256 + col) =
                            (u32x2){pack_bf16(gelu_tanh(a[n][0] + cb[0]), gelu_tanh(a[n][1] + cb[1])), pack_bf16(gelu_tanh(a[n][2] + cb[2]), gelu_tanh(a[n][3] + cb[3]))};
                    }
                }
            }, lds, tid);
    }
}
__device__ __forceinline__ void st_cmp2_mf(const P& p, int wg, int nwg, LDSP char* lds) {
    const int tid = otid();
    for (int w = wg; w < 2 * 16; w += nwg) {
        const int which = w >> 4, mt = w & 15;
        gemm128(4, 64, 64,
            [&](int r) { int m = mt * 128 + r; m = m < 2044 ? m : 2043; return p.chidb + (size_t)(which * 2048 + m) * 256; },
            [&](int r) { return p.wt_c2 + (size_t)(which * 64 + (r & 63)) * 256; },
            [&](int rl, int cl, const f32x4 (&a)[4], int mfrag) {
                const int m = mt * 128 + rl;
                if (m < 2044) {
#pragma unroll
                    for (int n = 0; n < 4; ++n) { const int col = cl + n * 16; if (col < 64) {
                        const int bk = m / 511, nn = m % 511;
                        *(u32x2*)(p.kcmpb + ((size_t)((which * 4 + bk) * 512 + nn)) * 64 + col) = (u32x2){cvtpk(a[n][0], a[n][1]), cvtpk(a[n][2], a[n][3])}; } }
                }
            }, lds, tid);
    }
}
template <int MF>
__device__ __forceinline__ void st_outproj_mf(const P& p, int layer, int wg, int nwg, LDSP char* lds) {
    const int tid = otid();
    const Pair8 P8 = pair8_init(tid);
    const bf16_t* W = layer ? p.wt_out1 : p.wt_out0;
    bf16_t* xout = layer ? p.xr3 : p.xr1;
    const XcdOrder ord(wg, nwg, ((T_TOK + 32 * MF - 1) / (32 * MF) + 7) & ~7, 8);
    auto Af = [&](int mt_) { return [=](int r) { int row = mt_ * (32 * MF) + r; row = row < T_TOK ? row : T_TOK - 1; return p.o + (size_t)row * DM; }; };
    auto Bf = [&](int nt_) { return [=](int r) { return W + (size_t)(nt_ * 128 + r) * 1024; }; };
    bool staged = false;
    for (int k = 0;; ++k) {
        int mt, nt, mt2 = 0, nt2 = 0;
        if (!ord.get(k, mt, nt)) break;
        if (mt * (32 * MF) >= T_TOK) break;
        const bool has2 = ord.get(k + 1, mt2, nt2) && mt2 * (32 * MF) < T_TOK;
        const bool st_ = staged; staged = has2;
        gemm128x<MF>(16, 64, 64, Af(mt), Bf(nt),
            [&](int rl, int cl, const f32x4 (&a)[4], int mfrag) {
                const int row = mt * (32 * MF) + rl, b = row >> 13;
                const float* g = p.modv + (size_t)(layer * 2 + (b & 1)) * 6144 + 2 * 1024;
                const int rowc = row < T_TOK ? row : T_TOK - 1;
                f32x4 r4[4];
#pragma unroll
                for (int n = 0; n < 4; ++n) {
                    const int col = nt * 128 + cl + n * 16;
                    const f32x4 gv = *(const f32x4*)(g + col);
                    f32x4 xv;
                    if (layer) { const u32x2 xb = *(const u32x2*)(p.xr2 + (size_t)rowc * DM + col);
                                 xv = (f32x4){__uint_as_float(xb[0] << 16), __uint_as_float(xb[0] & 0xffff0000u), __uint_as_float(xb[1] << 16), __uint_as_float(xb[1] & 0xffff0000u)}; }
                    else xv = *(const f32x4*)(p.x + (size_t)rowc * DM + col);
                    r4[n] = xv + gv * a[n];
                }
#pragma unroll
                for (int n = 0; n < 4; n += 2) {
                    const u32x4v w8 = pair8(P8, r4[n], r4[n + 1]);
                    if (row < T_TOK) *(u32x4v*)(xout + (size_t)row * DM + nt * 128 + cl + n * 16 + P8.cadj) = w8;
                }
            }, lds, tid, st_, [&] { if (has2) g128_stage0<MF>(Af(mt2), Bf(nt2), lds, tid); });
    }
}
template <int BM>
__device__ __forceinline__ bool moe_tile128(const int* cnt, int tt, int& e, int& i0, int& off) {
    int acc = 0, o = 0;
    for (int q = 0; q < 16; ++q) {
        const int c = cnt[q * 32], nt = (c + BM - 1) / BM;
        if (tt < acc + nt) { e = q; i0 = (tt - acc) * BM; off = o; return true; }
        acc += nt; o += c;
    }
    return false;
}
struct MoeTile { int e, i0, off, nt, ce; bool ok; };
template <int BM>
__device__ __forceinline__ MoeTile moe_get(const int* cnt, int wg, int nwg, int k) {
    int mtot = 0;
    for (int q = 0; q < 16; ++q) mtot += (cnt[q * 32] + BM - 1) / BM;
    const int per = (mtot + 7) >> 3, lt = (wg >> 3) + k * (nwg >> 3), lm = lt >> 3;
    MoeTile t; t.nt = lt & 7; t.e = 0; t.i0 = 0; t.off = 0;
    t.ok = (lm < per) && moe_tile128<BM>(cnt, (wg & 7) * per + lm, t.e, t.i0, t.off);
    t.ce = t.ok ? cnt[t.e * 32] : 0; return t;
}
template <int MF>
__device__ __forceinline__ void st_moe_up_mf(const P& p, int layer, int wg, int nwg, LDSP char* lds) {
    const int tid = otid();
    const Pair8 P8 = pair8_init(tid);
    const int* cnt = p.cnt + layer * 512;
    auto Af = [&](const MoeTile& t) { const int* lst = p.list + t.e * T_TOK; const int i0 = t.i0, ce = t.ce;
                                      return [=](int r) { const int i = (i0 + r < ce) ? i0 + r : i0; return p.h + (size_t)(lst[i] >> 1) * DM; }; };
    auto Bf = [&](const MoeTile& t) { const bf16_t* B = p.wt_gu + ((size_t)(layer * 16 + t.e) * 1024 + t.nt * 128) * 1024; return [=](int r) { return B + (size_t)r * 1024; }; };
    MoeTile cur = moe_get<32 * MF>(cnt, wg, nwg, 0);
    bool staged = false;
    for (int k = 0; cur.ok; ++k) {
        const MoeTile nx = moe_get<32 * MF>(cnt, wg, nwg, k + 1);
        const bool st_ = staged; staged = nx.ok;
        const int i0 = cur.i0, ce = cur.ce, off = cur.off, nt = cur.nt;
        gemm128x<MF>(16, 64, 64, Af(cur), Bf(cur),
            [&](int rl, int cl, const f32x4 (&a)[4], int mfrag) {
                const int wc = cl >> 6, fq4 = cl & 63;
                f32x4 hv2[2];
#pragma unroll
                for (int n = 0; n < 2; ++n) { const f32x4 g = a[n], u = a[n + 2]; hv2[n] = (f32x4){siluf(g[0]) * u[0], siluf(g[1]) * u[1], siluf(g[2]) * u[2], siluf(g[3]) * u[3]}; }
                const u32x4v w8 = pair8(P8, hv2[0], hv2[1]);
                if (i0 + rl < ce) *(u32x4v*)(p.hid + (size_t)(off + i0 + rl) * 512 + nt * 64 + wc * 32 + fq4 + P8.cadj) = w8;
            }, lds, tid, st_, [&] { if (nx.ok) g128_stage0<MF>(Af(nx), Bf(nx), lds, tid); });
        cur = nx;
    }
}
template <int MF>
__device__ __forceinline__ void st_moe_down_mf(const P& p, int layer, int wg, int nwg, LDSP char* lds) {
    const int tid = otid();
    const Pair8 P8 = pair8_init(tid);
    const int* cnt = p.cnt + layer * 512;
    auto Af = [&](const MoeTile& t) { const int i0 = t.i0, ce = t.ce, off = t.off; return [=](int r) { const int i = (i0 + r < ce) ? i0 + r : i0; return p.hid + (size_t)(off + i) * 512; }; };
    auto Bf = [&](const MoeTile& t) { const bf16_t* B = p.wt_d + ((size_t)(layer * 16 + t.e) * 1024 + t.nt * 128) * 512; return [=](int r) { return B + (size_t)r * 512; }; };
    MoeTile cur = moe_get<32 * MF>(cnt, wg, nwg, 0);
    bool staged = false;
    for (int k = 0; cur.ok; ++k) {
        const MoeTile nx = moe_get<32 * MF>(cnt, wg, nwg, k + 1);
        const bool st_ = staged; staged = nx.ok;
        const int i0 = cur.i0, ce = cur.ce, nt = cur.nt;
        const int* lst = p.list + cur.e * T_TOK;
        int ids[MF]; float wts[MF];
#pragma unroll
        for (int m = 0; m < MF; ++m) { const int rl = ((tid >> 7) & 1) * (16 * MF) + m * 16 + (tid & 15); ids[m] = (i0 + rl < ce) ? lst[i0 + rl] : -1; }
#pragma unroll
        for (int m = 0; m < MF; ++m) wts[m] = ids[m] >= 0 ? p.tokw[ids[m]] : 0.f;
        gemm128x<MF>(8, 64, 64, Af(cur), Bf(cur),
            [&](int rl, int cl, const f32x4 (&a)[4], int mfrag) {
                const int id = ids[mfrag]; const float wt = wts[mfrag];
#pragma unroll
                for (int n = 0; n < 4; n += 2) {
                    const u32x4v w8 = pair8(P8, a[n] * wt, a[n + 1] * wt);
                    if (i0 + rl < ce) *(u32x4v*)(p.y + (size_t)id * DM + nt * 128 + cl + n * 16 + P8.cadj) = w8;
                }
            }, lds, tid, st_, [&] { if (nx.ok) g128_stage0<MF>(Af(nx), Bf(nx), lds, tid); });
        cur = nx;
    }
}
template <int MF>
__device__ __forceinline__ void st_inproj1_mf(const P& p, int wg, int nwg, LDSP char* lds) {
    const int tid = otid();
    const Pair8 P8 = pair8_init(tid);
    const XcdOrder ord(wg, nwg, ((T_TOK + 32 * MF - 1) / (32 * MF) + 7) & ~7, 10);
    auto Af = [&](int mt_) { return [=](int r) { int row = mt_ * (32 * MF) + r; row = row < T_TOK ? row : T_TOK - 1; return p.h + (size_t)row * DM; }; };
    auto Bf = [&](int nt_) { return [=](int r) { int n = nt_ * 128 + r; n = n < 1216 ? n : 1215; return p.wt_in1 + (size_t)n * 1024; }; };
    bool staged = false;
    for (int k = 0;; ++k) {
        int mt, nt, mt2 = 0, nt2 = 0;
        if (!ord.get(k, mt, nt)) break;
        if (mt * (32 * MF) >= T_TOK) break;
        const bool has2 = ord.get(k + 1, mt2, nt2) && mt2 * (32 * MF) < T_TOK;
        const bool st_ = staged; staged = has2;
        gemm128x<MF>(16, 64, 64, Af(mt), Bf(nt),
            [&](int rl, int cl, const f32x4 (&a)[4], int mfrag) {
                const int row = mt * (32 * MF) + rl;
#pragma unroll
                for (int n = 0; n < 4; n += 2) {
                    const u32x4v w8 = pair8(P8, a[n], a[n + 1]);
                    const int col8 = nt * 128 + cl + n * 16 + P8.cadj;
                    if (col8 < 1216 && row < T_TOK) *(u32x4v*)(p.proj1 + (size_t)row * 1216 + col8) = w8;
                }
            }, lds, tid, st_, [&] { if (has2) g128_stage0<MF>(Af(mt2), Bf(nt2), lds, tid); });
    }
}
__device__ __forceinline__ void st_mla_up_mf(const P& p, int wg, int nwg, LDSP char* lds) {
    const int tid = otid();
    const Pair8 P8 = pair8_init(tid);
    const XcdOrder ord(wg, nwg, 128, 14);
    for (int k = 0;; ++k) {
        int mt, c;
        if (!ord.get(k, mt, c)) break;
        if (c < 6) {
            gemm128(4, 64, 64,
                [&](int r) { return p.cqn + (size_t)(mt * 128 + r) * 384; },
                [&](int r) { return p.wt_qup + (size_t)(c * 128 + r) * 256; },
                [&](int rl, int cl, const f32x4 (&a)[4], int mfrag) {
                    const int row = mt * 128 + rl, wc = cl >> 6;
                    f32x4 v[4] = {a[0], a[1], a[2], a[3]};
                    if (((c == 1 || c == 4) && wc == 0) || ((c == 2 || c == 5) && wc == 1)) {
                        const int t = row & (SEQ - 1), i0 = cl & 63;
#pragma unroll
                        for (int n = 0; n < 2; ++n) {
                            const f32x4 cs = *(const f32x4*)(p.ropec + t * 32 + n * 16 + i0), sn = *(const f32x4*)(p.ropes + t * 32 + n * 16 + i0);
                            v[n] = a[n] * cs - a[n + 2] * sn; v[n + 2] = a[n] * sn + a[n + 2] * cs;
                        }
                    }
#pragma unroll
                    for (int n = 0; n < 4; n += 2) *(u32x4v*)(p.qmla + (size_t)row * 768 + c * 128 + cl + n * 16 + P8.cadj) = pair8(P8, v[n], v[n + 1]);
                }, lds, tid);
        } else {
            gemm128(2, 64, 64,
                [&](int r) { return p.cqn + (size_t)(mt * 128 + r) * 384 + 256; },
                [&](int r) { return p.wt_kvup + (size_t)((c - 6) * 128 + r) * 128; },
                [&](int rl, int cl, const f32x4 (&a)[4], int mfrag) {
                    const int row = mt * 128 + rl;
#pragma unroll
                    for (int n = 0; n < 4; n += 2) *(u32x4v*)(p.kvmla + (size_t)row * 1024 + (c - 6) * 128 + cl + n * 16 + P8.cadj) = pair8(P8, a[n], a[n + 1]);
                }, lds, tid);
        }
    }
}

typedef float f32x16 __attribute__((ext_vector_type(16)));
typedef short s16x4 __attribute__((ext_vector_type(4)));
#define ATT_NEG (-1e30f)
#define ATT_SHIFT (-16.0f)
#define LOG2E 1.4426950408889634f

__device__ __forceinline__ int swz128(int row) { return (((row >> 1) & 1) << 2) | ((row >> 2) & 3); }
__device__ __forceinline__ int swz256(int row) { return ((row & 3) << 2) | ((row >> 2) & 3); }

struct AttLane {
    int kbase;
    int v0[2];
};
template <int KROWB, int VROWB, int DT>
__device__ __forceinline__ void att_lane_init(AttLane& L, int lane) {
    const int q = lane & 31, hh = lane >> 5, x = hh ^ swz128(q);
    L.kbase = q * KROWB + x * 16;
    const int rl = 4 * hh + ((lane & 15) >> 2), blk = (lane >> 4) & 1, pp = lane & 3;
#pragma unroll
    for (int t = 0; t < 2; ++t) {
        const int g = (VROWB == 256) ? (((rl & 3) << 2) | ((2 * t + hh) & 3)) : ((((rl >> 1) & 1) << 2) | ((2 * t + hh) & 3));
        L.v0[t] = rl * VROWB + (((2 * blk + (pp >> 1)) ^ g) * 16) + 8 * (pp & 1);
    }
}
template <int KS, int KROWB, int MODE, bool WANT_P, bool IMP>
__device__ __forceinline__ void att_qk(LDSP const char* kb, const AttLane& L, const bf16x8 (&qf)[KS], bf16x8 (&pf)[4], float& lsum, const float c1, const float cadd,
                                       const unsigned lutv, const int dq16, LDSP float* improw, const float invl) {
    float la = 0.f, lb = 0.f, lc = 0.f, ld = 0.f;
#pragma unroll
    for (int kt = 0; kt < 2; ++kt) {
        f32x16 s;
#pragma unroll
        for (int r = 0; r < 16; ++r) s[r] = 0.f;
        constexpr int KG = (KS > 4) ? 2 : 4;
#pragma unroll
        for (int k4 = 0; k4 < KS; k4 += KG) {
            bf16x8 a[KG];
#pragma unroll
            for (int j = 0; j < KG; ++j) { const int ks = k4 + j; a[j] = *(const LDSP bf16x8*)(kb + (L.kbase ^ (32 * (ks & 3))) + (ks >> 2) * 128 + kt * 32 * KROWB); }
#pragma unroll
            for (int j = 0; j < KG; ++j) s = __builtin_amdgcn_mfma_f32_32x32x16_bf16(a[j], qf[k4 + j], s, 0, 0, 0);
            asm volatile("" ::: "memory");
        }
        float pr[16];
#pragma unroll
        for (int r = 0; r < 16; ++r) {
            const int koff = 32 * kt + (r & 3) + 8 * (r >> 2);
            float add = cadd;
            if (MODE == 1) add = *(const LDSP float*)(lutv + (63 - koff) * 4);
            if (MODE == 2) { int d = dq16 - 16 * koff; d = d < -1 ? -1 : d; d = d > 1087 ? 1087 : d; add = *(const LDSP float*)(lutv + (unsigned)(64 + d) * 4u); }
            pr[r] = __builtin_amdgcn_exp2f(__builtin_fmaf(s[r], c1, add));
        }
#pragma unroll
        for (int r = 0; r < 16; r += 4) { la += pr[r]; lb += pr[r + 1]; lc += pr[r + 2]; ld += pr[r + 3]; }
        if (IMP) {
#pragma unroll
            for (int g = 0; g < 4; ++g) {
                (void)__hip_atomic_fetch_add((LDSP unsigned*)improw + 8 * kt + 2 * g, (unsigned)(((pr[4 * g] + pr[4 * g + 1]) + (pr[4 * g + 2] + pr[4 * g + 3])) * invl + 0.5f), __ATOMIC_RELAXED, __HIP_MEMORY_SCOPE_WORKGROUP);
                (void)__hip_atomic_fetch_add((LDSP unsigned*)improw + 8 * kt + 2 * g + 1, (unsigned)(pr[4 * g + 3] * invl + 0.5f), __ATOMIC_RELAXED, __HIP_MEMORY_SCOPE_WORKGROUP);
            }
        }
        if (WANT_P) {
#pragma unroll
            for (int sI = 0; sI < 2; ++sI) {
                union { unsigned u[4]; bf16x8 v; } cv;
#pragma unroll
                for (int i = 0; i < 4; ++i) cv.u[i] = cvtpk_valu(pr[8 * sI + 2 * i], pr[8 * sI + 2 * i + 1]);
                pf[kt * 2 + sI] = cv.v;
            }
        }
    }
    lsum += (la + lb) + (lc + ld);
}
template <int DT, int VROWB>
__device__ __forceinline__ void att_pv(LDSP const char* vb, const AttLane& L, const bf16x8 (&pf)[4], f32x16 (&o)[DT]) {
    const unsigned vba = (unsigned)(size_t)vb;
#pragma unroll
    for (int ks2 = 0; ks2 < 4; ++ks2) {
#pragma unroll
        for (int d0 = 0; d0 < DT; d0 += 2) {
            s16x4 lo[2], hi[2];
#pragma unroll
            for (int j = 0; j < 2; ++j) {
                asm volatile("ds_read_b64_tr_b16 %0, %1 offset:%2" : "=v"(lo[j]) : "v"(vba + (L.v0[0] ^ ((d0 + j) << 6))), "i"((16 * ks2) * VROWB) : "memory");
                asm volatile("ds_read_b64_tr_b16 %0, %1 offset:%2" : "=v"(hi[j]) : "v"(vba + (L.v0[1] ^ ((d0 + j) << 6))), "i"((16 * ks2 + 8) * VROWB) : "memory");
            }
            asm volatile("s_waitcnt lgkmcnt(0)" ::: "memory");
#pragma unroll
            for (int j = 0; j < 2; ++j) {
                asm volatile("" : "+v"(lo[j]), "+v"(hi[j]));
                const bf16x8 vf = __builtin_shufflevector(lo[j], hi[j], 0, 1, 2, 3, 4, 5, 6, 7);
                o[d0 + j] = __builtin_amdgcn_mfma_f32_32x32x16_bf16(vf, pf[ks2], o[d0 + j], 0, 0, 0);
            }
        }
    }
}
template <int CPR>
__device__ __forceinline__ void att_stage_map(int (&rowc)[(CPR == 24) ? 6 : 1], int tid) {
    if (CPR == 24) {
#pragma unroll
        for (int i = 0; i < 6; ++i) {
            const int c = tid + 256 * i, row = c / 24, cc = c % 24;
            rowc[i % ((CPR == 24) ? 6 : 1)] = (row << 8) | ((cc & ~7) | ((cc & 7) ^ swz128(row)));
        }
    } else if (CPR == 16) {
        const int row = tid >> 4; rowc[0] = (row << 8) | ((tid & 15) ^ swz256(row));
    } else {
        const int row = tid >> 3; rowc[0] = (row << 8) | ((tid & 7) ^ swz128(row));
    }
}
template <int CPR, class SRC>
__device__ __forceinline__ void att_stage(LDSP char* dst, SRC src, const int (&rowc)[(CPR == 24) ? 6 : 1], int wid) {
#pragma unroll
    for (int i = 0; i < CPR / 4; ++i) {
        const int rc = rowc[(CPR == 24) ? i : 0];
        const int row = (rc >> 8) + ((CPR == 24) ? 0 : i * (256 / CPR));
        __builtin_amdgcn_global_load_lds((const unsigned*)src(row, rc & 255), (LDSP unsigned*)(dst + (256 * i + 64 * wid) * 16), 16, 0, 0);
    }
}
__device__ __forceinline__ int wq_next(int* ctr, LDSP int* slot, int tid) {
    __syncthreads();
    if (tid == 0) *slot = atomicAdd(ctr, 1);
    __syncthreads();
    return *slot;
}

__device__ __forceinline__ void build_lut(LDSP float* tab, const float* blut_h, int n, int wlimit, int tid) {
    for (int i = tid; i < n; i += 256) { const int d = i - 64; tab[i] = (d < 0 || d >= wlimit) ? ATT_NEG : blut_h[d > 1023 ? 1023 : d] * LOG2E + ATT_SHIFT; }
}
#define ATT_BAR() do { __builtin_amdgcn_s_barrier(); asm volatile("" ::: "memory"); } while (0)

__device__ __forceinline__ void mla_item(const P& p, const int item, LDSP char* lds, const int tid0) {
    LDSP char* kb = lds; LDSP char* vb = lds + 24576; LDSP float* lut = (LDSP float*)(lds + 40960);
    const float c1 = 0.07216878364870322f * LOG2E;
    int tid = tid0; asm volatile("" : "+v"(tid));
    const int wid = tid >> 6, lane = tid & 63, q = lane & 31, hh = lane >> 5;
    AttLane L; att_lane_init<384, 256, 4>(L, lane);
    int krc[6], vrc[1];
    att_stage_map<24>(krc, tid); att_stage_map<16>(vrc, tid);
    int qt, bh, part;
    if (item >= 640) { const int r = item - 640; qt = 15 - (r >> 3); bh = r & 7; part = 0; }
    else {
        int g = 0; while (16 * (g + 1) + 8 * ((g + 2) >> 1) <= item) ++g;
        const int r = item - (16 * g + 8 * ((g + 1) >> 1)), Ln = 64 - g;
        if (r < 16) { qt = Ln - 1; bh = r & 7; part = 1 + (r >> 3); } else { qt = (Ln >> 1) - 1; bh = (r - 16) & 7; part = 0; }
    }
    const int b = bh >> 2, h = bh & 3;
    const int tw = qt * 128 + wid * 32;
    bf16x8 qf[12];
    {
        const bf16_t* qp = p.qmla + (size_t)(b * SEQ + tw + q) * 768 + h * 192 + 8 * hh;
#pragma unroll
        for (int ks = 0; ks < 12; ++ks) qf[ks] = *(const bf16x8*)(qp + 16 * ks);
    }
    f32x16 o[4];
#pragma unroll
    for (int dt = 0; dt < 4; ++dt)
#pragma unroll
        for (int r = 0; r < 16; ++r) o[dt][r] = 0.f;
    float lsum = 0.f;
    const int i0 = (part == 2) ? qt + 1 : 0, ntiles = (part == 1) ? qt + 1 : 2 * qt + 2;
    const bf16_t* kvb = p.kvmla + (size_t)b * SEQ * 1024 + h * 256;
    const bf16_t* krb = p.krope + (size_t)b * SEQ * 64;
    auto ksrc = [&](int pos0) { return [=](int row, int gc) { return gc < 16 ? kvb + (size_t)(pos0 + row) * 1024 + gc * 8 : krb + (size_t)(pos0 + row) * 64 + (gc - 16) * 8; }; };
    auto vsrc = [&](int pos0) { return [=](int row, int gc) { return kvb + (size_t)(pos0 + row) * 1024 + 128 + gc * 8; }; };
    att_stage<24>(kb, ksrc(i0 * 64), krc, wid);
    for (int i = i0; i < ntiles; ++i) {
        const int pos0 = i * 64;
        asm volatile("s_waitcnt vmcnt(0)" ::: "memory"); ATT_BAR();
        att_stage<16>(vb, vsrc(pos0), vrc, wid);
        const bool active = pos0 <= tw + 31, diag = pos0 + 63 > tw;
        bf16x8 pf[4];
        if (active) {
            if (diag) {
                int dq = tw + q - pos0 - 4 * hh; dq = dq < -1 ? -1 : dq;
                att_qk<12, 384, 1, true, false>(kb, L, qf, pf, lsum, c1, 0.f, (unsigned)(size_t)lut + (unsigned)(dq + 1) * 4u, 0, nullptr, 0.f);
            } else att_qk<12, 384, 0, true, false>(kb, L, qf, pf, lsum, c1, ATT_SHIFT, 0u, 0, nullptr, 0.f);
        }
        asm volatile("s_waitcnt vmcnt(0) lgkmcnt(0)" ::: "memory"); ATT_BAR();
        if (i + 1 < ntiles) att_stage<24>(kb, ksrc(pos0 + 64), krc, wid);
        if (active) att_pv<4, 256>(vb, L, pf, o);
    }
    const float lt = lsum + __shfl_xor(lsum, 32);
    int tid2 = tid0; asm volatile("" : "+v"(tid2));
    const int lane2 = tid2 & 63, trow = qt * 128 + (tid2 >> 6) * 32 + (lane2 & 31);
    bf16_t* op; float inv;
    if (part == 0) { inv = 1.0f / lt; op = p.o + (size_t)(b * SEQ + trow) * DM + h * 128 + 4 * (lane2 >> 5); }
    else {
        const size_t rec = (size_t)((part - 1) * 8 + bh) * (SEQ / 2) + (trow - SEQ / 2);
        inv = 1.0f; op = p.mlap + rec * 128 + 4 * (lane2 >> 5);
        if (lane2 < 32) p.mlal[rec] = lt;
    }
#pragma unroll
    for (int dt = 0; dt < 4; ++dt)
#pragma unroll
        for (int rq = 0; rq < 4; ++rq)
            *(u32x2*)(op + 32 * dt + 8 * rq) = (u32x2){cvtpk(o[dt][4 * rq] * inv, o[dt][4 * rq + 1] * inv), cvtpk(o[dt][4 * rq + 2] * inv, o[dt][4 * rq + 3] * inv)};
}
__device__ __forceinline__ void st_mla_combine(const P& p, int wg, int nwg) {
    const int TIDX = otid();
    const int wid = TIDX >> 6, lane = TIDX & 63;
    for (int w = wg * 4 + wid; w < 8 * (SEQ / 2); w += nwg * 4) {
        const int bh = w / (SEQ / 2), t = SEQ / 2 + w % (SEQ / 2), b = bh >> 2, h = bh & 3;
        const size_t r0 = (size_t)w, r1 = (size_t)(8 * (SEQ / 2) + w);
        const float inv = 1.0f / (p.mlal[r0] + p.mlal[r1]);
        const unsigned a = *(const unsigned*)(p.mlap + r0 * 128 + lane * 2), c = *(const unsigned*)(p.mlap + r1 * 128 + lane * 2);
        const float x0 = __uint_as_float(a << 16) + __uint_as_float(c << 16), x1 = __uint_as_float(a & 0xffff0000u) + __uint_as_float(c & 0xffff0000u);
        *(unsigned*)(p.o + (size_t)(b * SEQ + t) * DM + h * 128 + lane * 2) = cvtpk(x0 * inv, x1 * inv);
    }
}

__device__ __forceinline__ void swa_item(const P& p, const int item, LDSP char* lds, const int tid0) {
    LDSP char* kb = lds; LDSP char* vb = lds + 8192; LDSP float* luts = (LDSP float*)(lds + 46080);
    const float c1 = 0.125f * LOG2E;
    int tid = tid0; asm volatile("" : "+v"(tid));
    const int wid = tid >> 6, lane = tid & 63, q = lane & 31, hh = lane >> 5;
    AttLane L; att_lane_init<128, 128, 2>(L, lane);
    int rc[1]; att_stage_map<8>(rc, tid);
    const int b = item >> 9, kvh = (item >> 8) & 1, t0 = (item & 255) * 32, head = kvh * 4 + wid;
    bf16x8 qf[4];
    {
        const bf16_t* qp = p.proj1 + (size_t)(b * SEQ + t0 + q) * 1216 + 448 + head * 64 + 8 * hh;
#pragma unroll
        for (int ks = 0; ks < 4; ++ks) qf[ks] = *(const bf16x8*)(qp + 16 * ks);
    }
    f32x16 o[2];
#pragma unroll
    for (int dt = 0; dt < 2; ++dt)
#pragma unroll
        for (int r = 0; r < 16; ++r) o[dt][r] = 0.f;
    float lsum = 0.f;
    const bf16_t* kbp = p.proj1 + (size_t)b * SEQ * 1216 + 960 + kvh * 64;
    const bf16_t* zr = p.zrow;
    auto ksrc = [&](int pos0) { return [=](int row, int gc) { const int pos = pos0 + row; return (pos >= 0 && pos < SEQ) ? kbp + (size_t)pos * 1216 + gc * 8 : zr + gc * 8; }; };
    auto vsrc = [&](int pos0) { return [=](int row, int gc) { const int pos = pos0 + row; return (pos >= 0 && pos < SEQ) ? kbp + (size_t)pos * 1216 + 128 + gc * 8 : zr + gc * 8; }; };
    const unsigned tab = (unsigned)(size_t)(luts + head * 256);
    att_stage<8>(kb, ksrc(t0 - 128), rc, wid);
    for (int i = 0; i < 3; ++i) {
        const int pos0 = t0 - 128 + 64 * i;
        asm volatile("s_waitcnt vmcnt(0)" ::: "memory"); ATT_BAR();
        att_stage<8>(vb, vsrc(pos0), rc, wid);
        bf16x8 pf[4];
        int dq = t0 + q - pos0 - 4 * hh; dq = dq < -1 ? -1 : dq;
        att_qk<4, 128, 1, true, false>(kb, L, qf, pf, lsum, c1, 0.f, tab + (unsigned)(dq + 1) * 4u, 0, nullptr, 0.f);
        asm volatile("s_waitcnt vmcnt(0) lgkmcnt(0)" ::: "memory"); ATT_BAR();
        if (i + 1 < 3) att_stage<8>(kb, ksrc(pos0 + 64), rc, wid);
        att_pv<2, 128>(vb, L, pf, o);
    }
    const float lt = lsum + __shfl_xor(lsum, 32) + __builtin_amdgcn_exp2f(p.sinks[head] * LOG2E + ATT_SHIFT);
    const float inv = 1.0f / lt;
    bf16_t* op = p.o + (size_t)(b * SEQ + t0 + q) * DM + 512 + head * 64 + 4 * hh;
#pragma unroll
    for (int dt = 0; dt < 2; ++dt)
#pragma unroll
        for (int rq = 0; rq < 4; ++rq)
            *(u32x2*)(op + 32 * dt + 8 * rq) = (u32x2){cvtpk(o[dt][4 * rq] * inv, o[dt][4 * rq + 1] * inv), cvtpk(o[dt][4 * rq + 2] * inv, o[dt][4 * rq + 3] * inv)};
}
__device__ __forceinline__ void moe_conv_item(const P& p, const int layer, const int item, LDSP char* lds, const int tid0) {
    float* sm = (float*)lds;
    const int set = item >> 8, t0 = (item & 255) * 8;
    if (set == 0) conv_batched<1>(p.moe_wg + (size_t)layer * 16 * 1024 * 512, 16, 1024, 512, (size_t)1024 * 512, p.wt_gu + (size_t)layer * 16 * 1024 * 1024, (size_t)1024 * 1024, t0, 1, sm, tid0, t0 + 8);
    else if (set == 1) conv_batched<2>(p.moe_wu + (size_t)layer * 16 * 1024 * 512, 16, 1024, 512, (size_t)1024 * 512, p.wt_gu + (size_t)layer * 16 * 1024 * 1024, (size_t)1024 * 1024, t0, 1, sm, tid0, t0 + 8);
    else conv_batched<0>(p.moe_wd + (size_t)layer * 16 * 512 * 1024, 16, 512, 1024, (size_t)512 * 1024, p.wt_d + (size_t)layer * 16 * 1024 * 512, (size_t)1024 * 512, t0, 1, sm, tid0, t0 + 8);
}
__device__ __forceinline__ void st_attn1(const P& p, LDSP char* lds) {
    const int tid0 = otid();
    LDSP float* lut = (LDSP float*)(lds + 40960); LDSP int* slot = (LDSP int*)(lds + 45568); LDSP float* luts = (LDSP float*)(lds + 46080);
    for (int i = tid0; i < 1152; i += 256) lut[i] = (i < 64) ? ATT_NEG : ATT_SHIFT;
#pragma unroll 1
    for (int h = 0; h < 8; ++h) build_lut(luts + h * 256, p.blut + h * 1024, 256, 128, tid0);
    for (;;) {
        const int item = wq_next(p.wq + 0, slot, tid0);
        if (item >= 768 + 1024 + 768) break;
        if (item < 768) mla_item(p, item, lds, tid0);
        else { const int r = item - 768, g = r / 7, ps = r - g * 7;
               if (ps < 4) swa_item(p, g * 4 + ps, lds, tid0); else moe_conv_item(p, 1, g * 3 + ps - 4, lds, tid0); }
    }
}

#define A0_GLUT 16384
#define A0_WLUT 34816
#define A0_IMP 45056
#define A0_SEL 61568
#define A0_UN 62080
#define A0_LIST 62144
#define A0_SLOT 62720
__device__ __forceinline__ unsigned wmax_u32(unsigned v) {
#pragma unroll
    for (int o = 32; o > 0; o >>= 1) { const unsigned t = (unsigned)__shfl_xor((int)v, o); v = t > v ? t : v; }
    return v;
}
#define ATT_STORE_O(op, o, sc) do { _Pragma("unroll") for (int dt_ = 0; dt_ < 2; ++dt_) _Pragma("unroll") for (int rq_ = 0; rq_ < 4; ++rq_) \
        *(u32x2*)((op) + 32 * dt_ + 8 * rq_) = (u32x2){cvtpk((o)[dt_][4 * rq_] * (sc), (o)[dt_][4 * rq_ + 1] * (sc)), cvtpk((o)[dt_][4 * rq_ + 2] * (sc), (o)[dt_][4 * rq_ + 3] * (sc))}; } while (0)

__device__ __forceinline__ void nsa_item(const P& p, const int item, LDSP char* lds, const int tid0) {
    LDSP char* kb = lds; LDSP char* vb = lds + 8192;
    LDSP float* glut = (LDSP float*)(lds + A0_GLUT); LDSP float* wlut = (LDSP float*)(lds + A0_WLUT); LDSP float* imp = (LDSP float*)(lds + A0_IMP);
    LDSP unsigned* sel = (LDSP unsigned*)(lds + A0_SEL); LDSP unsigned* un = (LDSP unsigned*)(lds + A0_UN); LDSP unsigned short* blist = (LDSP unsigned short*)(lds + A0_LIST);
    const float c1 = 0.125f * LOG2E;
    int tid = tid0; asm volatile("" : "+v"(tid));
    const int wid = tid >> 6, lane = tid & 63, q = lane & 31, hh = lane >> 5;
    const int tile = 255 - (item >> 2), b = (item >> 1) & 1, kvh = item & 1, t0 = tile * 32, blk_t = t0 >> 6, head = kvh * 4 + wid;
#pragma unroll 1
    for (int h = 0; h < 4; ++h) { build_lut(glut + h * 1152, p.blut + (kvh * 4 + h) * 1024, 1152, 1 << 30, tid); build_lut(wlut + h * 640, p.blut + (kvh * 4 + h) * 1024, 640, 512, tid); }
    for (int i = tid; i < 32 * 129; i += 256) imp[i] = 0.f;
    AttLane L; att_lane_init<128, 128, 2>(L, lane);
    int rc[1]; att_stage_map<8>(rc, tid);
    const size_t rowq = (size_t)(b * SEQ + t0 + q);
    bf16x8 qf[4];
    {
        const bf16_t* qp = p.proj + rowq * 2840 + head * 64 + 8 * hh;
#pragma unroll
        for (int ks = 0; ks < 4; ++ks) qf[ks] = *(const bf16x8*)(qp + 16 * ks);
    }
    const float gc = p.gates[rowq * 24 + head * 3 + 0], gs = p.gates[rowq * 24 + head * 3 + 1], gw = p.gates[rowq * 24 + head * 3 + 2];
    const unsigned gtab = (unsigned)(size_t)(glut + wid * 1152), wtab = (unsigned)(size_t)(wlut + wid * 640);
    const bf16_t* zr = p.zrow;
    const bf16_t* pb = p.proj + (size_t)b * SEQ * 2840;
    f32x16 of[2], o[2];
#pragma unroll
    for (int dt = 0; dt < 2; ++dt)
#pragma unroll
        for (int r = 0; r < 16; ++r) { of[dt][r] = 0.f; o[dt][r] = 0.f; }
    bf16x8 pf[4];
    __syncthreads();
    const float cfar = glut[wid * 1152 + 64 + 1023];
    {
        int nvm = (t0 >> 4) + 1; nvm = nvm > 511 ? 511 : nvm;
        const int ntc = (nvm + 63) >> 6;
        const bf16_t* kcb = p.kcmpb + (size_t)((b * 2 + kvh) * 512) * 64;
        const bf16_t* vcb = p.kcmpb + (size_t)((4 + b * 2 + kvh) * 512) * 64;
        auto csrc = [&](const bf16_t* base, int n0) { return [=](int row, int gcx) { const int n = n0 + row; return n < 511 ? base + (size_t)n * 64 + gcx * 8 : zr + gcx * 8; }; };
        float lsum = 0.f;
        for (int nt = 0; nt < ntc; ++nt) {
            att_stage<8>(kb, csrc(kcb, nt * 64), rc, wid);
            asm volatile("s_waitcnt vmcnt(0)" ::: "memory"); ATT_BAR();
            const int dq16 = t0 + q - 31 - 1024 * nt - 64 * hh;
            if (t0 - 31 - 16 * (nt * 64 + 63) >= 1023) att_qk<4, 128, 0, false, false>(kb, L, qf, pf, lsum, c1, cfar, 0u, 0, nullptr, 0.f);
            else att_qk<4, 128, 2, false, false>(kb, L, qf, pf, lsum, c1, 0.f, gtab, dq16, nullptr, 0.f);
            asm volatile("s_waitcnt lgkmcnt(0)" ::: "memory"); ATT_BAR();
        }
        const float lc = lsum + __shfl_xor(lsum, 32);
        const float invl = lc > 0.f ? 1.0f / lc : 0.f;
        float dummy = 0.f;
        for (int nt = 0; nt < ntc; ++nt) {
            att_stage<8>(kb, csrc(kcb, nt * 64), rc, wid);
            att_stage<8>(vb, csrc(vcb, nt * 64), rc, wid);
            asm volatile("s_waitcnt vmcnt(0)" ::: "memory"); ATT_BAR();
            const int dq16 = t0 + q - 31 - 1024 * nt - 64 * hh;
            LDSP float* improw = imp + q * 129 + 16 * nt + hh;
            if (t0 - 31 - 16 * (nt * 64 + 63) >= 1023) att_qk<4, 128, 0, true, true>(kb, L, qf, pf, dummy, c1, cfar, 0u, 0, improw, invl * 524288.0f);
            else att_qk<4, 128, 2, true, true>(kb, L, qf, pf, dummy, c1, 0.f, gtab, dq16, improw, invl * 524288.0f);
            att_pv<2, 128>(vb, L, pf, o);
            asm volatile("s_waitcnt lgkmcnt(0)" ::: "memory"); ATT_BAR();
        }
        const float sc = gc * invl;
#pragma unroll
        for (int dt = 0; dt < 2; ++dt)
#pragma unroll
            for (int r = 0; r < 16; ++r) { of[dt][r] = o[dt][r] * sc; o[dt][r] = 0.f; }
    }
    __syncthreads();
    {
        unsigned u0 = 0u, u1 = 0u, u2 = 0u, u3 = 0u;
        for (int i = 0; i < 8; ++i) {
            const int tok = wid * 8 + i;
            const unsigned v0 = ((LDSP const unsigned*)imp)[tok * 129 + lane], v1 = ((LDSP const unsigned*)imp)[tok * 129 + 64 + lane];
            const int j0 = lane, j1 = lane + 64;
            const bool f0 = (j0 == 0) || (j0 == blk_t) || (j0 == blk_t - 1), f1 = (j1 == blk_t) || (j1 == blk_t - 1);
            unsigned k0 = f0 ? (0xFFFFFF80u | (unsigned)(127 - j0)) : (j0 <= blk_t ? ((v0 << 7) | (unsigned)(127 - j0)) : 0u);
            unsigned k1 = f1 ? (0xFFFFFF80u | (unsigned)(127 - j1)) : (j1 <= blk_t ? ((v1 << 7) | (unsigned)(127 - j1)) : 0u);
            unsigned thr = 0u;
#pragma unroll 1
            for (int bit = 31; bit >= 0; --bit) {
                const unsigned cand = thr | (1u << bit);
                const int c = __popcll(__ballot(k0 >= cand)) + __popcll(__ballot(k1 >= cand));
                thr = (c >= 16) ? cand : thr;
            }
            thr = thr ? thr : 1u;
            const unsigned long long b0 = __ballot(k0 >= thr), b1 = __ballot(k1 >= thr);
            const unsigned m0 = (unsigned)b0, m1 = (unsigned)(b0 >> 32), m2 = (unsigned)b1, m3 = (unsigned)(b1 >> 32);
            if (lane == 0) { sel[tok * 4 + 0] = m0; sel[tok * 4 + 1] = m1; sel[tok * 4 + 2] = m2; sel[tok * 4 + 3] = m3; }
            u0 |= m0; u1 |= m1; u2 |= m2; u3 |= m3;
        }
        if (lane == 0) { un[wid * 4 + 0] = u0; un[wid * 4 + 1] = u1; un[wid * 4 + 2] = u2; un[wid * 4 + 3] = u3; }
    }
    __syncthreads();
    {
        unsigned uw[4];
#pragma unroll
        for (int k = 0; k < 4; ++k) uw[k] = (unsigned)__builtin_amdgcn_readfirstlane((int)(un[k] | un[4 + k] | un[8 + k] | un[12 + k]));
        if (tid < 128) {
            const int k = tid >> 5, jb = tid & 31;
            unsigned wv = 0u; int below = 0;
#pragma unroll
            for (int kk = 0; kk < 4; ++kk) { if (kk == k) wv = uw[kk]; if (kk < k) below += __popc(uw[kk]); }
            if ((wv >> jb) & 1u) blist[below + __popc(wv & ((1u << jb) - 1u))] = (unsigned short)tid;
        }
        const int nb = __popc(uw[0]) + __popc(uw[1]) + __popc(uw[2]) + __popc(uw[3]);
        unsigned sq[4];
#pragma unroll
        for (int k = 0; k < 4; ++k) sq[k] = sel[q * 4 + k];
        __syncthreads();
        const bf16_t* ksb = pb + 768 + kvh * 64;
        auto ssrc = [&](int pos0, int colo) { return [=](int row, int gcx) { return ksb + (size_t)(pos0 + row) * 2840 + colo + gcx * 8; }; };
        float lsum = 0.f;
        att_stage<8>(kb, ssrc(64 * (int)blist[0], 0), rc, wid);
        for (int i = 0; i < nb; ++i) {
            const int j = __builtin_amdgcn_readfirstlane((int)blist[i]), pos0 = 64 * j;
            asm volatile("s_waitcnt vmcnt(0)" ::: "memory"); ATT_BAR();
            att_stage<8>(vb, ssrc(pos0, 128), rc, wid);
            unsigned sw = 0u;
#pragma unroll
            for (int k = 0; k < 4; ++k) if ((j >> 5) == k) sw = sq[k];
            const bool selq = (sw >> (j & 31)) & 1u;
            if (t0 - (pos0 + 63) >= 1023) att_qk<4, 128, 0, true, false>(kb, L, qf, pf, lsum, c1, selq ? cfar : ATT_NEG, 0u, 0, nullptr, 0.f);
            else {
                int dq = t0 + q - pos0 - 4 * hh; dq = dq > 1087 ? 1087 : dq; dq = (dq < -1 || !selq) ? -1 : dq;
                att_qk<4, 128, 1, true, false>(kb, L, qf, pf, lsum, c1, 0.f, gtab + (unsigned)(dq + 1) * 4u, 0, nullptr, 0.f);
            }
            asm volatile("s_waitcnt vmcnt(0) lgkmcnt(0)" ::: "memory"); ATT_BAR();
            if (i + 1 < nb) att_stage<8>(kb, ssrc(64 * (int)blist[i + 1], 0), rc, wid);
            att_pv<2, 128>(vb, L, pf, o);
        }
        const float ls = lsum + __shfl_xor(lsum, 32);
        const float sc = gs / ls;
#pragma unroll
        for (int dt = 0; dt < 2; ++dt)
#pragma unroll
            for (int r = 0; r < 16; ++r) { of[dt][r] += o[dt][r] * sc; o[dt][r] = 0.f; }
    }
    {
        const bf16_t* kwb = pb + 1024 + kvh * 64;
        auto wsrc = [&](int pos0, int colo) { return [=](int row, int gcx) { const int pos = pos0 + row; return (pos >= 0 && pos < SEQ) ? kwb + (size_t)pos * 2840 + colo + gcx * 8 : zr + gcx * 8; }; };
        float lsum = 0.f;
        asm volatile("s_waitcnt lgkmcnt(0)" ::: "memory"); ATT_BAR();
        att_stage<8>(kb, wsrc(t0 - 512, 0), rc, wid);
        for (int i = 0; i < 9; ++i) {
            const int pos0 = t0 - 512 + 64 * i;
            asm volatile("s_waitcnt vmcnt(0)" ::: "memory"); ATT_BAR();
            att_stage<8>(vb, wsrc(pos0, 128), rc, wid);
            int dq = t0 + q - pos0 - 4 * hh; dq = dq < -1 ? -1 : dq;
            att_qk<4, 128, 1, true, false>(kb, L, qf, pf, lsum, c1, 0.f, wtab + (unsigned)(dq + 1) * 4u, 0, nullptr, 0.f);
            asm volatile("s_waitcnt vmcnt(0) lgkmcnt(0)" ::: "memory"); ATT_BAR();
            if (i + 1 < 9) att_stage<8>(kb, wsrc(pos0 + 64, 0), rc, wid);
            att_pv<2, 128>(vb, L, pf, o);
        }
        const float lw = lsum + __shfl_xor(lsum, 32);
        const float sc = gw / lw;
#pragma unroll
        for (int dt = 0; dt < 2; ++dt)
#pragma unroll
            for (int r = 0; r < 16; ++r) of[dt][r] += o[dt][r] * sc;
    }
    bf16_t* op = p.o + rowq * DM + head * 64 + 4 * hh;
    ATT_STORE_O(op, of, 1.0f);
}

#define MG_CNT 8192
#define MG_BASE 8320
#define MG_ENT 8448
__device__ __forceinline__ void st_moba_gate(const P& p, int wg, int nwg, LDSP char* lds) {
    const int tid = otid();
    const int wid = tid >> 6, lane = tid & 63, q = lane & 31, hh = lane >> 5;
    LDSP char* kmt = lds; LDSP int* lcnt = (LDSP int*)(lds + MG_CNT); LDSP int* lbase = (LDSP int*)(lds + MG_BASE); LDSP int* ent = (LDSP int*)(lds + MG_ENT);
    AttLane L; att_lane_init<128, 128, 2>(L, lane);
    int rc[1]; att_stage_map<8>(rc, tid);
    const bf16_t* zr = p.zrow;
    for (int item = wg; item < 1024; item += nwg) {
        const int tile = item >> 4, b = (item >> 3) & 1, h = item & 7, t0 = tile * 128, own = t0 >> 8, tw = t0 + wid * 32, bh = b * 8 + h;
        if (own == 0) continue;
        __syncthreads();
        if (tid < 32) lcnt[tid] = 0;
        bf16x8 qf[4];
        {
            const bf16_t* qp = p.proj + (size_t)(b * SEQ + tw + q) * 2840 + 1304 + h * 64 + 8 * hh;
#pragma unroll
            for (int ks = 0; ks < 4; ++ks) qf[ks] = *(const bf16x8*)(qp + 16 * ks);
        }
        const bf16_t* kmb = p.kmeanb + (size_t)(bh * 32) * 64;
        att_stage<8>(kmt, [=](int row, int gcx) { return row < 32 ? kmb + (size_t)row * 64 + gcx * 8 : zr + gcx * 8; }, rc, wid);
        asm volatile("s_waitcnt vmcnt(0)" ::: "memory");
        __syncthreads();
        f32x16 s;
#pragma unroll
        for (int r = 0; r < 16; ++r) s[r] = 0.f;
#pragma unroll
        for (int ks = 0; ks < 4; ++ks) {
            const bf16x8 a = *(const LDSP bf16x8*)(kmt + (L.kbase ^ (32 * (ks & 3))));
            s = __builtin_amdgcn_mfma_f32_32x32x16_bf16(a, qf[ks], s, 0, 0, 0);
        }
        unsigned key[16];
#pragma unroll
        for (int r = 0; r < 16; ++r) {
            const int j = (r & 3) + 8 * (r >> 2) + 4 * hh;
            const unsigned bits = __float_as_uint(s[r]);
            const unsigned srt = (bits & 0x80000000u) ? ~bits : (bits | 0x80000000u);
            key[r] = (j < own) ? ((srt & ~31u) | (unsigned)(31 - j)) : 0u;
        }
        unsigned selm = 0u;
#pragma unroll 1
        for (int rnd = 0; rnd < 3; ++rnd) {
            unsigned m = 0u;
#pragma unroll
            for (int r = 0; r < 16; ++r) m = key[r] > m ? key[r] : m;
            const unsigned mo = (unsigned)__shfl_xor((int)m, 32);
            const unsigned wk = mo > m ? mo : m;
            if (wk != 0u) selm |= 1u << (31 - (wk & 31u));
#pragma unroll
            for (int r = 0; r < 16; ++r) key[r] = (key[r] == wk) ? 0u : key[r];
        }
        if (hh == 0) {
            unsigned mm = selm;
#pragma unroll
            for (int sI = 0; sI < 3; ++sI) {
                int en = -1;
                if (mm) { const int j = __builtin_ctz(mm); mm &= mm - 1u; const int lp = __hip_atomic_fetch_add(lcnt + j, 1, __ATOMIC_RELAXED, __HIP_MEMORY_SCOPE_WORKGROUP); en = (j << 8) | lp; }
                ent[(wid * 32 + q) * 3 + sI] = en;
            }
        }
        __syncthreads();
        if (tid < 32) { const int c = lcnt[tid]; lbase[tid] = c ? atomicAdd(p.mcnt + bh * 32 + tid, c) : 0; }
        __syncthreads();
        for (int e = tid; e < 384; e += 256) {
            const int en = ent[e];
            if (en >= 0) { const int j = en >> 8, tokl = e / 3, sI = e - tokl * 3; p.mlist[(size_t)(bh * 32 + j) * 8192 + lbase[j] + (en & 255)] = (unsigned short)((t0 + tokl) | (sI << 13)); }
        }
    }
}
__device__ __forceinline__ bf16_t* moba_part(const P& p, int slot, size_t row) { return (slot < 2 ? p.mp01 + (size_t)slot * 131072 * 64 : p.mp2) + row * 64; }

__device__ __forceinline__ void moba_inv_item(const P& p, const int lid, const int chunk, LDSP char* lds, const int tid0) {
    LDSP char* kb = lds; LDSP char* vb = lds + 8192; LDSP float* glut = (LDSP float*)(lds + A0_GLUT);
    const float c1 = 0.125f * LOG2E;
    int tid = tid0; asm volatile("" : "+v"(tid));
    const int wid = tid >> 6, lane = tid & 63, q = lane & 31, hh = lane >> 5;
    const int bh = lid / 31, j = lid - bh * 31, b = bh >> 3, h = bh & 7;
    build_lut(glut, p.blut + h * 1024, 1152, 1 << 30, tid);
    AttLane L; att_lane_init<128, 128, 2>(L, lane);
    int rc[1]; att_stage_map<8>(rc, tid);
    const int n = p.mcnt[bh * 32 + j], idx = chunk * 128 + wid * 32 + q;
    const bool valid = idx < n;
    const unsigned en = valid ? (unsigned)p.mlist[(size_t)(bh * 32 + j) * 8192 + idx] : (unsigned)(256 * (j + 1));
    const int tok = (int)(en & 8191u), slot = (int)(en >> 13);
    bf16x8 qf[4];
    {
        const bf16_t* qp = p.proj + (size_t)(b * SEQ + tok) * 2840 + 1304 + h * 64 + 8 * hh;
#pragma unroll
        for (int ks = 0; ks < 4; ++ks) qf[ks] = *(const bf16x8*)(qp + 16 * ks);
    }
    const unsigned gtab = (unsigned)(size_t)glut;
    const bf16_t* kbb = p.proj + (size_t)b * SEQ * 2840 + 1816 + h * 64;
    auto msrc = [&](int pos0, int colo) { return [=](int row, int gcx) { return kbb + (size_t)(pos0 + row) * 2840 + colo + gcx * 8; }; };
    f32x16 o[2];
#pragma unroll
    for (int dt = 0; dt < 2; ++dt)
#pragma unroll
        for (int r = 0; r < 16; ++r) o[dt][r] = 0.f;
    float lsum = 0.f;
    bf16x8 pf[4];
    __syncthreads();
    att_stage<8>(kb, msrc(256 * j, 0), rc, wid);
    for (int i = 0; i < 4; ++i) {
        const int pos0 = 256 * j + 64 * i;
        asm volatile("s_waitcnt vmcnt(0)" ::: "memory"); ATT_BAR();
        att_stage<8>(vb, msrc(pos0, 512), rc, wid);
        {
            int dq = tok - pos0 - 4 * hh; dq = dq > 1087 ? 1087 : dq; dq = valid ? dq : -1;
            att_qk<4, 128, 1, true, false>(kb, L, qf, pf, lsum, c1, 0.f, gtab + (unsigned)(dq + 1) * 4u, 0, nullptr, 0.f);
        }
        asm volatile("s_waitcnt vmcnt(0) lgkmcnt(0)" ::: "memory"); ATT_BAR();
        if (i + 1 < 4) att_stage<8>(kb, msrc(pos0 + 64, 0), rc, wid);
        att_pv<2, 128>(vb, L, pf, o);
    }
    const float lt = lsum + __shfl_xor(lsum, 32);
    if (valid) {
        const size_t row = (size_t)bh * SEQ + tok;
        bf16_t* op = moba_part(p, slot, row) + 4 * hh;
        ATT_STORE_O(op, o, 1.0f);
        if (hh == 0) p.mpl[(size_t)slot * 131072 + row] = lt;
    }
}
__device__ __forceinline__ void moba_own_item(const P& p, const int item, LDSP char* lds, const int tid0) {
    LDSP char* kb = lds; LDSP char* vb = lds + 8192; LDSP float* glut = (LDSP float*)(lds + A0_GLUT);
    const float c1 = 0.125f * LOG2E;
    int tid = tid0; asm volatile("" : "+v"(tid));
    const int wid = tid >> 6, lane = tid & 63, q = lane & 31, hh = lane >> 5;
    const int tile = item >> 4, b = (item >> 3) & 1, h = item & 7, t0 = tile * 128, own = t0 >> 8, tw = t0 + wid * 32, bh = b * 8 + h;
    __syncthreads();
    build_lut(glut, p.blut + h * 1024, 1152, 1 << 30, tid);
    AttLane L; att_lane_init<128, 128, 2>(L, lane);
    int rc[1]; att_stage_map<8>(rc, tid);
    const size_t rowq = (size_t)(b * SEQ + tw + q);
    bf16x8 qf[4];
    {
        const bf16_t* qp = p.proj + rowq * 2840 + 1304 + h * 64 + 8 * hh;
#pragma unroll
        for (int ks = 0; ks < 4; ++ks) qf[ks] = *(const bf16x8*)(qp + 16 * ks);
    }
    const unsigned gtab = (unsigned)(size_t)glut;
    const bf16_t* kbb = p.proj + (size_t)b * SEQ * 2840 + 1816 + h * 64;
    auto msrc = [&](int pos0, int colo) { return [=](int row, int gcx) { return kbb + (size_t)(pos0 + row) * 2840 + colo + gcx * 8; }; };
    f32x16 o[2];
#pragma unroll
    for (int dt = 0; dt < 2; ++dt)
#pragma unroll
        for (int r = 0; r < 16; ++r) o[dt][r] = 0.f;
    float lsum = 0.f;
    bf16x8 pf[4];
    const int nb = (((t0 + 127) >> 6) & 3) + 1;
    __syncthreads();
    att_stage<8>(kb, msrc(256 * own, 0), rc, wid);
    for (int i = 0; i < nb; ++i) {
        const int pos0 = 256 * own + 64 * i;
        asm volatile("s_waitcnt vmcnt(0)" ::: "memory"); ATT_BAR();
        att_stage<8>(vb, msrc(pos0, 512), rc, wid);
        const bool active = pos0 <= tw + 31;
        if (active) {
            int dq = tw + q - pos0 - 4 * hh; dq = dq < -1 ? -1 : dq;
            att_qk<4, 128, 1, true, false>(kb, L, qf, pf, lsum, c1, 0.f, gtab + (unsigned)(dq + 1) * 4u, 0, nullptr, 0.f);
        }
        asm volatile("s_waitcnt vmcnt(0) lgkmcnt(0)" ::: "memory"); ATT_BAR();
        if (i + 1 < nb) att_stage<8>(kb, msrc(pos0 + 64, 0), rc, wid);
        if (active) att_pv<2, 128>(vb, L, pf, o);
    }
    float lt = lsum + __shfl_xor(lsum, 32);
    const int npick = own < 3 ? own : 3;
    const size_t row = (size_t)bh * SEQ + tw + q;
#pragma unroll 1
    for (int sI = 0; sI < npick; ++sI) {
        lt += p.mpl[(size_t)sI * 131072 + row];
        const bf16_t* pp = moba_part(p, sI, row) + 4 * hh;
#pragma unroll
        for (int dt = 0; dt < 2; ++dt)
#pragma unroll
            for (int rq = 0; rq < 4; ++rq) {
                const u32x2 w = *(const u32x2*)(pp + 32 * dt + 8 * rq);
                o[dt][4 * rq] += __uint_as_float(w[0] << 16); o[dt][4 * rq + 1] += __uint_as_float(w[0] & 0xffff0000u);
                o[dt][4 * rq + 2] += __uint_as_float(w[1] << 16); o[dt][4 * rq + 3] += __uint_as_float(w[1] & 0xffff0000u);
            }
    }
    const float inv = 1.0f / lt;
    bf16_t* op = p.o + rowq * DM + 512 + h * 64 + 4 * hh;
    ATT_STORE_O(op, o, inv);
}
__device__ __forceinline__ void st_moba_own(const P& p, int wg, int nwg, LDSP char* lds) {
    const int tid0 = otid();
    for (int item = wg; item < 1024; item += nwg) moba_own_item(p, item, lds, tid0);
}
#define A0_PRE 62736
__device__ __forceinline__ void st_attn0(const P& p, LDSP char* lds) {
    const int tid0 = otid();
    LDSP int* slot = (LDSP int*)(lds + A0_SLOT); LDSP int* pre = (LDSP int*)(lds + A0_PRE);
    LDSP int* tmp = (LDSP int*)lds;
    for (int i = tid0; i < 496; i += 256) { const int bh = i / 31, j = i - bh * 31; tmp[i] = (p.mcnt[bh * 32 + j] + 127) >> 7; }
    __syncthreads();
    for (int i = tid0; i < 497; i += 256) { int s = 0; for (int k = 0; k < i; ++k) s += tmp[k]; pre[i] = s; }
    __syncthreads();
    const int ninv = pre[496];
    for (;;) {
        const int item = wq_next(p.wq + 1, slot, tid0);
        const int ntail = 5 * 768 + (ninv > 3072 ? ninv - 3072 : 0);
        if (item >= 1024 + ntail) break;
        if (item < 1024) nsa_item(p, item, lds, tid0);
        else {
            const int r = item - 1024, g = r / 5, ps = r - g * 5;
            if (g < 768 && ps == 4) { moe_conv_item(p, 0, g, lds, tid0); continue; }
            const int idx = (g < 768) ? g * 4 + ps : 3072 + (r - 5 * 768);
            if (idx >= ninv) continue;
            int lo = 0, hi = 495;
            while (lo < hi) { const int mid = (lo + hi + 1) >> 1; if (pre[mid] <= idx) lo = mid; else hi = mid - 1; }
            moba_inv_item(p, lo, idx - pre[lo], lds, tid0);
        }
    }
}

#define XB_TMO      128
#define XB_XCNT(j)  (256  + 64 * (j))
#define XB_XSUB(j)  (1280 + 64 * (j))
#define XB_XGEN(j)  (2304 + 64 * (j))
#define XB_TOP      3328
#define XB_TOPGEN   3392
#define XCD_BAR_WORDS 3456
#define XB_SPIN_CAP (1u << 20)
#define LAS __attribute__((address_space(3)))

__device__ __forceinline__ unsigned xb_ld(unsigned* p)              { return __hip_atomic_load(p, __ATOMIC_RELAXED, __HIP_MEMORY_SCOPE_AGENT); }
__device__ __forceinline__ unsigned xb_add(unsigned* p, unsigned v) { return __hip_atomic_fetch_add(p, v, __ATOMIC_RELAXED, __HIP_MEMORY_SCOPE_AGENT); }
__device__ __forceinline__ unsigned xb_xcc_id() { return (unsigned)__builtin_amdgcn_s_getreg((3 << 11) | 20) & 0xFu; }
#define XB_SPIN(cond, bar) do { unsigned _sp = 0; while (cond) { __builtin_amdgcn_s_sleep(1); \
    if ((++_sp & 255u) == 0u) { if (xb_ld(&(bar)[XB_TMO])) break; if (_sp > XB_SPIN_CAP) { atomicAdd(&(bar)[XB_TMO], 1u); break; } } } } while (0)

struct XcdBarrier {
    unsigned* bar; unsigned x;
    volatile LAS unsigned* st;
};

__device__ __forceinline__ XcdBarrier xcd_barrier_post(unsigned* bar, volatile LAS unsigned* st) {
    XcdBarrier b; b.bar = bar; b.x = xb_xcc_id(); b.st = st;
    if (threadIdx.x == 0) (void)xb_add(&bar[XB_XCNT(b.x)], 1u);
    return b;
}
__device__ __forceinline__ void xcd_barrier_complete(unsigned* bar, unsigned x, unsigned& nloc, unsigned& nx) {
    const unsigned G = gridDim.x * gridDim.y * gridDim.z;
    unsigned sum, cnt, mine, sp = 0u;
    for (;;) {
        sum = 0u; cnt = 0u; mine = 0u;
#pragma unroll
        for (unsigned j = 0; j < 16; ++j) { const unsigned c = xb_ld(&bar[XB_XCNT(j)]); sum += c; cnt += (c > 0u) ? 1u : 0u; mine = (j == x) ? c : mine; }
        if (sum == G) break;
        __builtin_amdgcn_s_sleep(1);
        if ((++sp & 255u) == 0u) { if (xb_ld(&bar[XB_TMO])) break; if (sp > XB_SPIN_CAP) { atomicAdd(&bar[XB_TMO], 1u); break; } }
    }
    nloc = mine > 0u ? mine : 1u; nx = cnt > 0u ? cnt : 1u;
}

__device__ __forceinline__ void xcd_barrier(const XcdBarrier& b) {
    asm volatile("s_waitcnt vmcnt(0)" ::: "memory");
    __syncthreads();
    if (threadIdx.x == 0) {
        unsigned* bar = b.bar;
        __builtin_amdgcn_s_waitcnt(0);
        unsigned nloc = b.st[0], nx = b.st[1];
        if (nloc == 0u) { xcd_barrier_complete(bar, b.x, nloc, nx); b.st[0] = nloc; b.st[1] = nx; }
        const unsigned old = xb_add(&bar[XB_XSUB(b.x)], 1u);
        const unsigned gen = old / nloc;
        if (old + 1u == (gen + 1u) * nloc) {
            __builtin_amdgcn_fence(__ATOMIC_RELEASE, "agent");
            asm volatile("s_waitcnt vmcnt(0)" ::: "memory");
            const unsigned og = xb_add(&bar[XB_TOP], 1u);
            const unsigned tg = og / nx;
            if (og + 1u == (tg + 1u) * nx) xb_add(&bar[XB_TOPGEN], 1u);
            else XB_SPIN(xb_ld(&bar[XB_TOPGEN]) == tg, bar);
            __builtin_amdgcn_fence(__ATOMIC_ACQUIRE, "agent");
            xb_add(&bar[XB_XGEN(b.x)], 1u);
            asm volatile("s_waitcnt vmcnt(0)" ::: "memory");
        } else {
            XB_SPIN(xb_ld(&bar[XB_XGEN(b.x)]) == gen, bar);
            __builtin_amdgcn_fence(__ATOMIC_ACQUIRE, "agent");
            asm volatile("s_waitcnt vmcnt(0)" ::: "memory");
        }
    }
    __syncthreads();
}


#define PHASE_SYNC() do { PP qb_ = (PP)__builtin_amdgcn_kernarg_segment_ptr(); asm volatile("" : "+s"(qb_)); XcdBarrier b_; b_.bar = qb_->bar; b_.x = xb_xcc_id(); \
        b_.st = (volatile LAS unsigned*)(dlds + BAR_LDS_OFF); xcd_barrier(b_); } while (0)
typedef const __attribute__((address_space(4))) P* PP;
#define BAR_SAVE() const unsigned bs0_ = __builtin_amdgcn_readfirstlane(*(volatile LAS unsigned*)(dlds + BAR_LDS_OFF)), \
        bs1_ = __builtin_amdgcn_readfirstlane(*(volatile LAS unsigned*)(dlds + BAR_LDS_OFF + 4)); __syncthreads()
#define BAR_RESTORE() do { __syncthreads(); if (threadIdx.x == 0) { *(volatile LAS unsigned*)(dlds + BAR_LDS_OFF) = bs0_; *(volatile LAS unsigned*)(dlds + BAR_LDS_OFF + 4) = bs1_; } } while (0)
#define PHASE_ARGS() PP q_ = (PP)__builtin_amdgcn_kernarg_segment_ptr(); int wg = blockIdx.x, nwg = gridDim.x; asm volatile("" : "+s"(q_), "+s"(wg), "+s"(nwg)); P p; { const __attribute__((address_space(4))) unsigned long long* s64_ = (const __attribute__((address_space(4))) unsigned long long*)q_; void** d64_ = (void**)&p; _Pragma("unroll") for (int i_ = 0; i_ < (int)(sizeof(P) / 8); ++i_) d64_[i_] = (void*)(__attribute__((address_space(1))) void*)s64_[i_]; } float* sm = (float*)dlds; LDSP char* lds = (LDSP char*)dlds; (void)sm; (void)lds
__global__ void __launch_bounds__(256, 2) k_mega(P pk) {
    extern __shared__ __attribute__((aligned(16))) unsigned char dlds[];
    if (threadIdx.x == 0) *(uint4*)(dlds + BAR_LDS_OFF) = make_uint4(0u, 0u, 0u, 0u);
    __syncthreads();
    (void)xcd_barrier_post(pk.bar, (volatile LAS unsigned*)(dlds + BAR_LDS_OFF));
    { PHASE_ARGS(); st_prologue(p, wg, nwg, sm); st_convert(p, wg, nwg, sm); } PHASE_SYNC();
    { PHASE_ARGS(); st_norm<0>(p, 0, wg, nwg, sm); st_c1_reduce(p, wg, nwg); } PHASE_SYNC();
    { PHASE_ARGS(); BAR_SAVE(); st_inproj0_mf<6>(p, wg, nwg, lds); BAR_RESTORE(); } PHASE_SYNC();
    { PHASE_ARGS(); st_cmp1_mf(p, wg, nwg, lds); st_kmean(p, wg, nwg, sm); } PHASE_SYNC();
    { PHASE_ARGS(); st_cmp2_mf(p, wg, nwg, lds); st_moba_gate(p, wg, nwg, lds); } PHASE_SYNC();
    { PHASE_ARGS(); st_attn0(p, lds); } PHASE_SYNC();
    { PHASE_ARGS(); st_moba_own(p, wg, nwg, lds); } PHASE_SYNC();
    { PHASE_ARGS(); st_outproj_mf<4>(p, 0, wg, nwg, lds); } PHASE_SYNC();
    { PHASE_ARGS(); st_norm<1>(p, 0, wg, nwg, sm); } PHASE_SYNC();
    { PHASE_ARGS(); BAR_SAVE(); st_moe_up_mf<6>(p, 0, wg, nwg, lds); BAR_RESTORE(); } PHASE_SYNC();
    { PHASE_ARGS(); BAR_SAVE(); st_moe_down_mf<6>(p, 0, wg, nwg, lds); BAR_RESTORE(); } PHASE_SYNC();
    { PHASE_ARGS(); st_norm<2>(p, 1, wg, nwg, sm); } PHASE_SYNC();
    { PHASE_ARGS(); BAR_SAVE(); st_inproj1_mf<6>(p, wg, nwg, lds); BAR_RESTORE(); } PHASE_SYNC();
    { PHASE_ARGS(); st_mla_prep(p, wg, nwg); } PHASE_SYNC();
    { PHASE_ARGS(); st_mla_up_mf(p, wg, nwg, lds); } PHASE_SYNC();
    { PHASE_ARGS(); st_attn1(p, lds); } PHASE_SYNC();
    { PHASE_ARGS(); st_mla_combine(p, wg, nwg); } PHASE_SYNC();
    { PHASE_ARGS(); st_outproj_mf<4>(p, 1, wg, nwg, lds); } PHASE_SYNC();
    { PHASE_ARGS(); st_norm<1>(p, 1, wg, nwg, sm); } PHASE_SYNC();
    { PHASE_ARGS(); BAR_SAVE(); st_moe_up_mf<6>(p, 1, wg, nwg, lds); BAR_RESTORE(); } PHASE_SYNC();
    { PHASE_ARGS(); BAR_SAVE(); st_moe_down_mf<6>(p, 1, wg, nwg, lds); BAR_RESTORE(); } PHASE_SYNC();
    { PHASE_ARGS(); st_norm<3>(p, 1, wg, nwg, sm); }
}

extern "C" void kernel_launch(void* const* d_in, const int* in_sizes, int n_in, void* d_out, int out_size, void* d_ws, size_t ws_size,
                              hipStream_t stream) {
    (void)in_sizes; (void)n_in; (void)out_size; (void)ws_size;
    P p{};
    const float* const* in = (const float* const*)d_in;
    p.x = in[0]; p.c = in[1]; p.rel = in[2]; p.router_w = in[3]; p.router_b = in[4]; p.final_norm = in[5]; p.norm_mix = in[6]; p.norm_ffn = in[7];
    p.ada_w = in[8]; p.ada_b = in[9]; p.moe_wg = in[10]; p.moe_wu = in[11]; p.moe_wd = in[12]; p.ev_w_in = in[13]; p.ev_w_out = in[14];
    p.pos_k = in[15]; p.pos_v = in[16]; p.ck_w1 = in[17]; p.ck_w2 = in[18]; p.cv_w1 = in[19]; p.cv_w2 = in[20]; p.od_w_in = in[21]; p.od_w_out = in[22];
    p.q_norm = in[23]; p.kv_norm = in[24]; p.w_q_up = in[25]; p.w_kv_up = in[26]; p.sinks = in[27];
    p.out = (float*)d_out;
    char* ws = (char*)d_ws; size_t off = 0;
    auto take = [&](size_t bytes) { char* r = ws + off; off += (bytes + 255) & ~(size_t)255; return r; };
    p.bar = (unsigned*)take(16384);
    p.cnt = (int*)take(4096);
    p.wq = (int*)take(256);
    p.mcnt = (int*)take(512 * 4);
    p.modv = (float*)take(2 * 2 * 6144 * 4);
    p.zrow = (bf16_t*)take(256);
    const size_t zero_bytes = off;
    p.ropec = (float*)take(SEQ * 32 * 4); p.ropes = (float*)take(SEQ * 32 * 4);
    p.blut = (float*)take(8 * 1024 * 4);
    p.gates = (float*)take((size_t)T_TOK * 24 * 4);
    p.kmean = (float*)take(2 * 8 * 32 * 64 * 4);
    p.tokw = (float*)take((size_t)T_TOK * 2 * 4);
    p.list = (int*)take((size_t)16 * T_TOK * 4);
    p.cqn = (bf16_t*)take((size_t)T_TOK * 384 * 2);
    p.krope = (bf16_t*)take((size_t)T_TOK * 64 * 2);
    p.h = (bf16_t*)take((size_t)T_TOK * DM * 2);
    p.o = (bf16_t*)take((size_t)T_TOK * DM * 2);
    p.mlap = p.h;
    p.mlal = (float*)(p.h + (size_t)2 * 8 * (SEQ / 2) * 128);
    p.mp01 = p.h;
    p.mp2 = (bf16_t*)take((size_t)131072 * 64 * 2);
    p.mpl = (float*)take((size_t)3 * 131072 * 4);
    p.mlist = (unsigned short*)take((size_t)16 * 32 * 8192 * 2);
    p.hid = p.o;
    char* region = take((size_t)100 * 1024 * 1024);
    p.proj = (bf16_t*)region;
    p.proj1 = (bf16_t*)region;
    p.qmla = (bf16_t*)(region + (size_t)T_TOK * 1216 * 2);
    p.kvmla = (bf16_t*)(region + (size_t)T_TOK * (1216 + 768) * 2);
    p.y = (bf16_t*)region;
    p.xr1 = (bf16_t*)d_out;
    p.xr2 = (bf16_t*)((char*)d_out + (size_t)T_TOK * DM * 2);
    p.xr3 = (bf16_t*)(region + (size_t)2 * T_TOK * DM * 2);
    p.chidb = (bf16_t*)take((size_t)2 * 2048 * 256 * 2);
    p.kcmpb = (bf16_t*)take((size_t)8 * 512 * 64 * 2);
    p.kmeanb = (bf16_t*)take((size_t)2 * 8 * 32 * 64 * 2);
    p.c1 = (float*)take(512 * 4);
    p.c1p = (float*)take((size_t)2 * 64 * 256 * 4);
    p.wt_gu = (bf16_t*)take((size_t)32 * 1024 * 1024 * 2);
    p.wt_d = (bf16_t*)take((size_t)32 * 1024 * 512 * 2);
    p.wt_in0 = (bf16_t*)take((size_t)2840 * 1024 * 2);
    p.wt_out0 = (bf16_t*)take((size_t)1024 * 1024 * 2);
    p.wt_c1 = (bf16_t*)take((size_t)2 * 256 * 2048 * 2);
    p.wt_c2 = (bf16_t*)take((size_t)2 * 64 * 256 * 2);
    p.wt_in1 = (bf16_t*)take((size_t)1216 * 1024 * 2);
    p.wt_out1 = (bf16_t*)take((size_t)1024 * 1024 * 2);
    p.wt_qup = (bf16_t*)take((size_t)768 * 256 * 2);
    p.wt_kvup = (bf16_t*)take((size_t)1024 * 128 * 2);
    static int grid = 0;
    if (!grid) {
        int dev = 0, cus = 0, per_cu = 0;
        (void)hipGetDevice(&dev);
        (void)hipDeviceGetAttribute(&cus, hipDeviceAttributeMultiprocessorCount, dev);
        (void)hipFuncSetAttribute((const void*)k_mega, hipFuncAttributeMaxDynamicSharedMemorySize, KERNEL_LDS_BYTES);
        (void)hipOccupancyMaxActiveBlocksPerMultiprocessor(&per_cu, k_mega, 256, KERNEL_LDS_BYTES);
        if (cus <= 0) cus = 256;
        if (per_cu < 1) per_cu = 1;
        grid = cus * (per_cu < 2 ? per_cu : 2);
    }
    (void)hipMemsetAsync(d_ws, 0, zero_bytes, stream);
    hipLaunchKernelGGL(k_mega, dim3(grid), dim3(256), KERNEL_LDS_BYTES, stream, p);
}
```

```cpp
#include <hip/hip_runtime.h>
#include <stdint.h>

typedef unsigned u32x2n __attribute__((ext_vector_type(2)));
typedef float f32x2n __attribute__((ext_vector_type(2)));
#define T_TOK 16384
#define SEQ 8192
#define DM 1024
#define NEGF (-1e30f)
#define BIGF (1e30f)

typedef unsigned short bf16_t;

__device__ __forceinline__ float bf2f(bf16_t v) { return __uint_as_float(((unsigned)v) << 16); }
__device__ __forceinline__ bf16_t f2bf(float f) {
    unsigned u = __float_as_uint(f);
    u += 0x7fffu + ((u >> 16) & 1u);
    return (bf16_t)(u >> 16);
}
typedef __bf16 bf16x2_t __attribute__((ext_vector_type(2)));
typedef float f32x2_t __attribute__((ext_vector_type(2)));
__device__ __forceinline__ unsigned cvtpk(float lo, float hi) { const f32x2_t f = {lo, hi}; return __builtin_bit_cast(unsigned, __builtin_convertvector(f, bf16x2_t)); }
__device__ __forceinline__ unsigned cvtpk_valu(float lo, float hi) { unsigned r; asm("s_nop 0\n\tv_cvt_pk_bf16_f32 %0, %1, %2" : "=v"(r) : "v"(lo), "v"(hi)); return r; }
__device__ __forceinline__ float wsum(float v) {
    v += __builtin_bit_cast(float, __builtin_amdgcn_update_dpp(0, __builtin_bit_cast(int, v), 0xB1, 0xF, 0xF, true));
    v += __builtin_bit_cast(float, __builtin_amdgcn_update_dpp(0, __builtin_bit_cast(int, v), 0x4E, 0xF, 0xF, true));
    v += __builtin_bit_cast(float, __builtin_amdgcn_update_dpp(0, __builtin_bit_cast(int, v), 0x124, 0xF, 0xF, true));
    v += __builtin_bit_cast(float, __builtin_amdgcn_update_dpp(0, __builtin_bit_cast(int, v), 0x128, 0xF, 0xF, true));
    const int iv = __builtin_bit_cast(int, v);
    const float r0 = __builtin_bit_cast(float, __builtin_amdgcn_readlane(iv, 0)), r1 = __builtin_bit_cast(float, __builtin_amdgcn_readlane(iv, 16));
    const float r2 = __builtin_bit_cast(float, __builtin_amdgcn_readlane(iv, 32)), r3 = __builtin_bit_cast(float, __builtin_amdgcn_readlane(iv, 48));
    return (r0 + r1) + (r2 + r3);
}
__device__ __forceinline__ float siluf(float v) { return v / (1.0f + __expf(-v)); }
__device__ __forceinline__ float sigmf(float v) { return 1.0f / (1.0f + __expf(-v)); }
__device__ __forceinline__ float gelu_tanh(float x) {
    const float k0 = 0.7978845608028654f, k1 = 0.044715f;
    float u = k0 * (x + k1 * x * x * x);
    return 0.5f * x * (1.0f + tanhf(u));
}
__device__ __forceinline__ int rel_bucket(int d) {
    if (d < 16) return d < 0 ? 0 : d;
    int b = 16;
    b += (d >= 21); b += (d >= 27); b += (d >= 35); b += (d >= 46); b += (d >= 59); b += (d >= 77); b += (d >= 99); b += (d >= 128);
    b += (d >= 166); b += (d >= 216); b += (d >= 280); b += (d >= 363); b += (d >= 470); b += (d >= 609); b += (d >= 790);
    return b;
}

__device__ __forceinline__ int otid() { int t = threadIdx.x; asm volatile("" : "+v"(t)); return t; }

struct P {
    const float *x, *c, *rel, *router_w, *router_b, *final_norm, *norm_mix, *norm_ffn, *ada_w, *ada_b, *moe_wg, *moe_wu, *moe_wd,
        *ev_w_in, *ev_w_out, *pos_k, *pos_v, *ck_w1, *ck_w2, *cv_w1, *cv_w2, *od_w_in, *od_w_out, *q_norm, *kv_norm, *w_q_up, *w_kv_up, *sinks;
    float* out;
    unsigned* bar; int* cnt;
    float *modv, *ropec, *ropes, *blut, *gates, *kcmp, *vcmp, *chid, *kmean, *tokw;
    bf16_t *h, *proj, *o, *hid, *y, *proj1, *qmla, *kvmla, *krope, *cqn;
    int* list;
    bf16_t *wt_gu, *wt_d, *wt_in0, *wt_out0, *wt_c1, *wt_c2, *wt_in1, *wt_out1, *wt_qup, *wt_kvup, *chidb;
    float *c1, *c1p;
    int* wq;
    bf16_t* zrow;
    bf16_t *kcmpb, *kmeanb, *mlap;
    float* mlal;
    int* mcnt; unsigned short* mlist; bf16_t *mp01, *mp2; float* mpl;
    bf16_t *xr1, *xr2, *xr3;
};


__device__ __forceinline__ void st_prologue(const P& p, int wg, int nwg, float* sm) {
    const int TIDX = otid();
    const int tid = TIDX;
    {
        for (int i = tid; i < 2048; i += 256) sm[i] = siluf(p.c[i]);
        __syncthreads();
        const int wid = tid >> 6, lane = tid & 63;
        for (int w = wg; w < 192; w += nwg) {
            const int l = w / 96, cg = w % 96, col = cg * 64 + lane;
            const float* W = p.ada_w + (size_t)l * 1024 * 6144 + (size_t)(wid * 256) * 6144 + col;
            float a0 = 0.f, a1 = 0.f;
#pragma unroll 32
            for (int k = 0; k < 256; ++k) { const float wv = W[(size_t)k * 6144]; a0 += sm[wid * 256 + k] * wv; a1 += sm[1024 + wid * 256 + k] * wv; }
            sm[2048 + tid] = a0; sm[2304 + tid] = a1;
            __syncthreads();
            if (tid < 64) {
                const float bb = p.ada_b[l * 6144 + col];
                p.modv[(l * 2 + 0) * 6144 + col] = ((sm[2048 + tid] + sm[2048 + 64 + tid]) + (sm[2048 + 128 + tid] + sm[2048 + 192 + tid])) + bb;
                p.modv[(l * 2 + 1) * 6144 + col] = ((sm[2304 + tid] + sm[2304 + 64 + tid]) + (sm[2304 + 128 + tid] + sm[2304 + 192 + tid])) + bb;
            }
            __syncthreads();
        }
        __syncthreads();
    }
    for (int i = wg * 256 + tid; i < SEQ * 32; i += nwg * 256) {
        const int t = i >> 5, j = i & 31;
        const float inv = powf(10000.0f, -(float)(2 * j) / 64.0f);
        const float ang = (float)t * inv;
        p.ropec[i] = cosf(ang); p.ropes[i] = sinf(ang);
    }
    for (int i = wg * 256 + tid; i < 8 * 1024; i += nwg * 256) { const int h = i >> 10, d = i & 1023; p.blut[i] = p.rel[rel_bucket(d) * 8 + h]; }
}

#define RT_OFF 4096
template <int MODE>
__device__ __forceinline__ void st_norm(const P& p, int layer, int wg, int nwg, float* sm) {
    const int TIDX = otid();
    const int wid = TIDX >> 6, lane = TIDX & 63;
    int* rl_cnt = (int*)sm; int* rl_base = rl_cnt + 16; int* rl_ent = rl_cnt + 32; float* rl_lg = sm + 256;
    if (MODE == 1) {
        if (TIDX < 16) rl_cnt[TIDX] = 0;
        for (int i = TIDX; i < 64; i += 256) rl_ent[i] = -1;
        for (int idx = TIDX; idx < 4096; idx += 256) {
            const int col = idx >> 2, q = idx & 3;
            *(float4*)((char*)sm + RT_OFF + q * 16384 + (col & 3) * 4096 + ((col >> 8) * 64 + ((col >> 2) & 63)) * 16) = *(const float4*)(p.router_w + idx * 4);
        }
        __syncthreads();
    }
    const int niter = (T_TOK + nwg * 4 - 1) / (nwg * 4);
    constexpr bool XB = (MODE != 0);
    const float* xin = p.x;
    const bf16_t* xinb = (MODE == 1) ? (layer ? p.xr3 : p.xr1) : (MODE == 2) ? p.xr1 : p.xr3;
    float4 pre4[4]; u32x2n pre2[4];
    {
        const int row0 = wg * 4 + wid;
#pragma unroll
        for (int i = 0; i < 4; ++i) {
            if (XB) pre2[i] = (row0 < T_TOK) ? *(const u32x2n*)(xinb + (size_t)row0 * DM + i * 256 + lane * 4) : (u32x2n){0u, 0u};
            else pre4[i] = (row0 < T_TOK) ? *(const float4*)(xin + (size_t)row0 * DM + i * 256 + lane * 4) : make_float4(0.f, 0.f, 0.f, 0.f);
        }
    }
    for (int it = 0; it < niter; ++it) {
        const int row = wg * 4 + wid + it * nwg * 4;
        if (MODE != 1 && row >= T_TOK) break;
        float v[16];
#pragma unroll
        for (int i = 0; i < 4; ++i) {
            if (XB) { v[i * 4 + 0] = __uint_as_float(pre2[i][0] << 16); v[i * 4 + 1] = __uint_as_float(pre2[i][0] & 0xffff0000u); v[i * 4 + 2] = __uint_as_float(pre2[i][1] << 16); v[i * 4 + 3] = __uint_as_float(pre2[i][1] & 0xffff0000u); }
            else { v[i * 4 + 0] = pre4[i].x; v[i * 4 + 1] = pre4[i].y; v[i * 4 + 2] = pre4[i].z; v[i * 4 + 3] = pre4[i].w; }
        }
        {
            const int rown = row + nwg * 4;
            if (rown < T_TOK) {
#pragma unroll
                for (int i = 0; i < 4; ++i) {
                    if (XB) pre2[i] = *(const u32x2n*)(xinb + (size_t)rown * DM + i * 256 + lane * 4);
                    else pre4[i] = *(const float4*)(xin + (size_t)rown * DM + i * 256 + lane * 4);
                }
            }
        }
        if (MODE != 1 || row < T_TOK) {
        const int b = row >> 13;
        if (MODE >= 2) {
            const int lp = (MODE == 2) ? layer - 1 : 1;
            const float* gf = p.modv + (size_t)(lp * 2 + b) * 6144 + 5 * 1024;
#pragma unroll
            for (int i = 0; i < 4; ++i)
#pragma unroll
                for (int j = 0; j < 4; ++j) {
                    const int col = i * 256 + lane * 4 + j;
                    const float y0 = bf2f(p.y[(size_t)(2 * row) * DM + col]), y1 = bf2f(p.y[(size_t)(2 * row + 1) * DM + col]);
                    v[i * 4 + j] += gf[col] * (y0 + y1);
                }
            if (MODE == 2) {
#pragma unroll
                for (int i = 0; i < 4; ++i) {
                    const u32x2n xo = {cvtpk(v[i * 4], v[i * 4 + 1]), cvtpk(v[i * 4 + 2], v[i * 4 + 3])};
                    *(u32x2n*)(p.xr2 + (size_t)row * DM + i * 256 + lane * 4) = xo;
#pragma unroll
                    for (int j = 0; j < 4; ++j) v[i * 4 + j] = __uint_as_float((j & 1) ? (xo[j >> 1] & 0xffff0000u) : (xo[j >> 1] << 16));
                }
            }
        }
        float ss = 0.f;
#pragma unroll
        for (int i = 0; i < 16; ++i) ss += v[i] * v[i];
        ss = wsum(ss);
        const float r = rsqrtf(ss * (1.0f / 1024.0f) + 1e-6f);
        if (MODE == 3) {
#pragma unroll
            for (int i = 0; i < 4; ++i) {
                const float4 g4 = *(const float4*)(p.final_norm + i * 256 + lane * 4);
                *(float4*)(p.out + (size_t)row * DM + i * 256 + lane * 4) =
                    make_float4(v[i * 4] * r * g4.x, v[i * 4 + 1] * r * g4.y, v[i * 4 + 2] * r * g4.z, v[i * 4 + 3] * r * g4.w);
            }
            continue;
        }
        const float* g = ((MODE == 1) ? p.norm_ffn : p.norm_mix) + layer * 1024;
        const float* mv = p.modv + (size_t)(layer * 2 + b) * 6144;
        const float* shift = mv + ((MODE == 1) ? 3 : 0) * 1024;
        const float* scale = mv + ((MODE == 1) ? 4 : 1) * 1024;
        float hv[16];
#pragma unroll
        for (int i = 0; i < 4; ++i)
#pragma unroll
            for (int j = 0; j < 4; ++j) {
                const int col = i * 256 + lane * 4 + j;
                hv[i * 4 + j] = v[i * 4 + j] * r * g[col] * (1.0f + scale[col]) + shift[col];
                p.h[(size_t)row * DM + col] = f2bf(hv[i * 4 + j]);
            }
        if (MODE == 1) {
            f32x2n lg2[8];
#pragma unroll
            for (int e = 0; e < 8; ++e) lg2[e] = (f32x2n){0.f, 0.f};
#pragma unroll
            for (int i = 0; i < 4; ++i)
#pragma unroll
                for (int j = 0; j < 4; ++j) {
                    const char* rw = (const char*)sm + RT_OFF + lane * 16 + j * 4096 + i * 1024;
#pragma unroll
                    for (int q = 0; q < 4; ++q) {
                        const f32x2n* w2 = (const f32x2n*)(rw + q * 16384);
                        const f32x2n hh2 = {hv[i * 4 + j], hv[i * 4 + j]};
                        lg2[2 * q] = hh2 * w2[0] + lg2[2 * q]; lg2[2 * q + 1] = hh2 * w2[1] + lg2[2 * q + 1];
                    }
                    asm volatile("" ::: "memory");
                }
            float lg[16];
#pragma unroll
            for (int e = 0; e < 8; ++e) { lg[2 * e] = lg2[e][0]; lg[2 * e + 1] = lg2[e][1]; }
            float r8[8], r4[4], r2[2], r1;
#pragma unroll
            for (int k = 0; k < 8; ++k) {
                float sa = lg[k], sb = lg[8 + k];
                asm("s_nop 1\n\tv_permlane32_swap_b32 %0, %1\n\ts_nop 0" : "+v"(sa), "+v"(sb));
                r8[k] = sa + sb;
            }
#pragma unroll
            for (int k = 0; k < 4; ++k) {
                float sa = r8[k], sb = r8[4 + k];
                asm("s_nop 1\n\tv_permlane16_swap_b32 %0, %1\n\ts_nop 0" : "+v"(sa), "+v"(sb));
                r4[k] = sa + sb;
            }
            { const bool hi = (lane & 8) != 0;
#pragma unroll
              for (int k = 0; k < 2; ++k) { const float keep = hi ? r4[2 + k] : r4[k], send = hi ? r4[k] : r4[2 + k];
                                            r2[k] = keep + __builtin_bit_cast(float, __builtin_amdgcn_update_dpp(0, __builtin_bit_cast(int, send), 0x128, 0xF, 0xF, true)); } }
            { const bool hi = (lane & 4) != 0; const float keep = hi ? r2[1] : r2[0], send = hi ? r2[0] : r2[1]; r1 = keep + __shfl_xor(send, 4); }
            r1 += __builtin_bit_cast(float, __builtin_amdgcn_update_dpp(0, __builtin_bit_cast(int, r1), 0x4E, 0xF, 0xF, true));
            r1 += __builtin_bit_cast(float, __builtin_amdgcn_update_dpp(0, __builtin_bit_cast(int, r1), 0xB1, 0xF, 0xF, true));
            int t32a = 0, k32 = 1, t16a = 0, k16 = 1;
            asm("s_nop 1\n\tv_permlane32_swap_b32 %0, %1\n\ts_nop 0" : "+v"(t32a), "+v"(k32));
            asm("s_nop 1\n\tv_permlane16_swap_b32 %0, %1\n\ts_nop 0" : "+v"(t16a), "+v"(k16));
            if ((lane & 3) == 0) rl_lg[((it & 7) * 4 + wid) * 16 + (k32 * 8 + k16 * 4 + ((lane >> 3) & 1) * 2 + ((lane >> 2) & 1))] = r1;
        }
        }
        if (MODE == 1 && ((it & 7) == 7 || it == niter - 1)) {
            __syncthreads();
            if (TIDX < 32) {
                const int its = (it & ~7) + (TIDX >> 2), row = wg * 4 + (TIDX & 3) + its * nwg * 4;
                if (its <= it && row < T_TOK) {
                    float lg[16];
#pragma unroll
                    for (int e = 0; e < 16; ++e) lg[e] = rl_lg[TIDX * 16 + e];
                    float aff[16], bi[16];
        #pragma unroll
                    for (int e = 0; e < 16; ++e) { aff[e] = 1.0f / (1.0f + expf(-lg[e])); bi[e] = aff[e] + p.router_b[e]; }
                    float bestsc = -3e38f; int be0 = 0, be1 = 1; float bw0 = 0.f, bw1 = 0.f;
        #pragma unroll
                    for (int gI = 0; gI < 4; ++gI) {
                        int i1 = 0; float m1 = bi[gI * 4];
        #pragma unroll
                        for (int i = 1; i < 4; ++i) if (bi[gI * 4 + i] > m1) { m1 = bi[gI * 4 + i]; i1 = i; }
                        int i2 = -1; float m2 = -3e38f;
        #pragma unroll
                        for (int i = 0; i < 4; ++i) if (i != i1 && bi[gI * 4 + i] > m2) { m2 = bi[gI * 4 + i]; i2 = i; }
                        const float sc = m1 + m2;
                        float a1 = 0.f, a2 = 0.f;
        #pragma unroll
                        for (int i = 0; i < 4; ++i) { a1 = (i == i1) ? aff[gI * 4 + i] : a1; a2 = (i == i2) ? aff[gI * 4 + i] : a2; }
                        if (sc > bestsc) { bestsc = sc; be0 = gI * 4 + i1; be1 = gI * 4 + i2; bw0 = a1; bw1 = a2; }
                    }
                    const float ws = bw0 + bw1;
                    p.tokw[row * 2] = bw0 / ws; p.tokw[row * 2 + 1] = bw1 / ws;
                    const int r0 = atomicAdd(&rl_cnt[be0], 1), r1 = atomicAdd(&rl_cnt[be1], 1);
                    rl_ent[TIDX * 2] = (row << 12) | (be0 << 8) | r0;
                    rl_ent[TIDX * 2 + 1] = (row << 12) | (be1 << 8) | r1;
                }
            }
            __syncthreads();
            if (TIDX < 16) { const int c = rl_cnt[TIDX]; rl_base[TIDX] = c ? atomicAdd(&p.cnt[(layer * 16 + TIDX) * 32], c) : 0; rl_cnt[TIDX] = 0; }
            __syncthreads();
            if (TIDX < 64) {
                const int en = rl_ent[TIDX];
                if (en >= 0) { const int e = (en >> 8) & 15; p.list[e * T_TOK + rl_base[e] + (en & 255)] = (en >> 12) * 2 + (TIDX & 1); rl_ent[TIDX] = -1; }
            }
            __syncthreads();
        }
    }
}

__device__ __forceinline__ void st_kmean(const P& p, int wg, int nwg, float* sm) {
    const int TIDX = otid();
    const int wid = TIDX >> 6, lane = TIDX & 63;
    for (int w = wg; w < 2 * 8 * 32; w += nwg) {
        const int b = w >> 8, h = (w >> 5) & 7, j = w & 31;
        const bf16_t* kp = p.proj + (size_t)(b * SEQ + j * 256 + wid * 64) * 2840 + 1816 + h * 64 + lane;
        float s = 0.f;
#pragma unroll 16
        for (int i = 0; i < 64; ++i) s += bf2f(kp[(size_t)i * 2840]);
        __syncthreads();
        sm[TIDX] = s;
        __syncthreads();
        if (TIDX < 64) {
            const float m = ((sm[TIDX] + sm[64 + TIDX]) + (sm[128 + TIDX] + sm[192 + TIDX])) * (1.0f / 256.0f);
            p.kmean[(size_t)w * 64 + TIDX] = m;
            p.kmeanb[(size_t)w * 64 + TIDX] = f2bf(m);
        }
    }
}
__device__ __forceinline__ void st_mla_prep(const P& p, int wg, int nwg) {
    const int TIDX = otid();
    const int wid = TIDX >> 6, lane = TIDX & 63;
    for (int row = wg * 4 + wid; row < T_TOK; row += nwg * 4) {
        const int t = row & (SEQ - 1);
        const bf16_t* pr = p.proj1 + (size_t)row * 1216;
        float q[4], ss = 0.f;
#pragma unroll
        for (int i = 0; i < 4; ++i) { q[i] = bf2f(pr[i * 64 + lane]); ss += q[i] * q[i]; }
        ss = wsum(ss);
        float r = rsqrtf(ss * (1.0f / 256.0f) + 1e-6f);
#pragma unroll
        for (int i = 0; i < 4; ++i) p.cqn[(size_t)row * 384 + i * 64 + lane] = f2bf(q[i] * r * p.q_norm[i * 64 + lane]);
        float kvv[2]; ss = 0.f;
#pragma unroll
        for (int i = 0; i < 2; ++i) { kvv[i] = bf2f(pr[256 + i * 64 + lane]); ss += kvv[i] * kvv[i]; }
        ss = wsum(ss);
        r = rsqrtf(ss * (1.0f / 128.0f) + 1e-6f);
#pragma unroll
        for (int i = 0; i < 2; ++i) p.cqn[(size_t)row * 384 + 256 + i * 64 + lane] = f2bf(kvv[i] * r * p.kv_norm[i * 64 + lane]);
        if (lane < 32) {
            const float x1 = bf2f(pr[384 + lane]), x2 = bf2f(pr[384 + 32 + lane]);
            const float cs = p.ropec[t * 32 + lane], sn = p.ropes[t * 32 + lane];
            p.krope[(size_t)row * 64 + lane] = f2bf(x1 * cs - x2 * sn);
            p.krope[(size_t)row * 64 + 32 + lane] = f2bf(x1 * sn + x2 * cs);
        }
    }
}


typedef short bf16x8 __attribute__((ext_vector_type(8)));
typedef float f32x4 __attribute__((ext_vector_type(4)));
typedef unsigned u32x2 __attribute__((ext_vector_type(2)));
typedef unsigned u32x4v __attribute__((ext_vector_type(4)));
#define LDSP __attribute__((address_space(3)))
#define GEMM_LDS_BYTES 81920
#define KERNEL_LDS_BYTES 81920
#define BAR_LDS_OFF (KERNEL_LDS_BYTES - 16)

__device__ __forceinline__ unsigned pack_bf16(float lo, float hi) { return cvtpk(lo, hi); }
struct Pair8 { bool lo_is_a; int cadj; };
__device__ __forceinline__ void plswap16(unsigned& a, unsigned& b) { asm("s_nop 1\n\tv_permlane16_swap_b32 %0, %1\n\ts_nop 0" : "+v"(a), "+v"(b)); }
__device__ __forceinline__ Pair8 pair8_init(int tid) {
    const unsigned lane = (unsigned)tid & 63u; unsigned ia = lane, ib = lane, ga = 0u, gb = 1u;
    plswap16(ia, ib); plswap16(ga, gb);
    const bool ownv = (ia == lane), odd = ((lane >> 4) & 1u) != 0u;
    Pair8 r; r.lo_is_a = (odd != ownv); r.cadj = (int)ga * 16 - (odd ? 4 : 0);
    return r;
}
__device__ __forceinline__ u32x4v pair8(const Pair8& P8, const f32x4 va, const f32x4 vb) {
    unsigned ax = pack_bf16(va[0], va[1]), ay = pack_bf16(va[2], va[3]), bx = pack_bf16(vb[0], vb[1]), by = pack_bf16(vb[2], vb[3]);
    plswap16(ax, bx); plswap16(ay, by);
    return P8.lo_is_a ? (u32x4v){ax, ay, bx, by} : (u32x4v){bx, by, ax, ay};
}

template <int MF, class AR, class BR, class Epi, class NX>
__device__ __forceinline__ void gemm128x(const int nk, const size_t akstep, const size_t bkstep, AR arow, BR brow, Epi epi, LDSP char* lds, const int tid, const bool staged, NX next) {
    constexpr int SS = MF * 4096 + 16384, BO = MF * 4096;
    const int wid = tid >> 6, lane = tid & 63, wr = wid >> 1, wc = wid & 1, fr = lane & 15, fq = lane >> 4;
    const int srow = tid >> 3, gch = ((tid & 7) ^ (srow & 7)) * 8;
    const bf16_t* ap[MF]; const bf16_t* bp[4];
#pragma unroll
    for (int i = 0; i < MF; ++i) ap[i] = arow(32 * i + srow) + gch;
#pragma unroll
    for (int i = 0; i < 4; ++i) bp[i] = brow(32 * i + srow) + gch;
    LDSP char* lw = lds + wid * 1024;
#define G128_ISSUE(st, kt) do { LDSP char* la_ = lw + (st) * SS; const size_t ao_ = (size_t)(kt) * akstep, bo_ = (size_t)(kt) * bkstep; \
        _Pragma("unroll") for (int i_ = 0; i_ < MF; ++i_) __builtin_amdgcn_global_load_lds((const unsigned*)(ap[i_] + ao_), (LDSP unsigned*)(la_ + 4096 * i_), 16, 0, 0); \
        _Pragma("unroll") for (int i_ = 0; i_ < 4; ++i_) __builtin_amdgcn_global_load_lds((const unsigned*)(bp[i_] + bo_), (LDSP unsigned*)(la_ + BO + 4096 * i_), 16, 0, 0); } while (0)
    f32x4 acc[MF][4];
#pragma unroll
    for (int m = 0; m < MF; ++m)
#pragma unroll
        for (int n = 0; n < 4; ++n) acc[m][n] = (f32x4){0.f, 0.f, 0.f, 0.f};
    const int aoff = (wr * 16 * MF + fr) * 128, boff = BO + (wc * 64 + fr) * 128, c0 = (fq ^ (fr & 7)) * 16;
    if (!staged) G128_ISSUE(0, 0);
    for (int kt = 0; kt < nk; ++kt) {
        const int cur = kt & 1;
        asm volatile("s_waitcnt vmcnt(0)" ::: "memory");
        __builtin_amdgcn_s_barrier();
        asm volatile("" ::: "memory");
        LDSP char* sb = lds + cur * SS;
        constexpr int NG = 2 * MF, PD = 3;
        bf16x8 af[NG], bf[2][4];
#define G128_AF(s_) (*(const LDSP bf16x8*)(sb + aoff + ((s_) % MF) * 2048 + (((s_) / MF) ? (c0 ^ 64) : c0)))
#pragma unroll
        for (int n = 0; n < 4; ++n) bf[0][n] = *(const LDSP bf16x8*)(sb + boff + n * 2048 + c0);
#pragma unroll
        for (int s = 0; s < PD; ++s) af[s] = G128_AF(s);
        __builtin_amdgcn_sched_barrier(0);
        if (kt + 1 < nk) G128_ISSUE(cur ^ 1, kt + 1);
        __builtin_amdgcn_sched_barrier(0);
#pragma unroll
        for (int s = 0; s < NG; ++s) {
            if (s + PD < NG) af[s + PD] = G128_AF(s + PD);
            if (s == MF - PD) {
#pragma unroll
                for (int n = 0; n < 4; ++n) bf[1][n] = *(const LDSP bf16x8*)(sb + boff + n * 2048 + (c0 ^ 64));
            }
#pragma unroll
            for (int n = 0; n < 4; ++n) acc[s % MF][n] = __builtin_amdgcn_mfma_f32_16x16x32_bf16(bf[s / MF][n], af[s], acc[s % MF][n], 0, 0, 0);
            __builtin_amdgcn_sched_barrier(0);
        }
#undef G128_AF
    }
    asm volatile("s_waitcnt lgkmcnt(0)" ::: "memory");
    __builtin_amdgcn_s_barrier();
    asm volatile("" ::: "memory");
    next();
#undef G128_ISSUE
#pragma unroll
    for (int m = 0; m < MF; ++m) epi(wr * 16 * MF + m * 16 + fr, wc * 64 + fq * 4, acc[m], m);
}

template <int MF, class AR, class BR>
__device__ __forceinline__ void g128_stage0(AR arow, BR brow, LDSP char* lds, const int tid) {
    const int wid = tid >> 6, srow = tid >> 3, gch = ((tid & 7) ^ (srow & 7)) * 8;
    LDSP char* lw = lds + wid * 1024;
#pragma unroll
    for (int i = 0; i < MF; ++i) {
        __builtin_amdgcn_global_load_lds((const unsigned*)(arow(32 * i + srow) + gch), (LDSP unsigned*)(lw + 4096 * i), 16, 0, 0);
    }
#pragma unroll
    for (int i = 0; i < 4; ++i) {
        __builtin_amdgcn_global_load_lds((const unsigned*)(brow(32 * i + srow) + gch), (LDSP unsigned*)(lw + MF * 4096 + 4096 * i), 16, 0, 0);
    }
}
template <class AR, class BR, class Epi>
__device__ __forceinline__ void gemm128(const int nk, const size_t akstep, const size_t bkstep, AR arow, BR brow, Epi epi, LDSP char* lds, const int tid) {
    gemm128x<4>(nk, akstep, bkstep, arow, brow, epi, lds, tid, false, [] {});
}

template <int MAP> __device__ __forceinline__ int conv_rowmap(int n) {
    if (MAP == 0) return n;
    const int tile = n >> 6, cc = n & 63, wc = cc >> 5, i16 = (cc >> 4) & 1, i = cc & 15;
    return tile * 128 + wc * 64 + ((MAP == 1 ? 0 : 2) + i16) * 16 + i;
}
template <int MAP>
__device__ __forceinline__ void conv_batched(const float* src, int nmat, int K, int N, size_t sstride, bf16_t* dst, size_t dstride, int wg, int nwg, float* sm, int tid, int wend = 0x7fffffff) {
    float(*t)[65] = (float(*)[65])sm;
    const int tk = K >> 6, tn = (N + 63) >> 6, per = tk * tn, total = (nmat * per < wend) ? nmat * per : wend;
    f32x4 v[4];
    auto ld = [&](int w) {
        const int mat = w / per, r = w % per, kt = r / tn, nt = r % tn;
        const float* s = src + (size_t)mat * sstride;
#pragma unroll
        for (int i = 0; i < 4; ++i) {
            const int idx = tid + 256 * i, k = idx >> 4, n = (idx & 15) * 4;
            v[i] = (f32x4){0.f, 0.f, 0.f, 0.f};
            if (nt * 64 + n < N) v[i] = *(const f32x4*)(s + (size_t)(kt * 64 + k) * N + nt * 64 + n);
        }
    };
    if (wg < total) ld(wg);
    for (int w = wg; w < total; w += nwg) {
        const int mat = w / per, r = w % per, kt = r / tn, nt = r % tn;
        bf16_t* d = dst + (size_t)mat * dstride;
#pragma unroll
        for (int i = 0; i < 4; ++i) {
            const int idx = tid + 256 * i, k = idx >> 4, n = (idx & 15) * 4;
            t[k][n] = v[i][0]; t[k][n + 1] = v[i][1]; t[k][n + 2] = v[i][2]; t[k][n + 3] = v[i][3];
        }
        __syncthreads();
        if (w + nwg < total) ld(w + nwg);
        {
            const int n = tid >> 2, kq = (tid & 3) * 16;
            if (nt * 64 + n < N) {
                unsigned pk[8];
#pragma unroll
                for (int j = 0; j < 8; ++j) pk[j] = cvtpk(t[kq + 2 * j][n], t[kq + 2 * j + 1][n]);
                bf16_t* o = d + (size_t)conv_rowmap<MAP>(nt * 64 + n) * K + kt * 64 + kq;
                *(u32x4v*)o = (u32x4v){pk[0], pk[1], pk[2], pk[3]};
                *(u32x4v*)(o + 8) = (u32x4v){pk[4], pk[5], pk[6], pk[7]};
            }
        }
        __syncthreads();
    }
}
__device__ __forceinline__ void st_convert(const P& p, int wg, int nwg, float* sm) {
    const int tid = otid();
    conv_batched<0>(p.ev_w_in, 1, 1024, 2840, 0, p.wt_in0, 0, wg, nwg, sm, tid);
    conv_batched<0>(p.ev_w_out, 1, 1024, 1024, 0, p.wt_out0, 0, wg, nwg, sm, tid);
    conv_batched<0>(p.ck_w1, 1, 2048, 256, 0, p.wt_c1, 0, wg, nwg, sm, tid);
    conv_batched<0>(p.cv_w1, 1, 2048, 256, 0, p.wt_c1 + 256 * 2048, 0, wg, nwg, sm, tid);
    conv_batched<0>(p.ck_w2, 1, 256, 64, 0, p.wt_c2, 0, wg, nwg, sm, tid);
    conv_batched<0>(p.cv_w2, 1, 256, 64, 0, p.wt_c2 + 64 * 256, 0, wg, nwg, sm, tid);
    conv_batched<0>(p.od_w_in, 1, 1024, 1216, 0, p.wt_in1, 0, wg, nwg, sm, tid);
    conv_batched<0>(p.od_w_out, 1, 1024, 1024, 0, p.wt_out1, 0, wg, nwg, sm, tid);
    conv_batched<0>(p.w_q_up, 1, 256, 768, 0, p.wt_qup, 0, wg, nwg, sm, tid);
    conv_batched<0>(p.w_kv_up, 1, 128, 1024, 0, p.wt_kvup, 0, wg, nwg, sm, tid);
    {
        const int wid = tid >> 6, lane = tid & 63;
        for (int w = wg * 4 + wid; w < 512; w += nwg * 4) {
            const int which = w >> 8, cg = (w >> 6) & 3, ks = w & 63, col = cg * 64 + lane;
            const float* w1 = (which ? p.cv_w1 : p.ck_w1) + (size_t)(ks * 32) * 256 + col; const float* pos = (which ? p.pos_v : p.pos_k) + ks * 32;
            float a = 0.f;
#pragma unroll
            for (int k = 0; k < 32; ++k) a += pos[k] * w1[(size_t)k * 256];
            p.c1p[(which * 64 + ks) * 256 + col] = a;
        }
    }
}
__device__ __forceinline__ void st_c1_reduce(const P& p, int wg, int nwg) {
    const int tid = otid();
    for (int i = wg * 256 + tid; i < 512; i += nwg * 256) {
        const int which = i >> 8, col = i & 255;
        float a = 0.f;
#pragma unroll 16
        for (int ks = 0; ks < 64; ++ks) a += p.c1p[(which * 64 + ks) * 256 + col];
        p.c1[i] = a;
    }
}


struct XcdOrder {
    int xcd, lw, nlw, tn, per;
    __device__ __forceinline__ XcdOrder(int wg, int nwg, int nM, int tn_) : xcd(wg & 7), lw(wg >> 3), nlw(nwg >> 3), tn(tn_), per((nM >> 3) * tn_) {}
    __device__ __forceinline__ bool get(int k, int& mt, int& nt) const { const int lt = lw + k * nlw; if (lt >= per) return false; mt = xcd + 8 * (lt / tn); nt = lt % tn; return true; }
};
template <int MF>
__device__ __forceinline__ void st_inproj0_mf(const P& p, int wg, int nwg, LDSP char* lds) {
    const int tid = otid();
    const Pair8 P8 = pair8_init(tid);
    const XcdOrder ord(wg, nwg, ((T_TOK + 32 * MF - 1) / (32 * MF) + 7) & ~7, 23);
    auto Af = [&](int mt_) { return [=](int r) { int row = mt_ * (32 * MF) + r; row = row < T_TOK ? row : T_TOK - 1; return p.h + (size_t)row * DM; }; };
    auto Bf = [&](int nt_) { return [=](int r) { int n = nt_ * 128 + r; n = n < 2840 ? n : 2839; return p.wt_in0 + (size_t)n * 1024; }; };
    bool staged = false;
    for (int k = 0;; ++k) {
        int mt, nt, mt2 = 0, nt2 = 0;
        if (!ord.get(k, mt, nt)) break;
        if (mt * (32 * MF) >= T_TOK) break;
        const bool has2 = ord.get(k + 1, mt2, nt2) && mt2 * (32 * MF) < T_TOK;
        const bool st_ = staged; staged = has2;
        gemm128x<MF>(16, 64, 64, Af(mt), Bf(nt),
            [&](int rl, int cl, const f32x4 (&a)[4], int mfrag) {
                const int row = mt * (32 * MF) + rl;
#pragma unroll
                for (int n = 0; n < 4; n += 2) {
                    const u32x4v w8 = pair8(P8, a[n], a[n + 1]);
                    const int col8 = nt * 128 + cl + n * 16 + P8.cadj;
                    if (col8 < 2840 && row < T_TOK) *(u32x4v*)(p.proj + (size_t)row * 2840 + col8) = w8;
                }
#pragma unroll
                for (int n = 0; n < 4; ++n) {
                    const int col = nt * 128 + cl + n * 16;
                    if (col >= 1280 && col < 1304 && row < T_TOK)
                        *(f32x4*)(p.gates + (size_t)row * 24 + (col - 1280)) = (f32x4){sigmf(a[n][0]), sigmf(a[n][1]), sigmf(a[n][2]), sigmf(a[n][3])};
                }
            }, lds, tid, st_, [&] { if (has2) g128_stage0<MF>(Af(mt2), Bf(nt2), lds, tid); });
    }
}
__device__ __forceinline__ void st_cmp1_mf(const P& p, int wg, int nwg, LDSP char* lds) {
    const int tid = otid();
    for (int w = wg; w < 2 * 16 * 2; w += nwg) {
        const int which = w >> 5, mt = (w >> 1) & 15, nt = w & 1;
        const int colbase = which ? 640 : 512;
        gemm128(32, 2840, 64,
            [&](int r) { int m = mt * 128 + r; m = m < 2044 ? m : 2043; const int bk = m / 511, n = m % 511, b = bk >> 1, kv = bk & 1;
                         return p.proj + (size_t)(b * SEQ + 16 * n) * 2840 + colbase + kv * 64; },
            [&](int r) { return p.wt_c1 + (size_t)(which * 256 + nt * 128 + r) * 2048; },
            [&](int rl, int cl, const f32x4 (&a)[4], int mfrag) {
                const int m = mt * 128 + rl;
                if (m < 2044) {
#pragma unroll
                    for (int n = 0; n < 4; ++n) {
                        const int col = nt * 128 + cl + n * 16;
                        const f32x4 cb = *(const f32x4*)(p.c1 + which * 256 + col);
                        *(u32x2*)(p.chidb + (size_t)(which * 2048 + m) * 256 + col) =
                            (u32x2){pack_bf16(gelu_tanh(a[n][0] + cb[0]), gelu_tanh(a[n][1] + cb[1])), pack_bf16(gelu_tanh(a[n][2] + cb[2]), gelu_tanh(a[n][3] + cb[3]))};
                    }
                }
            }, lds, tid);
    }
}
__device__ __forceinline__ void st_cmp2_mf(const P& p, int wg, int nwg, LDSP char* lds) {
    const int tid = otid();
    for (int w = wg; w < 2 * 16; w += nwg) {
        const int which = w >> 4, mt = w & 15;
        gemm128(4, 64, 64,
            [&](int r) { int m = mt * 128 + r; m = m < 2044 ? m : 2043; return p.chidb + (size_t)(which * 2048 + m) * 256; },
            [&](int r) { return p.wt_c2 + (size_t)(which * 64 + (r & 63)) * 256; },
            [&](int rl, int cl, const f32x4 (&a)[4], int mfrag) {
                const int m = mt * 128 + rl;
                if (m < 2044) {
#pragma unroll
                    for (int n = 0; n < 4; ++n) { const int col = cl + n * 16; if (col < 64) {
                        const int bk = m / 511, nn = m % 511;
                        *(u32x2*)(p.kcmpb + ((size_t)((which * 4 + bk) * 512 + nn)) * 64 + col) = (u32x2){cvtpk(a[n][0], a[n][1]), cvtpk(a[n][2], a[n][3])}; } }
                }
            }, lds, tid);
    }
}
template <int MF>
__device__ __forceinline__ void st_outproj_mf(const P& p, int layer, int wg, int nwg, LDSP char* lds) {
    const int tid = otid();
    const Pair8 P8 = pair8_init(tid);
    const bf16_t* W = layer ? p.wt_out1 : p.wt_out0;
    bf16_t* xout = layer ? p.xr3 : p.xr1;
    const XcdOrder ord(wg, nwg, ((T_TOK + 32 * MF - 1) / (32 * MF) + 7) & ~7, 8);
    auto Af = [&](int mt_) { return [=](int r) { int row = mt_ * (32 * MF) + r; row = row < T_TOK ? row : T_TOK - 1; return p.o + (size_t)row * DM; }; };
    auto Bf = [&](int nt_) { return [=](int r) { return W + (size_t)(nt_ * 128 + r) * 1024; }; };
    bool staged = false;
    for (int k = 0;; ++k) {
        int mt, nt, mt2 = 0, nt2 = 0;
        if (!ord.get(k, mt, nt)) break;
        if (mt * (32 * MF) >= T_TOK) break;
        const bool has2 = ord.get(k + 1, mt2, nt2) && mt2 * (32 * MF) < T_TOK;
        const bool st_ = staged; staged = has2;
        gemm128x<MF>(16, 64, 64, Af(mt), Bf(nt),
            [&](int rl, int cl, const f32x4 (&a)[4], int mfrag) {
                const int row = mt * (32 * MF) + rl, b = row >> 13;
                const float* g = p.modv + (size_t)(layer * 2 + (b & 1)) * 6144 + 2 * 1024;
                const int rowc = row < T_TOK ? row : T_TOK - 1;
                f32x4 r4[4];
#pragma unroll
                for (int n = 0; n < 4; ++n) {
                    const int col = nt * 128 + cl + n * 16;
                    const f32x4 gv = *(const f32x4*)(g + col);
                    f32x4 xv;
                    if (layer) { const u32x2 xb = *(const u32x2*)(p.xr2 + (size_t)rowc * DM + col);
                                 xv = (f32x4){__uint_as_float(xb[0] << 16), __uint_as_float(xb[0] & 0xffff0000u), __uint_as_float(xb[1] << 16), __uint_as_float(xb[1] & 0xffff0000u)}; }
                    else xv = *(const f32x4*)(p.x + (size_t)rowc * DM + col);
                    r4[n] = xv + gv * a[n];
                }
#pragma unroll
                for (int n = 0; n < 4; n += 2) {
                    const u32x4v w8 = pair8(P8, r4[n], r4[n + 1]);
                    if (row < T_TOK) *(u32x4v*)(xout + (size_t)row * DM + nt * 128 + cl + n * 16 + P8.cadj) = w8;
                }
            }, lds, tid, st_, [&] { if (has2) g128_stage0<MF>(Af(mt2), Bf(nt2), lds, tid); });
    }
}
template <int BM>
__device__ __forceinline__ bool moe_tile128(const int* cnt, int tt, int& e, int& i0, int& off) {
    int acc = 0, o = 0;
    for (int q = 0; q < 16; ++q) {
        const int c = cnt[q * 32], nt = (c + BM - 1) / BM;
        if (tt < acc + nt) { e = q; i0 = (tt - acc) * BM; off = o; return true; }
        acc += nt; o += c;
    }
    return false;
}
struct MoeTile { int e, i0, off, nt, ce; bool ok; };
template <int BM>
__device__ __forceinline__ MoeTile moe_get(const int* cnt, int wg, int nwg, int k) {
    int mtot = 0;
    for (int q = 0; q < 16; ++q) mtot += (cnt[q * 32] + BM - 1) / BM;
    const int per = (mtot + 7) >> 3, lt = (wg >> 3) + k * (nwg >> 3), lm = lt >> 3;
    MoeTile t; t.nt = lt & 7; t.e = 0; t.i0 = 0; t.off = 0;
    t.ok = (lm < per) && moe_tile128<BM>(cnt, (wg & 7) * per + lm, t.e, t.i0, t.off);
    t.ce = t.ok ? cnt[t.e * 32] : 0; return t;
}
template <int MF>
__device__ __forceinline__ void st_moe_up_mf(const P& p, int layer, int wg, int nwg, LDSP char* lds) {
    const int tid = otid();
    const Pair8 P8 = pair8_init(tid);
    const int* cnt = p.cnt + layer * 512;
    auto Af = [&](const MoeTile& t) { const int* lst = p.list + t.e * T_TOK; const int i0 = t.i0, ce = t.ce;
                                      return [=](int r) { const int i = (i0 + r < ce) ? i0 + r : i0; return p.h + (size_t)(lst[i] >> 1) * DM; }; };
    auto Bf = [&](const MoeTile& t) { const bf16_t* B = p.wt_gu + ((size_t)(layer * 16 + t.e) * 1024 + t.nt * 128) * 1024; return [=](int r) { return B + (size_t)r * 1024; }; };
    MoeTile cur = moe_get<32 * MF>(cnt, wg, nwg, 0);
    bool staged = false;
    for (int k = 0; cur.ok; ++k) {
        const MoeTile nx = moe_get<32 * MF>(cnt, wg, nwg, k + 1);
        const bool st_ = staged; staged = nx.ok;
        const int i0 = cur.i0, ce = cur.ce, off = cur.off, nt = cur.nt;
        gemm128x<MF>(16, 64, 64, Af(cur), Bf(cur),
            [&](int rl, int cl, const f32x4 (&a)[4], int mfrag) {
                const int wc = cl >> 6, fq4 = cl & 63;
                f32x4 hv2[2];
#pragma unroll
                for (int n = 0; n < 2; ++n) { const f32x4 g = a[n], u = a[n + 2]; hv2[n] = (f32x4){siluf(g[0]) * u[0], siluf(g[1]) * u[1], siluf(g[2]) * u[2], siluf(g[3]) * u[3]}; }
                const u32x4v w8 = pair8(P8, hv2[0], hv2[1]);
                if (i0 + rl < ce) *(u32x4v*)(p.hid + (size_t)(off + i0 + rl) * 512 + nt * 64 + wc * 32 + fq4 + P8.cadj) = w8;
            }, lds, tid, st_, [&] { if (nx.ok) g128_stage0<MF>(Af(nx), Bf(nx), lds, tid); });
        cur = nx;
    }
}
template <int MF>
__device__ __forceinline__ void st_moe_down_mf(const P& p, int layer, int wg, int nwg, LDSP char* lds) {
    const int tid = otid();
    const Pair8 P8 = pair8_init(tid);
    const int* cnt = p.cnt + layer * 512;
    auto Af = [&](const MoeTile& t) { const int i0 = t.i0, ce = t.ce, off = t.off; return [=](int r) { const int i = (i0 + r < ce) ? i0 + r : i0; return p.hid + (size_t)(off + i) * 512; }; };
    auto Bf = [&](const MoeTile& t) { const bf16_t* B = p.wt_d + ((size_t)(layer * 16 + t.e) * 1024 + t.nt * 128) * 512; return [=](int r) { return B + (size_t)r * 512; }; };
    MoeTile cur = moe_get<32 * MF>(cnt, wg, nwg, 0);
    bool staged = false;
    for (int k = 0; cur.ok; ++k) {
        const MoeTile nx = moe_get<32 * MF>(cnt, wg, nwg, k + 1);
        const bool st_ = staged; staged = nx.ok;
        const int i0 = cur.i0, ce = cur.ce, nt = cur.nt;
        const int* lst = p.list + cur.e * T_TOK;
        int ids[MF]; float wts[MF];
#pragma unroll
        for (int m = 0; m < MF; ++m) { const int rl = ((tid >> 7) & 1) * (16 * MF) + m * 16 + (tid & 15); ids[m] = (i0 + rl < ce) ? lst[i0 + rl] : -1; }
#pragma unroll
        for (int m = 0; m < MF; ++m) wts[m] = ids[m] >= 0 ? p.tokw[ids[m]] : 0.f;
        gemm128x<MF>(8, 64, 64, Af(cur), Bf(cur),
            [&](int rl, int cl, const f32x4 (&a)[4], int mfrag) {
                const int id = ids[mfrag]; const float wt = wts[mfrag];
#pragma unroll
                for (int n = 0; n < 4; n += 2) {
                    const u32x4v w8 = pair8(P8, a[n] * wt, a[n + 1] * wt);
                    if (i0 + rl < ce) *(u32x4v*)(p.y + (size_t)id * DM + nt * 128 + cl + n * 16 + P8.cadj) = w8;
                }
            }, lds, tid, st_, [&] { if (nx.ok) g128_stage0<MF>(Af(nx), Bf(nx), lds, tid); });
        cur = nx;
    }
}
template <int MF>
__device__ __forceinline__ void st_inproj1_mf(const P& p, int wg, int nwg, LDSP char* lds) {
    const int tid = otid();
    const Pair8 P8 = pair8_init(tid);
    const XcdOrder ord(wg, nwg, ((T_TOK + 32 * MF - 1) / (32 * MF) + 7) & ~7, 10);
    auto Af = [&](int mt_) { return [=](int r) { int row = mt_ * (32 * MF) + r; row = row < T_TOK ? row : T_TOK - 1; return p.h + (size_t)row * DM; }; };
    auto Bf = [&](int nt_) { return [=](int r) { int n = nt_ * 128 + r; n = n < 1216 ? n : 1215; return p.wt_in1 + (size_t)n * 1024; }; };
    bool staged = false;
    for (int k = 0;; ++k) {
        int mt, nt, mt2 = 0, nt2 = 0;
        if (!ord.get(k, mt, nt)) break;
        if (mt * (32 * MF) >= T_TOK) break;
        const bool has2 = ord.get(k + 1, mt2, nt2) && mt2 * (32 * MF) < T_TOK;
        const bool st_ = staged; staged = has2;
        gemm128x<MF>(16, 64, 64, Af(mt), Bf(nt),
            [&](int rl, int cl, const f32x4 (&a)[4], int mfrag) {
                const int row = mt * (32 * MF) + rl;
#pragma unroll
                for (int n = 0; n < 4; n += 2) {
                    const u32x4v w8 = pair8(P8, a[n], a[n + 1]);
                    const int col8 = nt * 128 + cl + n * 16 + P8.cadj;
                    if (col8 < 1216 && row < T_TOK) *(u32x4v*)(p.proj1 + (size_t)row * 1216 + col8) = w8;
                }
            }, lds, tid, st_, [&] { if (has2) g128_stage0<MF>(Af(mt2), Bf(nt2), lds, tid); });
    }
}
__device__ __forceinline__ void st_mla_up_mf(const P& p, int wg, int nwg, LDSP char* lds) {
    const int tid = otid();
    const Pair8 P8 = pair8_init(tid);
    const XcdOrder ord(wg, nwg, 128, 14);
    for (int k = 0;; ++k) {
        int mt, c;
        if (!ord.get(k, mt, c)) break;
        if (c < 6) {
            gemm128(4, 64, 64,
                [&](int r) { return p.cqn + (size_t)(mt * 128 + r) * 384; },
                [&](int r) { return p.wt_qup + (size_t)(c * 128 + r) * 256; },
                [&](int rl, int cl, const f32x4 (&a)[4], int mfrag) {
                    const int row = mt * 128 + rl, wc = cl >> 6;
                    f32x4 v[4] = {a[0], a[1], a[2], a[3]};
                    if (((c == 1 || c == 4) && wc == 0) || ((c == 2 || c == 5) && wc == 1)) {
                        const int t = row & (SEQ - 1), i0 = cl & 63;
#pragma unroll
                        for (int n = 0; n < 2; ++n) {
                            const f32x4 cs = *(const f32x4*)(p.ropec + t * 32 + n * 16 + i0), sn = *(const f32x4*)(p.ropes + t * 32 + n * 16 + i0);
                            v[n] = a[n] * cs - a[n + 2] * sn; v[n + 2] = a[n] * sn + a[n + 2] * cs;
                        }
                    }
#pragma unroll
                    for (int n = 0; n < 4; n += 2) *(u32x4v*)(p.qmla + (size_t)row * 768 + c * 128 + cl + n * 16 + P8.cadj) = pair8(P8, v[n], v[n + 1]);
                }, lds, tid);
        } else {
            gemm128(2, 64, 64,
                [&](int r) { return p.cqn + (size_t)(mt * 128 + r) * 384 + 256; },
                [&](int r) { return p.wt_kvup + (size_t)((c - 6) * 128 + r) * 128; },
                [&](int rl, int cl, const f32x4 (&a)[4], int mfrag) {
                    const int row = mt * 128 + rl;
#pragma unroll
                    for (int n = 0; n < 4; n += 2) *(u32x4v*)(p.kvmla + (size_t)row * 1024 + (c - 6) * 128 + cl + n * 16 + P8.cadj) = pair8(P8, a[n], a[n + 1]);
                }, lds, tid);
        }
    }
}

typedef float f32x16 __attribute__((ext_vector_type(16)));
typedef short s16x4 __attribute__((ext_vector_type(4)));
#define ATT_NEG (-1e30f)
#define ATT_SHIFT (-16.0f)
#define LOG2E 1.4426950408889634f

__device__ __forceinline__ int swz128(int row) { return (((row >> 1) & 1) << 2) | ((row >> 2) & 3); }
__device__ __forceinline__ int swz256(int row) { return ((row & 3) << 2) | ((row >> 2) & 3); }

struct AttLane {
    int kbase;
    int v0[2];
};
template <int KROWB, int VROWB, int DT>
__device__ __forceinline__ void att_lane_init(AttLane& L, int lane) {
    const int q = lane & 31, hh = lane >> 5, x = hh ^ swz128(q);
    L.kbase = q * KROWB + x * 16;
    const int rl = 4 * hh + ((lane & 15) >> 2), blk = (lane >> 4) & 1, pp = lane & 3;
#pragma unroll
    for (int t = 0; t < 2; ++t) {
        const int g = (VROWB == 256) ? (((rl & 3) << 2) | ((2 * t + hh) & 3)) : ((((rl >> 1) & 1) << 2) | ((2 * t + hh) & 3));
        L.v0[t] = rl * VROWB + (((2 * blk + (pp >> 1)) ^ g) * 16) + 8 * (pp & 1);
    }
}
template <int KS, int KROWB, int MODE, bool WANT_P, bool IMP>
__device__ __forceinline__ void att_qk(LDSP const char* kb, const AttLane& L, const bf16x8 (&qf)[KS], bf16x8 (&pf)[4], float& lsum, const float c1, const float cadd,
                                       const unsigned lutv, const int dq16, LDSP float* improw, const float invl) {
    float la = 0.f, lb = 0.f, lc = 0.f, ld = 0.f;
#pragma unroll
    for (int kt = 0; kt < 2; ++kt) {
        f32x16 s;
#pragma unroll
        for (int r = 0; r < 16; ++r) s[r] = 0.f;
        constexpr int KG = (KS > 4) ? 2 : 4;
#pragma unroll
        for (int k4 = 0; k4 < KS; k4 += KG) {
            bf16x8 a[KG];
#pragma unroll
            for (int j = 0; j < KG; ++j) { const int ks = k4 + j; a[j] = *(const LDSP bf16x8*)(kb + (L.kbase ^ (32 * (ks & 3))) + (ks >> 2) * 128 + kt * 32 * KROWB); }
#pragma unroll
            for (int j = 0; j < KG; ++j) s = __builtin_amdgcn_mfma_f32_32x32x16_bf16(a[j], qf[k4 + j], s, 0, 0, 0);
            asm volatile("" ::: "memory");
        }
        float pr[16];
#pragma unroll
        for (int r = 0; r < 16; ++r) {
            const int koff = 32 * kt + (r & 3) + 8 * (r >> 2);
            float add = cadd;
            if (MODE == 1) add = *(const LDSP float*)(lutv + (63 - koff) * 4);
            if (MODE == 2) { int d = dq16 - 16 * koff; d = d < -1 ? -1 : d; d = d > 1087 ? 1087 : d; add = *(const LDSP float*)(lutv + (unsigned)(64 + d) * 4u); }
            pr[r] = __builtin_amdgcn_exp2f(__builtin_fmaf(s[r], c1, add));
        }
#pragma unroll
        for (int r = 0; r < 16; r += 4) { la += pr[r]; lb += pr[r + 1]; lc += pr[r + 2]; ld += pr[r + 3]; }
        if (IMP) {
#pragma unroll
            for (int g = 0; g < 4; ++g) {
                (void)__hip_atomic_fetch_add((LDSP unsigned*)improw + 8 * kt + 2 * g, (unsigned)(((pr[4 * g] + pr[4 * g + 1]) + (pr[4 * g + 2] + pr[4 * g + 3])) * invl + 0.5f), __ATOMIC_RELAXED, __HIP_MEMORY_SCOPE_WORKGROUP);
                (void)__hip_atomic_fetch_add((LDSP unsigned*)improw + 8 * kt + 2 * g + 1, (unsigned)(pr[4 * g + 3] * invl + 0.5f), __ATOMIC_RELAXED, __HIP_MEMORY_SCOPE_WORKGROUP);
            }
        }
        if (WANT_P) {
#pragma unroll
            for (int sI = 0; sI < 2; ++sI) {
                union { unsigned u[4]; bf16x8 v; } cv;
#pragma unroll
                for (int i = 0; i < 4; ++i) cv.u[i] = cvtpk_valu(pr[8 * sI + 2 * i], pr[8 * sI + 2 * i + 1]);
                pf[kt * 2 + sI] = cv.v;
            }
        }
    }
    lsum += (la + lb) + (lc + ld);
}
template <int DT, int VROWB>
__device__ __forceinline__ void att_pv(LDSP const char* vb, const AttLane& L, const bf16x8 (&pf)[4], f32x16 (&o)[DT]) {
    const unsigned vba = (unsigned)(size_t)vb;
#pragma unroll
    for (int ks2 = 0; ks2 < 4; ++ks2) {
#pragma unroll
        for (int d0 = 0; d0 < DT; d0 += 2) {
            s16x4 lo[2], hi[2];
#pragma unroll
            for (int j = 0; j < 2; ++j) {
                asm volatile("ds_read_b64_tr_b16 %0, %1 offset:%2" : "=v"(lo[j]) : "v"(vba + (L.v0[0] ^ ((d0 + j) << 6))), "i"((16 * ks2) * VROWB) : "memory");
                asm volatile("ds_read_b64_tr_b16 %0, %1 offset:%2" : "=v"(hi[j]) : "v"(vba + (L.v0[1] ^ ((d0 + j) << 6))), "i"((16 * ks2 + 8) * VROWB) : "memory");
            }
            asm volatile("s_waitcnt lgkmcnt(0)" ::: "memory");
#pragma unroll
            for (int j = 0; j < 2; ++j) {
                asm volatile("" : "+v"(lo[j]), "+v"(hi[j]));
                const bf16x8 vf = __builtin_shufflevector(lo[j], hi[j], 0, 1, 2, 3, 4, 5, 6, 7);
                o[d0 + j] = __builtin_amdgcn_mfma_f32_32x32x16_bf16(vf, pf[ks2], o[d0 + j], 0, 0, 0);
            }
        }
    }
}
template <int CPR>
__device__ __forceinline__ void att_stage_map(int (&rowc)[(CPR == 24) ? 6 : 1], int tid) {
    if (CPR == 24) {
#pragma unroll
        for (int i = 0; i < 6; ++i) {
            const int c = tid + 256 * i, row = c / 24, cc = c % 24;
            rowc[i % ((CPR == 24) ? 6 : 1)] = (row << 8) | ((cc & ~7) | ((cc & 7) ^ swz128(row)));
        }
    } else if (CPR == 16) {
        const int row = tid >> 4; rowc[0] = (row << 8) | ((tid & 15) ^ swz256(row));
    } else {
        const int row = tid >> 3; rowc[0] = (row << 8) | ((tid & 7) ^ swz128(row));
    }
}
template <int CPR, class SRC>
__device__ __forceinline__ void att_stage(LDSP char* dst, SRC src, const int (&rowc)[(CPR == 24) ? 6 : 1], int wid) {
#pragma unroll
    for (int i = 0; i < CPR / 4; ++i) {
        const int rc = rowc[(CPR == 24) ? i : 0];
        const int row = (rc >> 8) + ((CPR == 24) ? 0 : i * (256 / CPR));
        __builtin_amdgcn_global_load_lds((const unsigned*)src(row, rc & 255), (LDSP unsigned*)(dst + (256 * i + 64 * wid) * 16), 16, 0, 0);
    }
}
__device__ __forceinline__ int wq_next(int* ctr, LDSP int* slot, int tid) {
    __syncthreads();
    if (tid == 0) *slot = atomicAdd(ctr, 1);
    __syncthreads();
    return *slot;
}

__device__ __forceinline__ void build_lut(LDSP float* tab, const float* blut_h, int n, int wlimit, int tid) {
    for (int i = tid; i < n; i += 256) { const int d = i - 64; tab[i] = (d < 0 || d >= wlimit) ? ATT_NEG : blut_h[d > 1023 ? 1023 : d] * LOG2E + ATT_SHIFT; }
}
#define ATT_BAR() do { __builtin_amdgcn_s_barrier(); asm volatile("" ::: "memory"); } while (0)

__device__ __forceinline__ void mla_item(const P& p, const int item, LDSP char* lds, const int tid0) {
    LDSP char* kb = lds; LDSP char* vb = lds + 24576; LDSP float* lut = (LDSP float*)(lds + 40960);
    const float c1 = 0.07216878364870322f * LOG2E;
    int tid = tid0; asm volatile("" : "+v"(tid));
    const int wid = tid >> 6, lane = tid & 63, q = lane & 31, hh = lane >> 5;
    AttLane L; att_lane_init<384, 256, 4>(L, lane);
    int krc[6], vrc[1];
    att_stage_map<24>(krc, tid); att_stage_map<16>(vrc, tid);
    int qt, bh, part;
    if (item >= 640) { const int r = item - 640; qt = 15 - (r >> 3); bh = r & 7; part = 0; }
    else {
        int g = 0; while (16 * (g + 1) + 8 * ((g + 2) >> 1) <= item) ++g;
        const int r = item - (16 * g + 8 * ((g + 1) >> 1)), Ln = 64 - g;
        if (r < 16) { qt = Ln - 1; bh = r & 7; part = 1 + (r >> 3); } else { qt = (Ln >> 1) - 1; bh = (r - 16) & 7; part = 0; }
    }
    const int b = bh >> 2, h = bh & 3;
    const int tw = qt * 128 + wid * 32;
    bf16x8 qf[12];
    {
        const bf16_t* qp = p.qmla + (size_t)(b * SEQ + tw + q) * 768 + h * 192 + 8 * hh;
#pragma unroll
        for (int ks = 0; ks < 12; ++ks) qf[ks] = *(const bf16x8*)(qp + 16 * ks);
    }
    f32x16 o[4];
#pragma unroll
    for (int dt = 0; dt < 4; ++dt)
#pragma unroll
        for (int r = 0; r < 16; ++r) o[dt][r] = 0.f;
    float lsum = 0.f;
    const int i0 = (part == 2) ? qt + 1 : 0, ntiles = (part == 1) ? qt + 1 : 2 * qt + 2;
    const bf16_t* kvb = p.kvmla + (size_t)b * SEQ * 1024 + h * 256;
    const bf16_t* krb = p.krope + (size_t)b * SEQ * 64;
    auto ksrc = [&](int pos0) { return [=](int row, int gc) { return gc < 16 ? kvb + (size_t)(pos0 + row) * 1024 + gc * 8 : krb + (size_t)(pos0 + row) * 64 + (gc - 16) * 8; }; };
    auto vsrc = [&](int pos0) { return [=](int row, int gc) { return kvb + (size_t)(pos0 + row) * 1024 + 128 + gc * 8; }; };
    att_stage<24>(kb, ksrc(i0 * 64), krc, wid);
    for (int i = i0; i < ntiles; ++i) {
        const int pos0 = i * 64;
        asm volatile("s_waitcnt vmcnt(0)" ::: "memory"); ATT_BAR();
        att_stage<16>(vb, vsrc(pos0), vrc, wid);
        const bool active = pos0 <= tw + 31, diag = pos0 + 63 > tw;
        bf16x8 pf[4];
        if (active) {
            if (diag) {
                int dq = tw + q - pos0 - 4 * hh; dq = dq < -1 ? -1 : dq;
                att_qk<12, 384, 1, true, false>(kb, L, qf, pf, lsum, c1, 0.f, (unsigned)(size_t)lut + (unsigned)(dq + 1) * 4u, 0, nullptr, 0.f);
            } else att_qk<12, 384, 0, true, false>(kb, L, qf, pf, lsum, c1, ATT_SHIFT, 0u, 0, nullptr, 0.f);
        }
        asm volatile("s_waitcnt vmcnt(0) lgkmcnt(0)" ::: "memory"); ATT_BAR();
        if (i + 1 < ntiles) att_stage<24>(kb, ksrc(pos0 + 64), krc, wid);
        if (active) att_pv<4, 256>(vb, L, pf, o);
    }
    const float lt = lsum + __shfl_xor(lsum, 32);
    int tid2 = tid0; asm volatile("" : "+v"(tid2));
    const int lane2 = tid2 & 63, trow = qt * 128 + (tid2 >> 6) * 32 + (lane2 & 31);
    bf16_t* op; float inv;
    if (part == 0) { inv = 1.0f / lt; op = p.o + (size_t)(b * SEQ + trow) * DM + h * 128 + 4 * (lane2 >> 5); }
    else {
        const size_t rec = (size_t)((part - 1) * 8 + bh) * (SEQ / 2) + (trow - SEQ / 2);
        inv = 1.0f; op = p.mlap + rec * 128 + 4 * (lane2 >> 5);
        if (lane2 < 32) p.mlal[rec] = lt;
    }
#pragma unroll
    for (int dt = 0; dt < 4; ++dt)
#pragma unroll
        for (int rq = 0; rq < 4; ++rq)
            *(u32x2*)(op + 32 * dt + 8 * rq) = (u32x2){cvtpk(o[dt][4 * rq] * inv, o[dt][4 * rq + 1] * inv), cvtpk(o[dt][4 * rq + 2] * inv, o[dt][4 * rq + 3] * inv)};
}
__device__ __forceinline__ void st_mla_combine(const P& p, int wg, int nwg) {
    const int TIDX = otid();
    const int wid = TIDX >> 6, lane = TIDX & 63;
    for (int w = wg * 4 + wid; w < 8 * (SEQ / 2); w += nwg * 4) {
        const int bh = w / (SEQ / 2), t = SEQ / 2 + w % (SEQ / 2), b = bh >> 2, h = bh & 3;
        const size_t r0 = (size_t)w, r1 = (size_t)(8 * (SEQ / 2) + w);
        const float inv = 1.0f / (p.mlal[r0] + p.mlal[r1]);
        const unsigned a = *(const unsigned*)(p.mlap + r0 * 128 + lane * 2), c = *(const unsigned*)(p.mlap + r1 * 128 + lane * 2);
        const float x0 = __uint_as_float(a << 16) + __uint_as_float(c << 16), x1 = __uint_as_float(a & 0xffff0000u) + __uint_as_float(c & 0xffff0000u);
        *(unsigned*)(p.o + (size_t)(b * SEQ + t) * DM + h * 128 + lane * 2) = cvtpk(x0 * inv, x1 * inv);
    }
}

__device__ __forceinline__ void swa_item(const P& p, const int item, LDSP char* lds, const int tid0) {
    LDSP char* kb = lds; LDSP char* vb = lds + 8192; LDSP float* luts = (LDSP float*)(lds + 46080);
    const float c1 = 0.125f * LOG2E;
    int tid = tid0; asm volatile("" : "+v"(tid));
    const int wid = tid >> 6, lane = tid & 63, q = lane & 31, hh = lane >> 5;
    AttLane L; att_lane_init<128, 128, 2>(L, lane);
    int rc[1]; att_stage_map<8>(rc, tid);
    const int b = item >> 9, kvh = (item >> 8) & 1, t0 = (item & 255) * 32, head = kvh * 4 + wid;
    bf16x8 qf[4];
    {
        const bf16_t* qp = p.proj1 + (size_t)(b * SEQ + t0 + q) * 1216 + 448 + head * 64 + 8 * hh;
#pragma unroll
        for (int ks = 0; ks < 4; ++ks) qf[ks] = *(const bf16x8*)(qp + 16 * ks);
    }
    f32x16 o[2];
#pragma unroll
    for (int dt = 0; dt < 2; ++dt)
#pragma unroll
        for (int r = 0; r < 16; ++r) o[dt][r] = 0.f;
    float lsum = 0.f;
    const bf16_t* kbp = p.proj1 + (size_t)b * SEQ * 1216 + 960 + kvh * 64;
    const bf16_t* zr = p.zrow;
    auto ksrc = [&](int pos0) { return [=](int row, int gc) { const int pos = pos0 + row; return (pos >= 0 && pos < SEQ) ? kbp + (size_t)pos * 1216 + gc * 8 : zr + gc * 8; }; };
    auto vsrc = [&](int pos0) { return [=](int row, int gc) { const int pos = pos0 + row; return (pos >= 0 && pos < SEQ) ? kbp + (size_t)pos * 1216 + 128 + gc * 8 : zr + gc * 8; }; };
    const unsigned tab = (unsigned)(size_t)(luts + head * 256);
    att_stage<8>(kb, ksrc(t0 - 128), rc, wid);
    for (int i = 0; i < 3; ++i) {
        const int pos0 = t0 - 128 + 64 * i;
        asm volatile("s_waitcnt vmcnt(0)" ::: "memory"); ATT_BAR();
        att_stage<8>(vb, vsrc(pos0), rc, wid);
        bf16x8 pf[4];
        int dq = t0 + q - pos0 - 4 * hh; dq = dq < -1 ? -1 : dq;
        att_qk<4, 128, 1, true, false>(kb, L, qf, pf, lsum, c1, 0.f, tab + (unsigned)(dq + 1) * 4u, 0, nullptr, 0.f);
        asm volatile("s_waitcnt vmcnt(0) lgkmcnt(0)" ::: "memory"); ATT_BAR();
        if (i + 1 < 3) att_stage<8>(kb, ksrc(pos0 + 64), rc, wid);
        att_pv<2, 128>(vb, L, pf, o);
    }
    const float lt = lsum + __shfl_xor(lsum, 32) + __builtin_amdgcn_exp2f(p.sinks[head] * LOG2E + ATT_SHIFT);
    const float inv = 1.0f / lt;
    bf16_t* op = p.o + (size_t)(b * SEQ + t0 + q) * DM + 512 + head * 64 + 4 * hh;
#pragma unroll
    for (int dt = 0; dt < 2; ++dt)
#pragma unroll
        for (int rq = 0; rq < 4; ++rq)
            *(u32x2*)(op + 32 * dt + 8 * rq) = (u32x2){cvtpk(o[dt][4 * rq] * inv, o[dt][4 * rq + 1] * inv), cvtpk(o[dt][4 * rq + 2] * inv, o[dt][4 * rq + 3] * inv)};
}
__device__ __forceinline__ void moe_conv_item(const P& p, const int layer, const int item, LDSP char* lds, const int tid0) {
    float* sm = (float*)lds;
    const int set = item >> 8, t0 = (item & 255) * 8;
    if (set == 0) conv_batched<1>(p.moe_wg + (size_t)layer * 16 * 1024 * 512, 16, 1024, 512, (size_t)1024 * 512, p.wt_gu + (size_t)layer * 16 * 1024 * 1024, (size_t)1024 * 1024, t0, 1, sm, tid0, t0 + 8);
    else if (set == 1) conv_batched<2>(p.moe_wu + (size_t)layer * 16 * 1024 * 512, 16, 1024, 512, (size_t)1024 * 512, p.wt_gu + (size_t)layer * 16 * 1024 * 1024, (size_t)1024 * 1024, t0, 1, sm, tid0, t0 + 8);
    else conv_batched<0>(p.moe_wd + (size_t)layer * 16 * 512 * 1024, 16, 512, 1024, (size_t)512 * 1024, p.wt_d + (size_t)layer * 16 * 1024 * 512, (size_t)1024 * 512, t0, 1, sm, tid0, t0 + 8);
}
__device__ __forceinline__ void st_attn1(const P& p, LDSP char* lds) {
    const int tid0 = otid();
    LDSP float* lut = (LDSP float*)(lds + 40960); LDSP int* slot = (LDSP int*)(lds + 45568); LDSP float* luts = (LDSP float*)(lds + 46080);
    for (int i = tid0; i < 1152; i += 256) lut[i] = (i < 64) ? ATT_NEG : ATT_SHIFT;
#pragma unroll 1
    for (int h = 0; h < 8; ++h) build_lut(luts + h * 256, p.blut + h * 1024, 256, 128, tid0);
    for (;;) {
        const int item = wq_next(p.wq + 0, slot, tid0);
        if (item >= 768 + 1024 + 768) break;
        if (item < 768) mla_item(p, item, lds, tid0);
        else { const int r = item - 768, g = r / 7, ps = r - g * 7;
               if (ps < 4) swa_item(p, g * 4 + ps, lds, tid0); else moe_conv_item(p, 1, g * 3 + ps - 4, lds, tid0); }
    }
}

#define A0_GLUT 16384
#define A0_WLUT 34816
#define A0_IMP 45056
#define A0_SEL 61568
#define A0_UN 62080
#define A0_LIST 62144
#define A0_SLOT 62720
__device__ __forceinline__ unsigned wmax_u32(unsigned v) {
#pragma unroll
    for (int o = 32; o > 0; o >>= 1) { const unsigned t = (unsigned)__shfl_xor((int)v, o); v = t > v ? t : v; }
    return v;
}
#define ATT_STORE_O(op, o, sc) do { _Pragma("unroll") for (int dt_ = 0; dt_ < 2; ++dt_) _Pragma("unroll") for (int rq_ = 0; rq_ < 4; ++rq_) \
        *(u32x2*)((op) + 32 * dt_ + 8 * rq_) = (u32x2){cvtpk((o)[dt_][4 * rq_] * (sc), (o)[dt_][4 * rq_ + 1] * (sc)), cvtpk((o)[dt_][4 * rq_ + 2] * (sc), (o)[dt_][4 * rq_ + 3] * (sc))}; } while (0)

__device__ __forceinline__ void nsa_item(const P& p, const int item, LDSP char* lds, const int tid0) {
    LDSP char* kb = lds; LDSP char* vb = lds + 8192;
    LDSP float* glut = (LDSP float*)(lds + A0_GLUT); LDSP float* wlut = (LDSP float*)(lds + A0_WLUT); LDSP float* imp = (LDSP float*)(lds + A0_IMP);
    LDSP unsigned* sel = (LDSP unsigned*)(lds + A0_SEL); LDSP unsigned* un = (LDSP unsigned*)(lds + A0_UN); LDSP unsigned short* blist = (LDSP unsigned short*)(lds + A0_LIST);
    const float c1 = 0.125f * LOG2E;
    int tid = tid0; asm volatile("" : "+v"(tid));
    const int wid = tid >> 6, lane = tid & 63, q = lane & 31, hh = lane >> 5;
    const int tile = 255 - (item >> 2), b = (item >> 1) & 1, kvh = item & 1, t0 = tile * 32, blk_t = t0 >> 6, head = kvh * 4 + wid;
#pragma unroll 1
    for (int h = 0; h < 4; ++h) { build_lut(glut + h * 1152, p.blut + (kvh * 4 + h) * 1024, 1152, 1 << 30, tid); build_lut(wlut + h * 640, p.blut + (kvh * 4 + h) * 1024, 640, 512, tid); }
    for (int i = tid; i < 32 * 129; i += 256) imp[i] = 0.f;
    AttLane L; att_lane_init<128, 128, 2>(L, lane);
    int rc[1]; att_stage_map<8>(rc, tid);
    const size_t rowq = (size_t)(b * SEQ + t0 + q);
    bf16x8 qf[4];
    {
        const bf16_t* qp = p.proj + rowq * 2840 + head * 64 + 8 * hh;
#pragma unroll
        for (int ks = 0; ks < 4; ++ks) qf[ks] = *(const bf16x8*)(qp + 16 * ks);
    }
    const float gc = p.gates[rowq * 24 + head * 3 + 0], gs = p.gates[rowq * 24 + head * 3 + 1], gw = p.gates[rowq * 24 + head * 3 + 2];
    const unsigned gtab = (unsigned)(size_t)(glut + wid * 1152), wtab = (unsigned)(size_t)(wlut + wid * 640);
    const bf16_t* zr = p.zrow;
    const bf16_t* pb = p.proj + (size_t)b * SEQ * 2840;
    f32x16 of[2], o[2];
#pragma unroll
    for (int dt = 0; dt < 2; ++dt)
#pragma unroll
        for (int r = 0; r < 16; ++r) { of[dt][r] = 0.f; o[dt][r] = 0.f; }
    bf16x8 pf[4];
    __syncthreads();
    const float cfar = glut[wid * 1152 + 64 + 1023];
    {
        int nvm = (t0 >> 4) + 1; nvm = nvm > 511 ? 511 : nvm;
        const int ntc = (nvm + 63) >> 6;
        const bf16_t* kcb = p.kcmpb + (size_t)((b * 2 + kvh) * 512) * 64;
        const bf16_t* vcb = p.kcmpb + (size_t)((4 + b * 2 + kvh) * 512) * 64;
        auto csrc = [&](const bf16_t* base, int n0) { return [=](int row, int gcx) { const int n = n0 + row; return n < 511 ? base + (size_t)n * 64 + gcx * 8 : zr + gcx * 8; }; };
        float lsum = 0.f;
        for (int nt = 0; nt < ntc; ++nt) {
            att_stage<8>(kb, csrc(kcb, nt * 64), rc, wid);
            asm volatile("s_waitcnt vmcnt(0)" ::: "memory"); ATT_BAR();
            const int dq16 = t0 + q - 31 - 1024 * nt - 64 * hh;
            if (t0 - 31 - 16 * (nt * 64 + 63) >= 1023) att_qk<4, 128, 0, false, false>(kb, L, qf, pf, lsum, c1, cfar, 0u, 0, nullptr, 0.f);
            else att_qk<4, 128, 2, false, false>(kb, L, qf, pf, lsum, c1, 0.f, gtab, dq16, nullptr, 0.f);
            asm volatile("s_waitcnt lgkmcnt(0)" ::: "memory"); ATT_BAR();
        }
        const float lc = lsum + __shfl_xor(lsum, 32);
        const float invl = lc > 0.f ? 1.0f / lc : 0.f;
        float dummy = 0.f;
        for (int nt = 0; nt < ntc; ++nt) {
            att_stage<8>(kb, csrc(kcb, nt * 64), rc, wid);
            att_stage<8>(vb, csrc(vcb, nt * 64), rc, wid);
            asm volatile("s_waitcnt vmcnt(0)" ::: "memory"); ATT_BAR();
            const int dq16 = t0 + q - 31 - 1024 * nt - 64 * hh;
            LDSP float* improw = imp + q * 129 + 16 * nt + hh;
            if (t0 - 31 - 16 * (nt * 64 + 63) >= 1023) att_qk<4, 128, 0, true, true>(kb, L, qf, pf, dummy, c1, cfar, 0u, 0, improw, invl * 524288.0f);
            else att_qk<4, 128, 2, true, true>(kb, L, qf, pf, dummy, c1, 0.f, gtab, dq16, improw, invl * 524288.0f);
            att_pv<2, 128>(vb, L, pf, o);
            asm volatile("s_waitcnt lgkmcnt(0)" ::: "memory"); ATT_BAR();
        }
        const float sc = gc * invl;
#pragma unroll
        for (int dt = 0; dt < 2; ++dt)
#pragma unroll
            for (int r = 0; r < 16; ++r) { of[dt][r] = o[dt][r] * sc; o[dt][r] = 0.f; }
    }
    __syncthreads();
    {
        unsigned u0 = 0u, u1 = 0u, u2 = 0u, u3 = 0u;
        for (int i = 0; i < 8; ++i) {
            const int tok = wid * 8 + i;
            const unsigned v0 = ((LDSP const unsigned*)imp)[tok * 129 + lane], v1 = ((LDSP const unsigned*)imp)[tok * 129 + 64 + lane];
            const int j0 = lane, j1 = lane + 64;
            const bool f0 = (j0 == 0) || (j0 == blk_t) || (j0 == blk_t - 1), f1 = (j1 == blk_t) || (j1 == blk_t - 1);
            unsigned k0 = f0 ? (0xFFFFFF80u | (unsigned)(127 - j0)) : (j0 <= blk_t ? ((v0 << 7) | (unsigned)(127 - j0)) : 0u);
            unsigned k1 = f1 ? (0xFFFFFF80u | (unsigned)(127 - j1)) : (j1 <= blk_t ? ((v1 << 7) | (unsigned)(127 - j1)) : 0u);
            unsigned thr = 0u;
#pragma unroll 1
            for (int bit = 31; bit >= 0; --bit) {
                const unsigned cand = thr | (1u << bit);
                const int c = __popcll(__ballot(k0 >= cand)) + __popcll(__ballot(k1 >= cand));
                thr = (c >= 16) ? cand : thr;
            }
            thr = thr ? thr : 1u;
            const unsigned long long b0 = __ballot(k0 >= thr), b1 = __ballot(k1 >= thr);
            const unsigned m0 = (unsigned)b0, m1 = (unsigned)(b0 >> 32), m2 = (unsigned)b1, m3 = (unsigned)(b1 >> 32);
            if (lane == 0) { sel[tok * 4 + 0] = m0; sel[tok * 4 + 1] = m1; sel[tok * 4 + 2] = m2; sel[tok * 4 + 3] = m3; }
            u0 |= m0; u1 |= m1; u2 |= m2; u3 |= m3;
        }
        if (lane == 0) { un[wid * 4 + 0] = u0; un[wid * 4 + 1] = u1; un[wid * 4 + 2] = u2; un[wid * 4 + 3] = u3; }
    }
    __syncthreads();
    {
        unsigned uw[4];
#pragma unroll
        for (int k = 0; k < 4; ++k) uw[k] = (unsigned)__builtin_amdgcn_readfirstlane((int)(un[k] | un[4 + k] | un[8 + k] | un[12 + k]));
        if (tid < 128) {
            const int k = tid >> 5, jb = tid & 31;
            unsigned wv = 0u; int below = 0;
#pragma unroll
            for (int kk = 0; kk < 4; ++kk) { if (kk == k) wv = uw[kk]; if (kk < k) below += __popc(uw[kk]); }
            if ((wv >> jb) & 1u) blist[below + __popc(wv & ((1u << jb) - 1u))] = (unsigned short)tid;
        }
        const int nb = __popc(uw[0]) + __popc(uw[1]) + __popc(uw[2]) + __popc(uw[3]);
        unsigned sq[4];
#pragma unroll
        for (int k = 0; k < 4; ++k) sq[k] = sel[q * 4 + k];
        __syncthreads();
        const bf16_t* ksb = pb + 768 + kvh * 64;
        auto ssrc = [&](int pos0, int colo) { return [=](int row, int gcx) { return ksb + (size_t)(pos0 + row) * 2840 + colo + gcx * 8; }; };
        float lsum = 0.f;
        att_stage<8>(kb, ssrc(64 * (int)blist[0], 0), rc, wid);
        for (int i = 0; i < nb; ++i) {
            const int j = __builtin_amdgcn_readfirstlane((int)blist[i]), pos0 = 64 * j;
            asm volatile("s_waitcnt vmcnt(0)" ::: "memory"); ATT_BAR();
            att_stage<8>(vb, ssrc(pos0, 128), rc, wid);
            unsigned sw = 0u;
#pragma unroll
            for (int k = 0; k < 4; ++k) if ((j >> 5) == k) sw = sq[k];
            const bool selq = (sw >> (j & 31)) & 1u;
            if (t0 - (pos0 + 63) >= 1023) att_qk<4, 128, 0, true, false>(kb, L, qf, pf, lsum, c1, selq ? cfar : ATT_NEG, 0u, 0, nullptr, 0.f);
            else {
                int dq = t0 + q - pos0 - 4 * hh; dq = dq > 1087 ? 1087 : dq; dq = (dq < -1 || !selq) ? -1 : dq;
                att_qk<4, 128, 1, true, false>(kb, L, qf, pf, lsum, c1, 0.f, gtab + (unsigned)(dq + 1) * 4u, 0, nullptr, 0.f);
            }
            asm volatile("s_waitcnt vmcnt(0) lgkmcnt(0)" ::: "memory"); ATT_BAR();
            if (i + 1 < nb) att_stage<8>(kb, ssrc(64 * (int)blist[i + 1], 0), rc, wid);
            att_pv<2, 128>(vb, L, pf, o);
        }
        const float ls = lsum + __shfl_xor(lsum, 32);
        const float sc = gs / ls;
#pragma unroll
        for (int dt = 0; dt < 2; ++dt)
#pragma unroll
            for (int r = 0; r < 16; ++r) { of[dt][r] += o[dt][r] * sc; o[dt][r] = 0.f; }
    }
    {
        const bf16_t* kwb = pb + 1024 + kvh * 64;
        auto wsrc = [&](int pos0, int colo) { return [=](int row, int gcx) { const int pos = pos0 + row; return (pos >= 0 && pos < SEQ) ? kwb + (size_t)pos * 2840 + colo + gcx * 8 : zr + gcx * 8; }; };
        float lsum = 0.f;
        asm volatile("s_waitcnt lgkmcnt(0)" ::: "memory"); ATT_BAR();
        att_stage<8>(kb, wsrc(t0 - 512, 0), rc, wid);
        for (int i = 0; i < 9; ++i) {
            const int pos0 = t0 - 512 + 64 * i;
            asm volatile("s_waitcnt vmcnt(0)" ::: "memory"); ATT_BAR();
            att_stage<8>(vb, wsrc(pos0, 128), rc, wid);
            int dq = t0 + q - pos0 - 4 * hh; dq = dq < -1 ? -1 : dq;
            att_qk<4, 128, 1, true, false>(kb, L, qf, pf, lsum, c1, 0.f, wtab + (unsigned)(dq + 1) * 4u, 0, nullptr, 0.f);
            asm volatile("s_waitcnt vmcnt(0) lgkmcnt(0)" ::: "memory"); ATT_BAR();
            if (i + 1 < 9) att_stage<8>(kb, wsrc(pos0 + 64, 0), rc, wid);
            att_pv<2, 128>(vb, L, pf, o);
        }
        const float lw = lsum + __shfl_xor(lsum, 32);
        const float sc = gw / lw;
#pragma unroll
        for (int dt = 0; dt < 2; ++dt)
#pragma unroll
            for (int r = 0; r < 16; ++r) of[dt][r] += o[dt][r] * sc;
    }
    bf16_t* op = p.o + rowq * DM + head * 64 + 4 * hh;
    ATT_STORE_O(op, of, 1.0f);
}

#define MG_CNT 8192
#define MG_BASE 8320
#define MG_ENT 8448
__device__ __forceinline__ void st_moba_gate(const P& p, int wg, int nwg, LDSP char* lds) {
    const int tid = otid();
    const int wid = tid >> 6, lane = tid & 63, q = lane & 31, hh = lane >> 5;
    LDSP char* kmt = lds; LDSP int* lcnt = (LDSP int*)(lds + MG_CNT); LDSP int* lbase = (LDSP int*)(lds + MG_BASE); LDSP int* ent = (LDSP int*)(lds + MG_ENT);
    AttLane L; att_lane_init<128, 128, 2>(L, lane);
    int rc[1]; att_stage_map<8>(rc, tid);
    const bf16_t* zr = p.zrow;
    for (int item = wg; item < 1024; item += nwg) {
        const int tile = item >> 4, b = (item >> 3) & 1, h = item & 7, t0 = tile * 128, own = t0 >> 8, tw = t0 + wid * 32, bh = b * 8 + h;
        if (own == 0) continue;
        __syncthreads();
        if (tid < 32) lcnt[tid] = 0;
        bf16x8 qf[4];
        {
            const bf16_t* qp = p.proj + (size_t)(b * SEQ + tw + q) * 2840 + 1304 + h * 64 + 8 * hh;
#pragma unroll
            for (int ks = 0; ks < 4; ++ks) qf[ks] = *(const bf16x8*)(qp + 16 * ks);
        }
        const bf16_t* kmb = p.kmeanb + (size_t)(bh * 32) * 64;
        att_stage<8>(kmt, [=](int row, int gcx) { return row < 32 ? kmb + (size_t)row * 64 + gcx * 8 : zr + gcx * 8; }, rc, wid);
        asm volatile("s_waitcnt vmcnt(0)" ::: "memory");
        __syncthreads();
        f32x16 s;
#pragma unroll
        for (int r = 0; r < 16; ++r) s[r] = 0.f;
#pragma unroll
        for (int ks = 0; ks < 4; ++ks) {
            const bf16x8 a = *(const LDSP bf16x8*)(kmt + (L.kbase ^ (32 * (ks & 3))));
            s = __builtin_amdgcn_mfma_f32_32x32x16_bf16(a, qf[ks], s, 0, 0, 0);
        }
        unsigned key[16];
#pragma unroll
        for (int r = 0; r < 16; ++r) {
            const int j = (r & 3) + 8 * (r >> 2) + 4 * hh;
            const unsigned bits = __float_as_uint(s[r]);
            const unsigned srt = (bits & 0x80000000u) ? ~bits : (bits | 0x80000000u);
            key[r] = (j < own) ? ((srt & ~31u) | (unsigned)(31 - j)) : 0u;
        }
        unsigned selm = 0u;
#pragma unroll 1
        for (int rnd = 0; rnd < 3; ++rnd) {
            unsigned m = 0u;
#pragma unroll
            for (int r = 0; r < 16; ++r) m = key[r] > m ? key[r] : m;
            const unsigned mo = (unsigned)__shfl_xor((int)m, 32);
            const unsigned wk = mo > m ? mo : m;
            if (wk != 0u) selm |= 1u << (31 - (wk & 31u));
#pragma unroll
            for (int r = 0; r < 16; ++r) key[r] = (key[r] == wk) ? 0u : key[r];
        }
        if (hh == 0) {
            unsigned mm = selm;
#pragma unroll
            for (int sI = 0; sI < 3; ++sI) {
                int en = -1;
                if (mm) { const int j = __builtin_ctz(mm); mm &= mm - 1u; const int lp = __hip_atomic_fetch_add(lcnt + j, 1, __ATOMIC_RELAXED, __HIP_MEMORY_SCOPE_WORKGROUP); en = (j << 8) | lp; }
                ent[(wid * 32 + q) * 3 + sI] = en;
            }
        }
        __syncthreads();
        if (tid < 32) { const int c = lcnt[tid]; lbase[tid] = c ? atomicAdd(p.mcnt + bh * 32 + tid, c) : 0; }
        __syncthreads();
        for (int e = tid; e < 384; e += 256) {
            const int en = ent[e];
            if (en >= 0) { const int j = en >> 8, tokl = e / 3, sI = e - tokl * 3; p.mlist[(size_t)(bh * 32 + j) * 8192 + lbase[j] + (en & 255)] = (unsigned short)((t0 + tokl) | (sI << 13)); }
        }
    }
}
__device__ __forceinline__ bf16_t* moba_part(const P& p, int slot, size_t row) { return (slot < 2 ? p.mp01 + (size_t)slot * 131072 * 64 : p.mp2) + row * 64; }

__device__ __forceinline__ void moba_inv_item(const P& p, const int lid, const int chunk, LDSP char* lds, const int tid0) {
    LDSP char* kb = lds; LDSP char* vb = lds + 8192; LDSP float* glut = (LDSP float*)(lds + A0_GLUT);
    const float c1 = 0.125f * LOG2E;
    int tid = tid0; asm volatile("" : "+v"(tid));
    const int wid = tid >> 6, lane = tid & 63, q = lane & 31, hh = lane >> 5;
    const int bh = lid / 31, j = lid - bh * 31, b = bh >> 3, h = bh & 7;
    build_lut(glut, p.blut + h * 1024, 1152, 1 << 30, tid);
    AttLane L; att_lane_init<128, 128, 2>(L, lane);
    int rc[1]; att_stage_map<8>(rc, tid);
    const int n = p.mcnt[bh * 32 + j], idx = chunk * 128 + wid * 32 + q;
    const bool valid = idx < n;
    const unsigned en = valid ? (unsigned)p.mlist[(size_t)(bh * 32 + j) * 8192 + idx] : (unsigned)(256 * (j + 1));
    const int tok = (int)(en & 8191u), slot = (int)(en >> 13);
    bf16x8 qf[4];
    {
        const bf16_t* qp = p.proj + (size_t)(b * SEQ + tok) * 2840 + 1304 + h * 64 + 8 * hh;
#pragma unroll
        for (int ks = 0; ks < 4; ++ks) qf[ks] = *(const bf16x8*)(qp + 16 * ks);
    }
    const unsigned gtab = (unsigned)(size_t)glut;
    const bf16_t* kbb = p.proj + (size_t)b * SEQ * 2840 + 1816 + h * 64;
    auto msrc = [&](int pos0, int colo) { return [=](int row, int gcx) { return kbb + (size_t)(pos0 + row) * 2840 + colo + gcx * 8; }; };
    f32x16 o[2];
#pragma unroll
    for (int dt = 0; dt < 2; ++dt)
#pragma unroll
        for (int r = 0; r < 16; ++r) o[dt][r] = 0.f;
    float lsum = 0.f;
    bf16x8 pf[4];
    __syncthreads();
    att_stage<8>(kb, msrc(256 * j, 0), rc, wid);
    for (int i = 0; i < 4; ++i) {
        const int pos0 = 256 * j + 64 * i;
        asm volatile("s_waitcnt vmcnt(0)" ::: "memory"); ATT_BAR();
        att_stage<8>(vb, msrc(pos0, 512), rc, wid);
        {
            int dq = tok - pos0 - 4 * hh; dq = dq > 1087 ? 1087 : dq; dq = valid ? dq : -1;
            att_qk<4, 128, 1, true, false>(kb, L, qf, pf, lsum, c1, 0.f, gtab + (unsigned)(dq + 1) * 4u, 0, nullptr, 0.f);
        }
        asm volatile("s_waitcnt vmcnt(0) lgkmcnt(0)" ::: "memory"); ATT_BAR();
        if (i + 1 < 4) att_stage<8>(kb, msrc(pos0 + 64, 0), rc, wid);
        att_pv<2, 128>(vb, L, pf, o);
    }
    const float lt = lsum + __shfl_xor(lsum, 32);
    if (valid) {
        const size_t row = (size_t)bh * SEQ + tok;
        bf16_t* op = moba_part(p, slot, row) + 4 * hh;
        ATT_STORE_O(op, o, 1.0f);
        if (hh == 0) p.mpl[(size_t)slot * 131072 + row] = lt;
    }
}
__device__ __forceinline__ void moba_own_item(const P& p, const int item, LDSP char* lds, const int tid0) {
    LDSP char* kb = lds; LDSP char* vb = lds + 8192; LDSP float* glut = (LDSP float*)(lds + A0_GLUT);
    const float c1 = 0.125f * LOG2E;
    int tid = tid0; asm volatile("" : "+v"(tid));
    const int wid = tid >> 6, lane = tid & 63, q = lane & 31, hh = lane >> 5;
    const int tile = item >> 4, b = (item >> 3) & 1, h = item & 7, t0 = tile * 128, own = t0 >> 8, tw = t0 + wid * 32, bh = b * 8 + h;
    __syncthreads();
    build_lut(glut, p.blut + h * 1024, 1152, 1 << 30, tid);
    AttLane L; att_lane_init<128, 128, 2>(L, lane);
    int rc[1]; att_stage_map<8>(rc, tid);
    const size_t rowq = (size_t)(b * SEQ + tw + q);
    bf16x8 qf[4];
    {
        const bf16_t* qp = p.proj + rowq * 2840 + 1304 + h * 64 + 8 * hh;
#pragma unroll
        for (int ks = 0; ks < 4; ++ks) qf[ks] = *(const bf16x8*)(qp + 16 * ks);
    }
    const unsigned gtab = (unsigned)(size_t)glut;
    const bf16_t* kbb = p.proj + (size_t)b * SEQ * 2840 + 1816 + h * 64;
    auto msrc = [&](int pos0, int colo) { return [=](int row, int gcx) { return kbb + (size_t)(pos0 + row) * 2840 + colo + gcx * 8; }; };
    f32x16 o[2];
#pragma unroll
    for (int dt = 0; dt < 2; ++dt)
#pragma unroll
        for (int r = 0; r < 16; ++r) o[dt][r] = 0.f;
    float lsum = 0.f;
    bf16x8 pf[4];
    const int nb = (((t0 + 127) >> 6) & 3) + 1;
    __syncthreads();
    att_stage<8>(kb, msrc(256 * own, 0), rc, wid);
    for (int i = 0; i < nb; ++i) {
        const int pos0 = 256 * own + 64 * i;
        asm volatile("s_waitcnt vmcnt(0)" ::: "memory"); ATT_BAR();
        att_stage<8>(vb, msrc(pos0, 512), rc, wid);
        const bool active = pos0 <= tw + 31;
        if (active) {
            int dq = tw + q - pos0 - 4 * hh; dq = dq < -1 ? -1 : dq;
            att_qk<4, 128, 1, true, false>(kb, L, qf, pf, lsum, c1, 0.f, gtab + (unsigned)(dq + 1) * 4u, 0, nullptr, 0.f);
        }
        asm volatile("s_waitcnt vmcnt(0) lgkmcnt(0)" ::: "memory"); ATT_BAR();
        if (i + 1 < nb) att_stage<8>(kb, msrc(pos0 + 64, 0), rc, wid);
        if (active) att_pv<2, 128>(vb, L, pf, o);
    }
    float lt = lsum + __shfl_xor(lsum, 32);
    const int npick = own < 3 ? own : 3;
    const size_t row = (size_t)bh * SEQ + tw + q;
#pragma unroll 1
    for (int sI = 0; sI < npick; ++sI) {
        lt += p.mpl[(size_t)sI * 131072 + row];
        const bf16_t* pp = moba_part(p, sI, row) + 4 * hh;
#pragma unroll
        for (int dt = 0; dt < 2; ++dt)
#pragma unroll
            for (int rq = 0; rq < 4; ++rq) {
                const u32x2 w = *(const u32x2*)(pp + 32 * dt + 8 * rq);
                o[dt][4 * rq] += __uint_as_float(w[0] << 16); o[dt][4 * rq + 1] += __uint_as_float(w[0] & 0xffff0000u);
                o[dt][4 * rq + 2] += __uint_as_float(w[1] << 16); o[dt][4 * rq + 3] += __uint_as_float(w[1] & 0xffff0000u);
            }
    }
    const float inv = 1.0f / lt;
    bf16_t* op = p.o + rowq * DM + 512 + h * 64 + 4 * hh;
    ATT_STORE_O(op, o, inv);
}
__device__ __forceinline__ void st_moba_own(const P& p, int wg, int nwg, LDSP char* lds) {
    const int tid0 = otid();
    for (int item = wg; item < 1024; item += nwg) moba_own_item(p, item, lds, tid0);
}
#define A0_PRE 62736
__device__ __forceinline__ void st_attn0(const P& p, LDSP char* lds) {
    const int tid0 = otid();
    LDSP int* slot = (LDSP int*)(lds + A0_SLOT); LDSP int* pre = (LDSP int*)(lds + A0_PRE);
    LDSP int* tmp = (LDSP int*)lds;
    for (int i = tid0; i < 496; i += 256) { const int bh = i / 31, j = i - bh * 31; tmp[i] = (p.mcnt[bh * 32 + j] + 127) >> 7; }
    __syncthreads();
    for (int i = tid0; i < 497; i += 256) { int s = 0; for (int k = 0; k < i; ++k) s += tmp[k]; pre[i] = s; }
    __syncthreads();
    const int ninv = pre[496];
    for (;;) {
        const int item = wq_next(p.wq + 1, slot, tid0);
        const int ntail = 5 * 768 + (ninv > 3072 ? ninv - 3072 : 0);
        if (item >= 1024 + ntail) break;
        if (item < 1024) nsa_item(p, item, lds, tid0);
        else {
            const int r = item - 1024, g = r / 5, ps = r - g * 5;
            if (g < 768 && ps == 4) { moe_conv_item(p, 0, g, lds, tid0); continue; }
            const int idx = (g < 768) ? g * 4 + ps : 3072 + (r - 5 * 768);
            if (idx >= ninv) continue;
            int lo = 0, hi = 495;
            while (lo < hi) { const int mid = (lo + hi + 1) >> 1; if (pre[mid] <= idx) lo = mid; else hi = mid - 1; }
            moba_inv_item(p, lo, idx - pre[lo], lds, tid0);
        }
    }
}

#define XB_TMO      128
#define XB_XCNT(j)  (256  + 64 * (j))
#define XB_XSUB(j)  (1280 + 64 * (j))
#define XB_XGEN(j)  (2304 + 64 * (j))
#define XB_TOP      3328
#define XB_TOPGEN   3392
#define XCD_BAR_WORDS 3456
#define XB_SPIN_CAP (1u << 20)
#define LAS __attribute__((address_space(3)))

__device__ __forceinline__ unsigned xb_ld(unsigned* p)              { return __hip_atomic_load(p, __ATOMIC_RELAXED, __HIP_MEMORY_SCOPE_AGENT); }
__device__ __forceinline__ unsigned xb_add(unsigned* p, unsigned v) { return __hip_atomic_fetch_add(p, v, __ATOMIC_RELAXED, __HIP_MEMORY_SCOPE_AGENT); }
__device__ __forceinline__ unsigned xb_xcc_id() { return (unsigned)__builtin_amdgcn_s_getreg((3 << 11) | 20) & 0xFu; }
#define XB_SPIN(cond, bar) do { unsigned _sp = 0; while (cond) { __builtin_amdgcn_s_sleep(1); \
    if ((++_sp & 255u) == 0u) { if (xb_ld(&(bar)[XB_TMO])) break; if (_sp > XB_SPIN_CAP) { atomicAdd(&(bar)[XB_TMO], 1u); break; } } } } while (0)

struct XcdBarrier {
    unsigned* bar; unsigned x;
    volatile LAS unsigned* st;
};

__device__ __forceinline__ XcdBarrier xcd_barrier_post(unsigned* bar, volatile LAS unsigned* st) {
    XcdBarrier b; b.bar = bar; b.x = xb_xcc_id(); b.st = st;
    if (threadIdx.x == 0) (void)xb_add(&bar[XB_XCNT(b.x)], 1u);
    return b;
}
__device__ __forceinline__ void xcd_barrier_complete(unsigned* bar, unsigned x, unsigned& nloc, unsigned& nx) {
    const unsigned G = gridDim.x * gridDim.y * gridDim.z;
    unsigned sum, cnt, mine, sp = 0u;
    for (;;) {
        sum = 0u; cnt = 0u; mine = 0u;
#pragma unroll
        for (unsigned j = 0; j < 16; ++j) { const unsigned c = xb_ld(&bar[XB_XCNT(j)]); sum += c; cnt += (c > 0u) ? 1u : 0u; mine = (j == x) ? c : mine; }
        if (sum == G) break;
        __builtin_amdgcn_s_sleep(1);
        if ((++sp & 255u) == 0u) { if (xb_ld(&bar[XB_TMO])) break; if (sp > XB_SPIN_CAP) { atomicAdd(&bar[XB_TMO], 1u); break; } }
    }
    nloc = mine > 0u ? mine : 1u; nx = cnt > 0u ? cnt : 1u;
}

__device__ __forceinline__ void xcd_barrier(const XcdBarrier& b) {
    asm volatile("s_waitcnt vmcnt(0)" ::: "memory");
    __syncthreads();
    if (threadIdx.x == 0) {
        unsigned* bar = b.bar;
        __builtin_amdgcn_s_waitcnt(0);
        unsigned nloc = b.st[0], nx = b.st[1];
        if (nloc == 0u) { xcd_barrier_complete(bar, b.x, nloc, nx); b.st[0] = nloc; b.st[1] = nx; }
        const unsigned old = xb_add(&bar[XB_XSUB(b.x)], 1u);
        const unsigned gen = old / nloc;
        if (old + 1u == (gen + 1u) * nloc) {
            __builtin_amdgcn_fence(__ATOMIC_RELEASE, "agent");
            asm volatile("s_waitcnt vmcnt(0)" ::: "memory");
            const unsigned og = xb_add(&bar[XB_TOP], 1u);
            const unsigned tg = og / nx;
            if (og + 1u == (tg + 1u) * nx) xb_add(&bar[XB_TOPGEN], 1u);
            else XB_SPIN(xb_ld(&bar[XB_TOPGEN]) == tg, bar);
            __builtin_amdgcn_fence(__ATOMIC_ACQUIRE, "agent");
            xb_add(&bar[XB_XGEN(b.x)], 1u);
            asm volatile("s_waitcnt vmcnt(0)" ::: "memory");
        } else {
            XB_SPIN(xb_ld(&bar[XB_XGEN(b.x)]) == gen, bar);
            __builtin_amdgcn_fence(__ATOMIC_ACQUIRE, "agent");
            asm volatile("s_waitcnt vmcnt(0)" ::: "memory");
        }
    }
    __syncthreads();
}


#define PHASE_SYNC() do { PP qb_ = (PP)__builtin_amdgcn_kernarg_segment_ptr(); asm volatile("" : "+s"(qb_)); XcdBarrier b_; b_.bar = qb_->bar; b_.x = xb_xcc_id(); \
        b_.st = (volatile LAS unsigned*)(dlds + BAR_LDS_OFF); xcd_barrier(b_); } while (0)
typedef const __attribute__((address_space(4))) P* PP;
#define BAR_SAVE() const unsigned bs0_ = __builtin_amdgcn_readfirstlane(*(volatile LAS unsigned*)(dlds + BAR_LDS_OFF)), \
        bs1_ = __builtin_amdgcn_readfirstlane(*(volatile LAS unsigned*)(dlds + BAR_LDS_OFF + 4)); __syncthreads()
#define BAR_RESTORE() do { __syncthreads(); if (threadIdx.x == 0) { *(volatile LAS unsigned*)(dlds + BAR_LDS_OFF) = bs0_; *(volatile LAS unsigned*)(dlds + BAR_LDS_OFF + 4) = bs1_; } } while (0)
#define PHASE_ARGS() PP q_ = (PP)__builtin_amdgcn_kernarg_segment_ptr(); int wg = blockIdx.x, nwg = gridDim.x; asm volatile("" : "+s"(q_), "+s"(wg), "+s"(nwg)); P p; { const __attribute__((address_space(4))) unsigned long long* s64_ = (const __attribute__((address_space(4))) unsigned long long*)q_; void** d64_ = (void**)&p; _Pragma("unroll") for (int i_ = 0; i_ < (int)(sizeof(P) / 8); ++i_) d64_[i_] = (void*)(__attribute__((address_space(1))) void*)s64_[i_]; } float* sm = (float*)dlds; LDSP char* lds = (LDSP char*)dlds; (void)sm; (void)lds
__global__ void __launch_bounds__(256, 2) k_mega(P pk) {
    extern __shared__ __attribute__((aligned(16))) unsigned char dlds[];
    if (threadIdx.x == 0) *(uint4*)(dlds + BAR_LDS_OFF) = make_uint4(0u, 0u, 0u, 0u);
    __syncthreads();
    (void)xcd_barrier_post(pk.bar, (volatile LAS unsigned*)(dlds + BAR_LDS_OFF));
    { PHASE_ARGS(); st_prologue(p, wg, nwg, sm); st_convert(p, wg, nwg, sm); } PHASE_SYNC();
    { PHASE_ARGS(); st_norm<0>(p, 0, wg, nwg, sm); st_c1_reduce(p, wg, nwg); } PHASE_SYNC();
    { PHASE_ARGS(); BAR_SAVE(); st_inproj0_mf<6>(p, wg, nwg, lds); BAR_RESTORE(); } PHASE_SYNC();
    { PHASE_ARGS(); st_cmp1_mf(p, wg, nwg, lds); st_kmean(p, wg, nwg, sm); } PHASE_SYNC();
    { PHASE_ARGS(); st_cmp2_mf(p, wg, nwg, lds); st_moba_gate(p, wg, nwg, lds); } PHASE_SYNC();
    { PHASE_ARGS(); st_attn0(p, lds); } PHASE_SYNC();
    { PHASE_ARGS(); st_moba_own(p, wg, nwg, lds); } PHASE_SYNC();
    { PHASE_ARGS(); st_outproj_mf<4>(p, 0, wg, nwg, lds); } PHASE_SYNC();
    { PHASE_ARGS(); st_norm<1>(p, 0, wg, nwg, sm); } PHASE_SYNC();
    { PHASE_ARGS(); BAR_SAVE(); st_moe_up_mf<6>(p, 0, wg, nwg, lds); BAR_RESTORE(); } PHASE_SYNC();
    { PHASE_ARGS(); BAR_SAVE(); st_moe_down_mf<6>(p, 0, wg, nwg, lds); BAR_RESTORE(); } PHASE_SYNC();
    { PHASE_ARGS(); st_norm<2>(p, 1, wg, nwg, sm); } PHASE_SYNC();
    { PHASE_ARGS(); BAR_SAVE(); st_inproj1_mf<6>(p, wg, nwg, lds); BAR_RESTORE(); } PHASE_SYNC();
    { PHASE_ARGS(); st_mla_prep(p, wg, nwg); } PHASE_SYNC();
    { PHASE_ARGS(); st_mla_up_mf(p, wg, nwg, lds); } PHASE_SYNC();
    { PHASE_ARGS(); st_attn1(p, lds); } PHASE_SYNC();
    { PHASE_ARGS(); st_mla_combine(p, wg, nwg); } PHASE_SYNC();
    { PHASE_ARGS(); st_outproj_mf<4>(p, 1, wg, nwg, lds); } PHASE_SYNC();
    { PHASE_ARGS(); st_norm<1>(p, 1, wg, nwg, sm); } PHASE_SYNC();
    { PHASE_ARGS(); BAR_SAVE(); st_moe_up_mf<6>(p, 1, wg, nwg, lds); BAR_RESTORE(); } PHASE_SYNC();
    { PHASE_ARGS(); BAR_SAVE(); st_moe_down_mf<6>(p, 1, wg, nwg, lds); BAR_RESTORE(); } PHASE_SYNC();
    { PHASE_ARGS(); st_norm<3>(p, 1, wg, nwg, sm); }
}

extern "C" void kernel_launch(void* const* d_in, const int* in_sizes, int n_in, void* d_out, int out_size, void* d_ws, size_t ws_size,
                              hipStream_t stream) {
    (void)in_sizes; (void)n_in; (void)out_size; (void)ws_size;
    P p{};
    const float* const* in = (const float* const*)d_in;
    p.x = in[0]; p.c = in[1]; p.rel = in[2]; p.router_w = in[3]; p.router_b = in[4]; p.final_norm = in[5]; p.norm_mix = in[6]; p.norm_ffn = in[7];
    p.ada_w = in[8]; p.ada_b = in[9]; p.moe_wg = in[10]; p.moe_wu = in[11]; p.moe_wd = in[12]; p.ev_w_in = in[13]; p.ev_w_out = in[14];
    p.pos_k = in[15]; p.pos_v = in[16]; p.ck_w1 = in[17]; p.ck_w2 = in[18]; p.cv_w1 = in[19]; p.cv_w2 = in[20]; p.od_w_in = in[21]; p.od_w_out = in[22];
    p.q_norm = in[23]; p.kv_norm = in[24]; p.w_q_up = in[25]; p.w_kv_up = in[26]; p.sinks = in[27];
    p.out = (float*)d_out;
    char* ws = (char*)d_ws; size_t off = 0;
    auto take = [&](size_t bytes) { char* r = ws + off; off += (bytes + 255) & ~(size_t)255; return r; };
    p.bar = (unsigned*)take(16384);
    p.cnt = (int*)take(4096);
    p.wq = (int*)take(256);
    p.mcnt = (int*)take(512 * 4);
    p.modv = (float*)take(2 * 2 * 6144 * 4);
    p.zrow = (bf16_t*)take(256);
    const size_t zero_bytes = off;
    p.ropec = (float*)take(SEQ * 32 * 4); p.ropes = (float*)take(SEQ * 32 * 4);
    p.blut = (float*)take(8 * 1024 * 4);
    p.gates = (float*)take((size_t)T_TOK * 24 * 4);
    p.kmean = (float*)take(2 * 8 * 32 * 64 * 4);
    p.tokw = (float*)take((size_t)T_TOK * 2 * 4);
    p.list = (int*)take((size_t)16 * T_TOK * 4);
    p.cqn = (bf16_t*)take((size_t)T_TOK * 384 * 2);
    p.krope = (bf16_t*)take((size_t)T_TOK * 64 * 2);
    p.h = (bf16_t*)take((size_t)T_TOK * DM * 2);
    p.o = (bf16_t*)take((size_t)T_TOK * DM * 2);
    p.mlap = p.h;
    p.mlal = (float*)(p.h + (size_t)2 * 8 * (SEQ / 2) * 128);
    p.mp01 = p.h;
    p.mp2 = (bf16_t*)take((size_t)131072 * 64 * 2);
    p.mpl = (float*)take((size_t)3 * 131072 * 4);
    p.mlist = (unsigned short*)take((size_t)16 * 32 * 8192 * 2);
    p.hid = p.o;
    char* region = take((size_t)100 * 1024 * 1024);
    p.proj = (bf16_t*)region;
    p.proj1 = (bf16_t*)region;
    p.qmla = (bf16_t*)(region + (size_t)T_TOK * 1216 * 2);
    p.kvmla = (bf16_t*)(region + (size_t)T_TOK * (1216 + 768) * 2);
    p.y = (bf16_t*)region;
    p.xr1 = (bf16_t*)d_out;
    p.xr2 = (bf16_t*)((char*)d_out + (size_t)T_TOK * DM * 2);
    p.xr3 = (bf16_t*)(region + (size_t)2 * T_TOK * DM * 2);
    p.chidb = (bf16_t*)take((size_t)2 * 2048 * 256 * 2);
    p.kcmpb = (bf16_t*)take((size_t)8 * 512 * 64 * 2);
    p.kmeanb = (bf16_t*)take((size_t)2 * 8 * 32 * 64 * 2);
    p.c1 = (float*)take(512 * 4);
    p.c1p = (float*)take((size_t)2 * 64 * 256 * 4);
    p.wt_gu = (bf16_t*)take((size_t)32 * 1024 * 1024 * 2);
    p.wt_d = (bf16_t*)take((size_t)32 * 1024 * 512 * 2);
    p.wt_in0 = (bf16_t*)take((size_t)2840 * 1024 * 2);
    p.wt_out0 = (bf16_t*)take((size_t)1024 * 1024 * 2);
    p.wt_c1 = (bf16_t*)take((size_t)2 * 256 * 2048 * 2);
    p.wt_c2 = (bf16_t*)take((size_t)2 * 64 * 256 * 2);
    p.wt_in1 = (bf16_t*)take((size_t)1216 * 1024 * 2);
    p.wt_out1 = (bf16_t*)take((size_t)1024 * 1024 * 2);
    p.wt_qup = (bf16_t*)take((size_t)768 * 256 * 2);
    p.wt_kvup = (bf16_t*)take((size_t)1024 * 128 * 2);
    static int grid = 0;
    if (!grid) {
        int dev = 0, cus = 0, per_cu = 0;
        (void)hipGetDevice(&dev);
        (void)hipDeviceGetAttribute(&cus, hipDeviceAttributeMultiprocessorCount, dev);
        (void)hipFuncSetAttribute((const void*)k_mega, hipFuncAttributeMaxDynamicSharedMemorySize, KERNEL_LDS_BYTES);
        (void)hipOccupancyMaxActiveBlocksPerMultiprocessor(&per_cu, k_mega, 256, KERNEL_LDS_BYTES);
        if (cus <= 0) cus = 256;
        if (per_cu < 1) per_cu = 1;
        grid = cus * (per_cu < 2 ? per_cu : 2);
    }
    (void)hipMemsetAsync(d_ws, 0, zero_bytes, stream);
    hipLaunchKernelGGL(k_mega, dim3(grid), dim3(256), KERNEL_LDS_BYTES, stream, p);
}
```

```cpp
#include <hip/hip_runtime.h>
#include <stdint.h>

typedef unsigned u32x2n __attribute__((ext_vector_type(2)));
typedef float f32x2n __attribute__((ext_vector_type(2)));
#define T_TOK 16384
#define SEQ 8192
#define DM 1024
#define NEGF (-1e30f)
#define BIGF (1e30f)

typedef unsigned short bf16_t;

__device__ __forceinline__ float bf2f(bf16_t v) { return __uint_as_float(((unsigned)v) << 16); }
__device__ __forceinline__ bf16_t f2bf(float f) {
    unsigned u = __float_as_uint(f);
    u += 0x7fffu + ((u >> 16) & 1u);
    return (bf16_t)(u >> 16);
}
typedef __bf16 bf16x2_t __attribute__((ext_vector_type(2)));
typedef float f32x2_t __attribute__((ext_vector_type(2)));
__device__ __forceinline__ unsigned cvtpk(float lo, float hi) { const f32x2_t f = {lo, hi}; return __builtin_bit_cast(unsigned, __builtin_convertvector(f, bf16x2_t)); }
__device__ __forceinline__ unsigned cvtpk_valu(float lo, float hi) { unsigned r; asm("s_nop 0\n\tv_cvt_pk_bf16_f32 %0, %1, %2" : "=v"(r) : "v"(lo), "v"(hi)); return r; }
__device__ __forceinline__ float wsum(float v) {
    v += __builtin_bit_cast(float, __builtin_amdgcn_update_dpp(0, __builtin_bit_cast(int, v), 0xB1, 0xF, 0xF, true));
    v += __builtin_bit_cast(float, __builtin_amdgcn_update_dpp(0, __builtin_bit_cast(int, v), 0x4E, 0xF, 0xF, true));
    v += __builtin_bit_cast(float, __builtin_amdgcn_update_dpp(0, __builtin_bit_cast(int, v), 0x124, 0xF, 0xF, true));
    v += __builtin_bit_cast(float, __builtin_amdgcn_update_dpp(0, __builtin_bit_cast(int, v), 0x128, 0xF, 0xF, true));
    const int iv = __builtin_bit_cast(int, v);
    const float r0 = __builtin_bit_cast(float, __builtin_amdgcn_readlane(iv, 0)), r1 = __builtin_bit_cast(float, __builtin_amdgcn_readlane(iv, 16));
    const float r2 = __builtin_bit_cast(float, __builtin_amdgcn_readlane(iv, 32)), r3 = __builtin_bit_cast(float, __builtin_amdgcn_readlane(iv, 48));
    return (r0 + r1) + (r2 + r3);
}
__device__ __forceinline__ float siluf(float v) { return v / (1.0f + __expf(-v)); }
__device__ __forceinline__ float sigmf(float v) { return 1.0f / (1.0f + __expf(-v)); }
__device__ __forceinline__ float gelu_tanh(float x) {
    const float k0 = 0.7978845608028654f, k1 = 0.044715f;
    float u = k0 * (x + k1 * x * x * x);
    return 0.5f * x * (1.0f + tanhf(u));
}
__device__ __forceinline__ int rel_bucket(int d) {
    if (d < 16) return d < 0 ? 0 : d;
    int b = 16;
    b += (d >= 21); b += (d >= 27); b += (d >= 35); b += (d >= 46); b += (d >= 59); b += (d >= 77); b += (d >= 99); b += (d >= 128);
    b += (d >= 166); b += (d >= 216); b += (d >= 280); b += (d >= 363); b += (d >= 470); b += (d >= 609); b += (d >= 790);
    return b;
}

__device__ __forceinline__ int otid() { int t = threadIdx.x; asm volatile("" : "+v"(t)); return t; }

struct P {
    const float *x, *c, *rel, *router_w, *router_b, *final_norm, *norm_mix, *norm_ffn, *ada_w, *ada_b, *moe_wg, *moe_wu, *moe_wd,
        *ev_w_in, *ev_w_out, *pos_k, *pos_v, *ck_w1, *ck_w2, *cv_w1, *cv_w2, *od_w_in, *od_w_out, *q_norm, *kv_norm, *w_q_up, *w_kv_up, *sinks;
    float* out;
    unsigned* bar; int* cnt;
    float *modv, *ropec, *ropes, *blut, *gates, *kcmp, *vcmp, *chid, *kmean, *tokw, *glutg, *wlutg;
    bf16_t *h, *proj, *o, *hid, *y, *proj1, *qmla, *kvmla, *krope, *cqn;
    int* list;
    bf16_t *wt_gu, *wt_d, *wt_in0, *wt_out0, *wt_c1, *wt_c2, *wt_in1, *wt_out1, *wt_qup, *wt_kvup, *chidb;
    float *c1, *c1p;
    int* wq;
    bf16_t* zrow;
    bf16_t *kcmpb, *kmeanb, *mlap;
    float* mlal;
    int* mcnt; unsigned short* mlist; bf16_t *mp01, *mp2; float* mpl;
    bf16_t *xr1, *xr2, *xr3;
};


__device__ __forceinline__ void st_prologue(const P& p, int wg, int nwg, float* sm) {
    const int TIDX = otid();
    const int tid = TIDX;
    {
        for (int i = tid; i < 2048; i += 256) sm[i] = siluf(p.c[i]);
        __syncthreads();
        const int wid = tid >> 6, lane = tid & 63;
        for (int w = wg; w < 192; w += nwg) {
            const int l = w / 96, cg = w % 96, col = cg * 64 + lane;
            const float* W = p.ada_w + (size_t)l * 1024 * 6144 + (size_t)(wid * 256) * 6144 + col;
            float a0 = 0.f, a1 = 0.f;
#pragma unroll 32
            for (int k = 0; k < 256; ++k) { const float wv = W[(size_t)k * 6144]; a0 += sm[wid * 256 + k] * wv; a1 += sm[1024 + wid * 256 + k] * wv; }
            sm[2048 + tid] = a0; sm[2304 + tid] = a1;
            __syncthreads();
            if (tid < 64) {
                const float bb = p.ada_b[l * 6144 + col];
                p.modv[(l * 2 + 0) * 6144 + col] = ((sm[2048 + tid] + sm[2048 + 64 + tid]) + (sm[2048 + 128 + tid] + sm[2048 + 192 + tid])) + bb;
                p.modv[(l * 2 + 1) * 6144 + col] = ((sm[2304 + tid] + sm[2304 + 64 + tid]) + (sm[2304 + 128 + tid] + sm[2304 + 192 + tid])) + bb;
            }
            __syncthreads();
        }
        __syncthreads();
    }
    for (int i = wg * 256 + tid; i < SEQ * 32; i += nwg * 256) {
        const int t = i >> 5, j = i & 31;
        const float inv = powf(10000.0f, -(float)(2 * j) / 64.0f);
        const float ang = (float)t * inv;
        p.ropec[i] = cosf(ang); p.ropes[i] = sinf(ang);
    }
    for (int i = wg * 256 + tid; i < 8 * 1024; i += nwg * 256) { const int h = i >> 10, d = i & 1023; p.blut[i] = p.rel[rel_bucket(d) * 8 + h]; }
}

#define RT_OFF 4096
template <int MODE>
__device__ __forceinline__ void st_norm(const P& p, int layer, int wg, int nwg, float* sm) {
    const int TIDX = otid();
    const int wid = TIDX >> 6, lane = TIDX & 63;
    int* rl_cnt = (int*)sm; int* rl_base = rl_cnt + 16; int* rl_ent = rl_cnt + 32; float* rl_lg = sm + 256;
    if (MODE == 1) {
        if (TIDX < 16) rl_cnt[TIDX] = 0;
        for (int i = TIDX; i < 64; i += 256) rl_ent[i] = -1;
#pragma unroll
        for (int pc = 0; pc < 16; ++pc) {
            const int col = 256 * wid + 4 * lane + (pc & 3);
            __builtin_amdgcn_global_load_lds((const unsigned*)(p.router_w + (size_t)col * 16 + 4 * (pc >> 2)),
                                             (__attribute__((address_space(3))) unsigned*)((__attribute__((address_space(3))) char*)sm + RT_OFF + (256 * pc + 64 * wid) * 16), 16, 0, 0);
        }
        asm volatile("s_waitcnt vmcnt(0)" ::: "memory");
        __syncthreads();
    }
    const int niter = (T_TOK + nwg * 4 - 1) / (nwg * 4);
    constexpr bool XB = (MODE != 0);
    const float* xin = p.x;
    const bf16_t* xinb = (MODE == 1) ? (layer ? p.xr3 : p.xr1) : (MODE == 2) ? p.xr1 : p.xr3;
    float4 pre4[4]; u32x2n pre2[4];
    {
        const int row0 = wg * 4 + wid;
#pragma unroll
        for (int i = 0; i < 4; ++i) {
            if (XB) pre2[i] = (row0 < T_TOK) ? *(const u32x2n*)(xinb + (size_t)row0 * DM + i * 256 + lane * 4) : (u32x2n){0u, 0u};
            else pre4[i] = (row0 < T_TOK) ? *(const float4*)(xin + (size_t)row0 * DM + i * 256 + lane * 4) : make_float4(0.f, 0.f, 0.f, 0.f);
        }
    }
    for (int it = 0; it < niter; ++it) {
        const int row = wg * 4 + wid + it * nwg * 4;
        if (MODE != 1 && row >= T_TOK) break;
        float v[16];
#pragma unroll
        for (int i = 0; i < 4; ++i) {
            if (XB) { v[i * 4 + 0] = __uint_as_float(pre2[i][0] << 16); v[i * 4 + 1] = __uint_as_float(pre2[i][0] & 0xffff0000u); v[i * 4 + 2] = __uint_as_float(pre2[i][1] << 16); v[i * 4 + 3] = __uint_as_float(pre2[i][1] & 0xffff0000u); }
            else { v[i * 4 + 0] = pre4[i].x; v[i * 4 + 1] = pre4[i].y; v[i * 4 + 2] = pre4[i].z; v[i * 4 + 3] = pre4[i].w; }
        }
        {
            const int rown = row + nwg * 4;
            if (rown < T_TOK) {
#pragma unroll
                for (int i = 0; i < 4; ++i) {
                    if (XB) pre2[i] = *(const u32x2n*)(xinb + (size_t)rown * DM + i * 256 + lane * 4);
                    else pre4[i] = *(const float4*)(xin + (size_t)rown * DM + i * 256 + lane * 4);
                }
            }
        }
        if (MODE != 1 || row < T_TOK) {
        const int b = row >> 13;
        if (MODE >= 2) {
            const int lp = (MODE == 2) ? layer - 1 : 1;
            const float* gf = p.modv + (size_t)(lp * 2 + b) * 6144 + 5 * 1024;
#pragma unroll
            for (int i = 0; i < 4; ++i)
#pragma unroll
                for (int j = 0; j < 4; ++j) {
                    const int col = i * 256 + lane * 4 + j;
                    const float y0 = bf2f(p.y[(size_t)(2 * row) * DM + col]), y1 = bf2f(p.y[(size_t)(2 * row + 1) * DM + col]);
                    v[i * 4 + j] += gf[col] * (y0 + y1);
                }
            if (MODE == 2) {
#pragma unroll
                for (int i = 0; i < 4; ++i) {
                    const u32x2n xo = {cvtpk(v[i * 4], v[i * 4 + 1]), cvtpk(v[i * 4 + 2], v[i * 4 + 3])};
                    *(u32x2n*)(p.xr2 + (size_t)row * DM + i * 256 + lane * 4) = xo;
#pragma unroll
                    for (int j = 0; j < 4; ++j) v[i * 4 + j] = __uint_as_float((j & 1) ? (xo[j >> 1] & 0xffff0000u) : (xo[j >> 1] << 16));
                }
            }
        }
        float ss = 0.f;
#pragma unroll
        for (int i = 0; i < 16; ++i) ss += v[i] * v[i];
        ss = wsum(ss);
        const float r = rsqrtf(ss * (1.0f / 1024.0f) + 1e-6f);
        if (MODE == 3) {
#pragma unroll
            for (int i = 0; i < 4; ++i) {
                const float4 g4 = *(const float4*)(p.final_norm + i * 256 + lane * 4);
                *(float4*)(p.out + (size_t)row * DM + i * 256 + lane * 4) =
                    make_float4(v[i * 4] * r * g4.x, v[i * 4 + 1] * r * g4.y, v[i * 4 + 2] * r * g4.z, v[i * 4 + 3] * r * g4.w);
            }
            continue;
        }
        const float* g = ((MODE == 1) ? p.norm_ffn : p.norm_mix) + layer * 1024;
        const float* mv = p.modv + (size_t)(layer * 2 + b) * 6144;
        const float* shift = mv + ((MODE == 1) ? 3 : 0) * 1024;
        const float* scale = mv + ((MODE == 1) ? 4 : 1) * 1024;
        float hv[16];
#pragma unroll
        for (int i = 0; i < 4; ++i)
#pragma unroll
            for (int j = 0; j < 4; ++j) {
                const int col = i * 256 + lane * 4 + j;
                hv[i * 4 + j] = v[i * 4 + j] * r * g[col] * (1.0f + scale[col]) + shift[col];
                p.h[(size_t)row * DM + col] = f2bf(hv[i * 4 + j]);
            }
        if (MODE == 1) {
            f32x2n lg2[8];
#pragma unroll
            for (int e = 0; e < 8; ++e) lg2[e] = (f32x2n){0.f, 0.f};
#pragma unroll
            for (int i = 0; i < 4; ++i)
#pragma unroll
                for (int j = 0; j < 4; ++j) {
                    const char* rw = (const char*)sm + RT_OFF + lane * 16 + j * 4096 + i * 1024;
#pragma unroll
                    for (int q = 0; q < 4; ++q) {
                        const f32x2n* w2 = (const f32x2n*)(rw + q * 16384);
                        const f32x2n hh2 = {hv[i * 4 + j], hv[i * 4 + j]};
                        lg2[2 * q] = hh2 * w2[0] + lg2[2 * q]; lg2[2 * q + 1] = hh2 * w2[1] + lg2[2 * q + 1];
                    }
                    asm volatile("" ::: "memory");
                }
            float lg[16];
#pragma unroll
            for (int e = 0; e < 8; ++e) { lg[2 * e] = lg2[e][0]; lg[2 * e + 1] = lg2[e][1]; }
            float r8[8], r4[4], r2[2], r1;
#pragma unroll
            for (int k = 0; k < 8; ++k) {
                float sa = lg[k], sb = lg[8 + k];
                asm("s_nop 1\n\tv_permlane32_swap_b32 %0, %1\n\ts_nop 0" : "+v"(sa), "+v"(sb));
                r8[k] = sa + sb;
            }
#pragma unroll
            for (int k = 0; k < 4; ++k) {
                float sa = r8[k], sb = r8[4 + k];
                asm("s_nop 1\n\tv_permlane16_swap_b32 %0, %1\n\ts_nop 0" : "+v"(sa), "+v"(sb));
                r4[k] = sa + sb;
            }
            { const bool hi = (lane & 8) != 0;
#pragma unroll
              for (int k = 0; k < 2; ++k) { const float keep = hi ? r4[2 + k] : r4[k], send = hi ? r4[k] : r4[2 + k];
                                            r2[k] = keep + __builtin_bit_cast(float, __builtin_amdgcn_update_dpp(0, __builtin_bit_cast(int, send), 0x128, 0xF, 0xF, true)); } }
            { const bool hi = (lane & 4) != 0; const float keep = hi ? r2[1] : r2[0], send = hi ? r2[0] : r2[1]; r1 = keep + __shfl_xor(send, 4); }
            r1 += __builtin_bit_cast(float, __builtin_amdgcn_update_dpp(0, __builtin_bit_cast(int, r1), 0x4E, 0xF, 0xF, true));
            r1 += __builtin_bit_cast(float, __builtin_amdgcn_update_dpp(0, __builtin_bit_cast(int, r1), 0xB1, 0xF, 0xF, true));
            int t32a = 0, k32 = 1, t16a = 0, k16 = 1;
            asm("s_nop 1\n\tv_permlane32_swap_b32 %0, %1\n\ts_nop 0" : "+v"(t32a), "+v"(k32));
            asm("s_nop 1\n\tv_permlane16_swap_b32 %0, %1\n\ts_nop 0" : "+v"(t16a), "+v"(k16));
            if ((lane & 3) == 0) rl_lg[((it & 7) * 4 + wid) * 16 + (k32 * 8 + k16 * 4 + ((lane >> 3) & 1) * 2 + ((lane >> 2) & 1))] = r1;
        }
        }
        if (MODE == 1 && ((it & 7) == 7 || it == niter - 1)) {
            __syncthreads();
            if (TIDX < 32) {
                const int its = (it & ~7) + (TIDX >> 2), row = wg * 4 + (TIDX & 3) + its * nwg * 4;
                if (its <= it && row < T_TOK) {
                    float lg[16];
#pragma unroll
                    for (int e = 0; e < 16; ++e) lg[e] = rl_lg[TIDX * 16 + e];
                    float aff[16], bi[16];
        #pragma unroll
                    for (int e = 0; e < 16; ++e) { aff[e] = 1.0f / (1.0f + expf(-lg[e])); bi[e] = aff[e] + p.router_b[e]; }
                    float bestsc = -3e38f; int be0 = 0, be1 = 1; float bw0 = 0.f, bw1 = 0.f;
        #pragma unroll
                    for (int gI = 0; gI < 4; ++gI) {
                        int i1 = 0; float m1 = bi[gI * 4];
        #pragma unroll
                        for (int i = 1; i < 4; ++i) if (bi[gI * 4 + i] > m1) { m1 = bi[gI * 4 + i]; i1 = i; }
                        int i2 = -1; float m2 = -3e38f;
        #pragma unroll
                        for (int i = 0; i < 4; ++i) if (i != i1 && bi[gI * 4 + i] > m2) { m2 = bi[gI * 4 + i]; i2 = i; }
                        const float sc = m1 + m2;
                        float a1 = 0.f, a2 = 0.f;
        #pragma unroll
                        for (int i = 0; i < 4; ++i) { a1 = (i == i1) ? aff[gI * 4 + i] : a1; a2 = (i == i2) ? aff[gI * 4 + i] : a2; }
                        if (sc > bestsc) { bestsc = sc; be0 = gI * 4 + i1; be1 = gI * 4 + i2; bw0 = a1; bw1 = a2; }
                    }
                    const float ws = bw0 + bw1;
                    p.tokw[row * 2] = bw0 / ws; p.tokw[row * 2 + 1] = bw1 / ws;
                    const int r0 = atomicAdd(&rl_cnt[be0], 1), r1 = atomicAdd(&rl_cnt[be1], 1);
                    rl_ent[TIDX * 2] = (row << 12) | (be0 << 8) | r0;
                    rl_ent[TIDX * 2 + 1] = (row << 12) | (be1 << 8) | r1;
                }
            }
            __syncthreads();
            if (TIDX < 16) { const int c = rl_cnt[TIDX]; rl_base[TIDX] = c ? atomicAdd(&p.cnt[(layer * 16 + TIDX) * 32], c) : 0; rl_cnt[TIDX] = 0; }
            __syncthreads();
            if (TIDX < 64) {
                const int en = rl_ent[TIDX];
                if (en >= 0) { const int e = (en >> 8) & 15; p.list[e * T_TOK + rl_base[e] + (en & 255)] = (en >> 12) * 2 + (TIDX & 1); rl_ent[TIDX] = -1; }
            }
            __syncthreads();
        }
    }
}

__device__ __forceinline__ void st_kmean(const P& p, int wg, int nwg, float* sm) {
    const int TIDX = otid();
    const int wid = TIDX >> 6, lane = TIDX & 63;
    for (int w = wg; w < 2 * 8 * 32; w += nwg) {
        const int b = w >> 8, h = (w >> 5) & 7, j = w & 31;
        const bf16_t* kp = p.proj + (size_t)(b * SEQ + j * 256 + wid * 64) * 2840 + 1816 + h * 64 + lane;
        float s = 0.f;
#pragma unroll 16
        for (int i = 0; i < 64; ++i) s += bf2f(kp[(size_t)i * 2840]);
        __syncthreads();
        sm[TIDX] = s;
        __syncthreads();
        if (TIDX < 64) {
            const float m = ((sm[TIDX] + sm[64 + TIDX]) + (sm[128 + TIDX] + sm[192 + TIDX])) * (1.0f / 256.0f);
            p.kmean[(size_t)w * 64 + TIDX] = m;
            p.kmeanb[(size_t)w * 64 + TIDX] = f2bf(m);
        }
    }
}
__device__ __forceinline__ void st_mla_prep(const P& p, int wg, int nwg) {
    const int TIDX = otid();
    const int wid = TIDX >> 6, lane = TIDX & 63;
    for (int row = wg * 4 + wid; row < T_TOK; row += nwg * 4) {
        const int t = row & (SEQ - 1);
        const bf16_t* pr = p.proj1 + (size_t)row * 1216;
        float q[4], ss = 0.f;
        float kvv[2]; const float x1 = bf2f(pr[384 + (lane & 31)]), x2 = bf2f(pr[384 + 32 + (lane & 31)]);
#pragma unroll
        for (int i = 0; i < 2; ++i) kvv[i] = bf2f(pr[256 + i * 64 + lane]);
#pragma unroll
        for (int i = 0; i < 4; ++i) { q[i] = bf2f(pr[i * 64 + lane]); ss += q[i] * q[i]; }
        ss = wsum(ss);
        float r = rsqrtf(ss * (1.0f / 256.0f) + 1e-6f);
#pragma unroll
        for (int i = 0; i < 4; ++i) p.cqn[(size_t)row * 384 + i * 64 + lane] = f2bf(q[i] * r * p.q_norm[i * 64 + lane]);
        ss = 0.f;
#pragma unroll
        for (int i = 0; i < 2; ++i) ss += kvv[i] * kvv[i];
        ss = wsum(ss);
        r = rsqrtf(ss * (1.0f / 128.0f) + 1e-6f);
#pragma unroll
        for (int i = 0; i < 2; ++i) p.cqn[(size_t)row * 384 + 256 + i * 64 + lane] = f2bf(kvv[i] * r * p.kv_norm[i * 64 + lane]);
        if (lane < 32) {
            const float cs = p.ropec[t * 32 + lane], sn = p.ropes[t * 32 + lane];
            p.krope[(size_t)row * 64 + lane] = f2bf(x1 * cs - x2 * sn);
            p.krope[(size_t)row * 64 + 32 + lane] = f2bf(x1 * sn + x2 * cs);
        }
    }
}


typedef short bf16x8 __attribute__((ext_vector_type(8)));
typedef float f32x4 __attribute__((ext_vector_type(4)));
typedef unsigned u32x2 __attribute__((ext_vector_type(2)));
typedef unsigned u32x4v __attribute__((ext_vector_type(4)));
#define LDSP __attribute__((address_space(3)))
#define GEMM_LDS_BYTES 81920
#define KERNEL_LDS_BYTES 81920
#define BAR_LDS_OFF (KERNEL_LDS_BYTES - 16)

__device__ __forceinline__ unsigned pack_bf16(float lo, float hi) { return cvtpk(lo, hi); }
struct Pair8 { bool lo_is_a; int cadj; };
__device__ __forceinline__ void plswap16(unsigned& a, unsigned& b) { asm("s_nop 1\n\tv_permlane16_swap_b32 %0, %1\n\ts_nop 0" : "+v"(a), "+v"(b)); }
__device__ __forceinline__ Pair8 pair8_init(int tid) {
    const unsigned lane = (unsigned)tid & 63u; unsigned ia = lane, ib = lane, ga = 0u, gb = 1u;
    plswap16(ia, ib); plswap16(ga, gb);
    const bool ownv = (ia == lane), odd = ((lane >> 4) & 1u) != 0u;
    Pair8 r; r.lo_is_a = (odd != ownv); r.cadj = (int)ga * 16 - (odd ? 4 : 0);
    return r;
}
__device__ __forceinline__ u32x4v pair8(const Pair8& P8, const f32x4 va, const f32x4 vb) {
    unsigned ax = pack_bf16(va[0], va[1]), ay = pack_bf16(va[2], va[3]), bx = pack_bf16(vb[0], vb[1]), by = pack_bf16(vb[2], vb[3]);
    plswap16(ax, bx); plswap16(ay, by);
    return P8.lo_is_a ? (u32x4v){ax, ay, bx, by} : (u32x4v){bx, by, ax, ay};
}

template <int MF, class AR, class BR, class Epi, class NX>
__device__ __forceinline__ void gemm128x(const int nk, const size_t akstep, const size_t bkstep, AR arow, BR brow, Epi epi, LDSP char* lds, const int tid, const bool staged, NX next) {
    constexpr int SS = MF * 4096 + 16384, BO = MF * 4096;
    const int wid = tid >> 6, lane = tid & 63, wr = wid >> 1, wc = wid & 1, fr = lane & 15, fq = lane >> 4;
    const int srow = tid >> 3, gch = ((tid & 7) ^ (srow & 7)) * 8;
    const bf16_t* ap[MF]; const bf16_t* bp[4];
#pragma unroll
    for (int i = 0; i < MF; ++i) ap[i] = arow(32 * i + srow) + gch;
#pragma unroll
    for (int i = 0; i < 4; ++i) bp[i] = brow(32 * i + srow) + gch;
    LDSP char* lw = lds + wid * 1024;
#define G128_ISSUE(st, kt) do { LDSP char* la_ = lw + (st) * SS; const size_t ao_ = (size_t)(kt) * akstep, bo_ = (size_t)(kt) * bkstep; \
        _Pragma("unroll") for (int i_ = 0; i_ < MF; ++i_) __builtin_amdgcn_global_load_lds((const unsigned*)(ap[i_] + ao_), (LDSP unsigned*)(la_ + 4096 * i_), 16, 0, 0); \
        _Pragma("unroll") for (int i_ = 0; i_ < 4; ++i_) __builtin_amdgcn_global_load_lds((const unsigned*)(bp[i_] + bo_), (LDSP unsigned*)(la_ + BO + 4096 * i_), 16, 0, 0); } while (0)
    f32x4 acc[MF][4];
#pragma unroll
    for (int m = 0; m < MF; ++m)
#pragma unroll
        for (int n = 0; n < 4; ++n) acc[m][n] = (f32x4){0.f, 0.f, 0.f, 0.f};
    const int aoff = (wr * 16 * MF + fr) * 128, boff = BO + (wc * 64 + fr) * 128, c0 = (fq ^ (fr & 7)) * 16;
    if (!staged) G128_ISSUE(0, 0);
    for (int kt = 0; kt < nk; ++kt) {
        const int cur = kt & 1;
        asm volatile("s_waitcnt vmcnt(0)" ::: "memory");
        __builtin_amdgcn_s_barrier();
        asm volatile("" ::: "memory");
        LDSP char* sb = lds + cur * SS;
        constexpr int NG = 2 * MF, PD = 4;
        bf16x8 af[NG], bf[2][4];
#define G128_AF(s_) (*(const LDSP bf16x8*)(sb + aoff + ((s_) % MF) * 2048 + (((s_) / MF) ? (c0 ^ 64) : c0)))
#pragma unroll
        for (int n = 0; n < 4; ++n) bf[0][n] = *(const LDSP bf16x8*)(sb + boff + n * 2048 + c0);
#pragma unroll
        for (int s = 0; s < PD; ++s) af[s] = G128_AF(s);
        __builtin_amdgcn_sched_barrier(0);
        const bool pf_ = kt + 1 < nk;
        LDSP char* la_ = lw + (cur ^ 1) * SS;
        const size_t ao_ = (size_t)(kt + 1) * akstep, bo_ = (size_t)(kt + 1) * bkstep;
#pragma unroll
        for (int s = 0; s < NG; ++s) {
            if (s < MF) { if (pf_) __builtin_amdgcn_global_load_lds((const unsigned*)(ap[s] + ao_), (LDSP unsigned*)(la_ + 4096 * s), 16, 0, 0); }
            else if (s < MF + 4) { if (pf_) __builtin_amdgcn_global_load_lds((const unsigned*)(bp[s - MF] + bo_), (LDSP unsigned*)(la_ + BO + 4096 * (s - MF)), 16, 0, 0); }
            if (s + PD < NG) af[s + PD] = G128_AF(s + PD);
            if (s == MF - PD) {
#pragma unroll
                for (int n = 0; n < 4; ++n) bf[1][n] = *(const LDSP bf16x8*)(sb + boff + n * 2048 + (c0 ^ 64));
            }
#pragma unroll
            for (int n = 0; n < 4; ++n) acc[s % MF][n] = __builtin_amdgcn_mfma_f32_16x16x32_bf16(bf[s / MF][n], af[s], acc[s % MF][n], 0, 0, 0);
            __builtin_amdgcn_sched_barrier(0);
        }
#undef G128_AF
    }
    asm volatile("s_waitcnt lgkmcnt(0)" ::: "memory");
    __builtin_amdgcn_s_barrier();
    asm volatile("" ::: "memory");
    next();
#undef G128_ISSUE
#pragma unroll
    for (int m = 0; m < MF; ++m) epi(wr * 16 * MF + m * 16 + fr, wc * 64 + fq * 4, acc[m], m);
}

template <int MF, class AR, class BR>
__device__ __forceinline__ void g128_stage0(AR arow, BR brow, LDSP char* lds, const int tid) {
    const int wid = tid >> 6, srow = tid >> 3, gch = ((tid & 7) ^ (srow & 7)) * 8;
    LDSP char* lw = lds + wid * 1024;
#pragma unroll
    for (int i = 0; i < MF; ++i) {
        __builtin_amdgcn_global_load_lds((const unsigned*)(arow(32 * i + srow) + gch), (LDSP unsigned*)(lw + 4096 * i), 16, 0, 0);
    }
#pragma unroll
    for (int i = 0; i < 4; ++i) {
        __builtin_amdgcn_global_load_lds((const unsigned*)(brow(32 * i + srow) + gch), (LDSP unsigned*)(lw + MF * 4096 + 4096 * i), 16, 0, 0);
    }
}
template <class AR, class BR, class Epi>
__device__ __forceinline__ void gemm128(const int nk, const size_t akstep, const size_t bkstep, AR arow, BR brow, Epi epi, LDSP char* lds, const int tid) {
    gemm128x<4>(nk, akstep, bkstep, arow, brow, epi, lds, tid, false, [] {});
}

template <int MAP> __device__ __forceinline__ int conv_rowmap(int n) {
    if (MAP == 0) return n;
    const int tile = n >> 6, cc = n & 63, wc = cc >> 5, i16 = (cc >> 4) & 1, i = cc & 15;
    return tile * 128 + wc * 64 + ((MAP == 1 ? 0 : 2) + i16) * 16 + i;
}
template <int MAP, bool NT = false>
__device__ __forceinline__ void conv_batched(const float* src, int nmat, int K, int N, size_t sstride, bf16_t* dst, size_t dstride, int wg, int nwg, float* sm, int tid, int wend = 0x7fffffff) {
    float(*t)[65] = (float(*)[65])sm;
    const int tk = K >> 6, tn = (N + 63) >> 6, per = tk * tn, total = (nmat * per < wend) ? nmat * per : wend;
    f32x4 v[4];
    auto ld = [&](int w) {
        const int mat = w / per, r = w % per, kt = r / tn, nt = r % tn;
        const float* s = src + (size_t)mat * sstride;
#pragma unroll
        for (int i = 0; i < 4; ++i) {
            const int idx = tid + 256 * i, k = idx >> 4, n = (idx & 15) * 4;
            v[i] = (f32x4){0.f, 0.f, 0.f, 0.f};
            if (nt * 64 + n < N) v[i] = NT ? __builtin_nontemporal_load((const f32x4*)(s + (size_t)(kt * 64 + k) * N + nt * 64 + n)) : *(const f32x4*)(s + (size_t)(kt * 64 + k) * N + nt * 64 + n);
        }
    };
    if (wg < total) ld(wg);
    for (int w = wg; w < total; w += nwg) {
        const int mat = w / per, r = w % per, kt = r / tn, nt = r % tn;
        bf16_t* d = dst + (size_t)mat * dstride;
#pragma unroll
        for (int i = 0; i < 4; ++i) {
            const int idx = tid + 256 * i, k = idx >> 4, n = (idx & 15) * 4;
            t[k][n] = v[i][0]; t[k][n + 1] = v[i][1]; t[k][n + 2] = v[i][2]; t[k][n + 3] = v[i][3];
        }
        __syncthreads();
        if (w + nwg < total) ld(w + nwg);
        {
            const int n = tid >> 2, kq = (tid & 3) * 16;
            if (nt * 64 + n < N) {
                unsigned pk[8];
#pragma unroll
                for (int j = 0; j < 8; ++j) pk[j] = cvtpk(t[kq + 2 * j][n], t[kq + 2 * j + 1][n]);
                bf16_t* o = d + (size_t)conv_rowmap<MAP>(nt * 64 + n) * K + kt * 64 + kq;
                *(u32x4v*)o = (u32x4v){pk[0], pk[1], pk[2], pk[3]};
                *(u32x4v*)(o + 8) = (u32x4v){pk[4], pk[5], pk[6], pk[7]};
            }
        }
        __syncthreads();
    }
}
__device__ __forceinline__ void st_convert(const P& p, int wg, int nwg, float* sm) {
    const int tid = otid();
    conv_batched<0>(p.ev_w_in, 1, 1024, 2840, 0, p.wt_in0, 0, wg, nwg, sm, tid);
    conv_batched<0>(p.ev_w_out, 1, 1024, 1024, 0, p.wt_out0, 0, wg, nwg, sm, tid);
    conv_batched<0>(p.ck_w1, 1, 2048, 256, 0, p.wt_c1, 0, wg, nwg, sm, tid);
    conv_batched<0>(p.cv_w1, 1, 2048, 256, 0, p.wt_c1 + 256 * 2048, 0, wg, nwg, sm, tid);
    conv_batched<0>(p.ck_w2, 1, 256, 64, 0, p.wt_c2, 0, wg, nwg, sm, tid);
    conv_batched<0>(p.cv_w2, 1, 256, 64, 0, p.wt_c2 + 64 * 256, 0, wg, nwg, sm, tid);
    conv_batched<0>(p.od_w_in, 1, 1024, 1216, 0, p.wt_in1, 0, wg, nwg, sm, tid);
    conv_batched<0>(p.od_w_out, 1, 1024, 1024, 0, p.wt_out1, 0, wg, nwg, sm, tid);
    conv_batched<0>(p.w_q_up, 1, 256, 768, 0, p.wt_qup, 0, wg, nwg, sm, tid);
    conv_batched<0>(p.w_kv_up, 1, 128, 1024, 0, p.wt_kvup, 0, wg, nwg, sm, tid);
    {
        const int wid = tid >> 6, lane = tid & 63;
        for (int w = wg * 4 + wid; w < 512; w += nwg * 4) {
            const int which = w >> 8, cg = (w >> 6) & 3, ks = w & 63, col = cg * 64 + lane;
            const float* w1 = (which ? p.cv_w1 : p.ck_w1) + (size_t)(ks * 32) * 256 + col; const float* pos = (which ? p.pos_v : p.pos_k) + ks * 32;
            float a = 0.f;
#pragma unroll
            for (int k = 0; k < 32; ++k) a += pos[k] * w1[(size_t)k * 256];
            p.c1p[(which * 64 + ks) * 256 + col] = a;
        }
    }
}
__device__ __forceinline__ void st_c1_reduce(const P& p, int wg, int nwg) {
    const int tid = otid();
    for (int i = wg * 256 + tid; i < 512; i += nwg * 256) {
        const int which = i >> 8, col = i & 255;
        float a = 0.f;
#pragma unroll 16
        for (int ks = 0; ks < 64; ++ks) a += p.c1p[(which * 64 + ks) * 256 + col];
        p.c1[i] = a;
    }
}


struct XcdOrder {
    int xcd, lw, nlw, tn, per;
    __device__ __forceinline__ XcdOrder(int wg, int nwg, int nM, int tn_) : xcd(wg & 7), lw(wg >> 3), nlw(nwg >> 3), tn(tn_), per((nM >> 3) * tn_) {}
    __device__ __forceinline__ bool get(int k, int& mt, int& nt) const { const int lt = lw + k * nlw; if (lt >= per) return false; mt = xcd + 8 * (lt / tn); nt = lt % tn; return true; }
};
template <int MF>
__device__ __forceinline__ void st_inproj0_mf(const P& p, int wg, int nwg, LDSP char* lds) {
    const int tid = otid();
    const Pair8 P8 = pair8_init(tid);
    const XcdOrder ord(wg, nwg, ((T_TOK + 32 * MF - 1) / (32 * MF) + 7) & ~7, 23);
    auto Af = [&](int mt_) { return [=](int r) { int row = mt_ * (32 * MF) + r; row = row < T_TOK ? row : T_TOK - 1; return p.h + (size_t)row * DM; }; };
    auto Bf = [&](int nt_) { return [=](int r) { int n = nt_ * 128 + r; n = n < 2840 ? n : 2839; return p.wt_in0 + (size_t)n * 1024; }; };
    bool staged = false;
    for (int k = 0;; ++k) {
        int mt, nt, mt2 = 0, nt2 = 0;
        if (!ord.get(k, mt, nt)) break;
        if (mt * (32 * MF) >= T_TOK) break;
        const bool has2 = ord.get(k + 1, mt2, nt2) && mt2 * (32 * MF) < T_TOK;
        const bool st_ = staged; staged = has2;
        gemm128x<MF>(16, 64, 64, Af(mt), Bf(nt),
            [&](int rl, int cl, const f32x4 (&a)[4], int mfrag) {
                const int row = mt * (32 * MF) + rl;
#pragma unroll
                for (int n = 0; n < 4; n += 2) {
                    const u32x4v w8 = pair8(P8, a[n], a[n + 1]);
                    const int col8 = nt * 128 + cl + n * 16 + P8.cadj;
                    if (col8 < 2840 && row < T_TOK) *(u32x4v*)(p.proj + (size_t)row * 2840 + col8) = w8;
                }
#pragma unroll
                for (int n = 0; n < 4; ++n) {
                    const int col = nt * 128 + cl + n * 16;
                    if (col >= 1280 && col < 1304 && row < T_TOK)
                        *(f32x4*)(p.gates + (size_t)row * 24 + (col - 1280)) = (f32x4){sigmf(a[n][0]), sigmf(a[n][1]), sigmf(a[n][2]), sigmf(a[n][3])};
                }
            }, lds, tid, st_, [&] { if (has2) g128_stage0<MF>(Af(mt2), Bf(nt2), lds, tid); });
    }
}
__device__ __forceinline__ void st_cmp1_mf(const P& p, int wg, int nwg, LDSP char* lds) {
    const int tid = otid();
    for (int w = wg; w < 2 * 16 * 2; w += nwg) {
        const int which = w >> 5, mt = (w >> 1) & 15, nt = w & 1;
        const int colbase = which ? 640 : 512;
        gemm128(32, 2840, 64,
            [&](int r) { int m = mt * 128 + r; m = m < 2044 ? m : 2043; const int bk = m / 511, n = m % 511, b = bk >> 1, kv = bk & 1;
                         return p.proj + (size_t)(b * SEQ + 16 * n) * 2840 + colbase + kv * 64; },
            [&](int r) { return p.wt_c1 + (size_t)(which * 256 + nt * 128 + r) * 2048; },
            [&](int rl, int cl, const f32x4 (&a)[4], int mfrag) {
                const int m = mt * 128 + rl;
                if (m < 2044) {
#pragma unroll
                    for (int n = 0; n < 4; ++n) {
                        const int col = nt * 128 + cl + n * 16;
                        const f32x4 cb = *(const f32x4*)(p.c1 + which * 256 + col);
                        *(u32x2*)(p.chidb + (size_t)(which * 2048 + m) * 256 + col) =
                            (u32x2){pack_bf16(gelu_tanh(a[n][0] + cb[0]), gelu_tanh(a[n][1] + cb[1])), pack_bf16(gelu_tanh(a[n][2] + cb[2]), gelu_tanh(a[n][3] + cb[3]))};
                    }
                }
            }, lds, tid);
    }
}
__device__ __forceinline__ void st_cmp2_mf(const P& p, int wg, int nwg, LDSP char* lds) {
    const int tid = otid();
    for (int w = wg; w < 2 * 16; w += nwg) {
        const int which = w >> 4, mt = w & 15;
        gemm128(4, 64, 64,
            [&](int r) { int m = mt * 128 + r; m = m < 2044 ? m : 2043; return p.chidb + (size_t)(which * 2048 + m) * 256; },
            [&](int r) { return p.wt_c2 + (size_t)(which * 64 + (r & 63)) * 256; },
            [&](int rl, int cl, const f32x4 (&a)[4], int mfrag) {
                const int m = mt * 128 + rl;
                if (m < 2044) {
#pragma unroll
                    for (int n = 0; n < 4; ++n) { const int col = cl + n * 16; if (col < 64) {
                        const int bk = m / 511, nn = m % 511;
                        *(u32x2*)(p.kcmpb + ((size_t)((which * 4 + bk) * 512 + nn)) * 64 + col) = (u32x2){cvtpk(a[n][0], a[n][1]), cvtpk(a[n][2], a[n][3])}; } }
                }
            }, lds, tid);
    }
}
template <int MF>
__device__ __forceinline__ void st_outproj_mf(const P& p, int layer, int wg, int nwg, LDSP char* lds) {
    const int tid = otid();
    const Pair8 P8 = pair8_init(tid);
    const bf16_t* W = layer ? p.wt_out1 : p.wt_out0;
    bf16_t* xout = layer ? p.xr3 : p.xr1;
    const XcdOrder ord(wg, nwg, ((T_TOK + 32 * MF - 1) / (32 * MF) + 7) & ~7, 8);
    auto Af = [&](int mt_) { return [=](int r) { int row = mt_ * (32 * MF) + r; row = row < T_TOK ? row : T_TOK - 1; return p.o + (size_t)row * DM; }; };
    auto Bf = [&](int nt_) { return [=](int r) { return W + (size_t)(nt_ * 128 + r) * 1024; }; };
    bool staged = false;
    for (int k = 0;; ++k) {
        int mt, nt, mt2 = 0, nt2 = 0;
        if (!ord.get(k, mt, nt)) break;
        if (mt * (32 * MF) >= T_TOK) break;
        const bool has2 = ord.get(k + 1, mt2, nt2) && mt2 * (32 * MF) < T_TOK;
        const bool st_ = staged; staged = has2;
        gemm128x<MF>(16, 64, 64, Af(mt), Bf(nt),
            [&](int rl, int cl, const f32x4 (&a)[4], int mfrag) {
                const int row = mt * (32 * MF) + rl, b = row >> 13;
                const float* g = p.modv + (size_t)(layer * 2 + (b & 1)) * 6144 + 2 * 1024;
                const int rowc = row < T_TOK ? row : T_TOK - 1;
                f32x4 r4[4];
#pragma unroll
                for (int n = 0; n < 4; ++n) {
                    const int col = nt * 128 + cl + n * 16;
                    const f32x4 gv = *(const f32x4*)(g + col);
                    f32x4 xv;
                    if (layer) { const u32x2 xb = *(const u32x2*)(p.xr2 + (size_t)rowc * DM + col);
                                 xv = (f32x4){__uint_as_float(xb[0] << 16), __uint_as_float(xb[0] & 0xffff0000u), __uint_as_float(xb[1] << 16), __uint_as_float(xb[1] & 0xffff0000u)}; }
                    else xv = *(const f32x4*)(p.x + (size_t)rowc * DM + col);
                    r4[n] = xv + gv * a[n];
                }
#pragma unroll
                for (int n = 0; n < 4; n += 2) {
                    const u32x4v w8 = pair8(P8, r4[n], r4[n + 1]);
                    if (row < T_TOK) *(u32x4v*)(xout + (size_t)row * DM + nt * 128 + cl + n * 16 + P8.cadj) = w8;
                }
            }, lds, tid, st_, [&] { if (has2) g128_stage0<MF>(Af(mt2), Bf(nt2), lds, tid); });
    }
}
template <int BM>
__device__ __forceinline__ bool moe_tile128(const int* cnt, int tt, int& e, int& i0, int& off) {
    int acc = 0, o = 0;
    for (int q = 0; q < 16; ++q) {
        const int c = cnt[q * 32], nt = (c + BM - 1) / BM;
        if (tt < acc + nt) { e = q; i0 = (tt - acc) * BM; off = o; return true; }
        acc += nt; o += c;
    }
    return false;
}
struct MoeTile { int e, i0, off, nt, ce; bool ok; };
template <int BM>
__device__ __forceinline__ MoeTile moe_get(const int* cnt, int wg, int nwg, int k) {
    int mtot = 0;
    for (int q = 0; q < 16; ++q) mtot += (cnt[q * 32] + BM - 1) / BM;
    const int per = (mtot + 7) >> 3, lt = (wg >> 3) + k * (nwg >> 3), lm = lt >> 3;
    MoeTile t; t.nt = lt & 7; t.e = 0; t.i0 = 0; t.off = 0;
    t.ok = (lm < per) && moe_tile128<BM>(cnt, (wg & 7) * per + lm, t.e, t.i0, t.off);
    t.ce = t.ok ? cnt[t.e * 32] : 0; return t;
}
template <int MF>
__device__ __forceinline__ void st_moe_up_mf(const P& p, int layer, int wg, int nwg, LDSP char* lds) {
    const int tid = otid();
    const Pair8 P8 = pair8_init(tid);
    const int* cnt = p.cnt + layer * 512;
    auto Af = [&](const MoeTile& t) { const int* lst = p.list + t.e * T_TOK; const int i0 = t.i0, ce = t.ce;
                                      return [=](int r) { const int i = (i0 + r < ce) ? i0 + r : i0; return p.h + (size_t)(lst[i] >> 1) * DM; }; };
    auto Bf = [&](const MoeTile& t) { const bf16_t* B = p.wt_gu + ((size_t)(layer * 16 + t.e) * 1024 + t.nt * 128) * 1024; return [=](int r) { return B + (size_t)r * 1024; }; };
    MoeTile cur = moe_get<32 * MF>(cnt, wg, nwg, 0);
    bool staged = false;
    for (int k = 0; cur.ok; ++k) {
        const MoeTile nx = moe_get<32 * MF>(cnt, wg, nwg, k + 1);
        const bool st_ = staged; staged = nx.ok;
        const int i0 = cur.i0, ce = cur.ce, off = cur.off, nt = cur.nt;
        gemm128x<MF>(16, 64, 64, Af(cur), Bf(cur),
            [&](int rl, int cl, const f32x4 (&a)[4], int mfrag) {
                const int wc = cl >> 6, fq4 = cl & 63;
                f32x4 hv2[2];
#pragma unroll
                for (int n = 0; n < 2; ++n) { const f32x4 g = a[n], u = a[n + 2]; hv2[n] = (f32x4){siluf(g[0]) * u[0], siluf(g[1]) * u[1], siluf(g[2]) * u[2], siluf(g[3]) * u[3]}; }
                const u32x4v w8 = pair8(P8, hv2[0], hv2[1]);
                if (i0 + rl < ce) *(u32x4v*)(p.hid + (size_t)(off + i0 + rl) * 512 + nt * 64 + wc * 32 + fq4 + P8.cadj) = w8;
            }, lds, tid, st_, [&] { if (nx.ok) g128_stage0<MF>(Af(nx), Bf(nx), lds, tid); });
        cur = nx;
    }
}
template <int MF>
__device__ __forceinline__ void st_moe_down_mf(const P& p, int layer, int wg, int nwg, LDSP char* lds) {
    const int tid = otid();
    const Pair8 P8 = pair8_init(tid);
    const int* cnt = p.cnt + layer * 512;
    auto Af = [&](const MoeTile& t) { const int i0 = t.i0, ce = t.ce, off = t.off; return [=](int r) { const int i = (i0 + r < ce) ? i0 + r : i0; return p.hid + (size_t)(off + i) * 512; }; };
    auto Bf = [&](const MoeTile& t) { const bf16_t* B = p.wt_d + ((size_t)(layer * 16 + t.e) * 1024 + t.nt * 128) * 512; return [=](int r) { return B + (size_t)r * 512; }; };
    MoeTile cur = moe_get<32 * MF>(cnt, wg, nwg, 0);
    bool staged = false;
    for (int k = 0; cur.ok; ++k) {
        const MoeTile nx = moe_get<32 * MF>(cnt, wg, nwg, k + 1);
        const bool st_ = staged; staged = nx.ok;
        const int i0 = cur.i0, ce = cur.ce, nt = cur.nt;
        const int* lst = p.list + cur.e * T_TOK;
        int ids[MF]; float wts[MF];
#pragma unroll
        for (int m = 0; m < MF; ++m) { const int rl = ((tid >> 7) & 1) * (16 * MF) + m * 16 + (tid & 15); ids[m] = (i0 + rl < ce) ? lst[i0 + rl] : -1; }
#pragma unroll
        for (int m = 0; m < MF; ++m) wts[m] = ids[m] >= 0 ? p.tokw[ids[m]] : 0.f;
        gemm128x<MF>(8, 64, 64, Af(cur), Bf(cur),
            [&](int rl, int cl, const f32x4 (&a)[4], int mfrag) {
                const int id = ids[mfrag]; const float wt = wts[mfrag];
#pragma unroll
                for (int n = 0; n < 4; n += 2) {
                    const u32x4v w8 = pair8(P8, a[n] * wt, a[n + 1] * wt);
                    if (i0 + rl < ce) *(u32x4v*)(p.y + (size_t)id * DM + nt * 128 + cl + n * 16 + P8.cadj) = w8;
                }
            }, lds, tid, st_, [&] { if (nx.ok) g128_stage0<MF>(Af(nx), Bf(nx), lds, tid); });
        cur = nx;
    }
}
template <int MF>
__device__ __forceinline__ void st_inproj1_mf(const P& p, int wg, int nwg, LDSP char* lds) {
    const int tid = otid();
    const Pair8 P8 = pair8_init(tid);
    const XcdOrder ord(wg, nwg, ((T_TOK + 32 * MF - 1) / (32 * MF) + 7) & ~7, 10);
    auto Af = [&](int mt_) { return [=](int r) { int row = mt_ * (32 * MF) + r; row = row < T_TOK ? row : T_TOK - 1; return p.h + (size_t)row * DM; }; };
    auto Bf = [&](int nt_) { return [=](int r) { int n = nt_ * 128 + r; n = n < 1216 ? n : 1215; return p.wt_in1 + (size_t)n * 1024; }; };
    bool staged = false;
    for (int k = 0;; ++k) {
        int mt, nt, mt2 = 0, nt2 = 0;
        if (!ord.get(k, mt, nt)) break;
        if (mt * (32 * MF) >= T_TOK) break;
        const bool has2 = ord.get(k + 1, mt2, nt2) && mt2 * (32 * MF) < T_TOK;
        const bool st_ = staged; staged = has2;
        gemm128x<MF>(16, 64, 64, Af(mt), Bf(nt),
            [&](int rl, int cl, const f32x4 (&a)[4], int mfrag) {
                const int row = mt * (32 * MF) + rl;
#pragma unroll
                for (int n = 0; n < 4; n += 2) {
                    const u32x4v w8 = pair8(P8, a[n], a[n + 1]);
                    const int col8 = nt * 128 + cl + n * 16 + P8.cadj;
                    if (col8 < 1216 && row < T_TOK) *(u32x4v*)(p.proj1 + (size_t)row * 1216 + col8) = w8;
                }
            }, lds, tid, st_, [&] { if (has2) g128_stage0<MF>(Af(mt2), Bf(nt2), lds, tid); });
    }
}
__device__ __forceinline__ void st_mla_up_mf(const P& p, int wg, int nwg, LDSP char* lds) {
    const int tid = otid();
    const Pair8 P8 = pair8_init(tid);
    const XcdOrder ord(wg, nwg, 128, 14);
    for (int k = 0;; ++k) {
        int mt, c;
        if (!ord.get(k, mt, c)) break;
        if (c < 6) {
            gemm128(4, 64, 64,
                [&](int r) { return p.cqn + (size_t)(mt * 128 + r) * 384; },
                [&](int r) { return p.wt_qup + (size_t)(c * 128 + r) * 256; },
                [&](int rl, int cl, const f32x4 (&a)[4], int mfrag) {
                    const int row = mt * 128 + rl, wc = cl >> 6;
                    f32x4 v[4] = {a[0], a[1], a[2], a[3]};
                    if (((c == 1 || c == 4) && wc == 0) || ((c == 2 || c == 5) && wc == 1)) {
                        const int t = row & (SEQ - 1), i0 = cl & 63;
#pragma unroll
                        for (int n = 0; n < 2; ++n) {
                            const f32x4 cs = *(const f32x4*)(p.ropec + t * 32 + n * 16 + i0), sn = *(const f32x4*)(p.ropes + t * 32 + n * 16 + i0);
                            v[n] = a[n] * cs - a[n + 2] * sn; v[n + 2] = a[n] * sn + a[n + 2] * cs;
                        }
                    }
#pragma unroll
                    for (int n = 0; n < 4; n += 2) *(u32x4v*)(p.qmla + (size_t)row * 768 + c * 128 + cl + n * 16 + P8.cadj) = pair8(P8, v[n], v[n + 1]);
                }, lds, tid);
        } else {
            gemm128(2, 64, 64,
                [&](int r) { return p.cqn + (size_t)(mt * 128 + r) * 384 + 256; },
                [&](int r) { return p.wt_kvup + (size_t)((c - 6) * 128 + r) * 128; },
                [&](int rl, int cl, const f32x4 (&a)[4], int mfrag) {
                    const int row = mt * 128 + rl;
#pragma unroll
                    for (int n = 0; n < 4; n += 2) *(u32x4v*)(p.kvmla + (size_t)row * 1024 + (c - 6) * 128 + cl + n * 16 + P8.cadj) = pair8(P8, a[n], a[n + 1]);
                }, lds, tid);
        }
    }
}

typedef float f32x16 __attribute__((ext_vector_type(16)));
typedef short s16x4 __attribute__((ext_vector_type(4)));
#define ATT_NEG (-1e30f)
#define ATT_SHIFT (-16.0f)
#define LOG2E 1.4426950408889634f

__device__ __forceinline__ int swz128(int row) { return (((row >> 1) & 1) << 2) | ((row >> 2) & 3); }
__device__ __forceinline__ int swz256(int row) { return ((row & 3) << 2) | ((row >> 2) & 3); }

struct AttLane {
    int kbase;
    int v0[2];
};
template <int KROWB, int VROWB, int DT>
__device__ __forceinline__ void att_lane_init(AttLane& L, int lane) {
    const int q = lane & 31, hh = lane >> 5, x = hh ^ swz128(q);
    L.kbase = q * KROWB + x * 16;
    const int rl = 4 * hh + ((lane & 15) >> 2), blk = (lane >> 4) & 1, pp = lane & 3;
#pragma unroll
    for (int t = 0; t < 2; ++t) {
        const int g = (VROWB == 256) ? (((rl & 3) << 2) | ((2 * t + hh) & 3)) : ((((rl >> 1) & 1) << 2) | ((2 * t + hh) & 3));
        L.v0[t] = rl * VROWB + (((2 * blk + (pp >> 1)) ^ g) * 16) + 8 * (pp & 1);
    }
}
template <int KS, int KROWB, int MODE, bool WANT_P, bool IMP>
__device__ __forceinline__ void att_qk(LDSP const char* kb, const AttLane& L, const bf16x8 (&qf)[KS], bf16x8 (&pf)[4], float& lsum, const float c1, const float cadd,
                                       const unsigned lutv, const int dq16, LDSP float* improw, const float invl) {
    float la = 0.f, lb = 0.f, lc = 0.f, ld = 0.f;
#pragma unroll
    for (int kt = 0; kt < 2; ++kt) {
        f32x16 s;
#pragma unroll
        for (int r = 0; r < 16; ++r) s[r] = 0.f;
        constexpr int KG = (KS > 4) ? 2 : 4;
#pragma unroll
        for (int k4 = 0; k4 < KS; k4 += KG) {
            bf16x8 a[KG];
#pragma unroll
            for (int j = 0; j < KG; ++j) { const int ks = k4 + j; a[j] = *(const LDSP bf16x8*)(kb + (L.kbase ^ (32 * (ks & 3))) + (ks >> 2) * 128 + kt * 32 * KROWB); }
#pragma unroll
            for (int j = 0; j < KG; ++j) s = __builtin_amdgcn_mfma_f32_32x32x16_bf16(a[j], qf[k4 + j], s, 0, 0, 0);
            asm volatile("" ::: "memory");
        }
        float pr[16];
#pragma unroll
        for (int r = 0; r < 16; ++r) {
            const int koff = 32 * kt + (r & 3) + 8 * (r >> 2);
            float add = cadd;
            if (MODE == 1) add = *(const LDSP float*)(lutv + (63 - koff) * 4);
            if (MODE == 2) { int d = dq16 - 16 * koff; d = d < -1 ? -1 : d; d = d > 1087 ? 1087 : d; add = *(const LDSP float*)(lutv + (unsigned)(64 + d) * 4u); }
            pr[r] = __builtin_amdgcn_exp2f(__builtin_fmaf(s[r], c1, add));
        }
#pragma unroll
        for (int r = 0; r < 16; r += 4) { la += pr[r]; lb += pr[r + 1]; lc += pr[r + 2]; ld += pr[r + 3]; }
        if (IMP) {
#pragma unroll
            for (int g = 0; g < 4; ++g) {
                (void)__hip_atomic_fetch_add((LDSP unsigned*)improw + 8 * kt + 2 * g, (unsigned)(((pr[4 * g] + pr[4 * g + 1]) + (pr[4 * g + 2] + pr[4 * g + 3])) * invl + 0.5f), __ATOMIC_RELAXED, __HIP_MEMORY_SCOPE_WORKGROUP);
                (void)__hip_atomic_fetch_add((LDSP unsigned*)improw + 8 * kt + 2 * g + 1, (unsigned)(pr[4 * g + 3] * invl + 0.5f), __ATOMIC_RELAXED, __HIP_MEMORY_SCOPE_WORKGROUP);
            }
        }
        if (WANT_P) {
#pragma unroll
            for (int sI = 0; sI < 2; ++sI) {
                union { unsigned u[4]; bf16x8 v; } cv;
#pragma unroll
                for (int i = 0; i < 4; ++i) cv.u[i] = cvtpk_valu(pr[8 * sI + 2 * i], pr[8 * sI + 2 * i + 1]);
                pf[kt * 2 + sI] = cv.v;
            }
        }
    }
    lsum += (la + lb) + (lc + ld);
}
template <int DT, int VROWB>
__device__ __forceinline__ void att_pv(LDSP const char* vb, const AttLane& L, const bf16x8 (&pf)[4], f32x16 (&o)[DT]) {
    const unsigned vba = (unsigned)(size_t)vb;
#pragma unroll
    for (int ks2 = 0; ks2 < 4; ++ks2) {
#pragma unroll
        for (int d0 = 0; d0 < DT; d0 += 2) {
            s16x4 lo[2], hi[2];
#pragma unroll
            for (int j = 0; j < 2; ++j) {
                asm volatile("ds_read_b64_tr_b16 %0, %1 offset:%2" : "=v"(lo[j]) : "v"(vba + (L.v0[0] ^ ((d0 + j) << 6))), "i"((16 * ks2) * VROWB) : "memory");
                asm volatile("ds_read_b64_tr_b16 %0, %1 offset:%2" : "=v"(hi[j]) : "v"(vba + (L.v0[1] ^ ((d0 + j) << 6))), "i"((16 * ks2 + 8) * VROWB) : "memory");
            }
            asm volatile("s_waitcnt lgkmcnt(0)" ::: "memory");
#pragma unroll
            for (int j = 0; j < 2; ++j) {
                asm volatile("" : "+v"(lo[j]), "+v"(hi[j]));
                const bf16x8 vf = __builtin_shufflevector(lo[j], hi[j], 0, 1, 2, 3, 4, 5, 6, 7);
                o[d0 + j] = __builtin_amdgcn_mfma_f32_32x32x16_bf16(vf, pf[ks2], o[d0 + j], 0, 0, 0);
            }
        }
    }
}
template <int CPR>
__device__ __forceinline__ void att_stage_map(int (&rowc)[(CPR == 24) ? 6 : 1], int tid) {
    if (CPR == 24) {
#pragma unroll
        for (int i = 0; i < 6; ++i) {
            const int c = tid + 256 * i, row = c / 24, cc = c % 24;
            rowc[i % ((CPR == 24) ? 6 : 1)] = (row << 8) | ((cc & ~7) | ((cc & 7) ^ swz128(row)));
        }
    } else if (CPR == 16) {
        const int row = tid >> 4; rowc[0] = (row << 8) | ((tid & 15) ^ swz256(row));
    } else {
        const int row = tid >> 3; rowc[0] = (row << 8) | ((tid & 7) ^ swz128(row));
    }
}
template <int CPR, class SRC>
__device__ __forceinline__ void att_stage(LDSP char* dst, SRC src, const int (&rowc)[(CPR == 24) ? 6 : 1], int wid) {
#pragma unroll
    for (int i = 0; i < CPR / 4; ++i) {
        const int rc = rowc[(CPR == 24) ? i : 0];
        const int row = (rc >> 8) + ((CPR == 24) ? 0 : i * (256 / CPR));
        __builtin_amdgcn_global_load_lds((const unsigned*)src(row, rc & 255), (LDSP unsigned*)(dst + (256 * i + 64 * wid) * 16), 16, 0, 0);
    }
}
__device__ __forceinline__ int wq_next(int* ctr, LDSP int* slot, int tid) {
    __syncthreads();
    if (tid == 0) *slot = atomicAdd(ctr, 1);
    __syncthreads();
    return *slot;
}

__device__ __forceinline__ void build_lut(LDSP float* tab, const float* blut_h, int n, int wlimit, int tid) {
    for (int i = tid; i < n; i += 256) { const int d = i - 64; tab[i] = (d < 0 || d >= wlimit) ? ATT_NEG : blut_h[d > 1023 ? 1023 : d] * LOG2E + ATT_SHIFT; }
}
__device__ __forceinline__ void st_build_luts(const P& p, int wg, int nwg) {
    const int tid = otid();
    for (int i = wg * 256 + tid; i < 8 * 1152 + 128; i += nwg * 256) {
        const int h = (i / 1152) & 7, d = i % 1152 - 64;
        p.glutg[i] = (d < 0) ? ATT_NEG : p.rel[rel_bucket(d > 1023 ? 1023 : d) * 8 + h] * LOG2E + ATT_SHIFT;
    }
    for (int i = wg * 256 + tid; i < 8 * 640; i += nwg * 256) {
        const int h = i / 640, d = i % 640 - 64;
        p.wlutg[i] = (d < 0 || d >= 512) ? ATT_NEG : p.rel[rel_bucket(d) * 8 + h] * LOG2E + ATT_SHIFT;
    }
}
template <int N4>
__device__ __forceinline__ void lut_dma(LDSP float* dst, const float* src, int tid) {
    const int wid = tid >> 6;
#pragma unroll
    for (int i = 0; i < (N4 + 255) / 256; ++i)
        if (256 * i + tid < N4) __builtin_amdgcn_global_load_lds((const unsigned*)(src + (size_t)(256 * i + tid) * 4), (LDSP unsigned*)((LDSP char*)dst + (256 * i + 64 * wid) * 16), 16, 0, 0);
}
#define ATT_BAR() do { __builtin_amdgcn_s_barrier(); asm volatile("" ::: "memory"); } while (0)

__device__ __forceinline__ void mla_item(const P& p, const int item, LDSP char* lds, const int tid0) {
    LDSP char* kb = lds; LDSP char* vb = lds + 24576; LDSP float* lut = (LDSP float*)(lds + 40960);
    const float c1 = 0.07216878364870322f * LOG2E;
    int tid = tid0; asm volatile("" : "+v"(tid));
    const int wid = tid >> 6, lane = tid & 63, q = lane & 31, hh = lane >> 5;
    AttLane L; att_lane_init<384, 256, 4>(L, lane);
    int krc[6], vrc[1];
    att_stage_map<24>(krc, tid); att_stage_map<16>(vrc, tid);
    int qt, bh, part;
    if (item >= 640) { const int r = item - 640; qt = 15 - (r >> 3); bh = r & 7; part = 0; }
    else {
        int g = 0; while (16 * (g + 1) + 8 * ((g + 2) >> 1) <= item) ++g;
        const int r = item - (16 * g + 8 * ((g + 1) >> 1)), Ln = 64 - g;
        if (r < 16) { qt = Ln - 1; bh = r & 7; part = 1 + (r >> 3); } else { qt = (Ln >> 1) - 1; bh = (r - 16) & 7; part = 0; }
    }
    const int b = bh >> 2, h = bh & 3;
    const int tw = qt * 128 + wid * 32;
    bf16x8 qf[12];
    {
        const bf16_t* qp = p.qmla + (size_t)(b * SEQ + tw + q) * 768 + h * 192 + 8 * hh;
#pragma unroll
        for (int ks = 0; ks < 12; ++ks) qf[ks] = *(const bf16x8*)(qp + 16 * ks);
    }
    f32x16 o[4];
#pragma unroll
    for (int dt = 0; dt < 4; ++dt)
#pragma unroll
        for (int r = 0; r < 16; ++r) o[dt][r] = 0.f;
    float lsum = 0.f;
    const int i0 = (part == 2) ? qt + 1 : 0, ntiles = (part == 1) ? qt + 1 : 2 * qt + 2;
    const bf16_t* kvb = p.kvmla + (size_t)b * SEQ * 1024 + h * 256;
    const bf16_t* krb = p.krope + (size_t)b * SEQ * 64;
    auto ksrc = [&](int pos0) { return [=](int row, int gc) { return gc < 16 ? kvb + (size_t)(pos0 + row) * 1024 + gc * 8 : krb + (size_t)(pos0 + row) * 64 + (gc - 16) * 8; }; };
    auto vsrc = [&](int pos0) { return [=](int row, int gc) { return kvb + (size_t)(pos0 + row) * 1024 + 128 + gc * 8; }; };
    att_stage<24>(kb, ksrc(i0 * 64), krc, wid);
    for (int i = i0; i < ntiles; ++i) {
        const int pos0 = i * 64;
        asm volatile("s_waitcnt vmcnt(0)" ::: "memory"); ATT_BAR();
        att_stage<16>(vb, vsrc(pos0), vrc, wid);
        const bool active = pos0 <= tw + 31, diag = pos0 + 63 > tw;
        bf16x8 pf[4];
        if (active) {
            if (diag) {
                int dq = tw + q - pos0 - 4 * hh; dq = dq < -1 ? -1 : dq;
                att_qk<12, 384, 1, true, false>(kb, L, qf, pf, lsum, c1, 0.f, (unsigned)(size_t)lut + (unsigned)(dq + 1) * 4u, 0, nullptr, 0.f);
            } else att_qk<12, 384, 0, true, false>(kb, L, qf, pf, lsum, c1, ATT_SHIFT, 0u, 0, nullptr, 0.f);
        }
        asm volatile("s_waitcnt vmcnt(0) lgkmcnt(0)" ::: "memory"); ATT_BAR();
        if (i + 1 < ntiles) att_stage<24>(kb, ksrc(pos0 + 64), krc, wid);
        if (active) att_pv<4, 256>(vb, L, pf, o);
    }
    const float lt = lsum + __shfl_xor(lsum, 32);
    int tid2 = tid0; asm volatile("" : "+v"(tid2));
    const int lane2 = tid2 & 63, trow = qt * 128 + (tid2 >> 6) * 32 + (lane2 & 31);
    bf16_t* op; float inv;
    if (part == 0) { inv = 1.0f / lt; op = p.o + (size_t)(b * SEQ + trow) * DM + h * 128 + 4 * (lane2 >> 5); }
    else {
        const size_t rec = (size_t)((part - 1) * 8 + bh) * (SEQ / 2) + (trow - SEQ / 2);
        inv = 1.0f; op = p.mlap + rec * 128 + 4 * (lane2 >> 5);
        if (lane2 < 32) p.mlal[rec] = lt;
    }
#pragma unroll
    for (int dt = 0; dt < 4; ++dt)
#pragma unroll
        for (int rq = 0; rq < 4; ++rq)
            *(u32x2*)(op + 32 * dt + 8 * rq) = (u32x2){cvtpk(o[dt][4 * rq] * inv, o[dt][4 * rq + 1] * inv), cvtpk(o[dt][4 * rq + 2] * inv, o[dt][4 * rq + 3] * inv)};
}
__device__ __forceinline__ void st_mla_combine(const P& p, int wg, int nwg) {
    const int TIDX = otid();
    const int wid = TIDX >> 6, lane = TIDX & 63, sub = lane >> 4, c8 = (lane & 15) * 8;
    const int ngrp = 8 * (SEQ / 2) / 4, stride = nwg * 4;
    for (int g = wg * 4 + wid; g < ngrp; g += 2 * stride) {
        u32x4v a[2], c[2]; float l0[2], l1[2]; bool on[2];
#pragma unroll
        for (int u = 0; u < 2; ++u) {
            const int gg = g + u * stride; on[u] = gg < ngrp;
            const int w = (on[u] ? gg : g) * 4 + sub;
            const size_t r0 = (size_t)w, r1 = (size_t)(8 * (SEQ / 2) + w);
            l0[u] = p.mlal[r0]; l1[u] = p.mlal[r1];
            a[u] = *(const u32x4v*)(p.mlap + r0 * 128 + c8); c[u] = *(const u32x4v*)(p.mlap + r1 * 128 + c8);
        }
#pragma unroll
        for (int u = 0; u < 2; ++u) {
            if (!on[u]) continue;
            const int w = (g + u * stride) * 4 + sub;
            const int bh = w / (SEQ / 2), t = SEQ / 2 + w % (SEQ / 2), b = bh >> 2, h = bh & 3;
            const float inv = 1.0f / (l0[u] + l1[u]);
            u32x4v o4;
#pragma unroll
            for (int k = 0; k < 4; ++k) {
                const float x0 = __uint_as_float(a[u][k] << 16) + __uint_as_float(c[u][k] << 16), x1 = __uint_as_float(a[u][k] & 0xffff0000u) + __uint_as_float(c[u][k] & 0xffff0000u);
                o4[k] = cvtpk(x0 * inv, x1 * inv);
            }
            *(u32x4v*)(p.o + (size_t)(b * SEQ + t) * DM + h * 128 + c8) = o4;
        }
    }
}

__device__ __forceinline__ void swa_item(const P& p, const int item, LDSP char* lds, const int tid0) {
    LDSP char* kb = lds; LDSP char* vb = lds + 8192; LDSP float* luts = (LDSP float*)(lds + 46080);
    const float c1 = 0.125f * LOG2E;
    int tid = tid0; asm volatile("" : "+v"(tid));
    const int wid = tid >> 6, lane = tid & 63, q = lane & 31, hh = lane >> 5;
    AttLane L; att_lane_init<128, 128, 2>(L, lane);
    int rc[1]; att_stage_map<8>(rc, tid);
    const int b = item >> 9, kvh = (item >> 8) & 1, t0 = (item & 255) * 32, head = kvh * 4 + wid;
    bf16x8 qf[4];
    {
        const bf16_t* qp = p.proj1 + (size_t)(b * SEQ + t0 + q) * 1216 + 448 + head * 64 + 8 * hh;
#pragma unroll
        for (int ks = 0; ks < 4; ++ks) qf[ks] = *(const bf16x8*)(qp + 16 * ks);
    }
    f32x16 o[2];
#pragma unroll
    for (int dt = 0; dt < 2; ++dt)
#pragma unroll
        for (int r = 0; r < 16; ++r) o[dt][r] = 0.f;
    float lsum = 0.f;
    const bf16_t* kbp = p.proj1 + (size_t)b * SEQ * 1216 + 960 + kvh * 64;
    const bf16_t* zr = p.zrow;
    auto ksrc = [&](int pos0) { return [=](int row, int gc) { const int pos = pos0 + row; return (pos >= 0 && pos < SEQ) ? kbp + (size_t)pos * 1216 + gc * 8 : zr + gc * 8; }; };
    auto vsrc = [&](int pos0) { return [=](int row, int gc) { const int pos = pos0 + row; return (pos >= 0 && pos < SEQ) ? kbp + (size_t)pos * 1216 + 128 + gc * 8 : zr + gc * 8; }; };
    const unsigned tab = (unsigned)(size_t)(luts + head * 256);
    att_stage<8>(kb, ksrc(t0 - 128), rc, wid);
    for (int i = 0; i < 3; ++i) {
        const int pos0 = t0 - 128 + 64 * i;
        asm volatile("s_waitcnt vmcnt(0)" ::: "memory"); ATT_BAR();
        att_stage<8>(vb, vsrc(pos0), rc, wid);
        bf16x8 pf[4];
        int dq = t0 + q - pos0 - 4 * hh; dq = dq < -1 ? -1 : dq;
        att_qk<4, 128, 1, true, false>(kb, L, qf, pf, lsum, c1, 0.f, tab + (unsigned)(dq + 1) * 4u, 0, nullptr, 0.f);
        asm volatile("s_waitcnt vmcnt(0) lgkmcnt(0)" ::: "memory"); ATT_BAR();
        if (i + 1 < 3) att_stage<8>(kb, ksrc(pos0 + 64), rc, wid);
        att_pv<2, 128>(vb, L, pf, o);
    }
    const float lt = lsum + __shfl_xor(lsum, 32) + __builtin_amdgcn_exp2f(p.sinks[head] * LOG2E + ATT_SHIFT);
    const float inv = 1.0f / lt;
    bf16_t* op = p.o + (size_t)(b * SEQ + t0 + q) * DM + 512 + head * 64 + 4 * hh;
#pragma unroll
    for (int dt = 0; dt < 2; ++dt)
#pragma unroll
        for (int rq = 0; rq < 4; ++rq)
            *(u32x2*)(op + 32 * dt + 8 * rq) = (u32x2){cvtpk(o[dt][4 * rq] * inv, o[dt][4 * rq + 1] * inv), cvtpk(o[dt][4 * rq + 2] * inv, o[dt][4 * rq + 3] * inv)};
}
__device__ __forceinline__ void moe_conv_item(const P& p, const int layer, const int item, LDSP char* lds, const int tid0) {
    float* sm = (float*)lds;
    const int set = item >> 8, t0 = (item & 255) * 8;
    if (set == 0) conv_batched<1, true>(p.moe_wg + (size_t)layer * 16 * 1024 * 512, 16, 1024, 512, (size_t)1024 * 512, p.wt_gu + (size_t)layer * 16 * 1024 * 1024, (size_t)1024 * 1024, t0, 1, sm, tid0, t0 + 8);
    else if (set == 1) conv_batched<2, true>(p.moe_wu + (size_t)layer * 16 * 1024 * 512, 16, 1024, 512, (size_t)1024 * 512, p.wt_gu + (size_t)layer * 16 * 1024 * 1024, (size_t)1024 * 1024, t0, 1, sm, tid0, t0 + 8);
    else conv_batched<0, true>(p.moe_wd + (size_t)layer * 16 * 512 * 1024, 16, 512, 1024, (size_t)512 * 1024, p.wt_d + (size_t)layer * 16 * 1024 * 512, (size_t)1024 * 512, t0, 1, sm, tid0, t0 + 8);
}
__device__ __forceinline__ void st_attn1(const P& p, LDSP char* lds) {
    const int tid0 = otid();
    LDSP float* lut = (LDSP float*)(lds + 40960); LDSP int* slot = (LDSP int*)(lds + 45568); LDSP float* luts = (LDSP float*)(lds + 46080);
    for (int i = tid0; i < 1152; i += 256) lut[i] = (i < 64) ? ATT_NEG : ATT_SHIFT;
#pragma unroll 1
    for (int h = 0; h < 8; ++h) build_lut(luts + h * 256, p.blut + h * 1024, 256, 128, tid0);
    for (;;) {
        const int item = wq_next(p.wq + 0, slot, tid0);
        if (item >= 768 + 1024 + 768) break;
        if (item < 768) mla_item(p, item, lds, tid0);
        else { const int r = item - 768, g = r / 7, ps = r - g * 7;
               if (ps < 4) swa_item(p, g * 4 + ps, lds, tid0); else moe_conv_item(p, 1, g * 3 + ps - 4, lds, tid0); }
    }
}

#define A0_GLUT 16384
#define A0_WLUT 34816
#define A0_IMP 45056
#define A0_SEL 61568
#define A0_UN 62080
#define A0_LIST 62144
#define A0_SLOT 62720
__device__ __forceinline__ unsigned wmax_u32(unsigned v) {
#pragma unroll
    for (int o = 32; o > 0; o >>= 1) { const unsigned t = (unsigned)__shfl_xor((int)v, o); v = t > v ? t : v; }
    return v;
}
#define ATT_STORE_O(op, o, sc) do { _Pragma("unroll") for (int dt_ = 0; dt_ < 2; ++dt_) _Pragma("unroll") for (int rq_ = 0; rq_ < 4; ++rq_) \
        *(u32x2*)((op) + 32 * dt_ + 8 * rq_) = (u32x2){cvtpk((o)[dt_][4 * rq_] * (sc), (o)[dt_][4 * rq_ + 1] * (sc)), cvtpk((o)[dt_][4 * rq_ + 2] * (sc), (o)[dt_][4 * rq_ + 3] * (sc))}; } while (0)

__device__ __forceinline__ void nsa_item(const P& p, const int item, LDSP char* lds, const int tid0) {
    LDSP char* kb = lds; LDSP char* vb = lds + 8192;
    LDSP float* glut = (LDSP float*)(lds + A0_GLUT); LDSP float* wlut = (LDSP float*)(lds + A0_WLUT); LDSP float* imp = (LDSP float*)(lds + A0_IMP);
    LDSP unsigned* sel = (LDSP unsigned*)(lds + A0_SEL); LDSP unsigned* un = (LDSP unsigned*)(lds + A0_UN); LDSP unsigned short* blist = (LDSP unsigned short*)(lds + A0_LIST);
    const float c1 = 0.125f * LOG2E;
    int tid = tid0; asm volatile("" : "+v"(tid));
    const int wid = tid >> 6, lane = tid & 63, q = lane & 31, hh = lane >> 5;
    const int tile = 255 - (item >> 2), b = (item >> 1) & 1, kvh = item & 1, t0 = tile * 32, blk_t = t0 >> 6, head = kvh * 4 + wid;
    lut_dma<1152>(glut, p.glutg + (size_t)kvh * 4 * 1152, tid); lut_dma<640>(wlut, p.wlutg + (size_t)kvh * 4 * 640, tid);
    for (int i = tid; i < 32 * 129; i += 256) imp[i] = 0.f;
    AttLane L; att_lane_init<128, 128, 2>(L, lane);
    int rc[1]; att_stage_map<8>(rc, tid);
    const size_t rowq = (size_t)(b * SEQ + t0 + q);
    bf16x8 qf[4];
    {
        const bf16_t* qp = p.proj + rowq * 2840 + head * 64 + 8 * hh;
#pragma unroll
        for (int ks = 0; ks < 4; ++ks) qf[ks] = *(const bf16x8*)(qp + 16 * ks);
    }
    const float gc = p.gates[rowq * 24 + head * 3 + 0], gs = p.gates[rowq * 24 + head * 3 + 1], gw = p.gates[rowq * 24 + head * 3 + 2];
    const unsigned gtab = (unsigned)(size_t)(glut + wid * 1152), wtab = (unsigned)(size_t)(wlut + wid * 640);
    const bf16_t* zr = p.zrow;
    const bf16_t* pb = p.proj + (size_t)b * SEQ * 2840;
    f32x16 of[2], o[2];
#pragma unroll
    for (int dt = 0; dt < 2; ++dt)
#pragma unroll
        for (int r = 0; r < 16; ++r) { of[dt][r] = 0.f; o[dt][r] = 0.f; }
    bf16x8 pf[4];
    asm volatile("s_waitcnt vmcnt(0)" ::: "memory");
    __syncthreads();
    const float cfar = glut[wid * 1152 + 64 + 1023];
    {
        int nvm = (t0 >> 4) + 1; nvm = nvm > 511 ? 511 : nvm;
        const int ntc = (nvm + 63) >> 6;
        const bf16_t* kcb = p.kcmpb + (size_t)((b * 2 + kvh) * 512) * 64;
        const bf16_t* vcb = p.kcmpb + (size_t)((4 + b * 2 + kvh) * 512) * 64;
        auto csrc = [&](const bf16_t* base, int n0) { return [=](int row, int gcx) { const int n = n0 + row; return n < 511 ? base + (size_t)n * 64 + gcx * 8 : zr + gcx * 8; }; };
        float lsum = 0.f;
        for (int nt = 0; nt < ntc; ++nt) {
            att_stage<8>(kb, csrc(kcb, nt * 64), rc, wid);
            asm volatile("s_waitcnt vmcnt(0)" ::: "memory"); ATT_BAR();
            const int dq16 = t0 + q - 31 - 1024 * nt - 64 * hh;
            if (t0 - 31 - 16 * (nt * 64 + 63) >= 1023) att_qk<4, 128, 0, false, false>(kb, L, qf, pf, lsum, c1, cfar, 0u, 0, nullptr, 0.f);
            else att_qk<4, 128, 2, false, false>(kb, L, qf, pf, lsum, c1, 0.f, gtab, dq16, nullptr, 0.f);
            asm volatile("s_waitcnt lgkmcnt(0)" ::: "memory"); ATT_BAR();
        }
        const float lc = lsum + __shfl_xor(lsum, 32);
        const float invl = lc > 0.f ? 1.0f / lc : 0.f;
        float dummy = 0.f;
        for (int nt = 0; nt < ntc; ++nt) {
            att_stage<8>(kb, csrc(kcb, nt * 64), rc, wid);
            att_stage<8>(vb, csrc(vcb, nt * 64), rc, wid);
            asm volatile("s_waitcnt vmcnt(0)" ::: "memory"); ATT_BAR();
            const int dq16 = t0 + q - 31 - 1024 * nt - 64 * hh;
            LDSP float* improw = imp + q * 129 + 16 * nt + hh;
            if (t0 - 31 - 16 * (nt * 64 + 63) >= 1023) att_qk<4, 128, 0, true, true>(kb, L, qf, pf, dummy, c1, cfar, 0u, 0, improw, invl * 524288.0f);
            else att_qk<4, 128, 2, true, true>(kb, L, qf, pf, dummy, c1, 0.f, gtab, dq16, improw, invl * 524288.0f);
            att_pv<2, 128>(vb, L, pf, o);
            asm volatile("s_waitcnt lgkmcnt(0)" ::: "memory"); ATT_BAR();
        }
        const float sc = gc * invl;
#pragma unroll
        for (int dt = 0; dt < 2; ++dt)
#pragma unroll
            for (int r = 0; r < 16; ++r) { of[dt][r] = o[dt][r] * sc; o[dt][r] = 0.f; }
    }
    __syncthreads();
    {
        unsigned u0 = 0u, u1 = 0u, u2 = 0u, u3 = 0u;
        for (int i = 0; i < 8; i += 2) {
            unsigned k0[2], k1[2], thr[2] = {0u, 0u};
#pragma unroll
            for (int u = 0; u < 2; ++u) {
                const int tok = wid * 8 + i + u;
                const unsigned v0 = ((LDSP const unsigned*)imp)[tok * 129 + lane], v1 = ((LDSP const unsigned*)imp)[tok * 129 + 64 + lane];
                const int j0 = lane, j1 = lane + 64;
                const bool f0 = (j0 == 0) || (j0 == blk_t) || (j0 == blk_t - 1), f1 = (j1 == blk_t) || (j1 == blk_t - 1);
                k0[u] = f0 ? (0xFFFFFF80u | (unsigned)(127 - j0)) : (j0 <= blk_t ? ((v0 << 7) | (unsigned)(127 - j0)) : 0u);
                k1[u] = f1 ? (0xFFFFFF80u | (unsigned)(127 - j1)) : (j1 <= blk_t ? ((v1 << 7) | (unsigned)(127 - j1)) : 0u);
            }
            bool dn0 = false, dn1 = false;
#pragma unroll 1
            for (int bit = 31; bit >= 0; --bit) {
                const unsigned ca = thr[0] | (1u << bit), cb = thr[1] | (1u << bit);
                const int na = __popcll(__ballot(k0[0] >= ca)) + __popcll(__ballot(k1[0] >= ca));
                const int nb2 = __popcll(__ballot(k0[1] >= cb)) + __popcll(__ballot(k1[1] >= cb));
                if (!dn0) { thr[0] = (na >= 16) ? ca : thr[0]; dn0 = (na == 16); }
                if (!dn1) { thr[1] = (nb2 >= 16) ? cb : thr[1]; dn1 = (nb2 == 16); }
                if (dn0 && dn1) break;
            }
#pragma unroll
            for (int u = 0; u < 2; ++u) {
                const int tok = wid * 8 + i + u;
                const unsigned th = thr[u] ? thr[u] : 1u;
                const unsigned long long b0 = __ballot(k0[u] >= th), b1 = __ballot(k1[u] >= th);
                const unsigned m0 = (unsigned)b0, m1 = (unsigned)(b0 >> 32), m2 = (unsigned)b1, m3 = (unsigned)(b1 >> 32);
                if (lane == 0) { sel[tok * 4 + 0] = m0; sel[tok * 4 + 1] = m1; sel[tok * 4 + 2] = m2; sel[tok * 4 + 3] = m3; }
                u0 |= m0; u1 |= m1; u2 |= m2; u3 |= m3;
            }
        }
        if (lane == 0) { un[wid * 4 + 0] = u0; un[wid * 4 + 1] = u1; un[wid * 4 + 2] = u2; un[wid * 4 + 3] = u3; }
    }
    __syncthreads();
    {
        unsigned uw[4];
#pragma unroll
        for (int k = 0; k < 4; ++k) uw[k] = (unsigned)__builtin_amdgcn_readfirstlane((int)(un[k] | un[4 + k] | un[8 + k] | un[12 + k]));
        if (tid < 128) {
            const int k = tid >> 5, jb = tid & 31;
            unsigned wv = 0u; int below = 0;
#pragma unroll
            for (int kk = 0; kk < 4; ++kk) { if (kk == k) wv = uw[kk]; if (kk < k) below += __popc(uw[kk]); }
            if ((wv >> jb) & 1u) blist[below + __popc(wv & ((1u << jb) - 1u))] = (unsigned short)tid;
        }
        const int nb = __popc(uw[0]) + __popc(uw[1]) + __popc(uw[2]) + __popc(uw[3]);
        unsigned sq[4];
#pragma unroll
        for (int k = 0; k < 4; ++k) sq[k] = sel[q * 4 + k];
        __syncthreads();
        const bf16_t* ksb = pb + 768 + kvh * 64;
        auto ssrc = [&](int pos0, int colo) { return [=](int row, int gcx) { return ksb + (size_t)(pos0 + row) * 2840 + colo + gcx * 8; }; };
        float lsum = 0.f;
        att_stage<8>(kb, ssrc(64 * (int)blist[0], 0), rc, wid);
        for (int i = 0; i < nb; ++i) {
            const int j = __builtin_amdgcn_readfirstlane((int)blist[i]), pos0 = 64 * j;
            asm volatile("s_waitcnt vmcnt(0)" ::: "memory"); ATT_BAR();
            att_stage<8>(vb, ssrc(pos0, 128), rc, wid);
            unsigned sw = 0u;
#pragma unroll
            for (int k = 0; k < 4; ++k) if ((j >> 5) == k) sw = sq[k];
            const bool selq = (sw >> (j & 31)) & 1u;
            if (t0 - (pos0 + 63) >= 1023) att_qk<4, 128, 0, true, false>(kb, L, qf, pf, lsum, c1, selq ? cfar : ATT_NEG, 0u, 0, nullptr, 0.f);
            else {
                int dq = t0 + q - pos0 - 4 * hh; dq = dq > 1087 ? 1087 : dq; dq = (dq < -1 || !selq) ? -1 : dq;
                att_qk<4, 128, 1, true, false>(kb, L, qf, pf, lsum, c1, 0.f, gtab + (unsigned)(dq + 1) * 4u, 0, nullptr, 0.f);
            }
            asm volatile("s_waitcnt vmcnt(0) lgkmcnt(0)" ::: "memory"); ATT_BAR();
            if (i + 1 < nb) att_stage<8>(kb, ssrc(64 * (int)blist[i + 1], 0), rc, wid);
            att_pv<2, 128>(vb, L, pf, o);
        }
        const float ls = lsum + __shfl_xor(lsum, 32);
        const float sc = gs / ls;
#pragma unroll
        for (int dt = 0; dt < 2; ++dt)
#pragma unroll
            for (int r = 0; r < 16; ++r) { of[dt][r] += o[dt][r] * sc; o[dt][r] = 0.f; }
    }
    {
        const bf16_t* kwb = pb + 1024 + kvh * 64;
        auto wsrc = [&](int pos0, int colo) { return [=](int row, int gcx) { const int pos = pos0 + row; return (pos >= 0 && pos < SEQ) ? kwb + (size_t)pos * 2840 + colo + gcx * 8 : zr + gcx * 8; }; };
        float lsum = 0.f;
        asm volatile("s_waitcnt lgkmcnt(0)" ::: "memory"); ATT_BAR();
        att_stage<8>(kb, wsrc(t0 - 512, 0), rc, wid);
        for (int i = 0; i < 9; ++i) {
            const int pos0 = t0 - 512 + 64 * i;
            asm volatile("s_waitcnt vmcnt(0)" ::: "memory"); ATT_BAR();
            att_stage<8>(vb, wsrc(pos0, 128), rc, wid);
            int dq = t0 + q - pos0 - 4 * hh; dq = dq < -1 ? -1 : dq;
            att_qk<4, 128, 1, true, false>(kb, L, qf, pf, lsum, c1, 0.f, wtab + (unsigned)(dq + 1) * 4u, 0, nullptr, 0.f);
            asm volatile("s_waitcnt vmcnt(0) lgkmcnt(0)" ::: "memory"); ATT_BAR();
            if (i + 1 < 9) att_stage<8>(kb, wsrc(pos0 + 64, 0), rc, wid);
            att_pv<2, 128>(vb, L, pf, o);
        }
        const float lw = lsum + __shfl_xor(lsum, 32);
        const float sc = gw / lw;
#pragma unroll
        for (int dt = 0; dt < 2; ++dt)
#pragma unroll
            for (int r = 0; r < 16; ++r) of[dt][r] += o[dt][r] * sc;
    }
    bf16_t* op = p.o + rowq * DM + head * 64 + 4 * hh;
    ATT_STORE_O(op, of, 1.0f);
}

#define MG_CNT 8192
#define MG_BASE 8320
#define MG_ENT 8448
__device__ __forceinline__ void st_moba_gate(const P& p, int wg, int nwg, LDSP char* lds) {
    const int tid = otid();
    const int wid = tid >> 6, lane = tid & 63, q = lane & 31, hh = lane >> 5;
    LDSP char* kmt = lds; LDSP int* lcnt = (LDSP int*)(lds + MG_CNT); LDSP int* lbase = (LDSP int*)(lds + MG_BASE); LDSP int* ent = (LDSP int*)(lds + MG_ENT);
    AttLane L; att_lane_init<128, 128, 2>(L, lane);
    int rc[1]; att_stage_map<8>(rc, tid);
    const bf16_t* zr = p.zrow;
    for (int item = wg; item < 1024; item += nwg) {
        const int tile = item >> 4, b = (item >> 3) & 1, h = item & 7, t0 = tile * 128, own = t0 >> 8, tw = t0 + wid * 32, bh = b * 8 + h;
        if (own == 0) continue;
        __syncthreads();
        if (tid < 32) lcnt[tid] = 0;
        bf16x8 qf[4];
        {
            const bf16_t* qp = p.proj + (size_t)(b * SEQ + tw + q) * 2840 + 1304 + h * 64 + 8 * hh;
#pragma unroll
            for (int ks = 0; ks < 4; ++ks) qf[ks] = *(const bf16x8*)(qp + 16 * ks);
        }
        const bf16_t* kmb = p.kmeanb + (size_t)(bh * 32) * 64;
        att_stage<8>(kmt, [=](int row, int gcx) { return row < 32 ? kmb + (size_t)row * 64 + gcx * 8 : zr + gcx * 8; }, rc, wid);
        asm volatile("s_waitcnt vmcnt(0)" ::: "memory");
        __syncthreads();
        f32x16 s;
#pragma unroll
        for (int r = 0; r < 16; ++r) s[r] = 0.f;
#pragma unroll
        for (int ks = 0; ks < 4; ++ks) {
            const bf16x8 a = *(const LDSP bf16x8*)(kmt + (L.kbase ^ (32 * (ks & 3))));
            s = __builtin_amdgcn_mfma_f32_32x32x16_bf16(a, qf[ks], s, 0, 0, 0);
        }
        unsigned key[16];
#pragma unroll
        for (int r = 0; r < 16; ++r) {
            const int j = (r & 3) + 8 * (r >> 2) + 4 * hh;
            const unsigned bits = __float_as_uint(s[r]);
            const unsigned srt = (bits & 0x80000000u) ? ~bits : (bits | 0x80000000u);
            key[r] = (j < own) ? ((srt & ~31u) | (unsigned)(31 - j)) : 0u;
        }
        unsigned selm = 0u;
#pragma unroll 1
        for (int rnd = 0; rnd < 3; ++rnd) {
            unsigned m = 0u;
#pragma unroll
            for (int r = 0; r < 16; ++r) m = key[r] > m ? key[r] : m;
            const unsigned mo = (unsigned)__shfl_xor((int)m, 32);
            const unsigned wk = mo > m ? mo : m;
            if (wk != 0u) selm |= 1u << (31 - (wk & 31u));
#pragma unroll
            for (int r = 0; r < 16; ++r) key[r] = (key[r] == wk) ? 0u : key[r];
        }
        if (hh == 0) {
            unsigned mm = selm;
#pragma unroll
            for (int sI = 0; sI < 3; ++sI) {
                int en = -1;
                if (mm) { const int j = __builtin_ctz(mm); mm &= mm - 1u; const int lp = __hip_atomic_fetch_add(lcnt + j, 1, __ATOMIC_RELAXED, __HIP_MEMORY_SCOPE_WORKGROUP); en = (j << 8) | lp; }
                ent[(wid * 32 + q) * 3 + sI] = en;
            }
        }
        __syncthreads();
        if (tid < 32) { const int c = lcnt[tid]; lbase[tid] = c ? atomicAdd(p.mcnt + bh * 32 + tid, c) : 0; }
        __syncthreads();
        for (int e = tid; e < 384; e += 256) {
            const int en = ent[e];
            if (en >= 0) { const int j = en >> 8, tokl = e / 3, sI = e - tokl * 3; p.mlist[(size_t)(bh * 32 + j) * 8192 + lbase[j] + (en & 255)] = (unsigned short)((t0 + tokl) | (sI << 13)); }
        }
    }
}
__device__ __forceinline__ bf16_t* moba_part(const P& p, int slot, size_t row) { return (slot < 2 ? p.mp01 + (size_t)slot * 131072 * 64 : p.mp2) + row * 64; }

__device__ __forceinline__ void moba_inv_item(const P& p, const int lid, const int chunk, LDSP char* lds, const int tid0) {
    LDSP char* kb = lds; LDSP char* vb = lds + 8192; LDSP float* glut = (LDSP float*)(lds + A0_GLUT);
    const float c1 = 0.125f * LOG2E;
    int tid = tid0; asm volatile("" : "+v"(tid));
    const int wid = tid >> 6, lane = tid & 63, q = lane & 31, hh = lane >> 5;
    const int bh = lid / 31, j = lid - bh * 31, b = bh >> 3, h = bh & 7;
    lut_dma<320>(glut, p.glutg + (size_t)h * 1152, tid);
    AttLane L; att_lane_init<128, 128, 2>(L, lane);
    int rc[1]; att_stage_map<8>(rc, tid);
    const int n = p.mcnt[bh * 32 + j], idx = chunk * 128 + wid * 32 + q;
    const bool valid = idx < n;
    const unsigned en = valid ? (unsigned)p.mlist[(size_t)(bh * 32 + j) * 8192 + idx] : (unsigned)(256 * (j + 1));
    const int tok = (int)(en & 8191u), slot = (int)(en >> 13);
    bf16x8 qf[4];
    {
        const bf16_t* qp = p.proj + (size_t)(b * SEQ + tok) * 2840 + 1304 + h * 64 + 8 * hh;
#pragma unroll
        for (int ks = 0; ks < 4; ++ks) qf[ks] = *(const bf16x8*)(qp + 16 * ks);
    }
    const unsigned gtab = (unsigned)(size_t)glut;
    const bf16_t* kbb = p.proj + (size_t)b * SEQ * 2840 + 1816 + h * 64;
    auto msrc = [&](int pos0, int colo) { return [=](int row, int gcx) { return kbb + (size_t)(pos0 + row) * 2840 + colo + gcx * 8; }; };
    f32x16 o[2];
#pragma unroll
    for (int dt = 0; dt < 2; ++dt)
#pragma unroll
        for (int r = 0; r < 16; ++r) o[dt][r] = 0.f;
    float lsum = 0.f;
    bf16x8 pf[4];
    asm volatile("s_waitcnt vmcnt(0)" ::: "memory");
    __syncthreads();
    att_stage<8>(kb, msrc(256 * j, 0), rc, wid);
    for (int i = 0; i < 4; ++i) {
        const int pos0 = 256 * j + 64 * i;
        asm volatile("s_waitcnt vmcnt(0)" ::: "memory"); ATT_BAR();
        att_stage<8>(vb, msrc(pos0, 512), rc, wid);
        {
            int dq = tok - pos0 - 4 * hh; dq = dq > 1087 ? 1087 : dq; dq = valid ? dq : -1;
            att_qk<4, 128, 1, true, false>(kb, L, qf, pf, lsum, c1, 0.f, gtab + (unsigned)(dq + 1) * 4u, 0, nullptr, 0.f);
        }
        asm volatile("s_waitcnt vmcnt(0) lgkmcnt(0)" ::: "memory"); ATT_BAR();
        if (i + 1 < 4) att_stage<8>(kb, msrc(pos0 + 64, 0), rc, wid);
        att_pv<2, 128>(vb, L, pf, o);
    }
    const float lt = lsum + __shfl_xor(lsum, 32);
    if (valid) {
        const size_t row = (size_t)bh * SEQ + tok;
        bf16_t* op = moba_part(p, slot, row) + 4 * hh;
        ATT_STORE_O(op, o, 1.0f);
        if (hh == 0) p.mpl[(size_t)slot * 131072 + row] = lt;
    }
}
__device__ __forceinline__ void moba_own_item(const P& p, const int item, LDSP char* lds, const int tid0) {
    LDSP char* kb = lds; LDSP char* vb = lds + 8192; LDSP float* glut = (LDSP float*)(lds + A0_GLUT);
    const float c1 = 0.125f * LOG2E;
    int tid = tid0; asm volatile("" : "+v"(tid));
    const int wid = tid >> 6, lane = tid & 63, q = lane & 31, hh = lane >> 5;
    const int tile = item >> 4, b = (item >> 3) & 1, h = item & 7, t0 = tile * 128, own = t0 >> 8, tw = t0 + wid * 32, bh = b * 8 + h;
    __syncthreads();
    lut_dma<320>(glut, p.glutg + (size_t)h * 1152, tid);
    AttLane L; att_lane_init<128, 128, 2>(L, lane);
    int rc[1]; att_stage_map<8>(rc, tid);
    const size_t rowq = (size_t)(b * SEQ + tw + q);
    bf16x8 qf[4];
    {
        const bf16_t* qp = p.proj + rowq * 2840 + 1304 + h * 64 + 8 * hh;
#pragma unroll
        for (int ks = 0; ks < 4; ++ks) qf[ks] = *(const bf16x8*)(qp + 16 * ks);
    }
    const unsigned gtab = (unsigned)(size_t)glut;
    const bf16_t* kbb = p.proj + (size_t)b * SEQ * 2840 + 1816 + h * 64;
    auto msrc = [&](int pos0, int colo) { return [=](int row, int gcx) { return kbb + (size_t)(pos0 + row) * 2840 + colo + gcx * 8; }; };
    f32x16 o[2];
#pragma unroll
    for (int dt = 0; dt < 2; ++dt)
#pragma unroll
        for (int r = 0; r < 16; ++r) o[dt][r] = 0.f;
    float lsum = 0.f;
    bf16x8 pf[4];
    const int nb = (((t0 + 127) >> 6) & 3) + 1;
    asm volatile("s_waitcnt vmcnt(0)" ::: "memory");
    __syncthreads();
    att_stage<8>(kb, msrc(256 * own, 0), rc, wid);
    for (int i = 0; i < nb; ++i) {
        const int pos0 = 256 * own + 64 * i;
        asm volatile("s_waitcnt vmcnt(0)" ::: "memory"); ATT_BAR();
        att_stage<8>(vb, msrc(pos0, 512), rc, wid);
        const bool active = pos0 <= tw + 31;
        if (active) {
            int dq = tw + q - pos0 - 4 * hh; dq = dq < -1 ? -1 : dq;
            att_qk<4, 128, 1, true, false>(kb, L, qf, pf, lsum, c1, 0.f, gtab + (unsigned)(dq + 1) * 4u, 0, nullptr, 0.f);
        }
        asm volatile("s_waitcnt vmcnt(0) lgkmcnt(0)" ::: "memory"); ATT_BAR();
        if (i + 1 < nb) att_stage<8>(kb, msrc(pos0 + 64, 0), rc, wid);
        if (active) att_pv<2, 128>(vb, L, pf, o);
    }
    float lt = lsum + __shfl_xor(lsum, 32);
    const int npick = own < 3 ? own : 3;
    const size_t row = (size_t)bh * SEQ + tw + q;
#pragma unroll 1
    for (int sI = 0; sI < npick; ++sI) {
        lt += p.mpl[(size_t)sI * 131072 + row];
        const bf16_t* pp = moba_part(p, sI, row) + 4 * hh;
#pragma unroll
        for (int dt = 0; dt < 2; ++dt)
#pragma unroll
            for (int rq = 0; rq < 4; ++rq) {
                const u32x2 w = *(const u32x2*)(pp + 32 * dt + 8 * rq);
                o[dt][4 * rq] += __uint_as_float(w[0] << 16); o[dt][4 * rq + 1] += __uint_as_float(w[0] & 0xffff0000u);
                o[dt][4 * rq + 2] += __uint_as_float(w[1] << 16); o[dt][4 * rq + 3] += __uint_as_float(w[1] & 0xffff0000u);
            }
    }
    const float inv = 1.0f / lt;
    bf16_t* op = p.o + rowq * DM + 512 + h * 64 + 4 * hh;
    ATT_STORE_O(op, o, inv);
}
__device__ __forceinline__ void st_moba_own(const P& p, int wg, int nwg, LDSP char* lds) {
    const int tid0 = otid();
    for (int item = wg; item < 1024; item += nwg) moba_own_item(p, item, lds, tid0);
}
#define A0_PRE 62736
__device__ __forceinline__ void st_attn0(const P& p, LDSP char* lds) {
    const int tid0 = otid();
    LDSP int* slot = (LDSP int*)(lds + A0_SLOT); LDSP int* pre = (LDSP int*)(lds + A0_PRE);
    LDSP int* tmp = (LDSP int*)lds;
    for (int i = tid0; i < 496; i += 256) { const int bh = i / 31, j = i - bh * 31; tmp[i] = (p.mcnt[bh * 32 + j] + 127) >> 7; }
    __syncthreads();
    for (int i = tid0; i < 497; i += 256) { int s = 0; for (int k = 0; k < i; ++k) s += tmp[k]; pre[i] = s; }
    __syncthreads();
    const int ninv = pre[496];
    for (;;) {
        const int item = wq_next(p.wq + 1, slot, tid0);
        const int ntail = 5 * 768 + (ninv > 3072 ? ninv - 3072 : 0);
        if (item >= 1024 + ntail) break;
        if (item < 1024) nsa_item(p, item, lds, tid0);
        else {
            const int r = item - 1024, g = r / 5, ps = r - g * 5;
            if (g < 768 && ps == 4) { moe_conv_item(p, 0, g, lds, tid0); continue; }
            const int idx = (g < 768) ? g * 4 + ps : 3072 + (r - 5 * 768);
            if (idx >= ninv) continue;
            int lo = 0, hi = 495;
            while (lo < hi) { const int mid = (lo + hi + 1) >> 1; if (pre[mid] <= idx) lo = mid; else hi = mid - 1; }
            moba_inv_item(p, lo, idx - pre[lo], lds, tid0);
        }
    }
}

#define XB_TMO      128
#define XB_XCNT(j)  (256  + 64 * (j))
#define XB_XSUB(j)  (1280 + 64 * (j))
#define XB_XGEN(j)  (2304 + 64 * (j))
#define XB_TOP      3328
#define XB_TOPGEN   3392
#define XCD_BAR_WORDS 3456
#define XB_SPIN_CAP (1u << 20)
#define LAS __attribute__((address_space(3)))

__device__ __forceinline__ unsigned xb_ld(unsigned* p)              { return __hip_atomic_load(p, __ATOMIC_RELAXED, __HIP_MEMORY_SCOPE_AGENT); }
__device__ __forceinline__ unsigned xb_add(unsigned* p, unsigned v) { return __hip_atomic_fetch_add(p, v, __ATOMIC_RELAXED, __HIP_MEMORY_SCOPE_AGENT); }
__device__ __forceinline__ unsigned xb_xcc_id() { return (unsigned)__builtin_amdgcn_s_getreg((3 << 11) | 20) & 0xFu; }
#define XB_SPIN(cond, bar) do { unsigned _sp = 0; while (cond) { __builtin_amdgcn_s_sleep(1); \
    if ((++_sp & 255u) == 0u) { if (xb_ld(&(bar)[XB_TMO])) break; if (_sp > XB_SPIN_CAP) { atomicAdd(&(bar)[XB_TMO], 1u); break; } } } } while (0)

struct XcdBarrier {
    unsigned* bar; unsigned x;
    volatile LAS unsigned* st;
};

__device__ __forceinline__ XcdBarrier xcd_barrier_post(unsigned* bar, volatile LAS unsigned* st) {
    XcdBarrier b; b.bar = bar; b.x = xb_xcc_id(); b.st = st;
    if (threadIdx.x == 0) (void)xb_add(&bar[XB_XCNT(b.x)], 1u);
    return b;
}
__device__ __forceinline__ void xcd_barrier_complete(unsigned* bar, unsigned x, unsigned& nloc, unsigned& nx) {
    const unsigned G = gridDim.x * gridDim.y * gridDim.z;
    unsigned sum, cnt, mine, sp = 0u;
    for (;;) {
        sum = 0u; cnt = 0u; mine = 0u;
#pragma unroll
        for (unsigned j = 0; j < 16; ++j) { const unsigned c = xb_ld(&bar[XB_XCNT(j)]); sum += c; cnt += (c > 0u) ? 1u : 0u; mine = (j == x) ? c : mine; }
        if (sum == G) break;
        __builtin_amdgcn_s_sleep(1);
        if ((++sp & 255u) == 0u) { if (xb_ld(&bar[XB_TMO])) break; if (sp > XB_SPIN_CAP) { atomicAdd(&bar[XB_TMO], 1u); break; } }
    }
    nloc = mine > 0u ? mine : 1u; nx = cnt > 0u ? cnt : 1u;
}

__device__ __forceinline__ void xcd_barrier(const XcdBarrier& b) {
    asm volatile("s_waitcnt vmcnt(0)" ::: "memory");
    __syncthreads();
    if (threadIdx.x == 0) {
        unsigned* bar = b.bar;
        __builtin_amdgcn_s_waitcnt(0);
        unsigned nloc = b.st[0], nx = b.st[1];
        if (nloc == 0u) { xcd_barrier_complete(bar, b.x, nloc, nx); b.st[0] = nloc; b.st[1] = nx; }
        const unsigned old = xb_add(&bar[XB_XSUB(b.x)], 1u);
        const unsigned gen = old / nloc;
        if (old + 1u == (gen + 1u) * nloc) {
            __builtin_amdgcn_fence(__ATOMIC_RELEASE, "agent");
            asm volatile("s_waitcnt vmcnt(0)" ::: "memory");
            const unsigned og = xb_add(&bar[XB_TOP], 1u);
            const unsigned tg = og / nx;
            if (og + 1u == (tg + 1u) * nx) xb_add(&bar[XB_TOPGEN], 1u);
            else XB_SPIN(xb_ld(&bar[XB_TOPGEN]) == tg, bar);
            __builtin_amdgcn_fence(__ATOMIC_ACQUIRE, "agent");
            xb_add(&bar[XB_XGEN(b.x)], 1u);
            asm volatile("s_waitcnt vmcnt(0)" ::: "memory");
        } else {
            XB_SPIN(xb_ld(&bar[XB_TOPGEN]) == gen, bar);
            __builtin_amdgcn_fence(__ATOMIC_ACQUIRE, "agent");
            asm volatile("s_waitcnt vmcnt(0)" ::: "memory");
        }
    }
    __syncthreads();
}


#define PHASE_SYNC() do { PP qb_ = (PP)__builtin_amdgcn_kernarg_segment_ptr(); asm volatile("" : "+s"(qb_)); XcdBarrier b_; b_.bar = qb_->bar; b_.x = xb_xcc_id(); \
        b_.st = (volatile LAS unsigned*)(dlds + BAR_LDS_OFF); xcd_barrier(b_); } while (0)
typedef const __attribute__((address_space(4))) P* PP;
#define BAR_SAVE() const unsigned bs0_ = __builtin_amdgcn_readfirstlane(*(volatile LAS unsigned*)(dlds + BAR_LDS_OFF)), \
        bs1_ = __builtin_amdgcn_readfirstlane(*(volatile LAS unsigned*)(dlds + BAR_LDS_OFF + 4)); __syncthreads()
#define BAR_RESTORE() do { __syncthreads(); if (threadIdx.x == 0) { *(volatile LAS unsigned*)(dlds + BAR_LDS_OFF) = bs0_; *(volatile LAS unsigned*)(dlds + BAR_LDS_OFF + 4) = bs1_; } } while (0)
#define PHASE_ARGS() PP q_ = (PP)__builtin_amdgcn_kernarg_segment_ptr(); int wg = blockIdx.x, nwg = gridDim.x; asm volatile("" : "+s"(q_), "+s"(wg), "+s"(nwg)); P p; { const __attribute__((address_space(4))) unsigned long long* s64_ = (const __attribute__((address_space(4))) unsigned long long*)q_; void** d64_ = (void**)&p; _Pragma("unroll") for (int i_ = 0; i_ < (int)(sizeof(P) / 8); ++i_) d64_[i_] = (void*)(__attribute__((address_space(1))) void*)s64_[i_]; } float* sm = (float*)dlds; LDSP char* lds = (LDSP char*)dlds; (void)sm; (void)lds
__global__ void __launch_bounds__(256, 2) k_mega(P pk) {
    extern __shared__ __attribute__((aligned(16))) unsigned char dlds[];
    if (threadIdx.x == 0) *(uint4*)(dlds + BAR_LDS_OFF) = make_uint4(0u, 0u, 0u, 0u);
    __syncthreads();
    (void)xcd_barrier_post(pk.bar, (volatile LAS unsigned*)(dlds + BAR_LDS_OFF));
    { PHASE_ARGS(); st_prologue(p, wg, nwg, sm); st_build_luts(p, wg, nwg); st_convert(p, wg, nwg, sm); } PHASE_SYNC();
    { PHASE_ARGS(); st_norm<0>(p, 0, wg, nwg, sm); st_c1_reduce(p, wg, nwg); } PHASE_SYNC();
    { PHASE_ARGS(); BAR_SAVE(); st_inproj0_mf<6>(p, wg, nwg, lds); BAR_RESTORE(); } PHASE_SYNC();
    { PHASE_ARGS(); st_cmp1_mf(p, wg, nwg, lds); st_kmean(p, wg, nwg, sm); } PHASE_SYNC();
    { PHASE_ARGS(); st_cmp2_mf(p, wg, nwg, lds); st_moba_gate(p, wg, nwg, lds); } PHASE_SYNC();
    { PHASE_ARGS(); st_attn0(p, lds); } PHASE_SYNC();
    { PHASE_ARGS(); st_moba_own(p, wg, nwg, lds); } PHASE_SYNC();
    { PHASE_ARGS(); st_outproj_mf<4>(p, 0, wg, nwg, lds); } PHASE_SYNC();
    { PHASE_ARGS(); st_norm<1>(p, 0, wg, nwg, sm); } PHASE_SYNC();
    { PHASE_ARGS(); BAR_SAVE(); st_moe_up_mf<6>(p, 0, wg, nwg, lds); BAR_RESTORE(); } PHASE_SYNC();
    { PHASE_ARGS(); BAR_SAVE(); st_moe_down_mf<6>(p, 0, wg, nwg, lds); BAR_RESTORE(); } PHASE_SYNC();
    { PHASE_ARGS(); st_norm<2>(p, 1, wg, nwg, sm); } PHASE_SYNC();
    { PHASE_ARGS(); BAR_SAVE(); st_inproj1_mf<6>(p, wg, nwg, lds); BAR_RESTORE(); } PHASE_SYNC();
    { PHASE_ARGS(); st_mla_prep(p, wg, nwg); } PHASE_SYNC();
    { PHASE_ARGS(); st_mla_up_mf(p, wg, nwg, lds); } PHASE_SYNC();
    { PHASE_ARGS(); st_attn1(p, lds); } PHASE_SYNC();
    { PHASE_ARGS(); st_mla_combine(p, wg, nwg); } PHASE_SYNC();
    { PHASE_ARGS(); st_outproj_mf<4>(p, 1, wg, nwg, lds); } PHASE_SYNC();
    { PHASE_ARGS(); st_norm<1>(p, 1, wg, nwg, sm); } PHASE_SYNC();
    { PHASE_ARGS(); BAR_SAVE(); st_moe_up_mf<6>(p, 1, wg, nwg, lds); BAR_RESTORE(); } PHASE_SYNC();
    { PHASE_ARGS(); BAR_SAVE(); st_moe_down_mf<6>(p, 1, wg, nwg, lds); BAR_RESTORE(); } PHASE_SYNC();
    { PHASE_ARGS(); st_norm<3>(p, 1, wg, nwg, sm); }
}

extern "C" void kernel_launch(void* const* d_in, const int* in_sizes, int n_in, void* d_out, int out_size, void* d_ws, size_t ws_size,
                              hipStream_t stream) {
    (void)in_sizes; (void)n_in; (void)out_size; (void)ws_size;
    P p{};
    const float* const* in = (const float* const*)d_in;
    p.x = in[0]; p.c = in[1]; p.rel = in[2]; p.router_w = in[3]; p.router_b = in[4]; p.final_norm = in[5]; p.norm_mix = in[6]; p.norm_ffn = in[7];
    p.ada_w = in[8]; p.ada_b = in[9]; p.moe_wg = in[10]; p.moe_wu = in[11]; p.moe_wd = in[12]; p.ev_w_in = in[13]; p.ev_w_out = in[14];
    p.pos_k = in[15]; p.pos_v = in[16]; p.ck_w1 = in[17]; p.ck_w2 = in[18]; p.cv_w1 = in[19]; p.cv_w2 = in[20]; p.od_w_in = in[21]; p.od_w_out = in[22];
    p.q_norm = in[23]; p.kv_norm = in[24]; p.w_q_up = in[25]; p.w_kv_up = in[26]; p.sinks = in[27];
    p.out = (float*)d_out;
    char* ws = (char*)d_ws; size_t off = 0;
    auto take = [&](size_t bytes) { char* r = ws + off; off += (bytes + 255) & ~(size_t)255; return r; };
    p.bar = (unsigned*)take(16384);
    p.cnt = (int*)take(4096);
    p.wq = (int*)take(256);
    p.mcnt = (int*)take(512 * 4);
    p.modv = (float*)take(2 * 2 * 6144 * 4);
    p.zrow = (bf16_t*)take(256);
    const size_t zero_bytes = off;
    p.ropec = (float*)take(SEQ * 32 * 4); p.ropes = (float*)take(SEQ * 32 * 4);
    p.blut = (float*)take(8 * 1024 * 4);
    p.glutg = (float*)take((8 * 1152 + 128) * 4); p.wlutg = (float*)take(8 * 640 * 4);
    p.gates = (float*)take((size_t)T_TOK * 24 * 4);
    p.kmean = (float*)take(2 * 8 * 32 * 64 * 4);
    p.tokw = (float*)take((size_t)T_TOK * 2 * 4);
    p.list = (int*)take((size_t)16 * T_TOK * 4);
    p.cqn = (bf16_t*)take((size_t)T_TOK * 384 * 2);
    p.krope = (bf16_t*)take((size_t)T_TOK * 64 * 2);
    p.h = (bf16_t*)take((size_t)T_TOK * DM * 2);
    p.o = (bf16_t*)take((size_t)T_TOK * DM * 2);
    p.mlap = p.h;
    p.mlal = (float*)(p.h + (size_t)2 * 8 * (SEQ / 2) * 128);
    p.mp01 = p.h;
    p.mp2 = (bf16_t*)take((size_t)131072 * 64 * 2);
    p.mpl = (float*)take((size_t)3 * 131072 * 4);
    p.mlist = (unsigned short*)take((size_t)16 * 32 * 8192 * 2);
    p.hid = p.o;
    char* region = take((size_t)100 * 1024 * 1024);
    p.proj = (bf16_t*)region;
    p.proj1 = (bf16_t*)region;
    p.qmla = (bf16_t*)(region + (size_t)T_TOK * 1216 * 2);
    p.kvmla = (bf16_t*)(region + (size_t)T_TOK * (1216 + 768) * 2);
    p.y = (bf16_t*)region;
    p.xr1 = (bf16_t*)d_out;
    p.xr2 = (bf16_t*)((char*)d_out + (size_t)T_TOK * DM * 2);
    p.xr3 = (bf16_t*)(region + (size_t)2 * T_TOK * DM * 2);
    p.chidb = (bf16_t*)take((size_t)2 * 2048 * 256 * 2);
    p.kcmpb = (bf16_t*)take((size_t)8 * 512 * 64 * 2);
    p.kmeanb = (bf16_t*)take((size_t)2 * 8 * 32 * 64 * 2);
    p.c1 = (float*)take(512 * 4);
    p.c1p = (float*)take((size_t)2 * 64 * 256 * 4);
    p.wt_gu = (bf16_t*)take((size_t)32 * 1024 * 1024 * 2);
    p.wt_d = (bf16_t*)take((size_t)32 * 1024 * 512 * 2);
    p.wt_in0 = (bf16_t*)take((size_t)2840 * 1024 * 2);
    p.wt_out0 = (bf16_t*)take((size_t)1024 * 1024 * 2);
    p.wt_c1 = (bf16_t*)take((size_t)2 * 256 * 2048 * 2);
    p.wt_c2 = (bf16_t*)take((size_t)2 * 64 * 256 * 2);
    p.wt_in1 = (bf16_t*)take((size_t)1216 * 1024 * 2);
    p.wt_out1 = (bf16_t*)take((size_t)1024 * 1024 * 2);
    p.wt_qup = (bf16_t*)take((size_t)768 * 256 * 2);
    p.wt_kvup = (bf16_t*)take((size_t)1024 * 128 * 2);
    static int grid = 0;
    if (!grid) {
        int dev = 0, cus = 0, per_cu = 0;
        (void)hipGetDevice(&dev);
        (void)hipDeviceGetAttribute(&cus, hipDeviceAttributeMultiprocessorCount, dev);
        (void)hipFuncSetAttribute((const void*)k_mega, hipFuncAttributeMaxDynamicSharedMemorySize, KERNEL_LDS_BYTES);
        (void)hipOccupancyMaxActiveBlocksPerMultiprocessor(&per_cu, k_mega, 256, KERNEL_LDS_BYTES);
        if (cus <= 0) cus = 256;
        if (per_cu < 1) per_cu = 1;
        grid = cus * (per_cu < 2 ? per_cu : 2);
    }
    (void)hipMemsetAsync(d_ws, 0, zero_bytes, stream);
    hipLaunchKernelGGL(k_mega, dim3(grid), dim3(256), KERNEL_LDS_BYTES, stream, p);
}
```
